# Optimizing an MI355X kernel written in HIP

```python
import math
import jax, jax.numpy as jnp
from jax import lax
import numpy as np

D_MODEL = 2048
BATCH = 8
SEQ = 4096
DEPTH = 2

N_META = 16
MLA_HEADS = 16
MLA_NOPE_DIM = 128
MLA_ROPE_DIM = 64
MLA_V_DIM = 128
MLA_Q_RANK = 768
MLA_KV_RANK = 512
SWA_HEADS = 16
SWA_KV_HEADS = 4
SWA_GROUP = SWA_HEADS // SWA_KV_HEADS
SWA_HEAD_DIM = 128
WINDOW = 128
BLOCK = 128
N_BUCKETS = 32
MAX_DISTANCE = 128
D_FF = 5632
N_EXPERTS = 8
TOP_K = 2
MOE_BLOCK = 512
N_DENSE = (DEPTH + 1) // 2
N_MOE = DEPTH // 2
ROPE_THETA = 10000.0
LN_EPS = 1e-5
RMS_EPS = 1e-6
ALPHA = (2 * DEPTH) ** 0.25
BETA = (8 * DEPTH) ** -0.25
NEG = -1e30
SPLITS = (MLA_Q_RANK, MLA_KV_RANK, MLA_ROPE_DIM, SWA_HEADS * SWA_HEAD_DIM,
          SWA_KV_HEADS * SWA_HEAD_DIM, SWA_KV_HEADS * SWA_HEAD_DIM, D_MODEL, D_MODEL)
IN_DIM = sum(SPLITS)

kernel_name = 'hybrid_mla_swa_gated_moe_encoder'


def layer_norm(x, g, b):
    xf = x.astype(jnp.float32)
    mu = xf.mean(-1, keepdims=True)
    var = jnp.square(xf - mu).mean(-1, keepdims=True)
    y = (xf - mu) * lax.rsqrt(var + LN_EPS) * g.astype(jnp.float32) + b.astype(jnp.float32)
    return y.astype(x.dtype)


def rms_norm(x, g):
    xf = x.astype(jnp.float32)
    y = xf * lax.rsqrt(jnp.square(xf).mean(-1, keepdims=True) + RMS_EPS) * g.astype(jnp.float32)
    return y.astype(x.dtype)


def rope_tables(n):
    pos = jnp.arange(n, dtype=jnp.float32)
    inv = ROPE_THETA ** (-jnp.arange(0, MLA_ROPE_DIM, 2, dtype=jnp.float32) / MLA_ROPE_DIM)
    ang = pos[:, None] * inv[None, :]
    return jnp.cos(ang), jnp.sin(ang)


def apply_rope(x, cos, sin):
    half = x.shape[-1] // 2
    x1 = x[..., :half].astype(jnp.float32)
    x2 = x[..., half:].astype(jnp.float32)
    return jnp.concatenate([x1 * cos - x2 * sin, x1 * sin + x2 * cos], -1).astype(x.dtype)


def rel_bucket(rel):
    nb = N_BUCKETS // 2
    max_exact = nb // 2
    n = jnp.abs(rel)
    large = max_exact + (jnp.log(jnp.maximum(n, 1).astype(jnp.float32) / max_exact)
                         / math.log(MAX_DISTANCE / max_exact) * (nb - max_exact)).astype(jnp.int32)
    large = jnp.minimum(large, nb - 1)
    return jnp.where(rel > 0, nb, 0) + jnp.where(n < max_exact, n, large)


def mla_attend(q_nope, q_rope, k_nope, k_rope, v):
    scale = (MLA_NOPE_DIM + MLA_ROPE_DIM) ** -0.5
    s = (jnp.einsum('bqhd,bkhd->bhqk', q_nope, k_nope)
         + jnp.einsum('bqhd,bkd->bhqk', q_rope, k_rope)).astype(jnp.float32) * scale
    p = jax.nn.softmax(s, axis=-1).astype(v.dtype)
    return jnp.einsum('bhqk,bkhd->bqhd', p, v)


def mla_branch(c_q, c_kv, k_rope_raw, q_norm_g, kv_norm_g, w_uq, w_ukv, cos, sin):
    bsz, n_tok, _ = c_q.shape
    q = (rms_norm(c_q, q_norm_g) @ w_uq).reshape(bsz, n_tok, MLA_HEADS, MLA_NOPE_DIM + MLA_ROPE_DIM)
    q_nope = q[..., :MLA_NOPE_DIM]
    q_rope = apply_rope(q[..., MLA_NOPE_DIM:], cos[None, :, None], sin[None, :, None])
    kv = (rms_norm(c_kv, kv_norm_g) @ w_ukv).reshape(bsz, n_tok, MLA_HEADS, MLA_NOPE_DIM + MLA_V_DIM)
    k_nope = kv[..., :MLA_NOPE_DIM]
    v = kv[..., MLA_NOPE_DIM:]
    k_rope = apply_rope(k_rope_raw, cos[None], sin[None])
    n_blk = (n_tok - N_META) // BLOCK

    def to_blocks(t):
        return jnp.moveaxis(t[:, N_META:].reshape(bsz, n_blk, BLOCK, *t.shape[2:]), 1, 0)

    o_meta = mla_attend(q_nope[:, :N_META], q_rope[:, :N_META], k_nope, k_rope, v)
    o_real = lax.map(lambda a: mla_attend(a[0], a[1], k_nope, k_rope, v),
                     (to_blocks(q_nope), to_blocks(q_rope)))
    o_real = jnp.moveaxis(o_real, 0, 1).reshape(bsz, n_tok - N_META, MLA_HEADS, MLA_V_DIM)
    return jnp.concatenate([o_meta, o_real], 1).reshape(bsz, n_tok, MLA_HEADS * MLA_V_DIM)


def swa_attend(q, k, v, q_pos, k_pos, always, in_range, rel_bias, sink):
    rel = k_pos[None, :] - q_pos[:, None]
    visible = always[None, :] | (in_range[None, :] & (jnp.abs(rel) <= WINDOW))
    n_q, n_k = rel.shape
    bias = jnp.transpose(rel_bias[rel_bucket(rel)], (2, 0, 1)).reshape(
        SWA_KV_HEADS, SWA_GROUP, n_q, n_k).astype(jnp.float32)
    s = jnp.einsum('bqhgd,bnhd->bhgqn', q, k).astype(jnp.float32) * SWA_HEAD_DIM ** -0.5 + bias
    s = jnp.where(visible, s, NEG)
    sink_col = jnp.broadcast_to(sink.astype(jnp.float32).reshape(SWA_KV_HEADS, SWA_GROUP, 1, 1),
                                s.shape[:-1] + (1,))
    p = jax.nn.softmax(jnp.concatenate([s, sink_col], -1), axis=-1)[..., :-1].astype(v.dtype)
    return jnp.einsum('bhgqn,bnhd->bqhgd', p, v)


def swa_branch(q, k, v, rel_bias, sink):
    bsz, n_tok, _ = q.shape
    n_real = n_tok - N_META
    n_blk = n_real // BLOCK
    q = q.reshape(bsz, n_tok, SWA_KV_HEADS, SWA_GROUP, SWA_HEAD_DIM)
    k = k.reshape(bsz, n_tok, SWA_KV_HEADS, SWA_HEAD_DIM)
    v = v.reshape(bsz, n_tok, SWA_KV_HEADS, SWA_HEAD_DIM)
    k_meta, v_meta = k[:, :N_META], v[:, :N_META]
    meta_pos = jnp.arange(N_META)
    mk_pos = jnp.arange(N_META + BLOCK)
    o_meta = swa_attend(q[:, :N_META], k[:, :N_META + BLOCK], v[:, :N_META + BLOCK], meta_pos, mk_pos,
                        mk_pos < N_META, jnp.ones((N_META + BLOCK,), bool), rel_bias, sink)
    pad = ((0, 0), (BLOCK, BLOCK), (0, 0), (0, 0))
    k_pad = jnp.pad(k[:, N_META:], pad)
    v_pad = jnp.pad(v[:, N_META:], pad)
    band = jnp.arange(3 * BLOCK)
    always = jnp.concatenate([jnp.ones((N_META,), bool), jnp.zeros((3 * BLOCK,), bool)])
    q_blocks = jnp.moveaxis(q[:, N_META:].reshape(bsz, n_blk, BLOCK, SWA_KV_HEADS, SWA_GROUP,
                                                  SWA_HEAD_DIM), 1, 0)

    def block(args):
        qb, i = args
        start = i * BLOCK
        kb = lax.dynamic_slice_in_dim(k_pad, start, 3 * BLOCK, axis=1)
        vb = lax.dynamic_slice_in_dim(v_pad, start, 3 * BLOCK, axis=1)
        r_key = start - BLOCK + band
        k_pos = jnp.concatenate([meta_pos, N_META + r_key])
        in_range = jnp.concatenate([jnp.ones((N_META,), bool), (r_key >= 0) & (r_key < n_real)])
        q_pos = N_META + start + jnp.arange(BLOCK)
        return swa_attend(qb, jnp.concatenate([k_meta, kb], 1), jnp.concatenate([v_meta, vb], 1),
                          q_pos, k_pos, always, in_range, rel_bias, sink)

    o_real = lax.map(block, (q_blocks, jnp.arange(n_blk)))
    o_real = jnp.moveaxis(o_real, 0, 1).reshape(bsz, n_real, SWA_KV_HEADS, SWA_GROUP, SWA_HEAD_DIM)
    return jnp.concatenate([o_meta, o_real], 1).reshape(bsz, n_tok, SWA_HEADS * SWA_HEAD_DIM)


def mixer(h, w_in, q_norm_g, kv_norm_g, w_uq, w_ukv, sink, w_proj_a, w_proj_b, w_out,
          rel_bias, cos, sin):
    z = h @ w_in
    points = [int(p) for p in np.cumsum(SPLITS)[:-1]]
    c_q, c_kv, k_r, q_b, k_b, v_b, g_a, g_b = jnp.split(z, points, axis=-1)
    o_a = mla_branch(c_q, c_kv, k_r, q_norm_g, kv_norm_g, w_uq, w_ukv, cos, sin)
    o_b = swa_branch(q_b, k_b, v_b, rel_bias, sink)
    merged = jax.nn.sigmoid(g_a) * (o_a @ w_proj_a) + jax.nn.sigmoid(g_b) * (o_b @ w_proj_b)
    return merged @ w_out


def dense_swiglu(h, w1, w3, w2):
    def per_seq(hb):
        return (jax.nn.silu(hb @ w1) * (hb @ w3)) @ w2
    return lax.map(per_seq, h)


def moe_swiglu(h, router_w, router_b, w1, w3, w2):
    bsz, n_tok, dm = h.shape
    n = bsz * n_tok
    xt = h.reshape(n, dm)
    logits = (xt @ router_w).astype(jnp.float32) + router_b.astype(jnp.float32)
    top_val, top_idx = lax.top_k(logits, TOP_K)
    gate = jax.nn.softmax(top_val, axis=-1)
    n_assign = n * TOP_K
    e_flat = top_idx.reshape(n_assign)
    tok_flat = jnp.arange(n_assign) // TOP_K
    g_flat = gate.reshape(n_assign)
    order = jnp.argsort(e_flat)
    e_sorted = e_flat[order]
    counts = jnp.bincount(e_flat, length=N_EXPERTS)
    padded = (counts + MOE_BLOCK - 1) // MOE_BLOCK * MOE_BLOCK
    pad_end = jnp.cumsum(padded)
    pad_start = pad_end - padded
    start = jnp.cumsum(counts) - counts
    dest = pad_start[e_sorted] + jnp.arange(n_assign) - start[e_sorted]
    n_blocks = -(-n_assign // MOE_BLOCK) + N_EXPERTS
    n_slots = n_blocks * MOE_BLOCK
    slot_tok = jnp.full((n_slots,), n, jnp.int32).at[dest].set(tok_flat[order].astype(jnp.int32))
    slot_gate = jnp.zeros((n_slots,), jnp.float32).at[dest].set(g_flat[order])
    block_expert = jnp.minimum(jnp.searchsorted(pad_end, jnp.arange(n_blocks) * MOE_BLOCK, side='right'),
                               N_EXPERTS - 1)
    x_pad = jnp.concatenate([xt, jnp.zeros((1, dm), xt.dtype)], 0)

    def expert_block(args):
        toks, e = args
        xb = x_pad[toks]
        return (jax.nn.silu(xb @ w1[e]) * (xb @ w3[e])) @ w2[e]

    y = lax.map(expert_block, (slot_tok.reshape(n_blocks, MOE_BLOCK), block_expert)).reshape(n_slots, dm)
    out = jax.ops.segment_sum(y * slot_gate[:, None].astype(y.dtype), slot_tok, num_segments=n + 1)[:n]
    return out.reshape(bsz, n_tok, dm)


def setup_inputs(seed: int = 0) -> dict:
    key = jax.random.key(seed)
    ks = jax.random.split(key, 26)

    def nrm(k, shape, scale):
        return jax.random.normal(k, shape, jnp.float32) * scale

    d = D_MODEL
    return {
        'x': nrm(ks[0], (BATCH, SEQ, d), 1.0),
        'meta_tokens': nrm(ks[1], (N_META, d), 1.0),
        'emb_ln_g': 1.0 + nrm(ks[2], (d,), 0.1),
        'emb_ln_b': nrm(ks[3], (d,), 0.02),
        'rel_bias': nrm(ks[4], (N_BUCKETS, SWA_HEADS), 0.5),
        'w_in': nrm(ks[5], (DEPTH, d, IN_DIM), d ** -0.5),
        'q_norm_g': 1.0 + nrm(ks[6], (DEPTH, MLA_Q_RANK), 0.1),
        'kv_norm_g': 1.0 + nrm(ks[7], (DEPTH, MLA_KV_RANK), 0.1),
        'w_uq': nrm(ks[8], (DEPTH, MLA_Q_RANK, MLA_HEADS * (MLA_NOPE_DIM + MLA_ROPE_DIM)), MLA_Q_RANK ** -0.5),
        'w_ukv': nrm(ks[9], (DEPTH, MLA_KV_RANK, MLA_HEADS * (MLA_NOPE_DIM + MLA_V_DIM)), MLA_KV_RANK ** -0.5),
        'sink_logits': nrm(ks[10], (DEPTH, SWA_HEADS), 0.5),
        'w_proj_a': nrm(ks[11], (DEPTH, MLA_HEADS * MLA_V_DIM, d), BETA * (MLA_HEADS * MLA_V_DIM) ** -0.5),
        'w_proj_b': nrm(ks[12], (DEPTH, SWA_HEADS * SWA_HEAD_DIM, d), BETA * (SWA_HEADS * SWA_HEAD_DIM) ** -0.5),
        'w_out': nrm(ks[13], (DEPTH, d, d), BETA * d ** -0.5),
        'ln_mix_g': 1.0 + nrm(ks[14], (DEPTH, d), 0.1),
        'ln_mix_b': nrm(ks[15], (DEPTH, d), 0.02),
        'ln_ffn_g': 1.0 + nrm(ks[16], (DEPTH, d), 0.1),
        'ln_ffn_b': nrm(ks[17], (DEPTH, d), 0.02),
        'ffn_w1': nrm(ks[18], (N_DENSE, d, D_FF), d ** -0.5),
        'ffn_w3': nrm(ks[19], (N_DENSE, d, D_FF), d ** -0.5),
        'ffn_w2': nrm(ks[20], (N_DENSE, D_FF, d), BETA * D_FF ** -0.5),
        'router_w': nrm(ks[21], (N_MOE, d, N_EXPERTS), d ** -0.5),
        'router_b': nrm(ks[22], (N_MOE, N_EXPERTS), 0.01),
        'moe_w1': nrm(ks[23], (N_MOE, N_EXPERTS, d, D_FF), d ** -0.5),
        'moe_w3': nrm(ks[24], (N_MOE, N_EXPERTS, d, D_FF), d ** -0.5),
        'moe_w2': nrm(ks[25], (N_MOE, N_EXPERTS, D_FF, d), BETA * D_FF ** -0.5),
    }


def reference(x, meta_tokens, emb_ln_g, emb_ln_b, rel_bias, w_in, q_norm_g, kv_norm_g, w_uq, w_ukv,
              sink_logits, w_proj_a, w_proj_b, w_out, ln_mix_g, ln_mix_b, ln_ffn_g, ln_ffn_b,
              ffn_w1, ffn_w3, ffn_w2, router_w, router_b, moe_w1, moe_w3, moe_w2):
    bsz = x.shape[0]
    meta = jnp.broadcast_to(meta_tokens[None].astype(x.dtype), (bsz, N_META, x.shape[-1]))
    h = layer_norm(jnp.concatenate([meta, x], 1), emb_ln_g, emb_ln_b)
    cos, sin = rope_tables(h.shape[1])
    for l in range(DEPTH):
        m = mixer(h, w_in[l], q_norm_g[l], kv_norm_g[l], w_uq[l], w_ukv[l], sink_logits[l],
                  w_proj_a[l], w_proj_b[l], w_out[l], rel_bias, cos, sin)
        h = layer_norm(ALPHA * h + m, ln_mix_g[l], ln_mix_b[l])
        if l % 2 == 0:
            f = dense_swiglu(h, ffn_w1[l // 2], ffn_w3[l // 2], ffn_w2[l // 2])
        else:
            f = moe_swiglu(h, router_w[l // 2], router_b[l // 2], moe_w1[l // 2], moe_w3[l // 2],
                           moe_w2[l // 2])
        h = layer_norm(ALPHA * h + f, ln_ffn_g[l], ln_ffn_b[l])
    return h[:, N_META:]
```

```cpp
#define MK_ONE_LAUNCH 1
#include <hip/hip_runtime.h>
#include <cstdio>
#include <cstdint>
namespace pg8 {
#define PG8_LAS __attribute__((address_space(3)))
typedef unsigned short bf16_t;
typedef short bf16x8 __attribute__((ext_vector_type(8)));
typedef float f32x4 __attribute__((ext_vector_type(4)));
typedef float f32x2 __attribute__((ext_vector_type(2)));
typedef unsigned u32x4 __attribute__((ext_vector_type(4)));
typedef unsigned u32x2 __attribute__((ext_vector_type(2)));
constexpr int BM = 256, BK = 64, HALF = 128, HTB = HALF * BK * 2  , STAGE_BYTES = 8 * HTB, NXCD = 8, WGM = 8;

__host__ __device__ __forceinline__ int lds_byte(int r, int c) { const int st = (r >> 4) * 2 + (c >> 5), rr = r & 15, cc = c & 31, ob = rr * 64 + cc * 2; return st * 1024 + (ob ^ (((ob >> 9) & 1) << 5)); }
__host__ __device__ __forceinline__ void stage_rc(int b, int& R, int& C) { const int st = b / 1024, sb = b % 1024, swz = sb ^ (((sb >> 9) & 1) << 5); R = (st >> 1) * 16 + swz / 64; C = (st & 1) * 32 + (swz % 64) / 2; }
__host__ __device__ __forceinline__ int perm32(int rho) { const int n = rho >> 4, i = rho & 15; return 8 * (i >> 2) + 4 * n + (i & 3); }

struct Unit { int pm, pn; };

struct StaticOrder {
    int nM, nN, nwg, G, c;
    __device__ __forceinline__ void init(int nM_, int nN_, int G_, int c_) { nM = nM_; nN = nN_; nwg = nM * nN; G = G_; c = c_; }
    __device__ __forceinline__ bool next(int i, Unit& u) const {
        const long L = (long)i * G + c; if (L >= nwg) return false;
        int wgid = (int)L; { const int q = nwg / NXCD, r = nwg % NXCD, xcd = wgid % NXCD, off = wgid / NXCD; wgid = (xcd < r ? xcd * (q + 1) : r * (q + 1) + (xcd - r) * q) + off; }
        const int nig = WGM * nN, gid = wgid / nig, fm = gid * WGM, gsz = (nM - fm) < WGM ? (nM - fm) : WGM;
        u.pm = fm + ((wgid % nig) % gsz); u.pn = (wgid % nig) / gsz; return true;
    }
};
__device__ __forceinline__ unsigned cvt_pk_bf16(float lo, float hi) { unsigned r; asm volatile("v_cvt_pk_bf16_f32 %0, %1, %2" : "=v"(r) : "v"(lo), "v"(hi)); return r; }
__device__ __forceinline__ float bf_lo(unsigned w) { return __uint_as_float(w << 16); }
__device__ __forceinline__ float bf_hi(unsigned w) { return __uint_as_float(w & 0xffff0000u); }

template <class Epi, class Prob, bool GATHER = false>
__device__ __forceinline__ void gemm_phase(PG8_LAS unsigned char* lds, const int K, const Prob& S, const Epi& E) {
    int tid_ = threadIdx.x; asm volatile("" : "+v"(tid_));
    const int tid = tid_, wid = __builtin_amdgcn_readfirstlane(tid >> 6), lane = tid & 63, wr = wid >> 2, wc = wid & 3, fr = lane & 15, fq = lane >> 4;
    const int nt = K / BK;
    int sR[2], sC[2];
    unsigned voffA[2][2], nvoffA[2][2], voffB[2];
#pragma unroll
    for (int i = 0; i < 2; ++i) { int R, C; stage_rc(tid * 16 + i * 8192, R, C); sR[i] = R; sC[i] = C; const int Rb = (R & ~31) + perm32(R & 31);
        voffB[i] = (unsigned)(Rb * K + C) * 2u;
        voffA[0][i] = (unsigned)(R * K + C) * 2u; voffA[1][i] = (unsigned)((R + HALF) * K + C) * 2u; nvoffA[0][i] = voffA[0][i]; nvoffA[1][i] = voffA[1][i]; }
    const size_t kstep = (size_t)(BK * 2);
    const size_t hstep = (size_t)HALF * K * 2;
    const unsigned ldsw = (unsigned)wid * 1024u;
    const int aoff = lds_byte(wr * 64 + fr, fq * 8), boff = lds_byte(wc * 32 + fr, fq * 8);
#define PG8_SA(b, h) (((b) * 2 + (h)) * HTB)
#define PG8_SB(b, h) ((4 + (b) * 2 + (h)) * HTB)
#define PG8_STAGE(bufoff, gbase, voff) do { _Pragma("unroll") for (int _i = 0; _i < 2; ++_i) \
        __builtin_amdgcn_global_load_lds((const unsigned*)((const char*)(gbase) + (voff)[_i]), (PG8_LAS unsigned*)(lds + (bufoff) + ldsw + _i * 8192), 16, 0, 0); } while (0)
#define PG8_LDA(dst, b, h) do { _Pragma("unroll") for (int m = 0; m < 4; ++m) _Pragma("unroll") for (int k = 0; k < 2; ++k) dst[m][k] = *(const PG8_LAS bf16x8*)(lds + PG8_SA(b, h) + aoff + m * 2048 + k * 1024); } while (0)
#define PG8_LDB(dst, b, h) do { _Pragma("unroll") for (int n = 0; n < 2; ++n) _Pragma("unroll") for (int k = 0; k < 2; ++k) dst[n][k] = *(const PG8_LAS bf16x8*)(lds + PG8_SB(b, h) + boff + n * 2048 + k * 1024); } while (0)
#define PG8_MMA(ai, bj, At, Bt) do { __builtin_amdgcn_s_setprio(1); _Pragma("unroll") for (int m = 0; m < 4; ++m) _Pragma("unroll") for (int n = 0; n < 2; ++n) _Pragma("unroll") for (int k = 0; k < 2; ++k) \
        acc[ai][bj][m][n] = __builtin_amdgcn_mfma_f32_16x16x32_bf16(Bt[n][k], At[m][k], acc[ai][bj][m][n], 0, 0, 0); __builtin_amdgcn_s_setprio(0); } while (0)
#define PG8_WAIT_V(n) asm volatile("s_waitcnt vmcnt(" #n ")" ::: "memory")
#define PG8_WAIT_L(n) asm volatile("s_waitcnt lgkmcnt(" #n ")" ::: "memory")
#define PG8_BAR __builtin_amdgcn_s_barrier()
#define PG8_SCHED __builtin_amdgcn_sched_barrier(0)
    Unit cur, nxt; int ui = 0;
    if (!S.next(0, cur)) return;
    f32x4 acc[2][2][4][2];
#pragma unroll
    for (int a = 0; a < 2; ++a)
#pragma unroll
        for (int b = 0; b < 2; ++b)
#pragma unroll
            for (int m = 0; m < 4; ++m)
#pragma unroll
                for (int n = 0; n < 2; ++n) acc[a][b][m][n] = (f32x4){0.f, 0.f, 0.f, 0.f};
    bf16x8 At[4][2], B0[2][2], B1[2][2];
    const char* cA = S.a_base(cur); const char* cB = S.b_base(cur);
    if constexpr (GATHER) {
#pragma unroll
        for (int h = 0; h < 2; ++h)
#pragma unroll
            for (int i = 0; i < 2; ++i) { voffA[h][i] = (unsigned)(S.a_row(cur, sR[i] + h * HALF) * K + sC[i]) * 2u; nvoffA[h][i] = voffA[h][i]; }
    }
    PG8_STAGE(PG8_SB(0, 0), cB, voffB); PG8_STAGE(PG8_SB(0, 1), cB + hstep, voffB); PG8_STAGE(PG8_SA(0, 0), cA, voffA[0]); PG8_STAGE(PG8_SA(0, 1), cA, voffA[1]);
    if (wr == 1) PG8_BAR;
    PG8_WAIT_V(2); PG8_BAR;
    PG8_STAGE(PG8_SB(1, 0), cB + kstep, voffB); PG8_STAGE(PG8_SA(1, 0), cA + kstep, voffA[0]); PG8_STAGE(PG8_SB(1, 1), cB + hstep + kstep, voffB);
    PG8_WAIT_V(6); PG8_BAR;
    for (;;) {
        const bool has_next = S.next(ui + 1, nxt);
        const char* nA = has_next ? S.a_base(nxt) : cA; const char* nB = has_next ? S.b_base(nxt) : cB;
        if constexpr (GATHER) { if (has_next) {
#pragma unroll
            for (int h = 0; h < 2; ++h)
#pragma unroll
                for (int i = 0; i < 2; ++i) nvoffA[h][i] = (unsigned)(S.a_row(nxt, sR[i] + h * HALF) * K + sC[i]) * 2u; } }
        for (int t = 0; t < nt; t += 2) {
            const bool last = (t == nt - 2);
            if constexpr (Epi::MID) { if (t == (nt >> 1)) E.mid(acc, cur, wr, wc, fr, fq); }
            const char* a1 = cA + (size_t)(t + 1) * kstep;
            const char* a2 = last ? nA : cA + (size_t)(t + 2) * kstep; const char* b2 = last ? nB : cB + (size_t)(t + 2) * kstep;
            const char* a3 = a2 + kstep; const char* b3 = b2 + kstep;
            unsigned vA2[2][2];
#pragma unroll
            for (int h = 0; h < 2; ++h)
#pragma unroll
                for (int i = 0; i < 2; ++i) vA2[h][i] = GATHER ? (last ? nvoffA[h][i] : voffA[h][i]) : voffA[h][i];
            PG8_LDB(B0, 0, 0); PG8_LDB(B1, 0, 1); PG8_SCHED; PG8_LDA(At, 0, 0); PG8_STAGE(PG8_SA(1, 1), a1, voffA[1]);
            PG8_WAIT_V(8); PG8_WAIT_L(0); PG8_BAR; PG8_MMA(0, 0, At, B0); PG8_MMA(0, 1, At, B1); PG8_BAR; PG8_SCHED;
            PG8_LDA(At, 0, 1); PG8_STAGE(PG8_SB(0, 0), b2, voffB); PG8_STAGE(PG8_SB(0, 1), b2 + hstep, voffB); PG8_STAGE(PG8_SA(0, 0), a2, vA2[0]);
            PG8_WAIT_V(8); PG8_WAIT_L(0); PG8_BAR; PG8_MMA(1, 0, At, B0); PG8_MMA(1, 1, At, B1); PG8_BAR; PG8_SCHED;
            PG8_LDB(B0, 1, 0); PG8_LDB(B1, 1, 1); PG8_SCHED; PG8_LDA(At, 1, 0); PG8_STAGE(PG8_SA(0, 1), a2, vA2[1]);
            PG8_WAIT_V(8); PG8_WAIT_L(0); PG8_BAR; PG8_MMA(0, 0, At, B0); PG8_MMA(0, 1, At, B1); PG8_BAR; PG8_SCHED;
            PG8_LDA(At, 1, 1); PG8_STAGE(PG8_SB(1, 0), b3, voffB); PG8_STAGE(PG8_SB(1, 1), b3 + hstep, voffB); PG8_STAGE(PG8_SA(1, 0), a3, vA2[0]);
            PG8_WAIT_V(8); PG8_WAIT_L(0); PG8_BAR; PG8_MMA(1, 0, At, B0); PG8_MMA(1, 1, At, B1); PG8_BAR; PG8_SCHED;
        }
        if (wr == 0) PG8_BAR;
        E(acc, cur, wr, wc, fr, fq);
        if (!has_next) break;
#pragma unroll
        for (int a = 0; a < 2; ++a)
#pragma unroll
            for (int b = 0; b < 2; ++b)
#pragma unroll
                for (int m = 0; m < 4; ++m)
#pragma unroll
                    for (int n = 0; n < 2; ++n) acc[a][b][m][n] = (f32x4){0.f, 0.f, 0.f, 0.f};
        cur = nxt; cA = nA; cB = nB; ++ui;
        if constexpr (GATHER) {
#pragma unroll
            for (int h = 0; h < 2; ++h)
#pragma unroll
                for (int i = 0; i < 2; ++i) voffA[h][i] = nvoffA[h][i]; }
        if (wr == 1) PG8_BAR;
    }
    PG8_WAIT_V(0);
    PG8_BAR;
#undef PG8_SA
#undef PG8_SB
#undef PG8_STAGE
#undef PG8_LDA
#undef PG8_LDB
#undef PG8_MMA
#undef PG8_WAIT_V
#undef PG8_WAIT_L
#undef PG8_BAR
#undef PG8_SCHED
}
}
constexpr int D = 2048, NB = 8, SEQ = 4096, NMETA = 16, NH = 16;
constexpr int TREAL = NB * SEQ;
constexpr int T = TREAL + NB * NMETA;
constexpr int TP = 33024;
constexpr int LPOS = SEQ + NMETA;
constexpr int QRANK = 768, KVRANK = 512, DFF = 5632, NE = 8;
constexpr int NIN = 8704;
constexpr int INDIM = 8512;
constexpr float LN_EPS = 1e-5f, RMS_EPS = 1e-6f, ALPHA = 1.4142135623730951f;
constexpr float LOG2E = 1.4426950408889634f;
constexpr float QK_SCALE_MLA = 0.07216878364870322f * LOG2E;
constexpr float QK_SCALE_SWA = 0.08838834764831845f * LOG2E;

__device__ __forceinline__ int row_pos(int row) { return row < TREAL ? NMETA + (row & (SEQ - 1)) : ((row - TREAL) & (NMETA - 1)); }

struct ProbDense {
    pg8::StaticOrder so; const char* A; const char* Bt; size_t tstep;
    __device__ __forceinline__ bool next(int i, pg8::Unit& u) const { return so.next(i, u); }
    __device__ __forceinline__ const char* a_base(const pg8::Unit& u) const { return A + (size_t)u.pm * tstep; }
    __device__ __forceinline__ const char* b_base(const pg8::Unit& u) const { return Bt + (size_t)u.pn * tstep; }
    __device__ __forceinline__ int a_row(const pg8::Unit&, int) const { return 0; }
};
struct MoeTiles { int ts[9]; };
__device__ __forceinline__ int moe_expert(const MoeTiles& mt, int pm) { int e = 0;
#pragma unroll
    for (int k = 1; k < 8; ++k) e += (pm >= mt.ts[k]) ? 1 : 0; return e; }
struct ProbMoe1 {
    pg8::StaticOrder so; const char* HBp; const int* slot_tok; const char* W; MoeTiles mt;
    __device__ __forceinline__ bool next(int i, pg8::Unit& u) const { return so.next(i, u); }
    __device__ __forceinline__ const char* a_base(const pg8::Unit&) const { return HBp; }
    __device__ __forceinline__ const char* b_base(const pg8::Unit& u) const { return W + (size_t)moe_expert(mt, u.pm) * ((size_t)2 * DFF * D * 2) + (size_t)u.pn * (256 * (size_t)D * 2); }
    __device__ __forceinline__ int a_row(const pg8::Unit& u, int r) const { return slot_tok[u.pm * 256 + r]; }
};
struct ProbMoe2 {
    pg8::StaticOrder so; const char* ACTp; const char* W; MoeTiles mt;
    __device__ __forceinline__ bool next(int i, pg8::Unit& u) const { return so.next(i, u); }
    __device__ __forceinline__ const char* a_base(const pg8::Unit& u) const { return ACTp + (size_t)u.pm * (256 * (size_t)DFF * 2); }
    __device__ __forceinline__ const char* b_base(const pg8::Unit& u) const { return W + (size_t)moe_expert(mt, u.pm) * ((size_t)D * DFF * 2) + (size_t)u.pn * (256 * (size_t)DFF * 2); }
    __device__ __forceinline__ int a_row(const pg8::Unit&, int) const { return 0; }
};

namespace epi {
using pg8::f32x4; using pg8::u32x4; using pg8::bf16_t; using pg8::Unit; using pg8::cvt_pk_bf16;
typedef const f32x4 (&AccRef)[2][2][4][2];
__device__ __forceinline__ void store8(bf16_t* p, f32x4 v0, f32x4 v1) { u32x4 w; w.x = cvt_pk_bf16(v0[0], v0[1]); w.y = cvt_pk_bf16(v0[2], v0[3]); w.z = cvt_pk_bf16(v1[0], v1[1]); w.w = cvt_pk_bf16(v1[2], v1[3]); *(u32x4*)p = w; }
__device__ __forceinline__ void load8(const bf16_t* p, f32x4& v0, f32x4& v1) { const u32x4 w = *(const u32x4*)p;
    v0 = (f32x4){pg8::bf_lo(w.x), pg8::bf_hi(w.x), pg8::bf_lo(w.y), pg8::bf_hi(w.y)}; v1 = (f32x4){pg8::bf_lo(w.z), pg8::bf_hi(w.z), pg8::bf_lo(w.w), pg8::bf_hi(w.w)}; }
__device__ __forceinline__ bool epi_fence() { asm volatile("" ::: "memory"); return true; }
__device__ __forceinline__ float sigmoidf_(float x) { return __builtin_amdgcn_rcpf(1.f + __builtin_amdgcn_exp2f(-x * LOG2E)); }
#define EPI_AM _Pragma("unroll") for (int ai = 0; ai < 2; ++ai) _Pragma("unroll") for (int m = 0; m < 4; ++m) if (epi_fence())

struct EpiWin {
    static constexpr bool MID = false;
    bf16_t *CQ, *CKV, *KR, *QB, *KB, *VB, *GR, *GBb; float* SSQ; const float *CS, *SN;
    __device__ __forceinline__ void operator()(AccRef acc, const Unit& u, int wr, int wc, int fr, int fq) const {
        const int pn = u.pn, row0 = u.pm * 256 + wr * 64 + fr, cw = wc * 32 + fq * 8;
        if (pn < 5) {
            bf16_t* dst = pn < 3 ? CQ : CKV; const int ld = pn < 3 ? QRANK : KVRANK, c0 = (pn < 3 ? pn : pn - 3) * 256;
            EPI_AM { const int row = row0 + ai * 128 + m * 16; float s = 0.f;
#pragma unroll
                for (int bj = 0; bj < 2; ++bj) { const f32x4 v0 = acc[ai][bj][m][0], v1 = acc[ai][bj][m][1];
                    s += (v0[0] * v0[0] + v0[1] * v0[1]) + (v0[2] * v0[2] + v0[3] * v0[3]) + (v1[0] * v1[0] + v1[1] * v1[1]) + (v1[2] * v1[2] + v1[3] * v1[3]);
                    store8(dst + (size_t)row * ld + c0 + bj * 128 + cw, v0, v1); }
                s += __shfl_xor(s, 16); s += __shfl_xor(s, 32);
                if (fq == 0) SSQ[(size_t)row * 20 + pn * 4 + wc] = s; }
        } else if (pn == 5) {
            if (wc == 0) { EPI_AM { const int row = row0 + ai * 128 + m * 16, pos = row_pos(row);
                const f32x4 c0 = *(const f32x4*)(CS + pos * 32 + fq * 8), c1 = *(const f32x4*)(CS + pos * 32 + fq * 8 + 4), s0 = *(const f32x4*)(SN + pos * 32 + fq * 8), s1 = *(const f32x4*)(SN + pos * 32 + fq * 8 + 4);
                const f32x4 x10 = acc[ai][0][m][0], x11 = acc[ai][0][m][1], x20 = acc[ai][1][m][0], x21 = acc[ai][1][m][1];
                store8(KR + (size_t)row * 64 + fq * 8, x10 * c0 - x20 * s0, x11 * c1 - x21 * s1);
                store8(KR + (size_t)row * 64 + 32 + fq * 8, x10 * s0 + x20 * c0, x11 * s1 + x21 * c1); } }
        } else if (pn < 14) {
            EPI_AM { const int row = row0 + ai * 128 + m * 16;
#pragma unroll
                for (int bj = 0; bj < 2; ++bj) store8(QB + (size_t)row * 2048 + (pn - 6) * 256 + bj * 128 + cw, acc[ai][bj][m][0] * QK_SCALE_SWA, acc[ai][bj][m][1] * QK_SCALE_SWA); }
        } else if (pn < 18) {
            bf16_t* dst = pn < 16 ? KB : VB; const int c0 = (pn < 16 ? pn - 14 : pn - 16) * 256;
            EPI_AM { const int row = row0 + ai * 128 + m * 16;
#pragma unroll
                for (int bj = 0; bj < 2; ++bj) store8(dst + (size_t)row * 512 + c0 + bj * 128 + cw, acc[ai][bj][m][0], acc[ai][bj][m][1]); }
        } else {
            const int c0 = (pn - 18) * 128 + cw;
            EPI_AM { const int row = row0 + ai * 128 + m * 16; f32x4 r[2], g[2];
#pragma unroll
                for (int n = 0; n < 2; ++n)
#pragma unroll
                    for (int j = 0; j < 4; ++j) { const float a = acc[ai][0][m][n][j], b = fmaxf(acc[ai][1][m][n][j], -30.f);
                        const float ea = __builtin_amdgcn_exp2f(-a * LOG2E), eb = __builtin_amdgcn_exp2f(-b * LOG2E);
                        g[n][j] = __builtin_amdgcn_rcpf(1.f + eb); r[n][j] = (1.f + eb) * __builtin_amdgcn_rcpf(1.f + ea); }
                store8(GR + (size_t)row * 2048 + c0, r[0], r[1]); store8(GBb + (size_t)row * 2048 + c0, g[0], g[1]); }
        }
    }
};
struct EpiUq {
    static constexpr bool MID = false;
    bf16_t* Q; const float* SSQ; const float *CS, *SN;
    __device__ __forceinline__ void operator()(AccRef acc, const Unit& u, int wr, int wc, int fr, int fq) const {
        const int pn = u.pn, row0 = u.pm * 256 + wr * 64 + fr, cw = wc * 32 + fq * 8;
        EPI_AM { const int row = row0 + ai * 128 + m * 16;
            const f32x4 q0 = *(const f32x4*)(SSQ + (size_t)row * 20), q1 = *(const f32x4*)(SSQ + (size_t)row * 20 + 4), q2 = *(const f32x4*)(SSQ + (size_t)row * 20 + 8);
            const float ss = ((q0[0] + q0[1]) + (q0[2] + q0[3])) + ((q1[0] + q1[1]) + (q1[2] + q1[3])) + ((q2[0] + q2[1]) + (q2[2] + q2[3]));
            const float rs = __builtin_amdgcn_rsqf(ss * (1.f / QRANK) + RMS_EPS) * QK_SCALE_MLA;
            if (pn < 8) {
#pragma unroll
                for (int bj = 0; bj < 2; ++bj) store8(Q + (size_t)row * 3072 + (2 * pn + bj) * 192 + cw, acc[ai][bj][m][0] * rs, acc[ai][bj][m][1] * rs);
            } else {
                const int head = 4 * (pn - 8) + wc, pos = row_pos(row);
                const f32x4 c0 = *(const f32x4*)(CS + pos * 32 + fq * 8), c1 = *(const f32x4*)(CS + pos * 32 + fq * 8 + 4), s0 = *(const f32x4*)(SN + pos * 32 + fq * 8), s1 = *(const f32x4*)(SN + pos * 32 + fq * 8 + 4);
                const f32x4 x10 = acc[ai][0][m][0] * rs, x11 = acc[ai][0][m][1] * rs, x20 = acc[ai][1][m][0] * rs, x21 = acc[ai][1][m][1] * rs;
                store8(Q + (size_t)row * 3072 + head * 192 + 128 + fq * 8, x10 * c0 - x20 * s0, x11 * c1 - x21 * s1);
                store8(Q + (size_t)row * 3072 + head * 192 + 160 + fq * 8, x10 * s0 + x20 * c0, x11 * s1 + x21 * c1);
            } }
    }
};
struct EpiUkv {
    static constexpr bool MID = false;
    bf16_t *KN, *V; const float* SSQ;
    __device__ __forceinline__ void operator()(AccRef acc, const Unit& u, int wr, int wc, int fr, int fq) const {
        const int pn = u.pn, row0 = u.pm * 256 + wr * 64 + fr, cw = wc * 32 + fq * 8;
        EPI_AM { const int row = row0 + ai * 128 + m * 16;
            const f32x4 q0 = *(const f32x4*)(SSQ + (size_t)row * 20 + 12), q1 = *(const f32x4*)(SSQ + (size_t)row * 20 + 16);
            const float ss = ((q0[0] + q0[1]) + (q0[2] + q0[3])) + ((q1[0] + q1[1]) + (q1[2] + q1[3]));
            const float rs = __builtin_amdgcn_rsqf(ss * (1.f / KVRANK) + RMS_EPS);
            store8(KN + (size_t)row * 2048 + pn * 128 + cw, acc[ai][0][m][0] * rs, acc[ai][0][m][1] * rs);
            store8(V + (size_t)row * 2048 + pn * 128 + cw, acc[ai][1][m][0] * rs, acc[ai][1][m][1] * rs); }
    }
};
struct EpiProj {
    static constexpr bool MID = true;
    bf16_t* MG; const bf16_t *GR, *GBb;
    __device__ __forceinline__ void mid(f32x4 (&acc)[2][2][4][2], const Unit& u, int wr, int wc, int fr, int fq) const {
        int row0 = u.pm * 256 + wr * 64 + fr, c0 = u.pn * 256 + wc * 32 + fq * 8; asm volatile("" : "+v"(row0), "+v"(c0));
        EPI_AM { const int row = row0 + ai * 128 + m * 16;
#pragma unroll
            for (int bj = 0; bj < 2; ++bj) { f32x4 r0, r1; load8(GR + (size_t)row * 2048 + c0 + bj * 128, r0, r1); acc[ai][bj][m][0] *= r0; acc[ai][bj][m][1] *= r1; } }
    }
    __device__ __forceinline__ void operator()(AccRef acc, const Unit& u, int wr, int wc, int fr, int fq) const {
        const int row0 = u.pm * 256 + wr * 64 + fr, c0 = u.pn * 256 + wc * 32 + fq * 8;
        EPI_AM { const int row = row0 + ai * 128 + m * 16;
#pragma unroll
            for (int bj = 0; bj < 2; ++bj) { f32x4 g0, g1; load8(GBb + (size_t)row * 2048 + c0 + bj * 128, g0, g1); store8(MG + (size_t)row * 2048 + c0 + bj * 128, acc[ai][bj][m][0] * g0, acc[ai][bj][m][1] * g1); } }
    }
};
struct EpiResid {
    static constexpr bool MID = false;
    float* X; const bf16_t* HB;
    __device__ __forceinline__ void operator()(AccRef acc, const Unit& u, int wr, int wc, int fr, int fq) const {
        const int row0 = u.pm * 256 + wr * 64 + fr, c0 = u.pn * 256 + wc * 32 + fq * 8;
        EPI_AM { const int row = row0 + ai * 128 + m * 16;
#pragma unroll
            for (int bj = 0; bj < 2; ++bj) { f32x4 h0, h1; load8(HB + (size_t)row * 2048 + c0 + bj * 128, h0, h1);
                float* xp = X + (size_t)row * 2048 + c0 + bj * 128; *(f32x4*)xp = h0 * ALPHA + acc[ai][bj][m][0]; *(f32x4*)(xp + 4) = h1 * ALPHA + acc[ai][bj][m][1]; } }
    }
};
struct EpiSwiglu {
    static constexpr bool MID = false;
    bf16_t* ACT;
    __device__ __forceinline__ void operator()(AccRef acc, const Unit& u, int wr, int wc, int fr, int fq) const {
        const int row0 = u.pm * 256 + wr * 64 + fr, c0 = u.pn * 128 + wc * 32 + fq * 8;
        EPI_AM { const int row = row0 + ai * 128 + m * 16; f32x4 o[2];
#pragma unroll
            for (int n = 0; n < 2; ++n)
#pragma unroll
                for (int j = 0; j < 4; ++j) { const float g = acc[ai][0][m][n][j]; o[n][j] = g * sigmoidf_(g) * acc[ai][1][m][n][j]; }
            store8(ACT + (size_t)row * DFF + c0, o[0], o[1]); }
    }
};
struct EpiMoeDown {
    static constexpr bool MID = false;
    bf16_t* Y; const float* slot_gate;
    __device__ __forceinline__ void operator()(AccRef acc, const Unit& u, int wr, int wc, int fr, int fq) const {
        const int row0 = u.pm * 256 + wr * 64 + fr, c0 = u.pn * 256 + wc * 32 + fq * 8;
        EPI_AM { const int row = row0 + ai * 128 + m * 16; const float g = slot_gate[row];
#pragma unroll
            for (int bj = 0; bj < 2; ++bj) store8(Y + (size_t)row * 2048 + c0 + bj * 128, acc[ai][bj][m][0] * g, acc[ai][bj][m][1] * g); }
    }
};
#undef EPI_AM
}
namespace att {
typedef unsigned short bf16;
typedef short bf16x8 __attribute__((ext_vector_type(8)));
typedef short s16x4 __attribute__((ext_vector_type(4)));
typedef float f32x16 __attribute__((ext_vector_type(16)));
typedef unsigned u32x4 __attribute__((ext_vector_type(4)));
#define ATT_LAS __attribute__((address_space(3)))
#define SBAR() __builtin_amdgcn_sched_barrier(0)
constexpr int KN_BYTES = 16384, KR_BYTES = 8192, V_BYTES = 16384, BUF_BYTES = KN_BYTES + KR_BYTES + V_BYTES;
constexpr int OFF_KN = 0, OFF_KR = KN_BYTES, OFF_V = KN_BYTES + KR_BYTES;
constexpr int OFF_WS = 2 * BUF_BYTES;
constexpr int OFF_BT = OFF_WS + 8 * 64 * 4;
constexpr int ATT_LDS_BYTES = OFF_BT + 4 * 260 * 4;
constexpr float NEG_BIG = -1e30f;
constexpr float THR2 = 8.f;

__device__ __forceinline__ int crow(int r, int hi) { return (r & 3) + 8 * (r >> 2) + 4 * hi; }
__device__ __forceinline__ unsigned cvtpk(float lo, float hi) { unsigned r; asm volatile("v_cvt_pk_bf16_f32 %0, %1, %2" : "=v"(r) : "v"(lo), "v"(hi)); return r; }
__device__ __forceinline__ int kn_off(int row, int colB) { return row * 256 + (colB ^ ((row & 15) << 4)); }
__device__ __forceinline__ int kr_off(int row, int colB) { return row * 128 + (colB ^ (((row >> 1) & 7) << 4)); }
__device__ __forceinline__ int v_st(int k, int c) { const int kk = (k & ~0xC) | ((k & 4) << 1) | ((k & 8) >> 1); return ((kk >> 3) * 4 + (c >> 5)) * 512 + ((kk & 7) * 32 + (c & 31)) * 2; }
__device__ __forceinline__ int v_rd_base(int lane) { return ((lane & 3) << 3) | (((lane >> 2) & 3) << 6) | (((lane >> 4) & 1) << 5) | (((lane >> 5) & 1) << 8); }
constexpr int v_rd_off(int d0, int ks, int half) { return d0 * 512 + ks * 4096 + half * 2048; }
template <int OFF> __device__ __forceinline__ s16x4 tr_read(int vb) { s16x4 r; asm volatile("ds_read_b64_tr_b16 %0, %1 offset:%2" : "=&v"(r) : "v"(vb), "i"(OFF) : "memory"); return r; }
template <int D0> __device__ __forceinline__ void pv_one(f32x16& od, int vb, bf16x8 pa0, bf16x8 pa1, bf16x8 pa2, bf16x8 pa3) {
    const s16x4 l0 = tr_read<v_rd_off(D0, 0, 0)>(vb), h0 = tr_read<v_rd_off(D0, 0, 1)>(vb), l1 = tr_read<v_rd_off(D0, 1, 0)>(vb), h1 = tr_read<v_rd_off(D0, 1, 1)>(vb);
    const s16x4 l2 = tr_read<v_rd_off(D0, 2, 0)>(vb), h2 = tr_read<v_rd_off(D0, 2, 1)>(vb), l3 = tr_read<v_rd_off(D0, 3, 0)>(vb), h3 = tr_read<v_rd_off(D0, 3, 1)>(vb);
    asm volatile("s_waitcnt lgkmcnt(0)" ::: "memory"); SBAR();
#define PK(L, H) (bf16x8){L[0], L[1], L[2], L[3], H[0], H[1], H[2], H[3]}
    od = __builtin_amdgcn_mfma_f32_32x32x16_bf16(pa0, PK(l0, h0), od, 0, 0, 0);
    od = __builtin_amdgcn_mfma_f32_32x32x16_bf16(pa1, PK(l1, h1), od, 0, 0, 0);
    od = __builtin_amdgcn_mfma_f32_32x32x16_bf16(pa2, PK(l2, h2), od, 0, 0, 0);
    od = __builtin_amdgcn_mfma_f32_32x32x16_bf16(pa3, PK(l3, h3), od, 0, 0, 0);
#undef PK
}
__device__ __forceinline__ void pv_all(f32x16* o, int vb, bf16x8 pa0, bf16x8 pa1, bf16x8 pa2, bf16x8 pa3) {
    pv_one<0>(o[0], vb, pa0, pa1, pa2, pa3); pv_one<1>(o[1], vb, pa0, pa1, pa2, pa3); pv_one<2>(o[2], vb, pa0, pa1, pa2, pa3); pv_one<3>(o[3], vb, pa0, pa1, pa2, pa3);
}
__device__ __forceinline__ bool softmax_tile(f32x16& p0, f32x16& p1, float& m_reg, float& l_reg, float& alpha, bf16x8& pa0, bf16x8& pa1, bf16x8& pa2, bf16x8& pa3) {
    float pmax = p0[0];
#pragma unroll
    for (int r = 1; r < 16; ++r) pmax = fmaxf(pmax, p0[r]);
#pragma unroll
    for (int r = 0; r < 16; ++r) pmax = fmaxf(pmax, p1[r]);
    { auto rr = __builtin_amdgcn_permlane32_swap(__float_as_uint(pmax), __float_as_uint(pmax), false, false); pmax = fmaxf(__uint_as_float(rr[0]), __uint_as_float(rr[1])); }
    bool resc = false; alpha = 1.f;
    if (!__all(pmax - m_reg <= THR2)) { const float mn = fmaxf(m_reg, pmax); alpha = __builtin_amdgcn_exp2f(m_reg - mn); m_reg = mn; resc = true; }
    float ps = 0.f;
#pragma unroll
    for (int r = 0; r < 16; ++r) { p0[r] = __builtin_amdgcn_exp2f(p0[r] - m_reg); ps += p0[r]; }
#pragma unroll
    for (int r = 0; r < 16; ++r) { p1[r] = __builtin_amdgcn_exp2f(p1[r] - m_reg); ps += p1[r]; }
    { auto rr = __builtin_amdgcn_permlane32_swap(__float_as_uint(ps), __float_as_uint(ps), false, false); ps = __uint_as_float(rr[0]) + __uint_as_float(rr[1]); }
    l_reg = l_reg * alpha + ps;
#define PK4(P, BASE, OUT) do { unsigned a0 = cvtpk(P[BASE + 0], P[BASE + 1]), a1 = cvtpk(P[BASE + 2], P[BASE + 3]);   \
    unsigned b0 = cvtpk(P[BASE + 4], P[BASE + 5]), b1 = cvtpk(P[BASE + 6], P[BASE + 7]);                              \
    auto r0 = __builtin_amdgcn_permlane32_swap(a0, b0, false, false); auto r1 = __builtin_amdgcn_permlane32_swap(a1, b1, false, false); \
    u32x4 w = {r0[0], r1[0], r0[1], r1[1]}; OUT = *reinterpret_cast<bf16x8*>(&w); } while (0)
    PK4(p0, 0, pa0); PK4(p0, 8, pa1); PK4(p1, 0, pa2); PK4(p1, 8, pa3);
#undef PK4
    return resc;
}

__device__ __forceinline__ void mla_unit(char* lds, const bf16* __restrict__ Q, const bf16* __restrict__ KN, const bf16* __restrict__ KR, const bf16* __restrict__ V, bf16* __restrict__ OAB, int b, int h, int qb) {
    int tid_ = threadIdx.x; asm volatile("" : "+v"(tid_)); const int tid = tid_, lane = tid & 63, r32 = lane & 31, hi = lane >> 5; const int wid = __builtin_amdgcn_readfirstlane(tid >> 6);
    const bool metaq = (qb == 16);
    const bool wave_on = !metaq || wid == 0;
    const int qrow = metaq ? (TREAL + 16 * b + (r32 & 15)) : (b * SEQ + qb * 256 + wid * 32 + r32);
    float* wsf = (float*)(lds + OFF_WS) + wid * 64;
    bf16x8 qr[12];
    { const bf16* qp = Q + (size_t)qrow * 3072 + h * 192 + hi * 8;
#pragma unroll
      for (int d0 = 0; d0 < 12; ++d0) qr[d0] = *reinterpret_cast<const bf16x8*>(qp + d0 * 16); }
    const int sr = tid >> 4, sc = (tid & 15) * 8, rr = tid >> 3, rc = (tid & 7) * 8;
    const int kn_w0 = kn_off(sr, sc * 2), kn_w1 = kn_off(32 + sr, sc * 2), kr_w = kr_off(rr, rc * 2), v_w0 = v_st(sr, sc), v_w1 = v_st(32 + sr, sc);
    const int vb0 = (int)(uintptr_t)(lds + OFF_V) + v_rd_base(lane);
    bf16x8 sk0, sk1, skr, sv0, sv1;
    const size_t real0 = (size_t)b * SEQ, meta0 = (size_t)TREAL + 16 * b;
#define MLA_LOAD(t) do { size_t g0, g1, g2; if ((t) < 64) { g0 = real0 + (t) * 64 + sr; g1 = g0 + 32; g2 = real0 + (t) * 64 + rr; } else { g0 = meta0 + (sr & 15); g1 = g0; g2 = meta0 + (rr & 15); } \
        sk0 = *reinterpret_cast<const bf16x8*>(KN + g0 * 2048 + h * 128 + sc); sk1 = *reinterpret_cast<const bf16x8*>(KN + g1 * 2048 + h * 128 + sc); \
        skr = *reinterpret_cast<const bf16x8*>(KR + g2 * 64 + rc); \
        sv0 = *reinterpret_cast<const bf16x8*>(V + g0 * 2048 + h * 128 + sc); sv1 = *reinterpret_cast<const bf16x8*>(V + g1 * 2048 + h * 128 + sc); } while (0)
#define MLA_WRITE(bf) do { char* base = lds + (bf) * BUF_BYTES; \
        *reinterpret_cast<bf16x8*>(base + OFF_KN + kn_w0) = sk0; *reinterpret_cast<bf16x8*>(base + OFF_KN + kn_w1) = sk1; *reinterpret_cast<bf16x8*>(base + OFF_KR + kr_w) = skr; \
        *reinterpret_cast<bf16x8*>(base + OFF_V + v_w0) = sv0; *reinterpret_cast<bf16x8*>(base + OFF_V + v_w1) = sv1; } while (0)
    float m_reg = NEG_BIG, l_reg = 0.f; f32x16 o[4];
#pragma unroll
    for (int d = 0; d < 4; ++d) o[d] = f32x16{};
    constexpr int NT = 65;
    MLA_LOAD(0); MLA_WRITE(0); __syncthreads();
    for (int t = 0; t < NT; ++t) {
        const int bf = t & 1;
        if (t + 1 < NT) MLA_LOAD(t + 1);
        if (wave_on) {
            const char* kn = lds + bf * BUF_BYTES + OFF_KN; const char* kr = lds + bf * BUF_BYTES + OFF_KR;
            f32x16 p0 = f32x16{}, p1 = f32x16{};
#pragma unroll
            for (int d0 = 0; d0 < 8; ++d0) { const int cb = d0 * 32 + hi * 16;
                const bf16x8 b0 = *reinterpret_cast<const bf16x8*>(kn + kn_off(r32, cb)), b1 = *reinterpret_cast<const bf16x8*>(kn + kn_off(32 + r32, cb));
                p0 = __builtin_amdgcn_mfma_f32_32x32x16_bf16(b0, qr[d0], p0, 0, 0, 0); p1 = __builtin_amdgcn_mfma_f32_32x32x16_bf16(b1, qr[d0], p1, 0, 0, 0); }
#pragma unroll
            for (int d0 = 0; d0 < 4; ++d0) { const int cb = d0 * 32 + hi * 16;
                const bf16x8 b0 = *reinterpret_cast<const bf16x8*>(kr + kr_off(r32, cb)), b1 = *reinterpret_cast<const bf16x8*>(kr + kr_off(32 + r32, cb));
                p0 = __builtin_amdgcn_mfma_f32_32x32x16_bf16(b0, qr[8 + d0], p0, 0, 0, 0); p1 = __builtin_amdgcn_mfma_f32_32x32x16_bf16(b1, qr[8 + d0], p1, 0, 0, 0); }
            if (t == NT - 1) {
#pragma unroll
                for (int r = 0; r < 16; ++r) { if (crow(r, hi) >= 16) p0[r] = NEG_BIG; p1[r] = NEG_BIG; }
            }
            float alpha; bf16x8 pa0, pa1, pa2, pa3;
            const bool resc = softmax_tile(p0, p1, m_reg, l_reg, alpha, pa0, pa1, pa2, pa3);
            if (resc) { if (hi == 0) wsf[r32] = alpha; asm volatile("s_waitcnt lgkmcnt(0)" ::: "memory");
#pragma unroll
                for (int d = 0; d < 4; ++d)
#pragma unroll
                    for (int r = 0; r < 16; ++r) o[d][r] *= wsf[crow(r, hi)]; }
            pv_all(o, vb0 + bf * BUF_BYTES, pa0, pa1, pa2, pa3);
        }
        if (t + 1 < NT) MLA_WRITE(bf ^ 1);
        __syncthreads();
    }
#undef MLA_LOAD
#undef MLA_WRITE
    if (wave_on) {
        if (hi == 0) wsf[32 + r32] = l_reg; asm volatile("s_waitcnt lgkmcnt(0)" ::: "memory");
        const int orow0 = metaq ? (TREAL + 16 * b) : (b * SEQ + qb * 256 + wid * 32);
#pragma unroll
        for (int r = 0; r < 16; ++r) { const int rw = crow(r, hi); const float rl = __builtin_amdgcn_rcpf(wsf[32 + rw]);
            if (!metaq || rw < 16) { bf16* op = OAB + (size_t)(orow0 + rw) * 4096 + h * 128 + r32;
#pragma unroll
                for (int d0 = 0; d0 < 4; ++d0) op[d0 * 32] = (bf16)(cvtpk(o[d0][r] * rl, 0.f) & 0xffffu); } }
    }
    __syncthreads();
}

__device__ __forceinline__ void swa_unit(char* lds, const bf16* __restrict__ QB, const bf16* __restrict__ KB, const bf16* __restrict__ VB, bf16* __restrict__ OAB,
                                         const float* __restrict__ bias_l2, const float* __restrict__ sink_l2, int b, int hk, int j) {
    int tid_ = threadIdx.x; asm volatile("" : "+v"(tid_)); const int tid = tid_, lane = tid & 63, r32 = lane & 31, hi = lane >> 5; const int wid = __builtin_amdgcn_readfirstlane(tid >> 6);
    const bool metaq = (j == 64);
    const int hq = 4 * hk + (wid >> 1);
    const bool wave_on = !metaq || (wid & 1) == 0;
    const int qpos = metaq ? (r32 & 15) : (NMETA + 64 * j + 32 * (wid & 1) + r32);
    const int qrow = metaq ? (TREAL + 16 * b + (r32 & 15)) : (b * SEQ + 64 * j + 32 * (wid & 1) + r32);
    float* wsf = (float*)(lds + OFF_WS) + wid * 64;
    float* bt = (float*)(lds + OFF_BT);
    for (int i = tid; i < 4 * 257; i += 512) { const int g = i / 257, e = i - g * 257; bt[g * 260 + e] = bias_l2[(4 * hk + g) * 257 + e]; }
    const float* btw = bt + (wid >> 1) * 260 + 128;
    bf16x8 qr[8];
    { const bf16* qp = QB + (size_t)qrow * 2048 + hq * 128 + hi * 8;
#pragma unroll
      for (int d0 = 0; d0 < 8; ++d0) qr[d0] = *reinterpret_cast<const bf16x8*>(qp + d0 * 16); }
    const int sr = tid >> 4, sc = (tid & 15) * 8;
    const int kn_w0 = kn_off(sr, sc * 2), kn_w1 = kn_off(32 + sr, sc * 2), v_w0 = v_st(sr, sc), v_w1 = v_st(32 + sr, sc);
    const int vb0 = (int)(uintptr_t)(lds + OFF_V) + v_rd_base(lane);
    bf16x8 sk0, sk1, sv0, sv1;
    int nt, kt_lo = 0;
    if (metaq) nt = 3; else { kt_lo = j - 2 < 0 ? 0 : j - 2; const int kt_hi = j + 2 > 63 ? 63 : j + 2; nt = 1 + (kt_hi - kt_lo + 1); }
#define SWA_TILE(t, kpos0, mode) do { if (metaq) { kpos0 = 64 * (t); mode = 2; } else if ((t) == 0) { kpos0 = 0; mode = 0; } else { kpos0 = NMETA + 64 * (kt_lo + (t) - 1); mode = 1; } } while (0)
#define SWA_ROW(kp) ({ int kp_ = (kp) > LPOS - 1 ? LPOS - 1 : (kp); (size_t)(kp_ < NMETA ? TREAL + 16 * b + kp_ : b * SEQ + kp_ - NMETA); })
#define SWA_LOAD(t) do { int kpos0_, mode_; SWA_TILE(t, kpos0_, mode_); (void)mode_; const size_t g0 = SWA_ROW(kpos0_ + sr), g1 = SWA_ROW(kpos0_ + 32 + sr); \
        sk0 = *reinterpret_cast<const bf16x8*>(KB + g0 * 512 + hk * 128 + sc); sk1 = *reinterpret_cast<const bf16x8*>(KB + g1 * 512 + hk * 128 + sc); \
        sv0 = *reinterpret_cast<const bf16x8*>(VB + g0 * 512 + hk * 128 + sc); sv1 = *reinterpret_cast<const bf16x8*>(VB + g1 * 512 + hk * 128 + sc); } while (0)
#define SWA_WRITE(bf) do { char* base = lds + (bf) * BUF_BYTES; \
        *reinterpret_cast<bf16x8*>(base + OFF_KN + kn_w0) = sk0; *reinterpret_cast<bf16x8*>(base + OFF_KN + kn_w1) = sk1; \
        *reinterpret_cast<bf16x8*>(base + OFF_V + v_w0) = sv0; *reinterpret_cast<bf16x8*>(base + OFF_V + v_w1) = sv1; } while (0)
    float m_reg = sink_l2[hq], l_reg = 1.f; f32x16 o[4];
#pragma unroll
    for (int d = 0; d < 4; ++d) o[d] = f32x16{};
    SWA_LOAD(0); SWA_WRITE(0); __syncthreads();
    for (int t = 0; t < nt; ++t) {
        const int bf = t & 1;
        if (t + 1 < nt) SWA_LOAD(t + 1);
        if (wave_on) {
            int kpos0, mode; SWA_TILE(t, kpos0, mode);
            const char* kn = lds + bf * BUF_BYTES + OFF_KN;
            f32x16 p0 = f32x16{}, p1 = f32x16{};
#pragma unroll
            for (int d0 = 0; d0 < 8; ++d0) { const int cb = d0 * 32 + hi * 16;
                const bf16x8 b0 = *reinterpret_cast<const bf16x8*>(kn + kn_off(r32, cb)), b1 = *reinterpret_cast<const bf16x8*>(kn + kn_off(32 + r32, cb));
                p0 = __builtin_amdgcn_mfma_f32_32x32x16_bf16(b0, qr[d0], p0, 0, 0, 0); p1 = __builtin_amdgcn_mfma_f32_32x32x16_bf16(b1, qr[d0], p1, 0, 0, 0); }
#pragma unroll
            for (int r = 0; r < 16; ++r) {
#pragma unroll
                for (int half = 0; half < 2; ++half) { const int kp = kpos0 + crow(r, hi) + 32 * half; const int rel = kp - qpos; const int arel = rel < 0 ? -rel : rel;
                    const bool win = (kp >= NMETA) && (arel <= 128) && (kp < LPOS);
                    const bool vis = mode == 0 ? (kp < NMETA) : (mode == 1 ? win : ((kp < NMETA) || win));
                    const int rc = rel < -128 ? -128 : (rel > 128 ? 128 : rel);
                    const float bias = btw[rc];
                    if (half == 0) p0[r] = vis ? p0[r] + bias : NEG_BIG; else p1[r] = vis ? p1[r] + bias : NEG_BIG; } }
            float alpha; bf16x8 pa0, pa1, pa2, pa3;
            const bool resc = softmax_tile(p0, p1, m_reg, l_reg, alpha, pa0, pa1, pa2, pa3);
            if (resc) { if (hi == 0) wsf[r32] = alpha; asm volatile("s_waitcnt lgkmcnt(0)" ::: "memory");
#pragma unroll
                for (int d = 0; d < 4; ++d)
#pragma unroll
                    for (int r = 0; r < 16; ++r) o[d][r] *= wsf[crow(r, hi)]; }
            pv_all(o, vb0 + bf * BUF_BYTES, pa0, pa1, pa2, pa3);
        }
        if (t + 1 < nt) SWA_WRITE(bf ^ 1);
        __syncthreads();
    }
#undef SWA_TILE
#undef SWA_ROW
#undef SWA_LOAD
#undef SWA_WRITE
    if (wave_on) {
        if (hi == 0) wsf[32 + r32] = l_reg; asm volatile("s_waitcnt lgkmcnt(0)" ::: "memory");
        const int orow0 = metaq ? (TREAL + 16 * b) : (b * SEQ + 64 * j + 32 * (wid & 1));
#pragma unroll
        for (int r = 0; r < 16; ++r) { const int rw = crow(r, hi); const float rl = __builtin_amdgcn_rcpf(wsf[32 + rw]);
            if (!metaq || rw < 16) { bf16* op = OAB + (size_t)(orow0 + rw) * 4096 + 2048 + hq * 128 + r32;
#pragma unroll
                for (int d0 = 0; d0 < 4; ++d0) op[d0 * 32] = (bf16)(cvtpk(o[d0][r] * rl, 0.f) & 0xffffu); } }
    }
    __syncthreads();
}
}
constexpr int NWAVES = 8;
constexpr int N_PHASES = 20;
constexpr size_t MiB = 1u << 20, KiB32 = 32768;
constexpr size_t WS_CTL = 0, CTL_ZERO_BYTES = 65536;
constexpr size_t WS_CS = 1 * MiB, WS_SN = WS_CS + 540672;
constexpr size_t WS_BIAS = 3 * MiB;
constexpr size_t WS_SINK = WS_BIAS + 32768;
constexpr size_t WS_WHIST = WS_BIAS + 65536;
constexpr size_t WS_TOPI = 4 * MiB, WS_TOPG = WS_TOPI + 262144, WS_TOKSLOT = WS_TOPG + 262144;
constexpr size_t WS_SLOTTOK = 5 * MiB, WS_SLOTGATE = WS_SLOTTOK + 294912;
constexpr size_t WS_SSQ = 6 * MiB;
constexpr size_t WS_HB = 9 * MiB;
constexpr size_t WS_W = 138 * MiB;
constexpr size_t WL_IN = 0, WL_UQ = 34 * MiB, WL_UKV = WL_UQ + 9 * MiB / 2, WL_AB = WL_UKV + 4 * MiB, WL_OUT = WL_AB + 16 * MiB, WL_STRIDE = WL_OUT + 8 * MiB;
constexpr size_t WS_WF13 = WS_W + 2 * WL_STRIDE, WS_WF2 = WS_WF13 + 44 * MiB, WS_WEND = WS_WF2 + 22 * MiB;
constexpr size_t AR = 337 * MiB;
constexpr size_t WS_CQ = AR, WS_CKV = WS_CQ + 1548 * KiB32, WS_KR = WS_CKV + 1032 * KiB32, WS_QB = WS_KR + 132 * KiB32;
constexpr size_t WS_KB = WS_QB + 129 * MiB, WS_VB = WS_KB + 1032 * KiB32, WS_GR = WS_VB + 1032 * KiB32, WS_GBB = WS_GR + 129 * MiB;
constexpr size_t WS_Q = WS_GBB + 129 * MiB, WS_KN = WS_Q + 6192 * KiB32  , WS_V = WS_KN + 129 * MiB, WS_OAB = WS_V + 129 * MiB, WS_MIX_END = WS_OAB + 258 * MiB;
constexpr size_t WS_MG = WS_Q;
constexpr size_t WS_X = WS_OAB;
constexpr size_t WS_ACT = AR;
constexpr size_t WS_MW13 = 138 * MiB, WS_MW2 = WS_MW13 + 8 * 44 * MiB;
constexpr size_t WS_MACT = WS_MW2 + 8 * 22 * MiB;
constexpr size_t WS_Y = WS_MACT + 726 * MiB;
constexpr size_t WS_END = WS_Y + 264 * MiB;
static_assert(WS_MIX_END <= 1700 * MiB && WS_END <= 1700 * MiB, "d_ws map");
static_assert(WS_ACT + (size_t)TP * DFF * 2 <= WS_X, "dense ACT vs X");
static_assert(WS_SSQ + (size_t)TP * 20 * 4 <= WS_HB && WS_SLOTGATE + 294912 <= WS_SSQ && WS_TOKSLOT + 262144 <= WS_SLOTTOK && WS_SN + 540672 <= WS_BIAS, "small tables");
static_assert(WS_KR + (size_t)TP * 64 * 2 <= WS_QB, "KR");
constexpr int CW_TMO = 0, CW_CODE = 1;
constexpr int CW_MOE_TS = 64;
constexpr int CW_BAR = 4096;
constexpr int RING_OFF = 0, RING_BYTES = 131072;
constexpr int LDSCTL_OFF = RING_BYTES, MISC_OFF = LDSCTL_OFF + 320, PT_OFF = LDSCTL_OFF + 512;
constexpr int LDS_BYTES = 147456;
static_assert(att::ATT_LDS_BYTES <= RING_BYTES, "attention LDS");

#define GAS __attribute__((address_space(1)))
#define LAS __attribute__((address_space(3)))
typedef unsigned short bf16;
typedef unsigned v4u __attribute__((ext_vector_type(4)));
typedef unsigned v2u __attribute__((ext_vector_type(2)));
typedef float f32x4 __attribute__((ext_vector_type(4)));
typedef GAS unsigned gu32;
#define RLX_AGENT __ATOMIC_RELAXED, __HIP_MEMORY_SCOPE_AGENT
#define LDS_WAIT() asm volatile("s_waitcnt lgkmcnt(0)" ::: "memory")
#define VM_WAIT() asm volatile("s_waitcnt vmcnt(0)" ::: "memory")
__device__ __forceinline__ unsigned f2bf(float f) { unsigned u = __builtin_bit_cast(unsigned, f); return (u + 0x7fffu + ((u >> 16) & 1u)) >> 16; }
__device__ __forceinline__ unsigned pk2(float lo, float hi) { return f2bf(lo) | (f2bf(hi) << 16); }

#define XB_TMO      128
#define XB_XCNT(j)  (256  + 64 * (j))
#define XB_XSUB(j)  (1280 + 64 * (j))
#define XB_XGEN(j)  (2304 + 64 * (j))
#define XB_TOP      3328
#define XB_TOPGEN   3392
#define XCD_BAR_WORDS 3456
#define XB_SPIN_CAP (1u << 22)
__device__ __forceinline__ unsigned xb_ld(unsigned* p)              { return __hip_atomic_load(p, __ATOMIC_RELAXED, __HIP_MEMORY_SCOPE_AGENT); }
__device__ __forceinline__ unsigned xb_add(unsigned* p, unsigned v) { return __hip_atomic_fetch_add(p, v, __ATOMIC_RELAXED, __HIP_MEMORY_SCOPE_AGENT); }
__device__ __forceinline__ unsigned xb_xcc_id() { return (unsigned)__builtin_amdgcn_s_getreg((3 << 11) | 20) & 0xFu; }
#define XB_SPIN(cond, bar) do { unsigned _sp = 0; while (cond) { __builtin_amdgcn_s_sleep(1); \
    if ((++_sp & 255u) == 0u) { if (xb_ld(&(bar)[XB_TMO])) break; if (_sp > XB_SPIN_CAP) { atomicAdd(&(bar)[XB_TMO], 1u); break; } } } } while (0)
struct XcdBarrier { unsigned* bar; unsigned x; volatile LAS unsigned* st; };
__device__ __forceinline__ XcdBarrier xcd_barrier_post(unsigned* bar, volatile LAS unsigned* st) {
    XcdBarrier b; b.bar = bar; b.x = xb_xcc_id(); b.st = st;
    if (threadIdx.x == 0) (void)xb_add(&bar[XB_XCNT(b.x)], 1u);
    return b;
}
__device__ __forceinline__ void xcd_barrier_complete(unsigned* bar, unsigned x, unsigned& nloc, unsigned& nx) {
    const unsigned G = gridDim.x * gridDim.y * gridDim.z;
    unsigned sum, cnt, mine, sp = 0u;
    for (;;) {
        sum = 0u; cnt = 0u; mine = 0u;
#pragma unroll
        for (unsigned j = 0; j < 16; ++j) { const unsigned c = xb_ld(&bar[XB_XCNT(j)]); sum += c; cnt += (c > 0u) ? 1u : 0u; mine = (j == x) ? c : mine; }
        if (sum == G) break;
        __builtin_amdgcn_s_sleep(1);
        if ((++sp & 255u) == 0u) { if (xb_ld(&bar[XB_TMO])) break; if (sp > XB_SPIN_CAP) { atomicAdd(&bar[XB_TMO], 1u); break; } }
    }
    nloc = mine > 0u ? mine : 1u; nx = cnt > 0u ? cnt : 1u;
}
__device__ __forceinline__ void xcd_barrier(const XcdBarrier& b) {
    asm volatile("s_waitcnt vmcnt(0)" ::: "memory");
    __syncthreads();
    if (threadIdx.x == 0) {
        unsigned* bar = b.bar;
        __builtin_amdgcn_s_waitcnt(0);
        unsigned nloc = b.st[0], nx = b.st[1];
        if (nloc == 0u) { xcd_barrier_complete(bar, b.x, nloc, nx); b.st[0] = nloc; b.st[1] = nx; }
        const unsigned old = xb_add(&bar[XB_XSUB(b.x)], 1u);
        const unsigned gen = old / nloc;
        if (old + 1u == (gen + 1u) * nloc) {
            __builtin_amdgcn_fence(__ATOMIC_RELEASE, "agent");
            asm volatile("s_waitcnt vmcnt(0)" ::: "memory");
            const unsigned og = xb_add(&bar[XB_TOP], 1u);
            const unsigned tg = og / nx;
            if (og + 1u == (tg + 1u) * nx) xb_add(&bar[XB_TOPGEN], 1u);
            else XB_SPIN(xb_ld(&bar[XB_TOPGEN]) == tg, bar);
            __builtin_amdgcn_fence(__ATOMIC_ACQUIRE, "agent");
            xb_add(&bar[XB_XGEN(b.x)], 1u);
            asm volatile("s_waitcnt vmcnt(0)" ::: "memory");
        } else {
            XB_SPIN(xb_ld(&bar[XB_XGEN(b.x)]) == gen, bar);
            __builtin_amdgcn_fence(__ATOMIC_ACQUIRE, "agent");
            asm volatile("s_waitcnt vmcnt(0)" ::: "memory");
        }
    }
    __syncthreads();
}

__device__ __forceinline__ float wave_sum(float v) {
#pragma unroll
    for (int o = 1; o < 64; o <<= 1) v += __shfl_xor(v, o);
    return v;
}
__device__ __forceinline__ void transpose_item(const float* __restrict__ W, int ldw, int k0, int n0, bf16* __restrict__ WT, size_t ldt, int drow, int koff, const float* __restrict__ g, LAS float* scr, int lane) {
#pragma unroll 8
    for (int i = 0; i < 32; ++i) { const int kk = 2 * i + (lane >> 5); float v = W[(size_t)(k0 + kk) * ldw + n0 + (lane & 31)]; if (g) v *= g[k0 + kk]; scr[kk * 33 + (lane & 31)] = v; }
    LDS_WAIT(); asm volatile("" ::: "memory");
    const int c = lane & 7;
#pragma unroll
    for (int j = 0; j < 4; ++j) { const int n = (lane >> 3) + 8 * j; const LAS float* s = scr + (8 * c) * 33 + n;
        v4u o; o.x = pk2(s[0 * 33], s[1 * 33]); o.y = pk2(s[2 * 33], s[3 * 33]); o.z = pk2(s[4 * 33], s[5 * 33]); o.w = pk2(s[6 * 33], s[7 * 33]);
        *(GAS v4u*)(WT + (size_t)(drow + n) * ldt + koff + k0 + 8 * c) = o; }
    LDS_WAIT(); asm volatile("" ::: "memory");
}
__device__ __forceinline__ int dmap_in(int n0) {
    if (n0 < 1280) return n0;
    if (n0 < 1312) return 1280;
    if (n0 < 1344) return 1280 + 128;
    if (n0 < 3392) return 1536 + (n0 - 1344);
    if (n0 < 3904) return 3584 + (n0 - 3392);
    if (n0 < 4416) return 4096 + (n0 - 3904);
    if (n0 < 6464) { const int a = n0 - 4416; return 4608 + 256 * (a >> 7) + (a & 127); }
    const int a = n0 - 6464; return 4608 + 256 * (a >> 7) + 128 + (a & 127);
}
__device__ __forceinline__ int dmap_uq(int n0) {
    const int head = n0 / 192, off = n0 - head * 192;
    if (off < 128) return 256 * (head >> 1) + 128 * (head & 1) + off;
    if (off < 160) return 256 * (8 + (head >> 2)) + 32 * (head & 3);
    return 256 * (8 + (head >> 2)) + 128 + 32 * (head & 3);
}
__device__ __forceinline__ int dmap_glu(int n0) { return 256 * (n0 >> 7) + (n0 & 127); }
struct Row8 { f32x4 v[8]; };
__device__ __forceinline__ void ln_normalize(Row8& r) {
    float s = 0.f;
#pragma unroll
    for (int j = 0; j < 8; ++j) s += (r.v[j].x + r.v[j].y) + (r.v[j].z + r.v[j].w);
    const float mean = wave_sum(s) * (1.f / D); float s2 = 0.f;
#pragma unroll
    for (int j = 0; j < 8; ++j) { r.v[j] = r.v[j] - mean; s2 += (r.v[j].x * r.v[j].x + r.v[j].y * r.v[j].y) + (r.v[j].z * r.v[j].z + r.v[j].w * r.v[j].w); }
    const float rstd = 1.f / sqrtf(wave_sum(s2) * (1.f / D) + LN_EPS);
#pragma unroll
    for (int j = 0; j < 8; ++j) r.v[j] = r.v[j] * rstd;
}
__device__ __forceinline__ void ln_affine(Row8& r, const float* __restrict__ g, const float* __restrict__ b, int lane) {
#pragma unroll
    for (int j = 0; j < 8; ++j) { const f32x4 gg = *((const f32x4*)g + lane + 64 * j), bb = *((const f32x4*)b + lane + 64 * j); r.v[j] = r.v[j] * gg + bb; }
}
__device__ __forceinline__ void row_store_bf16(const Row8& r, bf16* orow, int lane) {
    GAS v2u* o8 = (GAS v2u*)orow + lane;
#pragma unroll
    for (int j = 0; j < 8; ++j) { v2u w; w.x = pk2(r.v[j].x, r.v[j].y); w.y = pk2(r.v[j].z, r.v[j].w); o8[64 * j] = w; }
}
__device__ __forceinline__ void row_load_f32(Row8& r, const float* xrow, int lane) {
#pragma unroll
    for (int j = 0; j < 8; ++j) r.v[j] = *((const GAS f32x4*)xrow + lane + 64 * j);
}
__device__ __forceinline__ f32x4 bf4(v2u w) { return (f32x4){__uint_as_float(w.x << 16), __uint_as_float(w.x & 0xffff0000u), __uint_as_float(w.y << 16), __uint_as_float(w.y & 0xffff0000u)}; }
__device__ __forceinline__ int t5_bucket(int rel) {
    const int n = rel < 0 ? -rel : rel; int v;
    if (n < 8) v = n; else if (n < 12) v = 8; else if (n < 16) v = 9; else if (n < 23) v = 10; else if (n < 32) v = 11; else if (n < 46) v = 12; else if (n < 64) v = 13; else if (n < 91) v = 14; else v = 15;
    return (rel > 0 ? 16 : 0) + v;
}
enum { I_X = 0, I_META, I_EMB_G, I_EMB_B, I_RELB, I_WIN, I_QNG, I_KVNG, I_WUQ, I_WUKV, I_SINK, I_WPA, I_WPB, I_WOUT, I_LMG, I_LMB, I_LFG, I_LFB,
       I_FW1, I_FW3, I_FW2, I_RW, I_RB, I_MW1, I_MW3, I_MW2, N_IN };
struct Args { const float* in[N_IN]; float* out; unsigned char* ws; int ph_lo, ph_hi; };

__global__ void __launch_bounds__(NWAVES * 64, 2) mk_fwd(Args args) {
    extern __shared__ __attribute__((aligned(16))) unsigned char lds_raw[];
    LAS unsigned char* const lds = (LAS unsigned char*)lds_raw;
    char* const ldsg = (char*)lds_raw;
    volatile LAS unsigned* const MISC = (volatile LAS unsigned*)(lds + MISC_OFF);
    const int tid_k = threadIdx.x; const int tid = tid_k, lane = tid & 63, wave = __builtin_amdgcn_readfirstlane(tid >> 6);
    const int G = gridDim.x; const int bx = blockIdx.x; const int vcu = (G % 8 == 0) ? (bx % 8) * (G / 8) + bx / 8 : bx;
    for (int u = tid; u < (LDS_BYTES - LDSCTL_OFF) / 4; u += NWAVES * 64) ((LAS unsigned*)(lds + LDSCTL_OFF))[u] = 0u;
    __syncthreads();
    volatile LAS unsigned long long* const PT = (volatile LAS unsigned long long*)(lds + PT_OFF);
    if (tid == 0) {
#pragma unroll
        for (int i = 0; i < N_IN; ++i) PT[i] = (unsigned long long)args.in[i];
        PT[N_IN] = (unsigned long long)args.out; PT[N_IN + 1] = (unsigned long long)args.ws; }
    const int lo = args.ph_lo, hi = args.ph_hi;
    __syncthreads();
#define LDP(i) ({ const unsigned long long v_ = PT[i]; (unsigned long long)(unsigned)__builtin_amdgcn_readfirstlane((int)(unsigned)v_) | ((unsigned long long)(unsigned)__builtin_amdgcn_readfirstlane((int)(unsigned)(v_ >> 32)) << 32); })
#define INP(i) ((const float*)LDP(i))
#define PH_WS() asm volatile("" ::: "memory"); int tid = tid_k; asm volatile("" : "+v"(tid)); const int lane = tid & 63; (void)lane; unsigned char* const ws = (unsigned char*)LDP(N_IN + 1); \
    bf16* const HB = (bf16*)(ws + WS_HB); float* const CS = (float*)(ws + WS_CS); float* const SN = (float*)(ws + WS_SN); float* const SSQ = (float*)(ws + WS_SSQ); float* const X = (float*)(ws + WS_X); \
    (void)HB; (void)CS; (void)SN; (void)SSQ; (void)X
    XcdBarrier bar; { unsigned char* const ws0 = (unsigned char*)LDP(N_IN + 1); bar.bar = (unsigned*)(ws0 + WS_CTL) + CW_BAR; bar.x = 0; bar.st = nullptr;
    if (hi - lo > 1) bar = xcd_barrier_post((unsigned*)(ws0 + WS_CTL) + CW_BAR, MISC + 8); }
#ifndef PHMASK
#define PHMASK 0xFFFF
#endif
#define KEN(kind) ((PHMASK >> (kind)) & 1)
#define IN(k) (lo <= (k) && (k) < hi)
#define SEAM(k) do { if (IN(k) && IN((k) + 1)) xcd_barrier(bar); } while (0)
    const int gw = vcu * NWAVES + wave, NGW = G * NWAVES;

    if (KEN(0) && IN(0)) { PH_WS(); int* const SLOT_TOK = (int*)(ws + WS_SLOTTOK); float* const SLOT_GATE = (float*)(ws + WS_SLOTGATE); int* const TOK_SLOT = (int*)(ws + WS_TOKSLOT); (void)SLOT_TOK; (void)SLOT_GATE; (void)TOK_SLOT;
        LAS float* scr = (LAS float*)(lds + RING_OFF + wave * 16384);
        constexpr int I_IN = (D / 64) * (INDIM / 32), I_UQ = (QRANK / 64) * (3072 / 32), I_UKV = (KVRANK / 64) * (4096 / 32), I_SQ = (D / 64) * (D / 32), I_LAYER = I_IN + I_UQ + I_UKV + 3 * I_SQ;
        constexpr int I_F = (D / 64) * (DFF / 32), I_F2 = (DFF / 64) * (D / 32), NITEMS = 2 * I_LAYER + 2 * I_F + I_F2;
        for (int it = gw; it < NITEMS; it += NGW) {
            int r = it;
            if (r < 2 * I_LAYER) { const int l = r / I_LAYER; r -= l * I_LAYER; unsigned char* wl = ws + WS_W + l * WL_STRIDE;
                if (r < I_IN) { const int nblk = INDIM / 32, kb = r / nblk, nb = r % nblk; transpose_item(INP(I_WIN) + (size_t)l * D * INDIM, INDIM, 64 * kb, 32 * nb, (bf16*)(ws + WS_W + l * WL_STRIDE + WL_IN), D, dmap_in(32 * nb), 0, nullptr, scr, lane); continue; } r -= I_IN;
                if (r < I_UQ) { const int nblk = 3072 / 32, kb = r / nblk, nb = r % nblk; transpose_item(INP(I_WUQ) + (size_t)l * QRANK * 3072, 3072, 64 * kb, 32 * nb, (bf16*)(ws + WS_W + l * WL_STRIDE + WL_UQ), QRANK, dmap_uq(32 * nb), 0, INP(I_QNG) + l * QRANK, scr, lane); continue; } r -= I_UQ;
                if (r < I_UKV) { const int nblk = 4096 / 32, kb = r / nblk, nb = r % nblk; transpose_item(INP(I_WUKV) + (size_t)l * KVRANK * 4096, 4096, 64 * kb, 32 * nb, (bf16*)(ws + WS_W + l * WL_STRIDE + WL_UKV), KVRANK, 32 * nb, 0, INP(I_KVNG) + l * KVRANK, scr, lane); continue; } r -= I_UKV;
                { const int which = r / I_SQ; r -= which * I_SQ; const int nblk = D / 32, kb = r / nblk, nb = r % nblk;
                  if (which == 0) transpose_item(INP(I_WPA) + (size_t)l * D * D, D, 64 * kb, 32 * nb, (bf16*)(ws + WS_W + l * WL_STRIDE + WL_AB), 2 * D, 32 * nb, 0, nullptr, scr, lane);
                  else if (which == 1) transpose_item(INP(I_WPB) + (size_t)l * D * D, D, 64 * kb, 32 * nb, (bf16*)(ws + WS_W + l * WL_STRIDE + WL_AB), 2 * D, 32 * nb, D, nullptr, scr, lane);
                  else transpose_item(INP(I_WOUT) + (size_t)l * D * D, D, 64 * kb, 32 * nb, (bf16*)(ws + WS_W + l * WL_STRIDE + WL_OUT), D, 32 * nb, 0, nullptr, scr, lane);
                  continue; }
            }
            r -= 2 * I_LAYER;
            if (r < 2 * I_F) { const int which = r / I_F; r -= which * I_F; const int nblk = DFF / 32, kb = r / nblk, nb = r % nblk;
                transpose_item(INP(which ? I_FW3 : I_FW1), DFF, 64 * kb, 32 * nb, (bf16*)(ws + WS_WF13), D, dmap_glu(32 * nb) + (which ? 128 : 0), 0, nullptr, scr, lane); continue; }
            r -= 2 * I_F;
            { const int nblk = D / 32, kb = r / nblk, nb = r % nblk; transpose_item(INP(I_FW2), D, 64 * kb, 32 * nb, (bf16*)(ws + WS_WF2), DFF, 32 * nb, 0, nullptr, scr, lane); }
        }
        for (int i = gw * 64 + lane; i < 2 * 192 * 256; i += NGW * 64) { const int l = i / (192 * 256), q = i % (192 * 256), rr = q / 256, c16 = q % 256; const int row = rr < 96 ? 1312 + rr : 1440 + (rr - 96);
            *(GAS v4u*)(ws + WS_W + l * WL_STRIDE + WL_IN + (size_t)row * (D * 2) + c16 * 16) = (v4u){0u, 0u, 0u, 0u}; }
        for (int i = gw * 64 + lane; i < LPOS * 32; i += NGW * 64) { const int pos = i >> 5, k = i & 31; const float inv = powf(10000.f, -(float)(2 * k) / 64.f); const float ang = (float)pos * inv; CS[i] = cosf(ang); SN[i] = sinf(ang); }
        for (int i = gw * 64 + lane; i < 16 * 257; i += NGW * 64) { const int hh = i / 257, rel = i % 257 - 128; ((float*)(ws + WS_BIAS))[i] = INP(I_RELB)[t5_bucket(rel) * 16 + hh] * LOG2E; }
        if (gw == 0 && lane < 32) ((float*)(ws + WS_SINK))[lane] = INP(I_SINK)[lane] * LOG2E;
        for (int m = gw; m < TP; m += NGW) {
            if (m < T) { Row8 r; row_load_f32(r, m < TREAL ? INP(I_X) + (size_t)m * D : INP(I_META) + (size_t)((m - TREAL) & 15) * D, lane);
                ln_normalize(r); ln_affine(r, INP(I_EMB_G), INP(I_EMB_B), lane); row_store_bf16(r, HB + (size_t)m * D, lane); }
            else { GAS v2u* o8 = (GAS v2u*)(HB + (size_t)m * D) + lane;
#pragma unroll
                for (int j = 0; j < 8; ++j) o8[64 * j] = (v2u){0u, 0u}; }
        }
    }
    SEAM(0);

#pragma unroll 1
    for (int l = 0; l < 2; ++l) {
        const int P = 1 + 9 * l + (l ? 0 : 0);
        const int nM_all = TP / 256;
        const int nM_post = l == 0 ? TP / 256 : TREAL / 256;
        if (KEN(1) && IN(P + 0)) { PH_WS(); int* const SLOT_TOK = (int*)(ws + WS_SLOTTOK); float* const SLOT_GATE = (float*)(ws + WS_SLOTGATE); int* const TOK_SLOT = (int*)(ws + WS_TOKSLOT); (void)SLOT_TOK; (void)SLOT_GATE; (void)TOK_SLOT;
            ProbDense pr; pr.so.init(nM_all, NIN / 256, G, bx); pr.A = (const char*)HB; pr.Bt = (const char*)(ws + WS_W + l * WL_STRIDE + WL_IN); pr.tstep = 256 * (size_t)D * 2;
            epi::EpiWin E{(bf16*)(ws + WS_CQ), (bf16*)(ws + WS_CKV), (bf16*)(ws + WS_KR), (bf16*)(ws + WS_QB), (bf16*)(ws + WS_KB), (bf16*)(ws + WS_VB), (bf16*)(ws + WS_GR), (bf16*)(ws + WS_GBB), SSQ, CS, SN};
            pg8::gemm_phase<epi::EpiWin, ProbDense>(lds + RING_OFF, D, pr, E);
        }
        SEAM(P + 0);
        if (KEN(2) && IN(P + 1)) { PH_WS(); int* const SLOT_TOK = (int*)(ws + WS_SLOTTOK); float* const SLOT_GATE = (float*)(ws + WS_SLOTGATE); int* const TOK_SLOT = (int*)(ws + WS_TOKSLOT); (void)SLOT_TOK; (void)SLOT_GATE; (void)TOK_SLOT;
            { ProbDense pr; pr.so.init(nM_all, 3072 / 256, G, bx); pr.A = (const char*)(ws + WS_CQ); pr.Bt = (const char*)(ws + WS_W + l * WL_STRIDE + WL_UQ); pr.tstep = 256 * (size_t)QRANK * 2;
              epi::EpiUq E{(bf16*)(ws + WS_Q), SSQ, CS, SN};
              pg8::gemm_phase<epi::EpiUq, ProbDense>(lds + RING_OFF, QRANK, pr, E); }
            { ProbDense pr; pr.so.init(nM_all, 4096 / 256, G, bx); pr.A = (const char*)(ws + WS_CKV); pr.Bt = (const char*)(ws + WS_W + l * WL_STRIDE + WL_UKV); pr.tstep = 256 * (size_t)KVRANK * 2;
              epi::EpiUkv E{(bf16*)(ws + WS_KN), (bf16*)(ws + WS_V), SSQ};
              pg8::gemm_phase<epi::EpiUkv, ProbDense>(lds + RING_OFF, KVRANK, pr, E); }
        }
        SEAM(P + 1);
        if (KEN(3) && IN(P + 2)) { PH_WS(); int* const SLOT_TOK = (int*)(ws + WS_SLOTTOK); float* const SLOT_GATE = (float*)(ws + WS_SLOTGATE); int* const TOK_SLOT = (int*)(ws + WS_TOKSLOT); (void)SLOT_TOK; (void)SLOT_GATE; (void)TOK_SLOT;
            const int nqb = l == 0 ? 17 : 16, nmla_full = NB * NH * 16, nmla = NB * NH * nqb;
            for (int u = vcu; u < nmla; u += G) {
                int b, h, qb;
                if (u < nmla_full) { qb = u & 15; h = (u >> 4) & 15; b = u >> 8; } else { const int v = u - nmla_full; qb = 16; h = v & 15; b = v >> 4; }
                att::mla_unit(ldsg + RING_OFF, (const bf16*)(ws + WS_Q), (const bf16*)(ws + WS_KN), (const bf16*)(ws + WS_KR), (const bf16*)(ws + WS_V), (bf16*)(ws + WS_OAB), b, h, qb);
            }
            const int nj = l == 0 ? 65 : 64, nswa_full = NB * 4 * 64, nswa = NB * 4 * nj;
            for (int u = vcu; u < nswa; u += G) {
                int b, hk, j;
                if (u < nswa_full) { j = u & 63; hk = (u >> 6) & 3; b = u >> 8; } else { const int v = u - nswa_full; j = 64; hk = v & 3; b = v >> 2; }
                att::swa_unit(ldsg + RING_OFF, (const bf16*)(ws + WS_QB), (const bf16*)(ws + WS_KB), (const bf16*)(ws + WS_VB), (bf16*)(ws + WS_OAB), (const float*)(ws + WS_BIAS), (const float*)(ws + WS_SINK) + 16 * l, b, hk, j);
            }
        }
        SEAM(P + 2);
        if (KEN(4) && IN(P + 3)) { PH_WS(); int* const SLOT_TOK = (int*)(ws + WS_SLOTTOK); float* const SLOT_GATE = (float*)(ws + WS_SLOTGATE); int* const TOK_SLOT = (int*)(ws + WS_TOKSLOT); (void)SLOT_TOK; (void)SLOT_GATE; (void)TOK_SLOT;
            ProbDense pr; pr.so.init(nM_post, D / 256, G, bx); pr.A = (const char*)(ws + WS_OAB); pr.Bt = (const char*)(ws + WS_W + l * WL_STRIDE + WL_AB); pr.tstep = 256 * (size_t)(2 * D) * 2;
            epi::EpiProj E{(bf16*)(ws + WS_MG), (const bf16*)(ws + WS_GR), (const bf16*)(ws + WS_GBB)};
            pg8::gemm_phase<epi::EpiProj, ProbDense>(lds + RING_OFF, 2 * D, pr, E);
        }
        SEAM(P + 3);
        if (KEN(5) && IN(P + 4)) { PH_WS(); int* const SLOT_TOK = (int*)(ws + WS_SLOTTOK); float* const SLOT_GATE = (float*)(ws + WS_SLOTGATE); int* const TOK_SLOT = (int*)(ws + WS_TOKSLOT); (void)SLOT_TOK; (void)SLOT_GATE; (void)TOK_SLOT;
            ProbDense pr; pr.so.init(nM_post, D / 256, G, bx); pr.A = (const char*)(ws + WS_MG); pr.Bt = (const char*)(ws + WS_W + l * WL_STRIDE + WL_OUT); pr.tstep = 256 * (size_t)D * 2;
            epi::EpiResid E{X, HB};
            pg8::gemm_phase<epi::EpiResid, ProbDense>(lds + RING_OFF, D, pr, E);
        }
        SEAM(P + 4);
        if (KEN(6) && IN(P + 5)) { PH_WS(); int* const SLOT_TOK = (int*)(ws + WS_SLOTTOK); float* const SLOT_GATE = (float*)(ws + WS_SLOTGATE); int* const TOK_SLOT = (int*)(ws + WS_TOKSLOT); (void)SLOT_TOK; (void)SLOT_GATE; (void)TOK_SLOT;
            const float* g = INP(I_LMG) + l * D; const float* bta = INP(I_LMB) + l * D;
            const int nrows = l == 0 ? T : TREAL;
            int h0 = 0, h1 = 0, h2 = 0, h3 = 0, h4 = 0, h5 = 0, h6 = 0, h7 = 0;
            for (int m = gw; m < nrows; m += NGW) {
                Row8 r; row_load_f32(r, X + (size_t)m * D, lane); ln_normalize(r); ln_affine(r, g, bta, lane); row_store_bf16(r, HB + (size_t)m * D, lane);
                if (l == 1) {
                    float lg[8];
#pragma unroll
                    for (int e = 0; e < 8; ++e) lg[e] = 0.f;
                    const float* rw = INP(I_RW);
#pragma unroll
                    for (int j = 0; j < 8; ++j) {
#pragma unroll
                        for (int q = 0; q < 4; ++q) { const int c = 4 * (lane + 64 * j) + q; const f32x4 w0 = *(const f32x4*)(rw + c * 8), w1 = *(const f32x4*)(rw + c * 8 + 4); const float y = r.v[j][q];
                            lg[0] += y * w0.x; lg[1] += y * w0.y; lg[2] += y * w0.z; lg[3] += y * w0.w; lg[4] += y * w1.x; lg[5] += y * w1.y; lg[6] += y * w1.z; lg[7] += y * w1.w; } }
#pragma unroll
                    for (int e = 0; e < 8; ++e) lg[e] = wave_sum(lg[e]) + INP(I_RB)[e];
                    int i0 = 0; float v0 = lg[0];
#pragma unroll
                    for (int e = 1; e < 8; ++e) if (lg[e] > v0) { v0 = lg[e]; i0 = e; }
                    int i1 = -1; float v1 = -3.0e38f;
#pragma unroll
                    for (int e = 0; e < 8; ++e) if (e != i0 && lg[e] > v1) { v1 = lg[e]; i1 = e; }
                    const float e1 = __expf(v1 - v0), g0 = 1.f / (1.f + e1), g1 = e1 / (1.f + e1);
                    if (lane == 0) { int* ti = (int*)(ws + WS_TOPI); float* tg = (float*)(ws + WS_TOPG); ti[2 * m] = i0; ti[2 * m + 1] = i1; tg[2 * m] = g0; tg[2 * m + 1] = g1; }
                    h0 += (i0 == 0) + (i1 == 0); h1 += (i0 == 1) + (i1 == 1); h2 += (i0 == 2) + (i1 == 2); h3 += (i0 == 3) + (i1 == 3);
                    h4 += (i0 == 4) + (i1 == 4); h5 += (i0 == 5) + (i1 == 5); h6 += (i0 == 6) + (i1 == 6); h7 += (i0 == 7) + (i1 == 7);
                }
            }
            if (l == 1 && lane == 0) { int* wh = (int*)(ws + WS_WHIST) + gw * 8; wh[0] = h0; wh[1] = h1; wh[2] = h2; wh[3] = h3; wh[4] = h4; wh[5] = h5; wh[6] = h6; wh[7] = h7; }
        }
        SEAM(P + 5);
        if (l == 0) {
            if (KEN(7) && IN(P + 6)) { PH_WS(); int* const SLOT_TOK = (int*)(ws + WS_SLOTTOK); float* const SLOT_GATE = (float*)(ws + WS_SLOTGATE); int* const TOK_SLOT = (int*)(ws + WS_TOKSLOT); (void)SLOT_TOK; (void)SLOT_GATE; (void)TOK_SLOT;
                ProbDense pr; pr.so.init(nM_all, 2 * DFF / 256, G, bx); pr.A = (const char*)HB; pr.Bt = (const char*)(ws + WS_WF13); pr.tstep = 256 * (size_t)D * 2;
                epi::EpiSwiglu E{(bf16*)(ws + WS_ACT)};
                pg8::gemm_phase<epi::EpiSwiglu, ProbDense>(lds + RING_OFF, D, pr, E);
            }
            SEAM(P + 6);
            if (KEN(8) && IN(P + 7)) { PH_WS(); int* const SLOT_TOK = (int*)(ws + WS_SLOTTOK); float* const SLOT_GATE = (float*)(ws + WS_SLOTGATE); int* const TOK_SLOT = (int*)(ws + WS_TOKSLOT); (void)SLOT_TOK; (void)SLOT_GATE; (void)TOK_SLOT;
                ProbDense pr; pr.so.init(nM_all, D / 256, G, bx); pr.A = (const char*)(ws + WS_ACT); pr.Bt = (const char*)(ws + WS_WF2); pr.tstep = 256 * (size_t)DFF * 2;
                epi::EpiResid E{X, HB};
                pg8::gemm_phase<epi::EpiResid, ProbDense>(lds + RING_OFF, DFF, pr, E);
            }
            SEAM(P + 7);
            if (KEN(9) && IN(P + 8)) { PH_WS(); int* const SLOT_TOK = (int*)(ws + WS_SLOTTOK); float* const SLOT_GATE = (float*)(ws + WS_SLOTGATE); int* const TOK_SLOT = (int*)(ws + WS_TOKSLOT); (void)SLOT_TOK; (void)SLOT_GATE; (void)TOK_SLOT;
                const float* g = INP(I_LFG); const float* bta = INP(I_LFB);
                for (int m = gw; m < T; m += NGW) { Row8 r; row_load_f32(r, X + (size_t)m * D, lane); ln_normalize(r); ln_affine(r, g, bta, lane); row_store_bf16(r, HB + (size_t)m * D, lane); }
            }
            SEAM(P + 8);
        } else {
            if (KEN(10) && IN(P + 6)) { PH_WS(); int* const SLOT_TOK = (int*)(ws + WS_SLOTTOK); float* const SLOT_GATE = (float*)(ws + WS_SLOTGATE); int* const TOK_SLOT = (int*)(ws + WS_TOKSLOT); (void)SLOT_TOK; (void)SLOT_GATE; (void)TOK_SLOT;
                LAS int* hist = (LAS int*)(lds + RING_OFF);
                LAS int* segsum = hist + 2048 * 8;
                LAS int* segpre = segsum + 64 * 8;
                LAS int* tot = segpre + 64 * 8;
                const int* wh = (const int*)(ws + WS_WHIST);
                for (int i = tid; i < NGW * 8; i += NWAVES * 64) hist[i] = wh[i];
                __syncthreads();
                { const int e = tid & 7, seg = tid >> 3; int s = 0;
_Pragma("unroll 1")
                  for (int w = 0; w < 32; ++w) { const int ww = seg * 32 + w; if (ww < NGW) s += hist[ww * 8 + e]; } segsum[seg * 8 + e] = s; }
                __syncthreads();
                if (tid < 8) { int run = 0;
_Pragma("unroll 1")
                    for (int s = 0; s < 64; ++s) { segpre[s * 8 + tid] = run; run += segsum[s * 8 + tid]; } tot[tid] = run; }
                __syncthreads();
                if (tid == 0) { int ts = 0; for (int e = 0; e < 8; ++e) { tot[8 + e] = ts; ts += (tot[e] + 255) >> 8; } tot[16] = ts;
                    if (bx == 0) for (int e = 0; e < 9; ++e) ((int*)(ws + WS_CTL))[CW_MOE_TS + e] = tot[8 + e]; }
                __syncthreads();
                int base = 0;
                if (lane < 8) { base = tot[8 + lane] * 256 + segpre[(gw >> 5) * 8 + lane];
_Pragma("unroll 1")
                    for (int w = (gw & ~31); w < gw; ++w) base += hist[w * 8 + lane]; }
                const int* ti = (const int*)(ws + WS_TOPI); const float* tg = (const float*)(ws + WS_TOPG);
                for (int m = gw; m < TREAL; m += NGW) {
#pragma unroll
                    for (int k = 0; k < 2; ++k) { const int e = __builtin_amdgcn_readfirstlane(ti[2 * m + k]); const float gt = tg[2 * m + k];
                        const int slot = __builtin_amdgcn_readlane(base, e); if (lane == e) base += 1;
                        if (lane == 0) { SLOT_TOK[slot] = m; SLOT_GATE[slot] = gt; TOK_SLOT[2 * m + k] = slot; } }
                }
                if (vcu < 8) { const int e = vcu; const int s0 = tot[8 + e] * 256 + tot[e], s1 = tot[8 + e + 1] * 256; for (int s = s0 + tid; s < s1; s += NWAVES * 64) { SLOT_TOK[s] = T; SLOT_GATE[s] = 0.f; } }
                __syncthreads();
                LAS float* scr = (LAS float*)(lds + RING_OFF + wave * 16384);
                constexpr int I_F = (D / 64) * (DFF / 32), I_F2 = (DFF / 64) * (D / 32), I_E = 2 * I_F + I_F2;
                for (int it = gw; it < NE * I_E; it += NGW) {
                    const int e = it / I_E; int r = it - e * I_E;
                    if (r < 2 * I_F) { const int which = r / I_F; r -= which * I_F; const int nblk = DFF / 32, kb = r / nblk, nb = r % nblk;
                        transpose_item(INP(which ? I_MW3 : I_MW1) + (size_t)e * D * DFF, DFF, 64 * kb, 32 * nb, (bf16*)(ws + WS_MW13) + (size_t)e * 2 * DFF * D, D, dmap_glu(32 * nb) + (which ? 128 : 0), 0, nullptr, scr, lane); continue; }
                    r -= 2 * I_F;
                    { const int nblk = D / 32, kb = r / nblk, nb = r % nblk; transpose_item(INP(I_MW2) + (size_t)e * DFF * D, D, 64 * kb, 32 * nb, (bf16*)(ws + WS_MW2) + (size_t)e * D * DFF, DFF, 32 * nb, 0, nullptr, scr, lane); }
                }
            }
            SEAM(P + 6);
            MoeTiles mt;
            if (IN(P + 7) || IN(P + 8)) { unsigned char* const ws = (unsigned char*)LDP(N_IN + 1);
#pragma unroll
                for (int e = 0; e < 9; ++e) mt.ts[e] = __builtin_amdgcn_readfirstlane(((const int*)(ws + WS_CTL))[CW_MOE_TS + e]);
            } else {
#pragma unroll
                for (int e = 0; e < 9; ++e) mt.ts[e] = 0;
            }
            if (KEN(11) && IN(P + 7)) { PH_WS(); int* const SLOT_TOK = (int*)(ws + WS_SLOTTOK); float* const SLOT_GATE = (float*)(ws + WS_SLOTGATE); int* const TOK_SLOT = (int*)(ws + WS_TOKSLOT); (void)SLOT_TOK; (void)SLOT_GATE; (void)TOK_SLOT;
                ProbMoe1 pr; pr.so.init(mt.ts[8], 2 * DFF / 256, G, bx); pr.HBp = (const char*)HB; pr.slot_tok = SLOT_TOK; pr.W = (const char*)(ws + WS_MW13); pr.mt = mt;
                epi::EpiSwiglu E{(bf16*)(ws + WS_MACT)};
                pg8::gemm_phase<epi::EpiSwiglu, ProbMoe1, true>(lds + RING_OFF, D, pr, E);
            }
            SEAM(P + 7);
            if (KEN(12) && IN(P + 8)) { PH_WS(); int* const SLOT_TOK = (int*)(ws + WS_SLOTTOK); float* const SLOT_GATE = (float*)(ws + WS_SLOTGATE); int* const TOK_SLOT = (int*)(ws + WS_TOKSLOT); (void)SLOT_TOK; (void)SLOT_GATE; (void)TOK_SLOT;
                ProbMoe2 pr; pr.so.init(mt.ts[8], D / 256, G, bx); pr.ACTp = (const char*)(ws + WS_MACT); pr.W = (const char*)(ws + WS_MW2); pr.mt = mt;
                epi::EpiMoeDown E{(bf16*)(ws + WS_Y), SLOT_GATE};
                pg8::gemm_phase<epi::EpiMoeDown, ProbMoe2>(lds + RING_OFF, DFF, pr, E);
            }
            SEAM(P + 8);
            if (KEN(13) && IN(P + 9)) { PH_WS(); int* const SLOT_TOK = (int*)(ws + WS_SLOTTOK); float* const SLOT_GATE = (float*)(ws + WS_SLOTGATE); int* const TOK_SLOT = (int*)(ws + WS_TOKSLOT); (void)SLOT_TOK; (void)SLOT_GATE; (void)TOK_SLOT;
                const float* g = INP(I_LFG) + D; const float* bta = INP(I_LFB) + D; const bf16* Y = (const bf16*)(ws + WS_Y);
                for (int m = gw; m < TREAL; m += NGW) {
                    const int s0 = TOK_SLOT[2 * m], s1 = TOK_SLOT[2 * m + 1]; Row8 r;
#pragma unroll
                    for (int j = 0; j < 8; ++j) { const v2u hw = *((const GAS v2u*)(HB + (size_t)m * D) + lane + 64 * j), y0 = *((const GAS v2u*)(Y + (size_t)s0 * D) + lane + 64 * j), y1 = *((const GAS v2u*)(Y + (size_t)s1 * D) + lane + 64 * j);
                        r.v[j] = (bf4(hw) * ALPHA + bf4(y0)) + bf4(y1); }
                    ln_normalize(r); ln_affine(r, g, bta, lane);
                    GAS f32x4* o = (GAS f32x4*)(((float*)LDP(N_IN)) + (size_t)m * D) + lane;
#pragma unroll
                    for (int j = 0; j < 8; ++j) o[64 * j] = r.v[j];
                }
            }
        }
    }
#undef IN
#undef SEAM
}

#ifndef MK_ONE_LAUNCH
#define MK_ONE_LAUNCH 0
#endif
extern "C" void kernel_launch(void* const* d_in, const int* in_sizes, int n_in, void* d_out, int out_size, void* d_ws, size_t ws_size, hipStream_t stream) {
    static int grid = 0;
    if (grid == 0) {
        if (n_in != N_IN || in_sizes[0] != NB * SEQ * D || out_size != NB * SEQ * D || ws_size < WS_END) { fprintf(stderr, "kernel_launch: shape mismatch: n_in %d in0 %d out %d ws %zu (need %zu)\n", n_in, n_in > 0 ? in_sizes[0] : -1, out_size, ws_size, (size_t)WS_END); grid = -1; return; }
        int dev = 0, cus = 0, per_cu = 0;
        if (hipGetDevice(&dev) != hipSuccess || hipDeviceGetAttribute(&cus, hipDeviceAttributeMultiprocessorCount, dev) != hipSuccess) { fprintf(stderr, "kernel_launch: device query failed\n"); grid = -1; return; }
        if (hipFuncSetAttribute((const void*)mk_fwd, hipFuncAttributeMaxDynamicSharedMemorySize, LDS_BYTES) != hipSuccess) { fprintf(stderr, "kernel_launch: hipFuncSetAttribute failed\n"); grid = -1; return; }
        if (hipOccupancyMaxActiveBlocksPerMultiprocessor(&per_cu, (const void*)mk_fwd, NWAVES * 64, LDS_BYTES) != hipSuccess || per_cu < 1) fprintf(stderr, "kernel_launch: occupancy query reports %d\n", per_cu);
        (void)hipGetLastError();
        grid = cus;
    }
    if (grid < 0) return;
    if (hipMemsetAsync((char*)d_ws + WS_CTL, 0, CTL_ZERO_BYTES, stream) != hipSuccess) { fprintf(stderr, "kernel_launch: memset failed\n"); return; }
    Args a{};
    for (int i = 0; i < N_IN; ++i) a.in[i] = (const float*)d_in[i];
    a.out = (float*)d_out; a.ws = (unsigned char*)d_ws;
#if MK_ONE_LAUNCH
    a.ph_lo = 0; a.ph_hi = N_PHASES;
    hipLaunchKernelGGL(mk_fwd, dim3(grid), dim3(NWAVES * 64), LDS_BYTES, stream, a);
#else
    for (int p = 0; p < N_PHASES; ++p) { a.ph_lo = p; a.ph_hi = p + 1; hipLaunchKernelGGL(mk_fwd, dim3(grid), dim3(NWAVES * 64), LDS_BYTES, stream, a); }
#endif
    const hipError_t le = hipPeekAtLastError();
    if (le != hipSuccess) fprintf(stderr, "kernel_launch: launch failed: %s\n", hipGetErrorName(le));
}
```

```cpp
#define REPMASK 0
#define MK_ONE_LAUNCH 1
#include <hip/hip_runtime.h>
#include <cstdio>
#include <cstdint>
namespace pg8 {
#define PG8_LAS __attribute__((address_space(3)))
typedef unsigned short bf16_t;
typedef short bf16x8 __attribute__((ext_vector_type(8)));
typedef float f32x4 __attribute__((ext_vector_type(4)));
typedef float f32x2 __attribute__((ext_vector_type(2)));
typedef unsigned u32x4 __attribute__((ext_vector_type(4)));
typedef unsigned u32x2 __attribute__((ext_vector_type(2)));
constexpr int BM = 256, BK = 64, HALF = 128, HTB = HALF * BK * 2  , STAGE_BYTES = 8 * HTB, NXCD = 8, WGM = 8;

__host__ __device__ __forceinline__ int lds_byte(int r, int c) { const int st = (r >> 4) * 2 + (c >> 5), rr = r & 15, cc = c & 31, ob = rr * 64 + cc * 2; return st * 1024 + (ob ^ (((ob >> 9) & 1) << 5)); }
__host__ __device__ __forceinline__ void stage_rc(int b, int& R, int& C) { const int st = b / 1024, sb = b % 1024, swz = sb ^ (((sb >> 9) & 1) << 5); R = (st >> 1) * 16 + swz / 64; C = (st & 1) * 32 + (swz % 64) / 2; }
__host__ __device__ __forceinline__ int perm32(int rho) { const int n = rho >> 4, i = rho & 15; return 8 * (i >> 2) + 4 * n + (i & 3); }

struct Unit { int pm, pn; };

struct StaticOrder {
    int nM, nN, nwg, G, c;
    __device__ __forceinline__ void init(int nM_, int nN_, int G_, int c_) { nM = nM_; nN = nN_; nwg = nM * nN; G = G_; c = c_; }
    __device__ __forceinline__ bool next(int i, Unit& u) const {
        const long L = (long)i * G + c; if (L >= nwg) return false;
        int wgid = (int)L; { const int q = nwg / NXCD, r = nwg % NXCD, xcd = wgid % NXCD, off = wgid / NXCD; wgid = (xcd < r ? xcd * (q + 1) : r * (q + 1) + (xcd - r) * q) + off; }
        const int nig = WGM * nN, gid = wgid / nig, fm = gid * WGM, gsz = (nM - fm) < WGM ? (nM - fm) : WGM;
        u.pm = fm + ((wgid % nig) % gsz); u.pn = (wgid % nig) / gsz; return true;
    }
};
__device__ __forceinline__ unsigned cvt_pk_bf16(float lo, float hi) { unsigned r; asm volatile("v_cvt_pk_bf16_f32 %0, %1, %2" : "=v"(r) : "v"(lo), "v"(hi)); return r; }
__device__ __forceinline__ float bf_lo(unsigned w) { return __uint_as_float(w << 16); }
__device__ __forceinline__ float bf_hi(unsigned w) { return __uint_as_float(w & 0xffff0000u); }

template <class Epi, class Prob, bool GATHER = false>
__device__ __forceinline__ void gemm_phase(PG8_LAS unsigned char* lds, const int K, const Prob& S, const Epi& E) {
    int tid_ = threadIdx.x; asm volatile("" : "+v"(tid_));
    const int tid = tid_, wid = __builtin_amdgcn_readfirstlane(tid >> 6), lane = tid & 63, wr = wid >> 2, wc = wid & 3, fr = lane & 15, fq = lane >> 4;
    const int nt = K / BK;
    int sR[2], sC[2];
    unsigned voffA[2][2], nvoffA[2][2], voffB[2];
#pragma unroll
    for (int i = 0; i < 2; ++i) { int R, C; stage_rc(tid * 16 + i * 8192, R, C); sR[i] = R; sC[i] = C; const int Rb = (R & ~31) + perm32(R & 31);
        voffB[i] = (unsigned)(Rb * K + C) * 2u;
        voffA[0][i] = (unsigned)(R * K + C) * 2u; voffA[1][i] = (unsigned)((R + HALF) * K + C) * 2u; nvoffA[0][i] = voffA[0][i]; nvoffA[1][i] = voffA[1][i]; }
    const size_t kstep = (size_t)(BK * 2);
    const size_t hstep = (size_t)HALF * K * 2;
    const unsigned ldsw = (unsigned)wid * 1024u;
    const int aoff = lds_byte(wr * 64 + fr, fq * 8), boff = lds_byte(wc * 32 + fr, fq * 8);
#define PG8_SA(b, h) (((b) * 2 + (h)) * HTB)
#define PG8_SB(b, h) ((4 + (b) * 2 + (h)) * HTB)
#define PG8_STAGE(bufoff, gbase, voff) do { _Pragma("unroll") for (int _i = 0; _i < 2; ++_i) \
        __builtin_amdgcn_global_load_lds((const unsigned*)((const char*)(gbase) + (voff)[_i]), (PG8_LAS unsigned*)(lds + (bufoff) + ldsw + _i * 8192), 16, 0, 0); } while (0)
#define PG8_LDA(dst, b, h) do { _Pragma("unroll") for (int m = 0; m < 4; ++m) _Pragma("unroll") for (int k = 0; k < 2; ++k) dst[m][k] = *(const PG8_LAS bf16x8*)(lds + PG8_SA(b, h) + aoff + m * 2048 + k * 1024); } while (0)
#define PG8_LDB(dst, b, h) do { _Pragma("unroll") for (int n = 0; n < 2; ++n) _Pragma("unroll") for (int k = 0; k < 2; ++k) dst[n][k] = *(const PG8_LAS bf16x8*)(lds + PG8_SB(b, h) + boff + n * 2048 + k * 1024); } while (0)
#define PG8_MMA(ai, bj, At, Bt) do { __builtin_amdgcn_s_setprio(1); _Pragma("unroll") for (int m = 0; m < 4; ++m) _Pragma("unroll") for (int n = 0; n < 2; ++n) _Pragma("unroll") for (int k = 0; k < 2; ++k) \
        acc[ai][bj][m][n] = __builtin_amdgcn_mfma_f32_16x16x32_bf16(Bt[n][k], At[m][k], acc[ai][bj][m][n], 0, 0, 0); __builtin_amdgcn_s_setprio(0); } while (0)
#define PG8_WAIT_V(n) asm volatile("s_waitcnt vmcnt(" #n ")" ::: "memory")
#define PG8_WAIT_L(n) asm volatile("s_waitcnt lgkmcnt(" #n ")" ::: "memory")
#define PG8_BAR __builtin_amdgcn_s_barrier()
#define PG8_SCHED __builtin_amdgcn_sched_barrier(0)
    Unit cur, nxt; int ui = 0;
    if (!S.next(0, cur)) return;
    f32x4 acc[2][2][4][2];
#pragma unroll
    for (int a = 0; a < 2; ++a)
#pragma unroll
        for (int b = 0; b < 2; ++b)
#pragma unroll
            for (int m = 0; m < 4; ++m)
#pragma unroll
                for (int n = 0; n < 2; ++n) acc[a][b][m][n] = (f32x4){0.f, 0.f, 0.f, 0.f};
    bf16x8 At[4][2], B0[2][2], B1[2][2];
    const char* cA = S.a_base(cur); const char* cB = S.b_base(cur);
    if constexpr (GATHER) {
#pragma unroll
        for (int h = 0; h < 2; ++h)
#pragma unroll
            for (int i = 0; i < 2; ++i) { voffA[h][i] = (unsigned)(S.a_row(cur, sR[i] + h * HALF) * K + sC[i]) * 2u; nvoffA[h][i] = voffA[h][i]; }
    }
    PG8_STAGE(PG8_SB(0, 0), cB, voffB); PG8_STAGE(PG8_SB(0, 1), cB + hstep, voffB); PG8_STAGE(PG8_SA(0, 0), cA, voffA[0]); PG8_STAGE(PG8_SA(0, 1), cA, voffA[1]);
    if (wr == 1) PG8_BAR;
    PG8_WAIT_V(2); PG8_BAR;
    PG8_STAGE(PG8_SB(1, 0), cB + kstep, voffB); PG8_STAGE(PG8_SA(1, 0), cA + kstep, voffA[0]); PG8_STAGE(PG8_SB(1, 1), cB + hstep + kstep, voffB);
    PG8_WAIT_V(6); PG8_BAR;
    for (;;) {
        const bool has_next = S.next(ui + 1, nxt);
        const char* nA = has_next ? S.a_base(nxt) : cA; const char* nB = has_next ? S.b_base(nxt) : cB;
        if constexpr (GATHER) { if (has_next) {
#pragma unroll
            for (int h = 0; h < 2; ++h)
#pragma unroll
                for (int i = 0; i < 2; ++i) nvoffA[h][i] = (unsigned)(S.a_row(nxt, sR[i] + h * HALF) * K + sC[i]) * 2u; } }
        for (int t = 0; t < nt; t += 2) {
            const bool last = (t == nt - 2);
            if constexpr (Epi::MID) { if (t == (nt >> 1)) E.mid(acc, cur, wr, wc, fr, fq); }
            const char* a1 = cA + (size_t)(t + 1) * kstep;
            const char* a2 = last ? nA : cA + (size_t)(t + 2) * kstep; const char* b2 = last ? nB : cB + (size_t)(t + 2) * kstep;
            const char* a3 = a2 + kstep; const char* b3 = b2 + kstep;
            unsigned vA2[2][2];
#pragma unroll
            for (int h = 0; h < 2; ++h)
#pragma unroll
                for (int i = 0; i < 2; ++i) vA2[h][i] = GATHER ? (last ? nvoffA[h][i] : voffA[h][i]) : voffA[h][i];
            PG8_LDB(B0, 0, 0); PG8_LDB(B1, 0, 1); PG8_SCHED; PG8_LDA(At, 0, 0); PG8_STAGE(PG8_SA(1, 1), a1, voffA[1]);
            PG8_WAIT_V(8); PG8_WAIT_L(0); PG8_BAR; PG8_MMA(0, 0, At, B0); PG8_MMA(0, 1, At, B1); PG8_BAR; PG8_SCHED;
            PG8_LDA(At, 0, 1); PG8_STAGE(PG8_SB(0, 0), b2, voffB); PG8_STAGE(PG8_SB(0, 1), b2 + hstep, voffB); PG8_STAGE(PG8_SA(0, 0), a2, vA2[0]);
            PG8_WAIT_V(8); PG8_WAIT_L(0); PG8_BAR; PG8_MMA(1, 0, At, B0); PG8_MMA(1, 1, At, B1); PG8_BAR; PG8_SCHED;
            PG8_LDB(B0, 1, 0); PG8_LDB(B1, 1, 1); PG8_SCHED; PG8_LDA(At, 1, 0); PG8_STAGE(PG8_SA(0, 1), a2, vA2[1]);
            PG8_WAIT_V(8); PG8_WAIT_L(0); PG8_BAR; PG8_MMA(0, 0, At, B0); PG8_MMA(0, 1, At, B1); PG8_BAR; PG8_SCHED;
            PG8_LDA(At, 1, 1); PG8_STAGE(PG8_SB(1, 0), b3, voffB); PG8_STAGE(PG8_SB(1, 1), b3 + hstep, voffB); PG8_STAGE(PG8_SA(1, 0), a3, vA2[0]);
            PG8_WAIT_V(8); PG8_WAIT_L(0); PG8_BAR; PG8_MMA(1, 0, At, B0); PG8_MMA(1, 1, At, B1); PG8_BAR; PG8_SCHED;
        }
        if (wr == 0) PG8_BAR;
        E(acc, cur, wr, wc, fr, fq);
        if (!has_next) break;
#pragma unroll
        for (int a = 0; a < 2; ++a)
#pragma unroll
            for (int b = 0; b < 2; ++b)
#pragma unroll
                for (int m = 0; m < 4; ++m)
#pragma unroll
                    for (int n = 0; n < 2; ++n) acc[a][b][m][n] = (f32x4){0.f, 0.f, 0.f, 0.f};
        cur = nxt; cA = nA; cB = nB; ++ui;
        if constexpr (GATHER) {
#pragma unroll
            for (int h = 0; h < 2; ++h)
#pragma unroll
                for (int i = 0; i < 2; ++i) voffA[h][i] = nvoffA[h][i]; }
        if (wr == 1) PG8_BAR;
    }
    PG8_WAIT_V(0);
    PG8_BAR;
#undef PG8_SA
#undef PG8_SB
#undef PG8_STAGE
#undef PG8_LDA
#undef PG8_LDB
#undef PG8_MMA
#undef PG8_WAIT_V
#undef PG8_WAIT_L
#undef PG8_BAR
#undef PG8_SCHED
}
}
constexpr int D = 2048, NB = 8, SEQ = 4096, NMETA = 16, NH = 16;
constexpr int TREAL = NB * SEQ;
constexpr int T = TREAL + NB * NMETA;
constexpr int TP = 33024;
constexpr int LPOS = SEQ + NMETA;
constexpr int QRANK = 768, KVRANK = 512, DFF = 5632, NE = 8;
constexpr int NIN = 8704;
constexpr int INDIM = 8512;
constexpr float LN_EPS = 1e-5f, RMS_EPS = 1e-6f, ALPHA = 1.4142135623730951f;
constexpr float LOG2E = 1.4426950408889634f;
constexpr float QK_SCALE_MLA = 0.07216878364870322f * LOG2E;
constexpr float QK_SCALE_SWA = 0.08838834764831845f * LOG2E;

__device__ __forceinline__ int row_pos(int row) { return row < TREAL ? NMETA + (row & (SEQ - 1)) : ((row - TREAL) & (NMETA - 1)); }

struct ProbDense {
    pg8::StaticOrder so; const char* A; const char* Bt; size_t tstep;
    __device__ __forceinline__ bool next(int i, pg8::Unit& u) const { return so.next(i, u); }
    __device__ __forceinline__ const char* a_base(const pg8::Unit& u) const { return A + (size_t)u.pm * tstep; }
    __device__ __forceinline__ const char* b_base(const pg8::Unit& u) const { return Bt + (size_t)u.pn * tstep; }
    __device__ __forceinline__ int a_row(const pg8::Unit&, int) const { return 0; }
};
struct MoeTiles { int ts[9]; };
__device__ __forceinline__ int moe_expert(const MoeTiles& mt, int pm) { int e = 0;
#pragma unroll
    for (int k = 1; k < 8; ++k) e += (pm >= mt.ts[k]) ? 1 : 0; return e; }
struct ProbMoe1 {
    pg8::StaticOrder so; const char* HBp; const int* slot_tok; const char* W; MoeTiles mt;
    __device__ __forceinline__ bool next(int i, pg8::Unit& u) const { return so.next(i, u); }
    __device__ __forceinline__ const char* a_base(const pg8::Unit&) const { return HBp; }
    __device__ __forceinline__ const char* b_base(const pg8::Unit& u) const { return W + (size_t)moe_expert(mt, u.pm) * ((size_t)2 * DFF * D * 2) + (size_t)u.pn * (256 * (size_t)D * 2); }
    __device__ __forceinline__ int a_row(const pg8::Unit& u, int r) const { return slot_tok[u.pm * 256 + r]; }
};
struct ProbMoe2 {
    pg8::StaticOrder so; const char* ACTp; const char* W; MoeTiles mt;
    __device__ __forceinline__ bool next(int i, pg8::Unit& u) const { return so.next(i, u); }
    __device__ __forceinline__ const char* a_base(const pg8::Unit& u) const { return ACTp + (size_t)u.pm * (256 * (size_t)DFF * 2); }
    __device__ __forceinline__ const char* b_base(const pg8::Unit& u) const { return W + (size_t)moe_expert(mt, u.pm) * ((size_t)D * DFF * 2) + (size_t)u.pn * (256 * (size_t)DFF * 2); }
    __device__ __forceinline__ int a_row(const pg8::Unit&, int) const { return 0; }
};

namespace epi {
using pg8::f32x4; using pg8::u32x4; using pg8::bf16_t; using pg8::Unit; using pg8::cvt_pk_bf16;
typedef const f32x4 (&AccRef)[2][2][4][2];
__device__ __forceinline__ void store8(bf16_t* p, f32x4 v0, f32x4 v1) { u32x4 w; w.x = cvt_pk_bf16(v0[0], v0[1]); w.y = cvt_pk_bf16(v0[2], v0[3]); w.z = cvt_pk_bf16(v1[0], v1[1]); w.w = cvt_pk_bf16(v1[2], v1[3]); *(u32x4*)p = w; }
__device__ __forceinline__ void load8(const bf16_t* p, f32x4& v0, f32x4& v1) { const u32x4 w = *(const u32x4*)p;
    v0 = (f32x4){pg8::bf_lo(w.x), pg8::bf_hi(w.x), pg8::bf_lo(w.y), pg8::bf_hi(w.y)}; v1 = (f32x4){pg8::bf_lo(w.z), pg8::bf_hi(w.z), pg8::bf_lo(w.w), pg8::bf_hi(w.w)}; }
__device__ __forceinline__ bool epi_fence() { asm volatile("" ::: "memory"); return true; }
__device__ __forceinline__ float sigmoidf_(float x) { return __builtin_amdgcn_rcpf(1.f + __builtin_amdgcn_exp2f(-x * LOG2E)); }
#define EPI_AM _Pragma("unroll") for (int ai = 0; ai < 2; ++ai) _Pragma("unroll") for (int m = 0; m < 4; ++m) if (epi_fence())

struct EpiWin {
    static constexpr bool MID = false;
    bf16_t *CQ, *CKV, *KR, *QB, *KB, *VB, *GR, *GBb; float* SSQ; const float *CS, *SN;
    __device__ __forceinline__ void operator()(AccRef acc, const Unit& u, int wr, int wc, int fr, int fq) const {
        const int pn = u.pn, row0 = u.pm * 256 + wr * 64 + fr, cw = wc * 32 + fq * 8;
        if (pn < 5) {
            bf16_t* dst = pn < 3 ? CQ : CKV; const int ld = pn < 3 ? QRANK : KVRANK, c0 = (pn < 3 ? pn : pn - 3) * 256;
            EPI_AM { const int row = row0 + ai * 128 + m * 16; float s = 0.f;
#pragma unroll
                for (int bj = 0; bj < 2; ++bj) { const f32x4 v0 = acc[ai][bj][m][0], v1 = acc[ai][bj][m][1];
                    s += (v0[0] * v0[0] + v0[1] * v0[1]) + (v0[2] * v0[2] + v0[3] * v0[3]) + (v1[0] * v1[0] + v1[1] * v1[1]) + (v1[2] * v1[2] + v1[3] * v1[3]);
                    store8(dst + (size_t)row * ld + c0 + bj * 128 + cw, v0, v1); }
                s += __shfl_xor(s, 16); s += __shfl_xor(s, 32);
                if (fq == 0) SSQ[(size_t)row * 20 + pn * 4 + wc] = s; }
        } else if (pn == 5) {
            if (wc == 0) { EPI_AM { const int row = row0 + ai * 128 + m * 16, pos = row_pos(row);
                const f32x4 c0 = *(const f32x4*)(CS + pos * 32 + fq * 8), c1 = *(const f32x4*)(CS + pos * 32 + fq * 8 + 4), s0 = *(const f32x4*)(SN + pos * 32 + fq * 8), s1 = *(const f32x4*)(SN + pos * 32 + fq * 8 + 4);
                const f32x4 x10 = acc[ai][0][m][0], x11 = acc[ai][0][m][1], x20 = acc[ai][1][m][0], x21 = acc[ai][1][m][1];
                store8(KR + (size_t)row * 64 + fq * 8, x10 * c0 - x20 * s0, x11 * c1 - x21 * s1);
                store8(KR + (size_t)row * 64 + 32 + fq * 8, x10 * s0 + x20 * c0, x11 * s1 + x21 * c1); } }
        } else if (pn < 14) {
            EPI_AM { const int row = row0 + ai * 128 + m * 16;
#pragma unroll
                for (int bj = 0; bj < 2; ++bj) store8(QB + (size_t)row * 2048 + (pn - 6) * 256 + bj * 128 + cw, acc[ai][bj][m][0] * QK_SCALE_SWA, acc[ai][bj][m][1] * QK_SCALE_SWA); }
        } else if (pn < 18) {
            bf16_t* dst = pn < 16 ? KB : VB; const int c0 = (pn < 16 ? pn - 14 : pn - 16) * 256;
            EPI_AM { const int row = row0 + ai * 128 + m * 16;
#pragma unroll
                for (int bj = 0; bj < 2; ++bj) store8(dst + (size_t)row * 512 + c0 + bj * 128 + cw, acc[ai][bj][m][0], acc[ai][bj][m][1]); }
        } else {
            const int c0 = (pn - 18) * 128 + cw;
            EPI_AM { const int row = row0 + ai * 128 + m * 16; f32x4 r[2], g[2];
#pragma unroll
                for (int n = 0; n < 2; ++n)
#pragma unroll
                    for (int j = 0; j < 4; ++j) { const float a = acc[ai][0][m][n][j], b = fmaxf(acc[ai][1][m][n][j], -30.f);
                        const float ea = __builtin_amdgcn_exp2f(-a * LOG2E), eb = __builtin_amdgcn_exp2f(-b * LOG2E);
                        g[n][j] = __builtin_amdgcn_rcpf(1.f + eb); r[n][j] = (1.f + eb) * __builtin_amdgcn_rcpf(1.f + ea); }
                store8(GR + (size_t)row * 2048 + c0, r[0], r[1]); store8(GBb + (size_t)row * 2048 + c0, g[0], g[1]); }
        }
    }
};
struct EpiUq {
    static constexpr bool MID = false;
    bf16_t* Q; const float* SSQ; const float *CS, *SN;
    __device__ __forceinline__ void operator()(AccRef acc, const Unit& u, int wr, int wc, int fr, int fq) const {
        const int pn = u.pn, row0 = u.pm * 256 + wr * 64 + fr, cw = wc * 32 + fq * 8;
        EPI_AM { const int row = row0 + ai * 128 + m * 16;
            const f32x4 q0 = *(const f32x4*)(SSQ + (size_t)row * 20), q1 = *(const f32x4*)(SSQ + (size_t)row * 20 + 4), q2 = *(const f32x4*)(SSQ + (size_t)row * 20 + 8);
            const float ss = ((q0[0] + q0[1]) + (q0[2] + q0[3])) + ((q1[0] + q1[1]) + (q1[2] + q1[3])) + ((q2[0] + q2[1]) + (q2[2] + q2[3]));
            const float rs = __builtin_amdgcn_rsqf(ss * (1.f / QRANK) + RMS_EPS) * QK_SCALE_MLA;
            if (pn < 8) {
#pragma unroll
                for (int bj = 0; bj < 2; ++bj) store8(Q + (size_t)row * 3072 + (2 * pn + bj) * 192 + cw, acc[ai][bj][m][0] * rs, acc[ai][bj][m][1] * rs);
            } else {
                const int head = 4 * (pn - 8) + wc, pos = row_pos(row);
                const f32x4 c0 = *(const f32x4*)(CS + pos * 32 + fq * 8), c1 = *(const f32x4*)(CS + pos * 32 + fq * 8 + 4), s0 = *(const f32x4*)(SN + pos * 32 + fq * 8), s1 = *(const f32x4*)(SN + pos * 32 + fq * 8 + 4);
                const f32x4 x10 = acc[ai][0][m][0] * rs, x11 = acc[ai][0][m][1] * rs, x20 = acc[ai][1][m][0] * rs, x21 = acc[ai][1][m][1] * rs;
                store8(Q + (size_t)row * 3072 + head * 192 + 128 + fq * 8, x10 * c0 - x20 * s0, x11 * c1 - x21 * s1);
                store8(Q + (size_t)row * 3072 + head * 192 + 160 + fq * 8, x10 * s0 + x20 * c0, x11 * s1 + x21 * c1);
            } }
    }
};
struct EpiUkv {
    static constexpr bool MID = false;
    bf16_t *KN, *V; const float* SSQ;
    __device__ __forceinline__ void operator()(AccRef acc, const Unit& u, int wr, int wc, int fr, int fq) const {
        const int pn = u.pn, row0 = u.pm * 256 + wr * 64 + fr, cw = wc * 32 + fq * 8;
        EPI_AM { const int row = row0 + ai * 128 + m * 16;
            const f32x4 q0 = *(const f32x4*)(SSQ + (size_t)row * 20 + 12), q1 = *(const f32x4*)(SSQ + (size_t)row * 20 + 16);
            const float ss = ((q0[0] + q0[1]) + (q0[2] + q0[3])) + ((q1[0] + q1[1]) + (q1[2] + q1[3]));
            const float rs = __builtin_amdgcn_rsqf(ss * (1.f / KVRANK) + RMS_EPS);
            store8(KN + (size_t)row * 2048 + pn * 128 + cw, acc[ai][0][m][0] * rs, acc[ai][0][m][1] * rs);
            store8(V + (size_t)row * 2048 + pn * 128 + cw, acc[ai][1][m][0] * rs, acc[ai][1][m][1] * rs); }
    }
};
struct EpiProj {
    static constexpr bool MID = true;
    bf16_t* MG; const bf16_t *GR, *GBb;
    __device__ __forceinline__ void mid(f32x4 (&acc)[2][2][4][2], const Unit& u, int wr, int wc, int fr, int fq) const {
        int row0 = u.pm * 256 + wr * 64 + fr, c0 = u.pn * 256 + wc * 32 + fq * 8; asm volatile("" : "+v"(row0), "+v"(c0));
        EPI_AM { const int row = row0 + ai * 128 + m * 16;
#pragma unroll
            for (int bj = 0; bj < 2; ++bj) { f32x4 r0, r1; load8(GR + (size_t)row * 2048 + c0 + bj * 128, r0, r1); acc[ai][bj][m][0] *= r0; acc[ai][bj][m][1] *= r1; } }
    }
    __device__ __forceinline__ void operator()(AccRef acc, const Unit& u, int wr, int wc, int fr, int fq) const {
        const int row0 = u.pm * 256 + wr * 64 + fr, c0 = u.pn * 256 + wc * 32 + fq * 8;
        EPI_AM { const int row = row0 + ai * 128 + m * 16;
#pragma unroll
            for (int bj = 0; bj < 2; ++bj) { f32x4 g0, g1; load8(GBb + (size_t)row * 2048 + c0 + bj * 128, g0, g1); store8(MG + (size_t)row * 2048 + c0 + bj * 128, acc[ai][bj][m][0] * g0, acc[ai][bj][m][1] * g1); } }
    }
};
struct EpiResid {
    static constexpr bool MID = false;
    float* X; const bf16_t* HB;
    __device__ __forceinline__ void operator()(AccRef acc, const Unit& u, int wr, int wc, int fr, int fq) const {
        const int row0 = u.pm * 256 + wr * 64 + fr, c0 = u.pn * 256 + wc * 32 + fq * 8;
        EPI_AM { const int row = row0 + ai * 128 + m * 16;
#pragma unroll
            for (int bj = 0; bj < 2; ++bj) { f32x4 h0, h1; load8(HB + (size_t)row * 2048 + c0 + bj * 128, h0, h1);
                float* xp = X + (size_t)row * 2048 + c0 + bj * 128; *(f32x4*)xp = h0 * ALPHA + acc[ai][bj][m][0]; *(f32x4*)(xp + 4) = h1 * ALPHA + acc[ai][bj][m][1]; } }
    }
};
struct EpiSwiglu {
    static constexpr bool MID = false;
    bf16_t* ACT;
    __device__ __forceinline__ void operator()(AccRef acc, const Unit& u, int wr, int wc, int fr, int fq) const {
        const int row0 = u.pm * 256 + wr * 64 + fr, c0 = u.pn * 128 + wc * 32 + fq * 8;
        EPI_AM { const int row = row0 + ai * 128 + m * 16; f32x4 o[2];
#pragma unroll
            for (int n = 0; n < 2; ++n)
#pragma unroll
                for (int j = 0; j < 4; ++j) { const float g = acc[ai][0][m][n][j]; o[n][j] = g * sigmoidf_(g) * acc[ai][1][m][n][j]; }
            store8(ACT + (size_t)row * DFF + c0, o[0], o[1]); }
    }
};
struct EpiMoeDown {
    static constexpr bool MID = false;
    bf16_t* Y; const float* slot_gate;
    __device__ __forceinline__ void operator()(AccRef acc, const Unit& u, int wr, int wc, int fr, int fq) const {
        const int row0 = u.pm * 256 + wr * 64 + fr, c0 = u.pn * 256 + wc * 32 + fq * 8;
        EPI_AM { const int row = row0 + ai * 128 + m * 16; const float g = slot_gate[row];
#pragma unroll
            for (int bj = 0; bj < 2; ++bj) store8(Y + (size_t)row * 2048 + c0 + bj * 128, acc[ai][bj][m][0] * g, acc[ai][bj][m][1] * g); }
    }
};
#undef EPI_AM
}
namespace att {
typedef unsigned short bf16;
typedef short bf16x8 __attribute__((ext_vector_type(8)));
typedef short s16x4 __attribute__((ext_vector_type(4)));
typedef float f32x16 __attribute__((ext_vector_type(16)));
typedef unsigned u32x4 __attribute__((ext_vector_type(4)));
#define ATT_LAS __attribute__((address_space(3)))
#define SBAR() __builtin_amdgcn_sched_barrier(0)
constexpr int KN_BYTES = 16384, KR_BYTES = 8192, V_BYTES = 16384, BUF_BYTES = KN_BYTES + KR_BYTES + V_BYTES;
constexpr int OFF_KN = 0, OFF_KR = KN_BYTES, OFF_V = KN_BYTES + KR_BYTES;
constexpr int OFF_WS = 2 * BUF_BYTES;
constexpr int OFF_BT = OFF_WS + 8 * 64 * 4;
constexpr int ATT_LDS_BYTES = OFF_BT + 4 * 260 * 4;
constexpr float NEG_BIG = -1e30f;
constexpr float THR2 = 8.f;

__device__ __forceinline__ int crow(int r, int hi) { return (r & 3) + 8 * (r >> 2) + 4 * hi; }
__device__ __forceinline__ unsigned cvtpk(float lo, float hi) { unsigned r; asm volatile("v_cvt_pk_bf16_f32 %0, %1, %2" : "=v"(r) : "v"(lo), "v"(hi)); return r; }
__device__ __forceinline__ int kn_off(int row, int colB) { return row * 256 + (colB ^ ((row & 15) << 4)); }
__device__ __forceinline__ int kr_off(int row, int colB) { return row * 128 + (colB ^ (((row >> 1) & 7) << 4)); }
__device__ __forceinline__ int v_st(int k, int c) { const int kk = (k & ~0xC) | ((k & 4) << 1) | ((k & 8) >> 1); return ((kk >> 3) * 4 + (c >> 5)) * 512 + ((kk & 7) * 32 + (c & 31)) * 2; }
__device__ __forceinline__ int v_rd_base(int lane) { return ((lane & 3) << 3) | (((lane >> 2) & 3) << 6) | (((lane >> 4) & 1) << 5) | (((lane >> 5) & 1) << 8); }
constexpr int v_rd_off(int d0, int ks, int half) { return d0 * 512 + ks * 4096 + half * 2048; }
template <int OFF> __device__ __forceinline__ s16x4 tr_read(int vb) { s16x4 r; asm volatile("ds_read_b64_tr_b16 %0, %1 offset:%2" : "=&v"(r) : "v"(vb), "i"(OFF) : "memory"); return r; }
template <int D0> __device__ __forceinline__ void pv_one(f32x16& od, int vb, bf16x8 pa0, bf16x8 pa1, bf16x8 pa2, bf16x8 pa3) {
    const s16x4 l0 = tr_read<v_rd_off(D0, 0, 0)>(vb), h0 = tr_read<v_rd_off(D0, 0, 1)>(vb), l1 = tr_read<v_rd_off(D0, 1, 0)>(vb), h1 = tr_read<v_rd_off(D0, 1, 1)>(vb);
    const s16x4 l2 = tr_read<v_rd_off(D0, 2, 0)>(vb), h2 = tr_read<v_rd_off(D0, 2, 1)>(vb), l3 = tr_read<v_rd_off(D0, 3, 0)>(vb), h3 = tr_read<v_rd_off(D0, 3, 1)>(vb);
    asm volatile("s_waitcnt lgkmcnt(0)" ::: "memory"); SBAR();
#define PK(L, H) (bf16x8){L[0], L[1], L[2], L[3], H[0], H[1], H[2], H[3]}
    od = __builtin_amdgcn_mfma_f32_32x32x16_bf16(pa0, PK(l0, h0), od, 0, 0, 0);
    od = __builtin_amdgcn_mfma_f32_32x32x16_bf16(pa1, PK(l1, h1), od, 0, 0, 0);
    od = __builtin_amdgcn_mfma_f32_32x32x16_bf16(pa2, PK(l2, h2), od, 0, 0, 0);
    od = __builtin_amdgcn_mfma_f32_32x32x16_bf16(pa3, PK(l3, h3), od, 0, 0, 0);
#undef PK
}
__device__ __forceinline__ void pv_all(f32x16* o, int vb, bf16x8 pa0, bf16x8 pa1, bf16x8 pa2, bf16x8 pa3) {
    pv_one<0>(o[0], vb, pa0, pa1, pa2, pa3); pv_one<1>(o[1], vb, pa0, pa1, pa2, pa3); pv_one<2>(o[2], vb, pa0, pa1, pa2, pa3); pv_one<3>(o[3], vb, pa0, pa1, pa2, pa3);
}
__device__ __forceinline__ bool softmax_tile(f32x16& p0, f32x16& p1, float& m_reg, float& l_reg, float& alpha, bf16x8& pa0, bf16x8& pa1, bf16x8& pa2, bf16x8& pa3) {
    float pmax = p0[0];
#pragma unroll
    for (int r = 1; r < 16; ++r) pmax = fmaxf(pmax, p0[r]);
#pragma unroll
    for (int r = 0; r < 16; ++r) pmax = fmaxf(pmax, p1[r]);
    { auto rr = __builtin_amdgcn_permlane32_swap(__float_as_uint(pmax), __float_as_uint(pmax), false, false); pmax = fmaxf(__uint_as_float(rr[0]), __uint_as_float(rr[1])); }
    bool resc = false; alpha = 1.f;
    if (!__all(pmax - m_reg <= THR2)) { const float mn = fmaxf(m_reg, pmax); alpha = __builtin_amdgcn_exp2f(m_reg - mn); m_reg = mn; resc = true; }
    float ps = 0.f;
#pragma unroll
    for (int r = 0; r < 16; ++r) { p0[r] = __builtin_amdgcn_exp2f(p0[r] - m_reg); ps += p0[r]; }
#pragma unroll
    for (int r = 0; r < 16; ++r) { p1[r] = __builtin_amdgcn_exp2f(p1[r] - m_reg); ps += p1[r]; }
    { auto rr = __builtin_amdgcn_permlane32_swap(__float_as_uint(ps), __float_as_uint(ps), false, false); ps = __uint_as_float(rr[0]) + __uint_as_float(rr[1]); }
    l_reg = l_reg * alpha + ps;
#define PK4(P, BASE, OUT) do { unsigned a0 = cvtpk(P[BASE + 0], P[BASE + 1]), a1 = cvtpk(P[BASE + 2], P[BASE + 3]);   \
    unsigned b0 = cvtpk(P[BASE + 4], P[BASE + 5]), b1 = cvtpk(P[BASE + 6], P[BASE + 7]);                              \
    auto r0 = __builtin_amdgcn_permlane32_swap(a0, b0, false, false); auto r1 = __builtin_amdgcn_permlane32_swap(a1, b1, false, false); \
    u32x4 w = {r0[0], r1[0], r0[1], r1[1]}; OUT = *reinterpret_cast<bf16x8*>(&w); } while (0)
    PK4(p0, 0, pa0); PK4(p0, 8, pa1); PK4(p1, 0, pa2); PK4(p1, 8, pa3);
#undef PK4
    return resc;
}

__device__ __forceinline__ void mla_unit(char* lds, const bf16* __restrict__ Q, const bf16* __restrict__ KN, const bf16* __restrict__ KR, const bf16* __restrict__ V, bf16* __restrict__ OAB, int b, int h, int qb) {
    int tid_ = threadIdx.x; asm volatile("" : "+v"(tid_)); const int tid = tid_, lane = tid & 63, r32 = lane & 31, hi = lane >> 5; const int wid = __builtin_amdgcn_readfirstlane(tid >> 6);
    const bool metaq = (qb == 16);
    const bool wave_on = !metaq || wid == 0;
    const int qrow = metaq ? (TREAL + 16 * b + (r32 & 15)) : (b * SEQ + qb * 256 + wid * 32 + r32);
    float* wsf = (float*)(lds + OFF_WS) + wid * 64;
    bf16x8 qr[12];
    { const bf16* qp = Q + (size_t)qrow * 3072 + h * 192 + hi * 8;
#pragma unroll
      for (int d0 = 0; d0 < 12; ++d0) qr[d0] = *reinterpret_cast<const bf16x8*>(qp + d0 * 16); }
    const int sr = tid >> 4, sc = (tid & 15) * 8, rr = tid >> 3, rc = (tid & 7) * 8;
    const int kn_w0 = kn_off(sr, sc * 2), kn_w1 = kn_off(32 + sr, sc * 2), kr_w = kr_off(rr, rc * 2), v_w0 = v_st(sr, sc), v_w1 = v_st(32 + sr, sc);
    const int vb0 = (int)(uintptr_t)(lds + OFF_V) + v_rd_base(lane);
    bf16x8 sk0, sk1, skr, sv0, sv1;
    const size_t real0 = (size_t)b * SEQ, meta0 = (size_t)TREAL + 16 * b;
#define MLA_LOAD(t) do { size_t g0, g1, g2; if ((t) < 64) { g0 = real0 + (t) * 64 + sr; g1 = g0 + 32; g2 = real0 + (t) * 64 + rr; } else { g0 = meta0 + (sr & 15); g1 = g0; g2 = meta0 + (rr & 15); } \
        sk0 = *reinterpret_cast<const bf16x8*>(KN + g0 * 2048 + h * 128 + sc); sk1 = *reinterpret_cast<const bf16x8*>(KN + g1 * 2048 + h * 128 + sc); \
        skr = *reinterpret_cast<const bf16x8*>(KR + g2 * 64 + rc); \
        sv0 = *reinterpret_cast<const bf16x8*>(V + g0 * 2048 + h * 128 + sc); sv1 = *reinterpret_cast<const bf16x8*>(V + g1 * 2048 + h * 128 + sc); } while (0)
#define MLA_WRITE(bf) do { char* base = lds + (bf) * BUF_BYTES; \
        *reinterpret_cast<bf16x8*>(base + OFF_KN + kn_w0) = sk0; *reinterpret_cast<bf16x8*>(base + OFF_KN + kn_w1) = sk1; *reinterpret_cast<bf16x8*>(base + OFF_KR + kr_w) = skr; \
        *reinterpret_cast<bf16x8*>(base + OFF_V + v_w0) = sv0; *reinterpret_cast<bf16x8*>(base + OFF_V + v_w1) = sv1; } while (0)
    float m_reg = NEG_BIG, l_reg = 0.f; f32x16 o[4];
#pragma unroll
    for (int d = 0; d < 4; ++d) o[d] = f32x16{};
    constexpr int NT = 65;
    MLA_LOAD(0); MLA_WRITE(0); __syncthreads();
    for (int t = 0; t < NT; ++t) {
        const int bf = t & 1;
        if (t + 1 < NT) MLA_LOAD(t + 1);
        if (wave_on) {
            const char* kn = lds + bf * BUF_BYTES + OFF_KN; const char* kr = lds + bf * BUF_BYTES + OFF_KR;
            f32x16 p0 = f32x16{}, p1 = f32x16{};
#pragma unroll
            for (int d0 = 0; d0 < 8; ++d0) { const int cb = d0 * 32 + hi * 16;
                const bf16x8 b0 = *reinterpret_cast<const bf16x8*>(kn + kn_off(r32, cb)), b1 = *reinterpret_cast<const bf16x8*>(kn + kn_off(32 + r32, cb));
                p0 = __builtin_amdgcn_mfma_f32_32x32x16_bf16(b0, qr[d0], p0, 0, 0, 0); p1 = __builtin_amdgcn_mfma_f32_32x32x16_bf16(b1, qr[d0], p1, 0, 0, 0); }
#pragma unroll
            for (int d0 = 0; d0 < 4; ++d0) { const int cb = d0 * 32 + hi * 16;
                const bf16x8 b0 = *reinterpret_cast<const bf16x8*>(kr + kr_off(r32, cb)), b1 = *reinterpret_cast<const bf16x8*>(kr + kr_off(32 + r32, cb));
                p0 = __builtin_amdgcn_mfma_f32_32x32x16_bf16(b0, qr[8 + d0], p0, 0, 0, 0); p1 = __builtin_amdgcn_mfma_f32_32x32x16_bf16(b1, qr[8 + d0], p1, 0, 0, 0); }
            if (t == NT - 1) {
#pragma unroll
                for (int r = 0; r < 16; ++r) { if (crow(r, hi) >= 16) p0[r] = NEG_BIG; p1[r] = NEG_BIG; }
            }
            float alpha; bf16x8 pa0, pa1, pa2, pa3;
            const bool resc = softmax_tile(p0, p1, m_reg, l_reg, alpha, pa0, pa1, pa2, pa3);
            if (resc) { if (hi == 0) wsf[r32] = alpha; asm volatile("s_waitcnt lgkmcnt(0)" ::: "memory");
#pragma unroll
                for (int d = 0; d < 4; ++d)
#pragma unroll
                    for (int r = 0; r < 16; ++r) o[d][r] *= wsf[crow(r, hi)]; }
            pv_all(o, vb0 + bf * BUF_BYTES, pa0, pa1, pa2, pa3);
        }
        if (t + 1 < NT) MLA_WRITE(bf ^ 1);
        __syncthreads();
    }
#undef MLA_LOAD
#undef MLA_WRITE
    if (wave_on) {
        if (hi == 0) wsf[32 + r32] = l_reg; asm volatile("s_waitcnt lgkmcnt(0)" ::: "memory");
        const int orow0 = metaq ? (TREAL + 16 * b) : (b * SEQ + qb * 256 + wid * 32);
#pragma unroll
        for (int r = 0; r < 16; ++r) { const int rw = crow(r, hi); const float rl = __builtin_amdgcn_rcpf(wsf[32 + rw]);
            if (!metaq || rw < 16) { bf16* op = OAB + (size_t)(orow0 + rw) * 4096 + h * 128 + r32;
#pragma unroll
                for (int d0 = 0; d0 < 4; ++d0) op[d0 * 32] = (bf16)(cvtpk(o[d0][r] * rl, 0.f) & 0xffffu); } }
    }
    __syncthreads();
}

__device__ __forceinline__ void swa_unit(char* lds, const bf16* __restrict__ QB, const bf16* __restrict__ KB, const bf16* __restrict__ VB, bf16* __restrict__ OAB,
                                         const float* __restrict__ bias_l2, const float* __restrict__ sink_l2, int b, int hk, int j) {
    int tid_ = threadIdx.x; asm volatile("" : "+v"(tid_)); const int tid = tid_, lane = tid & 63, r32 = lane & 31, hi = lane >> 5; const int wid = __builtin_amdgcn_readfirstlane(tid >> 6);
    const bool metaq = (j == 64);
    const int hq = 4 * hk + (wid >> 1);
    const bool wave_on = !metaq || (wid & 1) == 0;
    const int qpos = metaq ? (r32 & 15) : (NMETA + 64 * j + 32 * (wid & 1) + r32);
    const int qrow = metaq ? (TREAL + 16 * b + (r32 & 15)) : (b * SEQ + 64 * j + 32 * (wid & 1) + r32);
    float* wsf = (float*)(lds + OFF_WS) + wid * 64;
    float* bt = (float*)(lds + OFF_BT);
    for (int i = tid; i < 4 * 257; i += 512) { const int g = i / 257, e = i - g * 257; bt[g * 260 + e] = bias_l2[(4 * hk + g) * 257 + e]; }
    const float* btw = bt + (wid >> 1) * 260 + 128;
    bf16x8 qr[8];
    { const bf16* qp = QB + (size_t)qrow * 2048 + hq * 128 + hi * 8;
#pragma unroll
      for (int d0 = 0; d0 < 8; ++d0) qr[d0] = *reinterpret_cast<const bf16x8*>(qp + d0 * 16); }
    const int sr = tid >> 4, sc = (tid & 15) * 8;
    const int kn_w0 = kn_off(sr, sc * 2), kn_w1 = kn_off(32 + sr, sc * 2), v_w0 = v_st(sr, sc), v_w1 = v_st(32 + sr, sc);
    const int vb0 = (int)(uintptr_t)(lds + OFF_V) + v_rd_base(lane);
    bf16x8 sk0, sk1, sv0, sv1;
    int nt, kt_lo = 0;
    if (metaq) nt = 3; else { kt_lo = j - 2 < 0 ? 0 : j - 2; const int kt_hi = j + 2 > 63 ? 63 : j + 2; nt = 1 + (kt_hi - kt_lo + 1); }
#define SWA_TILE(t, kpos0, mode) do { if (metaq) { kpos0 = 64 * (t); mode = 2; } else if ((t) == 0) { kpos0 = 0; mode = 0; } else { kpos0 = NMETA + 64 * (kt_lo + (t) - 1); mode = 1; } } while (0)
#define SWA_ROW(kp) ({ int kp_ = (kp) > LPOS - 1 ? LPOS - 1 : (kp); (size_t)(kp_ < NMETA ? TREAL + 16 * b + kp_ : b * SEQ + kp_ - NMETA); })
#define SWA_LOAD(t) do { int kpos0_, mode_; SWA_TILE(t, kpos0_, mode_); (void)mode_; const size_t g0 = SWA_ROW(kpos0_ + sr), g1 = SWA_ROW(kpos0_ + 32 + sr); \
        sk0 = *reinterpret_cast<const bf16x8*>(KB + g0 * 512 + hk * 128 + sc); sk1 = *reinterpret_cast<const bf16x8*>(KB + g1 * 512 + hk * 128 + sc); \
        sv0 = *reinterpret_cast<const bf16x8*>(VB + g0 * 512 + hk * 128 + sc); sv1 = *reinterpret_cast<const bf16x8*>(VB + g1 * 512 + hk * 128 + sc); } while (0)
#define SWA_WRITE(bf) do { char* base = lds + (bf) * BUF_BYTES; \
        *reinterpret_cast<bf16x8*>(base + OFF_KN + kn_w0) = sk0; *reinterpret_cast<bf16x8*>(base + OFF_KN + kn_w1) = sk1; \
        *reinterpret_cast<bf16x8*>(base + OFF_V + v_w0) = sv0; *reinterpret_cast<bf16x8*>(base + OFF_V + v_w1) = sv1; } while (0)
    float m_reg = sink_l2[hq], l_reg = 1.f; f32x16 o[4];
#pragma unroll
    for (int d = 0; d < 4; ++d) o[d] = f32x16{};
    SWA_LOAD(0); SWA_WRITE(0); __syncthreads();
    for (int t = 0; t < nt; ++t) {
        const int bf = t & 1;
        if (t + 1 < nt) SWA_LOAD(t + 1);
        if (wave_on) {
            int kpos0, mode; SWA_TILE(t, kpos0, mode);
            const char* kn = lds + bf * BUF_BYTES + OFF_KN;
            f32x16 p0 = f32x16{}, p1 = f32x16{};
#pragma unroll
            for (int d0 = 0; d0 < 8; ++d0) { const int cb = d0 * 32 + hi * 16;
                const bf16x8 b0 = *reinterpret_cast<const bf16x8*>(kn + kn_off(r32, cb)), b1 = *reinterpret_cast<const bf16x8*>(kn + kn_off(32 + r32, cb));
                p0 = __builtin_amdgcn_mfma_f32_32x32x16_bf16(b0, qr[d0], p0, 0, 0, 0); p1 = __builtin_amdgcn_mfma_f32_32x32x16_bf16(b1, qr[d0], p1, 0, 0, 0); }
#pragma unroll
            for (int r = 0; r < 16; ++r) {
#pragma unroll
                for (int half = 0; half < 2; ++half) { const int kp = kpos0 + crow(r, hi) + 32 * half; const int rel = kp - qpos; const int arel = rel < 0 ? -rel : rel;
                    const bool win = (kp >= NMETA) && (arel <= 128) && (kp < LPOS);
                    const bool vis = mode == 0 ? (kp < NMETA) : (mode == 1 ? win : ((kp < NMETA) || win));
                    const int rc = rel < -128 ? -128 : (rel > 128 ? 128 : rel);
                    const float bias = btw[rc];
                    if (half == 0) p0[r] = vis ? p0[r] + bias : NEG_BIG; else p1[r] = vis ? p1[r] + bias : NEG_BIG; } }
            float alpha; bf16x8 pa0, pa1, pa2, pa3;
            const bool resc = softmax_tile(p0, p1, m_reg, l_reg, alpha, pa0, pa1, pa2, pa3);
            if (resc) { if (hi == 0) wsf[r32] = alpha; asm volatile("s_waitcnt lgkmcnt(0)" ::: "memory");
#pragma unroll
                for (int d = 0; d < 4; ++d)
#pragma unroll
                    for (int r = 0; r < 16; ++r) o[d][r] *= wsf[crow(r, hi)]; }
            pv_all(o, vb0 + bf * BUF_BYTES, pa0, pa1, pa2, pa3);
        }
        if (t + 1 < nt) SWA_WRITE(bf ^ 1);
        __syncthreads();
    }
#undef SWA_TILE
#undef SWA_ROW
#undef SWA_LOAD
#undef SWA_WRITE
    if (wave_on) {
        if (hi == 0) wsf[32 + r32] = l_reg; asm volatile("s_waitcnt lgkmcnt(0)" ::: "memory");
        const int orow0 = metaq ? (TREAL + 16 * b) : (b * SEQ + 64 * j + 32 * (wid & 1));
#pragma unroll
        for (int r = 0; r < 16; ++r) { const int rw = crow(r, hi); const float rl = __builtin_amdgcn_rcpf(wsf[32 + rw]);
            if (!metaq || rw < 16) { bf16* op = OAB + (size_t)(orow0 + rw) * 4096 + 2048 + hq * 128 + r32;
#pragma unroll
                for (int d0 = 0; d0 < 4; ++d0) op[d0 * 32] = (bf16)(cvtpk(o[d0][r] * rl, 0.f) & 0xffffu); } }
    }
    __syncthreads();
}
}
constexpr int NWAVES = 8;
constexpr int N_PHASES = 20;
constexpr size_t MiB = 1u << 20, KiB32 = 32768;
constexpr size_t WS_CTL = 0, CTL_ZERO_BYTES = 65536;
constexpr size_t WS_CS = 1 * MiB, WS_SN = WS_CS + 540672;
constexpr size_t WS_BIAS = 3 * MiB;
constexpr size_t WS_SINK = WS_BIAS + 32768;
constexpr size_t WS_WHIST = WS_BIAS + 65536;
constexpr size_t WS_TOPI = 4 * MiB, WS_TOPG = WS_TOPI + 262144, WS_TOKSLOT = WS_TOPG + 262144;
constexpr size_t WS_SLOTTOK = 5 * MiB, WS_SLOTGATE = WS_SLOTTOK + 294912;
constexpr size_t WS_SSQ = 6 * MiB;
constexpr size_t WS_HB = 9 * MiB;
constexpr size_t WS_W = 138 * MiB;
constexpr size_t WL_IN = 0, WL_UQ = 34 * MiB, WL_UKV = WL_UQ + 9 * MiB / 2, WL_AB = WL_UKV + 4 * MiB, WL_OUT = WL_AB + 16 * MiB, WL_STRIDE = WL_OUT + 8 * MiB;
constexpr size_t WS_WF13 = WS_W + 2 * WL_STRIDE, WS_WF2 = WS_WF13 + 44 * MiB, WS_WEND = WS_WF2 + 22 * MiB;
constexpr size_t AR = 337 * MiB;
constexpr size_t WS_CQ = AR, WS_CKV = WS_CQ + 1548 * KiB32, WS_KR = WS_CKV + 1032 * KiB32, WS_QB = WS_KR + 132 * KiB32;
constexpr size_t WS_KB = WS_QB + 129 * MiB, WS_VB = WS_KB + 1032 * KiB32, WS_GR = WS_VB + 1032 * KiB32, WS_GBB = WS_GR + 129 * MiB;
constexpr size_t WS_Q = WS_GBB + 129 * MiB, WS_KN = WS_Q + 6192 * KiB32  , WS_V = WS_KN + 129 * MiB, WS_OAB = WS_V + 129 * MiB, WS_MIX_END = WS_OAB + 258 * MiB;
constexpr size_t WS_MG = WS_Q;
constexpr size_t WS_X = WS_OAB;
constexpr size_t WS_ACT = AR;
constexpr size_t WS_MW13 = 138 * MiB, WS_MW2 = WS_MW13 + 8 * 44 * MiB;
constexpr size_t WS_MACT = WS_MW2 + 8 * 22 * MiB;
constexpr size_t WS_Y = WS_MACT + 726 * MiB;
constexpr size_t WS_END = WS_Y + 264 * MiB;
static_assert(WS_MIX_END <= 1700 * MiB && WS_END <= 1700 * MiB, "d_ws map");
static_assert(WS_ACT + (size_t)TP * DFF * 2 <= WS_X, "dense ACT vs X");
static_assert(WS_SSQ + (size_t)TP * 20 * 4 <= WS_HB && WS_SLOTGATE + 294912 <= WS_SSQ && WS_TOKSLOT + 262144 <= WS_SLOTTOK && WS_SN + 540672 <= WS_BIAS, "small tables");
static_assert(WS_KR + (size_t)TP * 64 * 2 <= WS_QB, "KR");
constexpr int CW_TMO = 0, CW_CODE = 1;
constexpr int CW_MOE_TS = 64;
constexpr int CW_BAR = 4096;
constexpr int RING_OFF = 0, RING_BYTES = 131072;
constexpr int LDSCTL_OFF = RING_BYTES, MISC_OFF = LDSCTL_OFF + 320, PT_OFF = LDSCTL_OFF + 512;
constexpr int LDS_BYTES = 147456;
static_assert(att::ATT_LDS_BYTES <= RING_BYTES, "attention LDS");

#define GAS __attribute__((address_space(1)))
#define LAS __attribute__((address_space(3)))
typedef unsigned short bf16;
typedef unsigned v4u __attribute__((ext_vector_type(4)));
typedef unsigned v2u __attribute__((ext_vector_type(2)));
typedef float f32x4 __attribute__((ext_vector_type(4)));
typedef GAS unsigned gu32;
#define RLX_AGENT __ATOMIC_RELAXED, __HIP_MEMORY_SCOPE_AGENT
#define LDS_WAIT() asm volatile("s_waitcnt lgkmcnt(0)" ::: "memory")
#define VM_WAIT() asm volatile("s_waitcnt vmcnt(0)" ::: "memory")
__device__ __forceinline__ unsigned f2bf(float f) { unsigned u = __builtin_bit_cast(unsigned, f); return (u + 0x7fffu + ((u >> 16) & 1u)) >> 16; }
__device__ __forceinline__ unsigned pk2(float lo, float hi) { return f2bf(lo) | (f2bf(hi) << 16); }

#define XB_TMO      128
#define XB_XCNT(j)  (256  + 64 * (j))
#define XB_XSUB(j)  (1280 + 64 * (j))
#define XB_XGEN(j)  (2304 + 64 * (j))
#define XB_TOP      3328
#define XB_TOPGEN   3392
#define XCD_BAR_WORDS 3456
#define XB_SPIN_CAP (1u << 22)
__device__ __forceinline__ unsigned xb_ld(unsigned* p)              { return __hip_atomic_load(p, __ATOMIC_RELAXED, __HIP_MEMORY_SCOPE_AGENT); }
__device__ __forceinline__ unsigned xb_add(unsigned* p, unsigned v) { return __hip_atomic_fetch_add(p, v, __ATOMIC_RELAXED, __HIP_MEMORY_SCOPE_AGENT); }
__device__ __forceinline__ unsigned xb_xcc_id() { return (unsigned)__builtin_amdgcn_s_getreg((3 << 11) | 20) & 0xFu; }
#define XB_SPIN(cond, bar) do { unsigned _sp = 0; while (cond) { __builtin_amdgcn_s_sleep(1); \
    if ((++_sp & 255u) == 0u) { if (xb_ld(&(bar)[XB_TMO])) break; if (_sp > XB_SPIN_CAP) { atomicAdd(&(bar)[XB_TMO], 1u); break; } } } } while (0)
struct XcdBarrier { unsigned* bar; unsigned x; volatile LAS unsigned* st; };
__device__ __forceinline__ XcdBarrier xcd_barrier_post(unsigned* bar, volatile LAS unsigned* st) {
    XcdBarrier b; b.bar = bar; b.x = xb_xcc_id(); b.st = st;
    if (threadIdx.x == 0) (void)xb_add(&bar[XB_XCNT(b.x)], 1u);
    return b;
}
__device__ __forceinline__ void xcd_barrier_complete(unsigned* bar, unsigned x, unsigned& nloc, unsigned& nx) {
    const unsigned G = gridDim.x * gridDim.y * gridDim.z;
    unsigned sum, cnt, mine, sp = 0u;
    for (;;) {
        sum = 0u; cnt = 0u; mine = 0u;
#pragma unroll
        for (unsigned j = 0; j < 16; ++j) { const unsigned c = xb_ld(&bar[XB_XCNT(j)]); sum += c; cnt += (c > 0u) ? 1u : 0u; mine = (j == x) ? c : mine; }
        if (sum == G) break;
        __builtin_amdgcn_s_sleep(1);
        if ((++sp & 255u) == 0u) { if (xb_ld(&bar[XB_TMO])) break; if (sp > XB_SPIN_CAP) { atomicAdd(&bar[XB_TMO], 1u); break; } }
    }
    nloc = mine > 0u ? mine : 1u; nx = cnt > 0u ? cnt : 1u;
}
__device__ __forceinline__ void xcd_barrier(const XcdBarrier& b) {
    asm volatile("s_waitcnt vmcnt(0)" ::: "memory");
    __syncthreads();
    if (threadIdx.x == 0) {
        unsigned* bar = b.bar;
        __builtin_amdgcn_s_waitcnt(0);
        unsigned nloc = b.st[0], nx = b.st[1];
        if (nloc == 0u) { xcd_barrier_complete(bar, b.x, nloc, nx); b.st[0] = nloc; b.st[1] = nx; }
        const unsigned old = xb_add(&bar[XB_XSUB(b.x)], 1u);
        const unsigned gen = old / nloc;
        if (old + 1u == (gen + 1u) * nloc) {
            __builtin_amdgcn_fence(__ATOMIC_RELEASE, "agent");
            asm volatile("s_waitcnt vmcnt(0)" ::: "memory");
            const unsigned og = xb_add(&bar[XB_TOP], 1u);
            const unsigned tg = og / nx;
            if (og + 1u == (tg + 1u) * nx) xb_add(&bar[XB_TOPGEN], 1u);
            else XB_SPIN(xb_ld(&bar[XB_TOPGEN]) == tg, bar);
            __builtin_amdgcn_fence(__ATOMIC_ACQUIRE, "agent");
            xb_add(&bar[XB_XGEN(b.x)], 1u);
            asm volatile("s_waitcnt vmcnt(0)" ::: "memory");
        } else {
            XB_SPIN(xb_ld(&bar[XB_XGEN(b.x)]) == gen, bar);
            __builtin_amdgcn_fence(__ATOMIC_ACQUIRE, "agent");
            asm volatile("s_waitcnt vmcnt(0)" ::: "memory");
        }
    }
    __syncthreads();
}

__device__ __forceinline__ float wave_sum(float v) {
#pragma unroll
    for (int o = 1; o < 64; o <<= 1) v += __shfl_xor(v, o);
    return v;
}
__device__ __forceinline__ void transpose_item(const float* __restrict__ W, int ldw, int k0, int n0, bf16* __restrict__ WT, size_t ldt, int drow, int koff, const float* __restrict__ g, LAS float* scr, int lane) {
    const int kr = lane >> 3, c4 = (lane & 7) * 4;
    f32x4 v[8];
#pragma unroll
    for (int i = 0; i < 8; ++i) v[i] = *(const GAS f32x4*)(W + (size_t)(k0 + 8 * i + kr) * ldw + n0 + c4);
    if (g) {
#pragma unroll
        for (int i = 0; i < 8; ++i) v[i] = v[i] * g[k0 + 8 * i + kr]; }
#pragma unroll
    for (int i = 0; i < 8; ++i) { LAS float* d = scr + (8 * i + kr) * 33 + c4; d[0] = v[i].x; d[1] = v[i].y; d[2] = v[i].z; d[3] = v[i].w; }
    LDS_WAIT(); asm volatile("" ::: "memory");
    const int c = lane & 7;
#pragma unroll
    for (int j = 0; j < 4; ++j) { const int n = (lane >> 3) + 8 * j; const LAS float* s = scr + (8 * c) * 33 + n;
        v4u o; o.x = pk2(s[0 * 33], s[1 * 33]); o.y = pk2(s[2 * 33], s[3 * 33]); o.z = pk2(s[4 * 33], s[5 * 33]); o.w = pk2(s[6 * 33], s[7 * 33]);
        *(GAS v4u*)(WT + (size_t)(drow + n) * ldt + koff + k0 + 8 * c) = o; }
    LDS_WAIT(); asm volatile("" ::: "memory");
}
__device__ __forceinline__ int dmap_in(int n0) {
    if (n0 < 1280) return n0;
    if (n0 < 1312) return 1280;
    if (n0 < 1344) return 1280 + 128;
    if (n0 < 3392) return 1536 + (n0 - 1344);
    if (n0 < 3904) return 3584 + (n0 - 3392);
    if (n0 < 4416) return 4096 + (n0 - 3904);
    if (n0 < 6464) { const int a = n0 - 4416; return 4608 + 256 * (a >> 7) + (a & 127); }
    const int a = n0 - 6464; return 4608 + 256 * (a >> 7) + 128 + (a & 127);
}
__device__ __forceinline__ int dmap_uq(int n0) {
    const int head = n0 / 192, off = n0 - head * 192;
    if (off < 128) return 256 * (head >> 1) + 128 * (head & 1) + off;
    if (off < 160) return 256 * (8 + (head >> 2)) + 32 * (head & 3);
    return 256 * (8 + (head >> 2)) + 128 + 32 * (head & 3);
}
__device__ __forceinline__ int dmap_glu(int n0) { return 256 * (n0 >> 7) + (n0 & 127); }
struct Row8 { f32x4 v[8]; };
__device__ __forceinline__ void ln_normalize(Row8& r) {
    float s = 0.f;
#pragma unroll
    for (int j = 0; j < 8; ++j) s += (r.v[j].x + r.v[j].y) + (r.v[j].z + r.v[j].w);
    const float mean = wave_sum(s) * (1.f / D); float s2 = 0.f;
#pragma unroll
    for (int j = 0; j < 8; ++j) { r.v[j] = r.v[j] - mean; s2 += (r.v[j].x * r.v[j].x + r.v[j].y * r.v[j].y) + (r.v[j].z * r.v[j].z + r.v[j].w * r.v[j].w); }
    const float rstd = 1.f / sqrtf(wave_sum(s2) * (1.f / D) + LN_EPS);
#pragma unroll
    for (int j = 0; j < 8; ++j) r.v[j] = r.v[j] * rstd;
}
__device__ __forceinline__ void ln_affine(Row8& r, const float* __restrict__ g, const float* __restrict__ b, int lane) {
#pragma unroll
    for (int j = 0; j < 8; ++j) { const f32x4 gg = *((const f32x4*)g + lane + 64 * j), bb = *((const f32x4*)b + lane + 64 * j); r.v[j] = r.v[j] * gg + bb; }
}
__device__ __forceinline__ void row_store_bf16(const Row8& r, bf16* orow, int lane) {
    GAS v2u* o8 = (GAS v2u*)orow + lane;
#pragma unroll
    for (int j = 0; j < 8; ++j) { v2u w; w.x = pk2(r.v[j].x, r.v[j].y); w.y = pk2(r.v[j].z, r.v[j].w); o8[64 * j] = w; }
}
__device__ __forceinline__ void row_load_f32(Row8& r, const float* xrow, int lane) {
#pragma unroll
    for (int j = 0; j < 8; ++j) r.v[j] = *((const GAS f32x4*)xrow + lane + 64 * j);
}
__device__ __forceinline__ f32x4 bf4(v2u w) { return (f32x4){__uint_as_float(w.x << 16), __uint_as_float(w.x & 0xffff0000u), __uint_as_float(w.y << 16), __uint_as_float(w.y & 0xffff0000u)}; }
__device__ __forceinline__ int t5_bucket(int rel) {
    const int n = rel < 0 ? -rel : rel; int v;
    if (n < 8) v = n; else if (n < 12) v = 8; else if (n < 16) v = 9; else if (n < 23) v = 10; else if (n < 32) v = 11; else if (n < 46) v = 12; else if (n < 64) v = 13; else if (n < 91) v = 14; else v = 15;
    return (rel > 0 ? 16 : 0) + v;
}
enum { I_X = 0, I_META, I_EMB_G, I_EMB_B, I_RELB, I_WIN, I_QNG, I_KVNG, I_WUQ, I_WUKV, I_SINK, I_WPA, I_WPB, I_WOUT, I_LMG, I_LMB, I_LFG, I_LFB,
       I_FW1, I_FW3, I_FW2, I_RW, I_RB, I_MW1, I_MW3, I_MW2, N_IN };
struct Args { const float* in[N_IN]; float* out; unsigned char* ws; int ph_lo, ph_hi; };

__global__ void __launch_bounds__(NWAVES * 64, 2) mk_fwd(Args args) {
    extern __shared__ __attribute__((aligned(16))) unsigned char lds_raw[];
    LAS unsigned char* const lds = (LAS unsigned char*)lds_raw;
    char* const ldsg = (char*)lds_raw;
    volatile LAS unsigned* const MISC = (volatile LAS unsigned*)(lds + MISC_OFF);
    const int tid_k = threadIdx.x; const int tid = tid_k, lane = tid & 63, wave = __builtin_amdgcn_readfirstlane(tid >> 6);
    const int G = gridDim.x; const int bx = blockIdx.x; const int vcu = (G % 8 == 0) ? (bx % 8) * (G / 8) + bx / 8 : bx;
    for (int u = tid; u < (LDS_BYTES - LDSCTL_OFF) / 4; u += NWAVES * 64) ((LAS unsigned*)(lds + LDSCTL_OFF))[u] = 0u;
    __syncthreads();
    volatile LAS unsigned long long* const PT = (volatile LAS unsigned long long*)(lds + PT_OFF);
    if (tid == 0) {
#pragma unroll
        for (int i = 0; i < N_IN; ++i) PT[i] = (unsigned long long)args.in[i];
        PT[N_IN] = (unsigned long long)args.out; PT[N_IN + 1] = (unsigned long long)args.ws; }
    const int lo = args.ph_lo, hi = args.ph_hi;
    __syncthreads();
#define LDP(i) ({ const unsigned long long v_ = PT[i]; (unsigned long long)(unsigned)__builtin_amdgcn_readfirstlane((int)(unsigned)v_) | ((unsigned long long)(unsigned)__builtin_amdgcn_readfirstlane((int)(unsigned)(v_ >> 32)) << 32); })
#define INP(i) ((const float*)LDP(i))
#define PH_WS() asm volatile("" ::: "memory"); int tid = tid_k; asm volatile("" : "+v"(tid)); const int lane = tid & 63; (void)lane; unsigned char* const ws = (unsigned char*)LDP(N_IN + 1); \
    bf16* const HB = (bf16*)(ws + WS_HB); float* const CS = (float*)(ws + WS_CS); float* const SN = (float*)(ws + WS_SN); float* const SSQ = (float*)(ws + WS_SSQ); float* const X = (float*)(ws + WS_X); \
    (void)HB; (void)CS; (void)SN; (void)SSQ; (void)X
    XcdBarrier bar; { unsigned char* const ws0 = (unsigned char*)LDP(N_IN + 1); bar.bar = (unsigned*)(ws0 + WS_CTL) + CW_BAR; bar.x = 0; bar.st = nullptr;
    if (hi - lo > 1) bar = xcd_barrier_post((unsigned*)(ws0 + WS_CTL) + CW_BAR, MISC + 8); }
#ifndef PHMASK
#define PHMASK 0xFFFF
#endif
#define KEN(kind) ((PHMASK >> (kind)) & 1)
#ifndef REPMASK
#define REPMASK 0
#endif
#define NREP(kind) (((REPMASK >> (kind)) & 1) ? 2 : 1)
#define IN(k) (lo <= (k) && (k) < hi)
#define SEAM(k) do { if (IN(k) && IN((k) + 1)) xcd_barrier(bar); } while (0)
    const int gw = vcu * NWAVES + wave, NGW = G * NWAVES;

    for (int rep_ = 0; rep_ < NREP(0); ++rep_) if (KEN(0) && IN(0)) { PH_WS(); int* const SLOT_TOK = (int*)(ws + WS_SLOTTOK); float* const SLOT_GATE = (float*)(ws + WS_SLOTGATE); int* const TOK_SLOT = (int*)(ws + WS_TOKSLOT); (void)SLOT_TOK; (void)SLOT_GATE; (void)TOK_SLOT;
        LAS float* scr = (LAS float*)(lds + RING_OFF + wave * 16384);
        constexpr int I_IN = (D / 64) * (INDIM / 32), I_UQ = (QRANK / 64) * (3072 / 32), I_UKV = (KVRANK / 64) * (4096 / 32), I_SQ = (D / 64) * (D / 32), I_LAYER = I_IN + I_UQ + I_UKV + 3 * I_SQ;
        constexpr int I_F = (D / 64) * (DFF / 32), I_F2 = (DFF / 64) * (D / 32), NITEMS = 2 * I_LAYER + 2 * I_F + I_F2;
        for (int it = gw; it < NITEMS; it += NGW) {
            int r = it;
            if (r < 2 * I_LAYER) { const int l = r / I_LAYER; r -= l * I_LAYER; unsigned char* wl = ws + WS_W + l * WL_STRIDE;
                if (r < I_IN) { const int nblk = INDIM / 32, kb = r / nblk, nb = r % nblk; transpose_item(INP(I_WIN) + (size_t)l * D * INDIM, INDIM, 64 * kb, 32 * nb, (bf16*)(ws + WS_W + l * WL_STRIDE + WL_IN), D, dmap_in(32 * nb), 0, nullptr, scr, lane); continue; } r -= I_IN;
                if (r < I_UQ) { const int nblk = 3072 / 32, kb = r / nblk, nb = r % nblk; transpose_item(INP(I_WUQ) + (size_t)l * QRANK * 3072, 3072, 64 * kb, 32 * nb, (bf16*)(ws + WS_W + l * WL_STRIDE + WL_UQ), QRANK, dmap_uq(32 * nb), 0, INP(I_QNG) + l * QRANK, scr, lane); continue; } r -= I_UQ;
                if (r < I_UKV) { const int nblk = 4096 / 32, kb = r / nblk, nb = r % nblk; transpose_item(INP(I_WUKV) + (size_t)l * KVRANK * 4096, 4096, 64 * kb, 32 * nb, (bf16*)(ws + WS_W + l * WL_STRIDE + WL_UKV), KVRANK, 32 * nb, 0, INP(I_KVNG) + l * KVRANK, scr, lane); continue; } r -= I_UKV;
                { const int which = r / I_SQ; r -= which * I_SQ; const int nblk = D / 32, kb = r / nblk, nb = r % nblk;
                  if (which == 0) transpose_item(INP(I_WPA) + (size_t)l * D * D, D, 64 * kb, 32 * nb, (bf16*)(ws + WS_W + l * WL_STRIDE + WL_AB), 2 * D, 32 * nb, 0, nullptr, scr, lane);
                  else if (which == 1) transpose_item(INP(I_WPB) + (size_t)l * D * D, D, 64 * kb, 32 * nb, (bf16*)(ws + WS_W + l * WL_STRIDE + WL_AB), 2 * D, 32 * nb, D, nullptr, scr, lane);
                  else transpose_item(INP(I_WOUT) + (size_t)l * D * D, D, 64 * kb, 32 * nb, (bf16*)(ws + WS_W + l * WL_STRIDE + WL_OUT), D, 32 * nb, 0, nullptr, scr, lane);
                  continue; }
            }
            r -= 2 * I_LAYER;
            if (r < 2 * I_F) { const int which = r / I_F; r -= which * I_F; const int nblk = DFF / 32, kb = r / nblk, nb = r % nblk;
                transpose_item(INP(which ? I_FW3 : I_FW1), DFF, 64 * kb, 32 * nb, (bf16*)(ws + WS_WF13), D, dmap_glu(32 * nb) + (which ? 128 : 0), 0, nullptr, scr, lane); continue; }
            r -= 2 * I_F;
            { const int nblk = D / 32, kb = r / nblk, nb = r % nblk; transpose_item(INP(I_FW2), D, 64 * kb, 32 * nb, (bf16*)(ws + WS_WF2), DFF, 32 * nb, 0, nullptr, scr, lane); }
        }
        for (int i = gw * 64 + lane; i < 2 * 192 * 256; i += NGW * 64) { const int l = i / (192 * 256), q = i % (192 * 256), rr = q / 256, c16 = q % 256; const int row = rr < 96 ? 1312 + rr : 1440 + (rr - 96);
            *(GAS v4u*)(ws + WS_W + l * WL_STRIDE + WL_IN + (size_t)row * (D * 2) + c16 * 16) = (v4u){0u, 0u, 0u, 0u}; }
        for (int i = gw * 64 + lane; i < LPOS * 32; i += NGW * 64) { const int pos = i >> 5, k = i & 31; const float inv = powf(10000.f, -(float)(2 * k) / 64.f); const float ang = (float)pos * inv; CS[i] = cosf(ang); SN[i] = sinf(ang); }
        for (int i = gw * 64 + lane; i < 16 * 257; i += NGW * 64) { const int hh = i / 257, rel = i % 257 - 128; ((float*)(ws + WS_BIAS))[i] = INP(I_RELB)[t5_bucket(rel) * 16 + hh] * LOG2E; }
        if (gw == 0 && lane < 32) ((float*)(ws + WS_SINK))[lane] = INP(I_SINK)[lane] * LOG2E;
        for (int m = gw; m < TP; m += NGW) {
            if (m < T) { Row8 r; row_load_f32(r, m < TREAL ? INP(I_X) + (size_t)m * D : INP(I_META) + (size_t)((m - TREAL) & 15) * D, lane);
                ln_normalize(r); ln_affine(r, INP(I_EMB_G), INP(I_EMB_B), lane); row_store_bf16(r, HB + (size_t)m * D, lane); }
            else { GAS v2u* o8 = (GAS v2u*)(HB + (size_t)m * D) + lane;
#pragma unroll
                for (int j = 0; j < 8; ++j) o8[64 * j] = (v2u){0u, 0u}; }
        }
    }
    SEAM(0);

#pragma unroll 1
    for (int l = 0; l < 2; ++l) {
        const int P = 1 + 9 * l + (l ? 0 : 0);
        const int nM_all = TP / 256;
        const int nM_post = l == 0 ? TP / 256 : TREAL / 256;
        for (int rep_ = 0; rep_ < NREP(1); ++rep_) if (KEN(1) && IN(P + 0)) { PH_WS(); int* const SLOT_TOK = (int*)(ws + WS_SLOTTOK); float* const SLOT_GATE = (float*)(ws + WS_SLOTGATE); int* const TOK_SLOT = (int*)(ws + WS_TOKSLOT); (void)SLOT_TOK; (void)SLOT_GATE; (void)TOK_SLOT;
            ProbDense pr; pr.so.init(nM_all, NIN / 256, G, bx); pr.A = (const char*)HB; pr.Bt = (const char*)(ws + WS_W + l * WL_STRIDE + WL_IN); pr.tstep = 256 * (size_t)D * 2;
            epi::EpiWin E{(bf16*)(ws + WS_CQ), (bf16*)(ws + WS_CKV), (bf16*)(ws + WS_KR), (bf16*)(ws + WS_QB), (bf16*)(ws + WS_KB), (bf16*)(ws + WS_VB), (bf16*)(ws + WS_GR), (bf16*)(ws + WS_GBB), SSQ, CS, SN};
            pg8::gemm_phase<epi::EpiWin, ProbDense>(lds + RING_OFF, D, pr, E);
        }
        SEAM(P + 0);
        for (int rep_ = 0; rep_ < NREP(2); ++rep_) if (KEN(2) && IN(P + 1)) { PH_WS(); int* const SLOT_TOK = (int*)(ws + WS_SLOTTOK); float* const SLOT_GATE = (float*)(ws + WS_SLOTGATE); int* const TOK_SLOT = (int*)(ws + WS_TOKSLOT); (void)SLOT_TOK; (void)SLOT_GATE; (void)TOK_SLOT;
            { ProbDense pr; pr.so.init(nM_all, 3072 / 256, G, bx); pr.A = (const char*)(ws + WS_CQ); pr.Bt = (const char*)(ws + WS_W + l * WL_STRIDE + WL_UQ); pr.tstep = 256 * (size_t)QRANK * 2;
              epi::EpiUq E{(bf16*)(ws + WS_Q), SSQ, CS, SN};
              pg8::gemm_phase<epi::EpiUq, ProbDense>(lds + RING_OFF, QRANK, pr, E); }
            { ProbDense pr; pr.so.init(nM_all, 4096 / 256, G, bx); pr.A = (const char*)(ws + WS_CKV); pr.Bt = (const char*)(ws + WS_W + l * WL_STRIDE + WL_UKV); pr.tstep = 256 * (size_t)KVRANK * 2;
              epi::EpiUkv E{(bf16*)(ws + WS_KN), (bf16*)(ws + WS_V), SSQ};
              pg8::gemm_phase<epi::EpiUkv, ProbDense>(lds + RING_OFF, KVRANK, pr, E); }
        }
        SEAM(P + 1);
        for (int rep_ = 0; rep_ < NREP(3); ++rep_) if (KEN(3) && IN(P + 2)) { PH_WS(); int* const SLOT_TOK = (int*)(ws + WS_SLOTTOK); float* const SLOT_GATE = (float*)(ws + WS_SLOTGATE); int* const TOK_SLOT = (int*)(ws + WS_TOKSLOT); (void)SLOT_TOK; (void)SLOT_GATE; (void)TOK_SLOT;
            const int nqb = l == 0 ? 17 : 16, nmla_full = NB * NH * 16, nmla = NB * NH * nqb;
            for (int rep2_ = 0; rep2_ < NREP(14); ++rep2_)
            for (int u = vcu; u < nmla; u += G) {
                int b, h, qb;
                if (u < nmla_full) { qb = u & 15; h = (u >> 4) & 15; b = u >> 8; } else { const int v = u - nmla_full; qb = 16; h = v & 15; b = v >> 4; }
                att::mla_unit(ldsg + RING_OFF, (const bf16*)(ws + WS_Q), (const bf16*)(ws + WS_KN), (const bf16*)(ws + WS_KR), (const bf16*)(ws + WS_V), (bf16*)(ws + WS_OAB), b, h, qb);
            }
            const int nj = l == 0 ? 65 : 64, nswa_full = NB * 4 * 64, nswa = NB * 4 * nj;
            for (int rep2_ = 0; rep2_ < NREP(15); ++rep2_)
            for (int u = vcu; u < nswa; u += G) {
                int b, hk, j;
                if (u < nswa_full) { j = u & 63; hk = (u >> 6) & 3; b = u >> 8; } else { const int v = u - nswa_full; j = 64; hk = v & 3; b = v >> 2; }
                att::swa_unit(ldsg + RING_OFF, (const bf16*)(ws + WS_QB), (const bf16*)(ws + WS_KB), (const bf16*)(ws + WS_VB), (bf16*)(ws + WS_OAB), (const float*)(ws + WS_BIAS), (const float*)(ws + WS_SINK) + 16 * l, b, hk, j);
            }
        }
        SEAM(P + 2);
        for (int rep_ = 0; rep_ < NREP(4); ++rep_) if (KEN(4) && IN(P + 3)) { PH_WS(); int* const SLOT_TOK = (int*)(ws + WS_SLOTTOK); float* const SLOT_GATE = (float*)(ws + WS_SLOTGATE); int* const TOK_SLOT = (int*)(ws + WS_TOKSLOT); (void)SLOT_TOK; (void)SLOT_GATE; (void)TOK_SLOT;
            ProbDense pr; pr.so.init(nM_post, D / 256, G, bx); pr.A = (const char*)(ws + WS_OAB); pr.Bt = (const char*)(ws + WS_W + l * WL_STRIDE + WL_AB); pr.tstep = 256 * (size_t)(2 * D) * 2;
            epi::EpiProj E{(bf16*)(ws + WS_MG), (const bf16*)(ws + WS_GR), (const bf16*)(ws + WS_GBB)};
            pg8::gemm_phase<epi::EpiProj, ProbDense>(lds + RING_OFF, 2 * D, pr, E);
        }
        SEAM(P + 3);
        for (int rep_ = 0; rep_ < NREP(5); ++rep_) if (KEN(5) && IN(P + 4)) { PH_WS(); int* const SLOT_TOK = (int*)(ws + WS_SLOTTOK); float* const SLOT_GATE = (float*)(ws + WS_SLOTGATE); int* const TOK_SLOT = (int*)(ws + WS_TOKSLOT); (void)SLOT_TOK; (void)SLOT_GATE; (void)TOK_SLOT;
            ProbDense pr; pr.so.init(nM_post, D / 256, G, bx); pr.A = (const char*)(ws + WS_MG); pr.Bt = (const char*)(ws + WS_W + l * WL_STRIDE + WL_OUT); pr.tstep = 256 * (size_t)D * 2;
            epi::EpiResid E{X, HB};
            pg8::gemm_phase<epi::EpiResid, ProbDense>(lds + RING_OFF, D, pr, E);
        }
        SEAM(P + 4);
        for (int rep_ = 0; rep_ < NREP(6); ++rep_) if (KEN(6) && IN(P + 5)) { PH_WS(); int* const SLOT_TOK = (int*)(ws + WS_SLOTTOK); float* const SLOT_GATE = (float*)(ws + WS_SLOTGATE); int* const TOK_SLOT = (int*)(ws + WS_TOKSLOT); (void)SLOT_TOK; (void)SLOT_GATE; (void)TOK_SLOT;
            const float* g = INP(I_LMG) + l * D; const float* bta = INP(I_LMB) + l * D;
            const int nrows = l == 0 ? T : TREAL;
            int h0 = 0, h1 = 0, h2 = 0, h3 = 0, h4 = 0, h5 = 0, h6 = 0, h7 = 0;
            LAS f32x4* const rwl = (LAS f32x4*)(lds + RING_OFF);
            if (l == 1) { const GAS f32x4* rwg = (const GAS f32x4*)INP(I_RW); for (int i = tid; i < D * 2; i += NWAVES * 64) { const int k = i >> 1, hf = i & 1; rwl[hf * 2048 + ((k >> 8) * 4 + (k & 3)) * 64 + ((k >> 2) & 63)] = rwg[i]; } __syncthreads(); }
            for (int m = gw; m < nrows; m += NGW) {
                Row8 r; row_load_f32(r, X + (size_t)m * D, lane); ln_normalize(r); ln_affine(r, g, bta, lane); row_store_bf16(r, HB + (size_t)m * D, lane);
                if (l == 1) {
                    float lg[8];
#pragma unroll
                    for (int e = 0; e < 8; ++e) lg[e] = 0.f;
#pragma unroll
                    for (int j = 0; j < 8; ++j) {
#pragma unroll
                        for (int q = 0; q < 4; ++q) { const f32x4 w0 = rwl[(j * 4 + q) * 64 + lane], w1 = rwl[2048 + (j * 4 + q) * 64 + lane]; const float y = r.v[j][q];
                            lg[0] += y * w0.x; lg[1] += y * w0.y; lg[2] += y * w0.z; lg[3] += y * w0.w; lg[4] += y * w1.x; lg[5] += y * w1.y; lg[6] += y * w1.z; lg[7] += y * w1.w; } }
#pragma unroll
                    for (int e = 0; e < 8; ++e) lg[e] = wave_sum(lg[e]) + INP(I_RB)[e];
                    int i0 = 0; float v0 = lg[0];
#pragma unroll
                    for (int e = 1; e < 8; ++e) if (lg[e] > v0) { v0 = lg[e]; i0 = e; }
                    int i1 = -1; float v1 = -3.0e38f;
#pragma unroll
                    for (int e = 0; e < 8; ++e) if (e != i0 && lg[e] > v1) { v1 = lg[e]; i1 = e; }
                    const float e1 = __expf(v1 - v0), g0 = 1.f / (1.f + e1), g1 = e1 / (1.f + e1);
                    if (lane == 0) { int* ti = (int*)(ws + WS_TOPI); float* tg = (float*)(ws + WS_TOPG); ti[2 * m] = i0; ti[2 * m + 1] = i1; tg[2 * m] = g0; tg[2 * m + 1] = g1; }
                    h0 += (i0 == 0) + (i1 == 0); h1 += (i0 == 1) + (i1 == 1); h2 += (i0 == 2) + (i1 == 2); h3 += (i0 == 3) + (i1 == 3);
                    h4 += (i0 == 4) + (i1 == 4); h5 += (i0 == 5) + (i1 == 5); h6 += (i0 == 6) + (i1 == 6); h7 += (i0 == 7) + (i1 == 7);
                }
            }
            if (l == 1 && lane == 0) { int* wh = (int*)(ws + WS_WHIST) + gw * 8; wh[0] = h0; wh[1] = h1; wh[2] = h2; wh[3] = h3; wh[4] = h4; wh[5] = h5; wh[6] = h6; wh[7] = h7; }
        }
        SEAM(P + 5);
        if (l == 0) {
            for (int rep_ = 0; rep_ < NREP(7); ++rep_) if (KEN(7) && IN(P + 6)) { PH_WS(); int* const SLOT_TOK = (int*)(ws + WS_SLOTTOK); float* const SLOT_GATE = (float*)(ws + WS_SLOTGATE); int* const TOK_SLOT = (int*)(ws + WS_TOKSLOT); (void)SLOT_TOK; (void)SLOT_GATE; (void)TOK_SLOT;
                ProbDense pr; pr.so.init(nM_all, 2 * DFF / 256, G, bx); pr.A = (const char*)HB; pr.Bt = (const char*)(ws + WS_WF13); pr.tstep = 256 * (size_t)D * 2;
                epi::EpiSwiglu E{(bf16*)(ws + WS_ACT)};
                pg8::gemm_phase<epi::EpiSwiglu, ProbDense>(lds + RING_OFF, D, pr, E);
            }
            SEAM(P + 6);
            for (int rep_ = 0; rep_ < NREP(8); ++rep_) if (KEN(8) && IN(P + 7)) { PH_WS(); int* const SLOT_TOK = (int*)(ws + WS_SLOTTOK); float* const SLOT_GATE = (float*)(ws + WS_SLOTGATE); int* const TOK_SLOT = (int*)(ws + WS_TOKSLOT); (void)SLOT_TOK; (void)SLOT_GATE; (void)TOK_SLOT;
                ProbDense pr; pr.so.init(nM_all, D / 256, G, bx); pr.A = (const char*)(ws + WS_ACT); pr.Bt = (const char*)(ws + WS_WF2); pr.tstep = 256 * (size_t)DFF * 2;
                epi::EpiResid E{X, HB};
                pg8::gemm_phase<epi::EpiResid, ProbDense>(lds + RING_OFF, DFF, pr, E);
            }
            SEAM(P + 7);
            for (int rep_ = 0; rep_ < NREP(9); ++rep_) if (KEN(9) && IN(P + 8)) { PH_WS(); int* const SLOT_TOK = (int*)(ws + WS_SLOTTOK); float* const SLOT_GATE = (float*)(ws + WS_SLOTGATE); int* const TOK_SLOT = (int*)(ws + WS_TOKSLOT); (void)SLOT_TOK; (void)SLOT_GATE; (void)TOK_SLOT;
                const float* g = INP(I_LFG); const float* bta = INP(I_LFB);
                for (int m = gw; m < T; m += NGW) { Row8 r; row_load_f32(r, X + (size_t)m * D, lane); ln_normalize(r); ln_affine(r, g, bta, lane); row_store_bf16(r, HB + (size_t)m * D, lane); }
            }
            SEAM(P + 8);
        } else {
            for (int rep_ = 0; rep_ < NREP(10); ++rep_) if (KEN(10) && IN(P + 6)) { PH_WS(); int* const SLOT_TOK = (int*)(ws + WS_SLOTTOK); float* const SLOT_GATE = (float*)(ws + WS_SLOTGATE); int* const TOK_SLOT = (int*)(ws + WS_TOKSLOT); (void)SLOT_TOK; (void)SLOT_GATE; (void)TOK_SLOT;
                LAS int* hist = (LAS int*)(lds + RING_OFF);
                LAS int* segsum = hist + 2048 * 8;
                LAS int* segpre = segsum + 64 * 8;
                LAS int* tot = segpre + 64 * 8;
                const int* wh = (const int*)(ws + WS_WHIST);
                for (int i = tid; i < NGW * 8; i += NWAVES * 64) hist[i] = wh[i];
                __syncthreads();
                { const int e = tid & 7, seg = tid >> 3; int s = 0;
_Pragma("unroll 1")
                  for (int w = 0; w < 32; ++w) { const int ww = seg * 32 + w; if (ww < NGW) s += hist[ww * 8 + e]; } segsum[seg * 8 + e] = s; }
                __syncthreads();
                if (tid < 8) { int run = 0;
_Pragma("unroll 1")
                    for (int s = 0; s < 64; ++s) { segpre[s * 8 + tid] = run; run += segsum[s * 8 + tid]; } tot[tid] = run; }
                __syncthreads();
                if (tid == 0) { int ts = 0; for (int e = 0; e < 8; ++e) { tot[8 + e] = ts; ts += (tot[e] + 255) >> 8; } tot[16] = ts;
                    if (bx == 0) for (int e = 0; e < 9; ++e) ((int*)(ws + WS_CTL))[CW_MOE_TS + e] = tot[8 + e]; }
                __syncthreads();
                int base = 0;
                if (lane < 8) { base = tot[8 + lane] * 256 + segpre[(gw >> 5) * 8 + lane];
_Pragma("unroll 1")
                    for (int w = (gw & ~31); w < gw; ++w) base += hist[w * 8 + lane]; }
                const int* ti = (const int*)(ws + WS_TOPI); const float* tg = (const float*)(ws + WS_TOPG);
                for (int m = gw; m < TREAL; m += NGW) {
#pragma unroll
                    for (int k = 0; k < 2; ++k) { const int e = __builtin_amdgcn_readfirstlane(ti[2 * m + k]); const float gt = tg[2 * m + k];
                        const int slot = __builtin_amdgcn_readlane(base, e); if (lane == e) base += 1;
                        if (lane == 0) { SLOT_TOK[slot] = m; SLOT_GATE[slot] = gt; TOK_SLOT[2 * m + k] = slot; } }
                }
                if (vcu < 8) { const int e = vcu; const int s0 = tot[8 + e] * 256 + tot[e], s1 = tot[8 + e + 1] * 256; for (int s = s0 + tid; s < s1; s += NWAVES * 64) { SLOT_TOK[s] = T; SLOT_GATE[s] = 0.f; } }
                __syncthreads();
                LAS float* scr = (LAS float*)(lds + RING_OFF + wave * 16384);
                constexpr int I_F = (D / 64) * (DFF / 32), I_F2 = (DFF / 64) * (D / 32), I_E = 2 * I_F + I_F2;
                for (int it = gw; it < NE * I_E; it += NGW) {
                    const int e = it / I_E; int r = it - e * I_E;
                    if (r < 2 * I_F) { const int which = r / I_F; r -= which * I_F; const int nblk = DFF / 32, kb = r / nblk, nb = r % nblk;
                        transpose_item(INP(which ? I_MW3 : I_MW1) + (size_t)e * D * DFF, DFF, 64 * kb, 32 * nb, (bf16*)(ws + WS_MW13) + (size_t)e * 2 * DFF * D, D, dmap_glu(32 * nb) + (which ? 128 : 0), 0, nullptr, scr, lane); continue; }
                    r -= 2 * I_F;
                    { const int nblk = D / 32, kb = r / nblk, nb = r % nblk; transpose_item(INP(I_MW2) + (size_t)e * DFF * D, D, 64 * kb, 32 * nb, (bf16*)(ws + WS_MW2) + (size_t)e * D * DFF, DFF, 32 * nb, 0, nullptr, scr, lane); }
                }
            }
            SEAM(P + 6);
            MoeTiles mt;
            if (IN(P + 7) || IN(P + 8)) { unsigned char* const ws = (unsigned char*)LDP(N_IN + 1);
#pragma unroll
                for (int e = 0; e < 9; ++e) mt.ts[e] = __builtin_amdgcn_readfirstlane(((const int*)(ws + WS_CTL))[CW_MOE_TS + e]);
            } else {
#pragma unroll
                for (int e = 0; e < 9; ++e) mt.ts[e] = 0;
            }
            for (int rep_ = 0; rep_ < NREP(11); ++rep_) if (KEN(11) && IN(P + 7)) { PH_WS(); int* const SLOT_TOK = (int*)(ws + WS_SLOTTOK); float* const SLOT_GATE = (float*)(ws + WS_SLOTGATE); int* const TOK_SLOT = (int*)(ws + WS_TOKSLOT); (void)SLOT_TOK; (void)SLOT_GATE; (void)TOK_SLOT;
                ProbMoe1 pr; pr.so.init(mt.ts[8], 2 * DFF / 256, G, bx); pr.HBp = (const char*)HB; pr.slot_tok = SLOT_TOK; pr.W = (const char*)(ws + WS_MW13); pr.mt = mt;
                epi::EpiSwiglu E{(bf16*)(ws + WS_MACT)};
                pg8::gemm_phase<epi::EpiSwiglu, ProbMoe1, true>(lds + RING_OFF, D, pr, E);
            }
            SEAM(P + 7);
            for (int rep_ = 0; rep_ < NREP(12); ++rep_) if (KEN(12) && IN(P + 8)) { PH_WS(); int* const SLOT_TOK = (int*)(ws + WS_SLOTTOK); float* const SLOT_GATE = (float*)(ws + WS_SLOTGATE); int* const TOK_SLOT = (int*)(ws + WS_TOKSLOT); (void)SLOT_TOK; (void)SLOT_GATE; (void)TOK_SLOT;
                ProbMoe2 pr; pr.so.init(mt.ts[8], D / 256, G, bx); pr.ACTp = (const char*)(ws + WS_MACT); pr.W = (const char*)(ws + WS_MW2); pr.mt = mt;
                epi::EpiMoeDown E{(bf16*)(ws + WS_Y), SLOT_GATE};
                pg8::gemm_phase<epi::EpiMoeDown, ProbMoe2>(lds + RING_OFF, DFF, pr, E);
            }
            SEAM(P + 8);
            for (int rep_ = 0; rep_ < NREP(13); ++rep_) if (KEN(13) && IN(P + 9)) { PH_WS(); int* const SLOT_TOK = (int*)(ws + WS_SLOTTOK); float* const SLOT_GATE = (float*)(ws + WS_SLOTGATE); int* const TOK_SLOT = (int*)(ws + WS_TOKSLOT); (void)SLOT_TOK; (void)SLOT_GATE; (void)TOK_SLOT;
                const float* g = INP(I_LFG) + D; const float* bta = INP(I_LFB) + D; const bf16* Y = (const bf16*)(ws + WS_Y);
                for (int m = gw; m < TREAL; m += NGW) {
                    const int s0 = TOK_SLOT[2 * m], s1 = TOK_SLOT[2 * m + 1]; Row8 r;
#pragma unroll
                    for (int j = 0; j < 8; ++j) { const v2u hw = *((const GAS v2u*)(HB + (size_t)m * D) + lane + 64 * j), y0 = *((const GAS v2u*)(Y + (size_t)s0 * D) + lane + 64 * j), y1 = *((const GAS v2u*)(Y + (size_t)s1 * D) + lane + 64 * j);
                        r.v[j] = (bf4(hw) * ALPHA + bf4(y0)) + bf4(y1); }
                    ln_normalize(r); ln_affine(r, g, bta, lane);
                    GAS f32x4* o = (GAS f32x4*)(((float*)LDP(N_IN)) + (size_t)m * D) + lane;
#pragma unroll
                    for (int j = 0; j < 8; ++j) o[64 * j] = r.v[j];
                }
            }
        }
    }
#undef IN
#undef SEAM
}

#ifndef MK_ONE_LAUNCH
#define MK_ONE_LAUNCH 0
#endif
extern "C" void kernel_launch(void* const* d_in, const int* in_sizes, int n_in, void* d_out, int out_size, void* d_ws, size_t ws_size, hipStream_t stream) {
    static int grid = 0;
    if (grid == 0) {
        if (n_in != N_IN || in_sizes[0] != NB * SEQ * D || out_size != NB * SEQ * D || ws_size < WS_END) { fprintf(stderr, "kernel_launch: shape mismatch: n_in %d in0 %d out %d ws %zu (need %zu)\n", n_in, n_in > 0 ? in_sizes[0] : -1, out_size, ws_size, (size_t)WS_END); grid = -1; return; }
        int dev = 0, cus = 0, per_cu = 0;
        if (hipGetDevice(&dev) != hipSuccess || hipDeviceGetAttribute(&cus, hipDeviceAttributeMultiprocessorCount, dev) != hipSuccess) { fprintf(stderr, "kernel_launch: device query failed\n"); grid = -1; return; }
        if (hipFuncSetAttribute((const void*)mk_fwd, hipFuncAttributeMaxDynamicSharedMemorySize, LDS_BYTES) != hipSuccess) { fprintf(stderr, "kernel_launch: hipFuncSetAttribute failed\n"); grid = -1; return; }
        if (hipOccupancyMaxActiveBlocksPerMultiprocessor(&per_cu, (const void*)mk_fwd, NWAVES * 64, LDS_BYTES) != hipSuccess || per_cu < 1) fprintf(stderr, "kernel_launch: occupancy query reports %d\n", per_cu);
        (void)hipGetLastError();
        grid = cus;
    }
    if (grid < 0) return;
    if (hipMemsetAsync((char*)d_ws + WS_CTL, 0, CTL_ZERO_BYTES, stream) != hipSuccess) { fprintf(stderr, "kernel_launch: memset failed\n"); return; }
    Args a{};
    for (int i = 0; i < N_IN; ++i) a.in[i] = (const float*)d_in[i];
    a.out = (float*)d_out; a.ws = (unsigned char*)d_ws;
#if MK_ONE_LAUNCH
    a.ph_lo = 0; a.ph_hi = N_PHASES;
    hipLaunchKernelGGL(mk_fwd, dim3(grid), dim3(NWAVES * 64), LDS_BYTES, stream, a);
#else
    for (int p = 0; p < N_PHASES; ++p) { a.ph_lo = p; a.ph_hi = p + 1; hipLaunchKernelGGL(mk_fwd, dim3(grid), dim3(NWAVES * 64), LDS_BYTES, stream, a); }
#endif
    const hipError_t le = hipPeekAtLastError();
    if (le != hipSuccess) fprintf(stderr, "kernel_launch: launch failed: %s\n", hipGetErrorName(le));
}
```

```cpp
#define REPMASK 0
#define MK_ONE_LAUNCH 1
#include <hip/hip_runtime.h>
#include <cstdio>
#include <cstdint>
namespace pg8 {
#define PG8_LAS __attribute__((address_space(3)))
typedef unsigned short bf16_t;
typedef short bf16x8 __attribute__((ext_vector_type(8)));
typedef float f32x4 __attribute__((ext_vector_type(4)));
typedef float f32x2 __attribute__((ext_vector_type(2)));
typedef unsigned u32x4 __attribute__((ext_vector_type(4)));
typedef unsigned u32x2 __attribute__((ext_vector_type(2)));
constexpr int BM = 256, BK = 64, HALF = 128, HTB = HALF * BK * 2  , STAGE_BYTES = 8 * HTB, NXCD = 8, WGM = 8;

__host__ __device__ __forceinline__ int lds_byte(int r, int c) { const int st = (r >> 4) * 2 + (c >> 5), rr = r & 15, cc = c & 31, ob = rr * 64 + cc * 2; return st * 1024 + (ob ^ (((ob >> 9) & 1) << 5)); }
__host__ __device__ __forceinline__ void stage_rc(int b, int& R, int& C) { const int st = b / 1024, sb = b % 1024, swz = sb ^ (((sb >> 9) & 1) << 5); R = (st >> 1) * 16 + swz / 64; C = (st & 1) * 32 + (swz % 64) / 2; }
__host__ __device__ __forceinline__ int perm32(int rho) { const int n = rho >> 4, i = rho & 15; return 8 * (i >> 2) + 4 * n + (i & 3); }

struct Unit { int pm, pn; };

struct StaticOrder {
    int nM, nN, nwg, G, c;
    __device__ __forceinline__ void init(int nM_, int nN_, int G_, int c_) { nM = nM_; nN = nN_; nwg = nM * nN; G = G_; c = c_; }
    __device__ __forceinline__ bool next(int i, Unit& u) const {
        const long L = (long)i * G + c; if (L >= nwg) return false;
        int wgid = (int)L; { const int q = nwg / NXCD, r = nwg % NXCD, xcd = wgid % NXCD, off = wgid / NXCD; wgid = (xcd < r ? xcd * (q + 1) : r * (q + 1) + (xcd - r) * q) + off; }
        const int nig = WGM * nN, gid = wgid / nig, fm = gid * WGM, gsz = (nM - fm) < WGM ? (nM - fm) : WGM;
        u.pm = fm + ((wgid % nig) % gsz); u.pn = (wgid % nig) / gsz; return true;
    }
};
__device__ __forceinline__ unsigned cvt_pk_bf16(float lo, float hi) { unsigned r; asm volatile("v_cvt_pk_bf16_f32 %0, %1, %2" : "=v"(r) : "v"(lo), "v"(hi)); return r; }
__device__ __forceinline__ float bf_lo(unsigned w) { return __uint_as_float(w << 16); }
__device__ __forceinline__ float bf_hi(unsigned w) { return __uint_as_float(w & 0xffff0000u); }

template <class Epi, class Prob, bool GATHER = false>
__device__ __forceinline__ void gemm_phase(PG8_LAS unsigned char* lds, const int K, const Prob& S, const Epi& E) {
    int tid_ = threadIdx.x; asm volatile("" : "+v"(tid_));
    const int tid = tid_, wid = __builtin_amdgcn_readfirstlane(tid >> 6), lane = tid & 63, wr = wid >> 2, wc = wid & 3, fr = lane & 15, fq = lane >> 4;
    const int nt = K / BK;
    int sR[2], sC[2];
    unsigned voffA[2][2], nvoffA[2][2], voffB[2];
#pragma unroll
    for (int i = 0; i < 2; ++i) { int R, C; stage_rc(tid * 16 + i * 8192, R, C); sR[i] = R; sC[i] = C; const int Rb = (R & ~31) + perm32(R & 31);
        voffB[i] = (unsigned)(Rb * K + C) * 2u;
        voffA[0][i] = (unsigned)(R * K + C) * 2u; voffA[1][i] = (unsigned)((R + HALF) * K + C) * 2u; nvoffA[0][i] = voffA[0][i]; nvoffA[1][i] = voffA[1][i]; }
    const size_t kstep = (size_t)(BK * 2);
    const size_t hstep = (size_t)HALF * K * 2;
    const unsigned ldsw = (unsigned)wid * 1024u;
    const int aoff = lds_byte(wr * 64 + fr, fq * 8), boff = lds_byte(wc * 32 + fr, fq * 8);
#define PG8_SA(b, h) (((b) * 2 + (h)) * HTB)
#define PG8_SB(b, h) ((4 + (b) * 2 + (h)) * HTB)
#define PG8_STAGE(bufoff, gbase, voff) do { _Pragma("unroll") for (int _i = 0; _i < 2; ++_i) \
        __builtin_amdgcn_global_load_lds((const unsigned*)((const char*)(gbase) + (voff)[_i]), (PG8_LAS unsigned*)(lds + (bufoff) + ldsw + _i * 8192), 16, 0, 0); } while (0)
#define PG8_LDA(dst, b, h) do { _Pragma("unroll") for (int m = 0; m < 4; ++m) _Pragma("unroll") for (int k = 0; k < 2; ++k) dst[m][k] = *(const PG8_LAS bf16x8*)(lds + PG8_SA(b, h) + aoff + m * 2048 + k * 1024); } while (0)
#define PG8_LDB(dst, b, h) do { _Pragma("unroll") for (int n = 0; n < 2; ++n) _Pragma("unroll") for (int k = 0; k < 2; ++k) dst[n][k] = *(const PG8_LAS bf16x8*)(lds + PG8_SB(b, h) + boff + n * 2048 + k * 1024); } while (0)
#define PG8_MMA(ai, bj, At, Bt) do { __builtin_amdgcn_s_setprio(1); _Pragma("unroll") for (int m = 0; m < 4; ++m) _Pragma("unroll") for (int n = 0; n < 2; ++n) _Pragma("unroll") for (int k = 0; k < 2; ++k) \
        acc[ai][bj][m][n] = __builtin_amdgcn_mfma_f32_16x16x32_bf16(Bt[n][k], At[m][k], acc[ai][bj][m][n], 0, 0, 0); __builtin_amdgcn_s_setprio(0); } while (0)
#define PG8_WAIT_V(n) asm volatile("s_waitcnt vmcnt(" #n ")" ::: "memory")
#define PG8_WAIT_L(n) asm volatile("s_waitcnt lgkmcnt(" #n ")" ::: "memory")
#define PG8_BAR __builtin_amdgcn_s_barrier()
#define PG8_SCHED __builtin_amdgcn_sched_barrier(0)
    Unit cur, nxt; int ui = 0;
    if (!S.next(0, cur)) return;
    f32x4 acc[2][2][4][2];
#pragma unroll
    for (int a = 0; a < 2; ++a)
#pragma unroll
        for (int b = 0; b < 2; ++b)
#pragma unroll
            for (int m = 0; m < 4; ++m)
#pragma unroll
                for (int n = 0; n < 2; ++n) acc[a][b][m][n] = (f32x4){0.f, 0.f, 0.f, 0.f};
    bf16x8 At[4][2], B0[2][2], B1[2][2];
    const char* cA = S.a_base(cur); const char* cB = S.b_base(cur);
    if constexpr (GATHER) {
#pragma unroll
        for (int h = 0; h < 2; ++h)
#pragma unroll
            for (int i = 0; i < 2; ++i) { voffA[h][i] = (unsigned)(S.a_row(cur, sR[i] + h * HALF) * K + sC[i]) * 2u; nvoffA[h][i] = voffA[h][i]; }
    }
    PG8_STAGE(PG8_SB(0, 0), cB, voffB); PG8_STAGE(PG8_SB(0, 1), cB + hstep, voffB); PG8_STAGE(PG8_SA(0, 0), cA, voffA[0]); PG8_STAGE(PG8_SA(0, 1), cA, voffA[1]);
    if (wr == 1) PG8_BAR;
    PG8_WAIT_V(2); PG8_BAR;
    PG8_STAGE(PG8_SB(1, 0), cB + kstep, voffB); PG8_STAGE(PG8_SA(1, 0), cA + kstep, voffA[0]); PG8_STAGE(PG8_SB(1, 1), cB + hstep + kstep, voffB);
    PG8_WAIT_V(6); PG8_BAR;
    for (;;) {
        const bool has_next = S.next(ui + 1, nxt);
        const char* nA = has_next ? S.a_base(nxt) : cA; const char* nB = has_next ? S.b_base(nxt) : cB;
        if constexpr (GATHER) { if (has_next) {
#pragma unroll
            for (int h = 0; h < 2; ++h)
#pragma unroll
                for (int i = 0; i < 2; ++i) nvoffA[h][i] = (unsigned)(S.a_row(nxt, sR[i] + h * HALF) * K + sC[i]) * 2u; } }
        for (int t = 0; t < nt; t += 2) {
            const bool last = (t == nt - 2);
            if constexpr (Epi::MID) { if (t == (nt >> 1)) E.mid(acc, cur, wr, wc, fr, fq); }
            const char* a1 = cA + (size_t)(t + 1) * kstep;
            const char* a2 = last ? nA : cA + (size_t)(t + 2) * kstep; const char* b2 = last ? nB : cB + (size_t)(t + 2) * kstep;
            const char* a3 = a2 + kstep; const char* b3 = b2 + kstep;
            unsigned vA2[2][2];
#pragma unroll
            for (int h = 0; h < 2; ++h)
#pragma unroll
                for (int i = 0; i < 2; ++i) vA2[h][i] = GATHER ? (last ? nvoffA[h][i] : voffA[h][i]) : voffA[h][i];
            PG8_LDB(B0, 0, 0); PG8_LDB(B1, 0, 1); PG8_SCHED; PG8_LDA(At, 0, 0); PG8_STAGE(PG8_SA(1, 1), a1, voffA[1]);
            PG8_WAIT_V(8); PG8_WAIT_L(0); PG8_BAR; PG8_MMA(0, 0, At, B0); PG8_MMA(0, 1, At, B1); PG8_BAR; PG8_SCHED;
            PG8_LDA(At, 0, 1); PG8_STAGE(PG8_SB(0, 0), b2, voffB); PG8_STAGE(PG8_SB(0, 1), b2 + hstep, voffB); PG8_STAGE(PG8_SA(0, 0), a2, vA2[0]);
            PG8_WAIT_V(8); PG8_WAIT_L(0); PG8_BAR; PG8_MMA(1, 0, At, B0); PG8_MMA(1, 1, At, B1); PG8_BAR; PG8_SCHED;
            PG8_LDB(B0, 1, 0); PG8_LDB(B1, 1, 1); PG8_SCHED; PG8_LDA(At, 1, 0); PG8_STAGE(PG8_SA(0, 1), a2, vA2[1]);
            PG8_WAIT_V(8); PG8_WAIT_L(0); PG8_BAR; PG8_MMA(0, 0, At, B0); PG8_MMA(0, 1, At, B1); PG8_BAR; PG8_SCHED;
            PG8_LDA(At, 1, 1); PG8_STAGE(PG8_SB(1, 0), b3, voffB); PG8_STAGE(PG8_SB(1, 1), b3 + hstep, voffB); PG8_STAGE(PG8_SA(1, 0), a3, vA2[0]);
            PG8_WAIT_V(8); PG8_WAIT_L(0); PG8_BAR; PG8_MMA(1, 0, At, B0); PG8_MMA(1, 1, At, B1); PG8_BAR; PG8_SCHED;
        }
        if (wr == 0) PG8_BAR;
        E(acc, cur, wr, wc, fr, fq);
        if (!has_next) break;
#pragma unroll
        for (int a = 0; a < 2; ++a)
#pragma unroll
            for (int b = 0; b < 2; ++b)
#pragma unroll
                for (int m = 0; m < 4; ++m)
#pragma unroll
                    for (int n = 0; n < 2; ++n) acc[a][b][m][n] = (f32x4){0.f, 0.f, 0.f, 0.f};
        cur = nxt; cA = nA; cB = nB; ++ui;
        if constexpr (GATHER) {
#pragma unroll
            for (int h = 0; h < 2; ++h)
#pragma unroll
                for (int i = 0; i < 2; ++i) voffA[h][i] = nvoffA[h][i]; }
        if (wr == 1) PG8_BAR;
    }
    PG8_WAIT_V(0);
    PG8_BAR;
#undef PG8_SA
#undef PG8_SB
#undef PG8_STAGE
#undef PG8_LDA
#undef PG8_LDB
#undef PG8_MMA
#undef PG8_WAIT_V
#undef PG8_WAIT_L
#undef PG8_BAR
#undef PG8_SCHED
}
}
constexpr int D = 2048, NB = 8, SEQ = 4096, NMETA = 16, NH = 16;
constexpr int TREAL = NB * SEQ;
constexpr int T = TREAL + NB * NMETA;
constexpr int TP = 33024;
constexpr int LPOS = SEQ + NMETA;
constexpr int QRANK = 768, KVRANK = 512, DFF = 5632, NE = 8;
constexpr int NIN = 8704;
constexpr int INDIM = 8512;
constexpr float LN_EPS = 1e-5f, RMS_EPS = 1e-6f, ALPHA = 1.4142135623730951f;
constexpr float LOG2E = 1.4426950408889634f;
constexpr float QK_SCALE_MLA = 0.07216878364870322f * LOG2E;
constexpr float QK_SCALE_SWA = 0.08838834764831845f * LOG2E;

__device__ __forceinline__ int row_pos(int row) { return row < TREAL ? NMETA + (row & (SEQ - 1)) : ((row - TREAL) & (NMETA - 1)); }

struct ProbDense {
    pg8::StaticOrder so; const char* A; const char* Bt; size_t tstep;
    __device__ __forceinline__ bool next(int i, pg8::Unit& u) const { return so.next(i, u); }
    __device__ __forceinline__ const char* a_base(const pg8::Unit& u) const { return A + (size_t)u.pm * tstep; }
    __device__ __forceinline__ const char* b_base(const pg8::Unit& u) const { return Bt + (size_t)u.pn * tstep; }
    __device__ __forceinline__ int a_row(const pg8::Unit&, int) const { return 0; }
};
struct MoeTiles { int ts[9]; };
__device__ __forceinline__ int moe_expert(const MoeTiles& mt, int pm) { int e = 0;
#pragma unroll
    for (int k = 1; k < 8; ++k) e += (pm >= mt.ts[k]) ? 1 : 0; return e; }
struct ProbMoe1 {
    pg8::StaticOrder so; const char* HBp; const int* slot_tok; const char* W; MoeTiles mt;
    __device__ __forceinline__ bool next(int i, pg8::Unit& u) const { return so.next(i, u); }
    __device__ __forceinline__ const char* a_base(const pg8::Unit&) const { return HBp; }
    __device__ __forceinline__ const char* b_base(const pg8::Unit& u) const { return W + (size_t)moe_expert(mt, u.pm) * ((size_t)2 * DFF * D * 2) + (size_t)u.pn * (256 * (size_t)D * 2); }
    __device__ __forceinline__ int a_row(const pg8::Unit& u, int r) const { return slot_tok[u.pm * 256 + r]; }
};
struct ProbMoe2 {
    pg8::StaticOrder so; const char* ACTp; const char* W; MoeTiles mt;
    __device__ __forceinline__ bool next(int i, pg8::Unit& u) const { return so.next(i, u); }
    __device__ __forceinline__ const char* a_base(const pg8::Unit& u) const { return ACTp + (size_t)u.pm * (256 * (size_t)DFF * 2); }
    __device__ __forceinline__ const char* b_base(const pg8::Unit& u) const { return W + (size_t)moe_expert(mt, u.pm) * ((size_t)D * DFF * 2) + (size_t)u.pn * (256 * (size_t)DFF * 2); }
    __device__ __forceinline__ int a_row(const pg8::Unit&, int) const { return 0; }
};

namespace epi {
using pg8::f32x4; using pg8::u32x4; using pg8::bf16_t; using pg8::Unit; using pg8::cvt_pk_bf16;
typedef const f32x4 (&AccRef)[2][2][4][2];
__device__ __forceinline__ void store8(bf16_t* p, f32x4 v0, f32x4 v1) { u32x4 w; w.x = cvt_pk_bf16(v0[0], v0[1]); w.y = cvt_pk_bf16(v0[2], v0[3]); w.z = cvt_pk_bf16(v1[0], v1[1]); w.w = cvt_pk_bf16(v1[2], v1[3]); *(u32x4*)p = w; }
__device__ __forceinline__ void load8(const bf16_t* p, f32x4& v0, f32x4& v1) { const u32x4 w = *(const u32x4*)p;
    v0 = (f32x4){pg8::bf_lo(w.x), pg8::bf_hi(w.x), pg8::bf_lo(w.y), pg8::bf_hi(w.y)}; v1 = (f32x4){pg8::bf_lo(w.z), pg8::bf_hi(w.z), pg8::bf_lo(w.w), pg8::bf_hi(w.w)}; }
__device__ __forceinline__ bool epi_fence() { asm volatile("" ::: "memory"); return true; }
__device__ __forceinline__ float sigmoidf_(float x) { return __builtin_amdgcn_rcpf(1.f + __builtin_amdgcn_exp2f(-x * LOG2E)); }
#define EPI_AM _Pragma("unroll") for (int ai = 0; ai < 2; ++ai) _Pragma("unroll") for (int m = 0; m < 4; ++m) if (epi_fence())

struct EpiWin {
    static constexpr bool MID = false;
    bf16_t *CQ, *CKV, *KR, *QB, *KB, *VB, *GR, *GBb; float* SSQ; const float *CS, *SN;
    __device__ __forceinline__ void operator()(AccRef acc, const Unit& u, int wr, int wc, int fr, int fq) const {
        const int pn = u.pn, row0 = u.pm * 256 + wr * 64 + fr, cw = wc * 32 + fq * 8;
        if (pn < 5) {
            bf16_t* dst = pn < 3 ? CQ : CKV; const int ld = pn < 3 ? QRANK : KVRANK, c0 = (pn < 3 ? pn : pn - 3) * 256;
            EPI_AM { const int row = row0 + ai * 128 + m * 16; float s = 0.f;
#pragma unroll
                for (int bj = 0; bj < 2; ++bj) { const f32x4 v0 = acc[ai][bj][m][0], v1 = acc[ai][bj][m][1];
                    s += (v0[0] * v0[0] + v0[1] * v0[1]) + (v0[2] * v0[2] + v0[3] * v0[3]) + (v1[0] * v1[0] + v1[1] * v1[1]) + (v1[2] * v1[2] + v1[3] * v1[3]);
                    store8(dst + (size_t)row * ld + c0 + bj * 128 + cw, v0, v1); }
                s += __shfl_xor(s, 16); s += __shfl_xor(s, 32);
                if (fq == 0) SSQ[(size_t)row * 20 + pn * 4 + wc] = s; }
        } else if (pn == 5) {
            if (wc == 0) { EPI_AM { const int row = row0 + ai * 128 + m * 16, pos = row_pos(row);
                const f32x4 c0 = *(const f32x4*)(CS + pos * 32 + fq * 8), c1 = *(const f32x4*)(CS + pos * 32 + fq * 8 + 4), s0 = *(const f32x4*)(SN + pos * 32 + fq * 8), s1 = *(const f32x4*)(SN + pos * 32 + fq * 8 + 4);
                const f32x4 x10 = acc[ai][0][m][0], x11 = acc[ai][0][m][1], x20 = acc[ai][1][m][0], x21 = acc[ai][1][m][1];
                store8(KR + (size_t)row * 64 + fq * 8, x10 * c0 - x20 * s0, x11 * c1 - x21 * s1);
                store8(KR + (size_t)row * 64 + 32 + fq * 8, x10 * s0 + x20 * c0, x11 * s1 + x21 * c1); } }
        } else if (pn < 14) {
            EPI_AM { const int row = row0 + ai * 128 + m * 16;
#pragma unroll
                for (int bj = 0; bj < 2; ++bj) store8(QB + (size_t)row * 2048 + (pn - 6) * 256 + bj * 128 + cw, acc[ai][bj][m][0] * QK_SCALE_SWA, acc[ai][bj][m][1] * QK_SCALE_SWA); }
        } else if (pn < 18) {
            bf16_t* dst = pn < 16 ? KB : VB; const int c0 = (pn < 16 ? pn - 14 : pn - 16) * 256;
            EPI_AM { const int row = row0 + ai * 128 + m * 16;
#pragma unroll
                for (int bj = 0; bj < 2; ++bj) store8(dst + (size_t)row * 512 + c0 + bj * 128 + cw, acc[ai][bj][m][0], acc[ai][bj][m][1]); }
        } else {
            const int c0 = (pn - 18) * 128 + cw;
            EPI_AM { const int row = row0 + ai * 128 + m * 16; f32x4 r[2], g[2];
#pragma unroll
                for (int n = 0; n < 2; ++n)
#pragma unroll
                    for (int j = 0; j < 4; ++j) { const float a = acc[ai][0][m][n][j], b = fmaxf(acc[ai][1][m][n][j], -30.f);
                        const float ea = __builtin_amdgcn_exp2f(-a * LOG2E), eb = __builtin_amdgcn_exp2f(-b * LOG2E);
                        g[n][j] = __builtin_amdgcn_rcpf(1.f + eb); r[n][j] = (1.f + eb) * __builtin_amdgcn_rcpf(1.f + ea); }
                store8(GR + (size_t)row * 2048 + c0, r[0], r[1]); store8(GBb + (size_t)row * 2048 + c0, g[0], g[1]); }
        }
    }
};
struct EpiUq {
    static constexpr bool MID = false;
    bf16_t* Q; const float* SSQ; const float *CS, *SN;
    __device__ __forceinline__ void operator()(AccRef acc, const Unit& u, int wr, int wc, int fr, int fq) const {
        const int pn = u.pn, row0 = u.pm * 256 + wr * 64 + fr, cw = wc * 32 + fq * 8;
        EPI_AM { const int row = row0 + ai * 128 + m * 16;
            const f32x4 q0 = *(const f32x4*)(SSQ + (size_t)row * 20), q1 = *(const f32x4*)(SSQ + (size_t)row * 20 + 4), q2 = *(const f32x4*)(SSQ + (size_t)row * 20 + 8);
            const float ss = ((q0[0] + q0[1]) + (q0[2] + q0[3])) + ((q1[0] + q1[1]) + (q1[2] + q1[3])) + ((q2[0] + q2[1]) + (q2[2] + q2[3]));
            const float rs = __builtin_amdgcn_rsqf(ss * (1.f / QRANK) + RMS_EPS) * QK_SCALE_MLA;
            if (pn < 8) {
#pragma unroll
                for (int bj = 0; bj < 2; ++bj) store8(Q + (size_t)row * 3072 + (2 * pn + bj) * 192 + cw, acc[ai][bj][m][0] * rs, acc[ai][bj][m][1] * rs);
            } else {
                const int head = 4 * (pn - 8) + wc, pos = row_pos(row);
                const f32x4 c0 = *(const f32x4*)(CS + pos * 32 + fq * 8), c1 = *(const f32x4*)(CS + pos * 32 + fq * 8 + 4), s0 = *(const f32x4*)(SN + pos * 32 + fq * 8), s1 = *(const f32x4*)(SN + pos * 32 + fq * 8 + 4);
                const f32x4 x10 = acc[ai][0][m][0] * rs, x11 = acc[ai][0][m][1] * rs, x20 = acc[ai][1][m][0] * rs, x21 = acc[ai][1][m][1] * rs;
                store8(Q + (size_t)row * 3072 + head * 192 + 128 + fq * 8, x10 * c0 - x20 * s0, x11 * c1 - x21 * s1);
                store8(Q + (size_t)row * 3072 + head * 192 + 160 + fq * 8, x10 * s0 + x20 * c0, x11 * s1 + x21 * c1);
            } }
    }
};
struct EpiUkv {
    static constexpr bool MID = false;
    bf16_t *KN, *V; const float* SSQ;
    __device__ __forceinline__ void operator()(AccRef acc, const Unit& u, int wr, int wc, int fr, int fq) const {
        const int pn = u.pn, row0 = u.pm * 256 + wr * 64 + fr, cw = wc * 32 + fq * 8;
        EPI_AM { const int row = row0 + ai * 128 + m * 16;
            const f32x4 q0 = *(const f32x4*)(SSQ + (size_t)row * 20 + 12), q1 = *(const f32x4*)(SSQ + (size_t)row * 20 + 16);
            const float ss = ((q0[0] + q0[1]) + (q0[2] + q0[3])) + ((q1[0] + q1[1]) + (q1[2] + q1[3]));
            const float rs = __builtin_amdgcn_rsqf(ss * (1.f / KVRANK) + RMS_EPS);
            store8(KN + (size_t)row * 2048 + pn * 128 + cw, acc[ai][0][m][0] * rs, acc[ai][0][m][1] * rs);
            store8(V + (size_t)row * 2048 + pn * 128 + cw, acc[ai][1][m][0] * rs, acc[ai][1][m][1] * rs); }
    }
};
struct EpiProj {
    static constexpr bool MID = true;
    bf16_t* MG; const bf16_t *GR, *GBb;
    __device__ __forceinline__ void mid(f32x4 (&acc)[2][2][4][2], const Unit& u, int wr, int wc, int fr, int fq) const {
        int row0 = u.pm * 256 + wr * 64 + fr, c0 = u.pn * 256 + wc * 32 + fq * 8; asm volatile("" : "+v"(row0), "+v"(c0));
        EPI_AM { const int row = row0 + ai * 128 + m * 16;
#pragma unroll
            for (int bj = 0; bj < 2; ++bj) { f32x4 r0, r1; load8(GR + (size_t)row * 2048 + c0 + bj * 128, r0, r1); acc[ai][bj][m][0] *= r0; acc[ai][bj][m][1] *= r1; } }
    }
    __device__ __forceinline__ void operator()(AccRef acc, const Unit& u, int wr, int wc, int fr, int fq) const {
        const int row0 = u.pm * 256 + wr * 64 + fr, c0 = u.pn * 256 + wc * 32 + fq * 8;
        EPI_AM { const int row = row0 + ai * 128 + m * 16;
#pragma unroll
            for (int bj = 0; bj < 2; ++bj) { f32x4 g0, g1; load8(GBb + (size_t)row * 2048 + c0 + bj * 128, g0, g1); store8(MG + (size_t)row * 2048 + c0 + bj * 128, acc[ai][bj][m][0] * g0, acc[ai][bj][m][1] * g1); } }
    }
};
struct EpiResid {
    static constexpr bool MID = false;
    float* X; const bf16_t* HB;
    __device__ __forceinline__ void operator()(AccRef acc, const Unit& u, int wr, int wc, int fr, int fq) const {
        const int row0 = u.pm * 256 + wr * 64 + fr, c0 = u.pn * 256 + wc * 32 + fq * 8;
        EPI_AM { const int row = row0 + ai * 128 + m * 16;
#pragma unroll
            for (int bj = 0; bj < 2; ++bj) { f32x4 h0, h1; load8(HB + (size_t)row * 2048 + c0 + bj * 128, h0, h1);
                float* xp = X + (size_t)row * 2048 + c0 + bj * 128; *(f32x4*)xp = h0 * ALPHA + acc[ai][bj][m][0]; *(f32x4*)(xp + 4) = h1 * ALPHA + acc[ai][bj][m][1]; } }
    }
};
struct EpiSwiglu {
    static constexpr bool MID = false;
    bf16_t* ACT;
    __device__ __forceinline__ void operator()(AccRef acc, const Unit& u, int wr, int wc, int fr, int fq) const {
        const int row0 = u.pm * 256 + wr * 64 + fr, c0 = u.pn * 128 + wc * 32 + fq * 8;
        EPI_AM { const int row = row0 + ai * 128 + m * 16; f32x4 o[2];
#pragma unroll
            for (int n = 0; n < 2; ++n)
#pragma unroll
                for (int j = 0; j < 4; ++j) { const float g = acc[ai][0][m][n][j]; o[n][j] = g * sigmoidf_(g) * acc[ai][1][m][n][j]; }
            store8(ACT + (size_t)row * DFF + c0, o[0], o[1]); }
    }
};
struct EpiMoeDown {
    static constexpr bool MID = false;
    bf16_t* Y; const float* slot_gate;
    __device__ __forceinline__ void operator()(AccRef acc, const Unit& u, int wr, int wc, int fr, int fq) const {
        const int row0 = u.pm * 256 + wr * 64 + fr, c0 = u.pn * 256 + wc * 32 + fq * 8;
        EPI_AM { const int row = row0 + ai * 128 + m * 16; const float g = slot_gate[row];
#pragma unroll
            for (int bj = 0; bj < 2; ++bj) store8(Y + (size_t)row * 2048 + c0 + bj * 128, acc[ai][bj][m][0] * g, acc[ai][bj][m][1] * g); }
    }
};
#undef EPI_AM
}
namespace att {
typedef unsigned short bf16;
typedef short bf16x8 __attribute__((ext_vector_type(8)));
typedef short s16x4 __attribute__((ext_vector_type(4)));
typedef float f32x16 __attribute__((ext_vector_type(16)));
typedef unsigned u32x4 __attribute__((ext_vector_type(4)));
#define ATT_LAS __attribute__((address_space(3)))
#define SBAR() __builtin_amdgcn_sched_barrier(0)
constexpr int KN_BYTES = 16384, KR_BYTES = 8192, V_BYTES = 16384, BUF_BYTES = KN_BYTES + KR_BYTES + V_BYTES;
constexpr int OFF_KN = 0, OFF_KR = KN_BYTES, OFF_V = KN_BYTES + KR_BYTES;
constexpr int OFF_WS = 2 * BUF_BYTES;
constexpr int OFF_BT = OFF_WS + 8 * 64 * 4;
constexpr int ATT_LDS_BYTES = OFF_BT + 4 * 260 * 4;
constexpr float NEG_BIG = -1e30f;
constexpr float THR2 = 8.f;

__device__ __forceinline__ int crow(int r, int hi) { return (r & 3) + 8 * (r >> 2) + 4 * hi; }
__device__ __forceinline__ unsigned cvtpk(float lo, float hi) { unsigned r; asm volatile("v_cvt_pk_bf16_f32 %0, %1, %2" : "=v"(r) : "v"(lo), "v"(hi)); return r; }
__device__ __forceinline__ int kn_off(int row, int colB) { return row * 256 + (colB ^ ((row & 15) << 4)); }
__device__ __forceinline__ int kr_off(int row, int colB) { return row * 128 + (colB ^ (((row >> 1) & 7) << 4)); }
__device__ __forceinline__ int v_st(int k, int c) { const int kk = (k & ~0xC) | ((k & 4) << 1) | ((k & 8) >> 1); return ((kk >> 3) * 4 + (c >> 5)) * 512 + ((kk & 7) * 32 + (c & 31)) * 2; }
__device__ __forceinline__ int v_rd_base(int lane) { return ((lane & 3) << 3) | (((lane >> 2) & 3) << 6) | (((lane >> 4) & 1) << 5) | (((lane >> 5) & 1) << 8); }
constexpr int v_rd_off(int d0, int ks, int half) { return d0 * 512 + ks * 4096 + half * 2048; }
template <int OFF> __device__ __forceinline__ s16x4 tr_read(int vb) { s16x4 r; asm volatile("ds_read_b64_tr_b16 %0, %1 offset:%2" : "=&v"(r) : "v"(vb), "i"(OFF) : "memory"); return r; }
template <int D0> __device__ __forceinline__ void pv_one(f32x16& od, int vb, bf16x8 pa0, bf16x8 pa1, bf16x8 pa2, bf16x8 pa3) {
    const s16x4 l0 = tr_read<v_rd_off(D0, 0, 0)>(vb), h0 = tr_read<v_rd_off(D0, 0, 1)>(vb), l1 = tr_read<v_rd_off(D0, 1, 0)>(vb), h1 = tr_read<v_rd_off(D0, 1, 1)>(vb);
    const s16x4 l2 = tr_read<v_rd_off(D0, 2, 0)>(vb), h2 = tr_read<v_rd_off(D0, 2, 1)>(vb), l3 = tr_read<v_rd_off(D0, 3, 0)>(vb), h3 = tr_read<v_rd_off(D0, 3, 1)>(vb);
    asm volatile("s_waitcnt lgkmcnt(0)" ::: "memory"); SBAR();
#define PK(L, H) (bf16x8){L[0], L[1], L[2], L[3], H[0], H[1], H[2], H[3]}
    od = __builtin_amdgcn_mfma_f32_32x32x16_bf16(pa0, PK(l0, h0), od, 0, 0, 0);
    od = __builtin_amdgcn_mfma_f32_32x32x16_bf16(pa1, PK(l1, h1), od, 0, 0, 0);
    od = __builtin_amdgcn_mfma_f32_32x32x16_bf16(pa2, PK(l2, h2), od, 0, 0, 0);
    od = __builtin_amdgcn_mfma_f32_32x32x16_bf16(pa3, PK(l3, h3), od, 0, 0, 0);
#undef PK
}
__device__ __forceinline__ void pv_all(f32x16* o, int vb, bf16x8 pa0, bf16x8 pa1, bf16x8 pa2, bf16x8 pa3) {
    pv_one<0>(o[0], vb, pa0, pa1, pa2, pa3); pv_one<1>(o[1], vb, pa0, pa1, pa2, pa3); pv_one<2>(o[2], vb, pa0, pa1, pa2, pa3); pv_one<3>(o[3], vb, pa0, pa1, pa2, pa3);
}
__device__ __forceinline__ bool softmax_tile(f32x16& p0, f32x16& p1, float& m_reg, float& l_reg, float& alpha, bf16x8& pa0, bf16x8& pa1, bf16x8& pa2, bf16x8& pa3) {
    float pmax = p0[0];
#pragma unroll
    for (int r = 1; r < 16; ++r) pmax = fmaxf(pmax, p0[r]);
#pragma unroll
    for (int r = 0; r < 16; ++r) pmax = fmaxf(pmax, p1[r]);
    { auto rr = __builtin_amdgcn_permlane32_swap(__float_as_uint(pmax), __float_as_uint(pmax), false, false); pmax = fmaxf(__uint_as_float(rr[0]), __uint_as_float(rr[1])); }
    bool resc = false; alpha = 1.f;
    if (!__all(pmax - m_reg <= THR2)) { const float mn = fmaxf(m_reg, pmax); alpha = __builtin_amdgcn_exp2f(m_reg - mn); m_reg = mn; resc = true; }
    float ps = 0.f;
#pragma unroll
    for (int r = 0; r < 16; ++r) { p0[r] = __builtin_amdgcn_exp2f(p0[r] - m_reg); ps += p0[r]; }
#pragma unroll
    for (int r = 0; r < 16; ++r) { p1[r] = __builtin_amdgcn_exp2f(p1[r] - m_reg); ps += p1[r]; }
    { auto rr = __builtin_amdgcn_permlane32_swap(__float_as_uint(ps), __float_as_uint(ps), false, false); ps = __uint_as_float(rr[0]) + __uint_as_float(rr[1]); }
    l_reg = l_reg * alpha + ps;
#define PK4(P, BASE, OUT) do { unsigned a0 = cvtpk(P[BASE + 0], P[BASE + 1]), a1 = cvtpk(P[BASE + 2], P[BASE + 3]);   \
    unsigned b0 = cvtpk(P[BASE + 4], P[BASE + 5]), b1 = cvtpk(P[BASE + 6], P[BASE + 7]);                              \
    auto r0 = __builtin_amdgcn_permlane32_swap(a0, b0, false, false); auto r1 = __builtin_amdgcn_permlane32_swap(a1, b1, false, false); \
    u32x4 w = {r0[0], r1[0], r0[1], r1[1]}; OUT = *reinterpret_cast<bf16x8*>(&w); } while (0)
    PK4(p0, 0, pa0); PK4(p0, 8, pa1); PK4(p1, 0, pa2); PK4(p1, 8, pa3);
#undef PK4
    return resc;
}

__device__ __forceinline__ void mla_unit(char* lds, const bf16* __restrict__ Q, const bf16* __restrict__ KN, const bf16* __restrict__ KR, const bf16* __restrict__ V, bf16* __restrict__ OAB, int b, int h, int qb) {
    int tid_ = threadIdx.x; asm volatile("" : "+v"(tid_)); const int tid = tid_, lane = tid & 63, r32 = lane & 31, hi = lane >> 5; const int wid = __builtin_amdgcn_readfirstlane(tid >> 6);
    const bool metaq = (qb == 16);
    const bool wave_on = !metaq || wid == 0;
    const int qrow = metaq ? (TREAL + 16 * b + (r32 & 15)) : (b * SEQ + qb * 256 + wid * 32 + r32);
    float* wsf = (float*)(lds + OFF_WS) + wid * 64;
    bf16x8 qr[12];
    { const bf16* qp = Q + (size_t)qrow * 3072 + h * 192 + hi * 8;
#pragma unroll
      for (int d0 = 0; d0 < 12; ++d0) qr[d0] = *reinterpret_cast<const bf16x8*>(qp + d0 * 16); }
    const int sr = tid >> 4, sc = (tid & 15) * 8, rr = tid >> 3, rc = (tid & 7) * 8;
    const int kn_w0 = kn_off(sr, sc * 2), kn_w1 = kn_off(32 + sr, sc * 2), kr_w = kr_off(rr, rc * 2), v_w0 = v_st(sr, sc), v_w1 = v_st(32 + sr, sc);
    const int vb0 = (int)(uintptr_t)(lds + OFF_V) + v_rd_base(lane);
    bf16x8 sk0, sk1, skr, sv0, sv1;
    const size_t real0 = (size_t)b * SEQ, meta0 = (size_t)TREAL + 16 * b;
#define MLA_LOAD(t) do { size_t g0, g1, g2; if ((t) < 64) { g0 = real0 + (t) * 64 + sr; g1 = g0 + 32; g2 = real0 + (t) * 64 + rr; } else { g0 = meta0 + (sr & 15); g1 = g0; g2 = meta0 + (rr & 15); } \
        sk0 = *reinterpret_cast<const bf16x8*>(KN + g0 * 2048 + h * 128 + sc); sk1 = *reinterpret_cast<const bf16x8*>(KN + g1 * 2048 + h * 128 + sc); \
        skr = *reinterpret_cast<const bf16x8*>(KR + g2 * 64 + rc); \
        sv0 = *reinterpret_cast<const bf16x8*>(V + g0 * 2048 + h * 128 + sc); sv1 = *reinterpret_cast<const bf16x8*>(V + g1 * 2048 + h * 128 + sc); } while (0)
#define MLA_WRITE(bf) do { char* base = lds + (bf) * BUF_BYTES; \
        *reinterpret_cast<bf16x8*>(base + OFF_KN + kn_w0) = sk0; *reinterpret_cast<bf16x8*>(base + OFF_KN + kn_w1) = sk1; *reinterpret_cast<bf16x8*>(base + OFF_KR + kr_w) = skr; \
        *reinterpret_cast<bf16x8*>(base + OFF_V + v_w0) = sv0; *reinterpret_cast<bf16x8*>(base + OFF_V + v_w1) = sv1; } while (0)
    float m_reg = NEG_BIG, l_reg = 0.f; f32x16 o[4];
#pragma unroll
    for (int d = 0; d < 4; ++d) o[d] = f32x16{};
    constexpr int NT = 65;
    MLA_LOAD(0); MLA_WRITE(0); __syncthreads();
    for (int t = 0; t < NT; ++t) {
        const int bf = t & 1;
        if (t + 1 < NT) MLA_LOAD(t + 1);
        if (wave_on) {
            const char* kn = lds + bf * BUF_BYTES + OFF_KN; const char* kr = lds + bf * BUF_BYTES + OFF_KR;
            f32x16 p0 = f32x16{}, p1 = f32x16{};
#pragma unroll
            for (int d0 = 0; d0 < 8; ++d0) { const int cb = d0 * 32 + hi * 16;
                const bf16x8 b0 = *reinterpret_cast<const bf16x8*>(kn + kn_off(r32, cb)), b1 = *reinterpret_cast<const bf16x8*>(kn + kn_off(32 + r32, cb));
                p0 = __builtin_amdgcn_mfma_f32_32x32x16_bf16(b0, qr[d0], p0, 0, 0, 0); p1 = __builtin_amdgcn_mfma_f32_32x32x16_bf16(b1, qr[d0], p1, 0, 0, 0); }
#pragma unroll
            for (int d0 = 0; d0 < 4; ++d0) { const int cb = d0 * 32 + hi * 16;
                const bf16x8 b0 = *reinterpret_cast<const bf16x8*>(kr + kr_off(r32, cb)), b1 = *reinterpret_cast<const bf16x8*>(kr + kr_off(32 + r32, cb));
                p0 = __builtin_amdgcn_mfma_f32_32x32x16_bf16(b0, qr[8 + d0], p0, 0, 0, 0); p1 = __builtin_amdgcn_mfma_f32_32x32x16_bf16(b1, qr[8 + d0], p1, 0, 0, 0); }
            if (t == NT - 1) {
#pragma unroll
                for (int r = 0; r < 16; ++r) { if (crow(r, hi) >= 16) p0[r] = NEG_BIG; p1[r] = NEG_BIG; }
            }
            float alpha; bf16x8 pa0, pa1, pa2, pa3;
            const bool resc = softmax_tile(p0, p1, m_reg, l_reg, alpha, pa0, pa1, pa2, pa3);
            if (resc) { if (hi == 0) wsf[r32] = alpha; asm volatile("s_waitcnt lgkmcnt(0)" ::: "memory");
#pragma unroll
                for (int d = 0; d < 4; ++d)
#pragma unroll
                    for (int r = 0; r < 16; ++r) o[d][r] *= wsf[crow(r, hi)]; }
            pv_all(o, vb0 + bf * BUF_BYTES, pa0, pa1, pa2, pa3);
        }
        if (t + 1 < NT) MLA_WRITE(bf ^ 1);
        __syncthreads();
    }
#undef MLA_LOAD
#undef MLA_WRITE
    if (wave_on) {
        if (hi == 0) wsf[32 + r32] = l_reg; asm volatile("s_waitcnt lgkmcnt(0)" ::: "memory");
        const int orow0 = metaq ? (TREAL + 16 * b) : (b * SEQ + qb * 256 + wid * 32);
#pragma unroll
        for (int r = 0; r < 16; ++r) { const int rw = crow(r, hi); const float rl = __builtin_amdgcn_rcpf(wsf[32 + rw]);
            if (!metaq || rw < 16) { bf16* op = OAB + (size_t)(orow0 + rw) * 4096 + h * 128 + r32;
#pragma unroll
                for (int d0 = 0; d0 < 4; ++d0) op[d0 * 32] = (bf16)(cvtpk(o[d0][r] * rl, 0.f) & 0xffffu); } }
    }
    __syncthreads();
}

__device__ __forceinline__ void swa_unit(char* lds, const bf16* __restrict__ QB, const bf16* __restrict__ KB, const bf16* __restrict__ VB, bf16* __restrict__ OAB,
                                         const float* __restrict__ bias_l2, const float* __restrict__ sink_l2, int b, int hk, int j) {
    int tid_ = threadIdx.x; asm volatile("" : "+v"(tid_)); const int tid = tid_, lane = tid & 63, r32 = lane & 31, hi = lane >> 5; const int wid = __builtin_amdgcn_readfirstlane(tid >> 6);
    const bool metaq = (j == 64);
    const int hq = 4 * hk + (wid >> 1);
    const bool wave_on = !metaq || (wid & 1) == 0;
    const int qpos = metaq ? (r32 & 15) : (NMETA + 64 * j + 32 * (wid & 1) + r32);
    const int qrow = metaq ? (TREAL + 16 * b + (r32 & 15)) : (b * SEQ + 64 * j + 32 * (wid & 1) + r32);
    float* wsf = (float*)(lds + OFF_WS) + wid * 64;
    float* bt = (float*)(lds + OFF_BT);
    for (int i = tid; i < 4 * 257; i += 512) { const int g = i / 257, e = i - g * 257; bt[g * 260 + e] = bias_l2[(4 * hk + g) * 257 + e]; }
    const float* btw = bt + (wid >> 1) * 260 + 128;
    bf16x8 qr[8];
    { const bf16* qp = QB + (size_t)qrow * 2048 + hq * 128 + hi * 8;
#pragma unroll
      for (int d0 = 0; d0 < 8; ++d0) qr[d0] = *reinterpret_cast<const bf16x8*>(qp + d0 * 16); }
    const int sr = tid >> 4, sc = (tid & 15) * 8;
    const int kn_w0 = kn_off(sr, sc * 2), kn_w1 = kn_off(32 + sr, sc * 2), v_w0 = v_st(sr, sc), v_w1 = v_st(32 + sr, sc);
    const int vb0 = (int)(uintptr_t)(lds + OFF_V) + v_rd_base(lane);
    bf16x8 sk0, sk1, sv0, sv1;
    int nt, kt_lo = 0;
    if (metaq) nt = 3; else { kt_lo = j - 2 < 0 ? 0 : j - 2; const int kt_hi = j + 2 > 63 ? 63 : j + 2; nt = 1 + (kt_hi - kt_lo + 1); }
#define SWA_TILE(t, kpos0, mode) do { if (metaq) { kpos0 = 64 * (t); mode = 2; } else if ((t) == 0) { kpos0 = 0; mode = 0; } else { kpos0 = NMETA + 64 * (kt_lo + (t) - 1); mode = 1; } } while (0)
#define SWA_ROW(kp) ({ int kp_ = (kp) > LPOS - 1 ? LPOS - 1 : (kp); (size_t)(kp_ < NMETA ? TREAL + 16 * b + kp_ : b * SEQ + kp_ - NMETA); })
#define SWA_LOAD(t) do { int kpos0_, mode_; SWA_TILE(t, kpos0_, mode_); (void)mode_; const size_t g0 = SWA_ROW(kpos0_ + sr), g1 = SWA_ROW(kpos0_ + 32 + sr); \
        sk0 = *reinterpret_cast<const bf16x8*>(KB + g0 * 512 + hk * 128 + sc); sk1 = *reinterpret_cast<const bf16x8*>(KB + g1 * 512 + hk * 128 + sc); \
        sv0 = *reinterpret_cast<const bf16x8*>(VB + g0 * 512 + hk * 128 + sc); sv1 = *reinterpret_cast<const bf16x8*>(VB + g1 * 512 + hk * 128 + sc); } while (0)
#define SWA_WRITE(bf) do { char* base = lds + (bf) * BUF_BYTES; \
        *reinterpret_cast<bf16x8*>(base + OFF_KN + kn_w0) = sk0; *reinterpret_cast<bf16x8*>(base + OFF_KN + kn_w1) = sk1; \
        *reinterpret_cast<bf16x8*>(base + OFF_V + v_w0) = sv0; *reinterpret_cast<bf16x8*>(base + OFF_V + v_w1) = sv1; } while (0)
    float m_reg = sink_l2[hq], l_reg = 1.f; f32x16 o[4];
#pragma unroll
    for (int d = 0; d < 4; ++d) o[d] = f32x16{};
    SWA_LOAD(0); SWA_WRITE(0); __syncthreads();
    for (int t = 0; t < nt; ++t) {
        const int bf = t & 1;
        if (t + 1 < nt) SWA_LOAD(t + 1);
        if (wave_on) {
            int kpos0, mode; SWA_TILE(t, kpos0, mode);
            const char* kn = lds + bf * BUF_BYTES + OFF_KN;
            f32x16 p0 = f32x16{}, p1 = f32x16{};
#pragma unroll
            for (int d0 = 0; d0 < 8; ++d0) { const int cb = d0 * 32 + hi * 16;
                const bf16x8 b0 = *reinterpret_cast<const bf16x8*>(kn + kn_off(r32, cb)), b1 = *reinterpret_cast<const bf16x8*>(kn + kn_off(32 + r32, cb));
                p0 = __builtin_amdgcn_mfma_f32_32x32x16_bf16(b0, qr[d0], p0, 0, 0, 0); p1 = __builtin_amdgcn_mfma_f32_32x32x16_bf16(b1, qr[d0], p1, 0, 0, 0); }
#pragma unroll
            for (int r = 0; r < 16; ++r) {
#pragma unroll
                for (int half = 0; half < 2; ++half) { const int kp = kpos0 + crow(r, hi) + 32 * half; const int rel = kp - qpos; const int arel = rel < 0 ? -rel : rel;
                    const bool win = (kp >= NMETA) && (arel <= 128) && (kp < LPOS);
                    const bool vis = mode == 0 ? (kp < NMETA) : (mode == 1 ? win : ((kp < NMETA) || win));
                    const int rc = rel < -128 ? -128 : (rel > 128 ? 128 : rel);
                    const float bias = btw[rc];
                    if (half == 0) p0[r] = vis ? p0[r] + bias : NEG_BIG; else p1[r] = vis ? p1[r] + bias : NEG_BIG; } }
            float alpha; bf16x8 pa0, pa1, pa2, pa3;
            const bool resc = softmax_tile(p0, p1, m_reg, l_reg, alpha, pa0, pa1, pa2, pa3);
            if (resc) { if (hi == 0) wsf[r32] = alpha; asm volatile("s_waitcnt lgkmcnt(0)" ::: "memory");
#pragma unroll
                for (int d = 0; d < 4; ++d)
#pragma unroll
                    for (int r = 0; r < 16; ++r) o[d][r] *= wsf[crow(r, hi)]; }
            pv_all(o, vb0 + bf * BUF_BYTES, pa0, pa1, pa2, pa3);
        }
        if (t + 1 < nt) SWA_WRITE(bf ^ 1);
        __syncthreads();
    }
#undef SWA_TILE
#undef SWA_ROW
#undef SWA_LOAD
#undef SWA_WRITE
    if (wave_on) {
        if (hi == 0) wsf[32 + r32] = l_reg; asm volatile("s_waitcnt lgkmcnt(0)" ::: "memory");
        const int orow0 = metaq ? (TREAL + 16 * b) : (b * SEQ + 64 * j + 32 * (wid & 1));
#pragma unroll
        for (int r = 0; r < 16; ++r) { const int rw = crow(r, hi); const float rl = __builtin_amdgcn_rcpf(wsf[32 + rw]);
            if (!metaq || rw < 16) { bf16* op = OAB + (size_t)(orow0 + rw) * 4096 + 2048 + hq * 128 + r32;
#pragma unroll
                for (int d0 = 0; d0 < 4; ++d0) op[d0 * 32] = (bf16)(cvtpk(o[d0][r] * rl, 0.f) & 0xffffu); } }
    }
    __syncthreads();
}
}
namespace att {
constexpr int M2_KSLOT = KN_BYTES + KR_BYTES;
constexpr int M2_OFF_K = 0, M2_OFF_V = 3 * M2_KSLOT;
constexpr int M2_OFF_WS = M2_OFF_V + 3 * V_BYTES;
constexpr int M2_LDS_BYTES = M2_OFF_WS + 8 * 64 * 4;
typedef __attribute__((address_space(3))) unsigned char* lds_ptr;

__device__ __forceinline__ void partialSM(f32x16& p0, f32x16& p1, float& m_reg, float& alpha) {
    float pmax = p0[0];
#pragma unroll
    for (int r = 1; r < 16; ++r) pmax = fmaxf(pmax, p0[r]);
#pragma unroll
    for (int r = 0; r < 16; ++r) pmax = fmaxf(pmax, p1[r]);
    { auto rr = __builtin_amdgcn_permlane32_swap(__float_as_uint(pmax), __float_as_uint(pmax), false, false); pmax = fmaxf(__uint_as_float(rr[0]), __uint_as_float(rr[1])); }
    if (__builtin_expect(__all(pmax - m_reg <= THR2), 1)) { alpha = 1.f; }
    else { const float mn = fmaxf(m_reg, pmax); alpha = __builtin_amdgcn_exp2f(m_reg - mn); m_reg = mn; }
    const float mn = m_reg;
#pragma unroll
    for (int r = 0; r < 16; ++r) p0[r] = __builtin_amdgcn_exp2f(p0[r] - mn);
#pragma unroll
    for (int r = 0; r < 16; ++r) p1[r] = p1[r] - mn;
}
__device__ __forceinline__ void finishSM(f32x16& p0, f32x16& p1, float alpha, float& l_reg, bf16x8& pa0, bf16x8& pa1, bf16x8& pa2, bf16x8& pa3) {
#pragma unroll
    for (int r = 0; r < 16; ++r) p1[r] = __builtin_amdgcn_exp2f(p1[r]);
    float ps = 0.f;
#pragma unroll
    for (int r = 0; r < 16; ++r) ps += p0[r];
#pragma unroll
    for (int r = 0; r < 16; ++r) ps += p1[r];
    { auto rr = __builtin_amdgcn_permlane32_swap(__float_as_uint(ps), __float_as_uint(ps), false, false); ps = __uint_as_float(rr[0]) + __uint_as_float(rr[1]); }
    l_reg = l_reg * alpha + ps;
#define PK4(P, BASE, OUT) do { unsigned a0 = cvtpk(P[BASE + 0], P[BASE + 1]), a1 = cvtpk(P[BASE + 2], P[BASE + 3]);   \
    unsigned b0 = cvtpk(P[BASE + 4], P[BASE + 5]), b1 = cvtpk(P[BASE + 6], P[BASE + 7]);                              \
    auto r0 = __builtin_amdgcn_permlane32_swap(a0, b0, false, false); auto r1 = __builtin_amdgcn_permlane32_swap(a1, b1, false, false); \
    u32x4 w = {r0[0], r1[0], r0[1], r1[1]}; OUT = *reinterpret_cast<bf16x8*>(&w); } while (0)
    PK4(p0, 0, pa0); PK4(p0, 8, pa1); PK4(p1, 0, pa2); PK4(p1, 8, pa3);
#undef PK4
}

__device__ __forceinline__ void mla_unit2(lds_ptr lds, const bf16* __restrict__ Q, const bf16* __restrict__ KN, const bf16* __restrict__ KR, const bf16* __restrict__ V, bf16* __restrict__ OAB, int b, int h, int qb) {
    int tid_ = threadIdx.x; asm volatile("" : "+v"(tid_)); const int tid = tid_, lane = tid & 63, r32 = lane & 31, hi = lane >> 5; const int wid = __builtin_amdgcn_readfirstlane(tid >> 6);
    const bool metaq = (qb == 16);
    const bool wave_on = !metaq || wid == 0;
    const int qrow = metaq ? (TREAL + 16 * b + (r32 & 15)) : (b * SEQ + qb * 256 + wid * 32 + r32);
    __attribute__((address_space(3))) float* wsf = (__attribute__((address_space(3))) float*)(lds + M2_OFF_WS) + wid * 64;
    unsigned so_kn[2], so_kr, so_v[2];
#pragma unroll
    for (int i = 0; i < 2; ++i) { const int P = 2 * wid + i;
        { const int row = 4 * P + (lane >> 4), c = (lane & 15) ^ (row & 15); so_kn[i] = (unsigned)(row * 4096 + c * 16); }
        { const int q = 64 * P + lane, s = q >> 5, kk = (s >> 2) * 8 + ((q & 31) >> 2), col = (s & 3) * 32 + (q & 3) * 8, k = (kk & ~0xC) | ((kk & 4) << 1) | ((kk & 8) >> 1); so_v[i] = (unsigned)(k * 4096 + col * 2); } }
    { const int row = 8 * wid + (lane >> 3), c = (lane & 7) ^ ((row >> 1) & 7); so_kr = (unsigned)(row * 128 + c * 16); }
    const char* const kn_h = (const char*)KN + h * 256; const char* const v_h = (const char*)V + h * 256; const char* const kr_b = (const char*)KR;
#define M2_DMA(src, dstoff) __builtin_amdgcn_global_load_lds((const unsigned*)(src), (__attribute__((address_space(3))) unsigned*)(lds + (dstoff)), 16, 0, 0)
#define M2_DMA_K(grow, slot) do { const size_t g_ = (size_t)(grow); const int so_ = M2_OFF_K + (slot) * M2_KSLOT; \
        M2_DMA(kn_h + g_ * 4096 + so_kn[0], so_ + (2 * wid) * 1024); M2_DMA(kn_h + g_ * 4096 + so_kn[1], so_ + (2 * wid + 1) * 1024); M2_DMA(kr_b + g_ * 128 + so_kr, so_ + KN_BYTES + wid * 1024); } while (0)
#define M2_DMA_V(grow, slot) do { const size_t g_ = (size_t)(grow); const int so_ = M2_OFF_V + (slot) * V_BYTES; \
        M2_DMA(v_h + g_ * 4096 + so_v[0], so_ + (2 * wid) * 1024); M2_DMA(v_h + g_ * 4096 + so_v[1], so_ + (2 * wid + 1) * 1024); } while (0)
#define M2_WAIT(n) asm volatile("s_waitcnt vmcnt(" #n ")" ::: "memory")
#define M2_BAR() do { asm volatile("" ::: "memory"); __builtin_amdgcn_s_barrier(); asm volatile("" ::: "memory"); } while (0)
    const size_t real0 = (size_t)b * SEQ, meta0 = (size_t)TREAL + 16 * b;
    M2_DMA_K(meta0, 2); M2_DMA_V(meta0, 2); M2_DMA_K(real0, 0); M2_DMA_V(real0, 0); M2_DMA_K(real0 + 64, 1);
    bf16x8 qr[12];
    { const bf16* qp = Q + (size_t)qrow * 3072 + h * 192 + hi * 8;
#pragma unroll
      for (int d0 = 0; d0 < 12; ++d0) qr[d0] = *reinterpret_cast<const bf16x8*>(qp + d0 * 16); }
    const int xkn = (r32 & 15) << 4, xkr = ((r32 >> 1) & 7) << 4, hb = hi * 16;
    const int vlane = v_rd_base(lane);
#define M2_QKT(P0, P1, slot) do { int xn_ = xkn, xr_ = xkr; asm volatile("" : "+v"(xn_), "+v"(xr_)); const lds_ptr kb_ = lds + M2_OFF_K + (slot) * M2_KSLOT + r32 * 256; const lds_ptr kr_ = lds + M2_OFF_K + (slot) * M2_KSLOT + KN_BYTES + r32 * 128; P0 = f32x16{}; P1 = f32x16{}; \
        _Pragma("unroll") for (int d0 = 0; d0 < 8; ++d0) { const int of_ = (d0 * 32 + hb) ^ xn_; const bf16x8 b0 = *(const __attribute__((address_space(3))) bf16x8*)(kb_ + of_), b1 = *(const __attribute__((address_space(3))) bf16x8*)(kb_ + of_ + 8192); \
            P0 = __builtin_amdgcn_mfma_f32_32x32x16_bf16(b0, qr[d0], P0, 0, 0, 0); P1 = __builtin_amdgcn_mfma_f32_32x32x16_bf16(b1, qr[d0], P1, 0, 0, 0); } \
        _Pragma("unroll") for (int d0 = 0; d0 < 4; ++d0) { const int of_ = (d0 * 32 + hb) ^ xr_; const bf16x8 b0 = *(const __attribute__((address_space(3))) bf16x8*)(kr_ + of_), b1 = *(const __attribute__((address_space(3))) bf16x8*)(kr_ + of_ + 4096); \
            P0 = __builtin_amdgcn_mfma_f32_32x32x16_bf16(b0, qr[8 + d0], P0, 0, 0, 0); P1 = __builtin_amdgcn_mfma_f32_32x32x16_bf16(b1, qr[8 + d0], P1, 0, 0, 0); } } while (0)
#define M2_PV(slot) pv_all(o, (int)(uintptr_t)(lds + M2_OFF_V + (slot) * V_BYTES) + vlane, pa0, pa1, pa2, pa3)
#define M2_RESC(a) do { if (__any((a) < 1.f)) { if (hi == 0) wsf[r32] = (a); asm volatile("s_waitcnt lgkmcnt(0)" ::: "memory"); \
        _Pragma("unroll") for (int d = 0; d < 4; ++d) _Pragma("unroll") for (int r = 0; r < 16; ++r) o[d][r] *= wsf[crow(r, hi)]; } } while (0)
    float m_reg = NEG_BIG, l_reg = 0.f; f32x16 o[4];
#pragma unroll
    for (int d = 0; d < 4; ++d) o[d] = f32x16{};
    f32x16 pA0, pA1, pB0, pB1; float alA = 1.f, alB = 1.f; bf16x8 pa0, pa1, pa2, pa3;
    M2_WAIT(0); M2_BAR();
    if (wave_on) {
        M2_QKT(pA0, pA1, 2);
#pragma unroll
        for (int r = 0; r < 16; ++r) { if (crow(r, hi) >= 16) pA0[r] = NEG_BIG; pA1[r] = NEG_BIG; }
        partialSM(pA0, pA1, m_reg, alA); finishSM(pA0, pA1, alA, l_reg, pa0, pa1, pa2, pa3);
        M2_PV(2);
    }
    M2_BAR();
    M2_DMA_K(real0 + 128, 2); M2_DMA_V(real0 + 64, 1);
    if (wave_on) { M2_QKT(pA0, pA1, 0); partialSM(pA0, pA1, m_reg, alA); M2_RESC(alA); }
    int ks = 1, vs = 0;
    for (int j = 1; j < 64; j += 2) {
        if (j < 62) M2_WAIT(5); else M2_WAIT(0);
        M2_BAR();
        { const int kn2 = ks == 0 ? 2 : ks - 1;
          const int vn1 = vs == 0 ? 2 : vs - 1;
          if (j + 2 < 64) M2_DMA_K(real0 + (size_t)(j + 2) * 64, kn2);
          if (j + 1 < 64) M2_DMA_V(real0 + (size_t)(j + 1) * 64, vn1); }
        if (wave_on) { SBAR(); M2_QKT(pB0, pB1, ks); finishSM(pA0, pA1, alA, l_reg, pa0, pa1, pa2, pa3); SBAR(); M2_PV(vs); partialSM(pB0, pB1, m_reg, alB); M2_RESC(alB); }
        ks = ks == 2 ? 0 : ks + 1; vs = vs == 2 ? 0 : vs + 1;
        if (j + 1 < 64) {
            if (j + 1 < 62) M2_WAIT(5); else M2_WAIT(0);
            M2_BAR();
            { const int kn2 = ks == 0 ? 2 : ks - 1; const int vn1 = vs == 0 ? 2 : vs - 1;
              if (j + 3 < 64) M2_DMA_K(real0 + (size_t)(j + 3) * 64, kn2);
              if (j + 2 < 64) M2_DMA_V(real0 + (size_t)(j + 2) * 64, vn1); }
            if (wave_on) { SBAR(); M2_QKT(pA0, pA1, ks); finishSM(pB0, pB1, alB, l_reg, pa0, pa1, pa2, pa3); SBAR(); M2_PV(vs); partialSM(pA0, pA1, m_reg, alA); M2_RESC(alA); }
            ks = ks == 2 ? 0 : ks + 1; vs = vs == 2 ? 0 : vs + 1;
        }
    }
    M2_WAIT(0); M2_BAR();
    if (wave_on) {
        finishSM(pB0, pB1, alB, l_reg, pa0, pa1, pa2, pa3); M2_PV(vs);
        if (hi == 0) wsf[32 + r32] = l_reg; asm volatile("s_waitcnt lgkmcnt(0)" ::: "memory");
        const int orow0 = metaq ? (TREAL + 16 * b) : (b * SEQ + qb * 256 + wid * 32);
#pragma unroll
        for (int r = 0; r < 16; ++r) { const int rw = crow(r, hi); const float rl = __builtin_amdgcn_rcpf(wsf[32 + rw]);
            if (!metaq || rw < 16) { bf16* op = OAB + (size_t)(orow0 + rw) * 4096 + h * 128 + r32;
#pragma unroll
                for (int d0 = 0; d0 < 4; ++d0) op[d0 * 32] = (bf16)(cvtpk(o[d0][r] * rl, 0.f) & 0xffffu); } }
    }
    M2_BAR();
#undef M2_DMA
#undef M2_DMA_K
#undef M2_DMA_V
#undef M2_WAIT
#undef M2_BAR
#undef M2_QKT
#undef M2_PV
#undef M2_RESC
}
}
constexpr int NWAVES = 8;
constexpr int N_PHASES = 20;
constexpr size_t MiB = 1u << 20, KiB32 = 32768;
constexpr size_t WS_CTL = 0, CTL_ZERO_BYTES = 65536;
constexpr size_t WS_CS = 1 * MiB, WS_SN = WS_CS + 540672;
constexpr size_t WS_BIAS = 3 * MiB;
constexpr size_t WS_SINK = WS_BIAS + 32768;
constexpr size_t WS_WHIST = WS_BIAS + 65536;
constexpr size_t WS_TOPI = 4 * MiB, WS_TOPG = WS_TOPI + 262144, WS_TOKSLOT = WS_TOPG + 262144;
constexpr size_t WS_SLOTTOK = 5 * MiB, WS_SLOTGATE = WS_SLOTTOK + 294912;
constexpr size_t WS_SSQ = 6 * MiB;
constexpr size_t WS_HB = 9 * MiB;
constexpr size_t WS_W = 138 * MiB;
constexpr size_t WL_IN = 0, WL_UQ = 34 * MiB, WL_UKV = WL_UQ + 9 * MiB / 2, WL_AB = WL_UKV + 4 * MiB, WL_OUT = WL_AB + 16 * MiB, WL_STRIDE = WL_OUT + 8 * MiB;
constexpr size_t WS_WF13 = WS_W + 2 * WL_STRIDE, WS_WF2 = WS_WF13 + 44 * MiB, WS_WEND = WS_WF2 + 22 * MiB;
constexpr size_t AR = 337 * MiB;
constexpr size_t WS_CQ = AR, WS_CKV = WS_CQ + 1548 * KiB32, WS_KR = WS_CKV + 1032 * KiB32, WS_QB = WS_KR + 132 * KiB32;
constexpr size_t WS_KB = WS_QB + 129 * MiB, WS_VB = WS_KB + 1032 * KiB32, WS_GR = WS_VB + 1032 * KiB32, WS_GBB = WS_GR + 129 * MiB;
constexpr size_t WS_Q = WS_GBB + 129 * MiB, WS_KN = WS_Q + 6192 * KiB32  , WS_V = WS_KN + 129 * MiB, WS_OAB = WS_V + 129 * MiB, WS_MIX_END = WS_OAB + 258 * MiB;
constexpr size_t WS_MG = WS_Q;
constexpr size_t WS_X = WS_OAB;
constexpr size_t WS_ACT = AR;
constexpr size_t WS_MW13 = 138 * MiB, WS_MW2 = WS_MW13 + 8 * 44 * MiB;
constexpr size_t WS_MACT = WS_MW2 + 8 * 22 * MiB;
constexpr size_t WS_Y = WS_MACT + 726 * MiB;
constexpr size_t WS_END = WS_Y + 264 * MiB;
static_assert(WS_MIX_END <= 1700 * MiB && WS_END <= 1700 * MiB, "d_ws map");
static_assert(WS_ACT + (size_t)TP * DFF * 2 <= WS_X, "dense ACT vs X");
static_assert(WS_SSQ + (size_t)TP * 20 * 4 <= WS_HB && WS_SLOTGATE + 294912 <= WS_SSQ && WS_TOKSLOT + 262144 <= WS_SLOTTOK && WS_SN + 540672 <= WS_BIAS, "small tables");
static_assert(WS_KR + (size_t)TP * 64 * 2 <= WS_QB, "KR");
constexpr int CW_TMO = 0, CW_CODE = 1;
constexpr int CW_MOE_TS = 64;
constexpr int CW_BAR = 4096;
constexpr int RING_OFF = 0, RING_BYTES = 131072;
constexpr int LDSCTL_OFF = RING_BYTES, MISC_OFF = LDSCTL_OFF + 320, PT_OFF = LDSCTL_OFF + 512;
constexpr int LDS_BYTES = 147456;
static_assert(att::ATT_LDS_BYTES <= RING_BYTES && att::M2_LDS_BYTES <= RING_BYTES, "attention LDS");

#define GAS __attribute__((address_space(1)))
#define LAS __attribute__((address_space(3)))
typedef unsigned short bf16;
typedef unsigned v4u __attribute__((ext_vector_type(4)));
typedef unsigned v2u __attribute__((ext_vector_type(2)));
typedef float f32x4 __attribute__((ext_vector_type(4)));
typedef GAS unsigned gu32;
#define RLX_AGENT __ATOMIC_RELAXED, __HIP_MEMORY_SCOPE_AGENT
#define LDS_WAIT() asm volatile("s_waitcnt lgkmcnt(0)" ::: "memory")
#define VM_WAIT() asm volatile("s_waitcnt vmcnt(0)" ::: "memory")
__device__ __forceinline__ unsigned f2bf(float f) { unsigned u = __builtin_bit_cast(unsigned, f); return (u + 0x7fffu + ((u >> 16) & 1u)) >> 16; }
__device__ __forceinline__ unsigned pk2(float lo, float hi) { return f2bf(lo) | (f2bf(hi) << 16); }

#define XB_TMO      128
#define XB_XCNT(j)  (256  + 64 * (j))
#define XB_XSUB(j)  (1280 + 64 * (j))
#define XB_XGEN(j)  (2304 + 64 * (j))
#define XB_TOP      3328
#define XB_TOPGEN   3392
#define XCD_BAR_WORDS 3456
#define XB_SPIN_CAP (1u << 22)
__device__ __forceinline__ unsigned xb_ld(unsigned* p)              { return __hip_atomic_load(p, __ATOMIC_RELAXED, __HIP_MEMORY_SCOPE_AGENT); }
__device__ __forceinline__ unsigned xb_add(unsigned* p, unsigned v) { return __hip_atomic_fetch_add(p, v, __ATOMIC_RELAXED, __HIP_MEMORY_SCOPE_AGENT); }
__device__ __forceinline__ unsigned xb_xcc_id() { return (unsigned)__builtin_amdgcn_s_getreg((3 << 11) | 20) & 0xFu; }
#define XB_SPIN(cond, bar) do { unsigned _sp = 0; while (cond) { __builtin_amdgcn_s_sleep(1); \
    if ((++_sp & 255u) == 0u) { if (xb_ld(&(bar)[XB_TMO])) break; if (_sp > XB_SPIN_CAP) { atomicAdd(&(bar)[XB_TMO], 1u); break; } } } } while (0)
struct XcdBarrier { unsigned* bar; unsigned x; volatile LAS unsigned* st; };
__device__ __forceinline__ XcdBarrier xcd_barrier_post(unsigned* bar, volatile LAS unsigned* st) {
    XcdBarrier b; b.bar = bar; b.x = xb_xcc_id(); b.st = st;
    if (threadIdx.x == 0) (void)xb_add(&bar[XB_XCNT(b.x)], 1u);
    return b;
}
__device__ __forceinline__ void xcd_barrier_complete(unsigned* bar, unsigned x, unsigned& nloc, unsigned& nx) {
    const unsigned G = gridDim.x * gridDim.y * gridDim.z;
    unsigned sum, cnt, mine, sp = 0u;
    for (;;) {
        sum = 0u; cnt = 0u; mine = 0u;
#pragma unroll
        for (unsigned j = 0; j < 16; ++j) { const unsigned c = xb_ld(&bar[XB_XCNT(j)]); sum += c; cnt += (c > 0u) ? 1u : 0u; mine = (j == x) ? c : mine; }
        if (sum == G) break;
        __builtin_amdgcn_s_sleep(1);
        if ((++sp & 255u) == 0u) { if (xb_ld(&bar[XB_TMO])) break; if (sp > XB_SPIN_CAP) { atomicAdd(&bar[XB_TMO], 1u); break; } }
    }
    nloc = mine > 0u ? mine : 1u; nx = cnt > 0u ? cnt : 1u;
}
__device__ __forceinline__ void xcd_barrier(const XcdBarrier& b) {
    asm volatile("s_waitcnt vmcnt(0)" ::: "memory");
    __syncthreads();
    if (threadIdx.x == 0) {
        unsigned* bar = b.bar;
        __builtin_amdgcn_s_waitcnt(0);
        unsigned nloc = b.st[0], nx = b.st[1];
        if (nloc == 0u) { xcd_barrier_complete(bar, b.x, nloc, nx); b.st[0] = nloc; b.st[1] = nx; }
        const unsigned old = xb_add(&bar[XB_XSUB(b.x)], 1u);
        const unsigned gen = old / nloc;
        if (old + 1u == (gen + 1u) * nloc) {
            __builtin_amdgcn_fence(__ATOMIC_RELEASE, "agent");
            asm volatile("s_waitcnt vmcnt(0)" ::: "memory");
            const unsigned og = xb_add(&bar[XB_TOP], 1u);
            const unsigned tg = og / nx;
            if (og + 1u == (tg + 1u) * nx) xb_add(&bar[XB_TOPGEN], 1u);
            else XB_SPIN(xb_ld(&bar[XB_TOPGEN]) == tg, bar);
            __builtin_amdgcn_fence(__ATOMIC_ACQUIRE, "agent");
            xb_add(&bar[XB_XGEN(b.x)], 1u);
            asm volatile("s_waitcnt vmcnt(0)" ::: "memory");
        } else {
            XB_SPIN(xb_ld(&bar[XB_XGEN(b.x)]) == gen, bar);
            __builtin_amdgcn_fence(__ATOMIC_ACQUIRE, "agent");
            asm volatile("s_waitcnt vmcnt(0)" ::: "memory");
        }
    }
    __syncthreads();
}

__device__ __forceinline__ float wave_sum(float v) {
#pragma unroll
    for (int o = 1; o < 64; o <<= 1) v += __shfl_xor(v, o);
    return v;
}
__device__ __forceinline__ void transpose_item(const float* __restrict__ W, int ldw, int k0, int n0, bf16* __restrict__ WT, size_t ldt, int drow, int koff, const float* __restrict__ g, LAS float* scr, int lane) {
    const int kr = lane >> 3, c4 = (lane & 7) * 4;
    f32x4 v[8];
#pragma unroll
    for (int i = 0; i < 8; ++i) v[i] = *(const GAS f32x4*)(W + (size_t)(k0 + 8 * i + kr) * ldw + n0 + c4);
    if (g) {
#pragma unroll
        for (int i = 0; i < 8; ++i) v[i] = v[i] * g[k0 + 8 * i + kr]; }
#pragma unroll
    for (int i = 0; i < 8; ++i) { LAS float* d = scr + (8 * i + kr) * 33 + c4; d[0] = v[i].x; d[1] = v[i].y; d[2] = v[i].z; d[3] = v[i].w; }
    LDS_WAIT(); asm volatile("" ::: "memory");
    const int c = lane & 7;
#pragma unroll
    for (int j = 0; j < 4; ++j) { const int n = (lane >> 3) + 8 * j; const LAS float* s = scr + (8 * c) * 33 + n;
        v4u o; o.x = pk2(s[0 * 33], s[1 * 33]); o.y = pk2(s[2 * 33], s[3 * 33]); o.z = pk2(s[4 * 33], s[5 * 33]); o.w = pk2(s[6 * 33], s[7 * 33]);
        *(GAS v4u*)(WT + (size_t)(drow + n) * ldt + koff + k0 + 8 * c) = o; }
    LDS_WAIT(); asm volatile("" ::: "memory");
}
__device__ __forceinline__ int dmap_in(int n0) {
    if (n0 < 1280) return n0;
    if (n0 < 1312) return 1280;
    if (n0 < 1344) return 1280 + 128;
    if (n0 < 3392) return 1536 + (n0 - 1344);
    if (n0 < 3904) return 3584 + (n0 - 3392);
    if (n0 < 4416) return 4096 + (n0 - 3904);
    if (n0 < 6464) { const int a = n0 - 4416; return 4608 + 256 * (a >> 7) + (a & 127); }
    const int a = n0 - 6464; return 4608 + 256 * (a >> 7) + 128 + (a & 127);
}
__device__ __forceinline__ int dmap_uq(int n0) {
    const int head = n0 / 192, off = n0 - head * 192;
    if (off < 128) return 256 * (head >> 1) + 128 * (head & 1) + off;
    if (off < 160) return 256 * (8 + (head >> 2)) + 32 * (head & 3);
    return 256 * (8 + (head >> 2)) + 128 + 32 * (head & 3);
}
__device__ __forceinline__ int dmap_glu(int n0) { return 256 * (n0 >> 7) + (n0 & 127); }
struct Row8 { f32x4 v[8]; };
__device__ __forceinline__ void ln_normalize(Row8& r) {
    float s = 0.f;
#pragma unroll
    for (int j = 0; j < 8; ++j) s += (r.v[j].x + r.v[j].y) + (r.v[j].z + r.v[j].w);
    const float mean = wave_sum(s) * (1.f / D); float s2 = 0.f;
#pragma unroll
    for (int j = 0; j < 8; ++j) { r.v[j] = r.v[j] - mean; s2 += (r.v[j].x * r.v[j].x + r.v[j].y * r.v[j].y) + (r.v[j].z * r.v[j].z + r.v[j].w * r.v[j].w); }
    const float rstd = 1.f / sqrtf(wave_sum(s2) * (1.f / D) + LN_EPS);
#pragma unroll
    for (int j = 0; j < 8; ++j) r.v[j] = r.v[j] * rstd;
}
__device__ __forceinline__ void ln_affine(Row8& r, const float* __restrict__ g, const float* __restrict__ b, int lane) {
#pragma unroll
    for (int j = 0; j < 8; ++j) { const f32x4 gg = *((const f32x4*)g + lane + 64 * j), bb = *((const f32x4*)b + lane + 64 * j); r.v[j] = r.v[j] * gg + bb; }
}
__device__ __forceinline__ void row_store_bf16(const Row8& r, bf16* orow, int lane) {
    GAS v2u* o8 = (GAS v2u*)orow + lane;
#pragma unroll
    for (int j = 0; j < 8; ++j) { v2u w; w.x = pk2(r.v[j].x, r.v[j].y); w.y = pk2(r.v[j].z, r.v[j].w); o8[64 * j] = w; }
}
__device__ __forceinline__ void row_load_f32(Row8& r, const float* xrow, int lane) {
#pragma unroll
    for (int j = 0; j < 8; ++j) r.v[j] = *((const GAS f32x4*)xrow + lane + 64 * j);
}
__device__ __forceinline__ f32x4 bf4(v2u w) { return (f32x4){__uint_as_float(w.x << 16), __uint_as_float(w.x & 0xffff0000u), __uint_as_float(w.y << 16), __uint_as_float(w.y & 0xffff0000u)}; }
__device__ __forceinline__ int t5_bucket(int rel) {
    const int n = rel < 0 ? -rel : rel; int v;
    if (n < 8) v = n; else if (n < 12) v = 8; else if (n < 16) v = 9; else if (n < 23) v = 10; else if (n < 32) v = 11; else if (n < 46) v = 12; else if (n < 64) v = 13; else if (n < 91) v = 14; else v = 15;
    return (rel > 0 ? 16 : 0) + v;
}
enum { I_X = 0, I_META, I_EMB_G, I_EMB_B, I_RELB, I_WIN, I_QNG, I_KVNG, I_WUQ, I_WUKV, I_SINK, I_WPA, I_WPB, I_WOUT, I_LMG, I_LMB, I_LFG, I_LFB,
       I_FW1, I_FW3, I_FW2, I_RW, I_RB, I_MW1, I_MW3, I_MW2, N_IN };
struct Args { const float* in[N_IN]; float* out; unsigned char* ws; int ph_lo, ph_hi; };

__global__ void __launch_bounds__(NWAVES * 64, 2) mk_fwd(Args args) {
    extern __shared__ __attribute__((aligned(16))) unsigned char lds_raw[];
    LAS unsigned char* const lds = (LAS unsigned char*)lds_raw;
    char* const ldsg = (char*)lds_raw;
    volatile LAS unsigned* const MISC = (volatile LAS unsigned*)(lds + MISC_OFF);
    const int tid_k = threadIdx.x; const int tid = tid_k, lane = tid & 63, wave = __builtin_amdgcn_readfirstlane(tid >> 6);
    const int G_k = gridDim.x; const int bx_k = blockIdx.x;
    for (int u = tid; u < (LDS_BYTES - LDSCTL_OFF) / 4; u += NWAVES * 64) ((LAS unsigned*)(lds + LDSCTL_OFF))[u] = 0u;
    __syncthreads();
    volatile LAS unsigned long long* const PT = (volatile LAS unsigned long long*)(lds + PT_OFF);
    if (tid == 0) {
#pragma unroll
        for (int i = 0; i < N_IN; ++i) PT[i] = (unsigned long long)args.in[i];
        PT[N_IN] = (unsigned long long)args.out; PT[N_IN + 1] = (unsigned long long)args.ws; }
    const int lo = args.ph_lo, hi = args.ph_hi;
    __syncthreads();
#define LDP(i) ({ const unsigned long long v_ = PT[i]; (unsigned long long)(unsigned)__builtin_amdgcn_readfirstlane((int)(unsigned)v_) | ((unsigned long long)(unsigned)__builtin_amdgcn_readfirstlane((int)(unsigned)(v_ >> 32)) << 32); })
#define INP(i) ((const float*)(const GAS float*)LDP(i))
#define WSP() ((unsigned char*)(GAS unsigned char*)LDP(N_IN + 1))
#define OUTP() ((float*)(GAS float*)LDP(N_IN))
#define PH_WS() asm volatile("" ::: "memory"); int tid = tid_k; asm volatile("" : "+v"(tid)); const int lane = tid & 63; (void)lane; \
    int G = G_k, bx = bx_k; asm volatile("" : "+s"(G), "+s"(bx));     \
    const int vcu = (G % 8 == 0) ? (bx % 8) * (G / 8) + bx / 8 : bx; const int gw = vcu * NWAVES + wave, NGW = G * NWAVES; (void)gw; (void)NGW; (void)vcu; unsigned char* const ws = WSP(); \
    bf16* const HB = (bf16*)(ws + WS_HB); float* const CS = (float*)(ws + WS_CS); float* const SN = (float*)(ws + WS_SN); float* const SSQ = (float*)(ws + WS_SSQ); float* const X = (float*)(ws + WS_X); \
    (void)HB; (void)CS; (void)SN; (void)SSQ; (void)X
    XcdBarrier bar; { unsigned char* const ws0 = WSP(); bar.bar = (unsigned*)(ws0 + WS_CTL) + CW_BAR; bar.x = 0; bar.st = nullptr;
    if (hi - lo > 1) bar = xcd_barrier_post((unsigned*)(ws0 + WS_CTL) + CW_BAR, MISC + 8); }
#ifndef PHMASK
#define PHMASK 0xFFFF
#endif
#define KEN(kind) ((PHMASK >> (kind)) & 1)
#ifndef REPMASK
#define REPMASK 0
#endif
#define NREP(kind) (((REPMASK >> (kind)) & 1) ? 2 : 1)
#define IN(k) (lo <= (k) && (k) < hi)
#define SEAM(k) do { if (IN(k) && IN((k) + 1)) xcd_barrier(bar); } while (0)

    for (int rep_ = 0; rep_ < NREP(0); ++rep_) if (KEN(0) && IN(0)) { PH_WS(); int* const SLOT_TOK = (int*)(ws + WS_SLOTTOK); float* const SLOT_GATE = (float*)(ws + WS_SLOTGATE); int* const TOK_SLOT = (int*)(ws + WS_TOKSLOT); (void)SLOT_TOK; (void)SLOT_GATE; (void)TOK_SLOT;
        LAS float* scr = (LAS float*)(lds + RING_OFF + wave * 16384);
        constexpr int I_IN = (D / 64) * (INDIM / 32), I_UQ = (QRANK / 64) * (3072 / 32), I_UKV = (KVRANK / 64) * (4096 / 32), I_SQ = (D / 64) * (D / 32), I_LAYER = I_IN + I_UQ + I_UKV + 3 * I_SQ;
        constexpr int I_F = (D / 64) * (DFF / 32), I_F2 = (DFF / 64) * (D / 32), NITEMS = 2 * I_LAYER + 2 * I_F + I_F2;
        for (int it = gw; it < NITEMS; it += NGW) {
            int r = it;
            if (r < 2 * I_LAYER) { const int l = r / I_LAYER; r -= l * I_LAYER; unsigned char* wl = ws + WS_W + l * WL_STRIDE;
                if (r < I_IN) { const int nblk = INDIM / 32, kb = r / nblk, nb = r % nblk; transpose_item(INP(I_WIN) + (size_t)l * D * INDIM, INDIM, 64 * kb, 32 * nb, (bf16*)(ws + WS_W + l * WL_STRIDE + WL_IN), D, dmap_in(32 * nb), 0, nullptr, scr, lane); continue; } r -= I_IN;
                if (r < I_UQ) { const int nblk = 3072 / 32, kb = r / nblk, nb = r % nblk; transpose_item(INP(I_WUQ) + (size_t)l * QRANK * 3072, 3072, 64 * kb, 32 * nb, (bf16*)(ws + WS_W + l * WL_STRIDE + WL_UQ), QRANK, dmap_uq(32 * nb), 0, INP(I_QNG) + l * QRANK, scr, lane); continue; } r -= I_UQ;
                if (r < I_UKV) { const int nblk = 4096 / 32, kb = r / nblk, nb = r % nblk; transpose_item(INP(I_WUKV) + (size_t)l * KVRANK * 4096, 4096, 64 * kb, 32 * nb, (bf16*)(ws + WS_W + l * WL_STRIDE + WL_UKV), KVRANK, 32 * nb, 0, INP(I_KVNG) + l * KVRANK, scr, lane); continue; } r -= I_UKV;
                { const int which = r / I_SQ; r -= which * I_SQ; const int nblk = D / 32, kb = r / nblk, nb = r % nblk;
                  if (which == 0) transpose_item(INP(I_WPA) + (size_t)l * D * D, D, 64 * kb, 32 * nb, (bf16*)(ws + WS_W + l * WL_STRIDE + WL_AB), 2 * D, 32 * nb, 0, nullptr, scr, lane);
                  else if (which == 1) transpose_item(INP(I_WPB) + (size_t)l * D * D, D, 64 * kb, 32 * nb, (bf16*)(ws + WS_W + l * WL_STRIDE + WL_AB), 2 * D, 32 * nb, D, nullptr, scr, lane);
                  else transpose_item(INP(I_WOUT) + (size_t)l * D * D, D, 64 * kb, 32 * nb, (bf16*)(ws + WS_W + l * WL_STRIDE + WL_OUT), D, 32 * nb, 0, nullptr, scr, lane);
                  continue; }
            }
            r -= 2 * I_LAYER;
            if (r < 2 * I_F) { const int which = r / I_F; r -= which * I_F; const int nblk = DFF / 32, kb = r / nblk, nb = r % nblk;
                transpose_item(INP(which ? I_FW3 : I_FW1), DFF, 64 * kb, 32 * nb, (bf16*)(ws + WS_WF13), D, dmap_glu(32 * nb) + (which ? 128 : 0), 0, nullptr, scr, lane); continue; }
            r -= 2 * I_F;
            { const int nblk = D / 32, kb = r / nblk, nb = r % nblk; transpose_item(INP(I_FW2), D, 64 * kb, 32 * nb, (bf16*)(ws + WS_WF2), DFF, 32 * nb, 0, nullptr, scr, lane); }
        }
        for (int i = gw * 64 + lane; i < 2 * 192 * 256; i += NGW * 64) { const int l = i / (192 * 256), q = i % (192 * 256), rr = q / 256, c16 = q % 256; const int row = rr < 96 ? 1312 + rr : 1440 + (rr - 96);
            *(GAS v4u*)(ws + WS_W + l * WL_STRIDE + WL_IN + (size_t)row * (D * 2) + c16 * 16) = (v4u){0u, 0u, 0u, 0u}; }
        for (int i = gw * 64 + lane; i < LPOS * 32; i += NGW * 64) { const int pos = i >> 5, k = i & 31; const float inv = powf(10000.f, -(float)(2 * k) / 64.f); const float ang = (float)pos * inv; CS[i] = cosf(ang); SN[i] = sinf(ang); }
        for (int i = gw * 64 + lane; i < 16 * 257; i += NGW * 64) { const int hh = i / 257, rel = i % 257 - 128; ((float*)(ws + WS_BIAS))[i] = INP(I_RELB)[t5_bucket(rel) * 16 + hh] * LOG2E; }
        if (gw == 0 && lane < 32) ((float*)(ws + WS_SINK))[lane] = INP(I_SINK)[lane] * LOG2E;
        for (int m = gw; m < TP; m += NGW) {
            if (m < T) { Row8 r; row_load_f32(r, m < TREAL ? INP(I_X) + (size_t)m * D : INP(I_META) + (size_t)((m - TREAL) & 15) * D, lane);
                ln_normalize(r); ln_affine(r, INP(I_EMB_G), INP(I_EMB_B), lane); row_store_bf16(r, HB + (size_t)m * D, lane); }
            else { GAS v2u* o8 = (GAS v2u*)(HB + (size_t)m * D) + lane;
#pragma unroll
                for (int j = 0; j < 8; ++j) o8[64 * j] = (v2u){0u, 0u}; }
        }
    }
    SEAM(0);

#pragma unroll 1
    for (int l = 0; l < 2; ++l) {
        const int P = 1 + 9 * l + (l ? 0 : 0);
        const int nM_all = TP / 256;
        const int nM_post = l == 0 ? TP / 256 : TREAL / 256;
        for (int rep_ = 0; rep_ < NREP(1); ++rep_) if (KEN(1) && IN(P + 0)) { PH_WS(); int* const SLOT_TOK = (int*)(ws + WS_SLOTTOK); float* const SLOT_GATE = (float*)(ws + WS_SLOTGATE); int* const TOK_SLOT = (int*)(ws + WS_TOKSLOT); (void)SLOT_TOK; (void)SLOT_GATE; (void)TOK_SLOT;
            ProbDense pr; pr.so.init(nM_all, NIN / 256, G, bx); pr.A = (const char*)HB; pr.Bt = (const char*)(ws + WS_W + l * WL_STRIDE + WL_IN); pr.tstep = 256 * (size_t)D * 2;
            epi::EpiWin E{(bf16*)(ws + WS_CQ), (bf16*)(ws + WS_CKV), (bf16*)(ws + WS_KR), (bf16*)(ws + WS_QB), (bf16*)(ws + WS_KB), (bf16*)(ws + WS_VB), (bf16*)(ws + WS_GR), (bf16*)(ws + WS_GBB), SSQ, CS, SN};
            pg8::gemm_phase<epi::EpiWin, ProbDense>(lds + RING_OFF, D, pr, E);
        }
        SEAM(P + 0);
        for (int rep_ = 0; rep_ < NREP(2); ++rep_) if (KEN(2) && IN(P + 1)) { PH_WS(); int* const SLOT_TOK = (int*)(ws + WS_SLOTTOK); float* const SLOT_GATE = (float*)(ws + WS_SLOTGATE); int* const TOK_SLOT = (int*)(ws + WS_TOKSLOT); (void)SLOT_TOK; (void)SLOT_GATE; (void)TOK_SLOT;
            { ProbDense pr; pr.so.init(nM_all, 3072 / 256, G, bx); pr.A = (const char*)(ws + WS_CQ); pr.Bt = (const char*)(ws + WS_W + l * WL_STRIDE + WL_UQ); pr.tstep = 256 * (size_t)QRANK * 2;
              epi::EpiUq E{(bf16*)(ws + WS_Q), SSQ, CS, SN};
              pg8::gemm_phase<epi::EpiUq, ProbDense>(lds + RING_OFF, QRANK, pr, E); }
            { ProbDense pr; pr.so.init(nM_all, 4096 / 256, G, bx); pr.A = (const char*)(ws + WS_CKV); pr.Bt = (const char*)(ws + WS_W + l * WL_STRIDE + WL_UKV); pr.tstep = 256 * (size_t)KVRANK * 2;
              epi::EpiUkv E{(bf16*)(ws + WS_KN), (bf16*)(ws + WS_V), SSQ};
              pg8::gemm_phase<epi::EpiUkv, ProbDense>(lds + RING_OFF, KVRANK, pr, E); }
        }
        SEAM(P + 1);
        for (int rep_ = 0; rep_ < NREP(3); ++rep_) if (KEN(3) && IN(P + 2)) { PH_WS(); int* const SLOT_TOK = (int*)(ws + WS_SLOTTOK); float* const SLOT_GATE = (float*)(ws + WS_SLOTGATE); int* const TOK_SLOT = (int*)(ws + WS_TOKSLOT); (void)SLOT_TOK; (void)SLOT_GATE; (void)TOK_SLOT;
            const int nqb = l == 0 ? 17 : 16, nmla_full = NB * NH * 16, nmla = NB * NH * nqb;
            for (int rep2_ = 0; rep2_ < NREP(14); ++rep2_)
            for (int u = vcu; u < nmla; u += G) {
                int b, h, qb;
                if (u < nmla_full) { qb = u & 15; h = (u >> 4) & 15; b = u >> 8; } else { const int v = u - nmla_full; qb = 16; h = v & 15; b = v >> 4; }
                att::mla_unit2((att::lds_ptr)(lds + RING_OFF), (const bf16*)(ws + WS_Q), (const bf16*)(ws + WS_KN), (const bf16*)(ws + WS_KR), (const bf16*)(ws + WS_V), (bf16*)(ws + WS_OAB), b, h, qb);
            }
            const int nj = l == 0 ? 65 : 64, nswa_full = NB * 4 * 64, nswa = NB * 4 * nj;
            for (int rep2_ = 0; rep2_ < NREP(15); ++rep2_)
            for (int u = vcu; u < nswa; u += G) {
                int b, hk, j;
                if (u < nswa_full) { j = u & 63; hk = (u >> 6) & 3; b = u >> 8; } else { const int v = u - nswa_full; j = 64; hk = v & 3; b = v >> 2; }
                att::swa_unit(ldsg + RING_OFF, (const bf16*)(ws + WS_QB), (const bf16*)(ws + WS_KB), (const bf16*)(ws + WS_VB), (bf16*)(ws + WS_OAB), (const float*)(ws + WS_BIAS), (const float*)(ws + WS_SINK) + 16 * l, b, hk, j);
            }
        }
        SEAM(P + 2);
        for (int rep_ = 0; rep_ < NREP(4); ++rep_) if (KEN(4) && IN(P + 3)) { PH_WS(); int* const SLOT_TOK = (int*)(ws + WS_SLOTTOK); float* const SLOT_GATE = (float*)(ws + WS_SLOTGATE); int* const TOK_SLOT = (int*)(ws + WS_TOKSLOT); (void)SLOT_TOK; (void)SLOT_GATE; (void)TOK_SLOT;
            ProbDense pr; pr.so.init(nM_post, D / 256, G, bx); pr.A = (const char*)(ws + WS_OAB); pr.Bt = (const char*)(ws + WS_W + l * WL_STRIDE + WL_AB); pr.tstep = 256 * (size_t)(2 * D) * 2;
            epi::EpiProj E{(bf16*)(ws + WS_MG), (const bf16*)(ws + WS_GR), (const bf16*)(ws + WS_GBB)};
            pg8::gemm_phase<epi::EpiProj, ProbDense>(lds + RING_OFF, 2 * D, pr, E);
        }
        SEAM(P + 3);
        for (int rep_ = 0; rep_ < NREP(5); ++rep_) if (KEN(5) && IN(P + 4)) { PH_WS(); int* const SLOT_TOK = (int*)(ws + WS_SLOTTOK); float* const SLOT_GATE = (float*)(ws + WS_SLOTGATE); int* const TOK_SLOT = (int*)(ws + WS_TOKSLOT); (void)SLOT_TOK; (void)SLOT_GATE; (void)TOK_SLOT;
            ProbDense pr; pr.so.init(nM_post, D / 256, G, bx); pr.A = (const char*)(ws + WS_MG); pr.Bt = (const char*)(ws + WS_W + l * WL_STRIDE + WL_OUT); pr.tstep = 256 * (size_t)D * 2;
            epi::EpiResid E{X, HB};
            pg8::gemm_phase<epi::EpiResid, ProbDense>(lds + RING_OFF, D, pr, E);
        }
        SEAM(P + 4);
        for (int rep_ = 0; rep_ < NREP(6); ++rep_) if (KEN(6) && IN(P + 5)) { PH_WS(); int* const SLOT_TOK = (int*)(ws + WS_SLOTTOK); float* const SLOT_GATE = (float*)(ws + WS_SLOTGATE); int* const TOK_SLOT = (int*)(ws + WS_TOKSLOT); (void)SLOT_TOK; (void)SLOT_GATE; (void)TOK_SLOT;
            const float* g = INP(I_LMG) + l * D; const float* bta = INP(I_LMB) + l * D;
            const int nrows = l == 0 ? T : TREAL;
            int h0 = 0, h1 = 0, h2 = 0, h3 = 0, h4 = 0, h5 = 0, h6 = 0, h7 = 0;
            LAS f32x4* const rwl = (LAS f32x4*)(lds + RING_OFF);
            if (l == 1) { const GAS f32x4* rwg = (const GAS f32x4*)INP(I_RW); for (int i = tid; i < D * 2; i += NWAVES * 64) { const int k = i >> 1, hf = i & 1; rwl[hf * 2048 + ((k >> 8) * 4 + (k & 3)) * 64 + ((k >> 2) & 63)] = rwg[i]; } __syncthreads(); }
            for (int m = gw; m < nrows; m += NGW) {
                Row8 r; row_load_f32(r, X + (size_t)m * D, lane); ln_normalize(r); ln_affine(r, g, bta, lane); row_store_bf16(r, HB + (size_t)m * D, lane);
                if (l == 1) {
                    float lg[8];
#pragma unroll
                    for (int e = 0; e < 8; ++e) lg[e] = 0.f;
#pragma unroll
                    for (int j = 0; j < 8; ++j) {
#pragma unroll
                        for (int q = 0; q < 4; ++q) { const f32x4 w0 = rwl[(j * 4 + q) * 64 + lane], w1 = rwl[2048 + (j * 4 + q) * 64 + lane]; const float y = r.v[j][q];
                            lg[0] += y * w0.x; lg[1] += y * w0.y; lg[2] += y * w0.z; lg[3] += y * w0.w; lg[4] += y * w1.x; lg[5] += y * w1.y; lg[6] += y * w1.z; lg[7] += y * w1.w; } }
#pragma unroll
                    for (int e = 0; e < 8; ++e) lg[e] = wave_sum(lg[e]) + INP(I_RB)[e];
                    int i0 = 0; float v0 = lg[0];
#pragma unroll
                    for (int e = 1; e < 8; ++e) if (lg[e] > v0) { v0 = lg[e]; i0 = e; }
                    int i1 = -1; float v1 = -3.0e38f;
#pragma unroll
                    for (int e = 0; e < 8; ++e) if (e != i0 && lg[e] > v1) { v1 = lg[e]; i1 = e; }
                    const float e1 = __expf(v1 - v0), g0 = 1.f / (1.f + e1), g1 = e1 / (1.f + e1);
                    if (lane == 0) { int* ti = (int*)(ws + WS_TOPI); float* tg = (float*)(ws + WS_TOPG); ti[2 * m] = i0; ti[2 * m + 1] = i1; tg[2 * m] = g0; tg[2 * m + 1] = g1; }
                    h0 += (i0 == 0) + (i1 == 0); h1 += (i0 == 1) + (i1 == 1); h2 += (i0 == 2) + (i1 == 2); h3 += (i0 == 3) + (i1 == 3);
                    h4 += (i0 == 4) + (i1 == 4); h5 += (i0 == 5) + (i1 == 5); h6 += (i0 == 6) + (i1 == 6); h7 += (i0 == 7) + (i1 == 7);
                }
            }
            if (l == 1 && lane == 0) { int* wh = (int*)(ws + WS_WHIST) + gw * 8; wh[0] = h0; wh[1] = h1; wh[2] = h2; wh[3] = h3; wh[4] = h4; wh[5] = h5; wh[6] = h6; wh[7] = h7; }
        }
        SEAM(P + 5);
        if (l == 0) {
            for (int rep_ = 0; rep_ < NREP(7); ++rep_) if (KEN(7) && IN(P + 6)) { PH_WS(); int* const SLOT_TOK = (int*)(ws + WS_SLOTTOK); float* const SLOT_GATE = (float*)(ws + WS_SLOTGATE); int* const TOK_SLOT = (int*)(ws + WS_TOKSLOT); (void)SLOT_TOK; (void)SLOT_GATE; (void)TOK_SLOT;
                ProbDense pr; pr.so.init(nM_all, 2 * DFF / 256, G, bx); pr.A = (const char*)HB; pr.Bt = (const char*)(ws + WS_WF13); pr.tstep = 256 * (size_t)D * 2;
                epi::EpiSwiglu E{(bf16*)(ws + WS_ACT)};
                pg8::gemm_phase<epi::EpiSwiglu, ProbDense>(lds + RING_OFF, D, pr, E);
            }
            SEAM(P + 6);
            for (int rep_ = 0; rep_ < NREP(8); ++rep_) if (KEN(8) && IN(P + 7)) { PH_WS(); int* const SLOT_TOK = (int*)(ws + WS_SLOTTOK); float* const SLOT_GATE = (float*)(ws + WS_SLOTGATE); int* const TOK_SLOT = (int*)(ws + WS_TOKSLOT); (void)SLOT_TOK; (void)SLOT_GATE; (void)TOK_SLOT;
                ProbDense pr; pr.so.init(nM_all, D / 256, G, bx); pr.A = (const char*)(ws + WS_ACT); pr.Bt = (const char*)(ws + WS_WF2); pr.tstep = 256 * (size_t)DFF * 2;
                epi::EpiResid E{X, HB};
                pg8::gemm_phase<epi::EpiResid, ProbDense>(lds + RING_OFF, DFF, pr, E);
            }
            SEAM(P + 7);
            for (int rep_ = 0; rep_ < NREP(9); ++rep_) if (KEN(9) && IN(P + 8)) { PH_WS(); int* const SLOT_TOK = (int*)(ws + WS_SLOTTOK); float* const SLOT_GATE = (float*)(ws + WS_SLOTGATE); int* const TOK_SLOT = (int*)(ws + WS_TOKSLOT); (void)SLOT_TOK; (void)SLOT_GATE; (void)TOK_SLOT;
                const float* g = INP(I_LFG); const float* bta = INP(I_LFB);
                for (int m = gw; m < T; m += NGW) { Row8 r; row_load_f32(r, X + (size_t)m * D, lane); ln_normalize(r); ln_affine(r, g, bta, lane); row_store_bf16(r, HB + (size_t)m * D, lane); }
            }
            SEAM(P + 8);
        } else {
            for (int rep_ = 0; rep_ < NREP(10); ++rep_) if (KEN(10) && IN(P + 6)) { PH_WS(); int* const SLOT_TOK = (int*)(ws + WS_SLOTTOK); float* const SLOT_GATE = (float*)(ws + WS_SLOTGATE); int* const TOK_SLOT = (int*)(ws + WS_TOKSLOT); (void)SLOT_TOK; (void)SLOT_GATE; (void)TOK_SLOT;
                LAS int* hist = (LAS int*)(lds + RING_OFF);
                LAS int* segsum = hist + 2048 * 8;
                LAS int* segpre = segsum + 64 * 8;
                LAS int* tot = segpre + 64 * 8;
                const int* wh = (const int*)(ws + WS_WHIST);
                for (int i = tid; i < NGW * 8; i += NWAVES * 64) hist[i] = wh[i];
                __syncthreads();
                { const int e = tid & 7, seg = tid >> 3; int s = 0;
_Pragma("unroll 1")
                  for (int w = 0; w < 32; ++w) { const int ww = seg * 32 + w; if (ww < NGW) s += hist[ww * 8 + e]; } segsum[seg * 8 + e] = s; }
                __syncthreads();
                if (tid < 8) { int run = 0;
_Pragma("unroll 1")
                    for (int s = 0; s < 64; ++s) { segpre[s * 8 + tid] = run; run += segsum[s * 8 + tid]; } tot[tid] = run; }
                __syncthreads();
                if (tid == 0) { int ts = 0; for (int e = 0; e < 8; ++e) { tot[8 + e] = ts; ts += (tot[e] + 255) >> 8; } tot[16] = ts;
                    if (bx == 0) for (int e = 0; e < 9; ++e) ((int*)(ws + WS_CTL))[CW_MOE_TS + e] = tot[8 + e]; }
                __syncthreads();
                int base = 0;
                if (lane < 8) { base = tot[8 + lane] * 256 + segpre[(gw >> 5) * 8 + lane];
_Pragma("unroll 1")
                    for (int w = (gw & ~31); w < gw; ++w) base += hist[w * 8 + lane]; }
                const int* ti = (const int*)(ws + WS_TOPI); const float* tg = (const float*)(ws + WS_TOPG);
                for (int m = gw; m < TREAL; m += NGW) {
#pragma unroll
                    for (int k = 0; k < 2; ++k) { const int e = __builtin_amdgcn_readfirstlane(ti[2 * m + k]); const float gt = tg[2 * m + k];
                        const int slot = __builtin_amdgcn_readlane(base, e); if (lane == e) base += 1;
                        if (lane == 0) { SLOT_TOK[slot] = m; SLOT_GATE[slot] = gt; TOK_SLOT[2 * m + k] = slot; } }
                }
                if (vcu < 8) { const int e = vcu; const int s0 = tot[8 + e] * 256 + tot[e], s1 = tot[8 + e + 1] * 256; for (int s = s0 + tid; s < s1; s += NWAVES * 64) { SLOT_TOK[s] = T; SLOT_GATE[s] = 0.f; } }
                __syncthreads();
                LAS float* scr = (LAS float*)(lds + RING_OFF + wave * 16384);
                constexpr int I_F = (D / 64) * (DFF / 32), I_F2 = (DFF / 64) * (D / 32), I_E = 2 * I_F + I_F2;
                for (int it = gw; it < NE * I_E; it += NGW) {
                    const int e = it / I_E; int r = it - e * I_E;
                    if (r < 2 * I_F) { const int which = r / I_F; r -= which * I_F; const int nblk = DFF / 32, kb = r / nblk, nb = r % nblk;
                        transpose_item(INP(which ? I_MW3 : I_MW1) + (size_t)e * D * DFF, DFF, 64 * kb, 32 * nb, (bf16*)(ws + WS_MW13) + (size_t)e * 2 * DFF * D, D, dmap_glu(32 * nb) + (which ? 128 : 0), 0, nullptr, scr, lane); continue; }
                    r -= 2 * I_F;
                    { const int nblk = D / 32, kb = r / nblk, nb = r % nblk; transpose_item(INP(I_MW2) + (size_t)e * DFF * D, D, 64 * kb, 32 * nb, (bf16*)(ws + WS_MW2) + (size_t)e * D * DFF, DFF, 32 * nb, 0, nullptr, scr, lane); }
                }
            }
            SEAM(P + 6);
            MoeTiles mt;
            if (IN(P + 7) || IN(P + 8)) { unsigned char* const ws = WSP();
#pragma unroll
                for (int e = 0; e < 9; ++e) mt.ts[e] = __builtin_amdgcn_readfirstlane(((const int*)(ws + WS_CTL))[CW_MOE_TS + e]);
            } else {
#pragma unroll
                for (int e = 0; e < 9; ++e) mt.ts[e] = 0;
            }
            for (int rep_ = 0; rep_ < NREP(11); ++rep_) if (KEN(11) && IN(P + 7)) { PH_WS(); int* const SLOT_TOK = (int*)(ws + WS_SLOTTOK); float* const SLOT_GATE = (float*)(ws + WS_SLOTGATE); int* const TOK_SLOT = (int*)(ws + WS_TOKSLOT); (void)SLOT_TOK; (void)SLOT_GATE; (void)TOK_SLOT;
                ProbMoe1 pr; pr.so.init(mt.ts[8], 2 * DFF / 256, G, bx); pr.HBp = (const char*)HB; pr.slot_tok = SLOT_TOK; pr.W = (const char*)(ws + WS_MW13); pr.mt = mt;
                epi::EpiSwiglu E{(bf16*)(ws + WS_MACT)};
                pg8::gemm_phase<epi::EpiSwiglu, ProbMoe1, true>(lds + RING_OFF, D, pr, E);
            }
            SEAM(P + 7);
            for (int rep_ = 0; rep_ < NREP(12); ++rep_) if (KEN(12) && IN(P + 8)) { PH_WS(); int* const SLOT_TOK = (int*)(ws + WS_SLOTTOK); float* const SLOT_GATE = (float*)(ws + WS_SLOTGATE); int* const TOK_SLOT = (int*)(ws + WS_TOKSLOT); (void)SLOT_TOK; (void)SLOT_GATE; (void)TOK_SLOT;
                ProbMoe2 pr; pr.so.init(mt.ts[8], D / 256, G, bx); pr.ACTp = (const char*)(ws + WS_MACT); pr.W = (const char*)(ws + WS_MW2); pr.mt = mt;
                epi::EpiMoeDown E{(bf16*)(ws + WS_Y), SLOT_GATE};
                pg8::gemm_phase<epi::EpiMoeDown, ProbMoe2>(lds + RING_OFF, DFF, pr, E);
            }
            SEAM(P + 8);
            for (int rep_ = 0; rep_ < NREP(13); ++rep_) if (KEN(13) && IN(P + 9)) { PH_WS(); int* const SLOT_TOK = (int*)(ws + WS_SLOTTOK); float* const SLOT_GATE = (float*)(ws + WS_SLOTGATE); int* const TOK_SLOT = (int*)(ws + WS_TOKSLOT); (void)SLOT_TOK; (void)SLOT_GATE; (void)TOK_SLOT;
                const float* g = INP(I_LFG) + D; const float* bta = INP(I_LFB) + D; const bf16* Y = (const bf16*)(ws + WS_Y);
                for (int m = gw; m < TREAL; m += NGW) {
                    const int s0 = TOK_SLOT[2 * m], s1 = TOK_SLOT[2 * m + 1]; Row8 r;
#pragma unroll
                    for (int j = 0; j < 8; ++j) { const v2u hw = *((const GAS v2u*)(HB + (size_t)m * D) + lane + 64 * j), y0 = *((const GAS v2u*)(Y + (size_t)s0 * D) + lane + 64 * j), y1 = *((const GAS v2u*)(Y + (size_t)s1 * D) + lane + 64 * j);
                        r.v[j] = (bf4(hw) * ALPHA + bf4(y0)) + bf4(y1); }
                    ln_normalize(r); ln_affine(r, g, bta, lane);
                    GAS f32x4* o = (GAS f32x4*)(OUTP() + (size_t)m * D) + lane;
#pragma unroll
                    for (int j = 0; j < 8; ++j) o[64 * j] = r.v[j];
                }
            }
        }
    }
#undef IN
#undef SEAM
}

#ifndef MK_ONE_LAUNCH
#define MK_ONE_LAUNCH 0
#endif
extern "C" void kernel_launch(void* const* d_in, const int* in_sizes, int n_in, void* d_out, int out_size, void* d_ws, size_t ws_size, hipStream_t stream) {
    static int grid = 0;
    if (grid == 0) {
        if (n_in != N_IN || in_sizes[0] != NB * SEQ * D || out_size != NB * SEQ * D || ws_size < WS_END) { fprintf(stderr, "kernel_launch: shape mismatch: n_in %d in0 %d out %d ws %zu (need %zu)\n", n_in, n_in > 0 ? in_sizes[0] : -1, out_size, ws_size, (size_t)WS_END); grid = -1; return; }
        int dev = 0, cus = 0, per_cu = 0;
        if (hipGetDevice(&dev) != hipSuccess || hipDeviceGetAttribute(&cus, hipDeviceAttributeMultiprocessorCount, dev) != hipSuccess) { fprintf(stderr, "kernel_launch: device query failed\n"); grid = -1; return; }
        if (hipFuncSetAttribute((const void*)mk_fwd, hipFuncAttributeMaxDynamicSharedMemorySize, LDS_BYTES) != hipSuccess) { fprintf(stderr, "kernel_launch: hipFuncSetAttribute failed\n"); grid = -1; return; }
        if (hipOccupancyMaxActiveBlocksPerMultiprocessor(&per_cu, (const void*)mk_fwd, NWAVES * 64, LDS_BYTES) != hipSuccess || per_cu < 1) fprintf(stderr, "kernel_launch: occupancy query reports %d\n", per_cu);
        (void)hipGetLastError();
        grid = cus;
    }
    if (grid < 0) return;
    if (hipMemsetAsync((char*)d_ws + WS_CTL, 0, CTL_ZERO_BYTES, stream) != hipSuccess) { fprintf(stderr, "kernel_launch: memset failed\n"); return; }
    Args a{};
    for (int i = 0; i < N_IN; ++i) a.in[i] = (const float*)d_in[i];
    a.out = (float*)d_out; a.ws = (unsigned char*)d_ws;
#if MK_ONE_LAUNCH
    a.ph_lo = 0; a.ph_hi = N_PHASES;
    hipLaunchKernelGGL(mk_fwd, dim3(grid), dim3(NWAVES * 64), LDS_BYTES, stream, a);
#else
    for (int p = 0; p < N_PHASES; ++p) { a.ph_lo = p; a.ph_hi = p + 1; hipLaunchKernelGGL(mk_fwd, dim3(grid), dim3(NWAVES * 64), LDS_BYTES, stream, a); }
#endif
    const hipError_t le = hipPeekAtLastError();
    if (le != hipSuccess) fprintf(stderr, "kernel_launch: launch failed: %s\n", hipGetErrorName(le));
}
```

```cpp
#define REPMASK 0
#define MK_ONE_LAUNCH 1
#include <hip/hip_runtime.h>
#include <cstdio>
#include <cstdint>
namespace pg8 {
#define PG8_LAS __attribute__((address_space(3)))
typedef unsigned short bf16_t;
typedef short bf16x8 __attribute__((ext_vector_type(8)));
typedef float f32x4 __attribute__((ext_vector_type(4)));
typedef float f32x2 __attribute__((ext_vector_type(2)));
typedef unsigned u32x4 __attribute__((ext_vector_type(4)));
typedef unsigned u32x2 __attribute__((ext_vector_type(2)));
constexpr int BM = 256, BK = 64, HALF = 128, HTB = HALF * BK * 2  , STAGE_BYTES = 8 * HTB, NXCD = 8, WGM = 8;

__host__ __device__ __forceinline__ int lds_byte(int r, int c) { const int st = (r >> 4) * 2 + (c >> 5), rr = r & 15, cc = c & 31, ob = rr * 64 + cc * 2; return st * 1024 + (ob ^ (((ob >> 9) & 1) << 5)); }
__host__ __device__ __forceinline__ void stage_rc(int b, int& R, int& C) { const int st = b / 1024, sb = b % 1024, swz = sb ^ (((sb >> 9) & 1) << 5); R = (st >> 1) * 16 + swz / 64; C = (st & 1) * 32 + (swz % 64) / 2; }
__host__ __device__ __forceinline__ int perm32(int rho) { const int n = rho >> 4, i = rho & 15; return 8 * (i >> 2) + 4 * n + (i & 3); }

struct Unit { int pm, pn; };

struct StaticOrder {
    int nM, nN, nwg, G, c;
    __device__ __forceinline__ void init(int nM_, int nN_, int G_, int c_) { nM = nM_; nN = nN_; nwg = nM * nN; G = G_; c = c_; }
    __device__ __forceinline__ bool next(int i, Unit& u) const {
        const long L = (long)i * G + c; if (L >= nwg) return false;
        int wgid = (int)L; { const int q = nwg / NXCD, r = nwg % NXCD, xcd = wgid % NXCD, off = wgid / NXCD; wgid = (xcd < r ? xcd * (q + 1) : r * (q + 1) + (xcd - r) * q) + off; }
        const int nig = WGM * nN, gid = wgid / nig, fm = gid * WGM, gsz = (nM - fm) < WGM ? (nM - fm) : WGM;
        u.pm = fm + ((wgid % nig) % gsz); u.pn = (wgid % nig) / gsz; return true;
    }
};
__device__ __forceinline__ unsigned cvt_pk_bf16(float lo, float hi) { unsigned r; asm volatile("v_cvt_pk_bf16_f32 %0, %1, %2" : "=v"(r) : "v"(lo), "v"(hi)); return r; }
__device__ __forceinline__ float bf_lo(unsigned w) { return __uint_as_float(w << 16); }
__device__ __forceinline__ float bf_hi(unsigned w) { return __uint_as_float(w & 0xffff0000u); }

template <class Epi, class Prob, bool GATHER = false>
__device__ __forceinline__ void gemm_phase(PG8_LAS unsigned char* lds, const int K, const Prob& S, const Epi& E) {
    int tid_ = threadIdx.x; asm volatile("" : "+v"(tid_));
    const int tid = tid_, wid = __builtin_amdgcn_readfirstlane(tid >> 6), lane = tid & 63, wr = wid >> 2, wc = wid & 3, fr = lane & 15, fq = lane >> 4;
    const int nt = K / BK;
    int sR[2], sC[2];
    unsigned voffA[2][2], nvoffA[2][2], voffB[2];
#pragma unroll
    for (int i = 0; i < 2; ++i) { int R, C; stage_rc(tid * 16 + i * 8192, R, C); sR[i] = R; sC[i] = C; const int Rb = (R & ~31) + perm32(R & 31);
        voffB[i] = (unsigned)(Rb * K + C) * 2u;
        voffA[0][i] = (unsigned)(R * K + C) * 2u; voffA[1][i] = (unsigned)((R + HALF) * K + C) * 2u; nvoffA[0][i] = voffA[0][i]; nvoffA[1][i] = voffA[1][i]; }
    const size_t kstep = (size_t)(BK * 2);
    const size_t hstep = (size_t)HALF * K * 2;
    const unsigned ldsw = (unsigned)wid * 1024u;
    const int aoff = lds_byte(wr * 64 + fr, fq * 8), boff = lds_byte(wc * 32 + fr, fq * 8);
#define PG8_SA(b, h) (((b) * 2 + (h)) * HTB)
#define PG8_SB(b, h) ((4 + (b) * 2 + (h)) * HTB)
#define PG8_STAGE(bufoff, gbase, voff) do { _Pragma("unroll") for (int _i = 0; _i < 2; ++_i) \
        __builtin_amdgcn_global_load_lds((const unsigned*)((const char*)(gbase) + (voff)[_i]), (PG8_LAS unsigned*)(lds + (bufoff) + ldsw + _i * 8192), 16, 0, 0); } while (0)
#define PG8_LDA(dst, b, h) do { _Pragma("unroll") for (int m = 0; m < 4; ++m) _Pragma("unroll") for (int k = 0; k < 2; ++k) dst[m][k] = *(const PG8_LAS bf16x8*)(lds + PG8_SA(b, h) + aoff + m * 2048 + k * 1024); } while (0)
#define PG8_LDB(dst, b, h) do { _Pragma("unroll") for (int n = 0; n < 2; ++n) _Pragma("unroll") for (int k = 0; k < 2; ++k) dst[n][k] = *(const PG8_LAS bf16x8*)(lds + PG8_SB(b, h) + boff + n * 2048 + k * 1024); } while (0)
#define PG8_MMA(ai, bj, At, Bt) do { __builtin_amdgcn_s_setprio(1); _Pragma("unroll") for (int m = 0; m < 4; ++m) _Pragma("unroll") for (int n = 0; n < 2; ++n) _Pragma("unroll") for (int k = 0; k < 2; ++k) \
        acc[ai][bj][m][n] = __builtin_amdgcn_mfma_f32_16x16x32_bf16(Bt[n][k], At[m][k], acc[ai][bj][m][n], 0, 0, 0); __builtin_amdgcn_s_setprio(0); } while (0)
#define PG8_WAIT_V(n) asm volatile("s_waitcnt vmcnt(" #n ")" ::: "memory")
#define PG8_WAIT_L(n) asm volatile("s_waitcnt lgkmcnt(" #n ")" ::: "memory")
#define PG8_BAR __builtin_amdgcn_s_barrier()
#define PG8_SCHED __builtin_amdgcn_sched_barrier(0)
    Unit cur, nxt; int ui = 0;
    if (!S.next(0, cur)) return;
    f32x4 acc[2][2][4][2];
#pragma unroll
    for (int a = 0; a < 2; ++a)
#pragma unroll
        for (int b = 0; b < 2; ++b)
#pragma unroll
            for (int m = 0; m < 4; ++m)
#pragma unroll
                for (int n = 0; n < 2; ++n) acc[a][b][m][n] = (f32x4){0.f, 0.f, 0.f, 0.f};
    bf16x8 At[4][2], B0[2][2], B1[2][2];
    const char* cA = S.a_base(cur); const char* cB = S.b_base(cur);
    if constexpr (GATHER) {
#pragma unroll
        for (int h = 0; h < 2; ++h)
#pragma unroll
            for (int i = 0; i < 2; ++i) { voffA[h][i] = (unsigned)(S.a_row(cur, sR[i] + h * HALF) * K + sC[i]) * 2u; nvoffA[h][i] = voffA[h][i]; }
    }
    PG8_STAGE(PG8_SB(0, 0), cB, voffB); PG8_STAGE(PG8_SB(0, 1), cB + hstep, voffB); PG8_STAGE(PG8_SA(0, 0), cA, voffA[0]); PG8_STAGE(PG8_SA(0, 1), cA, voffA[1]);
    if (wr == 1) PG8_BAR;
    PG8_WAIT_V(2); PG8_BAR;
    PG8_STAGE(PG8_SB(1, 0), cB + kstep, voffB); PG8_STAGE(PG8_SA(1, 0), cA + kstep, voffA[0]); PG8_STAGE(PG8_SB(1, 1), cB + hstep + kstep, voffB);
    PG8_WAIT_V(6); PG8_BAR;
    for (;;) {
        const bool has_next = S.next(ui + 1, nxt);
        const char* nA = has_next ? S.a_base(nxt) : cA; const char* nB = has_next ? S.b_base(nxt) : cB;
        if constexpr (GATHER) { if (has_next) {
#pragma unroll
            for (int h = 0; h < 2; ++h)
#pragma unroll
                for (int i = 0; i < 2; ++i) nvoffA[h][i] = (unsigned)(S.a_row(nxt, sR[i] + h * HALF) * K + sC[i]) * 2u; } }
        for (int t = 0; t < nt; t += 2) {
            const bool last = (t == nt - 2);
            if constexpr (Epi::MID) { if (t == (nt >> 1)) E.mid(acc, cur, wr, wc, fr, fq); }
            const char* a1 = cA + (size_t)(t + 1) * kstep;
            const char* a2 = last ? nA : cA + (size_t)(t + 2) * kstep; const char* b2 = last ? nB : cB + (size_t)(t + 2) * kstep;
            const char* a3 = a2 + kstep; const char* b3 = b2 + kstep;
            unsigned vA2[2][2];
#pragma unroll
            for (int h = 0; h < 2; ++h)
#pragma unroll
                for (int i = 0; i < 2; ++i) vA2[h][i] = GATHER ? (last ? nvoffA[h][i] : voffA[h][i]) : voffA[h][i];
            PG8_LDB(B0, 0, 0); PG8_LDB(B1, 0, 1); PG8_SCHED; PG8_LDA(At, 0, 0); PG8_STAGE(PG8_SA(1, 1), a1, voffA[1]);
            PG8_WAIT_V(8); PG8_WAIT_L(0); PG8_BAR; PG8_MMA(0, 0, At, B0); PG8_MMA(0, 1, At, B1); PG8_BAR; PG8_SCHED;
            PG8_LDA(At, 0, 1); PG8_STAGE(PG8_SB(0, 0), b2, voffB); PG8_STAGE(PG8_SB(0, 1), b2 + hstep, voffB); PG8_STAGE(PG8_SA(0, 0), a2, vA2[0]);
            PG8_WAIT_V(8); PG8_WAIT_L(0); PG8_BAR; PG8_MMA(1, 0, At, B0); PG8_MMA(1, 1, At, B1); PG8_BAR; PG8_SCHED;
            PG8_LDB(B0, 1, 0); PG8_LDB(B1, 1, 1); PG8_SCHED; PG8_LDA(At, 1, 0); PG8_STAGE(PG8_SA(0, 1), a2, vA2[1]);
            PG8_WAIT_V(8); PG8_WAIT_L(0); PG8_BAR; PG8_MMA(0, 0, At, B0); PG8_MMA(0, 1, At, B1); PG8_BAR; PG8_SCHED;
            PG8_LDA(At, 1, 1); PG8_STAGE(PG8_SB(1, 0), b3, voffB); PG8_STAGE(PG8_SB(1, 1), b3 + hstep, voffB); PG8_STAGE(PG8_SA(1, 0), a3, vA2[0]);
            PG8_WAIT_V(8); PG8_WAIT_L(0); PG8_BAR; PG8_MMA(1, 0, At, B0); PG8_MMA(1, 1, At, B1); PG8_BAR; PG8_SCHED;
        }
        if (wr == 0) PG8_BAR;
        E(acc, cur, wr, wc, fr, fq);
        if (!has_next) break;
#pragma unroll
        for (int a = 0; a < 2; ++a)
#pragma unroll
            for (int b = 0; b < 2; ++b)
#pragma unroll
                for (int m = 0; m < 4; ++m)
#pragma unroll
                    for (int n = 0; n < 2; ++n) acc[a][b][m][n] = (f32x4){0.f, 0.f, 0.f, 0.f};
        cur = nxt; cA = nA; cB = nB; ++ui;
        if constexpr (GATHER) {
#pragma unroll
            for (int h = 0; h < 2; ++h)
#pragma unroll
                for (int i = 0; i < 2; ++i) voffA[h][i] = nvoffA[h][i]; }
        if (wr == 1) PG8_BAR;
    }
    PG8_WAIT_V(0);
    PG8_BAR;
#undef PG8_SA
#undef PG8_SB
#undef PG8_STAGE
#undef PG8_LDA
#undef PG8_LDB
#undef PG8_MMA
#undef PG8_WAIT_V
#undef PG8_WAIT_L
#undef PG8_BAR
#undef PG8_SCHED
}
}
constexpr int D = 2048, NB = 8, SEQ = 4096, NMETA = 16, NH = 16;
constexpr int TREAL = NB * SEQ;
constexpr int T = TREAL + NB * NMETA;
constexpr int TP = 33024;
constexpr int LPOS = SEQ + NMETA;
constexpr int QRANK = 768, KVRANK = 512, DFF = 5632, NE = 8;
constexpr int NIN = 8704;
constexpr int INDIM = 8512;
constexpr float LN_EPS = 1e-5f, RMS_EPS = 1e-6f, ALPHA = 1.4142135623730951f;
constexpr float LOG2E = 1.4426950408889634f;
constexpr float QK_SCALE_MLA = 0.07216878364870322f * LOG2E;
constexpr float QK_SCALE_SWA = 0.08838834764831845f * LOG2E;

__device__ __forceinline__ int row_pos(int row) { return row < TREAL ? NMETA + (row & (SEQ - 1)) : ((row - TREAL) & (NMETA - 1)); }

struct ProbDense {
    pg8::StaticOrder so; const char* A; const char* Bt; size_t tstep;
    __device__ __forceinline__ bool next(int i, pg8::Unit& u) const { return so.next(i, u); }
    __device__ __forceinline__ const char* a_base(const pg8::Unit& u) const { return A + (size_t)u.pm * tstep; }
    __device__ __forceinline__ const char* b_base(const pg8::Unit& u) const { return Bt + (size_t)u.pn * tstep; }
    __device__ __forceinline__ int a_row(const pg8::Unit&, int) const { return 0; }
};
struct MoeTiles { int ts[9]; };
__device__ __forceinline__ int moe_expert(const MoeTiles& mt, int pm) { int e = 0;
#pragma unroll
    for (int k = 1; k < 8; ++k) e += (pm >= mt.ts[k]) ? 1 : 0; return e; }
struct ProbMoe1 {
    pg8::StaticOrder so; const char* HBp; const int* slot_tok; const char* W; MoeTiles mt;
    __device__ __forceinline__ bool next(int i, pg8::Unit& u) const { return so.next(i, u); }
    __device__ __forceinline__ const char* a_base(const pg8::Unit&) const { return HBp; }
    __device__ __forceinline__ const char* b_base(const pg8::Unit& u) const { return W + (size_t)moe_expert(mt, u.pm) * ((size_t)2 * DFF * D * 2) + (size_t)u.pn * (256 * (size_t)D * 2); }
    __device__ __forceinline__ int a_row(const pg8::Unit& u, int r) const { return slot_tok[u.pm * 256 + r]; }
};
struct ProbMoe2 {
    pg8::StaticOrder so; const char* ACTp; const char* W; MoeTiles mt;
    __device__ __forceinline__ bool next(int i, pg8::Unit& u) const { return so.next(i, u); }
    __device__ __forceinline__ const char* a_base(const pg8::Unit& u) const { return ACTp + (size_t)u.pm * (256 * (size_t)DFF * 2); }
    __device__ __forceinline__ const char* b_base(const pg8::Unit& u) const { return W + (size_t)moe_expert(mt, u.pm) * ((size_t)D * DFF * 2) + (size_t)u.pn * (256 * (size_t)DFF * 2); }
    __device__ __forceinline__ int a_row(const pg8::Unit&, int) const { return 0; }
};

namespace epi {
using pg8::f32x4; using pg8::u32x4; using pg8::bf16_t; using pg8::Unit; using pg8::cvt_pk_bf16;
typedef const f32x4 (&AccRef)[2][2][4][2];
__device__ __forceinline__ void store8(bf16_t* p, f32x4 v0, f32x4 v1) { u32x4 w; w.x = cvt_pk_bf16(v0[0], v0[1]); w.y = cvt_pk_bf16(v0[2], v0[3]); w.z = cvt_pk_bf16(v1[0], v1[1]); w.w = cvt_pk_bf16(v1[2], v1[3]); *(u32x4*)p = w; }
__device__ __forceinline__ void load8(const bf16_t* p, f32x4& v0, f32x4& v1) { const u32x4 w = *(const u32x4*)p;
    v0 = (f32x4){pg8::bf_lo(w.x), pg8::bf_hi(w.x), pg8::bf_lo(w.y), pg8::bf_hi(w.y)}; v1 = (f32x4){pg8::bf_lo(w.z), pg8::bf_hi(w.z), pg8::bf_lo(w.w), pg8::bf_hi(w.w)}; }
__device__ __forceinline__ bool epi_fence() { asm volatile("" ::: "memory"); return true; }
__device__ __forceinline__ float sigmoidf_(float x) { return __builtin_amdgcn_rcpf(1.f + __builtin_amdgcn_exp2f(-x * LOG2E)); }
#define EPI_AM _Pragma("unroll") for (int ai = 0; ai < 2; ++ai) _Pragma("unroll") for (int m = 0; m < 4; ++m) if (epi_fence())

struct EpiWin {
    static constexpr bool MID = false;
    bf16_t *CQ, *CKV, *KR, *QB, *KB, *VB, *GR, *GBb; float* SSQ; const float *CS, *SN;
    __device__ __forceinline__ void operator()(AccRef acc, const Unit& u, int wr, int wc, int fr, int fq) const {
        const int pn = u.pn, row0 = u.pm * 256 + wr * 64 + fr, cw = wc * 32 + fq * 8;
        if (pn < 5) {
            bf16_t* dst = pn < 3 ? CQ : CKV; const int ld = pn < 3 ? QRANK : KVRANK, c0 = (pn < 3 ? pn : pn - 3) * 256;
            EPI_AM { const int row = row0 + ai * 128 + m * 16; float s = 0.f;
#pragma unroll
                for (int bj = 0; bj < 2; ++bj) { const f32x4 v0 = acc[ai][bj][m][0], v1 = acc[ai][bj][m][1];
                    s += (v0[0] * v0[0] + v0[1] * v0[1]) + (v0[2] * v0[2] + v0[3] * v0[3]) + (v1[0] * v1[0] + v1[1] * v1[1]) + (v1[2] * v1[2] + v1[3] * v1[3]);
                    store8(dst + (size_t)row * ld + c0 + bj * 128 + cw, v0, v1); }
                s += __shfl_xor(s, 16); s += __shfl_xor(s, 32);
                if (fq == 0) SSQ[(size_t)row * 20 + pn * 4 + wc] = s; }
        } else if (pn == 5) {
            if (wc == 0) { EPI_AM { const int row = row0 + ai * 128 + m * 16, pos = row_pos(row);
                const f32x4 c0 = *(const f32x4*)(CS + pos * 32 + fq * 8), c1 = *(const f32x4*)(CS + pos * 32 + fq * 8 + 4), s0 = *(const f32x4*)(SN + pos * 32 + fq * 8), s1 = *(const f32x4*)(SN + pos * 32 + fq * 8 + 4);
                const f32x4 x10 = acc[ai][0][m][0], x11 = acc[ai][0][m][1], x20 = acc[ai][1][m][0], x21 = acc[ai][1][m][1];
                store8(KR + (size_t)row * 64 + fq * 8, x10 * c0 - x20 * s0, x11 * c1 - x21 * s1);
                store8(KR + (size_t)row * 64 + 32 + fq * 8, x10 * s0 + x20 * c0, x11 * s1 + x21 * c1); } }
        } else if (pn < 14) {
            EPI_AM { const int row = row0 + ai * 128 + m * 16;
#pragma unroll
                for (int bj = 0; bj < 2; ++bj) store8(QB + (size_t)row * 2048 + (pn - 6) * 256 + bj * 128 + cw, acc[ai][bj][m][0] * QK_SCALE_SWA, acc[ai][bj][m][1] * QK_SCALE_SWA); }
        } else if (pn < 18) {
            bf16_t* dst = pn < 16 ? KB : VB; const int c0 = (pn < 16 ? pn - 14 : pn - 16) * 256;
            EPI_AM { const int row = row0 + ai * 128 + m * 16;
#pragma unroll
                for (int bj = 0; bj < 2; ++bj) store8(dst + (size_t)row * 512 + c0 + bj * 128 + cw, acc[ai][bj][m][0], acc[ai][bj][m][1]); }
        } else {
            const int c0 = (pn - 18) * 128 + cw;
            EPI_AM { const int row = row0 + ai * 128 + m * 16; f32x4 r[2], g[2];
#pragma unroll
                for (int n = 0; n < 2; ++n)
#pragma unroll
                    for (int j = 0; j < 4; ++j) { const float a = acc[ai][0][m][n][j], b = fmaxf(acc[ai][1][m][n][j], -30.f);
                        const float ea = __builtin_amdgcn_exp2f(-a * LOG2E), eb = __builtin_amdgcn_exp2f(-b * LOG2E);
                        g[n][j] = __builtin_amdgcn_rcpf(1.f + eb); r[n][j] = (1.f + eb) * __builtin_amdgcn_rcpf(1.f + ea); }
                store8(GR + (size_t)row * 2048 + c0, r[0], r[1]); store8(GBb + (size_t)row * 2048 + c0, g[0], g[1]); }
        }
    }
};
struct EpiUq {
    static constexpr bool MID = false;
    bf16_t* Q; const float* SSQ; const float *CS, *SN;
    __device__ __forceinline__ void operator()(AccRef acc, const Unit& u, int wr, int wc, int fr, int fq) const {
        const int pn = u.pn, row0 = u.pm * 256 + wr * 64 + fr, cw = wc * 32 + fq * 8;
        EPI_AM { const int row = row0 + ai * 128 + m * 16;
            const f32x4 q0 = *(const f32x4*)(SSQ + (size_t)row * 20), q1 = *(const f32x4*)(SSQ + (size_t)row * 20 + 4), q2 = *(const f32x4*)(SSQ + (size_t)row * 20 + 8);
            const float ss = ((q0[0] + q0[1]) + (q0[2] + q0[3])) + ((q1[0] + q1[1]) + (q1[2] + q1[3])) + ((q2[0] + q2[1]) + (q2[2] + q2[3]));
            const float rs = __builtin_amdgcn_rsqf(ss * (1.f / QRANK) + RMS_EPS) * QK_SCALE_MLA;
            if (pn < 8) {
#pragma unroll
                for (int bj = 0; bj < 2; ++bj) store8(Q + (size_t)row * 3072 + (2 * pn + bj) * 192 + cw, acc[ai][bj][m][0] * rs, acc[ai][bj][m][1] * rs);
            } else {
                const int head = 4 * (pn - 8) + wc, pos = row_pos(row);
                const f32x4 c0 = *(const f32x4*)(CS + pos * 32 + fq * 8), c1 = *(const f32x4*)(CS + pos * 32 + fq * 8 + 4), s0 = *(const f32x4*)(SN + pos * 32 + fq * 8), s1 = *(const f32x4*)(SN + pos * 32 + fq * 8 + 4);
                const f32x4 x10 = acc[ai][0][m][0] * rs, x11 = acc[ai][0][m][1] * rs, x20 = acc[ai][1][m][0] * rs, x21 = acc[ai][1][m][1] * rs;
                store8(Q + (size_t)row * 3072 + head * 192 + 128 + fq * 8, x10 * c0 - x20 * s0, x11 * c1 - x21 * s1);
                store8(Q + (size_t)row * 3072 + head * 192 + 160 + fq * 8, x10 * s0 + x20 * c0, x11 * s1 + x21 * c1);
            } }
    }
};
struct EpiUkv {
    static constexpr bool MID = false;
    bf16_t *KN, *V; const float* SSQ;
    __device__ __forceinline__ void operator()(AccRef acc, const Unit& u, int wr, int wc, int fr, int fq) const {
        const int pn = u.pn, row0 = u.pm * 256 + wr * 64 + fr, cw = wc * 32 + fq * 8;
        EPI_AM { const int row = row0 + ai * 128 + m * 16;
            const f32x4 q0 = *(const f32x4*)(SSQ + (size_t)row * 20 + 12), q1 = *(const f32x4*)(SSQ + (size_t)row * 20 + 16);
            const float ss = ((q0[0] + q0[1]) + (q0[2] + q0[3])) + ((q1[0] + q1[1]) + (q1[2] + q1[3]));
            const float rs = __builtin_amdgcn_rsqf(ss * (1.f / KVRANK) + RMS_EPS);
            store8(KN + (size_t)row * 2048 + pn * 128 + cw, acc[ai][0][m][0] * rs, acc[ai][0][m][1] * rs);
            store8(V + (size_t)row * 2048 + pn * 128 + cw, acc[ai][1][m][0] * rs, acc[ai][1][m][1] * rs); }
    }
};
struct EpiProj {
    static constexpr bool MID = true;
    bf16_t* MG; const bf16_t *GR, *GBb;
    __device__ __forceinline__ void mid(f32x4 (&acc)[2][2][4][2], const Unit& u, int wr, int wc, int fr, int fq) const {
        int row0 = u.pm * 256 + wr * 64 + fr, c0 = u.pn * 256 + wc * 32 + fq * 8; asm volatile("" : "+v"(row0), "+v"(c0));
        EPI_AM { const int row = row0 + ai * 128 + m * 16;
#pragma unroll
            for (int bj = 0; bj < 2; ++bj) { f32x4 r0, r1; load8(GR + (size_t)row * 2048 + c0 + bj * 128, r0, r1); acc[ai][bj][m][0] *= r0; acc[ai][bj][m][1] *= r1; } }
    }
    __device__ __forceinline__ void operator()(AccRef acc, const Unit& u, int wr, int wc, int fr, int fq) const {
        const int row0 = u.pm * 256 + wr * 64 + fr, c0 = u.pn * 256 + wc * 32 + fq * 8;
        EPI_AM { const int row = row0 + ai * 128 + m * 16;
#pragma unroll
            for (int bj = 0; bj < 2; ++bj) { f32x4 g0, g1; load8(GBb + (size_t)row * 2048 + c0 + bj * 128, g0, g1); store8(MG + (size_t)row * 2048 + c0 + bj * 128, acc[ai][bj][m][0] * g0, acc[ai][bj][m][1] * g1); } }
    }
};
struct EpiResid {
    static constexpr bool MID = false;
    bf16_t* X; const bf16_t* HB;
    __device__ __forceinline__ void operator()(AccRef acc, const Unit& u, int wr, int wc, int fr, int fq) const {
        const int row0 = u.pm * 256 + wr * 64 + fr, c0 = u.pn * 256 + wc * 32 + fq * 8;
        EPI_AM { const int row = row0 + ai * 128 + m * 16;
#pragma unroll
            for (int bj = 0; bj < 2; ++bj) { f32x4 h0, h1; load8(HB + (size_t)row * 2048 + c0 + bj * 128, h0, h1);
                store8(X + (size_t)row * 2048 + c0 + bj * 128, h0 * ALPHA + acc[ai][bj][m][0], h1 * ALPHA + acc[ai][bj][m][1]); } }
    }
};
struct EpiSwiglu {
    static constexpr bool MID = false;
    bf16_t* ACT;
    __device__ __forceinline__ void operator()(AccRef acc, const Unit& u, int wr, int wc, int fr, int fq) const {
        const int row0 = u.pm * 256 + wr * 64 + fr, c0 = u.pn * 128 + wc * 32 + fq * 8;
        EPI_AM { const int row = row0 + ai * 128 + m * 16; f32x4 o[2];
#pragma unroll
            for (int n = 0; n < 2; ++n)
#pragma unroll
                for (int j = 0; j < 4; ++j) { const float g = acc[ai][0][m][n][j]; o[n][j] = g * sigmoidf_(g) * acc[ai][1][m][n][j]; }
            store8(ACT + (size_t)row * DFF + c0, o[0], o[1]); }
    }
};
struct EpiMoeDown {
    static constexpr bool MID = false;
    bf16_t* Y; const float* slot_gate;
    __device__ __forceinline__ void operator()(AccRef acc, const Unit& u, int wr, int wc, int fr, int fq) const {
        const int row0 = u.pm * 256 + wr * 64 + fr, c0 = u.pn * 256 + wc * 32 + fq * 8;
        EPI_AM { const int row = row0 + ai * 128 + m * 16; const float g = slot_gate[row];
#pragma unroll
            for (int bj = 0; bj < 2; ++bj) store8(Y + (size_t)row * 2048 + c0 + bj * 128, acc[ai][bj][m][0] * g, acc[ai][bj][m][1] * g); }
    }
};
#undef EPI_AM
}
namespace att {
typedef unsigned short bf16;
typedef short bf16x8 __attribute__((ext_vector_type(8)));
typedef short s16x4 __attribute__((ext_vector_type(4)));
typedef float f32x16 __attribute__((ext_vector_type(16)));
typedef unsigned u32x4 __attribute__((ext_vector_type(4)));
#define ATT_LAS __attribute__((address_space(3)))
#define SBAR() __builtin_amdgcn_sched_barrier(0)
constexpr int KN_BYTES = 16384, KR_BYTES = 8192, V_BYTES = 16384, BUF_BYTES = KN_BYTES + KR_BYTES + V_BYTES;
constexpr int OFF_KN = 0, OFF_KR = KN_BYTES, OFF_V = KN_BYTES + KR_BYTES;
constexpr int OFF_WS = 2 * BUF_BYTES;
constexpr int OFF_BT = OFF_WS + 8 * 64 * 4;
constexpr int ATT_LDS_BYTES = OFF_BT + 4 * 260 * 4;
constexpr float NEG_BIG = -1e30f;
constexpr float THR2 = 8.f;

__device__ __forceinline__ int crow(int r, int hi) { return (r & 3) + 8 * (r >> 2) + 4 * hi; }
__device__ __forceinline__ unsigned cvtpk(float lo, float hi) { unsigned r; asm volatile("v_cvt_pk_bf16_f32 %0, %1, %2" : "=v"(r) : "v"(lo), "v"(hi)); return r; }
__device__ __forceinline__ int kn_off(int row, int colB) { return row * 256 + (colB ^ ((row & 15) << 4)); }
__device__ __forceinline__ int kr_off(int row, int colB) { return row * 128 + (colB ^ (((row >> 1) & 7) << 4)); }
__device__ __forceinline__ int v_st(int k, int c) { const int kk = (k & ~0xC) | ((k & 4) << 1) | ((k & 8) >> 1); return ((kk >> 3) * 4 + (c >> 5)) * 512 + ((kk & 7) * 32 + (c & 31)) * 2; }
__device__ __forceinline__ int v_rd_base(int lane) { return ((lane & 3) << 3) | (((lane >> 2) & 3) << 6) | (((lane >> 4) & 1) << 5) | (((lane >> 5) & 1) << 8); }
constexpr int v_rd_off(int d0, int ks, int half) { return d0 * 512 + ks * 4096 + half * 2048; }
template <int OFF> __device__ __forceinline__ s16x4 tr_read(int vb) { s16x4 r; asm volatile("ds_read_b64_tr_b16 %0, %1 offset:%2" : "=&v"(r) : "v"(vb), "i"(OFF) : "memory"); return r; }
template <int D0> __device__ __forceinline__ void pv_one(f32x16& od, int vb, bf16x8 pa0, bf16x8 pa1, bf16x8 pa2, bf16x8 pa3) {
    const s16x4 l0 = tr_read<v_rd_off(D0, 0, 0)>(vb), h0 = tr_read<v_rd_off(D0, 0, 1)>(vb), l1 = tr_read<v_rd_off(D0, 1, 0)>(vb), h1 = tr_read<v_rd_off(D0, 1, 1)>(vb);
    const s16x4 l2 = tr_read<v_rd_off(D0, 2, 0)>(vb), h2 = tr_read<v_rd_off(D0, 2, 1)>(vb), l3 = tr_read<v_rd_off(D0, 3, 0)>(vb), h3 = tr_read<v_rd_off(D0, 3, 1)>(vb);
    asm volatile("s_waitcnt lgkmcnt(0)" ::: "memory"); SBAR();
#define PK(L, H) (bf16x8){L[0], L[1], L[2], L[3], H[0], H[1], H[2], H[3]}
    od = __builtin_amdgcn_mfma_f32_32x32x16_bf16(pa0, PK(l0, h0), od, 0, 0, 0);
    od = __builtin_amdgcn_mfma_f32_32x32x16_bf16(pa1, PK(l1, h1), od, 0, 0, 0);
    od = __builtin_amdgcn_mfma_f32_32x32x16_bf16(pa2, PK(l2, h2), od, 0, 0, 0);
    od = __builtin_amdgcn_mfma_f32_32x32x16_bf16(pa3, PK(l3, h3), od, 0, 0, 0);
#undef PK
}
__device__ __forceinline__ void pv_all(f32x16* o, int vb, bf16x8 pa0, bf16x8 pa1, bf16x8 pa2, bf16x8 pa3) {
    pv_one<0>(o[0], vb, pa0, pa1, pa2, pa3); pv_one<1>(o[1], vb, pa0, pa1, pa2, pa3); pv_one<2>(o[2], vb, pa0, pa1, pa2, pa3); pv_one<3>(o[3], vb, pa0, pa1, pa2, pa3);
}
__device__ __forceinline__ bool softmax_tile(f32x16& p0, f32x16& p1, float& m_reg, float& l_reg, float& alpha, bf16x8& pa0, bf16x8& pa1, bf16x8& pa2, bf16x8& pa3) {
    float pmax = p0[0];
#pragma unroll
    for (int r = 1; r < 16; ++r) pmax = fmaxf(pmax, p0[r]);
#pragma unroll
    for (int r = 0; r < 16; ++r) pmax = fmaxf(pmax, p1[r]);
    { auto rr = __builtin_amdgcn_permlane32_swap(__float_as_uint(pmax), __float_as_uint(pmax), false, false); pmax = fmaxf(__uint_as_float(rr[0]), __uint_as_float(rr[1])); }
    bool resc = false; alpha = 1.f;
    if (!__all(pmax - m_reg <= THR2)) { const float mn = fmaxf(m_reg, pmax); alpha = __builtin_amdgcn_exp2f(m_reg - mn); m_reg = mn; resc = true; }
    float ps = 0.f;
#pragma unroll
    for (int r = 0; r < 16; ++r) { p0[r] = __builtin_amdgcn_exp2f(p0[r] - m_reg); ps += p0[r]; }
#pragma unroll
    for (int r = 0; r < 16; ++r) { p1[r] = __builtin_amdgcn_exp2f(p1[r] - m_reg); ps += p1[r]; }
    { auto rr = __builtin_amdgcn_permlane32_swap(__float_as_uint(ps), __float_as_uint(ps), false, false); ps = __uint_as_float(rr[0]) + __uint_as_float(rr[1]); }
    l_reg = l_reg * alpha + ps;
#define PK4(P, BASE, OUT) do { unsigned a0 = cvtpk(P[BASE + 0], P[BASE + 1]), a1 = cvtpk(P[BASE + 2], P[BASE + 3]);   \
    unsigned b0 = cvtpk(P[BASE + 4], P[BASE + 5]), b1 = cvtpk(P[BASE + 6], P[BASE + 7]);                              \
    auto r0 = __builtin_amdgcn_permlane32_swap(a0, b0, false, false); auto r1 = __builtin_amdgcn_permlane32_swap(a1, b1, false, false); \
    u32x4 w = {r0[0], r1[0], r0[1], r1[1]}; OUT = *reinterpret_cast<bf16x8*>(&w); } while (0)
    PK4(p0, 0, pa0); PK4(p0, 8, pa1); PK4(p1, 0, pa2); PK4(p1, 8, pa3);
#undef PK4
    return resc;
}

__device__ __forceinline__ void mla_unit(char* lds, const bf16* __restrict__ Q, const bf16* __restrict__ KN, const bf16* __restrict__ KR, const bf16* __restrict__ V, bf16* __restrict__ OAB, int b, int h, int qb) {
    int tid_ = threadIdx.x; asm volatile("" : "+v"(tid_)); const int tid = tid_, lane = tid & 63, r32 = lane & 31, hi = lane >> 5; const int wid = __builtin_amdgcn_readfirstlane(tid >> 6);
    const bool metaq = (qb == 16);
    const bool wave_on = !metaq || wid == 0;
    const int qrow = metaq ? (TREAL + 16 * b + (r32 & 15)) : (b * SEQ + qb * 256 + wid * 32 + r32);
    float* wsf = (float*)(lds + OFF_WS) + wid * 64;
    bf16x8 qr[12];
    { const bf16* qp = Q + (size_t)qrow * 3072 + h * 192 + hi * 8;
#pragma unroll
      for (int d0 = 0; d0 < 12; ++d0) qr[d0] = *reinterpret_cast<const bf16x8*>(qp + d0 * 16); }
    const int sr = tid >> 4, sc = (tid & 15) * 8, rr = tid >> 3, rc = (tid & 7) * 8;
    const int kn_w0 = kn_off(sr, sc * 2), kn_w1 = kn_off(32 + sr, sc * 2), kr_w = kr_off(rr, rc * 2), v_w0 = v_st(sr, sc), v_w1 = v_st(32 + sr, sc);
    const int vb0 = (int)(uintptr_t)(lds + OFF_V) + v_rd_base(lane);
    bf16x8 sk0, sk1, skr, sv0, sv1;
    const size_t real0 = (size_t)b * SEQ, meta0 = (size_t)TREAL + 16 * b;
#define MLA_LOAD(t) do { size_t g0, g1, g2; if ((t) < 64) { g0 = real0 + (t) * 64 + sr; g1 = g0 + 32; g2 = real0 + (t) * 64 + rr; } else { g0 = meta0 + (sr & 15); g1 = g0; g2 = meta0 + (rr & 15); } \
        sk0 = *reinterpret_cast<const bf16x8*>(KN + g0 * 2048 + h * 128 + sc); sk1 = *reinterpret_cast<const bf16x8*>(KN + g1 * 2048 + h * 128 + sc); \
        skr = *reinterpret_cast<const bf16x8*>(KR + g2 * 64 + rc); \
        sv0 = *reinterpret_cast<const bf16x8*>(V + g0 * 2048 + h * 128 + sc); sv1 = *reinterpret_cast<const bf16x8*>(V + g1 * 2048 + h * 128 + sc); } while (0)
#define MLA_WRITE(bf) do { char* base = lds + (bf) * BUF_BYTES; \
        *reinterpret_cast<bf16x8*>(base + OFF_KN + kn_w0) = sk0; *reinterpret_cast<bf16x8*>(base + OFF_KN + kn_w1) = sk1; *reinterpret_cast<bf16x8*>(base + OFF_KR + kr_w) = skr; \
        *reinterpret_cast<bf16x8*>(base + OFF_V + v_w0) = sv0; *reinterpret_cast<bf16x8*>(base + OFF_V + v_w1) = sv1; } while (0)
    float m_reg = NEG_BIG, l_reg = 0.f; f32x16 o[4];
#pragma unroll
    for (int d = 0; d < 4; ++d) o[d] = f32x16{};
    constexpr int NT = 65;
    MLA_LOAD(0); MLA_WRITE(0); __syncthreads();
    for (int t = 0; t < NT; ++t) {
        const int bf = t & 1;
        if (t + 1 < NT) MLA_LOAD(t + 1);
        if (wave_on) {
            const char* kn = lds + bf * BUF_BYTES + OFF_KN; const char* kr = lds + bf * BUF_BYTES + OFF_KR;
            f32x16 p0 = f32x16{}, p1 = f32x16{};
#pragma unroll
            for (int d0 = 0; d0 < 8; ++d0) { const int cb = d0 * 32 + hi * 16;
                const bf16x8 b0 = *reinterpret_cast<const bf16x8*>(kn + kn_off(r32, cb)), b1 = *reinterpret_cast<const bf16x8*>(kn + kn_off(32 + r32, cb));
                p0 = __builtin_amdgcn_mfma_f32_32x32x16_bf16(b0, qr[d0], p0, 0, 0, 0); p1 = __builtin_amdgcn_mfma_f32_32x32x16_bf16(b1, qr[d0], p1, 0, 0, 0); }
#pragma unroll
            for (int d0 = 0; d0 < 4; ++d0) { const int cb = d0 * 32 + hi * 16;
                const bf16x8 b0 = *reinterpret_cast<const bf16x8*>(kr + kr_off(r32, cb)), b1 = *reinterpret_cast<const bf16x8*>(kr + kr_off(32 + r32, cb));
                p0 = __builtin_amdgcn_mfma_f32_32x32x16_bf16(b0, qr[8 + d0], p0, 0, 0, 0); p1 = __builtin_amdgcn_mfma_f32_32x32x16_bf16(b1, qr[8 + d0], p1, 0, 0, 0); }
            if (t == NT - 1) {
#pragma unroll
                for (int r = 0; r < 16; ++r) { if (crow(r, hi) >= 16) p0[r] = NEG_BIG; p1[r] = NEG_BIG; }
            }
            float alpha; bf16x8 pa0, pa1, pa2, pa3;
            const bool resc = softmax_tile(p0, p1, m_reg, l_reg, alpha, pa0, pa1, pa2, pa3);
            if (resc) { if (hi == 0) wsf[r32] = alpha; asm volatile("s_waitcnt lgkmcnt(0)" ::: "memory");
#pragma unroll
                for (int d = 0; d < 4; ++d)
#pragma unroll
                    for (int r = 0; r < 16; ++r) o[d][r] *= wsf[crow(r, hi)]; }
            pv_all(o, vb0 + bf * BUF_BYTES, pa0, pa1, pa2, pa3);
        }
        if (t + 1 < NT) MLA_WRITE(bf ^ 1);
        __syncthreads();
    }
#undef MLA_LOAD
#undef MLA_WRITE
    if (wave_on) {
        if (hi == 0) wsf[32 + r32] = l_reg; asm volatile("s_waitcnt lgkmcnt(0)" ::: "memory");
        const int orow0 = metaq ? (TREAL + 16 * b) : (b * SEQ + qb * 256 + wid * 32);
#pragma unroll
        for (int r = 0; r < 16; ++r) { const int rw = crow(r, hi); const float rl = __builtin_amdgcn_rcpf(wsf[32 + rw]);
            if (!metaq || rw < 16) { bf16* op = OAB + (size_t)(orow0 + rw) * 4096 + h * 128 + r32;
#pragma unroll
                for (int d0 = 0; d0 < 4; ++d0) op[d0 * 32] = (bf16)(cvtpk(o[d0][r] * rl, 0.f) & 0xffffu); } }
    }
    __syncthreads();
}

__device__ __forceinline__ void swa_unit(char* lds, const bf16* __restrict__ QB, const bf16* __restrict__ KB, const bf16* __restrict__ VB, bf16* __restrict__ OAB,
                                         const float* __restrict__ bias_l2, const float* __restrict__ sink_l2, int b, int hk, int j) {
    int tid_ = threadIdx.x; asm volatile("" : "+v"(tid_)); const int tid = tid_, lane = tid & 63, r32 = lane & 31, hi = lane >> 5; const int wid = __builtin_amdgcn_readfirstlane(tid >> 6);
    const bool metaq = (j == 64);
    const int hq = 4 * hk + (wid >> 1);
    const bool wave_on = !metaq || (wid & 1) == 0;
    const int qpos = metaq ? (r32 & 15) : (NMETA + 64 * j + 32 * (wid & 1) + r32);
    const int qrow = metaq ? (TREAL + 16 * b + (r32 & 15)) : (b * SEQ + 64 * j + 32 * (wid & 1) + r32);
    float* wsf = (float*)(lds + OFF_WS) + wid * 64;
    float* bt = (float*)(lds + OFF_BT);
    for (int i = tid; i < 4 * 257; i += 512) { const int g = i / 257, e = i - g * 257; bt[g * 260 + e] = bias_l2[(4 * hk + g) * 257 + e]; }
    const float* btw = bt + (wid >> 1) * 260 + 128;
    bf16x8 qr[8];
    { const bf16* qp = QB + (size_t)qrow * 2048 + hq * 128 + hi * 8;
#pragma unroll
      for (int d0 = 0; d0 < 8; ++d0) qr[d0] = *reinterpret_cast<const bf16x8*>(qp + d0 * 16); }
    const int sr = tid >> 4, sc = (tid & 15) * 8;
    const int kn_w0 = kn_off(sr, sc * 2), kn_w1 = kn_off(32 + sr, sc * 2), v_w0 = v_st(sr, sc), v_w1 = v_st(32 + sr, sc);
    const int vb0 = (int)(uintptr_t)(lds + OFF_V) + v_rd_base(lane);
    bf16x8 sk0, sk1, sv0, sv1;
    int nt, kt_lo = 0;
    if (metaq) nt = 3; else { kt_lo = j - 2 < 0 ? 0 : j - 2; const int kt_hi = j + 2 > 63 ? 63 : j + 2; nt = 1 + (kt_hi - kt_lo + 1); }
#define SWA_TILE(t, kpos0, mode) do { if (metaq) { kpos0 = 64 * (t); mode = 2; } else if ((t) == 0) { kpos0 = 0; mode = 0; } else { kpos0 = NMETA + 64 * (kt_lo + (t) - 1); mode = 1; } } while (0)
#define SWA_ROW(kp) ({ int kp_ = (kp) > LPOS - 1 ? LPOS - 1 : (kp); (size_t)(kp_ < NMETA ? TREAL + 16 * b + kp_ : b * SEQ + kp_ - NMETA); })
#define SWA_LOAD(t) do { int kpos0_, mode_; SWA_TILE(t, kpos0_, mode_); (void)mode_; const size_t g0 = SWA_ROW(kpos0_ + sr), g1 = SWA_ROW(kpos0_ + 32 + sr); \
        sk0 = *reinterpret_cast<const bf16x8*>(KB + g0 * 512 + hk * 128 + sc); sk1 = *reinterpret_cast<const bf16x8*>(KB + g1 * 512 + hk * 128 + sc); \
        sv0 = *reinterpret_cast<const bf16x8*>(VB + g0 * 512 + hk * 128 + sc); sv1 = *reinterpret_cast<const bf16x8*>(VB + g1 * 512 + hk * 128 + sc); } while (0)
#define SWA_WRITE(bf) do { char* base = lds + (bf) * BUF_BYTES; \
        *reinterpret_cast<bf16x8*>(base + OFF_KN + kn_w0) = sk0; *reinterpret_cast<bf16x8*>(base + OFF_KN + kn_w1) = sk1; \
        *reinterpret_cast<bf16x8*>(base + OFF_V + v_w0) = sv0; *reinterpret_cast<bf16x8*>(base + OFF_V + v_w1) = sv1; } while (0)
    float m_reg = sink_l2[hq], l_reg = 1.f; f32x16 o[4];
#pragma unroll
    for (int d = 0; d < 4; ++d) o[d] = f32x16{};
    SWA_LOAD(0); SWA_WRITE(0); __syncthreads();
    for (int t = 0; t < nt; ++t) {
        const int bf = t & 1;
        if (t + 1 < nt) SWA_LOAD(t + 1);
        if (wave_on) {
            int kpos0, mode; SWA_TILE(t, kpos0, mode);
            const char* kn = lds + bf * BUF_BYTES + OFF_KN;
            f32x16 p0 = f32x16{}, p1 = f32x16{};
#pragma unroll
            for (int d0 = 0; d0 < 8; ++d0) { const int cb = d0 * 32 + hi * 16;
                const bf16x8 b0 = *reinterpret_cast<const bf16x8*>(kn + kn_off(r32, cb)), b1 = *reinterpret_cast<const bf16x8*>(kn + kn_off(32 + r32, cb));
                p0 = __builtin_amdgcn_mfma_f32_32x32x16_bf16(b0, qr[d0], p0, 0, 0, 0); p1 = __builtin_amdgcn_mfma_f32_32x32x16_bf16(b1, qr[d0], p1, 0, 0, 0); }
#pragma unroll
            for (int r = 0; r < 16; ++r) {
#pragma unroll
                for (int half = 0; half < 2; ++half) { const int kp = kpos0 + crow(r, hi) + 32 * half; const int rel = kp - qpos; const int arel = rel < 0 ? -rel : rel;
                    const bool win = (kp >= NMETA) && (arel <= 128) && (kp < LPOS);
                    const bool vis = mode == 0 ? (kp < NMETA) : (mode == 1 ? win : ((kp < NMETA) || win));
                    const int rc = rel < -128 ? -128 : (rel > 128 ? 128 : rel);
                    const float bias = btw[rc];
                    if (half == 0) p0[r] = vis ? p0[r] + bias : NEG_BIG; else p1[r] = vis ? p1[r] + bias : NEG_BIG; } }
            float alpha; bf16x8 pa0, pa1, pa2, pa3;
            const bool resc = softmax_tile(p0, p1, m_reg, l_reg, alpha, pa0, pa1, pa2, pa3);
            if (resc) { if (hi == 0) wsf[r32] = alpha; asm volatile("s_waitcnt lgkmcnt(0)" ::: "memory");
#pragma unroll
                for (int d = 0; d < 4; ++d)
#pragma unroll
                    for (int r = 0; r < 16; ++r) o[d][r] *= wsf[crow(r, hi)]; }
            pv_all(o, vb0 + bf * BUF_BYTES, pa0, pa1, pa2, pa3);
        }
        if (t + 1 < nt) SWA_WRITE(bf ^ 1);
        __syncthreads();
    }
#undef SWA_TILE
#undef SWA_ROW
#undef SWA_LOAD
#undef SWA_WRITE
    if (wave_on) {
        if (hi == 0) wsf[32 + r32] = l_reg; asm volatile("s_waitcnt lgkmcnt(0)" ::: "memory");
        const int orow0 = metaq ? (TREAL + 16 * b) : (b * SEQ + 64 * j + 32 * (wid & 1));
#pragma unroll
        for (int r = 0; r < 16; ++r) { const int rw = crow(r, hi); const float rl = __builtin_amdgcn_rcpf(wsf[32 + rw]);
            if (!metaq || rw < 16) { bf16* op = OAB + (size_t)(orow0 + rw) * 4096 + 2048 + hq * 128 + r32;
#pragma unroll
                for (int d0 = 0; d0 < 4; ++d0) op[d0 * 32] = (bf16)(cvtpk(o[d0][r] * rl, 0.f) & 0xffffu); } }
    }
    __syncthreads();
}
}
namespace att {
constexpr int M2_KSLOT = KN_BYTES + KR_BYTES;
constexpr int M2_OFF_K = 0, M2_OFF_V = 3 * M2_KSLOT;
constexpr int M2_OFF_WS = M2_OFF_V + 3 * V_BYTES;
constexpr int M2_LDS_BYTES = M2_OFF_WS + 8 * 64 * 4;
typedef __attribute__((address_space(3))) unsigned char* lds_ptr;

__device__ __forceinline__ void partialSM(f32x16& p0, f32x16& p1, float& m_reg, float& alpha) {
    float pmax = p0[0];
#pragma unroll
    for (int r = 1; r < 16; ++r) pmax = fmaxf(pmax, p0[r]);
#pragma unroll
    for (int r = 0; r < 16; ++r) pmax = fmaxf(pmax, p1[r]);
    { auto rr = __builtin_amdgcn_permlane32_swap(__float_as_uint(pmax), __float_as_uint(pmax), false, false); pmax = fmaxf(__uint_as_float(rr[0]), __uint_as_float(rr[1])); }
    if (__builtin_expect(__all(pmax - m_reg <= THR2), 1)) { alpha = 1.f; }
    else { const float mn = fmaxf(m_reg, pmax); alpha = __builtin_amdgcn_exp2f(m_reg - mn); m_reg = mn; }
    const float mn = m_reg;
#pragma unroll
    for (int r = 0; r < 16; ++r) p0[r] = __builtin_amdgcn_exp2f(p0[r] - mn);
#pragma unroll
    for (int r = 0; r < 16; ++r) p1[r] = p1[r] - mn;
}
__device__ __forceinline__ void finishSM(f32x16& p0, f32x16& p1, float alpha, float& l_reg, bf16x8& pa0, bf16x8& pa1, bf16x8& pa2, bf16x8& pa3) {
#pragma unroll
    for (int r = 0; r < 16; ++r) p1[r] = __builtin_amdgcn_exp2f(p1[r]);
    float ps = 0.f;
#pragma unroll
    for (int r = 0; r < 16; ++r) ps += p0[r];
#pragma unroll
    for (int r = 0; r < 16; ++r) ps += p1[r];
    { auto rr = __builtin_amdgcn_permlane32_swap(__float_as_uint(ps), __float_as_uint(ps), false, false); ps = __uint_as_float(rr[0]) + __uint_as_float(rr[1]); }
    l_reg = l_reg * alpha + ps;
#define PK4(P, BASE, OUT) do { unsigned a0 = cvtpk(P[BASE + 0], P[BASE + 1]), a1 = cvtpk(P[BASE + 2], P[BASE + 3]);   \
    unsigned b0 = cvtpk(P[BASE + 4], P[BASE + 5]), b1 = cvtpk(P[BASE + 6], P[BASE + 7]);                              \
    auto r0 = __builtin_amdgcn_permlane32_swap(a0, b0, false, false); auto r1 = __builtin_amdgcn_permlane32_swap(a1, b1, false, false); \
    u32x4 w = {r0[0], r1[0], r0[1], r1[1]}; OUT = *reinterpret_cast<bf16x8*>(&w); } while (0)
    PK4(p0, 0, pa0); PK4(p0, 8, pa1); PK4(p1, 0, pa2); PK4(p1, 8, pa3);
#undef PK4
}

__device__ __forceinline__ void mla_unit2(lds_ptr lds, const bf16* __restrict__ Q, const bf16* __restrict__ KN, const bf16* __restrict__ KR, const bf16* __restrict__ V, bf16* __restrict__ OAB, int b, int h, int qb) {
    int tid_ = threadIdx.x; asm volatile("" : "+v"(tid_)); const int tid = tid_, lane = tid & 63, r32 = lane & 31, hi = lane >> 5; const int wid = __builtin_amdgcn_readfirstlane(tid >> 6);
    const bool metaq = (qb == 16);
    const bool wave_on = !metaq || wid == 0;
    const int qrow = metaq ? (TREAL + 16 * b + (r32 & 15)) : (b * SEQ + qb * 256 + wid * 32 + r32);
    __attribute__((address_space(3))) float* wsf = (__attribute__((address_space(3))) float*)(lds + M2_OFF_WS) + wid * 64;
    unsigned so_kn[2], so_kr, so_v[2];
#pragma unroll
    for (int i = 0; i < 2; ++i) { const int P = 2 * wid + i;
        { const int row = 4 * P + (lane >> 4), c = (lane & 15) ^ (row & 15); so_kn[i] = (unsigned)(row * 4096 + c * 16); }
        { const int q = 64 * P + lane, s = q >> 5, kk = (s >> 2) * 8 + ((q & 31) >> 2), col = (s & 3) * 32 + (q & 3) * 8, k = (kk & ~0xC) | ((kk & 4) << 1) | ((kk & 8) >> 1); so_v[i] = (unsigned)(k * 4096 + col * 2); } }
    { const int row = 8 * wid + (lane >> 3), c = (lane & 7) ^ ((row >> 1) & 7); so_kr = (unsigned)(row * 128 + c * 16); }
    const char* const kn_h = (const char*)KN + h * 256; const char* const v_h = (const char*)V + h * 256; const char* const kr_b = (const char*)KR;
#define M2_DMA(src, dstoff) __builtin_amdgcn_global_load_lds((const unsigned*)(src), (__attribute__((address_space(3))) unsigned*)(lds + (dstoff)), 16, 0, 0)
#define M2_DMA_K(grow, slot) do { const size_t g_ = (size_t)(grow); const int so_ = M2_OFF_K + (slot) * M2_KSLOT; \
        M2_DMA(kn_h + g_ * 4096 + so_kn[0], so_ + (2 * wid) * 1024); M2_DMA(kn_h + g_ * 4096 + so_kn[1], so_ + (2 * wid + 1) * 1024); M2_DMA(kr_b + g_ * 128 + so_kr, so_ + KN_BYTES + wid * 1024); } while (0)
#define M2_DMA_V(grow, slot) do { const size_t g_ = (size_t)(grow); const int so_ = M2_OFF_V + (slot) * V_BYTES; \
        M2_DMA(v_h + g_ * 4096 + so_v[0], so_ + (2 * wid) * 1024); M2_DMA(v_h + g_ * 4096 + so_v[1], so_ + (2 * wid + 1) * 1024); } while (0)
#define M2_WAIT(n) asm volatile("s_waitcnt vmcnt(" #n ")" ::: "memory")
#define M2_BAR() do { asm volatile("" ::: "memory"); __builtin_amdgcn_s_barrier(); asm volatile("" ::: "memory"); } while (0)
    const size_t real0 = (size_t)b * SEQ, meta0 = (size_t)TREAL + 16 * b;
    M2_DMA_K(meta0, 2); M2_DMA_V(meta0, 2); M2_DMA_K(real0, 0); M2_DMA_V(real0, 0); M2_DMA_K(real0 + 64, 1);
    bf16x8 qr[12];
    { const bf16* qp = Q + (size_t)qrow * 3072 + h * 192 + hi * 8;
#pragma unroll
      for (int d0 = 0; d0 < 12; ++d0) qr[d0] = *reinterpret_cast<const bf16x8*>(qp + d0 * 16); }
    const int xkn = (r32 & 15) << 4, xkr = ((r32 >> 1) & 7) << 4, hb = hi * 16;
    const int vlane = v_rd_base(lane);
#define M2_QKT(P0, P1, slot) do { int xn_ = xkn, xr_ = xkr; asm volatile("" : "+v"(xn_), "+v"(xr_)); const lds_ptr kb_ = lds + M2_OFF_K + (slot) * M2_KSLOT + r32 * 256; const lds_ptr kr_ = lds + M2_OFF_K + (slot) * M2_KSLOT + KN_BYTES + r32 * 128; P0 = f32x16{}; P1 = f32x16{}; \
        _Pragma("unroll") for (int d0 = 0; d0 < 8; ++d0) { const int of_ = (d0 * 32 + hb) ^ xn_; const bf16x8 b0 = *(const __attribute__((address_space(3))) bf16x8*)(kb_ + of_), b1 = *(const __attribute__((address_space(3))) bf16x8*)(kb_ + of_ + 8192); \
            P0 = __builtin_amdgcn_mfma_f32_32x32x16_bf16(b0, qr[d0], P0, 0, 0, 0); P1 = __builtin_amdgcn_mfma_f32_32x32x16_bf16(b1, qr[d0], P1, 0, 0, 0); } \
        _Pragma("unroll") for (int d0 = 0; d0 < 4; ++d0) { const int of_ = (d0 * 32 + hb) ^ xr_; const bf16x8 b0 = *(const __attribute__((address_space(3))) bf16x8*)(kr_ + of_), b1 = *(const __attribute__((address_space(3))) bf16x8*)(kr_ + of_ + 4096); \
            P0 = __builtin_amdgcn_mfma_f32_32x32x16_bf16(b0, qr[8 + d0], P0, 0, 0, 0); P1 = __builtin_amdgcn_mfma_f32_32x32x16_bf16(b1, qr[8 + d0], P1, 0, 0, 0); } } while (0)
#define M2_PV(slot) pv_all(o, (int)(uintptr_t)(lds + M2_OFF_V + (slot) * V_BYTES) + vlane, pa0, pa1, pa2, pa3)
#define M2_RESC(a) do { if (__any((a) < 1.f)) { if (hi == 0) wsf[r32] = (a); asm volatile("s_waitcnt lgkmcnt(0)" ::: "memory"); \
        _Pragma("unroll") for (int d = 0; d < 4; ++d) _Pragma("unroll") for (int r = 0; r < 16; ++r) o[d][r] *= wsf[crow(r, hi)]; } } while (0)
    float m_reg = NEG_BIG, l_reg = 0.f; f32x16 o[4];
#pragma unroll
    for (int d = 0; d < 4; ++d) o[d] = f32x16{};
    f32x16 pA0, pA1, pB0, pB1; float alA = 1.f, alB = 1.f; bf16x8 pa0, pa1, pa2, pa3;
    M2_WAIT(0); M2_BAR();
    if (wave_on) {
        M2_QKT(pA0, pA1, 2);
#pragma unroll
        for (int r = 0; r < 16; ++r) { if (crow(r, hi) >= 16) pA0[r] = NEG_BIG; pA1[r] = NEG_BIG; }
        partialSM(pA0, pA1, m_reg, alA); finishSM(pA0, pA1, alA, l_reg, pa0, pa1, pa2, pa3);
        M2_PV(2);
    }
    M2_BAR();
    M2_DMA_K(real0 + 128, 2); M2_DMA_V(real0 + 64, 1);
    if (wave_on) { M2_QKT(pA0, pA1, 0); partialSM(pA0, pA1, m_reg, alA); M2_RESC(alA); }
    int ks = 1, vs = 0;
    for (int j = 1; j < 64; j += 2) {
        if (j < 62) M2_WAIT(5); else M2_WAIT(0);
        M2_BAR();
        { const int kn2 = ks == 0 ? 2 : ks - 1;
          const int vn1 = vs == 0 ? 2 : vs - 1;
          if (j + 2 < 64) M2_DMA_K(real0 + (size_t)(j + 2) * 64, kn2);
          if (j + 1 < 64) M2_DMA_V(real0 + (size_t)(j + 1) * 64, vn1); }
        if (wave_on) { SBAR(); M2_QKT(pB0, pB1, ks); finishSM(pA0, pA1, alA, l_reg, pa0, pa1, pa2, pa3); SBAR(); M2_PV(vs); partialSM(pB0, pB1, m_reg, alB); M2_RESC(alB); }
        ks = ks == 2 ? 0 : ks + 1; vs = vs == 2 ? 0 : vs + 1;
        if (j + 1 < 64) {
            if (j + 1 < 62) M2_WAIT(5); else M2_WAIT(0);
            M2_BAR();
            { const int kn2 = ks == 0 ? 2 : ks - 1; const int vn1 = vs == 0 ? 2 : vs - 1;
              if (j + 3 < 64) M2_DMA_K(real0 + (size_t)(j + 3) * 64, kn2);
              if (j + 2 < 64) M2_DMA_V(real0 + (size_t)(j + 2) * 64, vn1); }
            if (wave_on) { SBAR(); M2_QKT(pA0, pA1, ks); finishSM(pB0, pB1, alB, l_reg, pa0, pa1, pa2, pa3); SBAR(); M2_PV(vs); partialSM(pA0, pA1, m_reg, alA); M2_RESC(alA); }
            ks = ks == 2 ? 0 : ks + 1; vs = vs == 2 ? 0 : vs + 1;
        }
    }
    M2_WAIT(0); M2_BAR();
    if (wave_on) {
        finishSM(pB0, pB1, alB, l_reg, pa0, pa1, pa2, pa3); M2_PV(vs);
        if (hi == 0) wsf[32 + r32] = l_reg; asm volatile("s_waitcnt lgkmcnt(0)" ::: "memory");
        const int orow0 = metaq ? (TREAL + 16 * b) : (b * SEQ + qb * 256 + wid * 32);
#pragma unroll
        for (int r = 0; r < 16; ++r) { const int rw = crow(r, hi); const float rl = __builtin_amdgcn_rcpf(wsf[32 + rw]);
            if (!metaq || rw < 16) { bf16* op = OAB + (size_t)(orow0 + rw) * 4096 + h * 128 + r32;
#pragma unroll
                for (int d0 = 0; d0 < 4; ++d0) op[d0 * 32] = (bf16)(cvtpk(o[d0][r] * rl, 0.f) & 0xffffu); } }
    }
    M2_BAR();
#undef M2_DMA
#undef M2_DMA_K
#undef M2_DMA_V
#undef M2_WAIT
#undef M2_BAR
#undef M2_QKT
#undef M2_PV
#undef M2_RESC
}
}
namespace att {
constexpr int M3_NT = 65;
__device__ __forceinline__ void softmax_seg(f32x16& p0, f32x16& p1, float& m_reg, float& l_reg, float& alpha, bf16x8& pa0, bf16x8& pa1, bf16x8& pa2, bf16x8& pa3) {
    float pmax = p0[0];
#pragma unroll
    for (int r = 1; r < 16; ++r) pmax = fmaxf(pmax, p0[r]);
#pragma unroll
    for (int r = 0; r < 16; ++r) pmax = fmaxf(pmax, p1[r]);
    { auto rr = __builtin_amdgcn_permlane32_swap(__float_as_uint(pmax), __float_as_uint(pmax), false, false); pmax = fmaxf(__uint_as_float(rr[0]), __uint_as_float(rr[1])); }
    if (__builtin_expect(__all(pmax - m_reg <= THR2), 1)) { alpha = 1.f; }
    else { const float mn = fmaxf(m_reg, pmax); alpha = __builtin_amdgcn_exp2f(m_reg - mn); m_reg = mn; }
    const float mn = m_reg; float ps = 0.f;
#pragma unroll
    for (int r = 0; r < 16; ++r) { p0[r] = __builtin_amdgcn_exp2f(p0[r] - mn); ps += p0[r]; }
#pragma unroll
    for (int r = 0; r < 16; ++r) { p1[r] = __builtin_amdgcn_exp2f(p1[r] - mn); ps += p1[r]; }
    { auto rr = __builtin_amdgcn_permlane32_swap(__float_as_uint(ps), __float_as_uint(ps), false, false); ps = __uint_as_float(rr[0]) + __uint_as_float(rr[1]); }
    l_reg = l_reg * alpha + ps;
#define PK4(P, BASE, OUT) do { unsigned a0 = cvtpk(P[BASE + 0], P[BASE + 1]), a1 = cvtpk(P[BASE + 2], P[BASE + 3]);   \
    unsigned b0 = cvtpk(P[BASE + 4], P[BASE + 5]), b1 = cvtpk(P[BASE + 6], P[BASE + 7]);                              \
    auto r0 = __builtin_amdgcn_permlane32_swap(a0, b0, false, false); auto r1 = __builtin_amdgcn_permlane32_swap(a1, b1, false, false); \
    u32x4 w = {r0[0], r1[0], r0[1], r1[1]}; OUT = *reinterpret_cast<bf16x8*>(&w); } while (0)
    PK4(p0, 0, pa0); PK4(p0, 8, pa1); PK4(p1, 0, pa2); PK4(p1, 8, pa3);
#undef PK4
}

__device__ __forceinline__ void mla_unit3(lds_ptr lds, const bf16* __restrict__ Q, const bf16* __restrict__ KN, const bf16* __restrict__ KR, const bf16* __restrict__ V, bf16* __restrict__ OAB, int b, int h, int qb) {
    int tid_ = threadIdx.x; asm volatile("" : "+v"(tid_)); const int tid = tid_, lane = tid & 63, r32 = lane & 31, hi = lane >> 5; const int wid = __builtin_amdgcn_readfirstlane(tid >> 6);
    const bool metaq = (qb == 16);
    const bool wave_on = !metaq || wid == 0;
    const int qrow = metaq ? (TREAL + 16 * b + (r32 & 15)) : (b * SEQ + qb * 256 + wid * 32 + r32);
    __attribute__((address_space(3))) float* wsf = (__attribute__((address_space(3))) float*)(lds + M2_OFF_WS) + wid * 64;
    unsigned so_kn[2], so_kr, so_v[2];
#pragma unroll
    for (int i = 0; i < 2; ++i) { const int P = 2 * wid + i;
        { const int row = 4 * P + (lane >> 4), c = (lane & 15) ^ (row & 15); so_kn[i] = (unsigned)(row * 4096 + c * 16); }
        { const int q = 64 * P + lane, s = q >> 5, kk = (s >> 2) * 8 + ((q & 31) >> 2), col = (s & 3) * 32 + (q & 3) * 8, k = (kk & ~0xC) | ((kk & 4) << 1) | ((kk & 8) >> 1); so_v[i] = (unsigned)(k * 4096 + col * 2); } }
    { const int row = 8 * wid + (lane >> 3), c = (lane & 7) ^ ((row >> 1) & 7); so_kr = (unsigned)(row * 128 + c * 16); }
    const char* const kn_h = (const char*)KN + h * 256; const char* const v_h = (const char*)V + h * 256; const char* const kr_b = (const char*)KR;
    const size_t real0 = (size_t)b * SEQ, meta0 = (size_t)TREAL + 16 * b;
#define M3_ROW(t) ((t) == 0 ? meta0 : real0 + (size_t)((t) - 1) * 64)
#define M3_DMA(src, dstoff) __builtin_amdgcn_global_load_lds((const unsigned*)(src), (__attribute__((address_space(3))) unsigned*)(lds + (dstoff)), 16, 0, 0)
#define M3_DMA_K(t, slot) do { const size_t g_ = M3_ROW(t); const int so_ = M2_OFF_K + (slot) * M2_KSLOT; \
        M3_DMA(kn_h + g_ * 4096 + so_kn[0], so_ + (2 * wid) * 1024); M3_DMA(kn_h + g_ * 4096 + so_kn[1], so_ + (2 * wid + 1) * 1024); M3_DMA(kr_b + g_ * 128 + so_kr, so_ + KN_BYTES + wid * 1024); } while (0)
#define M3_DMA_V(t, slot) do { const size_t g_ = M3_ROW(t); const int so_ = M2_OFF_V + (slot) * V_BYTES; \
        M3_DMA(v_h + g_ * 4096 + so_v[0], so_ + (2 * wid) * 1024); M3_DMA(v_h + g_ * 4096 + so_v[1], so_ + (2 * wid + 1) * 1024); } while (0)
#define M3_WAIT(n) asm volatile("s_waitcnt vmcnt(" #n ")" ::: "memory")
#define M3_BAR() do { asm volatile("" ::: "memory"); __builtin_amdgcn_s_barrier(); asm volatile("" ::: "memory"); } while (0)
#define M3_EVENT(i, s3) do { if ((i) + 2 < M3_NT) M3_DMA_K((i) + 2, (s3) == 0 ? 2 : (s3) - 1); if ((i) + 1 < M3_NT) M3_DMA_V((i) + 1, (s3) == 2 ? 0 : (s3) + 1); } while (0)
#define M3_WAITI(i) do { if ((i) < M3_NT - 2) M3_WAIT(5); else M3_WAIT(0); } while (0)
    M3_DMA_K(0, 0); M3_DMA_V(0, 0); M3_DMA_K(1, 1);
    bf16x8 qr[12];
    { const bf16* qp = Q + (size_t)qrow * 3072 + h * 192 + hi * 8;
#pragma unroll
      for (int d0 = 0; d0 < 12; ++d0) qr[d0] = *reinterpret_cast<const bf16x8*>(qp + d0 * 16); }
    const int xkn = (r32 & 15) << 4, xkr = ((r32 >> 1) & 7) << 4, hb = hi * 16;
    const int vlane = v_rd_base(lane);
#define M3_KLD(d, A0, A1) do { if ((d) < 8) { const int of_ = (((d) * 32 + hb) ^ xn_); A0 = *(const __attribute__((address_space(3))) bf16x8*)(kb_ + of_); A1 = *(const __attribute__((address_space(3))) bf16x8*)(kb_ + of_ + 8192); } \
        else { const int of_ = ((((d) - 8) * 32 + hb) ^ xr_); A0 = *(const __attribute__((address_space(3))) bf16x8*)(kr_ + of_); A1 = *(const __attribute__((address_space(3))) bf16x8*)(kr_ + of_ + 4096); } } while (0)
#define M3_KMM(d, A0, A1) do { p0 = __builtin_amdgcn_mfma_f32_32x32x16_bf16(A0, qr[d], p0, 0, 0, 0); p1 = __builtin_amdgcn_mfma_f32_32x32x16_bf16(A1, qr[d], p1, 0, 0, 0); } while (0)
#define M3_QKT(slot) do { int xn_ = xkn, xr_ = xkr; asm volatile("" : "+v"(xn_), "+v"(xr_)); const lds_ptr kb_ = lds + M2_OFF_K + (slot) * M2_KSLOT + r32 * 256; const lds_ptr kr_ = lds + M2_OFF_K + (slot) * M2_KSLOT + KN_BYTES + r32 * 128; p0 = f32x16{}; p1 = f32x16{}; \
        bf16x8 k0a, k0b, k1a, k1b, k2a, k2b, k3a, k3b; \
        M3_KLD(0, k0a, k0b); M3_KLD(1, k1a, k1b); M3_KLD(2, k2a, k2b); M3_KLD(3, k3a, k3b); SBAR(); \
        M3_KMM(0, k0a, k0b); M3_KLD(4, k0a, k0b); SBAR(); M3_KMM(1, k1a, k1b); M3_KLD(5, k1a, k1b); SBAR(); M3_KMM(2, k2a, k2b); M3_KLD(6, k2a, k2b); SBAR(); M3_KMM(3, k3a, k3b); M3_KLD(7, k3a, k3b); SBAR(); \
        M3_KMM(4, k0a, k0b); M3_KLD(8, k0a, k0b); SBAR(); M3_KMM(5, k1a, k1b); M3_KLD(9, k1a, k1b); SBAR(); M3_KMM(6, k2a, k2b); M3_KLD(10, k2a, k2b); SBAR(); M3_KMM(7, k3a, k3b); M3_KLD(11, k3a, k3b); SBAR(); \
        M3_KMM(8, k0a, k0b); SBAR(); M3_KMM(9, k1a, k1b); SBAR(); M3_KMM(10, k2a, k2b); SBAR(); M3_KMM(11, k3a, k3b); } while (0)
#define M3_PV(slot) pv_all(o, (int)(uintptr_t)(lds + M2_OFF_V + (slot) * V_BYTES) + vlane, pa0, pa1, pa2, pa3)
#define M3_X(j, s3) do { if (wave_on) { M3_QKT(s3); if ((j) > 0) M3_PV((s3) == 0 ? 2 : (s3) - 1); } } while (0)
#define M3_Y(j) do { if (wave_on) { if ((j) == 0) { _Pragma("unroll") for (int r = 0; r < 16; ++r) { if (crow(r, hi) >= 16) p0[r] = NEG_BIG; p1[r] = NEG_BIG; } } \
        float alpha_; softmax_seg(p0, p1, m_reg, l_reg, alpha_, pa0, pa1, pa2, pa3); \
        if (__any(alpha_ < 1.f)) { if (hi == 0) wsf[r32] = alpha_; asm volatile("s_waitcnt lgkmcnt(0)" ::: "memory"); \
            _Pragma("unroll") for (int d = 0; d < 4; ++d) _Pragma("unroll") for (int r = 0; r < 16; ++r) o[d][r] *= wsf[crow(r, hi)]; } } } while (0)
    float m_reg = NEG_BIG, l_reg = 0.f; f32x16 o[4];
#pragma unroll
    for (int d = 0; d < 4; ++d) o[d] = f32x16{};
    f32x16 p0, p1; bf16x8 pa0, pa1, pa2, pa3;
    int s3 = 0;
    if (wid < 4) {
        for (int j = 0; j < M3_NT; ++j) {
            M3_WAITI(j); M3_BAR(); M3_EVENT(j, s3);
            M3_X(j, s3);
            M3_BAR();
            M3_Y(j);
            s3 = s3 == 2 ? 0 : s3 + 1;
        }
        M3_BAR();
        if (wave_on) M3_PV(s3 == 0 ? 2 : s3 - 1);
        M3_BAR();
    } else {
        M3_WAITI(0); M3_BAR(); M3_EVENT(0, 0);
        for (int j = 0; j < M3_NT; ++j) {
            M3_BAR();
            M3_X(j, s3);
            M3_WAITI(j + 1); M3_BAR(); { const int s3n = s3 == 2 ? 0 : s3 + 1; M3_EVENT(j + 1, s3n); }
            M3_Y(j);
            s3 = s3 == 2 ? 0 : s3 + 1;
        }
        M3_BAR();
        if (wave_on) M3_PV(s3 == 0 ? 2 : s3 - 1);
    }
    if (wave_on) {
        if (hi == 0) wsf[32 + r32] = l_reg; asm volatile("s_waitcnt lgkmcnt(0)" ::: "memory");
        const int orow0 = metaq ? (TREAL + 16 * b) : (b * SEQ + qb * 256 + wid * 32);
#pragma unroll
        for (int r = 0; r < 16; ++r) { const int rw = crow(r, hi); const float rl = __builtin_amdgcn_rcpf(wsf[32 + rw]);
            if (!metaq || rw < 16) { bf16* op = OAB + (size_t)(orow0 + rw) * 4096 + h * 128 + r32;
#pragma unroll
                for (int d0 = 0; d0 < 4; ++d0) op[d0 * 32] = (bf16)(cvtpk(o[d0][r] * rl, 0.f) & 0xffffu); } }
    }
    M3_WAIT(0); M3_BAR();
#undef M3_ROW
#undef M3_DMA
#undef M3_DMA_K
#undef M3_DMA_V
#undef M3_WAIT
#undef M3_BAR
#undef M3_EVENT
#undef M3_WAITI
#undef M3_QKT
#undef M3_KLD
#undef M3_KMM
#undef M3_PV
#undef M3_X
#undef M3_Y
}
}
constexpr int NWAVES = 8;
constexpr int N_PHASES = 20;
constexpr size_t MiB = 1u << 20, KiB32 = 32768;
constexpr size_t WS_CTL = 0, CTL_ZERO_BYTES = 65536;
constexpr size_t WS_CS = 1 * MiB, WS_SN = WS_CS + 540672;
constexpr size_t WS_BIAS = 3 * MiB;
constexpr size_t WS_SINK = WS_BIAS + 32768;
constexpr size_t WS_WHIST = WS_BIAS + 65536;
constexpr size_t WS_TOPI = 4 * MiB, WS_TOPG = WS_TOPI + 262144, WS_TOKSLOT = WS_TOPG + 262144;
constexpr size_t WS_SLOTTOK = 5 * MiB, WS_SLOTGATE = WS_SLOTTOK + 294912;
constexpr size_t WS_SSQ = 6 * MiB;
constexpr size_t WS_HB = 9 * MiB;
constexpr size_t WS_W = 138 * MiB;
constexpr size_t WL_IN = 0, WL_UQ = 34 * MiB, WL_UKV = WL_UQ + 9 * MiB / 2, WL_AB = WL_UKV + 4 * MiB, WL_OUT = WL_AB + 16 * MiB, WL_STRIDE = WL_OUT + 8 * MiB;
constexpr size_t WS_WF13 = WS_W + 2 * WL_STRIDE, WS_WF2 = WS_WF13 + 44 * MiB, WS_WEND = WS_WF2 + 22 * MiB;
constexpr size_t AR = 337 * MiB;
constexpr size_t WS_CQ = AR, WS_CKV = WS_CQ + 1548 * KiB32, WS_KR = WS_CKV + 1032 * KiB32, WS_QB = WS_KR + 132 * KiB32;
constexpr size_t WS_KB = WS_QB + 129 * MiB, WS_VB = WS_KB + 1032 * KiB32, WS_GR = WS_VB + 1032 * KiB32, WS_GBB = WS_GR + 129 * MiB;
constexpr size_t WS_Q = WS_GBB + 129 * MiB, WS_KN = WS_Q + 6192 * KiB32  , WS_V = WS_KN + 129 * MiB, WS_OAB = WS_V + 129 * MiB, WS_MIX_END = WS_OAB + 258 * MiB;
constexpr size_t WS_MG = WS_Q;
constexpr size_t WS_X = WS_OAB;
constexpr size_t WS_ACT = AR;
constexpr size_t WS_MW13 = 138 * MiB, WS_MW2 = WS_MW13 + 8 * 44 * MiB;
constexpr size_t WS_MACT = WS_MW2 + 8 * 22 * MiB;
constexpr size_t WS_Y = WS_MACT + 726 * MiB;
constexpr size_t WS_END = WS_Y + 264 * MiB;
static_assert(WS_MIX_END <= 1700 * MiB && WS_END <= 1700 * MiB, "d_ws map");
static_assert(WS_ACT + (size_t)TP * DFF * 2 <= WS_X, "dense ACT vs X");
static_assert(WS_SSQ + (size_t)TP * 20 * 4 <= WS_HB && WS_SLOTGATE + 294912 <= WS_SSQ && WS_TOKSLOT + 262144 <= WS_SLOTTOK && WS_SN + 540672 <= WS_BIAS, "small tables");
static_assert(WS_KR + (size_t)TP * 64 * 2 <= WS_QB, "KR");
constexpr int CW_TMO = 0, CW_CODE = 1;
constexpr int CW_MOE_TS = 64;
constexpr int CW_BAR = 4096;
constexpr int RING_OFF = 0, RING_BYTES = 131072;
constexpr int LDSCTL_OFF = RING_BYTES, MISC_OFF = LDSCTL_OFF + 320, PT_OFF = LDSCTL_OFF + 512;
constexpr int LDS_BYTES = 147456;
static_assert(att::ATT_LDS_BYTES <= RING_BYTES && att::M2_LDS_BYTES <= RING_BYTES, "attention LDS");

#define GAS __attribute__((address_space(1)))
#define LAS __attribute__((address_space(3)))
typedef unsigned short bf16;
typedef unsigned v4u __attribute__((ext_vector_type(4)));
typedef unsigned v2u __attribute__((ext_vector_type(2)));
typedef float f32x4 __attribute__((ext_vector_type(4)));
typedef GAS unsigned gu32;
#define RLX_AGENT __ATOMIC_RELAXED, __HIP_MEMORY_SCOPE_AGENT
#define LDS_WAIT() asm volatile("s_waitcnt lgkmcnt(0)" ::: "memory")
#define VM_WAIT() asm volatile("s_waitcnt vmcnt(0)" ::: "memory")
__device__ __forceinline__ unsigned f2bf(float f) { unsigned u = __builtin_bit_cast(unsigned, f); return (u + 0x7fffu + ((u >> 16) & 1u)) >> 16; }
__device__ __forceinline__ unsigned pk2(float lo, float hi) { return f2bf(lo) | (f2bf(hi) << 16); }

#define XB_TMO      128
#define XB_XCNT(j)  (256  + 64 * (j))
#define XB_XSUB(j)  (1280 + 64 * (j))
#define XB_XGEN(j)  (2304 + 64 * (j))
#define XB_TOP      3328
#define XB_TOPGEN   3392
#define XCD_BAR_WORDS 3456
#define XB_SPIN_CAP (1u << 22)
__device__ __forceinline__ unsigned xb_ld(unsigned* p)              { return __hip_atomic_load(p, __ATOMIC_RELAXED, __HIP_MEMORY_SCOPE_AGENT); }
__device__ __forceinline__ unsigned xb_add(unsigned* p, unsigned v) { return __hip_atomic_fetch_add(p, v, __ATOMIC_RELAXED, __HIP_MEMORY_SCOPE_AGENT); }
__device__ __forceinline__ unsigned xb_xcc_id() { return (unsigned)__builtin_amdgcn_s_getreg((3 << 11) | 20) & 0xFu; }
#define XB_SPIN(cond, bar) do { unsigned _sp = 0; while (cond) { __builtin_amdgcn_s_sleep(1); \
    if ((++_sp & 255u) == 0u) { if (xb_ld(&(bar)[XB_TMO])) break; if (_sp > XB_SPIN_CAP) { atomicAdd(&(bar)[XB_TMO], 1u); break; } } } } while (0)
struct XcdBarrier { unsigned* bar; unsigned x; volatile LAS unsigned* st; };
__device__ __forceinline__ XcdBarrier xcd_barrier_post(unsigned* bar, volatile LAS unsigned* st) {
    XcdBarrier b; b.bar = bar; b.x = xb_xcc_id(); b.st = st;
    if (threadIdx.x == 0) (void)xb_add(&bar[XB_XCNT(b.x)], 1u);
    return b;
}
__device__ __forceinline__ void xcd_barrier_complete(unsigned* bar, unsigned x, unsigned& nloc, unsigned& nx) {
    const unsigned G = gridDim.x * gridDim.y * gridDim.z;
    unsigned sum, cnt, mine, sp = 0u;
    for (;;) {
        sum = 0u; cnt = 0u; mine = 0u;
#pragma unroll
        for (unsigned j = 0; j < 16; ++j) { const unsigned c = xb_ld(&bar[XB_XCNT(j)]); sum += c; cnt += (c > 0u) ? 1u : 0u; mine = (j == x) ? c : mine; }
        if (sum == G) break;
        __builtin_amdgcn_s_sleep(1);
        if ((++sp & 255u) == 0u) { if (xb_ld(&bar[XB_TMO])) break; if (sp > XB_SPIN_CAP) { atomicAdd(&bar[XB_TMO], 1u); break; } }
    }
    nloc = mine > 0u ? mine : 1u; nx = cnt > 0u ? cnt : 1u;
}
__device__ __forceinline__ void xcd_barrier(const XcdBarrier& b) {
    asm volatile("s_waitcnt vmcnt(0)" ::: "memory");
    __syncthreads();
    if (threadIdx.x == 0) {
        unsigned* bar = b.bar;
        __builtin_amdgcn_s_waitcnt(0);
        unsigned nloc = b.st[0], nx = b.st[1];
        if (nloc == 0u) { xcd_barrier_complete(bar, b.x, nloc, nx); b.st[0] = nloc; b.st[1] = nx; }
        const unsigned old = xb_add(&bar[XB_XSUB(b.x)], 1u);
        const unsigned gen = old / nloc;
        if (old + 1u == (gen + 1u) * nloc) {
            __builtin_amdgcn_fence(__ATOMIC_RELEASE, "agent");
            asm volatile("s_waitcnt vmcnt(0)" ::: "memory");
            const unsigned og = xb_add(&bar[XB_TOP], 1u);
            const unsigned tg = og / nx;
            if (og + 1u == (tg + 1u) * nx) xb_add(&bar[XB_TOPGEN], 1u);
            else XB_SPIN(xb_ld(&bar[XB_TOPGEN]) == tg, bar);
            __builtin_amdgcn_fence(__ATOMIC_ACQUIRE, "agent");
            xb_add(&bar[XB_XGEN(b.x)], 1u);
            asm volatile("s_waitcnt vmcnt(0)" ::: "memory");
        } else {
            XB_SPIN(xb_ld(&bar[XB_XGEN(b.x)]) == gen, bar);
            __builtin_amdgcn_fence(__ATOMIC_ACQUIRE, "agent");
            asm volatile("s_waitcnt vmcnt(0)" ::: "memory");
        }
    }
    __syncthreads();
}

__device__ __forceinline__ float wave_sum(float v) {
#pragma unroll
    for (int o = 1; o < 64; o <<= 1) v += __shfl_xor(v, o);
    return v;
}
__device__ __forceinline__ void transpose_item(const float* __restrict__ W, int ldw, int k0, int n0, bf16* __restrict__ WT, size_t ldt, int drow, int koff, const float* __restrict__ g, LAS float* scr, int lane) {
    const int kr = lane >> 3, c4 = (lane & 7) * 4;
    f32x4 v[8];
#pragma unroll
    for (int i = 0; i < 8; ++i) v[i] = *(const GAS f32x4*)(W + (size_t)(k0 + 8 * i + kr) * ldw + n0 + c4);
    if (g) {
#pragma unroll
        for (int i = 0; i < 8; ++i) v[i] = v[i] * g[k0 + 8 * i + kr]; }
#pragma unroll
    for (int i = 0; i < 8; ++i) { LAS float* d = scr + (8 * i + kr) * 33 + c4; d[0] = v[i].x; d[1] = v[i].y; d[2] = v[i].z; d[3] = v[i].w; }
    LDS_WAIT(); asm volatile("" ::: "memory");
    const int c = lane & 7;
#pragma unroll
    for (int j = 0; j < 4; ++j) { const int n = (lane >> 3) + 8 * j; const LAS float* s = scr + (8 * c) * 33 + n;
        v4u o; o.x = pk2(s[0 * 33], s[1 * 33]); o.y = pk2(s[2 * 33], s[3 * 33]); o.z = pk2(s[4 * 33], s[5 * 33]); o.w = pk2(s[6 * 33], s[7 * 33]);
        *(GAS v4u*)(WT + (size_t)(drow + n) * ldt + koff + k0 + 8 * c) = o; }
    LDS_WAIT(); asm volatile("" ::: "memory");
}
__device__ __forceinline__ int dmap_in(int n0) {
    if (n0 < 1280) return n0;
    if (n0 < 1312) return 1280;
    if (n0 < 1344) return 1280 + 128;
    if (n0 < 3392) return 1536 + (n0 - 1344);
    if (n0 < 3904) return 3584 + (n0 - 3392);
    if (n0 < 4416) return 4096 + (n0 - 3904);
    if (n0 < 6464) { const int a = n0 - 4416; return 4608 + 256 * (a >> 7) + (a & 127); }
    const int a = n0 - 6464; return 4608 + 256 * (a >> 7) + 128 + (a & 127);
}
__device__ __forceinline__ int dmap_uq(int n0) {
    const int head = n0 / 192, off = n0 - head * 192;
    if (off < 128) return 256 * (head >> 1) + 128 * (head & 1) + off;
    if (off < 160) return 256 * (8 + (head >> 2)) + 32 * (head & 3);
    return 256 * (8 + (head >> 2)) + 128 + 32 * (head & 3);
}
__device__ __forceinline__ int dmap_glu(int n0) { return 256 * (n0 >> 7) + (n0 & 127); }
struct Row8 { f32x4 v[8]; };
__device__ __forceinline__ void ln_normalize(Row8& r) {
    float s = 0.f;
#pragma unroll
    for (int j = 0; j < 8; ++j) s += (r.v[j].x + r.v[j].y) + (r.v[j].z + r.v[j].w);
    const float mean = wave_sum(s) * (1.f / D); float s2 = 0.f;
#pragma unroll
    for (int j = 0; j < 8; ++j) { r.v[j] = r.v[j] - mean; s2 += (r.v[j].x * r.v[j].x + r.v[j].y * r.v[j].y) + (r.v[j].z * r.v[j].z + r.v[j].w * r.v[j].w); }
    const float rstd = 1.f / sqrtf(wave_sum(s2) * (1.f / D) + LN_EPS);
#pragma unroll
    for (int j = 0; j < 8; ++j) r.v[j] = r.v[j] * rstd;
}
__device__ __forceinline__ void ln_affine(Row8& r, const float* __restrict__ g, const float* __restrict__ b, int lane) {
#pragma unroll
    for (int j = 0; j < 8; ++j) { const f32x4 gg = *((const f32x4*)g + lane + 64 * j), bb = *((const f32x4*)b + lane + 64 * j); r.v[j] = r.v[j] * gg + bb; }
}
__device__ __forceinline__ void row_store_bf16(const Row8& r, bf16* orow, int lane) {
    GAS v2u* o8 = (GAS v2u*)orow + lane;
#pragma unroll
    for (int j = 0; j < 8; ++j) { v2u w; w.x = pk2(r.v[j].x, r.v[j].y); w.y = pk2(r.v[j].z, r.v[j].w); o8[64 * j] = w; }
}
__device__ __forceinline__ void row_load_f32(Row8& r, const float* xrow, int lane) {
#pragma unroll
    for (int j = 0; j < 8; ++j) r.v[j] = *((const GAS f32x4*)xrow + lane + 64 * j);
}
__device__ __forceinline__ f32x4 bf4(v2u w);
__device__ __forceinline__ void row_load_bf16(Row8& r, const bf16* xrow, int lane) {
#pragma unroll
    for (int j = 0; j < 8; ++j) r.v[j] = bf4(*((const GAS v2u*)xrow + lane + 64 * j));
}
__device__ __forceinline__ f32x4 bf4(v2u w) { return (f32x4){__uint_as_float(w.x << 16), __uint_as_float(w.x & 0xffff0000u), __uint_as_float(w.y << 16), __uint_as_float(w.y & 0xffff0000u)}; }
__device__ __forceinline__ int t5_bucket(int rel) {
    const int n = rel < 0 ? -rel : rel; int v;
    if (n < 8) v = n; else if (n < 12) v = 8; else if (n < 16) v = 9; else if (n < 23) v = 10; else if (n < 32) v = 11; else if (n < 46) v = 12; else if (n < 64) v = 13; else if (n < 91) v = 14; else v = 15;
    return (rel > 0 ? 16 : 0) + v;
}

__device__ __forceinline__ void router_row(const Row8& r, const LAS f32x4* rwl, const float* __restrict__ rbias, int lane, int& i0, int& i1, float& g0, float& g1) {
    float lg[8];
#pragma unroll
    for (int e = 0; e < 8; ++e) lg[e] = 0.f;
#pragma unroll
    for (int j = 0; j < 8; ++j) {
#pragma unroll
        for (int q = 0; q < 4; ++q) { const f32x4 w0 = rwl[(j * 4 + q) * 64 + lane], w1 = rwl[2048 + (j * 4 + q) * 64 + lane]; const float y = r.v[j][q];
            lg[0] += y * w0.x; lg[1] += y * w0.y; lg[2] += y * w0.z; lg[3] += y * w0.w; lg[4] += y * w1.x; lg[5] += y * w1.y; lg[6] += y * w1.z; lg[7] += y * w1.w; } }
#pragma unroll
    for (int e = 0; e < 8; ++e) lg[e] = wave_sum(lg[e]) + rbias[e];
    i0 = 0; float v0 = lg[0];
#pragma unroll
    for (int e = 1; e < 8; ++e) if (lg[e] > v0) { v0 = lg[e]; i0 = e; }
    i1 = -1; float v1 = -3.0e38f;
#pragma unroll
    for (int e = 0; e < 8; ++e) if (e != i0 && lg[e] > v1) { v1 = lg[e]; i1 = e; }
    const float e1 = __expf(v1 - v0); g0 = 1.f / (1.f + e1); g1 = e1 / (1.f + e1);
}
enum { I_X = 0, I_META, I_EMB_G, I_EMB_B, I_RELB, I_WIN, I_QNG, I_KVNG, I_WUQ, I_WUKV, I_SINK, I_WPA, I_WPB, I_WOUT, I_LMG, I_LMB, I_LFG, I_LFB,
       I_FW1, I_FW3, I_FW2, I_RW, I_RB, I_MW1, I_MW3, I_MW2, N_IN };
struct Args { const float* in[N_IN]; float* out; unsigned char* ws; int ph_lo, ph_hi; };

__global__ void __launch_bounds__(NWAVES * 64, 2) mk_fwd(Args args) {
    extern __shared__ __attribute__((aligned(16))) unsigned char lds_raw[];
    LAS unsigned char* const lds = (LAS unsigned char*)lds_raw;
    char* const ldsg = (char*)lds_raw;
    volatile LAS unsigned* const MISC = (volatile LAS unsigned*)(lds + MISC_OFF);
    const int tid_k = threadIdx.x; const int tid = tid_k, lane = tid & 63, wave = __builtin_amdgcn_readfirstlane(tid >> 6);
    const int G_k = gridDim.x; const int bx_k = blockIdx.x;
    for (int u = tid; u < (LDS_BYTES - LDSCTL_OFF) / 4; u += NWAVES * 64) ((LAS unsigned*)(lds + LDSCTL_OFF))[u] = 0u;
    __syncthreads();
    volatile LAS unsigned long long* const PT = (volatile LAS unsigned long long*)(lds + PT_OFF);
    if (tid == 0) {
#pragma unroll
        for (int i = 0; i < N_IN; ++i) PT[i] = (unsigned long long)args.in[i];
        PT[N_IN] = (unsigned long long)args.out; PT[N_IN + 1] = (unsigned long long)args.ws; }
    const int lo = args.ph_lo, hi = args.ph_hi;
    __syncthreads();
#define LDP(i) ({ const unsigned long long v_ = PT[i]; (unsigned long long)(unsigned)__builtin_amdgcn_readfirstlane((int)(unsigned)v_) | ((unsigned long long)(unsigned)__builtin_amdgcn_readfirstlane((int)(unsigned)(v_ >> 32)) << 32); })
#define INP(i) ((const float*)(const GAS float*)LDP(i))
#define WSP() ((unsigned char*)(GAS unsigned char*)LDP(N_IN + 1))
#define OUTP() ((float*)(GAS float*)LDP(N_IN))
#define PH_WS() asm volatile("" ::: "memory"); int tid = tid_k; asm volatile("" : "+v"(tid)); const int lane = tid & 63; (void)lane; \
    int G = G_k, bx = bx_k; asm volatile("" : "+s"(G), "+s"(bx));     \
    const int vcu = (G % 8 == 0) ? (bx % 8) * (G / 8) + bx / 8 : bx; const int gw = vcu * NWAVES + wave, NGW = G * NWAVES; (void)gw; (void)NGW; (void)vcu; unsigned char* const ws = WSP(); \
    bf16* const HB = (bf16*)(ws + WS_HB); float* const CS = (float*)(ws + WS_CS); float* const SN = (float*)(ws + WS_SN); float* const SSQ = (float*)(ws + WS_SSQ); bf16* const X = (bf16*)(ws + WS_X); \
    (void)HB; (void)CS; (void)SN; (void)SSQ; (void)X
    XcdBarrier bar; { unsigned char* const ws0 = WSP(); bar.bar = (unsigned*)(ws0 + WS_CTL) + CW_BAR; bar.x = 0; bar.st = nullptr;
    if (hi - lo > 1) bar = xcd_barrier_post((unsigned*)(ws0 + WS_CTL) + CW_BAR, MISC + 8); }
#ifndef PHMASK
#define PHMASK 0xFFFF
#endif
#define KEN(kind) ((PHMASK >> (kind)) & 1)
#ifndef REPMASK
#define REPMASK 0
#endif
#define NREP(kind) (((REPMASK >> (kind)) & 1) ? 2 : 1)
#define IN(k) (lo <= (k) && (k) < hi)
#define SEAM(k) do { if (IN(k) && IN((k) + 1)) xcd_barrier(bar); } while (0)

    for (int rep_ = 0; rep_ < NREP(0); ++rep_) if (KEN(0) && IN(0)) { PH_WS(); int* const SLOT_TOK = (int*)(ws + WS_SLOTTOK); float* const SLOT_GATE = (float*)(ws + WS_SLOTGATE); int* const TOK_SLOT = (int*)(ws + WS_TOKSLOT); (void)SLOT_TOK; (void)SLOT_GATE; (void)TOK_SLOT;
        LAS float* scr = (LAS float*)(lds + RING_OFF + wave * 16384);
        constexpr int I_IN = (D / 64) * (INDIM / 32), I_UQ = (QRANK / 64) * (3072 / 32), I_UKV = (KVRANK / 64) * (4096 / 32), I_SQ = (D / 64) * (D / 32), I_LAYER = I_IN + I_UQ + I_UKV + 3 * I_SQ;
        constexpr int I_F = (D / 64) * (DFF / 32), I_F2 = (DFF / 64) * (D / 32), NITEMS = 2 * I_LAYER + 2 * I_F + I_F2;
        for (int it = gw; it < NITEMS; it += NGW) {
            int r = it;
            if (r < 2 * I_LAYER) { const int l = r / I_LAYER; r -= l * I_LAYER; unsigned char* wl = ws + WS_W + l * WL_STRIDE;
                if (r < I_IN) { const int nblk = INDIM / 32, kb = r / nblk, nb = r % nblk; transpose_item(INP(I_WIN) + (size_t)l * D * INDIM, INDIM, 64 * kb, 32 * nb, (bf16*)(ws + WS_W + l * WL_STRIDE + WL_IN), D, dmap_in(32 * nb), 0, nullptr, scr, lane); continue; } r -= I_IN;
                if (r < I_UQ) { const int nblk = 3072 / 32, kb = r / nblk, nb = r % nblk; transpose_item(INP(I_WUQ) + (size_t)l * QRANK * 3072, 3072, 64 * kb, 32 * nb, (bf16*)(ws + WS_W + l * WL_STRIDE + WL_UQ), QRANK, dmap_uq(32 * nb), 0, INP(I_QNG) + l * QRANK, scr, lane); continue; } r -= I_UQ;
                if (r < I_UKV) { const int nblk = 4096 / 32, kb = r / nblk, nb = r % nblk; transpose_item(INP(I_WUKV) + (size_t)l * KVRANK * 4096, 4096, 64 * kb, 32 * nb, (bf16*)(ws + WS_W + l * WL_STRIDE + WL_UKV), KVRANK, 32 * nb, 0, INP(I_KVNG) + l * KVRANK, scr, lane); continue; } r -= I_UKV;
                { const int which = r / I_SQ; r -= which * I_SQ; const int nblk = D / 32, kb = r / nblk, nb = r % nblk;
                  if (which == 0) transpose_item(INP(I_WPA) + (size_t)l * D * D, D, 64 * kb, 32 * nb, (bf16*)(ws + WS_W + l * WL_STRIDE + WL_AB), 2 * D, 32 * nb, 0, nullptr, scr, lane);
                  else if (which == 1) transpose_item(INP(I_WPB) + (size_t)l * D * D, D, 64 * kb, 32 * nb, (bf16*)(ws + WS_W + l * WL_STRIDE + WL_AB), 2 * D, 32 * nb, D, nullptr, scr, lane);
                  else transpose_item(INP(I_WOUT) + (size_t)l * D * D, D, 64 * kb, 32 * nb, (bf16*)(ws + WS_W + l * WL_STRIDE + WL_OUT), D, 32 * nb, 0, nullptr, scr, lane);
                  continue; }
            }
            r -= 2 * I_LAYER;
            if (r < 2 * I_F) { const int which = r / I_F; r -= which * I_F; const int nblk = DFF / 32, kb = r / nblk, nb = r % nblk;
                transpose_item(INP(which ? I_FW3 : I_FW1), DFF, 64 * kb, 32 * nb, (bf16*)(ws + WS_WF13), D, dmap_glu(32 * nb) + (which ? 128 : 0), 0, nullptr, scr, lane); continue; }
            r -= 2 * I_F;
            { const int nblk = D / 32, kb = r / nblk, nb = r % nblk; transpose_item(INP(I_FW2), D, 64 * kb, 32 * nb, (bf16*)(ws + WS_WF2), DFF, 32 * nb, 0, nullptr, scr, lane); }
        }
        for (int i = gw * 64 + lane; i < 2 * 192 * 256; i += NGW * 64) { const int l = i / (192 * 256), q = i % (192 * 256), rr = q / 256, c16 = q % 256; const int row = rr < 96 ? 1312 + rr : 1440 + (rr - 96);
            *(GAS v4u*)(ws + WS_W + l * WL_STRIDE + WL_IN + (size_t)row * (D * 2) + c16 * 16) = (v4u){0u, 0u, 0u, 0u}; }
        for (int i = gw * 64 + lane; i < LPOS * 32; i += NGW * 64) { const int pos = i >> 5, k = i & 31; const float inv = powf(10000.f, -(float)(2 * k) / 64.f); const float ang = (float)pos * inv; CS[i] = cosf(ang); SN[i] = sinf(ang); }
        for (int i = gw * 64 + lane; i < 16 * 257; i += NGW * 64) { const int hh = i / 257, rel = i % 257 - 128; ((float*)(ws + WS_BIAS))[i] = INP(I_RELB)[t5_bucket(rel) * 16 + hh] * LOG2E; }
        if (gw == 0 && lane < 32) ((float*)(ws + WS_SINK))[lane] = INP(I_SINK)[lane] * LOG2E;
        { const float* eg = INP(I_EMB_G); const float* eb = INP(I_EMB_B); const float* xin = INP(I_X); const float* min_ = INP(I_META);
#define P0_LOAD(R, m) row_load_f32(R, (m) < TREAL ? xin + (size_t)(m) * D : min_ + (size_t)(((m) - TREAL) & 15) * D, lane)
#define P0_PROC(R, m) do { ln_normalize(R); ln_affine(R, eg, eb, lane); row_store_bf16(R, HB + (size_t)(m) * D, lane); } while (0)
          Row8 ra{}, rb{}; int m = gw; if (m < T) P0_LOAD(ra, m);
          for (; m < T; m += 2 * NGW) { const int m1 = m + NGW, m2 = m + 2 * NGW; if (m1 < T) P0_LOAD(rb, m1); P0_PROC(ra, m); if (m1 < T) { if (m2 < T) P0_LOAD(ra, m2); P0_PROC(rb, m1); } }
#undef P0_LOAD
#undef P0_PROC
          for (int mz = T + gw; mz < TP; mz += NGW) { GAS v2u* o8 = (GAS v2u*)(HB + (size_t)mz * D) + lane;
#pragma unroll
              for (int j = 0; j < 8; ++j) o8[64 * j] = (v2u){0u, 0u}; } }
    }
    SEAM(0);

#pragma unroll 1
    for (int l = 0; l < 2; ++l) {
        const int P = 1 + 9 * l + (l ? 0 : 0);
        const int nM_all = TP / 256;
        const int nM_post = l == 0 ? TP / 256 : TREAL / 256;
        for (int rep_ = 0; rep_ < NREP(1); ++rep_) if (KEN(1) && IN(P + 0)) { PH_WS(); int* const SLOT_TOK = (int*)(ws + WS_SLOTTOK); float* const SLOT_GATE = (float*)(ws + WS_SLOTGATE); int* const TOK_SLOT = (int*)(ws + WS_TOKSLOT); (void)SLOT_TOK; (void)SLOT_GATE; (void)TOK_SLOT;
            ProbDense pr; pr.so.init(nM_all, NIN / 256, G, bx); pr.A = (const char*)HB; pr.Bt = (const char*)(ws + WS_W + l * WL_STRIDE + WL_IN); pr.tstep = 256 * (size_t)D * 2;
            epi::EpiWin E{(bf16*)(ws + WS_CQ), (bf16*)(ws + WS_CKV), (bf16*)(ws + WS_KR), (bf16*)(ws + WS_QB), (bf16*)(ws + WS_KB), (bf16*)(ws + WS_VB), (bf16*)(ws + WS_GR), (bf16*)(ws + WS_GBB), SSQ, CS, SN};
            pg8::gemm_phase<epi::EpiWin, ProbDense>(lds + RING_OFF, D, pr, E);
        }
        SEAM(P + 0);
        for (int rep_ = 0; rep_ < NREP(2); ++rep_) if (KEN(2) && IN(P + 1)) { PH_WS(); int* const SLOT_TOK = (int*)(ws + WS_SLOTTOK); float* const SLOT_GATE = (float*)(ws + WS_SLOTGATE); int* const TOK_SLOT = (int*)(ws + WS_TOKSLOT); (void)SLOT_TOK; (void)SLOT_GATE; (void)TOK_SLOT;
            { ProbDense pr; pr.so.init(nM_all, 3072 / 256, G, bx); pr.A = (const char*)(ws + WS_CQ); pr.Bt = (const char*)(ws + WS_W + l * WL_STRIDE + WL_UQ); pr.tstep = 256 * (size_t)QRANK * 2;
              epi::EpiUq E{(bf16*)(ws + WS_Q), SSQ, CS, SN};
              pg8::gemm_phase<epi::EpiUq, ProbDense>(lds + RING_OFF, QRANK, pr, E); }
            { ProbDense pr; pr.so.init(nM_all, 4096 / 256, G, bx); pr.A = (const char*)(ws + WS_CKV); pr.Bt = (const char*)(ws + WS_W + l * WL_STRIDE + WL_UKV); pr.tstep = 256 * (size_t)KVRANK * 2;
              epi::EpiUkv E{(bf16*)(ws + WS_KN), (bf16*)(ws + WS_V), SSQ};
              pg8::gemm_phase<epi::EpiUkv, ProbDense>(lds + RING_OFF, KVRANK, pr, E); }
        }
        SEAM(P + 1);
        for (int rep_ = 0; rep_ < NREP(3); ++rep_) if (KEN(3) && IN(P + 2)) { PH_WS(); int* const SLOT_TOK = (int*)(ws + WS_SLOTTOK); float* const SLOT_GATE = (float*)(ws + WS_SLOTGATE); int* const TOK_SLOT = (int*)(ws + WS_TOKSLOT); (void)SLOT_TOK; (void)SLOT_GATE; (void)TOK_SLOT;
            const int nqb = l == 0 ? 17 : 16, nmla_full = NB * NH * 16, nmla = NB * NH * nqb;
            for (int rep2_ = 0; rep2_ < NREP(14); ++rep2_)
            for (int u = vcu; u < nmla; u += G) {
                int b, h, qb;
                if (u < nmla_full) { qb = u & 15; h = (u >> 4) & 15; b = u >> 8; } else { const int v = u - nmla_full; qb = 16; h = v & 15; b = v >> 4; }
                att::mla_unit3((att::lds_ptr)(lds + RING_OFF), (const bf16*)(ws + WS_Q), (const bf16*)(ws + WS_KN), (const bf16*)(ws + WS_KR), (const bf16*)(ws + WS_V), (bf16*)(ws + WS_OAB), b, h, qb);
            }
            const int nj = l == 0 ? 65 : 64, nswa_full = NB * 4 * 64, nswa = NB * 4 * nj;
            for (int rep2_ = 0; rep2_ < NREP(15); ++rep2_)
            for (int u = vcu; u < nswa; u += G) {
                int b, hk, j;
                if (u < nswa_full) { j = u & 63; hk = (u >> 6) & 3; b = u >> 8; } else { const int v = u - nswa_full; j = 64; hk = v & 3; b = v >> 2; }
                att::swa_unit(ldsg + RING_OFF, (const bf16*)(ws + WS_QB), (const bf16*)(ws + WS_KB), (const bf16*)(ws + WS_VB), (bf16*)(ws + WS_OAB), (const float*)(ws + WS_BIAS), (const float*)(ws + WS_SINK) + 16 * l, b, hk, j);
            }
        }
        SEAM(P + 2);
        for (int rep_ = 0; rep_ < NREP(4); ++rep_) if (KEN(4) && IN(P + 3)) { PH_WS(); int* const SLOT_TOK = (int*)(ws + WS_SLOTTOK); float* const SLOT_GATE = (float*)(ws + WS_SLOTGATE); int* const TOK_SLOT = (int*)(ws + WS_TOKSLOT); (void)SLOT_TOK; (void)SLOT_GATE; (void)TOK_SLOT;
            ProbDense pr; pr.so.init(nM_post, D / 256, G, bx); pr.A = (const char*)(ws + WS_OAB); pr.Bt = (const char*)(ws + WS_W + l * WL_STRIDE + WL_AB); pr.tstep = 256 * (size_t)(2 * D) * 2;
            epi::EpiProj E{(bf16*)(ws + WS_MG), (const bf16*)(ws + WS_GR), (const bf16*)(ws + WS_GBB)};
            pg8::gemm_phase<epi::EpiProj, ProbDense>(lds + RING_OFF, 2 * D, pr, E);
        }
        SEAM(P + 3);
        for (int rep_ = 0; rep_ < NREP(5); ++rep_) if (KEN(5) && IN(P + 4)) { PH_WS(); int* const SLOT_TOK = (int*)(ws + WS_SLOTTOK); float* const SLOT_GATE = (float*)(ws + WS_SLOTGATE); int* const TOK_SLOT = (int*)(ws + WS_TOKSLOT); (void)SLOT_TOK; (void)SLOT_GATE; (void)TOK_SLOT;
            ProbDense pr; pr.so.init(nM_post, D / 256, G, bx); pr.A = (const char*)(ws + WS_MG); pr.Bt = (const char*)(ws + WS_W + l * WL_STRIDE + WL_OUT); pr.tstep = 256 * (size_t)D * 2;
            epi::EpiResid E{X, HB};
            pg8::gemm_phase<epi::EpiResid, ProbDense>(lds + RING_OFF, D, pr, E);
        }
        SEAM(P + 4);
        for (int rep_ = 0; rep_ < NREP(6); ++rep_) if (KEN(6) && IN(P + 5)) { PH_WS(); int* const SLOT_TOK = (int*)(ws + WS_SLOTTOK); float* const SLOT_GATE = (float*)(ws + WS_SLOTGATE); int* const TOK_SLOT = (int*)(ws + WS_TOKSLOT); (void)SLOT_TOK; (void)SLOT_GATE; (void)TOK_SLOT;
            const float* g = INP(I_LMG) + l * D; const float* bta = INP(I_LMB) + l * D;
            const int nrows = l == 0 ? T : TREAL;
            int h0 = 0, h1 = 0, h2 = 0, h3 = 0, h4 = 0, h5 = 0, h6 = 0, h7 = 0;
            LAS f32x4* const rwl = (LAS f32x4*)(lds + RING_OFF);
            if (l == 1) { const GAS f32x4* rwg = (const GAS f32x4*)INP(I_RW); for (int i = tid; i < D * 2; i += NWAVES * 64) { const int k = i >> 1, hf = i & 1; rwl[hf * 2048 + ((k >> 8) * 4 + (k & 3)) * 64 + ((k >> 2) & 63)] = rwg[i]; } __syncthreads(); }
#define LM_PROC(r, m) do { ln_normalize(r); ln_affine(r, g, bta, lane); row_store_bf16(r, HB + (size_t)(m) * D, lane); \
                if (l == 1) { int i0_, i1_; float g0_, g1_; router_row(r, rwl, rbias, lane, i0_, i1_, g0_, g1_); \
                    if (lane == 0) { int* ti = (int*)(ws + WS_TOPI); float* tg = (float*)(ws + WS_TOPG); ti[2 * (m)] = i0_; ti[2 * (m) + 1] = i1_; tg[2 * (m)] = g0_; tg[2 * (m) + 1] = g1_; } \
                    h0 += (i0_ == 0) + (i1_ == 0); h1 += (i0_ == 1) + (i1_ == 1); h2 += (i0_ == 2) + (i1_ == 2); h3 += (i0_ == 3) + (i1_ == 3); \
                    h4 += (i0_ == 4) + (i1_ == 4); h5 += (i0_ == 5) + (i1_ == 5); h6 += (i0_ == 6) + (i1_ == 6); h7 += (i0_ == 7) + (i1_ == 7); } } while (0)
            { const float* rbias = INP(I_RB); Row8 ra{}, rb{}; int m = gw; if (m < nrows) row_load_bf16(ra, X + (size_t)m * D, lane);
              for (; m < nrows; m += 2 * NGW) { const int m1 = m + NGW, m2 = m + 2 * NGW; if (m1 < nrows) row_load_bf16(rb, X + (size_t)m1 * D, lane); LM_PROC(ra, m);
                  if (m1 < nrows) { if (m2 < nrows) row_load_bf16(ra, X + (size_t)m2 * D, lane); LM_PROC(rb, m1); } } }
#undef LM_PROC
            if (l == 1 && lane == 0) { int* wh = (int*)(ws + WS_WHIST) + gw * 8; wh[0] = h0; wh[1] = h1; wh[2] = h2; wh[3] = h3; wh[4] = h4; wh[5] = h5; wh[6] = h6; wh[7] = h7; }
        }
        SEAM(P + 5);
        if (l == 0) {
            for (int rep_ = 0; rep_ < NREP(7); ++rep_) if (KEN(7) && IN(P + 6)) { PH_WS(); int* const SLOT_TOK = (int*)(ws + WS_SLOTTOK); float* const SLOT_GATE = (float*)(ws + WS_SLOTGATE); int* const TOK_SLOT = (int*)(ws + WS_TOKSLOT); (void)SLOT_TOK; (void)SLOT_GATE; (void)TOK_SLOT;
                ProbDense pr; pr.so.init(nM_all, 2 * DFF / 256, G, bx); pr.A = (const char*)HB; pr.Bt = (const char*)(ws + WS_WF13); pr.tstep = 256 * (size_t)D * 2;
                epi::EpiSwiglu E{(bf16*)(ws + WS_ACT)};
                pg8::gemm_phase<epi::EpiSwiglu, ProbDense>(lds + RING_OFF, D, pr, E);
            }
            SEAM(P + 6);
            for (int rep_ = 0; rep_ < NREP(8); ++rep_) if (KEN(8) && IN(P + 7)) { PH_WS(); int* const SLOT_TOK = (int*)(ws + WS_SLOTTOK); float* const SLOT_GATE = (float*)(ws + WS_SLOTGATE); int* const TOK_SLOT = (int*)(ws + WS_TOKSLOT); (void)SLOT_TOK; (void)SLOT_GATE; (void)TOK_SLOT;
                ProbDense pr; pr.so.init(nM_all, D / 256, G, bx); pr.A = (const char*)(ws + WS_ACT); pr.Bt = (const char*)(ws + WS_WF2); pr.tstep = 256 * (size_t)DFF * 2;
                epi::EpiResid E{X, HB};
                pg8::gemm_phase<epi::EpiResid, ProbDense>(lds + RING_OFF, DFF, pr, E);
            }
            SEAM(P + 7);
            for (int rep_ = 0; rep_ < NREP(9); ++rep_) if (KEN(9) && IN(P + 8)) { PH_WS(); int* const SLOT_TOK = (int*)(ws + WS_SLOTTOK); float* const SLOT_GATE = (float*)(ws + WS_SLOTGATE); int* const TOK_SLOT = (int*)(ws + WS_TOKSLOT); (void)SLOT_TOK; (void)SLOT_GATE; (void)TOK_SLOT;
                const float* g = INP(I_LFG); const float* bta = INP(I_LFB);
#define LF_PROC(r, m) do { ln_normalize(r); ln_affine(r, g, bta, lane); row_store_bf16(r, HB + (size_t)(m) * D, lane); } while (0)
                { Row8 ra{}, rb{}; int m = gw; if (m < T) row_load_bf16(ra, X + (size_t)m * D, lane);
                  for (; m < T; m += 2 * NGW) { const int m1 = m + NGW, m2 = m + 2 * NGW; if (m1 < T) row_load_bf16(rb, X + (size_t)m1 * D, lane); LF_PROC(ra, m);
                      if (m1 < T) { if (m2 < T) row_load_bf16(ra, X + (size_t)m2 * D, lane); LF_PROC(rb, m1); } } }
#undef LF_PROC
            }
            SEAM(P + 8);
        } else {
            for (int rep_ = 0; rep_ < NREP(10); ++rep_) if (KEN(10) && IN(P + 6)) { PH_WS(); int* const SLOT_TOK = (int*)(ws + WS_SLOTTOK); float* const SLOT_GATE = (float*)(ws + WS_SLOTGATE); int* const TOK_SLOT = (int*)(ws + WS_TOKSLOT); (void)SLOT_TOK; (void)SLOT_GATE; (void)TOK_SLOT;
                LAS int* hist = (LAS int*)(lds + RING_OFF);
                LAS int* segsum = hist + 2048 * 8;
                LAS int* segpre = segsum + 64 * 8;
                LAS int* tot = segpre + 64 * 8;
                const int* wh = (const int*)(ws + WS_WHIST);
                for (int i = tid; i < NGW * 8; i += NWAVES * 64) hist[i] = wh[i];
                __syncthreads();
                { const int e = tid & 7, seg = tid >> 3; int s = 0;
_Pragma("unroll 1")
                  for (int w = 0; w < 32; ++w) { const int ww = seg * 32 + w; if (ww < NGW) s += hist[ww * 8 + e]; } segsum[seg * 8 + e] = s; }
                __syncthreads();
                if (tid < 8) { int run = 0;
_Pragma("unroll 1")
                    for (int s = 0; s < 64; ++s) { segpre[s * 8 + tid] = run; run += segsum[s * 8 + tid]; } tot[tid] = run; }
                __syncthreads();
                if (tid == 0) { int ts = 0; for (int e = 0; e < 8; ++e) { tot[8 + e] = ts; ts += (tot[e] + 255) >> 8; } tot[16] = ts;
                    if (bx == 0) for (int e = 0; e < 9; ++e) ((int*)(ws + WS_CTL))[CW_MOE_TS + e] = tot[8 + e]; }
                __syncthreads();
                int base = 0;
                if (lane < 8) { base = tot[8 + lane] * 256 + segpre[(gw >> 5) * 8 + lane];
_Pragma("unroll 1")
                    for (int w = (gw & ~31); w < gw; ++w) base += hist[w * 8 + lane]; }
                const int* ti = (const int*)(ws + WS_TOPI); const float* tg = (const float*)(ws + WS_TOPG);
                for (int m = gw; m < TREAL; m += NGW) {
#pragma unroll
                    for (int k = 0; k < 2; ++k) { const int e = __builtin_amdgcn_readfirstlane(ti[2 * m + k]); const float gt = tg[2 * m + k];
                        const int slot = __builtin_amdgcn_readlane(base, e); if (lane == e) base += 1;
                        if (lane == 0) { SLOT_TOK[slot] = m; SLOT_GATE[slot] = gt; TOK_SLOT[2 * m + k] = slot; } }
                }
                if (vcu < 8) { const int e = vcu; const int s0 = tot[8 + e] * 256 + tot[e], s1 = tot[8 + e + 1] * 256; for (int s = s0 + tid; s < s1; s += NWAVES * 64) { SLOT_TOK[s] = T; SLOT_GATE[s] = 0.f; } }
                __syncthreads();
                LAS float* scr = (LAS float*)(lds + RING_OFF + wave * 16384);
                constexpr int I_F = (D / 64) * (DFF / 32), I_F2 = (DFF / 64) * (D / 32), I_E = 2 * I_F + I_F2;
                for (int it = gw; it < NE * I_E; it += NGW) {
                    const int e = it / I_E; int r = it - e * I_E;
                    if (r < 2 * I_F) { const int which = r / I_F; r -= which * I_F; const int nblk = DFF / 32, kb = r / nblk, nb = r % nblk;
                        transpose_item(INP(which ? I_MW3 : I_MW1) + (size_t)e * D * DFF, DFF, 64 * kb, 32 * nb, (bf16*)(ws + WS_MW13) + (size_t)e * 2 * DFF * D, D, dmap_glu(32 * nb) + (which ? 128 : 0), 0, nullptr, scr, lane); continue; }
                    r -= 2 * I_F;
                    { const int nblk = D / 32, kb = r / nblk, nb = r % nblk; transpose_item(INP(I_MW2) + (size_t)e * DFF * D, D, 64 * kb, 32 * nb, (bf16*)(ws + WS_MW2) + (size_t)e * D * DFF, DFF, 32 * nb, 0, nullptr, scr, lane); }
                }
            }
            SEAM(P + 6);
            MoeTiles mt;
            if (IN(P + 7) || IN(P + 8)) { unsigned char* const ws = WSP();
#pragma unroll
                for (int e = 0; e < 9; ++e) mt.ts[e] = __builtin_amdgcn_readfirstlane(((const int*)(ws + WS_CTL))[CW_MOE_TS + e]);
            } else {
#pragma unroll
                for (int e = 0; e < 9; ++e) mt.ts[e] = 0;
            }
            for (int rep_ = 0; rep_ < NREP(11); ++rep_) if (KEN(11) && IN(P + 7)) { PH_WS(); int* const SLOT_TOK = (int*)(ws + WS_SLOTTOK); float* const SLOT_GATE = (float*)(ws + WS_SLOTGATE); int* const TOK_SLOT = (int*)(ws + WS_TOKSLOT); (void)SLOT_TOK; (void)SLOT_GATE; (void)TOK_SLOT;
                ProbMoe1 pr; pr.so.init(mt.ts[8], 2 * DFF / 256, G, bx); pr.HBp = (const char*)HB; pr.slot_tok = SLOT_TOK; pr.W = (const char*)(ws + WS_MW13); pr.mt = mt;
                epi::EpiSwiglu E{(bf16*)(ws + WS_MACT)};
                pg8::gemm_phase<epi::EpiSwiglu, ProbMoe1, true>(lds + RING_OFF, D, pr, E);
            }
            SEAM(P + 7);
            for (int rep_ = 0; rep_ < NREP(12); ++rep_) if (KEN(12) && IN(P + 8)) { PH_WS(); int* const SLOT_TOK = (int*)(ws + WS_SLOTTOK); float* const SLOT_GATE = (float*)(ws + WS_SLOTGATE); int* const TOK_SLOT = (int*)(ws + WS_TOKSLOT); (void)SLOT_TOK; (void)SLOT_GATE; (void)TOK_SLOT;
                ProbMoe2 pr; pr.so.init(mt.ts[8], D / 256, G, bx); pr.ACTp = (const char*)(ws + WS_MACT); pr.W = (const char*)(ws + WS_MW2); pr.mt = mt;
                epi::EpiMoeDown E{(bf16*)(ws + WS_Y), SLOT_GATE};
                pg8::gemm_phase<epi::EpiMoeDown, ProbMoe2>(lds + RING_OFF, DFF, pr, E);
            }
            SEAM(P + 8);
            for (int rep_ = 0; rep_ < NREP(13); ++rep_) if (KEN(13) && IN(P + 9)) { PH_WS(); int* const SLOT_TOK = (int*)(ws + WS_SLOTTOK); float* const SLOT_GATE = (float*)(ws + WS_SLOTGATE); int* const TOK_SLOT = (int*)(ws + WS_TOKSLOT); (void)SLOT_TOK; (void)SLOT_GATE; (void)TOK_SLOT;
                const float* g = INP(I_LFG) + D; const float* bta = INP(I_LFB) + D; const bf16* Y = (const bf16*)(ws + WS_Y);
#define FL_LOAD(R, m) do { const int s0_ = TOK_SLOT[2 * (m)], s1_ = TOK_SLOT[2 * (m) + 1]; \
                    _Pragma("unroll") for (int j = 0; j < 8; ++j) { const v2u hw = *((const GAS v2u*)(HB + (size_t)(m) * D) + lane + 64 * j), y0 = *((const GAS v2u*)(Y + (size_t)s0_ * D) + lane + 64 * j), y1 = *((const GAS v2u*)(Y + (size_t)s1_ * D) + lane + 64 * j); \
                        R.v[j] = (bf4(hw) * ALPHA + bf4(y0)) + bf4(y1); } } while (0)
#define FL_PROC(R, m) do { ln_normalize(R); ln_affine(R, g, bta, lane); GAS f32x4* o = (GAS f32x4*)(outp + (size_t)(m) * D) + lane; \
                    _Pragma("unroll") for (int j = 0; j < 8; ++j) o[64 * j] = R.v[j]; } while (0)
                { float* const outp = OUTP(); Row8 ra{}, rb{}; int m = gw; if (m < TREAL) FL_LOAD(ra, m);
                  for (; m < TREAL; m += 2 * NGW) { const int m1 = m + NGW, m2 = m + 2 * NGW; if (m1 < TREAL) FL_LOAD(rb, m1); FL_PROC(ra, m);
                      if (m1 < TREAL) { if (m2 < TREAL) FL_LOAD(ra, m2); FL_PROC(rb, m1); } } }
#undef FL_LOAD
#undef FL_PROC
            }
        }
    }
#undef IN
#undef SEAM
}

#ifndef MK_ONE_LAUNCH
#define MK_ONE_LAUNCH 0
#endif
extern "C" void kernel_launch(void* const* d_in, const int* in_sizes, int n_in, void* d_out, int out_size, void* d_ws, size_t ws_size, hipStream_t stream) {
    static int grid = 0;
    if (grid == 0) {
        if (n_in != N_IN || in_sizes[0] != NB * SEQ * D || out_size != NB * SEQ * D || ws_size < WS_END) { fprintf(stderr, "kernel_launch: shape mismatch: n_in %d in0 %d out %d ws %zu (need %zu)\n", n_in, n_in > 0 ? in_sizes[0] : -1, out_size, ws_size, (size_t)WS_END); grid = -1; return; }
        int dev = 0, cus = 0, per_cu = 0;
        if (hipGetDevice(&dev) != hipSuccess || hipDeviceGetAttribute(&cus, hipDeviceAttributeMultiprocessorCount, dev) != hipSuccess) { fprintf(stderr, "kernel_launch: device query failed\n"); grid = -1; return; }
        if (hipFuncSetAttribute((const void*)mk_fwd, hipFuncAttributeMaxDynamicSharedMemorySize, LDS_BYTES) != hipSuccess) { fprintf(stderr, "kernel_launch: hipFuncSetAttribute failed\n"); grid = -1; return; }
        if (hipOccupancyMaxActiveBlocksPerMultiprocessor(&per_cu, (const void*)mk_fwd, NWAVES * 64, LDS_BYTES) != hipSuccess || per_cu < 1) fprintf(stderr, "kernel_launch: occupancy query reports %d\n", per_cu);
        (void)hipGetLastError();
        grid = cus;
    }
    if (grid < 0) return;
    if (hipMemsetAsync((char*)d_ws + WS_CTL, 0, CTL_ZERO_BYTES, stream) != hipSuccess) { fprintf(stderr, "kernel_launch: memset failed\n"); return; }
    Args a{};
    for (int i = 0; i < N_IN; ++i) a.in[i] = (const float*)d_in[i];
    a.out = (float*)d_out; a.ws = (unsigned char*)d_ws;
#if MK_ONE_LAUNCH
    a.ph_lo = 0; a.ph_hi = N_PHASES;
    hipLaunchKernelGGL(mk_fwd, dim3(grid), dim3(NWAVES * 64), LDS_BYTES, stream, a);
#else
    for (int p = 0; p < N_PHASES; ++p) { a.ph_lo = p; a.ph_hi = p + 1; hipLaunchKernelGGL(mk_fwd, dim3(grid), dim3(NWAVES * 64), LDS_BYTES, stream, a); }
#endif
    const hipError_t le = hipPeekAtLastError();
    if (le != hipSuccess) fprintf(stderr, "kernel_launch: launch failed: %s\n", hipGetErrorName(le));
}
```

```cpp
#define REPMASK 0
#define MK_ONE_LAUNCH 1
#include <hip/hip_runtime.h>
#include <cstdio>
#include <cstdint>
namespace pg8 {
#define PG8_LAS __attribute__((address_space(3)))
typedef unsigned short bf16_t;
typedef short bf16x8 __attribute__((ext_vector_type(8)));
typedef float f32x4 __attribute__((ext_vector_type(4)));
typedef float f32x2 __attribute__((ext_vector_type(2)));
typedef unsigned u32x4 __attribute__((ext_vector_type(4)));
typedef unsigned u32x2 __attribute__((ext_vector_type(2)));
constexpr int BM = 256, BK = 64, HALF = 128, HTB = HALF * BK * 2  , STAGE_BYTES = 8 * HTB, NXCD = 8, WGM = 8;

__host__ __device__ __forceinline__ int lds_byte(int r, int c) { const int st = (r >> 4) * 2 + (c >> 5), rr = r & 15, cc = c & 31, ob = rr * 64 + cc * 2; return st * 1024 + (ob ^ (((ob >> 9) & 1) << 5)); }
__host__ __device__ __forceinline__ void stage_rc(int b, int& R, int& C) { const int st = b / 1024, sb = b % 1024, swz = sb ^ (((sb >> 9) & 1) << 5); R = (st >> 1) * 16 + swz / 64; C = (st & 1) * 32 + (swz % 64) / 2; }
__host__ __device__ __forceinline__ int perm32(int rho) { const int n = rho >> 4, i = rho & 15; return 8 * (i >> 2) + 4 * n + (i & 3); }

struct Unit { int pm, pn; };

struct StaticOrder {
    int nM, nN, nwg, G, c, ntail;
    __device__ __forceinline__ void init(int nM_, int nN_, int G_, int c_, bool tail = false) { nM = nM_; nN = nN_; nwg = nM * nN; G = G_; c = c_; ntail = tail ? nN_ : 0; }
    __device__ __forceinline__ bool next(int i, Unit& u) const {
        const long L = (long)i * G + c; if (L >= nwg + ntail) return false;
        if (L >= nwg) { u.pm = nM; u.pn = (int)(L - nwg); return true; }
        int wgid = (int)L; { const int q = nwg / NXCD, r = nwg % NXCD, xcd = wgid % NXCD, off = wgid / NXCD; wgid = (xcd < r ? xcd * (q + 1) : r * (q + 1) + (xcd - r) * q) + off; }
        const int nig = WGM * nN, gid = wgid / nig, fm = gid * WGM, gsz = (nM - fm) < WGM ? (nM - fm) : WGM;
        u.pm = fm + ((wgid % nig) % gsz); u.pn = (wgid % nig) / gsz; return true;
    }
    __device__ __forceinline__ bool is_half(const Unit& u) const { return ntail != 0 && u.pm == nM; }
};
__device__ __forceinline__ unsigned cvt_pk_bf16(float lo, float hi) { unsigned r; asm volatile("v_cvt_pk_bf16_f32 %0, %1, %2" : "=v"(r) : "v"(lo), "v"(hi)); return r; }
__device__ __forceinline__ float bf_lo(unsigned w) { return __uint_as_float(w << 16); }
__device__ __forceinline__ float bf_hi(unsigned w) { return __uint_as_float(w & 0xffff0000u); }

template <class Epi, class Prob, bool GATHER = false>
__device__ __forceinline__ void gemm_phase(PG8_LAS unsigned char* lds, const int K, const Prob& S, const Epi& E, const int tid_in) {
    int tid_ = tid_in; asm volatile("" : "+v"(tid_));
    const int tid = tid_, wid = __builtin_amdgcn_readfirstlane(tid >> 6), lane = tid & 63, wr = wid >> 2, wc = wid & 3, fr = lane & 15, fq = lane >> 4;
    const int nt = K / BK;
    int sR[2], sC[2];
    unsigned voffA[2][2], nvoffA[2][2], voffB[2];
#pragma unroll
    for (int i = 0; i < 2; ++i) { int R, C; stage_rc(tid * 16 + i * 8192, R, C); sR[i] = R; sC[i] = C; const int Rb = (R & ~31) + perm32(R & 31);
        voffB[i] = (unsigned)(Rb * K + C) * 2u;
        voffA[0][i] = (unsigned)(R * K + C) * 2u; voffA[1][i] = (unsigned)((R + HALF) * K + C) * 2u; nvoffA[0][i] = voffA[0][i]; nvoffA[1][i] = voffA[1][i]; }
    const size_t kstep = (size_t)(BK * 2);
    const size_t hstep = (size_t)HALF * K * 2;
    const unsigned ldsw = (unsigned)wid * 1024u;
    const int aoff = lds_byte(wr * 64 + fr, fq * 8), boff = lds_byte(wc * 32 + fr, fq * 8);
#define PG8_SA(b, h) (((b) * 2 + (h)) * HTB)
#define PG8_SB(b, h) ((4 + (b) * 2 + (h)) * HTB)
#define PG8_STAGE(bufoff, gbase, voff) do { _Pragma("unroll") for (int _i = 0; _i < 2; ++_i) \
        __builtin_amdgcn_global_load_lds((const unsigned*)((const char*)(gbase) + (voff)[_i]), (PG8_LAS unsigned*)(lds + (bufoff) + ldsw + _i * 8192), 16, 0, 0); } while (0)
#define PG8_LDA(dst, b, h) do { _Pragma("unroll") for (int m = 0; m < 4; ++m) _Pragma("unroll") for (int k = 0; k < 2; ++k) dst[m][k] = *(const PG8_LAS bf16x8*)(lds + PG8_SA(b, h) + aoff + m * 2048 + k * 1024); } while (0)
#define PG8_LDB(dst, b, h) do { _Pragma("unroll") for (int n = 0; n < 2; ++n) _Pragma("unroll") for (int k = 0; k < 2; ++k) dst[n][k] = *(const PG8_LAS bf16x8*)(lds + PG8_SB(b, h) + boff + n * 2048 + k * 1024); } while (0)
#define PG8_MMA(ai, bj, At, Bt) do { __builtin_amdgcn_s_setprio(1); _Pragma("unroll") for (int m = 0; m < 4; ++m) _Pragma("unroll") for (int n = 0; n < 2; ++n) _Pragma("unroll") for (int k = 0; k < 2; ++k) \
        acc[ai][bj][m][n] = __builtin_amdgcn_mfma_f32_16x16x32_bf16(Bt[n][k], At[m][k], acc[ai][bj][m][n], 0, 0, 0); __builtin_amdgcn_s_setprio(0); } while (0)
#define PG8_WAIT_V(n) asm volatile("s_waitcnt vmcnt(" #n ")" ::: "memory")
#define PG8_WAIT_L(n) asm volatile("s_waitcnt lgkmcnt(" #n ")" ::: "memory")
#define PG8_BAR __builtin_amdgcn_s_barrier()
#define PG8_SCHED __builtin_amdgcn_sched_barrier(0)
    Unit cur, nxt; int ui = 0;
    if (!S.next(0, cur)) return;
    f32x4 acc[2][2][4][2];
#pragma unroll
    for (int a = 0; a < 2; ++a)
#pragma unroll
        for (int b = 0; b < 2; ++b)
#pragma unroll
            for (int m = 0; m < 4; ++m)
#pragma unroll
                for (int n = 0; n < 2; ++n) acc[a][b][m][n] = (f32x4){0.f, 0.f, 0.f, 0.f};
    bf16x8 At[4][2], B0[2][2], B1[2][2];
    const char* cA = S.a_base(cur); const char* cB = S.b_base(cur);
    if constexpr (GATHER) {
#pragma unroll
        for (int h = 0; h < 2; ++h)
#pragma unroll
            for (int i = 0; i < 2; ++i) { voffA[h][i] = (unsigned)(S.a_row(cur, sR[i] + h * HALF) * K + sC[i]) * 2u; nvoffA[h][i] = voffA[h][i]; }
    }
    PG8_STAGE(PG8_SB(0, 0), cB, voffB); PG8_STAGE(PG8_SB(0, 1), cB + hstep, voffB); PG8_STAGE(PG8_SA(0, 0), cA, voffA[0]); PG8_STAGE(PG8_SA(0, 1), cA, voffA[1]);
    if (wr == 1) PG8_BAR;
    PG8_WAIT_V(2); PG8_BAR;
    PG8_STAGE(PG8_SB(1, 0), cB + kstep, voffB); PG8_STAGE(PG8_SA(1, 0), cA + kstep, voffA[0]); PG8_STAGE(PG8_SB(1, 1), cB + hstep + kstep, voffB);
    PG8_WAIT_V(6); PG8_BAR;
    for (;;) {
        const bool has_next = S.next(ui + 1, nxt);
        const bool half = S.is_half(cur);
        const char* nA = has_next ? S.a_base(nxt) : cA; const char* nB = has_next ? S.b_base(nxt) : cB;
        if constexpr (GATHER) { if (has_next) {
#pragma unroll
            for (int h = 0; h < 2; ++h)
#pragma unroll
                for (int i = 0; i < 2; ++i) nvoffA[h][i] = (unsigned)(S.a_row(nxt, sR[i] + h * HALF) * K + sC[i]) * 2u; } }
        for (int t = 0; t < nt; t += 2) {
            const bool last = (t == nt - 2);
            if constexpr (Epi::MID) { if (t == (nt >> 1)) E.mid(acc, cur, wr, wc, fr, fq); }
            const char* a1 = cA + (size_t)(t + 1) * kstep;
            const char* a2 = last ? nA : cA + (size_t)(t + 2) * kstep; const char* b2 = last ? nB : cB + (size_t)(t + 2) * kstep;
            const char* a3 = a2 + kstep; const char* b3 = b2 + kstep;
            unsigned vA2[2][2];
#pragma unroll
            for (int h = 0; h < 2; ++h)
#pragma unroll
                for (int i = 0; i < 2; ++i) vA2[h][i] = GATHER ? (last ? nvoffA[h][i] : voffA[h][i]) : voffA[h][i];
            PG8_LDB(B0, 0, 0); PG8_LDB(B1, 0, 1); PG8_SCHED; PG8_LDA(At, 0, 0); PG8_STAGE(PG8_SA(1, 1), a1, voffA[1]);
            PG8_WAIT_V(8); PG8_WAIT_L(0); PG8_BAR; PG8_MMA(0, 0, At, B0); PG8_MMA(0, 1, At, B1); PG8_BAR; PG8_SCHED;
            if (!half) PG8_LDA(At, 0, 1); PG8_STAGE(PG8_SB(0, 0), b2, voffB); PG8_STAGE(PG8_SB(0, 1), b2 + hstep, voffB); PG8_STAGE(PG8_SA(0, 0), a2, vA2[0]);
            PG8_WAIT_V(8); PG8_WAIT_L(0); PG8_BAR; if (!half) { PG8_MMA(1, 0, At, B0); PG8_MMA(1, 1, At, B1); } PG8_BAR; PG8_SCHED;
            PG8_LDB(B0, 1, 0); PG8_LDB(B1, 1, 1); PG8_SCHED; PG8_LDA(At, 1, 0); PG8_STAGE(PG8_SA(0, 1), a2, vA2[1]);
            PG8_WAIT_V(8); PG8_WAIT_L(0); PG8_BAR; PG8_MMA(0, 0, At, B0); PG8_MMA(0, 1, At, B1); PG8_BAR; PG8_SCHED;
            if (!half) PG8_LDA(At, 1, 1); PG8_STAGE(PG8_SB(1, 0), b3, voffB); PG8_STAGE(PG8_SB(1, 1), b3 + hstep, voffB); PG8_STAGE(PG8_SA(1, 0), a3, vA2[0]);
            PG8_WAIT_V(8); PG8_WAIT_L(0); PG8_BAR; if (!half) { PG8_MMA(1, 0, At, B0); PG8_MMA(1, 1, At, B1); } PG8_BAR; PG8_SCHED;
        }
        if (wr == 0) PG8_BAR;
        E(acc, cur, wr, wc, fr, fq);
#ifdef PROBE_EPI2
        if (Epi::PROBE2) { asm volatile("" ::: "memory"); E(acc, cur, wr, wc, fr, fq); }
#endif
        if (!has_next) break;
#pragma unroll
        for (int a = 0; a < 2; ++a)
#pragma unroll
            for (int b = 0; b < 2; ++b)
#pragma unroll
                for (int m = 0; m < 4; ++m)
#pragma unroll
                    for (int n = 0; n < 2; ++n) acc[a][b][m][n] = (f32x4){0.f, 0.f, 0.f, 0.f};
        cur = nxt; cA = nA; cB = nB; ++ui;
        if constexpr (GATHER) {
#pragma unroll
            for (int h = 0; h < 2; ++h)
#pragma unroll
                for (int i = 0; i < 2; ++i) voffA[h][i] = nvoffA[h][i]; }
        if (wr == 1) PG8_BAR;
    }
    PG8_WAIT_V(0);
    PG8_BAR;
#undef PG8_SA
#undef PG8_SB
#undef PG8_STAGE
#undef PG8_LDA
#undef PG8_LDB
#undef PG8_MMA
#undef PG8_WAIT_V
#undef PG8_WAIT_L
#undef PG8_BAR
#undef PG8_SCHED
}
}
constexpr int D = 2048, NB = 8, SEQ = 4096, NMETA = 16, NH = 16;
constexpr int TREAL = NB * SEQ;
constexpr int T = TREAL + NB * NMETA;
constexpr int TP = 33024;
constexpr int LPOS = SEQ + NMETA;
constexpr int QRANK = 768, KVRANK = 512, DFF = 5632, NE = 8;
constexpr int NIN = 8704;
constexpr int INDIM = 8512;
constexpr float LN_EPS = 1e-5f, RMS_EPS = 1e-6f, ALPHA = 1.4142135623730951f;
constexpr float LOG2E = 1.4426950408889634f;
constexpr float QK_SCALE_MLA = 0.07216878364870322f * LOG2E;
constexpr float QK_SCALE_SWA = 0.08838834764831845f * LOG2E;

__device__ __forceinline__ int row_pos(int row) { return row < TREAL ? NMETA + (row & (SEQ - 1)) : ((row - TREAL) & (NMETA - 1)); }

struct ProbDense {
    pg8::StaticOrder so; const char* A; const char* Bt; size_t tstep;
    __device__ __forceinline__ bool next(int i, pg8::Unit& u) const { return so.next(i, u); }
    __device__ __forceinline__ const char* a_base(const pg8::Unit& u) const { return A + (size_t)u.pm * tstep; }
    __device__ __forceinline__ const char* b_base(const pg8::Unit& u) const { return Bt + (size_t)u.pn * tstep; }
    __device__ __forceinline__ int a_row(const pg8::Unit&, int) const { return 0; }
    __device__ __forceinline__ bool is_half(const pg8::Unit& u) const { return so.is_half(u); }
};
struct MoeTiles { int ts[9]; };
__device__ __forceinline__ int moe_expert(const MoeTiles& mt, int pm) { int e = 0;
#pragma unroll
    for (int k = 1; k < 8; ++k) e += (pm >= mt.ts[k]) ? 1 : 0; return e; }
struct ProbMoe1 {
    pg8::StaticOrder so; const char* HBp; const int* slot_tok; const char* W; MoeTiles mt;
    __device__ __forceinline__ bool next(int i, pg8::Unit& u) const { return so.next(i, u); }
    __device__ __forceinline__ const char* a_base(const pg8::Unit&) const { return HBp; }
    __device__ __forceinline__ const char* b_base(const pg8::Unit& u) const { return W + (size_t)moe_expert(mt, u.pm) * ((size_t)2 * DFF * D * 2) + (size_t)u.pn * (256 * (size_t)D * 2); }
    __device__ __forceinline__ int a_row(const pg8::Unit& u, int r) const { return slot_tok[u.pm * 256 + r]; }
    __device__ __forceinline__ bool is_half(const pg8::Unit&) const { return false; }
};
struct ProbMoe2 {
    pg8::StaticOrder so; const char* ACTp; const char* W; MoeTiles mt;
    __device__ __forceinline__ bool next(int i, pg8::Unit& u) const { return so.next(i, u); }
    __device__ __forceinline__ const char* a_base(const pg8::Unit& u) const { return ACTp + (size_t)u.pm * (256 * (size_t)DFF * 2); }
    __device__ __forceinline__ const char* b_base(const pg8::Unit& u) const { return W + (size_t)moe_expert(mt, u.pm) * ((size_t)D * DFF * 2) + (size_t)u.pn * (256 * (size_t)DFF * 2); }
    __device__ __forceinline__ int a_row(const pg8::Unit&, int) const { return 0; }
    __device__ __forceinline__ bool is_half(const pg8::Unit&) const { return false; }
};

namespace epi {
using pg8::f32x4; using pg8::u32x4; using pg8::bf16_t; using pg8::Unit; using pg8::cvt_pk_bf16;
typedef const f32x4 (&AccRef)[2][2][4][2];
__device__ __forceinline__ void store8(bf16_t* p, f32x4 v0, f32x4 v1) { u32x4 w; w.x = cvt_pk_bf16(v0[0], v0[1]); w.y = cvt_pk_bf16(v0[2], v0[3]); w.z = cvt_pk_bf16(v1[0], v1[1]); w.w = cvt_pk_bf16(v1[2], v1[3]); *(u32x4*)p = w; }
__device__ __forceinline__ void load8(const bf16_t* p, f32x4& v0, f32x4& v1) { const u32x4 w = *(const u32x4*)p;
    v0 = (f32x4){pg8::bf_lo(w.x), pg8::bf_hi(w.x), pg8::bf_lo(w.y), pg8::bf_hi(w.y)}; v1 = (f32x4){pg8::bf_lo(w.z), pg8::bf_hi(w.z), pg8::bf_lo(w.w), pg8::bf_hi(w.w)}; }
__device__ __forceinline__ bool epi_fence() { asm volatile("" ::: "memory"); return true; }
__device__ __forceinline__ float sigmoidf_(float x) { return __builtin_amdgcn_rcpf(1.f + __builtin_amdgcn_exp2f(-x * LOG2E)); }
#define EPI_AM _Pragma("unroll") for (int ai = 0; ai < 2; ++ai) _Pragma("unroll") for (int m = 0; m < 4; ++m) if (epi_fence())

struct EpiWin {
    static constexpr bool MID = false, PROBE2 = false;
    bf16_t *CQ, *CKV, *KR, *QB, *KB, *VB, *GR, *GBb; float* SSQ; const float *CS, *SN;
    __device__ __forceinline__ void operator()(AccRef acc, const Unit& u, int wr, int wc, int fr, int fq) const {
        const int pn = u.pn, row0 = u.pm * 256 + wr * 64 + fr, cw = wc * 32 + fq * 8;
        if (pn < 5) {
            bf16_t* dst = pn < 3 ? CQ : CKV; const int ld = pn < 3 ? QRANK : KVRANK, c0 = (pn < 3 ? pn : pn - 3) * 256;
            EPI_AM { const int row = row0 + ai * 128 + m * 16; float s = 0.f;
#pragma unroll
                for (int bj = 0; bj < 2; ++bj) { const f32x4 v0 = acc[ai][bj][m][0], v1 = acc[ai][bj][m][1];
                    s += (v0[0] * v0[0] + v0[1] * v0[1]) + (v0[2] * v0[2] + v0[3] * v0[3]) + (v1[0] * v1[0] + v1[1] * v1[1]) + (v1[2] * v1[2] + v1[3] * v1[3]);
                    store8(dst + (size_t)row * ld + c0 + bj * 128 + cw, v0, v1); }
                s += __shfl_xor(s, 16); s += __shfl_xor(s, 32);
                if (fq == 0) SSQ[(size_t)row * 20 + pn * 4 + wc] = s; }
        } else if (pn == 5) {
            if (wc == 0) { EPI_AM { const int row = row0 + ai * 128 + m * 16, pos = row_pos(row);
                const f32x4 c0 = *(const f32x4*)(CS + pos * 32 + fq * 8), c1 = *(const f32x4*)(CS + pos * 32 + fq * 8 + 4), s0 = *(const f32x4*)(SN + pos * 32 + fq * 8), s1 = *(const f32x4*)(SN + pos * 32 + fq * 8 + 4);
                const f32x4 x10 = acc[ai][0][m][0], x11 = acc[ai][0][m][1], x20 = acc[ai][1][m][0], x21 = acc[ai][1][m][1];
                store8(KR + (size_t)row * 64 + fq * 8, x10 * c0 - x20 * s0, x11 * c1 - x21 * s1);
                store8(KR + (size_t)row * 64 + 32 + fq * 8, x10 * s0 + x20 * c0, x11 * s1 + x21 * c1); } }
        } else if (pn < 14) {
            EPI_AM { const int row = row0 + ai * 128 + m * 16;
#pragma unroll
                for (int bj = 0; bj < 2; ++bj) store8(QB + (size_t)row * 2048 + (pn - 6) * 256 + bj * 128 + cw, acc[ai][bj][m][0] * QK_SCALE_SWA, acc[ai][bj][m][1] * QK_SCALE_SWA); }
        } else if (pn < 18) {
            bf16_t* dst = pn < 16 ? KB : VB; const int c0 = (pn < 16 ? pn - 14 : pn - 16) * 256;
            EPI_AM { const int row = row0 + ai * 128 + m * 16;
#pragma unroll
                for (int bj = 0; bj < 2; ++bj) store8(dst + (size_t)row * 512 + c0 + bj * 128 + cw, acc[ai][bj][m][0], acc[ai][bj][m][1]); }
        } else {
            const int c0 = (pn - 18) * 128 + cw;
            EPI_AM { const int row = row0 + ai * 128 + m * 16; f32x4 r[2], g[2];
#pragma unroll
                for (int n = 0; n < 2; ++n)
#pragma unroll
                    for (int j = 0; j < 4; ++j) { const float a = acc[ai][0][m][n][j], b = fmaxf(acc[ai][1][m][n][j], -30.f);
                        const float ea = __builtin_amdgcn_exp2f(-a * LOG2E), eb = __builtin_amdgcn_exp2f(-b * LOG2E);
                        g[n][j] = __builtin_amdgcn_rcpf(1.f + eb); r[n][j] = (1.f + eb) * __builtin_amdgcn_rcpf(1.f + ea); }
                store8(GR + (size_t)row * 2048 + c0, r[0], r[1]); store8(GBb + (size_t)row * 2048 + c0, g[0], g[1]); }
        }
    }
};
struct EpiUq {
    static constexpr bool MID = false, PROBE2 = false;
    bf16_t* Q; const float* SSQ; const float *CS, *SN;
    __device__ __forceinline__ void operator()(AccRef acc, const Unit& u, int wr, int wc, int fr, int fq) const {
        const int pn = u.pn, row0 = u.pm * 256 + wr * 64 + fr, cw = wc * 32 + fq * 8;
        EPI_AM { const int row = row0 + ai * 128 + m * 16;
            const f32x4 q0 = *(const f32x4*)(SSQ + (size_t)row * 20), q1 = *(const f32x4*)(SSQ + (size_t)row * 20 + 4), q2 = *(const f32x4*)(SSQ + (size_t)row * 20 + 8);
            const float ss = ((q0[0] + q0[1]) + (q0[2] + q0[3])) + ((q1[0] + q1[1]) + (q1[2] + q1[3])) + ((q2[0] + q2[1]) + (q2[2] + q2[3]));
            const float rs = __builtin_amdgcn_rsqf(ss * (1.f / QRANK) + RMS_EPS) * QK_SCALE_MLA;
            if (pn < 8) {
#pragma unroll
                for (int bj = 0; bj < 2; ++bj) store8(Q + (size_t)row * 3072 + (2 * pn + bj) * 192 + cw, acc[ai][bj][m][0] * rs, acc[ai][bj][m][1] * rs);
            } else {
                const int head = 4 * (pn - 8) + wc, pos = row_pos(row);
                const f32x4 c0 = *(const f32x4*)(CS + pos * 32 + fq * 8), c1 = *(const f32x4*)(CS + pos * 32 + fq * 8 + 4), s0 = *(const f32x4*)(SN + pos * 32 + fq * 8), s1 = *(const f32x4*)(SN + pos * 32 + fq * 8 + 4);
                const f32x4 x10 = acc[ai][0][m][0] * rs, x11 = acc[ai][0][m][1] * rs, x20 = acc[ai][1][m][0] * rs, x21 = acc[ai][1][m][1] * rs;
                store8(Q + (size_t)row * 3072 + head * 192 + 128 + fq * 8, x10 * c0 - x20 * s0, x11 * c1 - x21 * s1);
                store8(Q + (size_t)row * 3072 + head * 192 + 160 + fq * 8, x10 * s0 + x20 * c0, x11 * s1 + x21 * c1);
            } }
    }
};
struct EpiUkv {
    static constexpr bool MID = false, PROBE2 = false;
    bf16_t *KN, *V; const float* SSQ;
    __device__ __forceinline__ void operator()(AccRef acc, const Unit& u, int wr, int wc, int fr, int fq) const {
        const int pn = u.pn, row0 = u.pm * 256 + wr * 64 + fr, cw = wc * 32 + fq * 8;
        EPI_AM { const int row = row0 + ai * 128 + m * 16;
            const f32x4 q0 = *(const f32x4*)(SSQ + (size_t)row * 20 + 12), q1 = *(const f32x4*)(SSQ + (size_t)row * 20 + 16);
            const float ss = ((q0[0] + q0[1]) + (q0[2] + q0[3])) + ((q1[0] + q1[1]) + (q1[2] + q1[3]));
            const float rs = __builtin_amdgcn_rsqf(ss * (1.f / KVRANK) + RMS_EPS);
            store8(KN + (size_t)row * 2048 + pn * 128 + cw, acc[ai][0][m][0] * rs, acc[ai][0][m][1] * rs);
            store8(V + (size_t)row * 2048 + pn * 128 + cw, acc[ai][1][m][0] * rs, acc[ai][1][m][1] * rs); }
    }
};
struct EpiProj {
    static constexpr bool MID = true, PROBE2 = false;
    bf16_t* MG; const bf16_t *GR, *GBb;
    __device__ __forceinline__ void mid(f32x4 (&acc)[2][2][4][2], const Unit& u, int wr, int wc, int fr, int fq) const {
        int row0 = u.pm * 256 + wr * 64 + fr, c0 = u.pn * 256 + wc * 32 + fq * 8; asm volatile("" : "+v"(row0), "+v"(c0));
        EPI_AM { const int row = row0 + ai * 128 + m * 16;
#pragma unroll
            for (int bj = 0; bj < 2; ++bj) { f32x4 r0, r1; load8(GR + (size_t)row * 2048 + c0 + bj * 128, r0, r1); acc[ai][bj][m][0] *= r0; acc[ai][bj][m][1] *= r1; } }
    }
    __device__ __forceinline__ void operator()(AccRef acc, const Unit& u, int wr, int wc, int fr, int fq) const {
        const int row0 = u.pm * 256 + wr * 64 + fr, c0 = u.pn * 256 + wc * 32 + fq * 8;
        EPI_AM { const int row = row0 + ai * 128 + m * 16;
#pragma unroll
            for (int bj = 0; bj < 2; ++bj) { f32x4 g0, g1; load8(GBb + (size_t)row * 2048 + c0 + bj * 128, g0, g1); store8(MG + (size_t)row * 2048 + c0 + bj * 128, acc[ai][bj][m][0] * g0, acc[ai][bj][m][1] * g1); } }
    }
};
struct EpiResid {
    static constexpr bool MID = false, PROBE2 = false;
    bf16_t* X; const bf16_t* HB;
    __device__ __forceinline__ void operator()(AccRef acc, const Unit& u, int wr, int wc, int fr, int fq) const {
        const int row0 = u.pm * 256 + wr * 64 + fr, c0 = u.pn * 256 + wc * 32 + fq * 8;
        EPI_AM { const int row = row0 + ai * 128 + m * 16;
#pragma unroll
            for (int bj = 0; bj < 2; ++bj) { f32x4 h0, h1; load8(HB + (size_t)row * 2048 + c0 + bj * 128, h0, h1);
                store8(X + (size_t)row * 2048 + c0 + bj * 128, h0 * ALPHA + acc[ai][bj][m][0], h1 * ALPHA + acc[ai][bj][m][1]); } }
    }
};
struct EpiSwiglu {
    static constexpr bool MID = false, PROBE2 = false;
    bf16_t* ACT;
    __device__ __forceinline__ void operator()(AccRef acc, const Unit& u, int wr, int wc, int fr, int fq) const {
        const int row0 = u.pm * 256 + wr * 64 + fr, c0 = u.pn * 128 + wc * 32 + fq * 8;
        EPI_AM { const int row = row0 + ai * 128 + m * 16; f32x4 o[2];
#pragma unroll
            for (int n = 0; n < 2; ++n)
#pragma unroll
                for (int j = 0; j < 4; ++j) { const float g = acc[ai][0][m][n][j]; o[n][j] = g * sigmoidf_(g) * acc[ai][1][m][n][j]; }
            store8(ACT + (size_t)row * DFF + c0, o[0], o[1]); }
    }
};
struct EpiMoeDown {
    static constexpr bool MID = false, PROBE2 = false;
    bf16_t* Y; const float* slot_gate;
    __device__ __forceinline__ void operator()(AccRef acc, const Unit& u, int wr, int wc, int fr, int fq) const {
        const int row0 = u.pm * 256 + wr * 64 + fr, c0 = u.pn * 256 + wc * 32 + fq * 8;
        EPI_AM { const int row = row0 + ai * 128 + m * 16; const float g = slot_gate[row];
#pragma unroll
            for (int bj = 0; bj < 2; ++bj) store8(Y + (size_t)row * 2048 + c0 + bj * 128, acc[ai][bj][m][0] * g, acc[ai][bj][m][1] * g); }
    }
};
#undef EPI_AM
}
namespace att {
typedef unsigned short bf16;
typedef short bf16x8 __attribute__((ext_vector_type(8)));
typedef short s16x4 __attribute__((ext_vector_type(4)));
typedef float f32x16 __attribute__((ext_vector_type(16)));
typedef unsigned u32x4 __attribute__((ext_vector_type(4)));
#define ATT_LAS __attribute__((address_space(3)))
#define SBAR() __builtin_amdgcn_sched_barrier(0)
constexpr int KN_BYTES = 16384, KR_BYTES = 8192, V_BYTES = 16384, BUF_BYTES = KN_BYTES + KR_BYTES + V_BYTES;
constexpr int OFF_KN = 0, OFF_KR = KN_BYTES, OFF_V = KN_BYTES + KR_BYTES;
constexpr int OFF_WS = 2 * BUF_BYTES;
constexpr int OFF_BT = OFF_WS + 8 * 64 * 4;
constexpr int ATT_LDS_BYTES = OFF_BT + 4 * 260 * 4;
constexpr float NEG_BIG = -1e30f;
constexpr float THR2 = 8.f;

__device__ __forceinline__ int crow(int r, int hi) { return (r & 3) + 8 * (r >> 2) + 4 * hi; }
__device__ __forceinline__ unsigned cvtpk(float lo, float hi) { unsigned r; asm volatile("v_cvt_pk_bf16_f32 %0, %1, %2" : "=v"(r) : "v"(lo), "v"(hi)); return r; }
__device__ __forceinline__ int kn_off(int row, int colB) { return row * 256 + (colB ^ ((row & 15) << 4)); }
__device__ __forceinline__ int kr_off(int row, int colB) { return row * 128 + (colB ^ (((row >> 1) & 7) << 4)); }
__device__ __forceinline__ int v_st(int k, int c) { const int kk = (k & ~0xC) | ((k & 4) << 1) | ((k & 8) >> 1); return ((kk >> 3) * 4 + (c >> 5)) * 512 + ((kk & 7) * 32 + (c & 31)) * 2; }
__device__ __forceinline__ int v_rd_base(int lane) { return ((lane & 3) << 3) | (((lane >> 2) & 3) << 6) | (((lane >> 4) & 1) << 5) | (((lane >> 5) & 1) << 8); }
constexpr int v_rd_off(int d0, int ks, int half) { return d0 * 512 + ks * 4096 + half * 2048; }
template <int OFF> __device__ __forceinline__ s16x4 tr_read(int vb) { s16x4 r; asm volatile("ds_read_b64_tr_b16 %0, %1 offset:%2" : "=&v"(r) : "v"(vb), "i"(OFF) : "memory"); return r; }
template <int D0> __device__ __forceinline__ void pv_one(f32x16& od, int vb, bf16x8 pa0, bf16x8 pa1, bf16x8 pa2, bf16x8 pa3) {
    const s16x4 l0 = tr_read<v_rd_off(D0, 0, 0)>(vb), h0 = tr_read<v_rd_off(D0, 0, 1)>(vb), l1 = tr_read<v_rd_off(D0, 1, 0)>(vb), h1 = tr_read<v_rd_off(D0, 1, 1)>(vb);
    const s16x4 l2 = tr_read<v_rd_off(D0, 2, 0)>(vb), h2 = tr_read<v_rd_off(D0, 2, 1)>(vb), l3 = tr_read<v_rd_off(D0, 3, 0)>(vb), h3 = tr_read<v_rd_off(D0, 3, 1)>(vb);
    asm volatile("s_waitcnt lgkmcnt(0)" ::: "memory"); SBAR();
#define PK(L, H) (bf16x8){L[0], L[1], L[2], L[3], H[0], H[1], H[2], H[3]}
    od = __builtin_amdgcn_mfma_f32_32x32x16_bf16(pa0, PK(l0, h0), od, 0, 0, 0);
    od = __builtin_amdgcn_mfma_f32_32x32x16_bf16(pa1, PK(l1, h1), od, 0, 0, 0);
    od = __builtin_amdgcn_mfma_f32_32x32x16_bf16(pa2, PK(l2, h2), od, 0, 0, 0);
    od = __builtin_amdgcn_mfma_f32_32x32x16_bf16(pa3, PK(l3, h3), od, 0, 0, 0);
#undef PK
}
__device__ __forceinline__ void pv_all(f32x16* o, int vb, bf16x8 pa0, bf16x8 pa1, bf16x8 pa2, bf16x8 pa3) {
    pv_one<0>(o[0], vb, pa0, pa1, pa2, pa3); pv_one<1>(o[1], vb, pa0, pa1, pa2, pa3); pv_one<2>(o[2], vb, pa0, pa1, pa2, pa3); pv_one<3>(o[3], vb, pa0, pa1, pa2, pa3);
}
__device__ __forceinline__ bool softmax_tile(f32x16& p0, f32x16& p1, float& m_reg, float& l_reg, float& alpha, bf16x8& pa0, bf16x8& pa1, bf16x8& pa2, bf16x8& pa3) {
    float pmax = p0[0];
#pragma unroll
    for (int r = 1; r < 16; ++r) pmax = fmaxf(pmax, p0[r]);
#pragma unroll
    for (int r = 0; r < 16; ++r) pmax = fmaxf(pmax, p1[r]);
    { auto rr = __builtin_amdgcn_permlane32_swap(__float_as_uint(pmax), __float_as_uint(pmax), false, false); pmax = fmaxf(__uint_as_float(rr[0]), __uint_as_float(rr[1])); }
    bool resc = false; alpha = 1.f;
    if (!__all(pmax - m_reg <= THR2)) { const float mn = fmaxf(m_reg, pmax); alpha = __builtin_amdgcn_exp2f(m_reg - mn); m_reg = mn; resc = true; }
    float ps = 0.f;
#pragma unroll
    for (int r = 0; r < 16; ++r) { p0[r] = __builtin_amdgcn_exp2f(p0[r] - m_reg); ps += p0[r]; }
#pragma unroll
    for (int r = 0; r < 16; ++r) { p1[r] = __builtin_amdgcn_exp2f(p1[r] - m_reg); ps += p1[r]; }
    { auto rr = __builtin_amdgcn_permlane32_swap(__float_as_uint(ps), __float_as_uint(ps), false, false); ps = __uint_as_float(rr[0]) + __uint_as_float(rr[1]); }
    l_reg = l_reg * alpha + ps;
#define PK4(P, BASE, OUT) do { unsigned a0 = cvtpk(P[BASE + 0], P[BASE + 1]), a1 = cvtpk(P[BASE + 2], P[BASE + 3]);   \
    unsigned b0 = cvtpk(P[BASE + 4], P[BASE + 5]), b1 = cvtpk(P[BASE + 6], P[BASE + 7]);                              \
    auto r0 = __builtin_amdgcn_permlane32_swap(a0, b0, false, false); auto r1 = __builtin_amdgcn_permlane32_swap(a1, b1, false, false); \
    u32x4 w = {r0[0], r1[0], r0[1], r1[1]}; OUT = *reinterpret_cast<bf16x8*>(&w); } while (0)
    PK4(p0, 0, pa0); PK4(p0, 8, pa1); PK4(p1, 0, pa2); PK4(p1, 8, pa3);
#undef PK4
    return resc;
}

__device__ __forceinline__ void mla_unit(char* lds, const bf16* __restrict__ Q, const bf16* __restrict__ KN, const bf16* __restrict__ KR, const bf16* __restrict__ V, bf16* __restrict__ OAB, int b, int h, int qb) {
    int tid_ = threadIdx.x; asm volatile("" : "+v"(tid_)); const int tid = tid_, lane = tid & 63, r32 = lane & 31, hi = lane >> 5; const int wid = __builtin_amdgcn_readfirstlane(tid >> 6);
    const bool metaq = (qb == 16);
    const bool wave_on = !metaq || wid == 0;
    const int qrow = metaq ? (TREAL + 16 * b + (r32 & 15)) : (b * SEQ + qb * 256 + wid * 32 + r32);
    float* wsf = (float*)(lds + OFF_WS) + wid * 64;
    bf16x8 qr[12];
    { const bf16* qp = Q + (size_t)qrow * 3072 + h * 192 + hi * 8;
#pragma unroll
      for (int d0 = 0; d0 < 12; ++d0) qr[d0] = *reinterpret_cast<const bf16x8*>(qp + d0 * 16); }
    const int sr = tid >> 4, sc = (tid & 15) * 8, rr = tid >> 3, rc = (tid & 7) * 8;
    const int kn_w0 = kn_off(sr, sc * 2), kn_w1 = kn_off(32 + sr, sc * 2), kr_w = kr_off(rr, rc * 2), v_w0 = v_st(sr, sc), v_w1 = v_st(32 + sr, sc);
    const int vb0 = (int)(uintptr_t)(lds + OFF_V) + v_rd_base(lane);
    bf16x8 sk0, sk1, skr, sv0, sv1;
    const size_t real0 = (size_t)b * SEQ, meta0 = (size_t)TREAL + 16 * b;
#define MLA_LOAD(t) do { size_t g0, g1, g2; if ((t) < 64) { g0 = real0 + (t) * 64 + sr; g1 = g0 + 32; g2 = real0 + (t) * 64 + rr; } else { g0 = meta0 + (sr & 15); g1 = g0; g2 = meta0 + (rr & 15); } \
        sk0 = *reinterpret_cast<const bf16x8*>(KN + g0 * 2048 + h * 128 + sc); sk1 = *reinterpret_cast<const bf16x8*>(KN + g1 * 2048 + h * 128 + sc); \
        skr = *reinterpret_cast<const bf16x8*>(KR + g2 * 64 + rc); \
        sv0 = *reinterpret_cast<const bf16x8*>(V + g0 * 2048 + h * 128 + sc); sv1 = *reinterpret_cast<const bf16x8*>(V + g1 * 2048 + h * 128 + sc); } while (0)
#define MLA_WRITE(bf) do { char* base = lds + (bf) * BUF_BYTES; \
        *reinterpret_cast<bf16x8*>(base + OFF_KN + kn_w0) = sk0; *reinterpret_cast<bf16x8*>(base + OFF_KN + kn_w1) = sk1; *reinterpret_cast<bf16x8*>(base + OFF_KR + kr_w) = skr; \
        *reinterpret_cast<bf16x8*>(base + OFF_V + v_w0) = sv0; *reinterpret_cast<bf16x8*>(base + OFF_V + v_w1) = sv1; } while (0)
    float m_reg = NEG_BIG, l_reg = 0.f; f32x16 o[4];
#pragma unroll
    for (int d = 0; d < 4; ++d) o[d] = f32x16{};
    constexpr int NT = 65;
    MLA_LOAD(0); MLA_WRITE(0); __syncthreads();
    for (int t = 0; t < NT; ++t) {
        const int bf = t & 1;
        if (t + 1 < NT) MLA_LOAD(t + 1);
        if (wave_on) {
            const char* kn = lds + bf * BUF_BYTES + OFF_KN; const char* kr = lds + bf * BUF_BYTES + OFF_KR;
            f32x16 p0 = f32x16{}, p1 = f32x16{};
#pragma unroll
            for (int d0 = 0; d0 < 8; ++d0) { const int cb = d0 * 32 + hi * 16;
                const bf16x8 b0 = *reinterpret_cast<const bf16x8*>(kn + kn_off(r32, cb)), b1 = *reinterpret_cast<const bf16x8*>(kn + kn_off(32 + r32, cb));
                p0 = __builtin_amdgcn_mfma_f32_32x32x16_bf16(b0, qr[d0], p0, 0, 0, 0); p1 = __builtin_amdgcn_mfma_f32_32x32x16_bf16(b1, qr[d0], p1, 0, 0, 0); }
#pragma unroll
            for (int d0 = 0; d0 < 4; ++d0) { const int cb = d0 * 32 + hi * 16;
                const bf16x8 b0 = *reinterpret_cast<const bf16x8*>(kr + kr_off(r32, cb)), b1 = *reinterpret_cast<const bf16x8*>(kr + kr_off(32 + r32, cb));
                p0 = __builtin_amdgcn_mfma_f32_32x32x16_bf16(b0, qr[8 + d0], p0, 0, 0, 0); p1 = __builtin_amdgcn_mfma_f32_32x32x16_bf16(b1, qr[8 + d0], p1, 0, 0, 0); }
            if (t == NT - 1) {
#pragma unroll
                for (int r = 0; r < 16; ++r) { if (crow(r, hi) >= 16) p0[r] = NEG_BIG; p1[r] = NEG_BIG; }
            }
            float alpha; bf16x8 pa0, pa1, pa2, pa3;
            const bool resc = softmax_tile(p0, p1, m_reg, l_reg, alpha, pa0, pa1, pa2, pa3);
            if (resc) { if (hi == 0) wsf[r32] = alpha; asm volatile("s_waitcnt lgkmcnt(0)" ::: "memory");
#pragma unroll
                for (int d = 0; d < 4; ++d)
#pragma unroll
                    for (int r = 0; r < 16; ++r) o[d][r] *= wsf[crow(r, hi)]; }
            pv_all(o, vb0 + bf * BUF_BYTES, pa0, pa1, pa2, pa3);
        }
        if (t + 1 < NT) MLA_WRITE(bf ^ 1);
        __syncthreads();
    }
#undef MLA_LOAD
#undef MLA_WRITE
    if (wave_on) {
        if (hi == 0) wsf[32 + r32] = l_reg; asm volatile("s_waitcnt lgkmcnt(0)" ::: "memory");
        const int orow0 = metaq ? (TREAL + 16 * b) : (b * SEQ + qb * 256 + wid * 32);
#pragma unroll
        for (int r = 0; r < 16; ++r) { const int rw = crow(r, hi); const float rl = __builtin_amdgcn_rcpf(wsf[32 + rw]);
            if (!metaq || rw < 16) { bf16* op = OAB + (size_t)(orow0 + rw) * 4096 + h * 128 + r32;
#pragma unroll
                for (int d0 = 0; d0 < 4; ++d0) op[d0 * 32] = (bf16)(cvtpk(o[d0][r] * rl, 0.f) & 0xffffu); } }
    }
    __syncthreads();
}

__device__ __forceinline__ void swa_unit(char* lds, const bf16* __restrict__ QB, const bf16* __restrict__ KB, const bf16* __restrict__ VB, bf16* __restrict__ OAB,
                                         const float* __restrict__ bias_l2, const float* __restrict__ sink_l2, int b, int hk, int j) {
    int tid_ = threadIdx.x; asm volatile("" : "+v"(tid_)); const int tid = tid_, lane = tid & 63, r32 = lane & 31, hi = lane >> 5; const int wid = __builtin_amdgcn_readfirstlane(tid >> 6);
    const bool metaq = (j == 64);
    const int hq = 4 * hk + (wid >> 1);
    const bool wave_on = !metaq || (wid & 1) == 0;
    const int qpos = metaq ? (r32 & 15) : (NMETA + 64 * j + 32 * (wid & 1) + r32);
    const int qrow = metaq ? (TREAL + 16 * b + (r32 & 15)) : (b * SEQ + 64 * j + 32 * (wid & 1) + r32);
    float* wsf = (float*)(lds + OFF_WS) + wid * 64;
    float* bt = (float*)(lds + OFF_BT);
    for (int i = tid; i < 4 * 257; i += 512) { const int g = i / 257, e = i - g * 257; bt[g * 260 + e] = bias_l2[(4 * hk + g) * 257 + e]; }
    const float* btw = bt + (wid >> 1) * 260 + 128;
    bf16x8 qr[8];
    { const bf16* qp = QB + (size_t)qrow * 2048 + hq * 128 + hi * 8;
#pragma unroll
      for (int d0 = 0; d0 < 8; ++d0) qr[d0] = *reinterpret_cast<const bf16x8*>(qp + d0 * 16); }
    const int sr = tid >> 4, sc = (tid & 15) * 8;
    const int kn_w0 = kn_off(sr, sc * 2), kn_w1 = kn_off(32 + sr, sc * 2), v_w0 = v_st(sr, sc), v_w1 = v_st(32 + sr, sc);
    const int vb0 = (int)(uintptr_t)(lds + OFF_V) + v_rd_base(lane);
    bf16x8 sk0, sk1, sv0, sv1;
    int nt, kt_lo = 0;
    if (metaq) nt = 3; else { kt_lo = j - 2 < 0 ? 0 : j - 2; const int kt_hi = j + 2 > 63 ? 63 : j + 2; nt = 1 + (kt_hi - kt_lo + 1); }
#define SWA_TILE(t, kpos0, mode) do { if (metaq) { kpos0 = 64 * (t); mode = 2; } else if ((t) == 0) { kpos0 = 0; mode = 0; } else { kpos0 = NMETA + 64 * (kt_lo + (t) - 1); mode = 1; } } while (0)
#define SWA_ROW(kp) ({ int kp_ = (kp) > LPOS - 1 ? LPOS - 1 : (kp); (size_t)(kp_ < NMETA ? TREAL + 16 * b + kp_ : b * SEQ + kp_ - NMETA); })
#define SWA_LOAD(t) do { int kpos0_, mode_; SWA_TILE(t, kpos0_, mode_); (void)mode_; const size_t g0 = SWA_ROW(kpos0_ + sr), g1 = SWA_ROW(kpos0_ + 32 + sr); \
        sk0 = *reinterpret_cast<const bf16x8*>(KB + g0 * 512 + hk * 128 + sc); sk1 = *reinterpret_cast<const bf16x8*>(KB + g1 * 512 + hk * 128 + sc); \
        sv0 = *reinterpret_cast<const bf16x8*>(VB + g0 * 512 + hk * 128 + sc); sv1 = *reinterpret_cast<const bf16x8*>(VB + g1 * 512 + hk * 128 + sc); } while (0)
#define SWA_WRITE(bf) do { char* base = lds + (bf) * BUF_BYTES; \
        *reinterpret_cast<bf16x8*>(base + OFF_KN + kn_w0) = sk0; *reinterpret_cast<bf16x8*>(base + OFF_KN + kn_w1) = sk1; \
        *reinterpret_cast<bf16x8*>(base + OFF_V + v_w0) = sv0; *reinterpret_cast<bf16x8*>(base + OFF_V + v_w1) = sv1; } while (0)
    float m_reg = sink_l2[hq], l_reg = 1.f; f32x16 o[4];
#pragma unroll
    for (int d = 0; d < 4; ++d) o[d] = f32x16{};
    SWA_LOAD(0); SWA_WRITE(0); __syncthreads();
    for (int t = 0; t < nt; ++t) {
        const int bf = t & 1;
        if (t + 1 < nt) SWA_LOAD(t + 1);
        if (wave_on) {
            int kpos0, mode; SWA_TILE(t, kpos0, mode);
            const char* kn = lds + bf * BUF_BYTES + OFF_KN;
            f32x16 p0 = f32x16{}, p1 = f32x16{};
#pragma unroll
            for (int d0 = 0; d0 < 8; ++d0) { const int cb = d0 * 32 + hi * 16;
                const bf16x8 b0 = *reinterpret_cast<const bf16x8*>(kn + kn_off(r32, cb)), b1 = *reinterpret_cast<const bf16x8*>(kn + kn_off(32 + r32, cb));
                p0 = __builtin_amdgcn_mfma_f32_32x32x16_bf16(b0, qr[d0], p0, 0, 0, 0); p1 = __builtin_amdgcn_mfma_f32_32x32x16_bf16(b1, qr[d0], p1, 0, 0, 0); }
#pragma unroll
            for (int r = 0; r < 16; ++r) {
#pragma unroll
                for (int half = 0; half < 2; ++half) { const int kp = kpos0 + crow(r, hi) + 32 * half; const int rel = kp - qpos; const int arel = rel < 0 ? -rel : rel;
                    const bool win = (kp >= NMETA) && (arel <= 128) && (kp < LPOS);
                    const bool vis = mode == 0 ? (kp < NMETA) : (mode == 1 ? win : ((kp < NMETA) || win));
                    const int rc = rel < -128 ? -128 : (rel > 128 ? 128 : rel);
                    const float bias = btw[rc];
                    if (half == 0) p0[r] = vis ? p0[r] + bias : NEG_BIG; else p1[r] = vis ? p1[r] + bias : NEG_BIG; } }
            float alpha; bf16x8 pa0, pa1, pa2, pa3;
            const bool resc = softmax_tile(p0, p1, m_reg, l_reg, alpha, pa0, pa1, pa2, pa3);
            if (resc) { if (hi == 0) wsf[r32] = alpha; asm volatile("s_waitcnt lgkmcnt(0)" ::: "memory");
#pragma unroll
                for (int d = 0; d < 4; ++d)
#pragma unroll
                    for (int r = 0; r < 16; ++r) o[d][r] *= wsf[crow(r, hi)]; }
            pv_all(o, vb0 + bf * BUF_BYTES, pa0, pa1, pa2, pa3);
        }
        if (t + 1 < nt) SWA_WRITE(bf ^ 1);
        __syncthreads();
    }
#undef SWA_TILE
#undef SWA_ROW
#undef SWA_LOAD
#undef SWA_WRITE
    if (wave_on) {
        if (hi == 0) wsf[32 + r32] = l_reg; asm volatile("s_waitcnt lgkmcnt(0)" ::: "memory");
        const int orow0 = metaq ? (TREAL + 16 * b) : (b * SEQ + 64 * j + 32 * (wid & 1));
#pragma unroll
        for (int r = 0; r < 16; ++r) { const int rw = crow(r, hi); const float rl = __builtin_amdgcn_rcpf(wsf[32 + rw]);
            if (!metaq || rw < 16) { bf16* op = OAB + (size_t)(orow0 + rw) * 4096 + 2048 + hq * 128 + r32;
#pragma unroll
                for (int d0 = 0; d0 < 4; ++d0) op[d0 * 32] = (bf16)(cvtpk(o[d0][r] * rl, 0.f) & 0xffffu); } }
    }
    __syncthreads();
}
}
namespace att {
constexpr int M2_KSLOT = KN_BYTES + KR_BYTES;
constexpr int M2_OFF_K = 0, M2_OFF_V = 3 * M2_KSLOT;
constexpr int M2_OFF_WS = M2_OFF_V + 3 * V_BYTES;
constexpr int M2_LDS_BYTES = M2_OFF_WS + 8 * 64 * 4;
typedef __attribute__((address_space(3))) unsigned char* lds_ptr;

__device__ __forceinline__ void partialSM(f32x16& p0, f32x16& p1, float& m_reg, float& alpha) {
    float pmax = p0[0];
#pragma unroll
    for (int r = 1; r < 16; ++r) pmax = fmaxf(pmax, p0[r]);
#pragma unroll
    for (int r = 0; r < 16; ++r) pmax = fmaxf(pmax, p1[r]);
    { auto rr = __builtin_amdgcn_permlane32_swap(__float_as_uint(pmax), __float_as_uint(pmax), false, false); pmax = fmaxf(__uint_as_float(rr[0]), __uint_as_float(rr[1])); }
    if (__builtin_expect(__all(pmax - m_reg <= THR2), 1)) { alpha = 1.f; }
    else { const float mn = fmaxf(m_reg, pmax); alpha = __builtin_amdgcn_exp2f(m_reg - mn); m_reg = mn; }
    const float mn = m_reg;
#pragma unroll
    for (int r = 0; r < 16; ++r) p0[r] = __builtin_amdgcn_exp2f(p0[r] - mn);
#pragma unroll
    for (int r = 0; r < 16; ++r) p1[r] = p1[r] - mn;
}
__device__ __forceinline__ void finishSM(f32x16& p0, f32x16& p1, float alpha, float& l_reg, bf16x8& pa0, bf16x8& pa1, bf16x8& pa2, bf16x8& pa3) {
#pragma unroll
    for (int r = 0; r < 16; ++r) p1[r] = __builtin_amdgcn_exp2f(p1[r]);
    float ps = 0.f;
#pragma unroll
    for (int r = 0; r < 16; ++r) ps += p0[r];
#pragma unroll
    for (int r = 0; r < 16; ++r) ps += p1[r];
    { auto rr = __builtin_amdgcn_permlane32_swap(__float_as_uint(ps), __float_as_uint(ps), false, false); ps = __uint_as_float(rr[0]) + __uint_as_float(rr[1]); }
    l_reg = l_reg * alpha + ps;
#define PK4(P, BASE, OUT) do { unsigned a0 = cvtpk(P[BASE + 0], P[BASE + 1]), a1 = cvtpk(P[BASE + 2], P[BASE + 3]);   \
    unsigned b0 = cvtpk(P[BASE + 4], P[BASE + 5]), b1 = cvtpk(P[BASE + 6], P[BASE + 7]);                              \
    auto r0 = __builtin_amdgcn_permlane32_swap(a0, b0, false, false); auto r1 = __builtin_amdgcn_permlane32_swap(a1, b1, false, false); \
    u32x4 w = {r0[0], r1[0], r0[1], r1[1]}; OUT = *reinterpret_cast<bf16x8*>(&w); } while (0)
    PK4(p0, 0, pa0); PK4(p0, 8, pa1); PK4(p1, 0, pa2); PK4(p1, 8, pa3);
#undef PK4
}

__device__ __forceinline__ void mla_unit2(lds_ptr lds, const bf16* __restrict__ Q, const bf16* __restrict__ KN, const bf16* __restrict__ KR, const bf16* __restrict__ V, bf16* __restrict__ OAB, int b, int h, int qb) {
    int tid_ = threadIdx.x; asm volatile("" : "+v"(tid_)); const int tid = tid_, lane = tid & 63, r32 = lane & 31, hi = lane >> 5; const int wid = __builtin_amdgcn_readfirstlane(tid >> 6);
    const bool metaq = (qb == 16);
    const bool wave_on = !metaq || wid == 0;
    const int qrow = metaq ? (TREAL + 16 * b + (r32 & 15)) : (b * SEQ + qb * 256 + wid * 32 + r32);
    __attribute__((address_space(3))) float* wsf = (__attribute__((address_space(3))) float*)(lds + M2_OFF_WS) + wid * 64;
    unsigned so_kn[2], so_kr, so_v[2];
#pragma unroll
    for (int i = 0; i < 2; ++i) { const int P = 2 * wid + i;
        { const int row = 4 * P + (lane >> 4), c = (lane & 15) ^ (row & 15); so_kn[i] = (unsigned)(row * 4096 + c * 16); }
        { const int q = 64 * P + lane, s = q >> 5, kk = (s >> 2) * 8 + ((q & 31) >> 2), col = (s & 3) * 32 + (q & 3) * 8, k = (kk & ~0xC) | ((kk & 4) << 1) | ((kk & 8) >> 1); so_v[i] = (unsigned)(k * 4096 + col * 2); } }
    { const int row = 8 * wid + (lane >> 3), c = (lane & 7) ^ ((row >> 1) & 7); so_kr = (unsigned)(row * 128 + c * 16); }
    const char* const kn_h = (const char*)KN + h * 256; const char* const v_h = (const char*)V + h * 256; const char* const kr_b = (const char*)KR;
#define M2_DMA(src, dstoff) __builtin_amdgcn_global_load_lds((const unsigned*)(src), (__attribute__((address_space(3))) unsigned*)(lds + (dstoff)), 16, 0, 0)
#define M2_DMA_K(grow, slot) do { const size_t g_ = (size_t)(grow); const int so_ = M2_OFF_K + (slot) * M2_KSLOT; \
        M2_DMA(kn_h + g_ * 4096 + so_kn[0], so_ + (2 * wid) * 1024); M2_DMA(kn_h + g_ * 4096 + so_kn[1], so_ + (2 * wid + 1) * 1024); M2_DMA(kr_b + g_ * 128 + so_kr, so_ + KN_BYTES + wid * 1024); } while (0)
#define M2_DMA_V(grow, slot) do { const size_t g_ = (size_t)(grow); const int so_ = M2_OFF_V + (slot) * V_BYTES; \
        M2_DMA(v_h + g_ * 4096 + so_v[0], so_ + (2 * wid) * 1024); M2_DMA(v_h + g_ * 4096 + so_v[1], so_ + (2 * wid + 1) * 1024); } while (0)
#define M2_WAIT(n) asm volatile("s_waitcnt vmcnt(" #n ")" ::: "memory")
#define M2_BAR() do { asm volatile("" ::: "memory"); __builtin_amdgcn_s_barrier(); asm volatile("" ::: "memory"); } while (0)
    const size_t real0 = (size_t)b * SEQ, meta0 = (size_t)TREAL + 16 * b;
    M2_DMA_K(meta0, 2); M2_DMA_V(meta0, 2); M2_DMA_K(real0, 0); M2_DMA_V(real0, 0); M2_DMA_K(real0 + 64, 1);
    bf16x8 qr[12];
    { const bf16* qp = Q + (size_t)qrow * 3072 + h * 192 + hi * 8;
#pragma unroll
      for (int d0 = 0; d0 < 12; ++d0) qr[d0] = *reinterpret_cast<const bf16x8*>(qp + d0 * 16); }
    const int xkn = (r32 & 15) << 4, xkr = ((r32 >> 1) & 7) << 4, hb = hi * 16;
    const int vlane = v_rd_base(lane);
#define M2_QKT(P0, P1, slot) do { int xn_ = xkn, xr_ = xkr; asm volatile("" : "+v"(xn_), "+v"(xr_)); const lds_ptr kb_ = lds + M2_OFF_K + (slot) * M2_KSLOT + r32 * 256; const lds_ptr kr_ = lds + M2_OFF_K + (slot) * M2_KSLOT + KN_BYTES + r32 * 128; P0 = f32x16{}; P1 = f32x16{}; \
        _Pragma("unroll") for (int d0 = 0; d0 < 8; ++d0) { const int of_ = (d0 * 32 + hb) ^ xn_; const bf16x8 b0 = *(const __attribute__((address_space(3))) bf16x8*)(kb_ + of_), b1 = *(const __attribute__((address_space(3))) bf16x8*)(kb_ + of_ + 8192); \
            P0 = __builtin_amdgcn_mfma_f32_32x32x16_bf16(b0, qr[d0], P0, 0, 0, 0); P1 = __builtin_amdgcn_mfma_f32_32x32x16_bf16(b1, qr[d0], P1, 0, 0, 0); } \
        _Pragma("unroll") for (int d0 = 0; d0 < 4; ++d0) { const int of_ = (d0 * 32 + hb) ^ xr_; const bf16x8 b0 = *(const __attribute__((address_space(3))) bf16x8*)(kr_ + of_), b1 = *(const __attribute__((address_space(3))) bf16x8*)(kr_ + of_ + 4096); \
            P0 = __builtin_amdgcn_mfma_f32_32x32x16_bf16(b0, qr[8 + d0], P0, 0, 0, 0); P1 = __builtin_amdgcn_mfma_f32_32x32x16_bf16(b1, qr[8 + d0], P1, 0, 0, 0); } } while (0)
#define M2_PV(slot) pv_all(o, (int)(uintptr_t)(lds + M2_OFF_V + (slot) * V_BYTES) + vlane, pa0, pa1, pa2, pa3)
#define M2_RESC(a) do { if (__any((a) < 1.f)) { if (hi == 0) wsf[r32] = (a); asm volatile("s_waitcnt lgkmcnt(0)" ::: "memory"); \
        _Pragma("unroll") for (int d = 0; d < 4; ++d) _Pragma("unroll") for (int r = 0; r < 16; ++r) o[d][r] *= wsf[crow(r, hi)]; } } while (0)
    float m_reg = NEG_BIG, l_reg = 0.f; f32x16 o[4];
#pragma unroll
    for (int d = 0; d < 4; ++d) o[d] = f32x16{};
    f32x16 pA0, pA1, pB0, pB1; float alA = 1.f, alB = 1.f; bf16x8 pa0, pa1, pa2, pa3;
    M2_WAIT(0); M2_BAR();
    if (wave_on) {
        M2_QKT(pA0, pA1, 2);
#pragma unroll
        for (int r = 0; r < 16; ++r) { if (crow(r, hi) >= 16) pA0[r] = NEG_BIG; pA1[r] = NEG_BIG; }
        partialSM(pA0, pA1, m_reg, alA); finishSM(pA0, pA1, alA, l_reg, pa0, pa1, pa2, pa3);
        M2_PV(2);
    }
    M2_BAR();
    M2_DMA_K(real0 + 128, 2); M2_DMA_V(real0 + 64, 1);
    if (wave_on) { M2_QKT(pA0, pA1, 0); partialSM(pA0, pA1, m_reg, alA); M2_RESC(alA); }
    int ks = 1, vs = 0;
    for (int j = 1; j < 64; j += 2) {
        if (j < 62) M2_WAIT(5); else M2_WAIT(0);
        M2_BAR();
        { const int kn2 = ks == 0 ? 2 : ks - 1;
          const int vn1 = vs == 0 ? 2 : vs - 1;
          if (j + 2 < 64) M2_DMA_K(real0 + (size_t)(j + 2) * 64, kn2);
          if (j + 1 < 64) M2_DMA_V(real0 + (size_t)(j + 1) * 64, vn1); }
        if (wave_on) { SBAR(); M2_QKT(pB0, pB1, ks); finishSM(pA0, pA1, alA, l_reg, pa0, pa1, pa2, pa3); SBAR(); M2_PV(vs); partialSM(pB0, pB1, m_reg, alB); M2_RESC(alB); }
        ks = ks == 2 ? 0 : ks + 1; vs = vs == 2 ? 0 : vs + 1;
        if (j + 1 < 64) {
            if (j + 1 < 62) M2_WAIT(5); else M2_WAIT(0);
            M2_BAR();
            { const int kn2 = ks == 0 ? 2 : ks - 1; const int vn1 = vs == 0 ? 2 : vs - 1;
              if (j + 3 < 64) M2_DMA_K(real0 + (size_t)(j + 3) * 64, kn2);
              if (j + 2 < 64) M2_DMA_V(real0 + (size_t)(j + 2) * 64, vn1); }
            if (wave_on) { SBAR(); M2_QKT(pA0, pA1, ks); finishSM(pB0, pB1, alB, l_reg, pa0, pa1, pa2, pa3); SBAR(); M2_PV(vs); partialSM(pA0, pA1, m_reg, alA); M2_RESC(alA); }
            ks = ks == 2 ? 0 : ks + 1; vs = vs == 2 ? 0 : vs + 1;
        }
    }
    M2_WAIT(0); M2_BAR();
    if (wave_on) {
        finishSM(pB0, pB1, alB, l_reg, pa0, pa1, pa2, pa3); M2_PV(vs);
        if (hi == 0) wsf[32 + r32] = l_reg; asm volatile("s_waitcnt lgkmcnt(0)" ::: "memory");
        const int orow0 = metaq ? (TREAL + 16 * b) : (b * SEQ + qb * 256 + wid * 32);
#pragma unroll
        for (int r = 0; r < 16; ++r) { const int rw = crow(r, hi); const float rl = __builtin_amdgcn_rcpf(wsf[32 + rw]);
            if (!metaq || rw < 16) { bf16* op = OAB + (size_t)(orow0 + rw) * 4096 + h * 128 + r32;
#pragma unroll
                for (int d0 = 0; d0 < 4; ++d0) op[d0 * 32] = (bf16)(cvtpk(o[d0][r] * rl, 0.f) & 0xffffu); } }
    }
    M2_BAR();
#undef M2_DMA
#undef M2_DMA_K
#undef M2_DMA_V
#undef M2_WAIT
#undef M2_BAR
#undef M2_QKT
#undef M2_PV
#undef M2_RESC
}
}
namespace att {
constexpr int M3_NT = 65;
__device__ __forceinline__ void softmax_seg(f32x16& p0, f32x16& p1, float& m_reg, float& l_reg, float& alpha, bf16x8& pa0, bf16x8& pa1, bf16x8& pa2, bf16x8& pa3) {
    float pmax = p0[0];
#pragma unroll
    for (int r = 1; r < 16; ++r) pmax = fmaxf(pmax, p0[r]);
#pragma unroll
    for (int r = 0; r < 16; ++r) pmax = fmaxf(pmax, p1[r]);
    { auto rr = __builtin_amdgcn_permlane32_swap(__float_as_uint(pmax), __float_as_uint(pmax), false, false); pmax = fmaxf(__uint_as_float(rr[0]), __uint_as_float(rr[1])); }
    if (__builtin_expect(__all(pmax - m_reg <= THR2), 1)) { alpha = 1.f; }
    else { const float mn = fmaxf(m_reg, pmax); alpha = __builtin_amdgcn_exp2f(m_reg - mn); m_reg = mn; }
    const float mn = m_reg; float ps = 0.f;
#pragma unroll
    for (int r = 0; r < 16; ++r) { p0[r] = __builtin_amdgcn_exp2f(p0[r] - mn); ps += p0[r]; }
#pragma unroll
    for (int r = 0; r < 16; ++r) { p1[r] = __builtin_amdgcn_exp2f(p1[r] - mn); ps += p1[r]; }
    { auto rr = __builtin_amdgcn_permlane32_swap(__float_as_uint(ps), __float_as_uint(ps), false, false); ps = __uint_as_float(rr[0]) + __uint_as_float(rr[1]); }
    l_reg = l_reg * alpha + ps;
#define PK4(P, BASE, OUT) do { unsigned a0 = cvtpk(P[BASE + 0], P[BASE + 1]), a1 = cvtpk(P[BASE + 2], P[BASE + 3]);   \
    unsigned b0 = cvtpk(P[BASE + 4], P[BASE + 5]), b1 = cvtpk(P[BASE + 6], P[BASE + 7]);                              \
    auto r0 = __builtin_amdgcn_permlane32_swap(a0, b0, false, false); auto r1 = __builtin_amdgcn_permlane32_swap(a1, b1, false, false); \
    u32x4 w = {r0[0], r1[0], r0[1], r1[1]}; OUT = *reinterpret_cast<bf16x8*>(&w); } while (0)
    PK4(p0, 0, pa0); PK4(p0, 8, pa1); PK4(p1, 0, pa2); PK4(p1, 8, pa3);
#undef PK4
}

__device__ __forceinline__ void mla_unit3(lds_ptr lds, const bf16* __restrict__ Q, const bf16* __restrict__ KN, const bf16* __restrict__ KR, const bf16* __restrict__ V, bf16* __restrict__ OAB, int b, int h, int qb) {
    int tid_ = threadIdx.x; asm volatile("" : "+v"(tid_)); const int tid = tid_, lane = tid & 63, r32 = lane & 31, hi = lane >> 5; const int wid = __builtin_amdgcn_readfirstlane(tid >> 6);
    const bool metaq = (qb == 16);
    const bool wave_on = !metaq || wid == 0;
    const int qrow = metaq ? (TREAL + 16 * b + (r32 & 15)) : (b * SEQ + qb * 256 + wid * 32 + r32);
    __attribute__((address_space(3))) float* wsf = (__attribute__((address_space(3))) float*)(lds + M2_OFF_WS) + wid * 64;
    unsigned so_kn[2], so_kr, so_v[2];
#pragma unroll
    for (int i = 0; i < 2; ++i) { const int P = 2 * wid + i;
        { const int row = 4 * P + (lane >> 4), c = (lane & 15) ^ (row & 15); so_kn[i] = (unsigned)(row * 4096 + c * 16); }
        { const int q = 64 * P + lane, s = q >> 5, kk = (s >> 2) * 8 + ((q & 31) >> 2), col = (s & 3) * 32 + (q & 3) * 8, k = (kk & ~0xC) | ((kk & 4) << 1) | ((kk & 8) >> 1); so_v[i] = (unsigned)(k * 4096 + col * 2); } }
    { const int row = 8 * wid + (lane >> 3), c = (lane & 7) ^ ((row >> 1) & 7); so_kr = (unsigned)(row * 128 + c * 16); }
    const char* const kn_h = (const char*)KN + h * 256; const char* const v_h = (const char*)V + h * 256; const char* const kr_b = (const char*)KR;
    const size_t real0 = (size_t)b * SEQ, meta0 = (size_t)TREAL + 16 * b;
#define M3_ROW(t) ((t) == 0 ? meta0 : real0 + (size_t)((t) - 1) * 64)
#define M3_DMA(src, dstoff) __builtin_amdgcn_global_load_lds((const unsigned*)(src), (__attribute__((address_space(3))) unsigned*)(lds + (dstoff)), 16, 0, 0)
#define M3_DMA_K(t, slot) do { const size_t g_ = M3_ROW(t); const int so_ = M2_OFF_K + (slot) * M2_KSLOT; \
        M3_DMA(kn_h + g_ * 4096 + so_kn[0], so_ + (2 * wid) * 1024); M3_DMA(kn_h + g_ * 4096 + so_kn[1], so_ + (2 * wid + 1) * 1024); M3_DMA(kr_b + g_ * 128 + so_kr, so_ + KN_BYTES + wid * 1024); } while (0)
#define M3_DMA_V(t, slot) do { const size_t g_ = M3_ROW(t); const int so_ = M2_OFF_V + (slot) * V_BYTES; \
        M3_DMA(v_h + g_ * 4096 + so_v[0], so_ + (2 * wid) * 1024); M3_DMA(v_h + g_ * 4096 + so_v[1], so_ + (2 * wid + 1) * 1024); } while (0)
#define M3_WAIT(n) asm volatile("s_waitcnt vmcnt(" #n ")" ::: "memory")
#define M3_BAR() do { asm volatile("" ::: "memory"); __builtin_amdgcn_s_barrier(); asm volatile("" ::: "memory"); } while (0)
#define M3_EVENT(i, s3) do { if ((i) + 2 < M3_NT) M3_DMA_K((i) + 2, (s3) == 0 ? 2 : (s3) - 1); if ((i) + 1 < M3_NT) M3_DMA_V((i) + 1, (s3) == 2 ? 0 : (s3) + 1); } while (0)
#define M3_WAITI(i) do { if ((i) < M3_NT - 2) M3_WAIT(5); else M3_WAIT(0); } while (0)
    M3_DMA_K(0, 0); M3_DMA_V(0, 0); M3_DMA_K(1, 1);
    bf16x8 qr[12];
    { const bf16* qp = Q + (size_t)qrow * 3072 + h * 192 + hi * 8;
#pragma unroll
      for (int d0 = 0; d0 < 12; ++d0) qr[d0] = *reinterpret_cast<const bf16x8*>(qp + d0 * 16); }
    const int xkn = (r32 & 15) << 4, xkr = ((r32 >> 1) & 7) << 4, hb = hi * 16;
    const int vlane = v_rd_base(lane);
#define M3_KLD(d, A0, A1) do { if ((d) < 8) { const int of_ = (((d) * 32 + hb) ^ xn_); A0 = *(const __attribute__((address_space(3))) bf16x8*)(kb_ + of_); A1 = *(const __attribute__((address_space(3))) bf16x8*)(kb_ + of_ + 8192); } \
        else { const int of_ = ((((d) - 8) * 32 + hb) ^ xr_); A0 = *(const __attribute__((address_space(3))) bf16x8*)(kr_ + of_); A1 = *(const __attribute__((address_space(3))) bf16x8*)(kr_ + of_ + 4096); } } while (0)
#define M3_KMM(d, A0, A1) do { p0 = __builtin_amdgcn_mfma_f32_32x32x16_bf16(A0, qr[d], p0, 0, 0, 0); p1 = __builtin_amdgcn_mfma_f32_32x32x16_bf16(A1, qr[d], p1, 0, 0, 0); } while (0)
#define M3_QKT(slot) do { int xn_ = xkn, xr_ = xkr; asm volatile("" : "+v"(xn_), "+v"(xr_)); const lds_ptr kb_ = lds + M2_OFF_K + (slot) * M2_KSLOT + r32 * 256; const lds_ptr kr_ = lds + M2_OFF_K + (slot) * M2_KSLOT + KN_BYTES + r32 * 128; p0 = f32x16{}; p1 = f32x16{}; \
        bf16x8 k0a, k0b, k1a, k1b, k2a, k2b, k3a, k3b; \
        M3_KLD(0, k0a, k0b); M3_KLD(1, k1a, k1b); M3_KLD(2, k2a, k2b); M3_KLD(3, k3a, k3b); SBAR(); \
        M3_KMM(0, k0a, k0b); M3_KLD(4, k0a, k0b); SBAR(); M3_KMM(1, k1a, k1b); M3_KLD(5, k1a, k1b); SBAR(); M3_KMM(2, k2a, k2b); M3_KLD(6, k2a, k2b); SBAR(); M3_KMM(3, k3a, k3b); M3_KLD(7, k3a, k3b); SBAR(); \
        M3_KMM(4, k0a, k0b); M3_KLD(8, k0a, k0b); SBAR(); M3_KMM(5, k1a, k1b); M3_KLD(9, k1a, k1b); SBAR(); M3_KMM(6, k2a, k2b); M3_KLD(10, k2a, k2b); SBAR(); M3_KMM(7, k3a, k3b); M3_KLD(11, k3a, k3b); SBAR(); \
        M3_KMM(8, k0a, k0b); SBAR(); M3_KMM(9, k1a, k1b); SBAR(); M3_KMM(10, k2a, k2b); SBAR(); M3_KMM(11, k3a, k3b); } while (0)
#define M3_PV(slot) pv_all(o, (int)(uintptr_t)(lds + M2_OFF_V + (slot) * V_BYTES) + vlane, pa0, pa1, pa2, pa3)
#define M3_X(j, s3) do { if (wave_on) { M3_QKT(s3); if ((j) > 0) M3_PV((s3) == 0 ? 2 : (s3) - 1); } } while (0)
#define M3_Y(j) do { if (wave_on) { if ((j) == 0) { _Pragma("unroll") for (int r = 0; r < 16; ++r) { if (crow(r, hi) >= 16) p0[r] = NEG_BIG; p1[r] = NEG_BIG; } } \
        float alpha_; softmax_seg(p0, p1, m_reg, l_reg, alpha_, pa0, pa1, pa2, pa3); \
        if (__any(alpha_ < 1.f)) { if (hi == 0) wsf[r32] = alpha_; asm volatile("s_waitcnt lgkmcnt(0)" ::: "memory"); \
            _Pragma("unroll") for (int d = 0; d < 4; ++d) _Pragma("unroll") for (int r = 0; r < 16; ++r) o[d][r] *= wsf[crow(r, hi)]; } } } while (0)
    float m_reg = NEG_BIG, l_reg = 0.f; f32x16 o[4];
#pragma unroll
    for (int d = 0; d < 4; ++d) o[d] = f32x16{};
    f32x16 p0, p1; bf16x8 pa0, pa1, pa2, pa3;
    int s3 = 0;
    if (wid < 4) {
        for (int j = 0; j < M3_NT; ++j) {
            M3_WAITI(j); M3_BAR();
            M3_X(j, s3);
            M3_BAR(); M3_EVENT(j, s3);
            M3_Y(j);
            s3 = s3 == 2 ? 0 : s3 + 1;
        }
        M3_BAR();
        if (wave_on) M3_PV(s3 == 0 ? 2 : s3 - 1);
        M3_BAR();
    } else {
        M3_WAITI(0); M3_BAR(); M3_EVENT(0, 0);
        for (int j = 0; j < M3_NT; ++j) {
            M3_BAR();
            M3_X(j, s3);
            M3_WAITI(j + 1); M3_BAR(); { const int s3n = s3 == 2 ? 0 : s3 + 1; M3_EVENT(j + 1, s3n); }
            M3_Y(j);
            s3 = s3 == 2 ? 0 : s3 + 1;
        }
        M3_BAR();
        if (wave_on) M3_PV(s3 == 0 ? 2 : s3 - 1);
    }
    if (wave_on) {
        if (hi == 0) wsf[32 + r32] = l_reg; asm volatile("s_waitcnt lgkmcnt(0)" ::: "memory");
        const int orow0 = metaq ? (TREAL + 16 * b) : (b * SEQ + qb * 256 + wid * 32);
#pragma unroll
        for (int r = 0; r < 16; ++r) { const int rw = crow(r, hi); const float rl = __builtin_amdgcn_rcpf(wsf[32 + rw]);
            if (!metaq || rw < 16) { bf16* op = OAB + (size_t)(orow0 + rw) * 4096 + h * 128 + r32;
#pragma unroll
                for (int d0 = 0; d0 < 4; ++d0) op[d0 * 32] = (bf16)(cvtpk(o[d0][r] * rl, 0.f) & 0xffffu); } }
    }
    M3_WAIT(0); M3_BAR();
#undef M3_ROW
#undef M3_DMA
#undef M3_DMA_K
#undef M3_DMA_V
#undef M3_WAIT
#undef M3_BAR
#undef M3_EVENT
#undef M3_WAITI
#undef M3_QKT
#undef M3_KLD
#undef M3_KMM
#undef M3_PV
#undef M3_X
#undef M3_Y
}
}
namespace att {
constexpr int S2_OFF_K = 0, S2_OFF_V = 3 * KN_BYTES, S2_OFF_TW = S2_OFF_V + 3 * V_BYTES;
constexpr int S2_OFF_TM = S2_OFF_TW + 4 * 512 * 4, S2_OFF_WS = S2_OFF_TM + 4 * 256 * 4, S2_LDS_BYTES = S2_OFF_WS + 8 * 64 * 4;
__device__ __forceinline__ void swa_unit2(lds_ptr lds, const bf16* __restrict__ QB, const bf16* __restrict__ KB, const bf16* __restrict__ VB, bf16* __restrict__ OAB,
                                          const float* __restrict__ tw_g, const float* __restrict__ tm_g, const float* __restrict__ sink_l2, int b, int hk, int j, int& tables_hk, const int tid_in) {
    int tid_ = tid_in; asm volatile("" : "+v"(tid_)); const int tid = tid_, lane = tid & 63, r32 = lane & 31, hi = lane >> 5; const int wid = __builtin_amdgcn_readfirstlane(tid >> 6);
    const bool metaq = (j == 64);
    const int hq = 4 * hk + (wid >> 1);
    const bool wave_on = !metaq || (wid & 1) == 0;
    const int qpos = metaq ? (r32 & 15) : (NMETA + 64 * j + 32 * (wid & 1) + r32);
    const int qrow = metaq ? (TREAL + 16 * b + (r32 & 15)) : (b * SEQ + 64 * j + 32 * (wid & 1) + r32);
    __attribute__((address_space(3))) float* wsf = (__attribute__((address_space(3))) float*)(lds + S2_OFF_WS) + wid * 64;
    int nt, kt_lo = 0;
    if (metaq) nt = 3; else { kt_lo = j - 2 < 0 ? 0 : j - 2; const int kt_hi = j + 2 > 63 ? 63 : j + 2; nt = 1 + (kt_hi - kt_lo + 1); }
#define S2_KPOS0(t) (metaq ? 64 * (t) : ((t) == 0 ? 0 : NMETA + 64 * (kt_lo + (t) - 1)))
#define S2_ROW(kp) ({ int kp_ = (kp) > LPOS - 1 ? LPOS - 1 : (kp); (kp_ < NMETA ? TREAL + 16 * b + kp_ : b * SEQ + kp_ - NMETA); })
    int kk_k[2], kk_v[2]; unsigned co_k[2], co_v[2];
#pragma unroll
    for (int i = 0; i < 2; ++i) { const int P = 2 * wid + i;
        { const int row = 4 * P + (lane >> 4), c = (lane & 15) ^ (row & 15); kk_k[i] = row; co_k[i] = (unsigned)(c * 16); }
        { const int q = 64 * P + lane, s = q >> 5, kk = (s >> 2) * 8 + ((q & 31) >> 2), col = (s & 3) * 32 + (q & 3) * 8, k = (kk & ~0xC) | ((kk & 4) << 1) | ((kk & 8) >> 1); kk_v[i] = k; co_v[i] = (unsigned)(col * 2); } }
    const char* const kb_h = (const char*)KB + hk * 256; const char* const vb_h = (const char*)VB + hk * 256;
#define S2_DMA(src, dstoff) __builtin_amdgcn_global_load_lds((const unsigned*)(src), (__attribute__((address_space(3))) unsigned*)(lds + (dstoff)), 16, 0, 0)
#define S2_DMA_TILE(t, slot) do { const int kp0_ = S2_KPOS0(t); \
        _Pragma("unroll") for (int i_ = 0; i_ < 2; ++i_) { S2_DMA(kb_h + (size_t)S2_ROW(kp0_ + kk_k[i_]) * 1024 + co_k[i_], S2_OFF_K + (slot) * KN_BYTES + (2 * wid + i_) * 1024); \
                                                          S2_DMA(vb_h + (size_t)S2_ROW(kp0_ + kk_v[i_]) * 1024 + co_v[i_], S2_OFF_V + (slot) * V_BYTES + (2 * wid + i_) * 1024); } } while (0)
#define S2_BAR() do { asm volatile("s_waitcnt lgkmcnt(0)" ::: "memory"); __builtin_amdgcn_s_barrier(); asm volatile("" ::: "memory"); } while (0)
    S2_DMA_TILE(0, 0); S2_DMA_TILE(1, 1); S2_DMA_TILE(2, 2);
    bf16x8 qr[8];
    { const bf16* qp = QB + (size_t)qrow * 2048 + hq * 128 + hi * 8;
#pragma unroll
      for (int d0 = 0; d0 < 8; ++d0) qr[d0] = *reinterpret_cast<const bf16x8*>(qp + d0 * 16); }
    if (tables_hk != hk) {
        __attribute__((address_space(3))) float* tw = (__attribute__((address_space(3))) float*)(lds + S2_OFF_TW); __attribute__((address_space(3))) float* tm = (__attribute__((address_space(3))) float*)(lds + S2_OFF_TM);
        for (int i = tid; i < 4 * 512; i += 512) tw[i] = tw_g[(4 * hk) * 512 + i];
        for (int i = tid; i < 4 * 256; i += 512) tm[i] = tm_g[(4 * hk) * 256 + i];
        tables_hk = hk;
    }
    const int xkn = (r32 & 15) << 4, hb = hi * 16;
    const int vlane = v_rd_base(lane);
    const float sink = sink_l2[hq];
    float m_reg = sink, l_reg = 1.f; f32x16 o[4];
#pragma unroll
    for (int d = 0; d < 4; ++d) o[d] = f32x16{};
    f32x16 p0, p1; bf16x8 pa0, pa1, pa2, pa3;
#define S2_KLD(d, A0, A1) do { const int of_ = (((d) * 32 + hb) ^ xn_); A0 = *(const __attribute__((address_space(3))) bf16x8*)(kb_ + of_); A1 = *(const __attribute__((address_space(3))) bf16x8*)(kb_ + of_ + 8192); } while (0)
#define S2_KMM(d, A0, A1) do { p0 = __builtin_amdgcn_mfma_f32_32x32x16_bf16(A0, qr[d], p0, 0, 0, 0); p1 = __builtin_amdgcn_mfma_f32_32x32x16_bf16(A1, qr[d], p1, 0, 0, 0); } while (0)
    int slot = 0;
    for (int t = 0; t < nt; ++t) {
        { const int ahead = (nt < t + 3 ? nt : t + 3) - t - 1;
          if (ahead >= 2) asm volatile("s_waitcnt vmcnt(8)" ::: "memory"); else if (ahead == 1) asm volatile("s_waitcnt vmcnt(4)" ::: "memory"); else asm volatile("s_waitcnt vmcnt(0)" ::: "memory"); }
        S2_BAR();
        if (wave_on) {
            const int kpos0 = S2_KPOS0(t);
            { int xn_ = xkn; asm volatile("" : "+v"(xn_)); const lds_ptr kb_ = lds + S2_OFF_K + slot * KN_BYTES + r32 * 256; p0 = f32x16{}; p1 = f32x16{};
              bf16x8 k0a, k0b, k1a, k1b, k2a, k2b, k3a, k3b;
              S2_KLD(0, k0a, k0b); S2_KLD(1, k1a, k1b); S2_KLD(2, k2a, k2b); S2_KLD(3, k3a, k3b); SBAR();
              S2_KMM(0, k0a, k0b); S2_KLD(4, k0a, k0b); SBAR(); S2_KMM(1, k1a, k1b); S2_KLD(5, k1a, k1b); SBAR(); S2_KMM(2, k2a, k2b); S2_KLD(6, k2a, k2b); SBAR(); S2_KMM(3, k3a, k3b); S2_KLD(7, k3a, k3b); SBAR();
              S2_KMM(4, k0a, k0b); SBAR(); S2_KMM(5, k1a, k1b); SBAR(); S2_KMM(6, k2a, k2b); SBAR(); S2_KMM(7, k3a, k3b); }
            if (!metaq && t == 0) {
                int base = 4 * hi - qpos; base = base < -256 ? -256 : base;
                const __attribute__((address_space(3))) float* tb = (const __attribute__((address_space(3))) float*)(lds + S2_OFF_TM) + (wid >> 1) * 256 + base + 256;
#pragma unroll
                for (int r = 0; r < 16; ++r) { if (r < 8) p0[r] += tb[(r & 3) + 8 * (r >> 2)]; else p0[r] = NEG_BIG; p1[r] = NEG_BIG; }
            } else {
                const int base = kpos0 + 4 * hi - qpos;
                const __attribute__((address_space(3))) float* tb = (const __attribute__((address_space(3))) float*)(lds + S2_OFF_TW) + (wid >> 1) * 512 + base + 256;
#pragma unroll
                for (int r = 0; r < 16; ++r) { p0[r] += tb[(r & 3) + 8 * (r >> 2)]; p1[r] += tb[(r & 3) + 8 * (r >> 2) + 32]; }
                if (kpos0 + 64 > LPOS) {
#pragma unroll
                    for (int r = 0; r < 16; ++r) { if (kpos0 + crow(r, hi) >= LPOS) p0[r] = NEG_BIG; if (kpos0 + 32 + crow(r, hi) >= LPOS) p1[r] = NEG_BIG; } }
            }
            float alpha; softmax_seg(p0, p1, m_reg, l_reg, alpha, pa0, pa1, pa2, pa3);
            if (__any(alpha < 1.f)) { if (hi == 0) wsf[r32] = alpha; asm volatile("s_waitcnt lgkmcnt(0)" ::: "memory");
#pragma unroll
                for (int d = 0; d < 4; ++d)
#pragma unroll
                    for (int r = 0; r < 16; ++r) o[d][r] *= wsf[crow(r, hi)]; }
            pv_all(o, (int)(uintptr_t)(lds + S2_OFF_V + slot * V_BYTES) + vlane, pa0, pa1, pa2, pa3);
        }
        if (t + 3 < nt) { S2_BAR(); S2_DMA_TILE(t + 3, slot); }
        slot = slot == 2 ? 0 : slot + 1;
    }
    if (wave_on) {
        if (hi == 0) wsf[32 + r32] = l_reg; asm volatile("s_waitcnt lgkmcnt(0)" ::: "memory");
        const int orow0 = metaq ? (TREAL + 16 * b) : (b * SEQ + 64 * j + 32 * (wid & 1));
#pragma unroll
        for (int r = 0; r < 16; ++r) { const int rw = crow(r, hi); const float rl = __builtin_amdgcn_rcpf(wsf[32 + rw]);
            if (!metaq || rw < 16) { bf16* op = OAB + (size_t)(orow0 + rw) * 4096 + 2048 + hq * 128 + r32;
#pragma unroll
                for (int d0 = 0; d0 < 4; ++d0) op[d0 * 32] = (bf16)(cvtpk(o[d0][r] * rl, 0.f) & 0xffffu); } }
    }
    asm volatile("s_waitcnt vmcnt(0)" ::: "memory"); S2_BAR();
#undef S2_KPOS0
#undef S2_ROW
#undef S2_DMA
#undef S2_DMA_TILE
#undef S2_BAR
#undef S2_KLD
#undef S2_KMM
}
}
namespace att {
template <int OFF> __device__ __forceinline__ bf16x8 lds_rd128(int addr) { bf16x8 r; asm volatile("ds_read_b128 %0, %1 offset:%2" : "=&v"(r) : "v"(addr), "i"(OFF) : "memory"); return r; }
#define M4_XFULL(KS, VS) do { \
    int xn_ = xkn, xr_ = xkr; asm volatile("" : "+v"(xn_), "+v"(xr_)); \
    const int kbn_ = (int)(uintptr_t)(lds + M2_OFF_K + (KS) * M2_KSLOT) + r32 * 256, kbr_ = (int)(uintptr_t)(lds + M2_OFF_K + (KS) * M2_KSLOT + KN_BYTES) + r32 * 128; \
    const int vb_ = (int)(uintptr_t)(lds + M2_OFF_V + (VS) * V_BYTES) + vlane; (void)vb_; \
    bf16x8 ka0, ka1, ka2, ka3, ka4, kb0, kb1, kb2, kb3, kb4; s16x4 vl0, vl1, vl2, vl3, vl4, vh0, vh1, vh2, vh3, vh4; \
    p0 = f32x16{}; p1 = f32x16{}; \
    { const int a_ = kbn_ + (((0) * 32 + hb) ^ xn_); ka0 = lds_rd128<0>(a_); kb0 = lds_rd128<8192>(a_); } \
    { const int a_ = kbn_ + (((1) * 32 + hb) ^ xn_); ka1 = lds_rd128<0>(a_); kb1 = lds_rd128<8192>(a_); } \
    { const int a_ = kbn_ + (((2) * 32 + hb) ^ xn_); ka2 = lds_rd128<0>(a_); kb2 = lds_rd128<8192>(a_); } \
    { const int a_ = kbn_ + (((3) * 32 + hb) ^ xn_); ka3 = lds_rd128<0>(a_); kb3 = lds_rd128<8192>(a_); } \
    { const int a_ = kbn_ + (((4) * 32 + hb) ^ xn_); ka4 = lds_rd128<0>(a_); kb4 = lds_rd128<8192>(a_); } \
    asm volatile("s_waitcnt lgkmcnt(8)" ::: "memory"); SBAR(); p0 = __builtin_amdgcn_mfma_f32_32x32x16_bf16(ka0, qr[0], p0, 0, 0, 0); p1 = __builtin_amdgcn_mfma_f32_32x32x16_bf16(kb0, qr[0], p1, 0, 0, 0); SBAR(); \
    { const int a_ = kbn_ + (((5) * 32 + hb) ^ xn_); ka0 = lds_rd128<0>(a_); kb0 = lds_rd128<8192>(a_); } \
    asm volatile("s_waitcnt lgkmcnt(8)" ::: "memory"); SBAR(); p0 = __builtin_amdgcn_mfma_f32_32x32x16_bf16(ka1, qr[1], p0, 0, 0, 0); p1 = __builtin_amdgcn_mfma_f32_32x32x16_bf16(kb1, qr[1], p1, 0, 0, 0); SBAR(); \
    { const int a_ = kbn_ + (((6) * 32 + hb) ^ xn_); ka1 = lds_rd128<0>(a_); kb1 = lds_rd128<8192>(a_); } \
    asm volatile("s_waitcnt lgkmcnt(8)" ::: "memory"); SBAR(); p0 = __builtin_amdgcn_mfma_f32_32x32x16_bf16(ka2, qr[2], p0, 0, 0, 0); p1 = __builtin_amdgcn_mfma_f32_32x32x16_bf16(kb2, qr[2], p1, 0, 0, 0); SBAR(); \
    { const int a_ = kbn_ + (((7) * 32 + hb) ^ xn_); ka2 = lds_rd128<0>(a_); kb2 = lds_rd128<8192>(a_); } \
    asm volatile("s_waitcnt lgkmcnt(8)" ::: "memory"); SBAR(); p0 = __builtin_amdgcn_mfma_f32_32x32x16_bf16(ka3, qr[3], p0, 0, 0, 0); p1 = __builtin_amdgcn_mfma_f32_32x32x16_bf16(kb3, qr[3], p1, 0, 0, 0); SBAR(); \
    { const int a_ = kbr_ + (((0) * 32 + hb) ^ xr_); ka3 = lds_rd128<0>(a_); kb3 = lds_rd128<4096>(a_); } \
    asm volatile("s_waitcnt lgkmcnt(8)" ::: "memory"); SBAR(); p0 = __builtin_amdgcn_mfma_f32_32x32x16_bf16(ka4, qr[4], p0, 0, 0, 0); p1 = __builtin_amdgcn_mfma_f32_32x32x16_bf16(kb4, qr[4], p1, 0, 0, 0); SBAR(); \
    { const int a_ = kbr_ + (((1) * 32 + hb) ^ xr_); ka4 = lds_rd128<0>(a_); kb4 = lds_rd128<4096>(a_); } \
    asm volatile("s_waitcnt lgkmcnt(8)" ::: "memory"); SBAR(); p0 = __builtin_amdgcn_mfma_f32_32x32x16_bf16(ka0, qr[5], p0, 0, 0, 0); p1 = __builtin_amdgcn_mfma_f32_32x32x16_bf16(kb0, qr[5], p1, 0, 0, 0); SBAR(); \
    { const int a_ = kbr_ + (((2) * 32 + hb) ^ xr_); ka0 = lds_rd128<0>(a_); kb0 = lds_rd128<4096>(a_); } \
    asm volatile("s_waitcnt lgkmcnt(8)" ::: "memory"); SBAR(); p0 = __builtin_amdgcn_mfma_f32_32x32x16_bf16(ka1, qr[6], p0, 0, 0, 0); p1 = __builtin_amdgcn_mfma_f32_32x32x16_bf16(kb1, qr[6], p1, 0, 0, 0); SBAR(); \
    { const int a_ = kbr_ + (((3) * 32 + hb) ^ xr_); ka1 = lds_rd128<0>(a_); kb1 = lds_rd128<4096>(a_); } \
    asm volatile("s_waitcnt lgkmcnt(8)" ::: "memory"); SBAR(); p0 = __builtin_amdgcn_mfma_f32_32x32x16_bf16(ka2, qr[7], p0, 0, 0, 0); p1 = __builtin_amdgcn_mfma_f32_32x32x16_bf16(kb2, qr[7], p1, 0, 0, 0); SBAR(); \
    { vl2 = tr_read<v_rd_off(0, 0, 0)>(vb_); vh2 = tr_read<v_rd_off(0, 0, 1)>(vb_); } \
    asm volatile("s_waitcnt lgkmcnt(8)" ::: "memory"); SBAR(); p0 = __builtin_amdgcn_mfma_f32_32x32x16_bf16(ka3, qr[8], p0, 0, 0, 0); p1 = __builtin_amdgcn_mfma_f32_32x32x16_bf16(kb3, qr[8], p1, 0, 0, 0); SBAR(); \
    { vl3 = tr_read<v_rd_off(0, 1, 0)>(vb_); vh3 = tr_read<v_rd_off(0, 1, 1)>(vb_); } \
    asm volatile("s_waitcnt lgkmcnt(8)" ::: "memory"); SBAR(); p0 = __builtin_amdgcn_mfma_f32_32x32x16_bf16(ka4, qr[9], p0, 0, 0, 0); p1 = __builtin_amdgcn_mfma_f32_32x32x16_bf16(kb4, qr[9], p1, 0, 0, 0); SBAR(); \
    { vl4 = tr_read<v_rd_off(0, 2, 0)>(vb_); vh4 = tr_read<v_rd_off(0, 2, 1)>(vb_); } \
    asm volatile("s_waitcnt lgkmcnt(8)" ::: "memory"); SBAR(); p0 = __builtin_amdgcn_mfma_f32_32x32x16_bf16(ka0, qr[10], p0, 0, 0, 0); p1 = __builtin_amdgcn_mfma_f32_32x32x16_bf16(kb0, qr[10], p1, 0, 0, 0); SBAR(); \
    { vl0 = tr_read<v_rd_off(0, 3, 0)>(vb_); vh0 = tr_read<v_rd_off(0, 3, 1)>(vb_); } \
    asm volatile("s_waitcnt lgkmcnt(8)" ::: "memory"); SBAR(); p0 = __builtin_amdgcn_mfma_f32_32x32x16_bf16(ka1, qr[11], p0, 0, 0, 0); p1 = __builtin_amdgcn_mfma_f32_32x32x16_bf16(kb1, qr[11], p1, 0, 0, 0); SBAR(); \
    { vl1 = tr_read<v_rd_off(1, 0, 0)>(vb_); vh1 = tr_read<v_rd_off(1, 0, 1)>(vb_); } \
    asm volatile("s_waitcnt lgkmcnt(8)" ::: "memory"); SBAR(); o[0] = __builtin_amdgcn_mfma_f32_32x32x16_bf16(pa0, (bf16x8){vl2[0], vl2[1], vl2[2], vl2[3], vh2[0], vh2[1], vh2[2], vh2[3]}, o[0], 0, 0, 0); SBAR(); \
    { vl2 = tr_read<v_rd_off(1, 1, 0)>(vb_); vh2 = tr_read<v_rd_off(1, 1, 1)>(vb_); } \
    asm volatile("s_waitcnt lgkmcnt(8)" ::: "memory"); SBAR(); o[0] = __builtin_amdgcn_mfma_f32_32x32x16_bf16(pa1, (bf16x8){vl3[0], vl3[1], vl3[2], vl3[3], vh3[0], vh3[1], vh3[2], vh3[3]}, o[0], 0, 0, 0); SBAR(); \
    { vl3 = tr_read<v_rd_off(1, 2, 0)>(vb_); vh3 = tr_read<v_rd_off(1, 2, 1)>(vb_); } \
    asm volatile("s_waitcnt lgkmcnt(8)" ::: "memory"); SBAR(); o[0] = __builtin_amdgcn_mfma_f32_32x32x16_bf16(pa2, (bf16x8){vl4[0], vl4[1], vl4[2], vl4[3], vh4[0], vh4[1], vh4[2], vh4[3]}, o[0], 0, 0, 0); SBAR(); \
    { vl4 = tr_read<v_rd_off(1, 3, 0)>(vb_); vh4 = tr_read<v_rd_off(1, 3, 1)>(vb_); } \
    asm volatile("s_waitcnt lgkmcnt(8)" ::: "memory"); SBAR(); o[0] = __builtin_amdgcn_mfma_f32_32x32x16_bf16(pa3, (bf16x8){vl0[0], vl0[1], vl0[2], vl0[3], vh0[0], vh0[1], vh0[2], vh0[3]}, o[0], 0, 0, 0); SBAR(); \
    { vl0 = tr_read<v_rd_off(2, 0, 0)>(vb_); vh0 = tr_read<v_rd_off(2, 0, 1)>(vb_); } \
    asm volatile("s_waitcnt lgkmcnt(8)" ::: "memory"); SBAR(); o[1] = __builtin_amdgcn_mfma_f32_32x32x16_bf16(pa0, (bf16x8){vl1[0], vl1[1], vl1[2], vl1[3], vh1[0], vh1[1], vh1[2], vh1[3]}, o[1], 0, 0, 0); SBAR(); \
    { vl1 = tr_read<v_rd_off(2, 1, 0)>(vb_); vh1 = tr_read<v_rd_off(2, 1, 1)>(vb_); } \
    asm volatile("s_waitcnt lgkmcnt(8)" ::: "memory"); SBAR(); o[1] = __builtin_amdgcn_mfma_f32_32x32x16_bf16(pa1, (bf16x8){vl2[0], vl2[1], vl2[2], vl2[3], vh2[0], vh2[1], vh2[2], vh2[3]}, o[1], 0, 0, 0); SBAR(); \
    { vl2 = tr_read<v_rd_off(2, 2, 0)>(vb_); vh2 = tr_read<v_rd_off(2, 2, 1)>(vb_); } \
    asm volatile("s_waitcnt lgkmcnt(8)" ::: "memory"); SBAR(); o[1] = __builtin_amdgcn_mfma_f32_32x32x16_bf16(pa2, (bf16x8){vl3[0], vl3[1], vl3[2], vl3[3], vh3[0], vh3[1], vh3[2], vh3[3]}, o[1], 0, 0, 0); SBAR(); \
    { vl3 = tr_read<v_rd_off(2, 3, 0)>(vb_); vh3 = tr_read<v_rd_off(2, 3, 1)>(vb_); } \
    asm volatile("s_waitcnt lgkmcnt(8)" ::: "memory"); SBAR(); o[1] = __builtin_amdgcn_mfma_f32_32x32x16_bf16(pa3, (bf16x8){vl4[0], vl4[1], vl4[2], vl4[3], vh4[0], vh4[1], vh4[2], vh4[3]}, o[1], 0, 0, 0); SBAR(); \
    { vl4 = tr_read<v_rd_off(3, 0, 0)>(vb_); vh4 = tr_read<v_rd_off(3, 0, 1)>(vb_); } \
    asm volatile("s_waitcnt lgkmcnt(8)" ::: "memory"); SBAR(); o[2] = __builtin_amdgcn_mfma_f32_32x32x16_bf16(pa0, (bf16x8){vl0[0], vl0[1], vl0[2], vl0[3], vh0[0], vh0[1], vh0[2], vh0[3]}, o[2], 0, 0, 0); SBAR(); \
    { vl0 = tr_read<v_rd_off(3, 1, 0)>(vb_); vh0 = tr_read<v_rd_off(3, 1, 1)>(vb_); } \
    asm volatile("s_waitcnt lgkmcnt(8)" ::: "memory"); SBAR(); o[2] = __builtin_amdgcn_mfma_f32_32x32x16_bf16(pa1, (bf16x8){vl1[0], vl1[1], vl1[2], vl1[3], vh1[0], vh1[1], vh1[2], vh1[3]}, o[2], 0, 0, 0); SBAR(); \
    { vl1 = tr_read<v_rd_off(3, 2, 0)>(vb_); vh1 = tr_read<v_rd_off(3, 2, 1)>(vb_); } \
    asm volatile("s_waitcnt lgkmcnt(8)" ::: "memory"); SBAR(); o[2] = __builtin_amdgcn_mfma_f32_32x32x16_bf16(pa2, (bf16x8){vl2[0], vl2[1], vl2[2], vl2[3], vh2[0], vh2[1], vh2[2], vh2[3]}, o[2], 0, 0, 0); SBAR(); \
    { vl2 = tr_read<v_rd_off(3, 3, 0)>(vb_); vh2 = tr_read<v_rd_off(3, 3, 1)>(vb_); } \
    asm volatile("s_waitcnt lgkmcnt(8)" ::: "memory"); SBAR(); o[2] = __builtin_amdgcn_mfma_f32_32x32x16_bf16(pa3, (bf16x8){vl3[0], vl3[1], vl3[2], vl3[3], vh3[0], vh3[1], vh3[2], vh3[3]}, o[2], 0, 0, 0); SBAR(); \
    asm volatile("s_waitcnt lgkmcnt(6)" ::: "memory"); SBAR(); o[3] = __builtin_amdgcn_mfma_f32_32x32x16_bf16(pa0, (bf16x8){vl4[0], vl4[1], vl4[2], vl4[3], vh4[0], vh4[1], vh4[2], vh4[3]}, o[3], 0, 0, 0); SBAR(); \
    asm volatile("s_waitcnt lgkmcnt(4)" ::: "memory"); SBAR(); o[3] = __builtin_amdgcn_mfma_f32_32x32x16_bf16(pa1, (bf16x8){vl0[0], vl0[1], vl0[2], vl0[3], vh0[0], vh0[1], vh0[2], vh0[3]}, o[3], 0, 0, 0); SBAR(); \
    asm volatile("s_waitcnt lgkmcnt(2)" ::: "memory"); SBAR(); o[3] = __builtin_amdgcn_mfma_f32_32x32x16_bf16(pa2, (bf16x8){vl1[0], vl1[1], vl1[2], vl1[3], vh1[0], vh1[1], vh1[2], vh1[3]}, o[3], 0, 0, 0); SBAR(); \
    asm volatile("s_waitcnt lgkmcnt(0)" ::: "memory"); SBAR(); o[3] = __builtin_amdgcn_mfma_f32_32x32x16_bf16(pa3, (bf16x8){vl2[0], vl2[1], vl2[2], vl2[3], vh2[0], vh2[1], vh2[2], vh2[3]}, o[3], 0, 0, 0); SBAR(); \
} while (0)
#define M4_XFIRST(KS, VS) do { \
    int xn_ = xkn, xr_ = xkr; asm volatile("" : "+v"(xn_), "+v"(xr_)); \
    const int kbn_ = (int)(uintptr_t)(lds + M2_OFF_K + (KS) * M2_KSLOT) + r32 * 256, kbr_ = (int)(uintptr_t)(lds + M2_OFF_K + (KS) * M2_KSLOT + KN_BYTES) + r32 * 128; \
    const int vb_ = (int)(uintptr_t)(lds + M2_OFF_V + (VS) * V_BYTES) + vlane; (void)vb_; \
    bf16x8 ka0, ka1, ka2, ka3, ka4, kb0, kb1, kb2, kb3, kb4; s16x4 vl0, vl1, vl2, vl3, vl4, vh0, vh1, vh2, vh3, vh4; \
    p0 = f32x16{}; p1 = f32x16{}; \
    { const int a_ = kbn_ + (((0) * 32 + hb) ^ xn_); ka0 = lds_rd128<0>(a_); kb0 = lds_rd128<8192>(a_); } \
    { const int a_ = kbn_ + (((1) * 32 + hb) ^ xn_); ka1 = lds_rd128<0>(a_); kb1 = lds_rd128<8192>(a_); } \
    { const int a_ = kbn_ + (((2) * 32 + hb) ^ xn_); ka2 = lds_rd128<0>(a_); kb2 = lds_rd128<8192>(a_); } \
    { const int a_ = kbn_ + (((3) * 32 + hb) ^ xn_); ka3 = lds_rd128<0>(a_); kb3 = lds_rd128<8192>(a_); } \
    { const int a_ = kbn_ + (((4) * 32 + hb) ^ xn_); ka4 = lds_rd128<0>(a_); kb4 = lds_rd128<8192>(a_); } \
    asm volatile("s_waitcnt lgkmcnt(8)" ::: "memory"); SBAR(); p0 = __builtin_amdgcn_mfma_f32_32x32x16_bf16(ka0, qr[0], p0, 0, 0, 0); p1 = __builtin_amdgcn_mfma_f32_32x32x16_bf16(kb0, qr[0], p1, 0, 0, 0); SBAR(); \
    { const int a_ = kbn_ + (((5) * 32 + hb) ^ xn_); ka0 = lds_rd128<0>(a_); kb0 = lds_rd128<8192>(a_); } \
    asm volatile("s_waitcnt lgkmcnt(8)" ::: "memory"); SBAR(); p0 = __builtin_amdgcn_mfma_f32_32x32x16_bf16(ka1, qr[1], p0, 0, 0, 0); p1 = __builtin_amdgcn_mfma_f32_32x32x16_bf16(kb1, qr[1], p1, 0, 0, 0); SBAR(); \
    { const int a_ = kbn_ + (((6) * 32 + hb) ^ xn_); ka1 = lds_rd128<0>(a_); kb1 = lds_rd128<8192>(a_); } \
    asm volatile("s_waitcnt lgkmcnt(8)" ::: "memory"); SBAR(); p0 = __builtin_amdgcn_mfma_f32_32x32x16_bf16(ka2, qr[2], p0, 0, 0, 0); p1 = __builtin_amdgcn_mfma_f32_32x32x16_bf16(kb2, qr[2], p1, 0, 0, 0); SBAR(); \
    { const int a_ = kbn_ + (((7) * 32 + hb) ^ xn_); ka2 = lds_rd128<0>(a_); kb2 = lds_rd128<8192>(a_); } \
    asm volatile("s_waitcnt lgkmcnt(8)" ::: "memory"); SBAR(); p0 = __builtin_amdgcn_mfma_f32_32x32x16_bf16(ka3, qr[3], p0, 0, 0, 0); p1 = __builtin_amdgcn_mfma_f32_32x32x16_bf16(kb3, qr[3], p1, 0, 0, 0); SBAR(); \
    { const int a_ = kbr_ + (((0) * 32 + hb) ^ xr_); ka3 = lds_rd128<0>(a_); kb3 = lds_rd128<4096>(a_); } \
    asm volatile("s_waitcnt lgkmcnt(8)" ::: "memory"); SBAR(); p0 = __builtin_amdgcn_mfma_f32_32x32x16_bf16(ka4, qr[4], p0, 0, 0, 0); p1 = __builtin_amdgcn_mfma_f32_32x32x16_bf16(kb4, qr[4], p1, 0, 0, 0); SBAR(); \
    { const int a_ = kbr_ + (((1) * 32 + hb) ^ xr_); ka4 = lds_rd128<0>(a_); kb4 = lds_rd128<4096>(a_); } \
    asm volatile("s_waitcnt lgkmcnt(8)" ::: "memory"); SBAR(); p0 = __builtin_amdgcn_mfma_f32_32x32x16_bf16(ka0, qr[5], p0, 0, 0, 0); p1 = __builtin_amdgcn_mfma_f32_32x32x16_bf16(kb0, qr[5], p1, 0, 0, 0); SBAR(); \
    { const int a_ = kbr_ + (((2) * 32 + hb) ^ xr_); ka0 = lds_rd128<0>(a_); kb0 = lds_rd128<4096>(a_); } \
    asm volatile("s_waitcnt lgkmcnt(8)" ::: "memory"); SBAR(); p0 = __builtin_amdgcn_mfma_f32_32x32x16_bf16(ka1, qr[6], p0, 0, 0, 0); p1 = __builtin_amdgcn_mfma_f32_32x32x16_bf16(kb1, qr[6], p1, 0, 0, 0); SBAR(); \
    { const int a_ = kbr_ + (((3) * 32 + hb) ^ xr_); ka1 = lds_rd128<0>(a_); kb1 = lds_rd128<4096>(a_); } \
    asm volatile("s_waitcnt lgkmcnt(8)" ::: "memory"); SBAR(); p0 = __builtin_amdgcn_mfma_f32_32x32x16_bf16(ka2, qr[7], p0, 0, 0, 0); p1 = __builtin_amdgcn_mfma_f32_32x32x16_bf16(kb2, qr[7], p1, 0, 0, 0); SBAR(); \
    asm volatile("s_waitcnt lgkmcnt(6)" ::: "memory"); SBAR(); p0 = __builtin_amdgcn_mfma_f32_32x32x16_bf16(ka3, qr[8], p0, 0, 0, 0); p1 = __builtin_amdgcn_mfma_f32_32x32x16_bf16(kb3, qr[8], p1, 0, 0, 0); SBAR(); \
    asm volatile("s_waitcnt lgkmcnt(4)" ::: "memory"); SBAR(); p0 = __builtin_amdgcn_mfma_f32_32x32x16_bf16(ka4, qr[9], p0, 0, 0, 0); p1 = __builtin_amdgcn_mfma_f32_32x32x16_bf16(kb4, qr[9], p1, 0, 0, 0); SBAR(); \
    asm volatile("s_waitcnt lgkmcnt(2)" ::: "memory"); SBAR(); p0 = __builtin_amdgcn_mfma_f32_32x32x16_bf16(ka0, qr[10], p0, 0, 0, 0); p1 = __builtin_amdgcn_mfma_f32_32x32x16_bf16(kb0, qr[10], p1, 0, 0, 0); SBAR(); \
    asm volatile("s_waitcnt lgkmcnt(0)" ::: "memory"); SBAR(); p0 = __builtin_amdgcn_mfma_f32_32x32x16_bf16(ka1, qr[11], p0, 0, 0, 0); p1 = __builtin_amdgcn_mfma_f32_32x32x16_bf16(kb1, qr[11], p1, 0, 0, 0); SBAR(); \
} while (0)

__device__ __forceinline__ void mla_unit4(lds_ptr lds, const bf16* __restrict__ Q, const bf16* __restrict__ KN, const bf16* __restrict__ KR, const bf16* __restrict__ V, bf16* __restrict__ OAB, int b, int h, int qb, const int tid_in) {
    int tid_ = tid_in; asm volatile("" : "+v"(tid_)); const int tid = tid_, lane = tid & 63, r32 = lane & 31, hi = lane >> 5; const int wid = __builtin_amdgcn_readfirstlane(tid >> 6);
    const bool metaq = (qb == 16);
    const bool wave_on = !metaq || wid == 0;
    const int qrow = metaq ? (TREAL + 16 * b + (r32 & 15)) : (b * SEQ + qb * 256 + wid * 32 + r32);
    __attribute__((address_space(3))) float* wsf = (__attribute__((address_space(3))) float*)(lds + M2_OFF_WS) + wid * 64;
    unsigned so_kn[2], so_kr, so_v[2];
#pragma unroll
    for (int i = 0; i < 2; ++i) { const int P = 2 * wid + i;
        { const int row = 4 * P + (lane >> 4), c = (lane & 15) ^ (row & 15); so_kn[i] = (unsigned)(row * 4096 + c * 16); }
        { const int q = 64 * P + lane, s = q >> 5, kk = (s >> 2) * 8 + ((q & 31) >> 2), col = (s & 3) * 32 + (q & 3) * 8, k = (kk & ~0xC) | ((kk & 4) << 1) | ((kk & 8) >> 1); so_v[i] = (unsigned)(k * 4096 + col * 2); } }
    { const int row = 8 * wid + (lane >> 3), c = (lane & 7) ^ ((row >> 1) & 7); so_kr = (unsigned)(row * 128 + c * 16); }
    const char* const kn_h = (const char*)KN + h * 256; const char* const v_h = (const char*)V + h * 256; const char* const kr_b = (const char*)KR;
    const size_t real0 = (size_t)b * SEQ, meta0 = (size_t)TREAL + 16 * b;
#define M3_ROW(t) ((t) == 0 ? meta0 : real0 + (size_t)((t) - 1) * 64)
#define M3_DMA(src, dstoff) __builtin_amdgcn_global_load_lds((const unsigned*)(src), (__attribute__((address_space(3))) unsigned*)(lds + (dstoff)), 16, 0, 0)
#define M3_DMA_K(t, slot) do { const size_t g_ = M3_ROW(t); const int so_ = M2_OFF_K + (slot) * M2_KSLOT; \
        M3_DMA(kn_h + g_ * 4096 + so_kn[0], so_ + (2 * wid) * 1024); M3_DMA(kn_h + g_ * 4096 + so_kn[1], so_ + (2 * wid + 1) * 1024); M3_DMA(kr_b + g_ * 128 + so_kr, so_ + KN_BYTES + wid * 1024); } while (0)
#define M3_DMA_V(t, slot) do { const size_t g_ = M3_ROW(t); const int so_ = M2_OFF_V + (slot) * V_BYTES; \
        M3_DMA(v_h + g_ * 4096 + so_v[0], so_ + (2 * wid) * 1024); M3_DMA(v_h + g_ * 4096 + so_v[1], so_ + (2 * wid + 1) * 1024); } while (0)
#define M3_WAIT(n) asm volatile("s_waitcnt vmcnt(" #n ")" ::: "memory")
#define M3_BAR() do { asm volatile("" ::: "memory"); __builtin_amdgcn_s_barrier(); asm volatile("" ::: "memory"); } while (0)
#define M3_EVENT(i, s3) do { if ((i) + 2 < M3_NT) M3_DMA_K((i) + 2, (s3) == 0 ? 2 : (s3) - 1); if ((i) + 1 < M3_NT) M3_DMA_V((i) + 1, (s3) == 2 ? 0 : (s3) + 1); } while (0)
#define M3_WAITI(i) do { if ((i) < M3_NT - 2) M3_WAIT(5); else M3_WAIT(0); } while (0)
    M3_DMA_K(0, 0); M3_DMA_V(0, 0); M3_DMA_K(1, 1);
    bf16x8 qr[12];
    { const bf16* qp = Q + (size_t)qrow * 3072 + h * 192 + hi * 8;
#pragma unroll
      for (int d0 = 0; d0 < 12; ++d0) qr[d0] = *reinterpret_cast<const bf16x8*>(qp + d0 * 16); }
    const int xkn = (r32 & 15) << 4, xkr = ((r32 >> 1) & 7) << 4, hb = hi * 16;
    const int vlane = v_rd_base(lane);
#define M3_PV(slot) pv_all(o, (int)(uintptr_t)(lds + M2_OFF_V + (slot) * V_BYTES) + vlane, pa0, pa1, pa2, pa3)
#define M3_Y(j) do { if (wave_on) { if ((j) == 0) { _Pragma("unroll") for (int r = 0; r < 16; ++r) { if (crow(r, hi) >= 16) p0[r] = NEG_BIG; p1[r] = NEG_BIG; } } \
        float alpha_; softmax_seg(p0, p1, m_reg, l_reg, alpha_, pa0, pa1, pa2, pa3); \
        if (__any(alpha_ < 1.f)) { if (hi == 0) wsf[r32] = alpha_; asm volatile("s_waitcnt lgkmcnt(0)" ::: "memory"); \
            _Pragma("unroll") for (int d = 0; d < 4; ++d) _Pragma("unroll") for (int r = 0; r < 16; ++r) o[d][r] *= wsf[crow(r, hi)]; } } } while (0)
    float m_reg = NEG_BIG, l_reg = 0.f; f32x16 o[4];
#pragma unroll
    for (int d = 0; d < 4; ++d) o[d] = f32x16{};
    f32x16 p0, p1; bf16x8 pa0, pa1, pa2, pa3;
    int s3 = 0;
    if (wid < 4) {
        M3_WAITI(0); M3_BAR();
        if (wave_on) M4_XFIRST(0, 0);
        M3_BAR(); M3_EVENT(0, 0);
        M3_Y(0);
        s3 = 1;
        for (int j = 1; j < M3_NT; ++j) {
            M3_WAITI(j); M3_BAR();
            if (wave_on) M4_XFULL(s3, (s3 == 0 ? 2 : s3 - 1));
            M3_BAR(); M3_EVENT(j, s3);
            M3_Y(j);
            s3 = s3 == 2 ? 0 : s3 + 1;
        }
        M3_BAR();
        if (wave_on) M3_PV(s3 == 0 ? 2 : s3 - 1);
        M3_BAR();
    } else {
        M3_WAITI(0); M3_BAR(); M3_EVENT(0, 0);
        M3_BAR();
        if (wave_on) M4_XFIRST(0, 0);
        M3_WAITI(1); M3_BAR(); M3_EVENT(1, 1);
        M3_Y(0);
        s3 = 1;
        for (int j = 1; j < M3_NT; ++j) {
            M3_BAR();
            if (wave_on) M4_XFULL(s3, (s3 == 0 ? 2 : s3 - 1));
            M3_WAITI(j + 1); M3_BAR(); { const int s3n = s3 == 2 ? 0 : s3 + 1; M3_EVENT(j + 1, s3n); }
            M3_Y(j);
            s3 = s3 == 2 ? 0 : s3 + 1;
        }
        M3_BAR();
        if (wave_on) M3_PV(s3 == 0 ? 2 : s3 - 1);
    }
    if (wave_on) {
        if (hi == 0) wsf[32 + r32] = l_reg; asm volatile("s_waitcnt lgkmcnt(0)" ::: "memory");
        const int orow0 = metaq ? (TREAL + 16 * b) : (b * SEQ + qb * 256 + wid * 32);
#pragma unroll
        for (int r = 0; r < 16; ++r) { const int rw = crow(r, hi); const float rl = __builtin_amdgcn_rcpf(wsf[32 + rw]);
            if (!metaq || rw < 16) { bf16* op = OAB + (size_t)(orow0 + rw) * 4096 + h * 128 + r32;
#pragma unroll
                for (int d0 = 0; d0 < 4; ++d0) op[d0 * 32] = (bf16)(cvtpk(o[d0][r] * rl, 0.f) & 0xffffu); } }
    }
    M3_WAIT(0); M3_BAR();
#undef M3_ROW
#undef M3_DMA
#undef M3_DMA_K
#undef M3_DMA_V
#undef M3_WAIT
#undef M3_BAR
#undef M3_EVENT
#undef M3_WAITI
#undef M3_PV
#undef M3_Y
}
#undef M4_XFULL
#undef M4_XFIRST
}
constexpr int NWAVES = 8;
constexpr int N_PHASES = 20;
constexpr size_t MiB = 1u << 20, KiB32 = 32768;
constexpr size_t WS_CTL = 0, CTL_ZERO_BYTES = 65536;
constexpr size_t WS_CS = 1 * MiB, WS_SN = WS_CS + 540672;
constexpr size_t WS_BIAS = 3 * MiB;
constexpr size_t WS_TW = WS_BIAS, WS_TM = WS_BIAS + 32768, WS_SINK = WS_BIAS + 49152;
constexpr size_t WS_WHIST = WS_BIAS + 65536;
constexpr size_t WS_TOPI = 4 * MiB, WS_TOPG = WS_TOPI + 262144, WS_TOKSLOT = WS_TOPG + 262144;
constexpr size_t WS_SLOTTOK = 5 * MiB, WS_SLOTGATE = WS_SLOTTOK + 294912;
constexpr size_t WS_SSQ = 6 * MiB;
constexpr size_t WS_HB = 9 * MiB;
constexpr size_t WS_W = 138 * MiB;
constexpr size_t WL_IN = 0, WL_UQ = 34 * MiB, WL_UKV = WL_UQ + 9 * MiB / 2, WL_AB = WL_UKV + 4 * MiB, WL_OUT = WL_AB + 16 * MiB, WL_STRIDE = WL_OUT + 8 * MiB;
constexpr size_t WS_WF13 = WS_W + 2 * WL_STRIDE, WS_WF2 = WS_WF13 + 44 * MiB, WS_WEND = WS_WF2 + 22 * MiB;
constexpr size_t AR = 337 * MiB;
constexpr size_t WS_CQ = AR, WS_CKV = WS_CQ + 1548 * KiB32, WS_KR = WS_CKV + 1032 * KiB32, WS_QB = WS_KR + 132 * KiB32;
constexpr size_t WS_KB = WS_QB + 129 * MiB, WS_VB = WS_KB + 1032 * KiB32, WS_GR = WS_VB + 1032 * KiB32, WS_GBB = WS_GR + 129 * MiB;
constexpr size_t WS_Q = WS_GBB + 129 * MiB, WS_KN = WS_Q + 6192 * KiB32  , WS_V = WS_KN + 129 * MiB, WS_OAB = WS_V + 129 * MiB, WS_MIX_END = WS_OAB + 258 * MiB;
constexpr size_t WS_MG = WS_Q;
constexpr size_t WS_X = WS_OAB;
constexpr size_t WS_ACT = AR;
constexpr size_t WS_MW13 = 138 * MiB, WS_MW2 = WS_MW13 + 8 * 44 * MiB;
constexpr size_t WS_MACT = WS_MW2 + 8 * 22 * MiB;
constexpr size_t WS_Y = WS_MACT + 726 * MiB;
constexpr size_t WS_END = WS_Y + 264 * MiB;
static_assert(WS_MIX_END <= 1700 * MiB && WS_END <= 1700 * MiB, "d_ws map");
static_assert(WS_ACT + (size_t)TP * DFF * 2 <= WS_X, "dense ACT vs X");
static_assert(WS_SSQ + (size_t)TP * 20 * 4 <= WS_HB && WS_SLOTGATE + 294912 <= WS_SSQ && WS_TOKSLOT + 262144 <= WS_SLOTTOK && WS_SN + 540672 <= WS_BIAS, "small tables");
static_assert(WS_KR + (size_t)TP * 64 * 2 <= WS_QB, "KR");
constexpr int CW_TMO = 0, CW_CODE = 1;
constexpr int CW_MOE_TS = 64;
constexpr int CW_BAR = 4096;
constexpr int RING_OFF = 0, RING_BYTES = 131072;
constexpr int LDSCTL_OFF = RING_BYTES, MISC_OFF = LDSCTL_OFF + 320, PT_OFF = LDSCTL_OFF + 512;
constexpr int LDS_BYTES = 147456;
static_assert(att::ATT_LDS_BYTES <= RING_BYTES && att::M2_LDS_BYTES <= RING_BYTES && att::S2_LDS_BYTES <= RING_BYTES, "attention LDS");

#define GAS __attribute__((address_space(1)))
#define LAS __attribute__((address_space(3)))
typedef unsigned short bf16;
typedef unsigned v4u __attribute__((ext_vector_type(4)));
typedef unsigned v2u __attribute__((ext_vector_type(2)));
typedef float f32x4 __attribute__((ext_vector_type(4)));
typedef GAS unsigned gu32;
#define RLX_AGENT __ATOMIC_RELAXED, __HIP_MEMORY_SCOPE_AGENT
#define LDS_WAIT() asm volatile("s_waitcnt lgkmcnt(0)" ::: "memory")
#define VM_WAIT() asm volatile("s_waitcnt vmcnt(0)" ::: "memory")
__device__ __forceinline__ unsigned f2bf(float f) { unsigned u = __builtin_bit_cast(unsigned, f); return (u + 0x7fffu + ((u >> 16) & 1u)) >> 16; }
__device__ __forceinline__ unsigned pk2(float lo, float hi) { return f2bf(lo) | (f2bf(hi) << 16); }

#define XB_TMO      128
#define XB_XCNT(j)  (256  + 64 * (j))
#define XB_XSUB(j)  (1280 + 64 * (j))
#define XB_XGEN(j)  (2304 + 64 * (j))
#define XB_TOP      3328
#define XB_TOPGEN   3392
#define XCD_BAR_WORDS 3456
#define XB_SPIN_CAP (1u << 22)
__device__ __forceinline__ unsigned xb_ld(unsigned* p)              { return __hip_atomic_load(p, __ATOMIC_RELAXED, __HIP_MEMORY_SCOPE_AGENT); }
__device__ __forceinline__ unsigned xb_add(unsigned* p, unsigned v) { return __hip_atomic_fetch_add(p, v, __ATOMIC_RELAXED, __HIP_MEMORY_SCOPE_AGENT); }
__device__ __forceinline__ unsigned xb_xcc_id() { return (unsigned)__builtin_amdgcn_s_getreg((3 << 11) | 20) & 0xFu; }
#define XB_SPIN(cond, bar) do { unsigned _sp = 0; while (cond) { __builtin_amdgcn_s_sleep(1); \
    if ((++_sp & 255u) == 0u) { if (xb_ld(&(bar)[XB_TMO])) break; if (_sp > XB_SPIN_CAP) { atomicAdd(&(bar)[XB_TMO], 1u); break; } } } } while (0)
struct XcdBarrier { unsigned* bar; unsigned x; volatile LAS unsigned* st; };
__device__ __forceinline__ XcdBarrier xcd_barrier_post(unsigned* bar, volatile LAS unsigned* st, const int tid) {
    XcdBarrier b; b.bar = bar; b.x = xb_xcc_id(); b.st = st;
    if (tid == 0) (void)xb_add(&bar[XB_XCNT(b.x)], 1u);
    return b;
}
__device__ __forceinline__ void xcd_barrier_complete(unsigned* bar, unsigned x, unsigned& nloc, unsigned& nx) {
    const unsigned G = gridDim.x * gridDim.y * gridDim.z;
    unsigned sum, cnt, mine, sp = 0u;
    for (;;) {
        sum = 0u; cnt = 0u; mine = 0u;
#pragma unroll
        for (unsigned j = 0; j < 16; ++j) { const unsigned c = xb_ld(&bar[XB_XCNT(j)]); sum += c; cnt += (c > 0u) ? 1u : 0u; mine = (j == x) ? c : mine; }
        if (sum == G) break;
        __builtin_amdgcn_s_sleep(1);
        if ((++sp & 255u) == 0u) { if (xb_ld(&bar[XB_TMO])) break; if (sp > XB_SPIN_CAP) { atomicAdd(&bar[XB_TMO], 1u); break; } }
    }
    nloc = mine > 0u ? mine : 1u; nx = cnt > 0u ? cnt : 1u;
}
__device__ __forceinline__ void xcd_barrier(const XcdBarrier& b, const int tid) {
    asm volatile("s_waitcnt vmcnt(0)" ::: "memory");
    __syncthreads();
    if (tid == 0) {
        unsigned* bar = b.bar;
        __builtin_amdgcn_s_waitcnt(0);
        unsigned nloc = b.st[0], nx = b.st[1];
        if (nloc == 0u) { xcd_barrier_complete(bar, b.x, nloc, nx); b.st[0] = nloc; b.st[1] = nx; }
        const unsigned old = xb_add(&bar[XB_XSUB(b.x)], 1u);
        const unsigned gen = old / nloc;
        if (old + 1u == (gen + 1u) * nloc) {
            __builtin_amdgcn_fence(__ATOMIC_RELEASE, "agent");
            asm volatile("s_waitcnt vmcnt(0)" ::: "memory");
            const unsigned og = xb_add(&bar[XB_TOP], 1u);
            const unsigned tg = og / nx;
            if (og + 1u == (tg + 1u) * nx) xb_add(&bar[XB_TOPGEN], 1u);
            else XB_SPIN(xb_ld(&bar[XB_TOPGEN]) == tg, bar);
            __builtin_amdgcn_fence(__ATOMIC_ACQUIRE, "agent");
            xb_add(&bar[XB_XGEN(b.x)], 1u);
            asm volatile("s_waitcnt vmcnt(0)" ::: "memory");
        } else {
            XB_SPIN(xb_ld(&bar[XB_XGEN(b.x)]) == gen, bar);
            __builtin_amdgcn_fence(__ATOMIC_ACQUIRE, "agent");
            asm volatile("s_waitcnt vmcnt(0)" ::: "memory");
        }
    }
    __syncthreads();
}

__device__ __forceinline__ int lane_id() { int l; asm volatile("v_mbcnt_lo_u32_b32 %0, -1, 0\n\tv_mbcnt_hi_u32_b32 %0, -1, %0" : "=v"(l)); return l; }
__device__ __forceinline__ float wave_sum(float v) {
#pragma unroll
    for (int o = 1; o < 64; o <<= 1) v += __shfl_xor(v, o);
    return v;
}
__device__ __forceinline__ void transpose_item(const float* __restrict__ W, int ldw, int k0, int n0, bf16* __restrict__ WT, size_t ldt, int drow, int koff, const float* __restrict__ g, LAS float* scr, int lane) {
    const int kr = lane >> 3, c4 = (lane & 7) * 4;
    f32x4 v[8];
#pragma unroll
    for (int i = 0; i < 8; ++i) v[i] = *(const GAS f32x4*)(W + (size_t)(k0 + 8 * i + kr) * ldw + n0 + c4);
    if (g) {
#pragma unroll
        for (int i = 0; i < 8; ++i) v[i] = v[i] * g[k0 + 8 * i + kr]; }
#pragma unroll
    for (int i = 0; i < 8; ++i) { LAS float* d = scr + (8 * i + kr) * 33 + c4; d[0] = v[i].x; d[1] = v[i].y; d[2] = v[i].z; d[3] = v[i].w; }
    LDS_WAIT(); asm volatile("" ::: "memory");
    const int c = lane & 7;
#pragma unroll
    for (int j = 0; j < 4; ++j) { const int n = (lane >> 3) + 8 * j; const LAS float* s = scr + (8 * c) * 33 + n;
        v4u o; o.x = pk2(s[0 * 33], s[1 * 33]); o.y = pk2(s[2 * 33], s[3 * 33]); o.z = pk2(s[4 * 33], s[5 * 33]); o.w = pk2(s[6 * 33], s[7 * 33]);
        *(GAS v4u*)(WT + (size_t)(drow + n) * ldt + koff + k0 + 8 * c) = o; }
    LDS_WAIT(); asm volatile("" ::: "memory");
}
__device__ __forceinline__ int dmap_in(int n0) {
    if (n0 < 1280) return n0;
    if (n0 < 1312) return 1280;
    if (n0 < 1344) return 1280 + 128;
    if (n0 < 3392) return 1536 + (n0 - 1344);
    if (n0 < 3904) return 3584 + (n0 - 3392);
    if (n0 < 4416) return 4096 + (n0 - 3904);
    if (n0 < 6464) { const int a = n0 - 4416; return 4608 + 256 * (a >> 7) + (a & 127); }
    const int a = n0 - 6464; return 4608 + 256 * (a >> 7) + 128 + (a & 127);
}
__device__ __forceinline__ int dmap_uq(int n0) {
    const int head = n0 / 192, off = n0 - head * 192;
    if (off < 128) return 256 * (head >> 1) + 128 * (head & 1) + off;
    if (off < 160) return 256 * (8 + (head >> 2)) + 32 * (head & 3);
    return 256 * (8 + (head >> 2)) + 128 + 32 * (head & 3);
}
__device__ __forceinline__ int dmap_glu(int n0) { return 256 * (n0 >> 7) + (n0 & 127); }
struct Row8 { f32x4 v[8]; };
__device__ __forceinline__ void ln_normalize(Row8& r) {
    float s = 0.f;
#pragma unroll
    for (int j = 0; j < 8; ++j) s += (r.v[j].x + r.v[j].y) + (r.v[j].z + r.v[j].w);
    const float mean = wave_sum(s) * (1.f / D); float s2 = 0.f;
#pragma unroll
    for (int j = 0; j < 8; ++j) { r.v[j] = r.v[j] - mean; s2 += (r.v[j].x * r.v[j].x + r.v[j].y * r.v[j].y) + (r.v[j].z * r.v[j].z + r.v[j].w * r.v[j].w); }
    const float rstd = 1.f / sqrtf(wave_sum(s2) * (1.f / D) + LN_EPS);
#pragma unroll
    for (int j = 0; j < 8; ++j) r.v[j] = r.v[j] * rstd;
}
__device__ __forceinline__ void ln_affine(Row8& r, const float* __restrict__ g, const float* __restrict__ b, int lane) {
#pragma unroll
    for (int j = 0; j < 8; ++j) { const f32x4 gg = *((const f32x4*)g + lane + 64 * j), bb = *((const f32x4*)b + lane + 64 * j); r.v[j] = r.v[j] * gg + bb; }
}
__device__ __forceinline__ void row_store_bf16(const Row8& r, bf16* orow, int lane) {
    GAS v2u* o8 = (GAS v2u*)orow + lane;
#pragma unroll
    for (int j = 0; j < 8; ++j) { v2u w; w.x = pk2(r.v[j].x, r.v[j].y); w.y = pk2(r.v[j].z, r.v[j].w); o8[64 * j] = w; }
}
__device__ __forceinline__ void row_load_f32(Row8& r, const float* xrow, int lane) {
#pragma unroll
    for (int j = 0; j < 8; ++j) r.v[j] = *((const GAS f32x4*)xrow + lane + 64 * j);
}
__device__ __forceinline__ f32x4 bf4(v2u w);
__device__ __forceinline__ void row_load_bf16(Row8& r, const bf16* xrow, int lane) {
#pragma unroll
    for (int j = 0; j < 8; ++j) r.v[j] = bf4(*((const GAS v2u*)xrow + lane + 64 * j));
}
__device__ __forceinline__ f32x4 bf4(v2u w) { return (f32x4){__uint_as_float(w.x << 16), __uint_as_float(w.x & 0xffff0000u), __uint_as_float(w.y << 16), __uint_as_float(w.y & 0xffff0000u)}; }
__device__ __forceinline__ int t5_bucket(int rel) {
    const int n = rel < 0 ? -rel : rel; int v;
    if (n < 8) v = n; else if (n < 12) v = 8; else if (n < 16) v = 9; else if (n < 23) v = 10; else if (n < 32) v = 11; else if (n < 46) v = 12; else if (n < 64) v = 13; else if (n < 91) v = 14; else v = 15;
    return (rel > 0 ? 16 : 0) + v;
}

__device__ __forceinline__ void router_row(const Row8& r, const LAS f32x4* rwl, const float* __restrict__ rbias, int lane, int& i0, int& i1, float& g0, float& g1) {
    float lg[8];
#pragma unroll
    for (int e = 0; e < 8; ++e) lg[e] = 0.f;
#pragma unroll
    for (int j = 0; j < 8; ++j) {
#pragma unroll
        for (int q = 0; q < 4; ++q) { const f32x4 w0 = rwl[(j * 4 + q) * 64 + lane], w1 = rwl[2048 + (j * 4 + q) * 64 + lane]; const float y = r.v[j][q];
            lg[0] += y * w0.x; lg[1] += y * w0.y; lg[2] += y * w0.z; lg[3] += y * w0.w; lg[4] += y * w1.x; lg[5] += y * w1.y; lg[6] += y * w1.z; lg[7] += y * w1.w; } }
#pragma unroll
    for (int e = 0; e < 8; ++e) lg[e] = wave_sum(lg[e]) + rbias[e];
    i0 = 0; float v0 = lg[0];
#pragma unroll
    for (int e = 1; e < 8; ++e) if (lg[e] > v0) { v0 = lg[e]; i0 = e; }
    i1 = -1; float v1 = -3.0e38f;
#pragma unroll
    for (int e = 0; e < 8; ++e) if (e != i0 && lg[e] > v1) { v1 = lg[e]; i1 = e; }
    const float e1 = __expf(v1 - v0); g0 = 1.f / (1.f + e1); g1 = e1 / (1.f + e1);
}
enum { I_X = 0, I_META, I_EMB_G, I_EMB_B, I_RELB, I_WIN, I_QNG, I_KVNG, I_WUQ, I_WUKV, I_SINK, I_WPA, I_WPB, I_WOUT, I_LMG, I_LMB, I_LFG, I_LFB,
       I_FW1, I_FW3, I_FW2, I_RW, I_RB, I_MW1, I_MW3, I_MW2, N_IN };
struct Args { const float* in[N_IN]; float* out; unsigned char* ws; int ph_lo, ph_hi; };

__global__ void __launch_bounds__(NWAVES * 64, 2) mk_fwd(Args args) {
    extern __shared__ __attribute__((aligned(16))) unsigned char lds_raw[];
    LAS unsigned char* const lds = (LAS unsigned char*)lds_raw;
    char* const ldsg = (char*)lds_raw;
    volatile LAS unsigned* const MISC = (volatile LAS unsigned*)(lds + MISC_OFF);
    const int wave = __builtin_amdgcn_readfirstlane((int)threadIdx.x >> 6);
    const int tid = wave * 64 + lane_id();
    const int G_k = gridDim.x; const int bx_k = blockIdx.x;
    for (int u = tid; u < (LDS_BYTES - LDSCTL_OFF) / 4; u += NWAVES * 64) ((LAS unsigned*)(lds + LDSCTL_OFF))[u] = 0u;
    __syncthreads();
    volatile LAS unsigned long long* const PT = (volatile LAS unsigned long long*)(lds + PT_OFF);
    if (tid == 0) {
#pragma unroll
        for (int i = 0; i < N_IN; ++i) PT[i] = (unsigned long long)args.in[i];
        PT[N_IN] = (unsigned long long)args.out; PT[N_IN + 1] = (unsigned long long)args.ws; }
    const int lo = args.ph_lo, hi = args.ph_hi;
    __syncthreads();
#define LDP(i) ({ const unsigned long long v_ = PT[i]; (unsigned long long)(unsigned)__builtin_amdgcn_readfirstlane((int)(unsigned)v_) | ((unsigned long long)(unsigned)__builtin_amdgcn_readfirstlane((int)(unsigned)(v_ >> 32)) << 32); })
#define INP(i) ((const float*)(const GAS float*)LDP(i))
#define WSP() ((unsigned char*)(GAS unsigned char*)LDP(N_IN + 1))
#define OUTP() ((float*)(GAS float*)LDP(N_IN))
#define PH_WS() asm volatile("" ::: "memory"); int tid = wave * 64 + lane_id(); asm volatile("" : "+v"(tid)); const int lane = tid & 63; (void)lane; \
    int G = G_k, bx = bx_k; asm volatile("" : "+s"(G), "+s"(bx));     \
    const int vcu = (G % 8 == 0) ? (bx % 8) * (G / 8) + bx / 8 : bx; const int gw = vcu * NWAVES + wave, NGW = G * NWAVES; (void)gw; (void)NGW; (void)vcu; unsigned char* const ws = WSP(); \
    bf16* const HB = (bf16*)(ws + WS_HB); float* const CS = (float*)(ws + WS_CS); float* const SN = (float*)(ws + WS_SN); float* const SSQ = (float*)(ws + WS_SSQ); bf16* const X = (bf16*)(ws + WS_X); \
    (void)HB; (void)CS; (void)SN; (void)SSQ; (void)X
    XcdBarrier bar; { unsigned char* const ws0 = WSP(); bar.bar = (unsigned*)(ws0 + WS_CTL) + CW_BAR; bar.x = 0; bar.st = nullptr;
    if (hi - lo > 1) bar = xcd_barrier_post((unsigned*)(ws0 + WS_CTL) + CW_BAR, MISC + 8, tid); }
#ifndef PHMASK
#define PHMASK 0xFFFF
#endif
#define KEN(kind) ((PHMASK >> (kind)) & 1)
#ifndef REPMASK
#define REPMASK 0
#endif
#define NREP(kind) (((REPMASK >> (kind)) & 1) ? 2 : 1)
#define IN(k) (lo <= (k) && (k) < hi)
#define SEAM(k) do { if (IN(k) && IN((k) + 1)) xcd_barrier(bar, wave * 64 + lane_id()); } while (0)

    for (int rep_ = 0; rep_ < NREP(0); ++rep_) if (KEN(0) && IN(0)) { PH_WS(); int* const SLOT_TOK = (int*)(ws + WS_SLOTTOK); float* const SLOT_GATE = (float*)(ws + WS_SLOTGATE); int* const TOK_SLOT = (int*)(ws + WS_TOKSLOT); (void)SLOT_TOK; (void)SLOT_GATE; (void)TOK_SLOT;
        LAS float* scr = (LAS float*)(lds + RING_OFF + wave * 16384);
        constexpr int I_IN = (D / 64) * (INDIM / 32), I_UQ = (QRANK / 64) * (3072 / 32), I_UKV = (KVRANK / 64) * (4096 / 32), I_SQ = (D / 64) * (D / 32), I_LAYER = I_IN + I_UQ + I_UKV + 3 * I_SQ;
        constexpr int I_F = (D / 64) * (DFF / 32), I_F2 = (DFF / 64) * (D / 32), NITEMS = 2 * I_LAYER + 2 * I_F + I_F2;
        for (int it = gw; it < NITEMS; it += NGW) {
            int r = it;
            if (r < 2 * I_LAYER) { const int l = r / I_LAYER; r -= l * I_LAYER; unsigned char* wl = ws + WS_W + l * WL_STRIDE;
                if (r < I_IN) { const int nblk = INDIM / 32, kb = r / nblk, nb = r % nblk; transpose_item(INP(I_WIN) + (size_t)l * D * INDIM, INDIM, 64 * kb, 32 * nb, (bf16*)(ws + WS_W + l * WL_STRIDE + WL_IN), D, dmap_in(32 * nb), 0, nullptr, scr, lane); continue; } r -= I_IN;
                if (r < I_UQ) { const int nblk = 3072 / 32, kb = r / nblk, nb = r % nblk; transpose_item(INP(I_WUQ) + (size_t)l * QRANK * 3072, 3072, 64 * kb, 32 * nb, (bf16*)(ws + WS_W + l * WL_STRIDE + WL_UQ), QRANK, dmap_uq(32 * nb), 0, INP(I_QNG) + l * QRANK, scr, lane); continue; } r -= I_UQ;
                if (r < I_UKV) { const int nblk = 4096 / 32, kb = r / nblk, nb = r % nblk; transpose_item(INP(I_WUKV) + (size_t)l * KVRANK * 4096, 4096, 64 * kb, 32 * nb, (bf16*)(ws + WS_W + l * WL_STRIDE + WL_UKV), KVRANK, 32 * nb, 0, INP(I_KVNG) + l * KVRANK, scr, lane); continue; } r -= I_UKV;
                { const int which = r / I_SQ; r -= which * I_SQ; const int nblk = D / 32, kb = r / nblk, nb = r % nblk;
                  if (which == 0) transpose_item(INP(I_WPA) + (size_t)l * D * D, D, 64 * kb, 32 * nb, (bf16*)(ws + WS_W + l * WL_STRIDE + WL_AB), 2 * D, 32 * nb, 0, nullptr, scr, lane);
                  else if (which == 1) transpose_item(INP(I_WPB) + (size_t)l * D * D, D, 64 * kb, 32 * nb, (bf16*)(ws + WS_W + l * WL_STRIDE + WL_AB), 2 * D, 32 * nb, D, nullptr, scr, lane);
                  else transpose_item(INP(I_WOUT) + (size_t)l * D * D, D, 64 * kb, 32 * nb, (bf16*)(ws + WS_W + l * WL_STRIDE + WL_OUT), D, 32 * nb, 0, nullptr, scr, lane);
                  continue; }
            }
            r -= 2 * I_LAYER;
            if (r < 2 * I_F) { const int which = r / I_F; r -= which * I_F; const int nblk = DFF / 32, kb = r / nblk, nb = r % nblk;
                transpose_item(INP(which ? I_FW3 : I_FW1), DFF, 64 * kb, 32 * nb, (bf16*)(ws + WS_WF13), D, dmap_glu(32 * nb) + (which ? 128 : 0), 0, nullptr, scr, lane); continue; }
            r -= 2 * I_F;
            { const int nblk = D / 32, kb = r / nblk, nb = r % nblk; transpose_item(INP(I_FW2), D, 64 * kb, 32 * nb, (bf16*)(ws + WS_WF2), DFF, 32 * nb, 0, nullptr, scr, lane); }
        }
        for (int i = gw * 64 + lane; i < 2 * 192 * 256; i += NGW * 64) { const int l = i / (192 * 256), q = i % (192 * 256), rr = q / 256, c16 = q % 256; const int row = rr < 96 ? 1312 + rr : 1440 + (rr - 96);
            *(GAS v4u*)(ws + WS_W + l * WL_STRIDE + WL_IN + (size_t)row * (D * 2) + c16 * 16) = (v4u){0u, 0u, 0u, 0u}; }
        for (int i = gw * 64 + lane; i < LPOS * 32; i += NGW * 64) { const int pos = i >> 5, k = i & 31; const float inv = powf(10000.f, -(float)(2 * k) / 64.f); const float ang = (float)pos * inv; CS[i] = cosf(ang); SN[i] = sinf(ang); }
        for (int i = gw * 64 + lane; i < 16 * 512; i += NGW * 64) { const int hh = i >> 9, rel = (i & 511) - 256; const float bv = INP(I_RELB)[t5_bucket(rel) * 16 + hh] * LOG2E;
            ((float*)(ws + WS_TW))[i] = (rel >= -128 && rel <= 128) ? bv : att::NEG_BIG; if (rel < 0) ((float*)(ws + WS_TM))[hh * 256 + rel + 256] = bv; }
        if (gw == 0 && lane < 32) ((float*)(ws + WS_SINK))[lane] = INP(I_SINK)[lane] * LOG2E;
        { const float* eg = INP(I_EMB_G); const float* eb = INP(I_EMB_B); const float* xin = INP(I_X); const float* min_ = INP(I_META);
#define P0_LOAD(R, m) row_load_f32(R, (m) < TREAL ? xin + (size_t)(m) * D : min_ + (size_t)(((m) - TREAL) & 15) * D, lane)
#define P0_PROC(R, m) do { ln_normalize(R); ln_affine(R, eg, eb, lane); row_store_bf16(R, HB + (size_t)(m) * D, lane); } while (0)
          Row8 ra{}, rb{}; int m = gw; if (m < T) P0_LOAD(ra, m);
          for (; m < T; m += 2 * NGW) { const int m1 = m + NGW, m2 = m + 2 * NGW; if (m1 < T) P0_LOAD(rb, m1); P0_PROC(ra, m); if (m1 < T) { if (m2 < T) P0_LOAD(ra, m2); P0_PROC(rb, m1); } }
#undef P0_LOAD
#undef P0_PROC
          for (int mz = T + gw; mz < TP; mz += NGW) { GAS v2u* o8 = (GAS v2u*)(HB + (size_t)mz * D) + lane;
#pragma unroll
              for (int j = 0; j < 8; ++j) o8[64 * j] = (v2u){0u, 0u}; } }
    }
    SEAM(0);

#pragma unroll 1
    for (int l = 0; l < 2; ++l) {
        const int P = 1 + 9 * l + (l ? 0 : 0);
        const int nM_all = TREAL / 256;
        const int nM_post = TREAL / 256; const bool tail_post = (l == 0);
        for (int rep_ = 0; rep_ < NREP(1); ++rep_) if (KEN(1) && IN(P + 0)) { PH_WS(); int* const SLOT_TOK = (int*)(ws + WS_SLOTTOK); float* const SLOT_GATE = (float*)(ws + WS_SLOTGATE); int* const TOK_SLOT = (int*)(ws + WS_TOKSLOT); (void)SLOT_TOK; (void)SLOT_GATE; (void)TOK_SLOT;
            ProbDense pr; pr.so.init(nM_all, NIN / 256, G, bx, true); pr.A = (const char*)HB; pr.Bt = (const char*)(ws + WS_W + l * WL_STRIDE + WL_IN); pr.tstep = 256 * (size_t)D * 2;
            epi::EpiWin E{(bf16*)(ws + WS_CQ), (bf16*)(ws + WS_CKV), (bf16*)(ws + WS_KR), (bf16*)(ws + WS_QB), (bf16*)(ws + WS_KB), (bf16*)(ws + WS_VB), (bf16*)(ws + WS_GR), (bf16*)(ws + WS_GBB), SSQ, CS, SN};
            pg8::gemm_phase<epi::EpiWin, ProbDense>(lds + RING_OFF, D, pr, E, tid);
        }
        SEAM(P + 0);
        for (int rep_ = 0; rep_ < NREP(2); ++rep_) if (KEN(2) && IN(P + 1)) { PH_WS(); int* const SLOT_TOK = (int*)(ws + WS_SLOTTOK); float* const SLOT_GATE = (float*)(ws + WS_SLOTGATE); int* const TOK_SLOT = (int*)(ws + WS_TOKSLOT); (void)SLOT_TOK; (void)SLOT_GATE; (void)TOK_SLOT;
            { ProbDense pr; pr.so.init(nM_all, 3072 / 256, G, bx, true); pr.A = (const char*)(ws + WS_CQ); pr.Bt = (const char*)(ws + WS_W + l * WL_STRIDE + WL_UQ); pr.tstep = 256 * (size_t)QRANK * 2;
              epi::EpiUq E{(bf16*)(ws + WS_Q), SSQ, CS, SN};
              pg8::gemm_phase<epi::EpiUq, ProbDense>(lds + RING_OFF, QRANK, pr, E, tid); }
            { ProbDense pr; pr.so.init(nM_all, 4096 / 256, G, bx, true); pr.A = (const char*)(ws + WS_CKV); pr.Bt = (const char*)(ws + WS_W + l * WL_STRIDE + WL_UKV); pr.tstep = 256 * (size_t)KVRANK * 2;
              epi::EpiUkv E{(bf16*)(ws + WS_KN), (bf16*)(ws + WS_V), SSQ};
              pg8::gemm_phase<epi::EpiUkv, ProbDense>(lds + RING_OFF, KVRANK, pr, E, tid); }
        }
        SEAM(P + 1);
        for (int rep_ = 0; rep_ < NREP(3); ++rep_) if (KEN(3) && IN(P + 2)) { PH_WS(); int* const SLOT_TOK = (int*)(ws + WS_SLOTTOK); float* const SLOT_GATE = (float*)(ws + WS_SLOTGATE); int* const TOK_SLOT = (int*)(ws + WS_TOKSLOT); (void)SLOT_TOK; (void)SLOT_GATE; (void)TOK_SLOT;
            const int nqb = l == 0 ? 17 : 16, nmla_full = NB * NH * 16, nmla = NB * NH * nqb;
            for (int rep2_ = 0; rep2_ < NREP(14); ++rep2_)
            for (int u = vcu; u < nmla; u += G) {
                int b, h, qb;
                if (u < nmla_full) { qb = u & 15; h = (u >> 4) & 15; b = u >> 8; } else { const int v = u - nmla_full; qb = 16; h = v & 15; b = v >> 4; }
                att::mla_unit4((att::lds_ptr)(lds + RING_OFF), (const bf16*)(ws + WS_Q), (const bf16*)(ws + WS_KN), (const bf16*)(ws + WS_KR), (const bf16*)(ws + WS_V), (bf16*)(ws + WS_OAB), b, h, qb, tid);
            }
            const int nj = l == 0 ? 65 : 64, nswa_full = NB * 4 * 64, nswa = NB * 4 * nj;
            int tables_hk = -1;
            for (int rep2_ = 0; rep2_ < NREP(15); ++rep2_)
            for (int u = vcu; u < nswa; u += G) {
                int b, hk, j;
                if (u < nswa_full) { j = u & 63; hk = (u >> 6) & 3; b = u >> 8; } else { const int v = u - nswa_full; j = 64; hk = v & 3; b = v >> 2; }
                att::swa_unit2((att::lds_ptr)(lds + RING_OFF), (const bf16*)(ws + WS_QB), (const bf16*)(ws + WS_KB), (const bf16*)(ws + WS_VB), (bf16*)(ws + WS_OAB), (const float*)(ws + WS_TW), (const float*)(ws + WS_TM), (const float*)(ws + WS_SINK) + 16 * l, b, hk, j, tables_hk, tid);
            }
        }
        SEAM(P + 2);
        for (int rep_ = 0; rep_ < NREP(4); ++rep_) if (KEN(4) && IN(P + 3)) { PH_WS(); int* const SLOT_TOK = (int*)(ws + WS_SLOTTOK); float* const SLOT_GATE = (float*)(ws + WS_SLOTGATE); int* const TOK_SLOT = (int*)(ws + WS_TOKSLOT); (void)SLOT_TOK; (void)SLOT_GATE; (void)TOK_SLOT;
            ProbDense pr; pr.so.init(nM_post, D / 256, G, bx, tail_post); pr.A = (const char*)(ws + WS_OAB); pr.Bt = (const char*)(ws + WS_W + l * WL_STRIDE + WL_AB); pr.tstep = 256 * (size_t)(2 * D) * 2;
            epi::EpiProj E{(bf16*)(ws + WS_MG), (const bf16*)(ws + WS_GR), (const bf16*)(ws + WS_GBB)};
            pg8::gemm_phase<epi::EpiProj, ProbDense>(lds + RING_OFF, 2 * D, pr, E, tid);
        }
        SEAM(P + 3);
        for (int rep_ = 0; rep_ < NREP(5); ++rep_) if (KEN(5) && IN(P + 4)) { PH_WS(); int* const SLOT_TOK = (int*)(ws + WS_SLOTTOK); float* const SLOT_GATE = (float*)(ws + WS_SLOTGATE); int* const TOK_SLOT = (int*)(ws + WS_TOKSLOT); (void)SLOT_TOK; (void)SLOT_GATE; (void)TOK_SLOT;
            ProbDense pr; pr.so.init(nM_post, D / 256, G, bx, tail_post); pr.A = (const char*)(ws + WS_MG); pr.Bt = (const char*)(ws + WS_W + l * WL_STRIDE + WL_OUT); pr.tstep = 256 * (size_t)D * 2;
            epi::EpiResid E{X, HB};
            pg8::gemm_phase<epi::EpiResid, ProbDense>(lds + RING_OFF, D, pr, E, tid);
        }
        SEAM(P + 4);
        for (int rep_ = 0; rep_ < NREP(6); ++rep_) if (KEN(6) && IN(P + 5)) { PH_WS(); int* const SLOT_TOK = (int*)(ws + WS_SLOTTOK); float* const SLOT_GATE = (float*)(ws + WS_SLOTGATE); int* const TOK_SLOT = (int*)(ws + WS_TOKSLOT); (void)SLOT_TOK; (void)SLOT_GATE; (void)TOK_SLOT;
            const float* g = INP(I_LMG) + l * D; const float* bta = INP(I_LMB) + l * D;
            const int nrows = l == 0 ? T : TREAL;
            int h0 = 0, h1 = 0, h2 = 0, h3 = 0, h4 = 0, h5 = 0, h6 = 0, h7 = 0;
            LAS f32x4* const rwl = (LAS f32x4*)(lds + RING_OFF);
            if (l == 1) { const GAS f32x4* rwg = (const GAS f32x4*)INP(I_RW); for (int i = tid; i < D * 2; i += NWAVES * 64) { const int k = i >> 1, hf = i & 1; rwl[hf * 2048 + ((k >> 8) * 4 + (k & 3)) * 64 + ((k >> 2) & 63)] = rwg[i]; } __syncthreads(); }
#define LM_PROC(r, m) do { ln_normalize(r); ln_affine(r, g, bta, lane); row_store_bf16(r, HB + (size_t)(m) * D, lane); \
                if (l == 1) { int i0_, i1_; float g0_, g1_; router_row(r, rwl, rbias, lane, i0_, i1_, g0_, g1_); \
                    if (lane == 0) { int* ti = (int*)(ws + WS_TOPI); float* tg = (float*)(ws + WS_TOPG); ti[2 * (m)] = i0_; ti[2 * (m) + 1] = i1_; tg[2 * (m)] = g0_; tg[2 * (m) + 1] = g1_; } \
                    h0 += (i0_ == 0) + (i1_ == 0); h1 += (i0_ == 1) + (i1_ == 1); h2 += (i0_ == 2) + (i1_ == 2); h3 += (i0_ == 3) + (i1_ == 3); \
                    h4 += (i0_ == 4) + (i1_ == 4); h5 += (i0_ == 5) + (i1_ == 5); h6 += (i0_ == 6) + (i1_ == 6); h7 += (i0_ == 7) + (i1_ == 7); } } while (0)
            { const float* rbias = INP(I_RB); Row8 ra{}, rb{}; int m = gw; if (m < nrows) row_load_bf16(ra, X + (size_t)m * D, lane);
              for (; m < nrows; m += 2 * NGW) { const int m1 = m + NGW, m2 = m + 2 * NGW; if (m1 < nrows) row_load_bf16(rb, X + (size_t)m1 * D, lane); LM_PROC(ra, m);
                  if (m1 < nrows) { if (m2 < nrows) row_load_bf16(ra, X + (size_t)m2 * D, lane); LM_PROC(rb, m1); } } }
#undef LM_PROC
            if (l == 1 && lane == 0) { int* wh = (int*)(ws + WS_WHIST) + gw * 8; wh[0] = h0; wh[1] = h1; wh[2] = h2; wh[3] = h3; wh[4] = h4; wh[5] = h5; wh[6] = h6; wh[7] = h7; }
        }
        SEAM(P + 5);
        if (l == 0) {
            for (int rep_ = 0; rep_ < NREP(7); ++rep_) if (KEN(7) && IN(P + 6)) { PH_WS(); int* const SLOT_TOK = (int*)(ws + WS_SLOTTOK); float* const SLOT_GATE = (float*)(ws + WS_SLOTGATE); int* const TOK_SLOT = (int*)(ws + WS_TOKSLOT); (void)SLOT_TOK; (void)SLOT_GATE; (void)TOK_SLOT;
                ProbDense pr; pr.so.init(nM_all, 2 * DFF / 256, G, bx, true); pr.A = (const char*)HB; pr.Bt = (const char*)(ws + WS_WF13); pr.tstep = 256 * (size_t)D * 2;
                epi::EpiSwiglu E{(bf16*)(ws + WS_ACT)};
                pg8::gemm_phase<epi::EpiSwiglu, ProbDense>(lds + RING_OFF, D, pr, E, tid);
            }
            SEAM(P + 6);
            for (int rep_ = 0; rep_ < NREP(8); ++rep_) if (KEN(8) && IN(P + 7)) { PH_WS(); int* const SLOT_TOK = (int*)(ws + WS_SLOTTOK); float* const SLOT_GATE = (float*)(ws + WS_SLOTGATE); int* const TOK_SLOT = (int*)(ws + WS_TOKSLOT); (void)SLOT_TOK; (void)SLOT_GATE; (void)TOK_SLOT;
                ProbDense pr; pr.so.init(nM_all, D / 256, G, bx, true); pr.A = (const char*)(ws + WS_ACT); pr.Bt = (const char*)(ws + WS_WF2); pr.tstep = 256 * (size_t)DFF * 2;
                epi::EpiResid E{X, HB};
                pg8::gemm_phase<epi::EpiResid, ProbDense>(lds + RING_OFF, DFF, pr, E, tid);
            }
            SEAM(P + 7);
            for (int rep_ = 0; rep_ < NREP(9); ++rep_) if (KEN(9) && IN(P + 8)) { PH_WS(); int* const SLOT_TOK = (int*)(ws + WS_SLOTTOK); float* const SLOT_GATE = (float*)(ws + WS_SLOTGATE); int* const TOK_SLOT = (int*)(ws + WS_TOKSLOT); (void)SLOT_TOK; (void)SLOT_GATE; (void)TOK_SLOT;
                const float* g = INP(I_LFG); const float* bta = INP(I_LFB);
#define LF_PROC(r, m) do { ln_normalize(r); ln_affine(r, g, bta, lane); row_store_bf16(r, HB + (size_t)(m) * D, lane); } while (0)
                { Row8 ra{}, rb{}; int m = gw; if (m < T) row_load_bf16(ra, X + (size_t)m * D, lane);
                  for (; m < T; m += 2 * NGW) { const int m1 = m + NGW, m2 = m + 2 * NGW; if (m1 < T) row_load_bf16(rb, X + (size_t)m1 * D, lane); LF_PROC(ra, m);
                      if (m1 < T) { if (m2 < T) row_load_bf16(ra, X + (size_t)m2 * D, lane); LF_PROC(rb, m1); } } }
#undef LF_PROC
            }
            SEAM(P + 8);
        } else {
            for (int rep_ = 0; rep_ < NREP(10); ++rep_) if (KEN(10) && IN(P + 6)) { PH_WS(); int* const SLOT_TOK = (int*)(ws + WS_SLOTTOK); float* const SLOT_GATE = (float*)(ws + WS_SLOTGATE); int* const TOK_SLOT = (int*)(ws + WS_TOKSLOT); (void)SLOT_TOK; (void)SLOT_GATE; (void)TOK_SLOT;
                LAS int* hist = (LAS int*)(lds + RING_OFF);
                LAS int* segsum = hist + 2048 * 8;
                LAS int* segpre = segsum + 64 * 8;
                LAS int* tot = segpre + 64 * 8;
                const int* wh = (const int*)(ws + WS_WHIST);
                for (int i = tid; i < NGW * 8; i += NWAVES * 64) hist[i] = wh[i];
                __syncthreads();
                { const int e = tid & 7, seg = tid >> 3; int s = 0;
_Pragma("unroll 1")
                  for (int w = 0; w < 32; ++w) { const int ww = seg * 32 + w; if (ww < NGW) s += hist[ww * 8 + e]; } segsum[seg * 8 + e] = s; }
                __syncthreads();
                if (tid < 8) { int run = 0;
_Pragma("unroll 1")
                    for (int s = 0; s < 64; ++s) { segpre[s * 8 + tid] = run; run += segsum[s * 8 + tid]; } tot[tid] = run; }
                __syncthreads();
                if (tid == 0) { int ts = 0; for (int e = 0; e < 8; ++e) { tot[8 + e] = ts; ts += (tot[e] + 255) >> 8; } tot[16] = ts;
                    if (bx == 0) for (int e = 0; e < 9; ++e) ((int*)(ws + WS_CTL))[CW_MOE_TS + e] = tot[8 + e]; }
                __syncthreads();
                int base = 0;
                if (lane < 8) { base = tot[8 + lane] * 256 + segpre[(gw >> 5) * 8 + lane];
_Pragma("unroll 1")
                    for (int w = (gw & ~31); w < gw; ++w) base += hist[w * 8 + lane]; }
                const int* ti = (const int*)(ws + WS_TOPI); const float* tg = (const float*)(ws + WS_TOPG);
                for (int m = gw; m < TREAL; m += NGW) {
#pragma unroll
                    for (int k = 0; k < 2; ++k) { const int e = __builtin_amdgcn_readfirstlane(ti[2 * m + k]); const float gt = tg[2 * m + k];
                        const int slot = __builtin_amdgcn_readlane(base, e); if (lane == e) base += 1;
                        if (lane == 0) { SLOT_TOK[slot] = m; SLOT_GATE[slot] = gt; TOK_SLOT[2 * m + k] = slot; } }
                }
                if (vcu < 8) { const int e = vcu; const int s0 = tot[8 + e] * 256 + tot[e], s1 = tot[8 + e + 1] * 256; for (int s = s0 + tid; s < s1; s += NWAVES * 64) { SLOT_TOK[s] = T; SLOT_GATE[s] = 0.f; } }
                __syncthreads();
                LAS float* scr = (LAS float*)(lds + RING_OFF + wave * 16384);
                constexpr int I_F = (D / 64) * (DFF / 32), I_F2 = (DFF / 64) * (D / 32), I_E = 2 * I_F + I_F2;
                for (int it = gw; it < NE * I_E; it += NGW) {
                    const int e = it / I_E; int r = it - e * I_E;
                    if (r < 2 * I_F) { const int which = r / I_F; r -= which * I_F; const int nblk = DFF / 32, kb = r / nblk, nb = r % nblk;
                        transpose_item(INP(which ? I_MW3 : I_MW1) + (size_t)e * D * DFF, DFF, 64 * kb, 32 * nb, (bf16*)(ws + WS_MW13) + (size_t)e * 2 * DFF * D, D, dmap_glu(32 * nb) + (which ? 128 : 0), 0, nullptr, scr, lane); continue; }
                    r -= 2 * I_F;
                    { const int nblk = D / 32, kb = r / nblk, nb = r % nblk; transpose_item(INP(I_MW2) + (size_t)e * DFF * D, D, 64 * kb, 32 * nb, (bf16*)(ws + WS_MW2) + (size_t)e * D * DFF, DFF, 32 * nb, 0, nullptr, scr, lane); }
                }
            }
            SEAM(P + 6);
            MoeTiles mt;
            if (IN(P + 7) || IN(P + 8)) { unsigned char* const ws = WSP();
#pragma unroll
                for (int e = 0; e < 9; ++e) mt.ts[e] = __builtin_amdgcn_readfirstlane(((const int*)(ws + WS_CTL))[CW_MOE_TS + e]);
            } else {
#pragma unroll
                for (int e = 0; e < 9; ++e) mt.ts[e] = 0;
            }
            for (int rep_ = 0; rep_ < NREP(11); ++rep_) if (KEN(11) && IN(P + 7)) { PH_WS(); int* const SLOT_TOK = (int*)(ws + WS_SLOTTOK); float* const SLOT_GATE = (float*)(ws + WS_SLOTGATE); int* const TOK_SLOT = (int*)(ws + WS_TOKSLOT); (void)SLOT_TOK; (void)SLOT_GATE; (void)TOK_SLOT;
                ProbMoe1 pr; pr.so.init(mt.ts[8], 2 * DFF / 256, G, bx); pr.HBp = (const char*)HB; pr.slot_tok = SLOT_TOK; pr.W = (const char*)(ws + WS_MW13); pr.mt = mt;
                epi::EpiSwiglu E{(bf16*)(ws + WS_MACT)};
                pg8::gemm_phase<epi::EpiSwiglu, ProbMoe1, true>(lds + RING_OFF, D, pr, E, tid);
            }
            SEAM(P + 7);
            for (int rep_ = 0; rep_ < NREP(12); ++rep_) if (KEN(12) && IN(P + 8)) { PH_WS(); int* const SLOT_TOK = (int*)(ws + WS_SLOTTOK); float* const SLOT_GATE = (float*)(ws + WS_SLOTGATE); int* const TOK_SLOT = (int*)(ws + WS_TOKSLOT); (void)SLOT_TOK; (void)SLOT_GATE; (void)TOK_SLOT;
                ProbMoe2 pr; pr.so.init(mt.ts[8], D / 256, G, bx); pr.ACTp = (const char*)(ws + WS_MACT); pr.W = (const char*)(ws + WS_MW2); pr.mt = mt;
                epi::EpiMoeDown E{(bf16*)(ws + WS_Y), SLOT_GATE};
                pg8::gemm_phase<epi::EpiMoeDown, ProbMoe2>(lds + RING_OFF, DFF, pr, E, tid);
            }
            SEAM(P + 8);
            for (int rep_ = 0; rep_ < NREP(13); ++rep_) if (KEN(13) && IN(P + 9)) { PH_WS(); int* const SLOT_TOK = (int*)(ws + WS_SLOTTOK); float* const SLOT_GATE = (float*)(ws + WS_SLOTGATE); int* const TOK_SLOT = (int*)(ws + WS_TOKSLOT); (void)SLOT_TOK; (void)SLOT_GATE; (void)TOK_SLOT;
                const float* g = INP(I_LFG) + D; const float* bta = INP(I_LFB) + D; const bf16* Y = (const bf16*)(ws + WS_Y);
#define FL_LOAD(R, m) do { const int s0_ = TOK_SLOT[2 * (m)], s1_ = TOK_SLOT[2 * (m) + 1]; \
                    _Pragma("unroll") for (int j = 0; j < 8; ++j) { const v2u hw = *((const GAS v2u*)(HB + (size_t)(m) * D) + lane + 64 * j), y0 = *((const GAS v2u*)(Y + (size_t)s0_ * D) + lane + 64 * j), y1 = *((const GAS v2u*)(Y + (size_t)s1_ * D) + lane + 64 * j); \
                        R.v[j] = (bf4(hw) * ALPHA + bf4(y0)) + bf4(y1); } } while (0)
#define FL_PROC(R, m) do { ln_normalize(R); ln_affine(R, g, bta, lane); GAS f32x4* o = (GAS f32x4*)(outp + (size_t)(m) * D) + lane; \
                    _Pragma("unroll") for (int j = 0; j < 8; ++j) o[64 * j] = R.v[j]; } while (0)
                { float* const outp = OUTP(); Row8 ra{}, rb{}; int m = gw; if (m < TREAL) FL_LOAD(ra, m);
                  for (; m < TREAL; m += 2 * NGW) { const int m1 = m + NGW, m2 = m + 2 * NGW; if (m1 < TREAL) FL_LOAD(rb, m1); FL_PROC(ra, m);
                      if (m1 < TREAL) { if (m2 < TREAL) FL_LOAD(ra, m2); FL_PROC(rb, m1); } } }
#undef FL_LOAD
#undef FL_PROC
            }
        }
    }
#undef IN
#undef SEAM
}

#ifndef MK_ONE_LAUNCH
#define MK_ONE_LAUNCH 0
#endif
extern "C" void kernel_launch(void* const* d_in, const int* in_sizes, int n_in, void* d_out, int out_size, void* d_ws, size_t ws_size, hipStream_t stream) {
    static int grid = 0;
    if (grid == 0) {
        if (n_in != N_IN || in_sizes[0] != NB * SEQ * D || out_size != NB * SEQ * D || ws_size < WS_END) { fprintf(stderr, "kernel_launch: shape mismatch: n_in %d in0 %d out %d ws %zu (need %zu)\n", n_in, n_in > 0 ? in_sizes[0] : -1, out_size, ws_size, (size_t)WS_END); grid = -1; return; }
        int dev = 0, cus = 0, per_cu = 0;
        if (hipGetDevice(&dev) != hipSuccess || hipDeviceGetAttribute(&cus, hipDeviceAttributeMultiprocessorCount, dev) != hipSuccess) { fprintf(stderr, "kernel_launch: device query failed\n"); grid = -1; return; }
        if (hipFuncSetAttribute((const void*)mk_fwd, hipFuncAttributeMaxDynamicSharedMemorySize, LDS_BYTES) != hipSuccess) { fprintf(stderr, "kernel_launch: hipFuncSetAttribute failed\n"); grid = -1; return; }
        if (hipOccupancyMaxActiveBlocksPerMultiprocessor(&per_cu, (const void*)mk_fwd, NWAVES * 64, LDS_BYTES) != hipSuccess || per_cu < 1) fprintf(stderr, "kernel_launch: occupancy query reports %d\n", per_cu);
        (void)hipGetLastError();
        grid = cus;
    }
    if (grid < 0) return;
    if (hipMemsetAsync((char*)d_ws + WS_CTL, 0, CTL_ZERO_BYTES, stream) != hipSuccess) { fprintf(stderr, "kernel_launch: memset failed\n"); return; }
    Args a{};
    for (int i = 0; i < N_IN; ++i) a.in[i] = (const float*)d_in[i];
    a.out = (float*)d_out; a.ws = (unsigned char*)d_ws;
#if MK_ONE_LAUNCH
    a.ph_lo = 0; a.ph_hi = N_PHASES;
    hipLaunchKernelGGL(mk_fwd, dim3(grid), dim3(NWAVES * 64), LDS_BYTES, stream, a);
#else
    for (int p = 0; p < N_PHASES; ++p) { a.ph_lo = p; a.ph_hi = p + 1; hipLaunchKernelGGL(mk_fwd, dim3(grid), dim3(NWAVES * 64), LDS_BYTES, stream, a); }
#endif
    const hipError_t le = hipPeekAtLastError();
    if (le != hipSuccess) fprintf(stderr, "kernel_launch: launch failed: %s\n", hipGetErrorName(le));
}
```

```cpp
#define MK_ONE_LAUNCH 1
#include <hip/hip_runtime.h>
#include <cstdio>
#include <cstdint>
namespace pg8 {
#define PG8_LAS __attribute__((address_space(3)))
typedef unsigned short bf16_t;
typedef short bf16x8 __attribute__((ext_vector_type(8)));
typedef float f32x4 __attribute__((ext_vector_type(4)));
typedef float f32x2 __attribute__((ext_vector_type(2)));
typedef unsigned u32x4 __attribute__((ext_vector_type(4)));
typedef unsigned u32x2 __attribute__((ext_vector_type(2)));
constexpr int BM = 256, BK = 64, HALF = 128, HTB = HALF * BK * 2  , STAGE_BYTES = 8 * HTB, NXCD = 8, WGM = 8;

__host__ __device__ __forceinline__ int lds_byte(int r, int c) { const int st = (r >> 4) * 2 + (c >> 5), rr = r & 15, cc = c & 31, ob = rr * 64 + cc * 2; return st * 1024 + (ob ^ (((ob >> 9) & 1) << 5)); }
__host__ __device__ __forceinline__ void stage_rc(int b, int& R, int& C) { const int st = b / 1024, sb = b % 1024, swz = sb ^ (((sb >> 9) & 1) << 5); R = (st >> 1) * 16 + swz / 64; C = (st & 1) * 32 + (swz % 64) / 2; }
__host__ __device__ __forceinline__ int perm32(int rho) { const int n = rho >> 4, i = rho & 15; return 8 * (i >> 2) + 4 * n + (i & 3); }

struct Unit { int pm, pn; };

struct StaticOrder {
    int nM, nN, nwg, G, c, ntail;
    __device__ __forceinline__ void init(int nM_, int nN_, int G_, int c_, bool tail = false) { nM = nM_; nN = nN_; nwg = nM * nN; G = G_; c = c_; ntail = tail ? nN_ : 0; }
    __device__ __forceinline__ bool next(int i, Unit& u) const {
        const long L = (long)i * G + c; if (L >= nwg + ntail) return false;
        if (L >= nwg) { u.pm = nM; u.pn = (int)(L - nwg); return true; }
        int wgid = (int)L; { const int q = nwg / NXCD, r = nwg % NXCD, xcd = wgid % NXCD, off = wgid / NXCD; wgid = (xcd < r ? xcd * (q + 1) : r * (q + 1) + (xcd - r) * q) + off; }
        const int nig = WGM * nN, gid = wgid / nig, fm = gid * WGM, gsz = (nM - fm) < WGM ? (nM - fm) : WGM;
        u.pm = fm + ((wgid % nig) % gsz); u.pn = (wgid % nig) / gsz; return true;
    }
    __device__ __forceinline__ bool is_half(const Unit& u) const { return ntail != 0 && u.pm == nM; }
};
__device__ __forceinline__ unsigned cvt_pk_bf16(float lo, float hi) { unsigned r; asm volatile("v_cvt_pk_bf16_f32 %0, %1, %2" : "=v"(r) : "v"(lo), "v"(hi)); return r; }
__device__ __forceinline__ float bf_lo(unsigned w) { return __uint_as_float(w << 16); }
__device__ __forceinline__ float bf_hi(unsigned w) { return __uint_as_float(w & 0xffff0000u); }

template <class Epi, class Prob, bool GATHER = false>
__device__ __forceinline__ void gemm_phase(PG8_LAS unsigned char* lds, const int K, const Prob& S, const Epi& E, const int tid_in) {
    int tid_ = tid_in; asm volatile("" : "+v"(tid_));
    const int tid = tid_, wid = __builtin_amdgcn_readfirstlane(tid >> 6), lane = tid & 63, wr = wid >> 2, wc = wid & 3, fr = lane & 15, fq = lane >> 4;
    const int nt = K / BK;
    int sR[2], sC[2];
    unsigned voffA[2][2], nvoffA[2][2], voffB[2];
#pragma unroll
    for (int i = 0; i < 2; ++i) { int R, C; stage_rc(tid * 16 + i * 8192, R, C); sR[i] = R; sC[i] = C; const int Rb = (R & ~31) + perm32(R & 31);
        voffB[i] = (unsigned)(Rb * K + C) * 2u;
        voffA[0][i] = (unsigned)(R * K + C) * 2u; voffA[1][i] = (unsigned)((R + HALF) * K + C) * 2u; nvoffA[0][i] = voffA[0][i]; nvoffA[1][i] = voffA[1][i]; }
    const size_t kstep = (size_t)(BK * 2);
    const size_t hstep = (size_t)HALF * K * 2;
    const unsigned ldsw = (unsigned)wid * 1024u;
    const int aoff = lds_byte(wr * 64 + fr, fq * 8), boff = lds_byte(wc * 32 + fr, fq * 8);
#define PG8_SA(b, h) (((b) * 2 + (h)) * HTB)
#define PG8_SB(b, h) ((4 + (b) * 2 + (h)) * HTB)
#define PG8_STAGE(bufoff, gbase, voff) do { _Pragma("unroll") for (int _i = 0; _i < 2; ++_i) \
        __builtin_amdgcn_global_load_lds((const unsigned*)((const char*)(gbase) + (voff)[_i]), (PG8_LAS unsigned*)(lds + (bufoff) + ldsw + _i * 8192), 16, 0, 0); } while (0)
#define PG8_LDA(dst, b, h) do { _Pragma("unroll") for (int m = 0; m < 4; ++m) _Pragma("unroll") for (int k = 0; k < 2; ++k) dst[m][k] = *(const PG8_LAS bf16x8*)(lds + PG8_SA(b, h) + aoff + m * 2048 + k * 1024); } while (0)
#define PG8_LDB(dst, b, h) do { _Pragma("unroll") for (int n = 0; n < 2; ++n) _Pragma("unroll") for (int k = 0; k < 2; ++k) dst[n][k] = *(const PG8_LAS bf16x8*)(lds + PG8_SB(b, h) + boff + n * 2048 + k * 1024); } while (0)
#define PG8_MMA(ai, bj, At, Bt) do { __builtin_amdgcn_s_setprio(1); _Pragma("unroll") for (int m = 0; m < 4; ++m) _Pragma("unroll") for (int n = 0; n < 2; ++n) _Pragma("unroll") for (int k = 0; k < 2; ++k) \
        acc[ai][bj][m][n] = __builtin_amdgcn_mfma_f32_16x16x32_bf16(Bt[n][k], At[m][k], acc[ai][bj][m][n], 0, 0, 0); __builtin_amdgcn_s_setprio(0); } while (0)
#define PG8_WAIT_V(n) asm volatile("s_waitcnt vmcnt(" #n ")" ::: "memory")
#define PG8_WAIT_L(n) asm volatile("s_waitcnt lgkmcnt(" #n ")" ::: "memory")
#define PG8_BAR __builtin_amdgcn_s_barrier()
#define PG8_SCHED __builtin_amdgcn_sched_barrier(0)
    Unit cur, nxt; int ui = 0;
    if (!S.next(0, cur)) return;
    f32x4 acc[2][2][4][2];
#pragma unroll
    for (int a = 0; a < 2; ++a)
#pragma unroll
        for (int b = 0; b < 2; ++b)
#pragma unroll
            for (int m = 0; m < 4; ++m)
#pragma unroll
                for (int n = 0; n < 2; ++n) acc[a][b][m][n] = (f32x4){0.f, 0.f, 0.f, 0.f};
    bf16x8 At[4][2], B0[2][2], B1[2][2];
    const char* cA = S.a_base(cur); const char* cB = S.b_base(cur);
    if constexpr (GATHER) {
#pragma unroll
        for (int h = 0; h < 2; ++h)
#pragma unroll
            for (int i = 0; i < 2; ++i) { voffA[h][i] = (unsigned)(S.a_row(cur, sR[i] + h * HALF) * K + sC[i]) * 2u; nvoffA[h][i] = voffA[h][i]; }
    }
    PG8_STAGE(PG8_SB(0, 0), cB, voffB); PG8_STAGE(PG8_SB(0, 1), cB + hstep, voffB); PG8_STAGE(PG8_SA(0, 0), cA, voffA[0]); PG8_STAGE(PG8_SA(0, 1), cA, voffA[1]);
    if (wr == 1) PG8_BAR;
    PG8_WAIT_V(2); PG8_BAR;
    PG8_STAGE(PG8_SB(1, 0), cB + kstep, voffB); PG8_STAGE(PG8_SA(1, 0), cA + kstep, voffA[0]); PG8_STAGE(PG8_SB(1, 1), cB + hstep + kstep, voffB);
    PG8_WAIT_V(6); PG8_BAR;
    for (;;) {
        const bool has_next = S.next(ui + 1, nxt);
        const bool half = S.is_half(cur);
        const char* nA = has_next ? S.a_base(nxt) : cA; const char* nB = has_next ? S.b_base(nxt) : cB;
        if constexpr (GATHER) { if (has_next) {
#pragma unroll
            for (int h = 0; h < 2; ++h)
#pragma unroll
                for (int i = 0; i < 2; ++i) nvoffA[h][i] = (unsigned)(S.a_row(nxt, sR[i] + h * HALF) * K + sC[i]) * 2u; } }
        for (int t = 0; t < nt; t += 2) {
            const bool last = (t == nt - 2);
            if constexpr (Epi::MID) { if (t == (nt >> 1)) E.mid(acc, cur, wr, wc, fr, fq); }
            const char* a1 = cA + (size_t)(t + 1) * kstep;
            const char* a2 = last ? nA : cA + (size_t)(t + 2) * kstep; const char* b2 = last ? nB : cB + (size_t)(t + 2) * kstep;
            const char* a3 = a2 + kstep; const char* b3 = b2 + kstep;
            unsigned vA2[2][2];
#pragma unroll
            for (int h = 0; h < 2; ++h)
#pragma unroll
                for (int i = 0; i < 2; ++i) vA2[h][i] = GATHER ? (last ? nvoffA[h][i] : voffA[h][i]) : voffA[h][i];
            PG8_LDB(B0, 0, 0); PG8_LDB(B1, 0, 1); PG8_SCHED; PG8_LDA(At, 0, 0); PG8_STAGE(PG8_SA(1, 1), a1, voffA[1]);
            PG8_WAIT_V(8); PG8_WAIT_L(0); PG8_BAR; PG8_MMA(0, 0, At, B0); PG8_MMA(0, 1, At, B1); PG8_BAR; PG8_SCHED;
            if (!half) PG8_LDA(At, 0, 1); PG8_STAGE(PG8_SB(0, 0), b2, voffB); PG8_STAGE(PG8_SB(0, 1), b2 + hstep, voffB); PG8_STAGE(PG8_SA(0, 0), a2, vA2[0]);
            PG8_WAIT_V(8); PG8_WAIT_L(0); PG8_BAR; if (!half) { PG8_MMA(1, 0, At, B0); PG8_MMA(1, 1, At, B1); } PG8_BAR; PG8_SCHED;
            PG8_LDB(B0, 1, 0); PG8_LDB(B1, 1, 1); PG8_SCHED; PG8_LDA(At, 1, 0); PG8_STAGE(PG8_SA(0, 1), a2, vA2[1]);
            PG8_WAIT_V(8); PG8_WAIT_L(0); PG8_BAR; PG8_MMA(0, 0, At, B0); PG8_MMA(0, 1, At, B1); PG8_BAR; PG8_SCHED;
            if (!half) PG8_LDA(At, 1, 1); PG8_STAGE(PG8_SB(1, 0), b3, voffB); PG8_STAGE(PG8_SB(1, 1), b3 + hstep, voffB); PG8_STAGE(PG8_SA(1, 0), a3, vA2[0]);
            PG8_WAIT_V(8); PG8_WAIT_L(0); PG8_BAR; if (!half) { PG8_MMA(1, 0, At, B0); PG8_MMA(1, 1, At, B1); } PG8_BAR; PG8_SCHED;
        }
        if (wr == 0) PG8_BAR;
        E(acc, cur, wr, wc, fr, fq);
        if (!has_next) break;
#pragma unroll
        for (int a = 0; a < 2; ++a)
#pragma unroll
            for (int b = 0; b < 2; ++b)
#pragma unroll
                for (int m = 0; m < 4; ++m)
#pragma unroll
                    for (int n = 0; n < 2; ++n) acc[a][b][m][n] = (f32x4){0.f, 0.f, 0.f, 0.f};
        cur = nxt; cA = nA; cB = nB; ++ui;
        if constexpr (GATHER) {
#pragma unroll
            for (int h = 0; h < 2; ++h)
#pragma unroll
                for (int i = 0; i < 2; ++i) voffA[h][i] = nvoffA[h][i]; }
        if (wr == 1) PG8_BAR;
    }
    PG8_WAIT_V(0);
    PG8_BAR;
#undef PG8_SA
#undef PG8_SB
#undef PG8_STAGE
#undef PG8_LDA
#undef PG8_LDB
#undef PG8_MMA
#undef PG8_WAIT_V
#undef PG8_WAIT_L
#undef PG8_BAR
#undef PG8_SCHED
}
}
constexpr int D = 2048, NB = 8, SEQ = 4096, NMETA = 16, NH = 16;
constexpr int TREAL = NB * SEQ;
constexpr int T = TREAL + NB * NMETA;
constexpr int TP = 33024;
constexpr int LPOS = SEQ + NMETA;
constexpr int QRANK = 768, KVRANK = 512, DFF = 5632, NE = 8;
constexpr int NIN = 8704;
constexpr int INDIM = 8512;
constexpr float LN_EPS = 1e-5f, RMS_EPS = 1e-6f, ALPHA = 1.4142135623730951f;
constexpr float LOG2E = 1.4426950408889634f;
constexpr float QK_SCALE_MLA = 0.07216878364870322f * LOG2E;
constexpr float QK_SCALE_SWA = 0.08838834764831845f * LOG2E;

__device__ __forceinline__ int row_pos(int row) { return row < TREAL ? NMETA + (row & (SEQ - 1)) : ((row - TREAL) & (NMETA - 1)); }

struct ProbDense {
    pg8::StaticOrder so; const char* A; const char* Bt; size_t tstep;
    __device__ __forceinline__ bool next(int i, pg8::Unit& u) const { return so.next(i, u); }
    __device__ __forceinline__ const char* a_base(const pg8::Unit& u) const { return A + (size_t)u.pm * tstep; }
    __device__ __forceinline__ const char* b_base(const pg8::Unit& u) const { return Bt + (size_t)u.pn * tstep; }
    __device__ __forceinline__ int a_row(const pg8::Unit&, int) const { return 0; }
    __device__ __forceinline__ bool is_half(const pg8::Unit& u) const { return so.is_half(u); }
};
struct MoeTiles { int ts[9]; };
__device__ __forceinline__ int moe_expert(const MoeTiles& mt, int pm) { int e = 0;
#pragma unroll
    for (int k = 1; k < 8; ++k) e += (pm >= mt.ts[k]) ? 1 : 0; return e; }
struct ProbMoe1 {
    pg8::StaticOrder so; const char* HBp; const int* slot_tok; const char* W; MoeTiles mt;
    __device__ __forceinline__ bool next(int i, pg8::Unit& u) const { return so.next(i, u); }
    __device__ __forceinline__ const char* a_base(const pg8::Unit&) const { return HBp; }
    __device__ __forceinline__ const char* b_base(const pg8::Unit& u) const { return W + (size_t)moe_expert(mt, u.pm) * ((size_t)2 * DFF * D * 2) + (size_t)u.pn * (256 * (size_t)D * 2); }
    __device__ __forceinline__ int a_row(const pg8::Unit& u, int r) const { return slot_tok[u.pm * 256 + r]; }
    __device__ __forceinline__ bool is_half(const pg8::Unit&) const { return false; }
};
struct ProbMoe2 {
    pg8::StaticOrder so; const char* ACTp; const char* W; MoeTiles mt;
    __device__ __forceinline__ bool next(int i, pg8::Unit& u) const { return so.next(i, u); }
    __device__ __forceinline__ const char* a_base(const pg8::Unit& u) const { return ACTp + (size_t)u.pm * (256 * (size_t)DFF * 2); }
    __device__ __forceinline__ const char* b_base(const pg8::Unit& u) const { return W + (size_t)moe_expert(mt, u.pm) * ((size_t)D * DFF * 2) + (size_t)u.pn * (256 * (size_t)DFF * 2); }
    __device__ __forceinline__ int a_row(const pg8::Unit&, int) const { return 0; }
    __device__ __forceinline__ bool is_half(const pg8::Unit&) const { return false; }
};

namespace epi {
using pg8::f32x4; using pg8::u32x4; using pg8::bf16_t; using pg8::Unit; using pg8::cvt_pk_bf16;
typedef const f32x4 (&AccRef)[2][2][4][2];
__device__ __forceinline__ void store8(bf16_t* p, f32x4 v0, f32x4 v1) { u32x4 w; w.x = cvt_pk_bf16(v0[0], v0[1]); w.y = cvt_pk_bf16(v0[2], v0[3]); w.z = cvt_pk_bf16(v1[0], v1[1]); w.w = cvt_pk_bf16(v1[2], v1[3]); *(u32x4*)p = w; }
__device__ __forceinline__ void load8(const bf16_t* p, f32x4& v0, f32x4& v1) { const u32x4 w = *(const u32x4*)p;
    v0 = (f32x4){pg8::bf_lo(w.x), pg8::bf_hi(w.x), pg8::bf_lo(w.y), pg8::bf_hi(w.y)}; v1 = (f32x4){pg8::bf_lo(w.z), pg8::bf_hi(w.z), pg8::bf_lo(w.w), pg8::bf_hi(w.w)}; }
__device__ __forceinline__ bool epi_fence() { asm volatile("" ::: "memory"); return true; }
__device__ __forceinline__ float sigmoidf_(float x) { return __builtin_amdgcn_rcpf(1.f + __builtin_amdgcn_exp2f(-x * LOG2E)); }
#define EPI_AM _Pragma("unroll") for (int ai = 0; ai < 2; ++ai) _Pragma("unroll") for (int m = 0; m < 4; ++m) if (epi_fence())

struct EpiWin {
    static constexpr bool MID = false;
    bf16_t *CQ, *CKV, *KR, *QB, *KB, *VB, *GR, *GBb; float* SSQ; const float *CS, *SN;
    __device__ __forceinline__ void operator()(AccRef acc, const Unit& u, int wr, int wc, int fr, int fq) const {
        const int pn = u.pn, row0 = u.pm * 256 + wr * 64 + fr, cw = wc * 32 + fq * 8;
        if (pn < 5) {
            bf16_t* dst = pn < 3 ? CQ : CKV; const int ld = pn < 3 ? QRANK : KVRANK, c0 = (pn < 3 ? pn : pn - 3) * 256;
            EPI_AM { const int row = row0 + ai * 128 + m * 16; float s = 0.f;
#pragma unroll
                for (int bj = 0; bj < 2; ++bj) { const f32x4 v0 = acc[ai][bj][m][0], v1 = acc[ai][bj][m][1];
                    s += (v0[0] * v0[0] + v0[1] * v0[1]) + (v0[2] * v0[2] + v0[3] * v0[3]) + (v1[0] * v1[0] + v1[1] * v1[1]) + (v1[2] * v1[2] + v1[3] * v1[3]);
                    store8(dst + (size_t)row * ld + c0 + bj * 128 + cw, v0, v1); }
                s += __shfl_xor(s, 16); s += __shfl_xor(s, 32);
                if (fq == 0) SSQ[(size_t)row * 20 + pn * 4 + wc] = s; }
        } else if (pn == 5) {
            if (wc == 0) { EPI_AM { const int row = row0 + ai * 128 + m * 16, pos = row_pos(row);
                const f32x4 c0 = *(const f32x4*)(CS + pos * 32 + fq * 8), c1 = *(const f32x4*)(CS + pos * 32 + fq * 8 + 4), s0 = *(const f32x4*)(SN + pos * 32 + fq * 8), s1 = *(const f32x4*)(SN + pos * 32 + fq * 8 + 4);
                const f32x4 x10 = acc[ai][0][m][0], x11 = acc[ai][0][m][1], x20 = acc[ai][1][m][0], x21 = acc[ai][1][m][1];
                store8(KR + (size_t)row * 64 + fq * 8, x10 * c0 - x20 * s0, x11 * c1 - x21 * s1);
                store8(KR + (size_t)row * 64 + 32 + fq * 8, x10 * s0 + x20 * c0, x11 * s1 + x21 * c1); } }
        } else if (pn < 14) {
            EPI_AM { const int row = row0 + ai * 128 + m * 16;
#pragma unroll
                for (int bj = 0; bj < 2; ++bj) store8(QB + (size_t)row * 2048 + (pn - 6) * 256 + bj * 128 + cw, acc[ai][bj][m][0] * QK_SCALE_SWA, acc[ai][bj][m][1] * QK_SCALE_SWA); }
        } else if (pn < 18) {
            bf16_t* dst = pn < 16 ? KB : VB; const int c0 = (pn < 16 ? pn - 14 : pn - 16) * 256;
            EPI_AM { const int row = row0 + ai * 128 + m * 16;
#pragma unroll
                for (int bj = 0; bj < 2; ++bj) store8(dst + (size_t)row * 512 + c0 + bj * 128 + cw, acc[ai][bj][m][0], acc[ai][bj][m][1]); }
        } else {
            const int c0 = (pn - 18) * 128 + cw;
            EPI_AM { const int row = row0 + ai * 128 + m * 16; f32x4 r[2], g[2];
#pragma unroll
                for (int n = 0; n < 2; ++n)
#pragma unroll
                    for (int j = 0; j < 4; ++j) { const float a = acc[ai][0][m][n][j], b = fmaxf(acc[ai][1][m][n][j], -30.f);
                        const float ea = __builtin_amdgcn_exp2f(-a * LOG2E), eb = __builtin_amdgcn_exp2f(-b * LOG2E);
                        g[n][j] = __builtin_amdgcn_rcpf(1.f + eb); r[n][j] = (1.f + eb) * __builtin_amdgcn_rcpf(1.f + ea); }
                store8(GR + (size_t)row * 2048 + c0, r[0], r[1]); store8(GBb + (size_t)row * 2048 + c0, g[0], g[1]); }
        }
    }
};
struct EpiUq {
    static constexpr bool MID = false;
    bf16_t* Q; const float* SSQ; const float *CS, *SN;
    __device__ __forceinline__ void operator()(AccRef acc, const Unit& u, int wr, int wc, int fr, int fq) const {
        const int pn = u.pn, row0 = u.pm * 256 + wr * 64 + fr, cw = wc * 32 + fq * 8;
        EPI_AM { const int row = row0 + ai * 128 + m * 16;
            const f32x4 q0 = *(const f32x4*)(SSQ + (size_t)row * 20), q1 = *(const f32x4*)(SSQ + (size_t)row * 20 + 4), q2 = *(const f32x4*)(SSQ + (size_t)row * 20 + 8);
            const float ss = ((q0[0] + q0[1]) + (q0[2] + q0[3])) + ((q1[0] + q1[1]) + (q1[2] + q1[3])) + ((q2[0] + q2[1]) + (q2[2] + q2[3]));
            const float rs = __builtin_amdgcn_rsqf(ss * (1.f / QRANK) + RMS_EPS) * QK_SCALE_MLA;
            if (pn < 8) {
#pragma unroll
                for (int bj = 0; bj < 2; ++bj) store8(Q + (size_t)row * 3072 + (2 * pn + bj) * 192 + cw, acc[ai][bj][m][0] * rs, acc[ai][bj][m][1] * rs);
            } else {
                const int head = 4 * (pn - 8) + wc, pos = row_pos(row);
                const f32x4 c0 = *(const f32x4*)(CS + pos * 32 + fq * 8), c1 = *(const f32x4*)(CS + pos * 32 + fq * 8 + 4), s0 = *(const f32x4*)(SN + pos * 32 + fq * 8), s1 = *(const f32x4*)(SN + pos * 32 + fq * 8 + 4);
                const f32x4 x10 = acc[ai][0][m][0] * rs, x11 = acc[ai][0][m][1] * rs, x20 = acc[ai][1][m][0] * rs, x21 = acc[ai][1][m][1] * rs;
                store8(Q + (size_t)row * 3072 + head * 192 + 128 + fq * 8, x10 * c0 - x20 * s0, x11 * c1 - x21 * s1);
                store8(Q + (size_t)row * 3072 + head * 192 + 160 + fq * 8, x10 * s0 + x20 * c0, x11 * s1 + x21 * c1);
            } }
    }
};
struct EpiUkv {
    static constexpr bool MID = false;
    bf16_t *KN, *V; const float* SSQ;
    __device__ __forceinline__ void operator()(AccRef acc, const Unit& u, int wr, int wc, int fr, int fq) const {
        const int pn = u.pn, row0 = u.pm * 256 + wr * 64 + fr, cw = wc * 32 + fq * 8;
        EPI_AM { const int row = row0 + ai * 128 + m * 16;
            const f32x4 q0 = *(const f32x4*)(SSQ + (size_t)row * 20 + 12), q1 = *(const f32x4*)(SSQ + (size_t)row * 20 + 16);
            const float ss = ((q0[0] + q0[1]) + (q0[2] + q0[3])) + ((q1[0] + q1[1]) + (q1[2] + q1[3]));
            const float rs = __builtin_amdgcn_rsqf(ss * (1.f / KVRANK) + RMS_EPS);
            store8(KN + (size_t)row * 2048 + pn * 128 + cw, acc[ai][0][m][0] * rs, acc[ai][0][m][1] * rs);
            store8(V + (size_t)row * 2048 + pn * 128 + cw, acc[ai][1][m][0] * rs, acc[ai][1][m][1] * rs); }
    }
};
struct EpiProj {
    static constexpr bool MID = true;
    bf16_t* MG; const bf16_t *GR, *GBb;
    __device__ __forceinline__ void mid(f32x4 (&acc)[2][2][4][2], const Unit& u, int wr, int wc, int fr, int fq) const {
        int row0 = u.pm * 256 + wr * 64 + fr, c0 = u.pn * 256 + wc * 32 + fq * 8; asm volatile("" : "+v"(row0), "+v"(c0));
        EPI_AM { const int row = row0 + ai * 128 + m * 16;
#pragma unroll
            for (int bj = 0; bj < 2; ++bj) { f32x4 r0, r1; load8(GR + (size_t)row * 2048 + c0 + bj * 128, r0, r1); acc[ai][bj][m][0] *= r0; acc[ai][bj][m][1] *= r1; } }
    }
    __device__ __forceinline__ void operator()(AccRef acc, const Unit& u, int wr, int wc, int fr, int fq) const {
        const int row0 = u.pm * 256 + wr * 64 + fr, c0 = u.pn * 256 + wc * 32 + fq * 8;
        EPI_AM { const int row = row0 + ai * 128 + m * 16;
#pragma unroll
            for (int bj = 0; bj < 2; ++bj) { f32x4 g0, g1; load8(GBb + (size_t)row * 2048 + c0 + bj * 128, g0, g1); store8(MG + (size_t)row * 2048 + c0 + bj * 128, acc[ai][bj][m][0] * g0, acc[ai][bj][m][1] * g1); } }
    }
};
struct EpiResid {
    static constexpr bool MID = false;
    bf16_t* X; const bf16_t* HB;
    __device__ __forceinline__ void operator()(AccRef acc, const Unit& u, int wr, int wc, int fr, int fq) const {
        const int row0 = u.pm * 256 + wr * 64 + fr, c0 = u.pn * 256 + wc * 32 + fq * 8;
        EPI_AM { const int row = row0 + ai * 128 + m * 16;
#pragma unroll
            for (int bj = 0; bj < 2; ++bj) { f32x4 h0, h1; load8(HB + (size_t)row * 2048 + c0 + bj * 128, h0, h1);
                store8(X + (size_t)row * 2048 + c0 + bj * 128, h0 * ALPHA + acc[ai][bj][m][0], h1 * ALPHA + acc[ai][bj][m][1]); } }
    }
};
struct EpiSwiglu {
    static constexpr bool MID = false;
    bf16_t* ACT;
    __device__ __forceinline__ void operator()(AccRef acc, const Unit& u, int wr, int wc, int fr, int fq) const {
        const int row0 = u.pm * 256 + wr * 64 + fr, c0 = u.pn * 128 + wc * 32 + fq * 8;
        EPI_AM { const int row = row0 + ai * 128 + m * 16; f32x4 o[2];
#pragma unroll
            for (int n = 0; n < 2; ++n)
#pragma unroll
                for (int j = 0; j < 4; ++j) { const float g = acc[ai][0][m][n][j]; o[n][j] = g * sigmoidf_(g) * acc[ai][1][m][n][j]; }
            store8(ACT + (size_t)row * DFF + c0, o[0], o[1]); }
    }
};
struct EpiMoeDown {
    static constexpr bool MID = false;
    bf16_t* Y; const float* slot_gate;
    __device__ __forceinline__ void operator()(AccRef acc, const Unit& u, int wr, int wc, int fr, int fq) const {
        const int row0 = u.pm * 256 + wr * 64 + fr, c0 = u.pn * 256 + wc * 32 + fq * 8;
        EPI_AM { const int row = row0 + ai * 128 + m * 16; const float g = slot_gate[row];
#pragma unroll
            for (int bj = 0; bj < 2; ++bj) store8(Y + (size_t)row * 2048 + c0 + bj * 128, acc[ai][bj][m][0] * g, acc[ai][bj][m][1] * g); }
    }
};
#undef EPI_AM
}
namespace att {
typedef unsigned short bf16;
typedef short bf16x8 __attribute__((ext_vector_type(8)));
typedef short s16x4 __attribute__((ext_vector_type(4)));
typedef float f32x16 __attribute__((ext_vector_type(16)));
typedef unsigned u32x4 __attribute__((ext_vector_type(4)));
#define ATT_LAS __attribute__((address_space(3)))
#define SBAR() __builtin_amdgcn_sched_barrier(0)
constexpr int KN_BYTES = 16384, KR_BYTES = 8192, V_BYTES = 16384, BUF_BYTES = KN_BYTES + KR_BYTES + V_BYTES;
constexpr int OFF_KN = 0, OFF_KR = KN_BYTES, OFF_V = KN_BYTES + KR_BYTES;
constexpr int OFF_WS = 2 * BUF_BYTES;
constexpr int OFF_BT = OFF_WS + 8 * 64 * 4;
constexpr int ATT_LDS_BYTES = OFF_BT + 4 * 260 * 4;
constexpr float NEG_BIG = -1e30f;
constexpr float THR2 = 8.f;

__device__ __forceinline__ int crow(int r, int hi) { return (r & 3) + 8 * (r >> 2) + 4 * hi; }
__device__ __forceinline__ unsigned cvtpk(float lo, float hi) { unsigned r; asm volatile("v_cvt_pk_bf16_f32 %0, %1, %2" : "=v"(r) : "v"(lo), "v"(hi)); return r; }
__device__ __forceinline__ int kn_off(int row, int colB) { return row * 256 + (colB ^ ((row & 15) << 4)); }
__device__ __forceinline__ int kr_off(int row, int colB) { return row * 128 + (colB ^ (((row >> 1) & 7) << 4)); }
__device__ __forceinline__ int v_st(int k, int c) { const int kk = (k & ~0xC) | ((k & 4) << 1) | ((k & 8) >> 1); return ((kk >> 3) * 4 + (c >> 5)) * 512 + ((kk & 7) * 32 + (c & 31)) * 2; }
__device__ __forceinline__ int v_rd_base(int lane) { return ((lane & 3) << 3) | (((lane >> 2) & 3) << 6) | (((lane >> 4) & 1) << 5) | (((lane >> 5) & 1) << 8); }
constexpr int v_rd_off(int d0, int ks, int half) { return d0 * 512 + ks * 4096 + half * 2048; }
template <int OFF> __device__ __forceinline__ s16x4 tr_read(int vb) { s16x4 r; asm volatile("ds_read_b64_tr_b16 %0, %1 offset:%2" : "=&v"(r) : "v"(vb), "i"(OFF) : "memory"); return r; }
template <int D0> __device__ __forceinline__ void pv_one(f32x16& od, int vb, bf16x8 pa0, bf16x8 pa1, bf16x8 pa2, bf16x8 pa3) {
    const s16x4 l0 = tr_read<v_rd_off(D0, 0, 0)>(vb), h0 = tr_read<v_rd_off(D0, 0, 1)>(vb), l1 = tr_read<v_rd_off(D0, 1, 0)>(vb), h1 = tr_read<v_rd_off(D0, 1, 1)>(vb);
    const s16x4 l2 = tr_read<v_rd_off(D0, 2, 0)>(vb), h2 = tr_read<v_rd_off(D0, 2, 1)>(vb), l3 = tr_read<v_rd_off(D0, 3, 0)>(vb), h3 = tr_read<v_rd_off(D0, 3, 1)>(vb);
    asm volatile("s_waitcnt lgkmcnt(0)" ::: "memory"); SBAR();
#define PK(L, H) (bf16x8){L[0], L[1], L[2], L[3], H[0], H[1], H[2], H[3]}
    od = __builtin_amdgcn_mfma_f32_32x32x16_bf16(pa0, PK(l0, h0), od, 0, 0, 0);
    od = __builtin_amdgcn_mfma_f32_32x32x16_bf16(pa1, PK(l1, h1), od, 0, 0, 0);
    od = __builtin_amdgcn_mfma_f32_32x32x16_bf16(pa2, PK(l2, h2), od, 0, 0, 0);
    od = __builtin_amdgcn_mfma_f32_32x32x16_bf16(pa3, PK(l3, h3), od, 0, 0, 0);
#undef PK
}
__device__ __forceinline__ void pv_all(f32x16* o, int vb, bf16x8 pa0, bf16x8 pa1, bf16x8 pa2, bf16x8 pa3) {
    pv_one<0>(o[0], vb, pa0, pa1, pa2, pa3); pv_one<1>(o[1], vb, pa0, pa1, pa2, pa3); pv_one<2>(o[2], vb, pa0, pa1, pa2, pa3); pv_one<3>(o[3], vb, pa0, pa1, pa2, pa3);
}
}
namespace att {
constexpr int M2_KSLOT = KN_BYTES + KR_BYTES;
constexpr int M2_OFF_K = 0, M2_OFF_V = 3 * M2_KSLOT;
constexpr int M2_OFF_WS = M2_OFF_V + 3 * V_BYTES;
constexpr int M2_LDS_BYTES = M2_OFF_WS + 8 * 64 * 4;
typedef __attribute__((address_space(3))) unsigned char* lds_ptr;

}
namespace att {
constexpr int M3_NT = 65;
__device__ __forceinline__ void softmax_seg(f32x16& p0, f32x16& p1, float& m_reg, float& l_reg, float& alpha, bf16x8& pa0, bf16x8& pa1, bf16x8& pa2, bf16x8& pa3) {
    float pmax = p0[0];
#pragma unroll
    for (int r = 1; r < 16; ++r) pmax = fmaxf(pmax, p0[r]);
#pragma unroll
    for (int r = 0; r < 16; ++r) pmax = fmaxf(pmax, p1[r]);
    { auto rr = __builtin_amdgcn_permlane32_swap(__float_as_uint(pmax), __float_as_uint(pmax), false, false); pmax = fmaxf(__uint_as_float(rr[0]), __uint_as_float(rr[1])); }
    if (__builtin_expect(__all(pmax - m_reg <= THR2), 1)) { alpha = 1.f; }
    else { const float mn = fmaxf(m_reg, pmax); alpha = __builtin_amdgcn_exp2f(m_reg - mn); m_reg = mn; }
    const float mn = m_reg; float ps = 0.f;
#pragma unroll
    for (int r = 0; r < 16; ++r) { p0[r] = __builtin_amdgcn_exp2f(p0[r] - mn); ps += p0[r]; }
#pragma unroll
    for (int r = 0; r < 16; ++r) { p1[r] = __builtin_amdgcn_exp2f(p1[r] - mn); ps += p1[r]; }
    { auto rr = __builtin_amdgcn_permlane32_swap(__float_as_uint(ps), __float_as_uint(ps), false, false); ps = __uint_as_float(rr[0]) + __uint_as_float(rr[1]); }
    l_reg = l_reg * alpha + ps;
#define PK4(P, BASE, OUT) do { unsigned a0 = cvtpk(P[BASE + 0], P[BASE + 1]), a1 = cvtpk(P[BASE + 2], P[BASE + 3]);   \
    unsigned b0 = cvtpk(P[BASE + 4], P[BASE + 5]), b1 = cvtpk(P[BASE + 6], P[BASE + 7]);                              \
    auto r0 = __builtin_amdgcn_permlane32_swap(a0, b0, false, false); auto r1 = __builtin_amdgcn_permlane32_swap(a1, b1, false, false); \
    u32x4 w = {r0[0], r1[0], r0[1], r1[1]}; OUT = *reinterpret_cast<bf16x8*>(&w); } while (0)
    PK4(p0, 0, pa0); PK4(p0, 8, pa1); PK4(p1, 0, pa2); PK4(p1, 8, pa3);
#undef PK4
}

}
namespace att {
constexpr int S2_OFF_K = 0, S2_OFF_V = 3 * KN_BYTES, S2_OFF_TW = S2_OFF_V + 3 * V_BYTES;
constexpr int S2_OFF_TM = S2_OFF_TW + 4 * 512 * 4, S2_OFF_WS = S2_OFF_TM + 4 * 256 * 4, S2_LDS_BYTES = S2_OFF_WS + 8 * 64 * 4;
__device__ __forceinline__ void swa_unit2(lds_ptr lds, const bf16* __restrict__ QB, const bf16* __restrict__ KB, const bf16* __restrict__ VB, bf16* __restrict__ OAB,
                                          const float* __restrict__ tw_g, const float* __restrict__ tm_g, const float* __restrict__ sink_l2, int b, int hk, int j, int& tables_hk, const int tid_in) {
    int tid_ = tid_in; asm volatile("" : "+v"(tid_)); const int tid = tid_, lane = tid & 63, r32 = lane & 31, hi = lane >> 5; const int wid = __builtin_amdgcn_readfirstlane(tid >> 6);
    const bool metaq = (j == 64);
    const int hq = 4 * hk + (wid >> 1);
    const bool wave_on = !metaq || (wid & 1) == 0;
    const int qpos = metaq ? (r32 & 15) : (NMETA + 64 * j + 32 * (wid & 1) + r32);
    const int qrow = metaq ? (TREAL + 16 * b + (r32 & 15)) : (b * SEQ + 64 * j + 32 * (wid & 1) + r32);
    __attribute__((address_space(3))) float* wsf = (__attribute__((address_space(3))) float*)(lds + S2_OFF_WS) + wid * 64;
    int nt, kt_lo = 0;
    if (metaq) nt = 3; else { kt_lo = j - 2 < 0 ? 0 : j - 2; const int kt_hi = j + 2 > 63 ? 63 : j + 2; nt = 1 + (kt_hi - kt_lo + 1); }
#define S2_KPOS0(t) (metaq ? 64 * (t) : ((t) == 0 ? 0 : NMETA + 64 * (kt_lo + (t) - 1)))
#define S2_ROW(kp) ({ int kp_ = (kp) > LPOS - 1 ? LPOS - 1 : (kp); (kp_ < NMETA ? TREAL + 16 * b + kp_ : b * SEQ + kp_ - NMETA); })
    int kk_k[2], kk_v[2]; unsigned co_k[2], co_v[2];
#pragma unroll
    for (int i = 0; i < 2; ++i) { const int P = 2 * wid + i;
        { const int row = 4 * P + (lane >> 4), c = (lane & 15) ^ (row & 15); kk_k[i] = row; co_k[i] = (unsigned)(c * 16); }
        { const int q = 64 * P + lane, s = q >> 5, kk = (s >> 2) * 8 + ((q & 31) >> 2), col = (s & 3) * 32 + (q & 3) * 8, k = (kk & ~0xC) | ((kk & 4) << 1) | ((kk & 8) >> 1); kk_v[i] = k; co_v[i] = (unsigned)(col * 2); } }
    const char* const kb_h = (const char*)KB + hk * 256; const char* const vb_h = (const char*)VB + hk * 256;
#define S2_DMA(src, dstoff) __builtin_amdgcn_global_load_lds((const unsigned*)(src), (__attribute__((address_space(3))) unsigned*)(lds + (dstoff)), 16, 0, 0)
#define S2_DMA_TILE(t, slot) do { const int kp0_ = S2_KPOS0(t); \
        _Pragma("unroll") for (int i_ = 0; i_ < 2; ++i_) { S2_DMA(kb_h + (size_t)S2_ROW(kp0_ + kk_k[i_]) * 1024 + co_k[i_], S2_OFF_K + (slot) * KN_BYTES + (2 * wid + i_) * 1024); \
                                                          S2_DMA(vb_h + (size_t)S2_ROW(kp0_ + kk_v[i_]) * 1024 + co_v[i_], S2_OFF_V + (slot) * V_BYTES + (2 * wid + i_) * 1024); } } while (0)
#define S2_BAR() do { asm volatile("s_waitcnt lgkmcnt(0)" ::: "memory"); __builtin_amdgcn_s_barrier(); asm volatile("" ::: "memory"); } while (0)
    S2_DMA_TILE(0, 0); S2_DMA_TILE(1, 1); S2_DMA_TILE(2, 2);
    bf16x8 qr[8];
    { const bf16* qp = QB + (size_t)qrow * 2048 + hq * 128 + hi * 8;
#pragma unroll
      for (int d0 = 0; d0 < 8; ++d0) qr[d0] = *reinterpret_cast<const bf16x8*>(qp + d0 * 16); }
    if (tables_hk != hk) {
        __attribute__((address_space(3))) float* tw = (__attribute__((address_space(3))) float*)(lds + S2_OFF_TW); __attribute__((address_space(3))) float* tm = (__attribute__((address_space(3))) float*)(lds + S2_OFF_TM);
        for (int i = tid; i < 4 * 512; i += 512) tw[i] = tw_g[(4 * hk) * 512 + i];
        for (int i = tid; i < 4 * 256; i += 512) tm[i] = tm_g[(4 * hk) * 256 + i];
        tables_hk = hk;
    }
    const int xkn = (r32 & 15) << 4, hb = hi * 16;
    const int vlane = v_rd_base(lane);
    const float sink = sink_l2[hq];
    float m_reg = sink, l_reg = 1.f; f32x16 o[4];
#pragma unroll
    for (int d = 0; d < 4; ++d) o[d] = f32x16{};
    f32x16 p0, p1; bf16x8 pa0, pa1, pa2, pa3;
#define S2_KLD(d, A0, A1) do { const int of_ = (((d) * 32 + hb) ^ xn_); A0 = *(const __attribute__((address_space(3))) bf16x8*)(kb_ + of_); A1 = *(const __attribute__((address_space(3))) bf16x8*)(kb_ + of_ + 8192); } while (0)
#define S2_KMM(d, A0, A1) do { p0 = __builtin_amdgcn_mfma_f32_32x32x16_bf16(A0, qr[d], p0, 0, 0, 0); p1 = __builtin_amdgcn_mfma_f32_32x32x16_bf16(A1, qr[d], p1, 0, 0, 0); } while (0)
    int slot = 0;
    for (int t = 0; t < nt; ++t) {
        { const int ahead = (nt < t + 3 ? nt : t + 3) - t - 1;
          if (ahead >= 2) asm volatile("s_waitcnt vmcnt(8)" ::: "memory"); else if (ahead == 1) asm volatile("s_waitcnt vmcnt(4)" ::: "memory"); else asm volatile("s_waitcnt vmcnt(0)" ::: "memory"); }
        S2_BAR();
        if (wave_on) {
            const int kpos0 = S2_KPOS0(t);
            __builtin_amdgcn_s_setprio(3);
            { int xn_ = xkn; asm volatile("" : "+v"(xn_)); const lds_ptr kb_ = lds + S2_OFF_K + slot * KN_BYTES + r32 * 256; p0 = f32x16{}; p1 = f32x16{};
              bf16x8 k0a, k0b, k1a, k1b, k2a, k2b, k3a, k3b;
              S2_KLD(0, k0a, k0b); S2_KLD(1, k1a, k1b); S2_KLD(2, k2a, k2b); S2_KLD(3, k3a, k3b); SBAR();
              S2_KMM(0, k0a, k0b); S2_KLD(4, k0a, k0b); SBAR(); S2_KMM(1, k1a, k1b); S2_KLD(5, k1a, k1b); SBAR(); S2_KMM(2, k2a, k2b); S2_KLD(6, k2a, k2b); SBAR(); S2_KMM(3, k3a, k3b); S2_KLD(7, k3a, k3b); SBAR();
              S2_KMM(4, k0a, k0b); SBAR(); S2_KMM(5, k1a, k1b); SBAR(); S2_KMM(6, k2a, k2b); SBAR(); S2_KMM(7, k3a, k3b); }
            __builtin_amdgcn_s_setprio(0);
            if (!metaq && t == 0) {
                int base = 4 * hi - qpos; base = base < -256 ? -256 : base;
                const __attribute__((address_space(3))) float* tb = (const __attribute__((address_space(3))) float*)(lds + S2_OFF_TM) + (wid >> 1) * 256 + base + 256;
#pragma unroll
                for (int r = 0; r < 16; ++r) { if (r < 8) p0[r] += tb[(r & 3) + 8 * (r >> 2)]; else p0[r] = NEG_BIG; p1[r] = NEG_BIG; }
            } else {
                const int base = kpos0 + 4 * hi - qpos;
                const __attribute__((address_space(3))) float* tb = (const __attribute__((address_space(3))) float*)(lds + S2_OFF_TW) + (wid >> 1) * 512 + base + 256;
#pragma unroll
                for (int r = 0; r < 16; ++r) { p0[r] += tb[(r & 3) + 8 * (r >> 2)]; p1[r] += tb[(r & 3) + 8 * (r >> 2) + 32]; }
                if (kpos0 + 64 > LPOS) {
#pragma unroll
                    for (int r = 0; r < 16; ++r) { if (kpos0 + crow(r, hi) >= LPOS) p0[r] = NEG_BIG; if (kpos0 + 32 + crow(r, hi) >= LPOS) p1[r] = NEG_BIG; } }
            }
            float alpha; softmax_seg(p0, p1, m_reg, l_reg, alpha, pa0, pa1, pa2, pa3);
            if (__any(alpha < 1.f)) { if (hi == 0) wsf[r32] = alpha; asm volatile("s_waitcnt lgkmcnt(0)" ::: "memory");
#pragma unroll
                for (int d = 0; d < 4; ++d)
#pragma unroll
                    for (int r = 0; r < 16; ++r) o[d][r] *= wsf[crow(r, hi)]; }
            __builtin_amdgcn_s_setprio(3); pv_all(o, (int)(uintptr_t)(lds + S2_OFF_V + slot * V_BYTES) + vlane, pa0, pa1, pa2, pa3); __builtin_amdgcn_s_setprio(0);
        }
        if (t + 3 < nt) { S2_BAR(); S2_DMA_TILE(t + 3, slot); }
        slot = slot == 2 ? 0 : slot + 1;
    }
    if (wave_on) {
        if (hi == 0) wsf[32 + r32] = l_reg; asm volatile("s_waitcnt lgkmcnt(0)" ::: "memory");
        const int orow0 = metaq ? (TREAL + 16 * b) : (b * SEQ + 64 * j + 32 * (wid & 1));
#pragma unroll
        for (int r = 0; r < 16; ++r) { const int rw = crow(r, hi); const float rl = __builtin_amdgcn_rcpf(wsf[32 + rw]);
            if (!metaq || rw < 16) { bf16* op = OAB + (size_t)(orow0 + rw) * 4096 + 2048 + hq * 128 + r32;
#pragma unroll
                for (int d0 = 0; d0 < 4; ++d0) op[d0 * 32] = (bf16)(cvtpk(o[d0][r] * rl, 0.f) & 0xffffu); } }
    }
    asm volatile("s_waitcnt vmcnt(0)" ::: "memory"); S2_BAR();
#undef S2_KPOS0
#undef S2_ROW
#undef S2_DMA
#undef S2_DMA_TILE
#undef S2_BAR
#undef S2_KLD
#undef S2_KMM
}
}
namespace att {
template <int OFF> __device__ __forceinline__ bf16x8 lds_rd128(int addr) { bf16x8 r; asm volatile("ds_read_b128 %0, %1 offset:%2" : "=&v"(r) : "v"(addr), "i"(OFF) : "memory"); return r; }
#define M4_XFULL(KS, VS) do { \
    int xn_ = xkn, xr_ = xkr; asm volatile("" : "+v"(xn_), "+v"(xr_)); \
    const int kbn_ = (int)(uintptr_t)(lds + M2_OFF_K + (KS) * M2_KSLOT) + r32 * 256, kbr_ = (int)(uintptr_t)(lds + M2_OFF_K + (KS) * M2_KSLOT + KN_BYTES) + r32 * 128; \
    const int vb_ = (int)(uintptr_t)(lds + M2_OFF_V + (VS) * V_BYTES) + vlane; (void)vb_; \
    bf16x8 ka0, ka1, ka2, ka3, ka4, kb0, kb1, kb2, kb3, kb4; s16x4 vl0, vl1, vl2, vl3, vl4, vh0, vh1, vh2, vh3, vh4; \
    p0 = f32x16{}; p1 = f32x16{}; \
    { const int a_ = kbn_ + (((0) * 32 + hb) ^ xn_); ka0 = lds_rd128<0>(a_); kb0 = lds_rd128<8192>(a_); } \
    { const int a_ = kbn_ + (((1) * 32 + hb) ^ xn_); ka1 = lds_rd128<0>(a_); kb1 = lds_rd128<8192>(a_); } \
    { const int a_ = kbn_ + (((2) * 32 + hb) ^ xn_); ka2 = lds_rd128<0>(a_); kb2 = lds_rd128<8192>(a_); } \
    { const int a_ = kbn_ + (((3) * 32 + hb) ^ xn_); ka3 = lds_rd128<0>(a_); kb3 = lds_rd128<8192>(a_); } \
    { const int a_ = kbn_ + (((4) * 32 + hb) ^ xn_); ka4 = lds_rd128<0>(a_); kb4 = lds_rd128<8192>(a_); } \
    asm volatile("s_waitcnt lgkmcnt(8)" ::: "memory"); SBAR(); p0 = __builtin_amdgcn_mfma_f32_32x32x16_bf16(ka0, qr[0], p0, 0, 0, 0); p1 = __builtin_amdgcn_mfma_f32_32x32x16_bf16(kb0, qr[0], p1, 0, 0, 0); SBAR(); \
    { const int a_ = kbn_ + (((5) * 32 + hb) ^ xn_); ka0 = lds_rd128<0>(a_); kb0 = lds_rd128<8192>(a_); } \
    asm volatile("s_waitcnt lgkmcnt(8)" ::: "memory"); SBAR(); p0 = __builtin_amdgcn_mfma_f32_32x32x16_bf16(ka1, qr[1], p0, 0, 0, 0); p1 = __builtin_amdgcn_mfma_f32_32x32x16_bf16(kb1, qr[1], p1, 0, 0, 0); SBAR(); \
    { const int a_ = kbn_ + (((6) * 32 + hb) ^ xn_); ka1 = lds_rd128<0>(a_); kb1 = lds_rd128<8192>(a_); } \
    asm volatile("s_waitcnt lgkmcnt(8)" ::: "memory"); SBAR(); p0 = __builtin_amdgcn_mfma_f32_32x32x16_bf16(ka2, qr[2], p0, 0, 0, 0); p1 = __builtin_amdgcn_mfma_f32_32x32x16_bf16(kb2, qr[2], p1, 0, 0, 0); SBAR(); \
    { const int a_ = kbn_ + (((7) * 32 + hb) ^ xn_); ka2 = lds_rd128<0>(a_); kb2 = lds_rd128<8192>(a_); } \
    asm volatile("s_waitcnt lgkmcnt(8)" ::: "memory"); SBAR(); p0 = __builtin_amdgcn_mfma_f32_32x32x16_bf16(ka3, qr[3], p0, 0, 0, 0); p1 = __builtin_amdgcn_mfma_f32_32x32x16_bf16(kb3, qr[3], p1, 0, 0, 0); SBAR(); \
    { const int a_ = kbr_ + (((0) * 32 + hb) ^ xr_); ka3 = lds_rd128<0>(a_); kb3 = lds_rd128<4096>(a_); } \
    asm volatile("s_waitcnt lgkmcnt(8)" ::: "memory"); SBAR(); p0 = __builtin_amdgcn_mfma_f32_32x32x16_bf16(ka4, qr[4], p0, 0, 0, 0); p1 = __builtin_amdgcn_mfma_f32_32x32x16_bf16(kb4, qr[4], p1, 0, 0, 0); SBAR(); \
    { const int a_ = kbr_ + (((1) * 32 + hb) ^ xr_); ka4 = lds_rd128<0>(a_); kb4 = lds_rd128<4096>(a_); } \
    asm volatile("s_waitcnt lgkmcnt(8)" ::: "memory"); SBAR(); p0 = __builtin_amdgcn_mfma_f32_32x32x16_bf16(ka0, qr[5], p0, 0, 0, 0); p1 = __builtin_amdgcn_mfma_f32_32x32x16_bf16(kb0, qr[5], p1, 0, 0, 0); SBAR(); \
    { const int a_ = kbr_ + (((2) * 32 + hb) ^ xr_); ka0 = lds_rd128<0>(a_); kb0 = lds_rd128<4096>(a_); } \
    asm volatile("s_waitcnt lgkmcnt(8)" ::: "memory"); SBAR(); p0 = __builtin_amdgcn_mfma_f32_32x32x16_bf16(ka1, qr[6], p0, 0, 0, 0); p1 = __builtin_amdgcn_mfma_f32_32x32x16_bf16(kb1, qr[6], p1, 0, 0, 0); SBAR(); \
    { const int a_ = kbr_ + (((3) * 32 + hb) ^ xr_); ka1 = lds_rd128<0>(a_); kb1 = lds_rd128<4096>(a_); } \
    asm volatile("s_waitcnt lgkmcnt(8)" ::: "memory"); SBAR(); p0 = __builtin_amdgcn_mfma_f32_32x32x16_bf16(ka2, qr[7], p0, 0, 0, 0); p1 = __builtin_amdgcn_mfma_f32_32x32x16_bf16(kb2, qr[7], p1, 0, 0, 0); SBAR(); \
    { vl2 = tr_read<v_rd_off(0, 0, 0)>(vb_); vh2 = tr_read<v_rd_off(0, 0, 1)>(vb_); } \
    asm volatile("s_waitcnt lgkmcnt(8)" ::: "memory"); SBAR(); p0 = __builtin_amdgcn_mfma_f32_32x32x16_bf16(ka3, qr[8], p0, 0, 0, 0); p1 = __builtin_amdgcn_mfma_f32_32x32x16_bf16(kb3, qr[8], p1, 0, 0, 0); SBAR(); \
    { vl3 = tr_read<v_rd_off(0, 1, 0)>(vb_); vh3 = tr_read<v_rd_off(0, 1, 1)>(vb_); } \
    asm volatile("s_waitcnt lgkmcnt(8)" ::: "memory"); SBAR(); p0 = __builtin_amdgcn_mfma_f32_32x32x16_bf16(ka4, qr[9], p0, 0, 0, 0); p1 = __builtin_amdgcn_mfma_f32_32x32x16_bf16(kb4, qr[9], p1, 0, 0, 0); SBAR(); \
    { vl4 = tr_read<v_rd_off(0, 2, 0)>(vb_); vh4 = tr_read<v_rd_off(0, 2, 1)>(vb_); } \
    asm volatile("s_waitcnt lgkmcnt(8)" ::: "memory"); SBAR(); p0 = __builtin_amdgcn_mfma_f32_32x32x16_bf16(ka0, qr[10], p0, 0, 0, 0); p1 = __builtin_amdgcn_mfma_f32_32x32x16_bf16(kb0, qr[10], p1, 0, 0, 0); SBAR(); \
    { vl0 = tr_read<v_rd_off(0, 3, 0)>(vb_); vh0 = tr_read<v_rd_off(0, 3, 1)>(vb_); } \
    asm volatile("s_waitcnt lgkmcnt(8)" ::: "memory"); SBAR(); p0 = __builtin_amdgcn_mfma_f32_32x32x16_bf16(ka1, qr[11], p0, 0, 0, 0); p1 = __builtin_amdgcn_mfma_f32_32x32x16_bf16(kb1, qr[11], p1, 0, 0, 0); SBAR(); \
    { vl1 = tr_read<v_rd_off(1, 0, 0)>(vb_); vh1 = tr_read<v_rd_off(1, 0, 1)>(vb_); } \
    asm volatile("s_waitcnt lgkmcnt(8)" ::: "memory"); SBAR(); o[0] = __builtin_amdgcn_mfma_f32_32x32x16_bf16(pa0, (bf16x8){vl2[0], vl2[1], vl2[2], vl2[3], vh2[0], vh2[1], vh2[2], vh2[3]}, o[0], 0, 0, 0); SBAR(); \
    { vl2 = tr_read<v_rd_off(1, 1, 0)>(vb_); vh2 = tr_read<v_rd_off(1, 1, 1)>(vb_); } \
    asm volatile("s_waitcnt lgkmcnt(8)" ::: "memory"); SBAR(); o[0] = __builtin_amdgcn_mfma_f32_32x32x16_bf16(pa1, (bf16x8){vl3[0], vl3[1], vl3[2], vl3[3], vh3[0], vh3[1], vh3[2], vh3[3]}, o[0], 0, 0, 0); SBAR(); \
    { vl3 = tr_read<v_rd_off(1, 2, 0)>(vb_); vh3 = tr_read<v_rd_off(1, 2, 1)>(vb_); } \
    asm volatile("s_waitcnt lgkmcnt(8)" ::: "memory"); SBAR(); o[0] = __builtin_amdgcn_mfma_f32_32x32x16_bf16(pa2, (bf16x8){vl4[0], vl4[1], vl4[2], vl4[3], vh4[0], vh4[1], vh4[2], vh4[3]}, o[0], 0, 0, 0); SBAR(); \
    { vl4 = tr_read<v_rd_off(1, 3, 0)>(vb_); vh4 = tr_read<v_rd_off(1, 3, 1)>(vb_); } \
    asm volatile("s_waitcnt lgkmcnt(8)" ::: "memory"); SBAR(); o[0] = __builtin_amdgcn_mfma_f32_32x32x16_bf16(pa3, (bf16x8){vl0[0], vl0[1], vl0[2], vl0[3], vh0[0], vh0[1], vh0[2], vh0[3]}, o[0], 0, 0, 0); SBAR(); \
    { vl0 = tr_read<v_rd_off(2, 0, 0)>(vb_); vh0 = tr_read<v_rd_off(2, 0, 1)>(vb_); } \
    asm volatile("s_waitcnt lgkmcnt(8)" ::: "memory"); SBAR(); o[1] = __builtin_amdgcn_mfma_f32_32x32x16_bf16(pa0, (bf16x8){vl1[0], vl1[1], vl1[2], vl1[3], vh1[0], vh1[1], vh1[2], vh1[3]}, o[1], 0, 0, 0); SBAR(); \
    { vl1 = tr_read<v_rd_off(2, 1, 0)>(vb_); vh1 = tr_read<v_rd_off(2, 1, 1)>(vb_); } \
    asm volatile("s_waitcnt lgkmcnt(8)" ::: "memory"); SBAR(); o[1] = __builtin_amdgcn_mfma_f32_32x32x16_bf16(pa1, (bf16x8){vl2[0], vl2[1], vl2[2], vl2[3], vh2[0], vh2[1], vh2[2], vh2[3]}, o[1], 0, 0, 0); SBAR(); \
    { vl2 = tr_read<v_rd_off(2, 2, 0)>(vb_); vh2 = tr_read<v_rd_off(2, 2, 1)>(vb_); } \
    asm volatile("s_waitcnt lgkmcnt(8)" ::: "memory"); SBAR(); o[1] = __builtin_amdgcn_mfma_f32_32x32x16_bf16(pa2, (bf16x8){vl3[0], vl3[1], vl3[2], vl3[3], vh3[0], vh3[1], vh3[2], vh3[3]}, o[1], 0, 0, 0); SBAR(); \
    { vl3 = tr_read<v_rd_off(2, 3, 0)>(vb_); vh3 = tr_read<v_rd_off(2, 3, 1)>(vb_); } \
    asm volatile("s_waitcnt lgkmcnt(8)" ::: "memory"); SBAR(); o[1] = __builtin_amdgcn_mfma_f32_32x32x16_bf16(pa3, (bf16x8){vl4[0], vl4[1], vl4[2], vl4[3], vh4[0], vh4[1], vh4[2], vh4[3]}, o[1], 0, 0, 0); SBAR(); \
    { vl4 = tr_read<v_rd_off(3, 0, 0)>(vb_); vh4 = tr_read<v_rd_off(3, 0, 1)>(vb_); } \
    asm volatile("s_waitcnt lgkmcnt(8)" ::: "memory"); SBAR(); o[2] = __builtin_amdgcn_mfma_f32_32x32x16_bf16(pa0, (bf16x8){vl0[0], vl0[1], vl0[2], vl0[3], vh0[0], vh0[1], vh0[2], vh0[3]}, o[2], 0, 0, 0); SBAR(); \
    { vl0 = tr_read<v_rd_off(3, 1, 0)>(vb_); vh0 = tr_read<v_rd_off(3, 1, 1)>(vb_); } \
    asm volatile("s_waitcnt lgkmcnt(8)" ::: "memory"); SBAR(); o[2] = __builtin_amdgcn_mfma_f32_32x32x16_bf16(pa1, (bf16x8){vl1[0], vl1[1], vl1[2], vl1[3], vh1[0], vh1[1], vh1[2], vh1[3]}, o[2], 0, 0, 0); SBAR(); \
    { vl1 = tr_read<v_rd_off(3, 2, 0)>(vb_); vh1 = tr_read<v_rd_off(3, 2, 1)>(vb_); } \
    asm volatile("s_waitcnt lgkmcnt(8)" ::: "memory"); SBAR(); o[2] = __builtin_amdgcn_mfma_f32_32x32x16_bf16(pa2, (bf16x8){vl2[0], vl2[1], vl2[2], vl2[3], vh2[0], vh2[1], vh2[2], vh2[3]}, o[2], 0, 0, 0); SBAR(); \
    { vl2 = tr_read<v_rd_off(3, 3, 0)>(vb_); vh2 = tr_read<v_rd_off(3, 3, 1)>(vb_); } \
    asm volatile("s_waitcnt lgkmcnt(8)" ::: "memory"); SBAR(); o[2] = __builtin_amdgcn_mfma_f32_32x32x16_bf16(pa3, (bf16x8){vl3[0], vl3[1], vl3[2], vl3[3], vh3[0], vh3[1], vh3[2], vh3[3]}, o[2], 0, 0, 0); SBAR(); \
    asm volatile("s_waitcnt lgkmcnt(6)" ::: "memory"); SBAR(); o[3] = __builtin_amdgcn_mfma_f32_32x32x16_bf16(pa0, (bf16x8){vl4[0], vl4[1], vl4[2], vl4[3], vh4[0], vh4[1], vh4[2], vh4[3]}, o[3], 0, 0, 0); SBAR(); \
    asm volatile("s_waitcnt lgkmcnt(4)" ::: "memory"); SBAR(); o[3] = __builtin_amdgcn_mfma_f32_32x32x16_bf16(pa1, (bf16x8){vl0[0], vl0[1], vl0[2], vl0[3], vh0[0], vh0[1], vh0[2], vh0[3]}, o[3], 0, 0, 0); SBAR(); \
    asm volatile("s_waitcnt lgkmcnt(2)" ::: "memory"); SBAR(); o[3] = __builtin_amdgcn_mfma_f32_32x32x16_bf16(pa2, (bf16x8){vl1[0], vl1[1], vl1[2], vl1[3], vh1[0], vh1[1], vh1[2], vh1[3]}, o[3], 0, 0, 0); SBAR(); \
    asm volatile("s_waitcnt lgkmcnt(0)" ::: "memory"); SBAR(); o[3] = __builtin_amdgcn_mfma_f32_32x32x16_bf16(pa3, (bf16x8){vl2[0], vl2[1], vl2[2], vl2[3], vh2[0], vh2[1], vh2[2], vh2[3]}, o[3], 0, 0, 0); SBAR(); \
} while (0)
#define M4_XFIRST(KS, VS) do { \
    int xn_ = xkn, xr_ = xkr; asm volatile("" : "+v"(xn_), "+v"(xr_)); \
    const int kbn_ = (int)(uintptr_t)(lds + M2_OFF_K + (KS) * M2_KSLOT) + r32 * 256, kbr_ = (int)(uintptr_t)(lds + M2_OFF_K + (KS) * M2_KSLOT + KN_BYTES) + r32 * 128; \
    const int vb_ = (int)(uintptr_t)(lds + M2_OFF_V + (VS) * V_BYTES) + vlane; (void)vb_; \
    bf16x8 ka0, ka1, ka2, ka3, ka4, kb0, kb1, kb2, kb3, kb4; s16x4 vl0, vl1, vl2, vl3, vl4, vh0, vh1, vh2, vh3, vh4; \
    p0 = f32x16{}; p1 = f32x16{}; \
    { const int a_ = kbn_ + (((0) * 32 + hb) ^ xn_); ka0 = lds_rd128<0>(a_); kb0 = lds_rd128<8192>(a_); } \
    { const int a_ = kbn_ + (((1) * 32 + hb) ^ xn_); ka1 = lds_rd128<0>(a_); kb1 = lds_rd128<8192>(a_); } \
    { const int a_ = kbn_ + (((2) * 32 + hb) ^ xn_); ka2 = lds_rd128<0>(a_); kb2 = lds_rd128<8192>(a_); } \
    { const int a_ = kbn_ + (((3) * 32 + hb) ^ xn_); ka3 = lds_rd128<0>(a_); kb3 = lds_rd128<8192>(a_); } \
    { const int a_ = kbn_ + (((4) * 32 + hb) ^ xn_); ka4 = lds_rd128<0>(a_); kb4 = lds_rd128<8192>(a_); } \
    asm volatile("s_waitcnt lgkmcnt(8)" ::: "memory"); SBAR(); p0 = __builtin_amdgcn_mfma_f32_32x32x16_bf16(ka0, qr[0], p0, 0, 0, 0); p1 = __builtin_amdgcn_mfma_f32_32x32x16_bf16(kb0, qr[0], p1, 0, 0, 0); SBAR(); \
    { const int a_ = kbn_ + (((5) * 32 + hb) ^ xn_); ka0 = lds_rd128<0>(a_); kb0 = lds_rd128<8192>(a_); } \
    asm volatile("s_waitcnt lgkmcnt(8)" ::: "memory"); SBAR(); p0 = __builtin_amdgcn_mfma_f32_32x32x16_bf16(ka1, qr[1], p0, 0, 0, 0); p1 = __builtin_amdgcn_mfma_f32_32x32x16_bf16(kb1, qr[1], p1, 0, 0, 0); SBAR(); \
    { const int a_ = kbn_ + (((6) * 32 + hb) ^ xn_); ka1 = lds_rd128<0>(a_); kb1 = lds_rd128<8192>(a_); } \
    asm volatile("s_waitcnt lgkmcnt(8)" ::: "memory"); SBAR(); p0 = __builtin_amdgcn_mfma_f32_32x32x16_bf16(ka2, qr[2], p0, 0, 0, 0); p1 = __builtin_amdgcn_mfma_f32_32x32x16_bf16(kb2, qr[2], p1, 0, 0, 0); SBAR(); \
    { const int a_ = kbn_ + (((7) * 32 + hb) ^ xn_); ka2 = lds_rd128<0>(a_); kb2 = lds_rd128<8192>(a_); } \
    asm volatile("s_waitcnt lgkmcnt(8)" ::: "memory"); SBAR(); p0 = __builtin_amdgcn_mfma_f32_32x32x16_bf16(ka3, qr[3], p0, 0, 0, 0); p1 = __builtin_amdgcn_mfma_f32_32x32x16_bf16(kb3, qr[3], p1, 0, 0, 0); SBAR(); \
    { const int a_ = kbr_ + (((0) * 32 + hb) ^ xr_); ka3 = lds_rd128<0>(a_); kb3 = lds_rd128<4096>(a_); } \
    asm volatile("s_waitcnt lgkmcnt(8)" ::: "memory"); SBAR(); p0 = __builtin_amdgcn_mfma_f32_32x32x16_bf16(ka4, qr[4], p0, 0, 0, 0); p1 = __builtin_amdgcn_mfma_f32_32x32x16_bf16(kb4, qr[4], p1, 0, 0, 0); SBAR(); \
    { const int a_ = kbr_ + (((1) * 32 + hb) ^ xr_); ka4 = lds_rd128<0>(a_); kb4 = lds_rd128<4096>(a_); } \
    asm volatile("s_waitcnt lgkmcnt(8)" ::: "memory"); SBAR(); p0 = __builtin_amdgcn_mfma_f32_32x32x16_bf16(ka0, qr[5], p0, 0, 0, 0); p1 = __builtin_amdgcn_mfma_f32_32x32x16_bf16(kb0, qr[5], p1, 0, 0, 0); SBAR(); \
    { const int a_ = kbr_ + (((2) * 32 + hb) ^ xr_); ka0 = lds_rd128<0>(a_); kb0 = lds_rd128<4096>(a_); } \
    asm volatile("s_waitcnt lgkmcnt(8)" ::: "memory"); SBAR(); p0 = __builtin_amdgcn_mfma_f32_32x32x16_bf16(ka1, qr[6], p0, 0, 0, 0); p1 = __builtin_amdgcn_mfma_f32_32x32x16_bf16(kb1, qr[6], p1, 0, 0, 0); SBAR(); \
    { const int a_ = kbr_ + (((3) * 32 + hb) ^ xr_); ka1 = lds_rd128<0>(a_); kb1 = lds_rd128<4096>(a_); } \
    asm volatile("s_waitcnt lgkmcnt(8)" ::: "memory"); SBAR(); p0 = __builtin_amdgcn_mfma_f32_32x32x16_bf16(ka2, qr[7], p0, 0, 0, 0); p1 = __builtin_amdgcn_mfma_f32_32x32x16_bf16(kb2, qr[7], p1, 0, 0, 0); SBAR(); \
    asm volatile("s_waitcnt lgkmcnt(6)" ::: "memory"); SBAR(); p0 = __builtin_amdgcn_mfma_f32_32x32x16_bf16(ka3, qr[8], p0, 0, 0, 0); p1 = __builtin_amdgcn_mfma_f32_32x32x16_bf16(kb3, qr[8], p1, 0, 0, 0); SBAR(); \
    asm volatile("s_waitcnt lgkmcnt(4)" ::: "memory"); SBAR(); p0 = __builtin_amdgcn_mfma_f32_32x32x16_bf16(ka4, qr[9], p0, 0, 0, 0); p1 = __builtin_amdgcn_mfma_f32_32x32x16_bf16(kb4, qr[9], p1, 0, 0, 0); SBAR(); \
    asm volatile("s_waitcnt lgkmcnt(2)" ::: "memory"); SBAR(); p0 = __builtin_amdgcn_mfma_f32_32x32x16_bf16(ka0, qr[10], p0, 0, 0, 0); p1 = __builtin_amdgcn_mfma_f32_32x32x16_bf16(kb0, qr[10], p1, 0, 0, 0); SBAR(); \
    asm volatile("s_waitcnt lgkmcnt(0)" ::: "memory"); SBAR(); p0 = __builtin_amdgcn_mfma_f32_32x32x16_bf16(ka1, qr[11], p0, 0, 0, 0); p1 = __builtin_amdgcn_mfma_f32_32x32x16_bf16(kb1, qr[11], p1, 0, 0, 0); SBAR(); \
} while (0)

__device__ __forceinline__ void mla_unit4(lds_ptr lds, const bf16* __restrict__ Q, const bf16* __restrict__ KN, const bf16* __restrict__ KR, const bf16* __restrict__ V, bf16* __restrict__ OAB, int b, int h, int qb, const int tid_in) {
    int tid_ = tid_in; asm volatile("" : "+v"(tid_)); const int tid = tid_, lane = tid & 63, r32 = lane & 31, hi = lane >> 5; const int wid = __builtin_amdgcn_readfirstlane(tid >> 6);
    const bool metaq = (qb == 16);
    const bool wave_on = !metaq || wid == 0;
    const int qrow = metaq ? (TREAL + 16 * b + (r32 & 15)) : (b * SEQ + qb * 256 + wid * 32 + r32);
    __attribute__((address_space(3))) float* wsf = (__attribute__((address_space(3))) float*)(lds + M2_OFF_WS) + wid * 64;
    unsigned so_kn[2], so_kr, so_v[2];
#pragma unroll
    for (int i = 0; i < 2; ++i) { const int P = 2 * wid + i;
        { const int row = 4 * P + (lane >> 4), c = (lane & 15) ^ (row & 15); so_kn[i] = (unsigned)(row * 4096 + c * 16); }
        { const int q = 64 * P + lane, s = q >> 5, kk = (s >> 2) * 8 + ((q & 31) >> 2), col = (s & 3) * 32 + (q & 3) * 8, k = (kk & ~0xC) | ((kk & 4) << 1) | ((kk & 8) >> 1); so_v[i] = (unsigned)(k * 4096 + col * 2); } }
    { const int row = 8 * wid + (lane >> 3), c = (lane & 7) ^ ((row >> 1) & 7); so_kr = (unsigned)(row * 128 + c * 16); }
    const char* const kn_h = (const char*)KN + h * 256; const char* const v_h = (const char*)V + h * 256; const char* const kr_b = (const char*)KR;
    const size_t real0 = (size_t)b * SEQ, meta0 = (size_t)TREAL + 16 * b;
#define M3_ROW(t) ((t) == 0 ? meta0 : real0 + (size_t)((t) - 1) * 64)
#define M3_DMA(src, dstoff) __builtin_amdgcn_global_load_lds((const unsigned*)(src), (__attribute__((address_space(3))) unsigned*)(lds + (dstoff)), 16, 0, 0)
#define M3_DMA_K(t, slot) do { const size_t g_ = M3_ROW(t); const int so_ = M2_OFF_K + (slot) * M2_KSLOT; \
        M3_DMA(kn_h + g_ * 4096 + so_kn[0], so_ + (2 * wid) * 1024); M3_DMA(kn_h + g_ * 4096 + so_kn[1], so_ + (2 * wid + 1) * 1024); M3_DMA(kr_b + g_ * 128 + so_kr, so_ + KN_BYTES + wid * 1024); } while (0)
#define M3_DMA_V(t, slot) do { const size_t g_ = M3_ROW(t); const int so_ = M2_OFF_V + (slot) * V_BYTES; \
        M3_DMA(v_h + g_ * 4096 + so_v[0], so_ + (2 * wid) * 1024); M3_DMA(v_h + g_ * 4096 + so_v[1], so_ + (2 * wid + 1) * 1024); } while (0)
#define M3_WAIT(n) asm volatile("s_waitcnt vmcnt(" #n ")" ::: "memory")
#define M3_BAR() do { asm volatile("" ::: "memory"); __builtin_amdgcn_s_barrier(); asm volatile("" ::: "memory"); } while (0)
#define M3_EVENT(i, s3) do { if ((i) + 2 < M3_NT) M3_DMA_K((i) + 2, (s3) == 0 ? 2 : (s3) - 1); if ((i) + 1 < M3_NT) M3_DMA_V((i) + 1, (s3) == 2 ? 0 : (s3) + 1); } while (0)
#define M3_WAITI(i) do { if ((i) < M3_NT - 2) M3_WAIT(5); else M3_WAIT(0); } while (0)
    M3_DMA_K(0, 0); M3_DMA_V(0, 0); M3_DMA_K(1, 1);
    bf16x8 qr[12];
    { const bf16* qp = Q + (size_t)qrow * 3072 + h * 192 + hi * 8;
#pragma unroll
      for (int d0 = 0; d0 < 12; ++d0) qr[d0] = *reinterpret_cast<const bf16x8*>(qp + d0 * 16); }
    const int xkn = (r32 & 15) << 4, xkr = ((r32 >> 1) & 7) << 4, hb = hi * 16;
    const int vlane = v_rd_base(lane);
#define M3_PV(slot) pv_all(o, (int)(uintptr_t)(lds + M2_OFF_V + (slot) * V_BYTES) + vlane, pa0, pa1, pa2, pa3)
#define M3_Y(j) do { if (wave_on) { if ((j) == 0) { _Pragma("unroll") for (int r = 0; r < 16; ++r) { if (crow(r, hi) >= 16) p0[r] = NEG_BIG; p1[r] = NEG_BIG; } } \
        float alpha_; softmax_seg(p0, p1, m_reg, l_reg, alpha_, pa0, pa1, pa2, pa3); \
        if (__any(alpha_ < 1.f)) { if (hi == 0) wsf[r32] = alpha_; asm volatile("s_waitcnt lgkmcnt(0)" ::: "memory"); \
            _Pragma("unroll") for (int d = 0; d < 4; ++d) _Pragma("unroll") for (int r = 0; r < 16; ++r) o[d][r] *= wsf[crow(r, hi)]; } } } while (0)
    float m_reg = NEG_BIG, l_reg = 0.f; f32x16 o[4];
#pragma unroll
    for (int d = 0; d < 4; ++d) o[d] = f32x16{};
    f32x16 p0, p1; bf16x8 pa0, pa1, pa2, pa3;
    int s3 = 0;
    if (wid < 4) {
        M3_WAITI(0); M3_BAR();
        if (wave_on) M4_XFIRST(0, 0);
        M3_BAR(); M3_EVENT(0, 0);
        M3_Y(0);
        s3 = 1;
        for (int j = 1; j < M3_NT; ++j) {
            M3_WAITI(j); M3_BAR();
            if (wave_on) { __builtin_amdgcn_s_setprio(3); M4_XFULL(s3, (s3 == 0 ? 2 : s3 - 1)); __builtin_amdgcn_s_setprio(0); }
            M3_BAR(); M3_EVENT(j, s3);
            M3_Y(j);
            s3 = s3 == 2 ? 0 : s3 + 1;
        }
        M3_BAR();
        if (wave_on) M3_PV(s3 == 0 ? 2 : s3 - 1);
        M3_BAR();
    } else {
        M3_WAITI(0); M3_BAR(); M3_EVENT(0, 0);
        M3_BAR();
        if (wave_on) M4_XFIRST(0, 0);
        M3_WAITI(1); M3_BAR(); M3_EVENT(1, 1);
        M3_Y(0);
        s3 = 1;
        for (int j = 1; j < M3_NT; ++j) {
            M3_BAR();
            if (wave_on) { __builtin_amdgcn_s_setprio(3); M4_XFULL(s3, (s3 == 0 ? 2 : s3 - 1)); __builtin_amdgcn_s_setprio(0); }
            M3_WAITI(j + 1); M3_BAR(); { const int s3n = s3 == 2 ? 0 : s3 + 1; M3_EVENT(j + 1, s3n); }
            M3_Y(j);
            s3 = s3 == 2 ? 0 : s3 + 1;
        }
        M3_BAR();
        if (wave_on) M3_PV(s3 == 0 ? 2 : s3 - 1);
    }
    if (wave_on) {
        if (hi == 0) wsf[32 + r32] = l_reg; asm volatile("s_waitcnt lgkmcnt(0)" ::: "memory");
        const int orow0 = metaq ? (TREAL + 16 * b) : (b * SEQ + qb * 256 + wid * 32);
#pragma unroll
        for (int r = 0; r < 16; ++r) { const int rw = crow(r, hi); const float rl = __builtin_amdgcn_rcpf(wsf[32 + rw]);
            if (!metaq || rw < 16) { bf16* op = OAB + (size_t)(orow0 + rw) * 4096 + h * 128 + r32;
#pragma unroll
                for (int d0 = 0; d0 < 4; ++d0) op[d0 * 32] = (bf16)(cvtpk(o[d0][r] * rl, 0.f) & 0xffffu); } }
    }
    M3_WAIT(0); M3_BAR();
#undef M3_ROW
#undef M3_DMA
#undef M3_DMA_K
#undef M3_DMA_V
#undef M3_WAIT
#undef M3_BAR
#undef M3_EVENT
#undef M3_WAITI
#undef M3_PV
#undef M3_Y
}
#undef M4_XFULL
#undef M4_XFIRST
}
constexpr int NWAVES = 8;
constexpr int N_PHASES = 20;
constexpr size_t MiB = 1u << 20, KiB32 = 32768;
constexpr size_t WS_CTL = 0, CTL_ZERO_BYTES = 65536;
constexpr size_t WS_CS = 1 * MiB, WS_SN = WS_CS + 540672;
constexpr size_t WS_BIAS = 3 * MiB;
constexpr size_t WS_TW = WS_BIAS, WS_TM = WS_BIAS + 32768, WS_SINK = WS_BIAS + 49152;
constexpr size_t WS_WHIST = WS_BIAS + 65536;
constexpr size_t WS_TOPI = 4 * MiB, WS_TOPG = WS_TOPI + 262144, WS_TOKSLOT = WS_TOPG + 262144;
constexpr size_t WS_SLOTTOK = 5 * MiB, WS_SLOTGATE = WS_SLOTTOK + 294912;
constexpr size_t WS_SSQ = 6 * MiB;
constexpr size_t WS_HB = 9 * MiB;
constexpr size_t WS_W = 138 * MiB;
constexpr size_t WL_IN = 0, WL_UQ = 34 * MiB, WL_UKV = WL_UQ + 9 * MiB / 2, WL_AB = WL_UKV + 4 * MiB, WL_OUT = WL_AB + 16 * MiB, WL_STRIDE = WL_OUT + 8 * MiB;
constexpr size_t WS_WF13 = WS_W + 2 * WL_STRIDE, WS_WF2 = WS_WF13 + 44 * MiB, WS_WEND = WS_WF2 + 22 * MiB;
constexpr size_t AR = 337 * MiB;
constexpr size_t WS_CQ = AR, WS_CKV = WS_CQ + 1548 * KiB32, WS_KR = WS_CKV + 1032 * KiB32, WS_QB = WS_KR + 132 * KiB32;
constexpr size_t WS_KB = WS_QB + 129 * MiB, WS_VB = WS_KB + 1032 * KiB32, WS_GR = WS_VB + 1032 * KiB32, WS_GBB = WS_GR + 129 * MiB;
constexpr size_t WS_Q = WS_GBB + 129 * MiB, WS_KN = WS_Q + 6192 * KiB32  , WS_V = WS_KN + 129 * MiB, WS_OAB = WS_V + 129 * MiB, WS_MIX_END = WS_OAB + 258 * MiB;
constexpr size_t WS_MG = WS_Q;
constexpr size_t WS_X = WS_OAB;
constexpr size_t WS_ACT = AR;
constexpr size_t WS_MW13 = 138 * MiB, WS_MW2 = WS_MW13 + 8 * 44 * MiB;
constexpr size_t WS_MACT = WS_MW2 + 8 * 22 * MiB;
constexpr size_t WS_Y = WS_MACT + 726 * MiB;
constexpr size_t WS_END = WS_Y + 264 * MiB;
static_assert(WS_MIX_END <= 1700 * MiB && WS_END <= 1700 * MiB, "d_ws map");
static_assert(WS_ACT + (size_t)TP * DFF * 2 <= WS_X, "dense ACT vs X");
static_assert(WS_SSQ + (size_t)TP * 20 * 4 <= WS_HB && WS_SLOTGATE + 294912 <= WS_SSQ && WS_TOKSLOT + 262144 <= WS_SLOTTOK && WS_SN + 540672 <= WS_BIAS, "small tables");
static_assert(WS_KR + (size_t)TP * 64 * 2 <= WS_QB, "KR");
constexpr int CW_TMO = 0, CW_CODE = 1;
constexpr int CW_MOE_TS = 64;
constexpr int CW_BAR = 4096;
constexpr int RING_OFF = 0, RING_BYTES = 131072;
constexpr int LDSCTL_OFF = RING_BYTES, MISC_OFF = LDSCTL_OFF + 320, PT_OFF = LDSCTL_OFF + 512;
constexpr int LDS_BYTES = 147456;
static_assert(att::ATT_LDS_BYTES <= RING_BYTES && att::M2_LDS_BYTES <= RING_BYTES && att::S2_LDS_BYTES <= RING_BYTES, "attention LDS");

#define GAS __attribute__((address_space(1)))
#define LAS __attribute__((address_space(3)))
typedef unsigned short bf16;
typedef unsigned v4u __attribute__((ext_vector_type(4)));
typedef unsigned v2u __attribute__((ext_vector_type(2)));
typedef float f32x4 __attribute__((ext_vector_type(4)));
typedef GAS unsigned gu32;
#define RLX_AGENT __ATOMIC_RELAXED, __HIP_MEMORY_SCOPE_AGENT
#define LDS_WAIT() asm volatile("s_waitcnt lgkmcnt(0)" ::: "memory")
#define VM_WAIT() asm volatile("s_waitcnt vmcnt(0)" ::: "memory")
__device__ __forceinline__ unsigned f2bf(float f) { unsigned u = __builtin_bit_cast(unsigned, f); return (u + 0x7fffu + ((u >> 16) & 1u)) >> 16; }
__device__ __forceinline__ unsigned pk2(float lo, float hi) { return f2bf(lo) | (f2bf(hi) << 16); }

#define XB_TMO      128
#define XB_XCNT(j)  (256  + 64 * (j))
#define XB_XSUB(j)  (1280 + 64 * (j))
#define XB_XGEN(j)  (2304 + 64 * (j))
#define XB_TOP      3328
#define XB_TOPGEN   3392
#define XCD_BAR_WORDS 3456
#define XB_SPIN_CAP (1u << 22)
__device__ __forceinline__ unsigned xb_ld(unsigned* p)              { return __hip_atomic_load(p, __ATOMIC_RELAXED, __HIP_MEMORY_SCOPE_AGENT); }
__device__ __forceinline__ unsigned xb_add(unsigned* p, unsigned v) { return __hip_atomic_fetch_add(p, v, __ATOMIC_RELAXED, __HIP_MEMORY_SCOPE_AGENT); }
__device__ __forceinline__ unsigned xb_xcc_id() { return (unsigned)__builtin_amdgcn_s_getreg((3 << 11) | 20) & 0xFu; }
#define XB_SPIN(cond, bar) do { unsigned _sp = 0; while (cond) { __builtin_amdgcn_s_sleep(1); \
    if ((++_sp & 255u) == 0u) { if (xb_ld(&(bar)[XB_TMO])) break; if (_sp > XB_SPIN_CAP) { atomicAdd(&(bar)[XB_TMO], 1u); break; } } } } while (0)
struct XcdBarrier { unsigned* bar; unsigned x; volatile LAS unsigned* st; };
__device__ __forceinline__ XcdBarrier xcd_barrier_post(unsigned* bar, volatile LAS unsigned* st, const int tid) {
    XcdBarrier b; b.bar = bar; b.x = xb_xcc_id(); b.st = st;
    if (tid == 0) (void)xb_add(&bar[XB_XCNT(b.x)], 1u);
    return b;
}
__device__ __forceinline__ void xcd_barrier_complete(unsigned* bar, unsigned x, unsigned& nloc, unsigned& nx) {
    const unsigned G = gridDim.x * gridDim.y * gridDim.z;
    unsigned sum, cnt, mine, sp = 0u;
    for (;;) {
        sum = 0u; cnt = 0u; mine = 0u;
#pragma unroll
        for (unsigned j = 0; j < 16; ++j) { const unsigned c = xb_ld(&bar[XB_XCNT(j)]); sum += c; cnt += (c > 0u) ? 1u : 0u; mine = (j == x) ? c : mine; }
        if (sum == G) break;
        __builtin_amdgcn_s_sleep(1);
        if ((++sp & 255u) == 0u) { if (xb_ld(&bar[XB_TMO])) break; if (sp > XB_SPIN_CAP) { atomicAdd(&bar[XB_TMO], 1u); break; } }
    }
    nloc = mine > 0u ? mine : 1u; nx = cnt > 0u ? cnt : 1u;
}
__device__ __forceinline__ void xcd_barrier(const XcdBarrier& b, const int tid) {
    asm volatile("s_waitcnt vmcnt(0)" ::: "memory");
    __syncthreads();
    if (tid == 0) {
        unsigned* bar = b.bar;
        __builtin_amdgcn_s_waitcnt(0);
        unsigned nloc = b.st[0], nx = b.st[1];
        if (nloc == 0u) { xcd_barrier_complete(bar, b.x, nloc, nx); b.st[0] = nloc; b.st[1] = nx; }
        const unsigned old = xb_add(&bar[XB_XSUB(b.x)], 1u);
        const unsigned gen = old / nloc;
        if (old + 1u == (gen + 1u) * nloc) {
            __builtin_amdgcn_fence(__ATOMIC_RELEASE, "agent");
            asm volatile("s_waitcnt vmcnt(0)" ::: "memory");
            const unsigned og = xb_add(&bar[XB_TOP], 1u);
            const unsigned tg = og / nx;
            if (og + 1u == (tg + 1u) * nx) xb_add(&bar[XB_TOPGEN], 1u);
            else XB_SPIN(xb_ld(&bar[XB_TOPGEN]) == tg, bar);
            __builtin_amdgcn_fence(__ATOMIC_ACQUIRE, "agent");
            xb_add(&bar[XB_XGEN(b.x)], 1u);
            asm volatile("s_waitcnt vmcnt(0)" ::: "memory");
        } else {
            XB_SPIN(xb_ld(&bar[XB_XGEN(b.x)]) == gen, bar);
            __builtin_amdgcn_fence(__ATOMIC_ACQUIRE, "agent");
            asm volatile("s_waitcnt vmcnt(0)" ::: "memory");
        }
    }
    __syncthreads();
}

__device__ __forceinline__ int lane_id() { int l; asm volatile("v_mbcnt_lo_u32_b32 %0, -1, 0\n\tv_mbcnt_hi_u32_b32 %0, -1, %0" : "=v"(l)); return l; }
__device__ __forceinline__ float wave_sum(float v) {
#pragma unroll
    for (int o = 1; o < 64; o <<= 1) v += __shfl_xor(v, o);
    return v;
}
__device__ __forceinline__ void transpose_item(const float* __restrict__ W, int ldw, int k0, int n0, bf16* __restrict__ WT, size_t ldt, int drow, int koff, const float* __restrict__ g, LAS float* scr, int lane) {
    const int kr = lane >> 3, c4 = (lane & 7) * 4;
    f32x4 v[8];
#pragma unroll
    for (int i = 0; i < 8; ++i) v[i] = *(const GAS f32x4*)(W + (size_t)(k0 + 8 * i + kr) * ldw + n0 + c4);
    if (g) {
#pragma unroll
        for (int i = 0; i < 8; ++i) v[i] = v[i] * g[k0 + 8 * i + kr]; }
#pragma unroll
    for (int i = 0; i < 8; ++i) { LAS float* d = scr + (8 * i + kr) * 33 + c4; d[0] = v[i].x; d[1] = v[i].y; d[2] = v[i].z; d[3] = v[i].w; }
    LDS_WAIT(); asm volatile("" ::: "memory");
    const int c = lane & 7;
#pragma unroll
    for (int j = 0; j < 4; ++j) { const int n = (lane >> 3) + 8 * j; const LAS float* s = scr + (8 * c) * 33 + n;
        v4u o; o.x = pk2(s[0 * 33], s[1 * 33]); o.y = pk2(s[2 * 33], s[3 * 33]); o.z = pk2(s[4 * 33], s[5 * 33]); o.w = pk2(s[6 * 33], s[7 * 33]);
        *(GAS v4u*)(WT + (size_t)(drow + n) * ldt + koff + k0 + 8 * c) = o; }
    LDS_WAIT(); asm volatile("" ::: "memory");
}
struct TDesc { const float* W; bf16* WT; size_t ldt; int ldw, k0, n0, drow; };
__device__ __forceinline__ void t_load(const TDesc& d, f32x4 (&v)[8], int lane) {
    const int kr = lane >> 3, c4 = (lane & 7) * 4;
#pragma unroll
    for (int i = 0; i < 8; ++i) v[i] = *(const GAS f32x4*)(d.W + (size_t)(d.k0 + 8 * i + kr) * d.ldw + d.n0 + c4);
}
__device__ __forceinline__ void t_finish(const TDesc& d, const f32x4 (&v)[8], LAS float* scr, int lane) {
    const int kr = lane >> 3, c4 = (lane & 7) * 4;
#pragma unroll
    for (int i = 0; i < 8; ++i) { LAS float* p = scr + (8 * i + kr) * 33 + c4; p[0] = v[i].x; p[1] = v[i].y; p[2] = v[i].z; p[3] = v[i].w; }
    LDS_WAIT(); asm volatile("" ::: "memory");
    const int c = lane & 7;
#pragma unroll
    for (int j = 0; j < 4; ++j) { const int n = (lane >> 3) + 8 * j; const LAS float* s = scr + (8 * c) * 33 + n;
        v4u o; o.x = pk2(s[0 * 33], s[1 * 33]); o.y = pk2(s[2 * 33], s[3 * 33]); o.z = pk2(s[4 * 33], s[5 * 33]); o.w = pk2(s[6 * 33], s[7 * 33]);
        *(GAS v4u*)(d.WT + (size_t)(d.drow + n) * d.ldt + d.k0 + 8 * c) = o; }
    LDS_WAIT(); asm volatile("" ::: "memory");
}
__device__ __forceinline__ int dmap_in(int n0) {
    if (n0 < 1280) return n0;
    if (n0 < 1312) return 1280;
    if (n0 < 1344) return 1280 + 128;
    if (n0 < 3392) return 1536 + (n0 - 1344);
    if (n0 < 3904) return 3584 + (n0 - 3392);
    if (n0 < 4416) return 4096 + (n0 - 3904);
    if (n0 < 6464) { const int a = n0 - 4416; return 4608 + 256 * (a >> 7) + (a & 127); }
    const int a = n0 - 6464; return 4608 + 256 * (a >> 7) + 128 + (a & 127);
}
__device__ __forceinline__ int dmap_uq(int n0) {
    const int head = n0 / 192, off = n0 - head * 192;
    if (off < 128) return 256 * (head >> 1) + 128 * (head & 1) + off;
    if (off < 160) return 256 * (8 + (head >> 2)) + 32 * (head & 3);
    return 256 * (8 + (head >> 2)) + 128 + 32 * (head & 3);
}
__device__ __forceinline__ int dmap_glu(int n0) { return 256 * (n0 >> 7) + (n0 & 127); }
struct Row8 { f32x4 v[8]; };
__device__ __forceinline__ void ln_normalize(Row8& r) {
    float s = 0.f;
#pragma unroll
    for (int j = 0; j < 8; ++j) s += (r.v[j].x + r.v[j].y) + (r.v[j].z + r.v[j].w);
    const float mean = wave_sum(s) * (1.f / D); float s2 = 0.f;
#pragma unroll
    for (int j = 0; j < 8; ++j) { r.v[j] = r.v[j] - mean; s2 += (r.v[j].x * r.v[j].x + r.v[j].y * r.v[j].y) + (r.v[j].z * r.v[j].z + r.v[j].w * r.v[j].w); }
    const float rstd = 1.f / sqrtf(wave_sum(s2) * (1.f / D) + LN_EPS);
#pragma unroll
    for (int j = 0; j < 8; ++j) r.v[j] = r.v[j] * rstd;
}
__device__ __forceinline__ void ln_affine(Row8& r, const float* __restrict__ g, const float* __restrict__ b, int lane) {
#pragma unroll
    for (int j = 0; j < 8; ++j) { const f32x4 gg = *((const f32x4*)g + lane + 64 * j), bb = *((const f32x4*)b + lane + 64 * j); r.v[j] = r.v[j] * gg + bb; }
}
__device__ __forceinline__ void row_store_bf16(const Row8& r, bf16* orow, int lane) {
    GAS v2u* o8 = (GAS v2u*)orow + lane;
#pragma unroll
    for (int j = 0; j < 8; ++j) { v2u w; w.x = pk2(r.v[j].x, r.v[j].y); w.y = pk2(r.v[j].z, r.v[j].w); o8[64 * j] = w; }
}
__device__ __forceinline__ void row_load_f32(Row8& r, const float* xrow, int lane) {
#pragma unroll
    for (int j = 0; j < 8; ++j) r.v[j] = *((const GAS f32x4*)xrow + lane + 64 * j);
}
__device__ __forceinline__ f32x4 bf4(v2u w);
__device__ __forceinline__ void row_load_bf16(Row8& r, const bf16* xrow, int lane) {
#pragma unroll
    for (int j = 0; j < 8; ++j) r.v[j] = bf4(*((const GAS v2u*)xrow + lane + 64 * j));
}
__device__ __forceinline__ f32x4 bf4(v2u w) { return (f32x4){__uint_as_float(w.x << 16), __uint_as_float(w.x & 0xffff0000u), __uint_as_float(w.y << 16), __uint_as_float(w.y & 0xffff0000u)}; }
__device__ __forceinline__ int t5_bucket(int rel) {
    const int n = rel < 0 ? -rel : rel; int v;
    if (n < 8) v = n; else if (n < 12) v = 8; else if (n < 16) v = 9; else if (n < 23) v = 10; else if (n < 32) v = 11; else if (n < 46) v = 12; else if (n < 64) v = 13; else if (n < 91) v = 14; else v = 15;
    return (rel > 0 ? 16 : 0) + v;
}

__device__ __forceinline__ void router_row(const Row8& r, const LAS f32x4* rwl, const float* __restrict__ rbias, int lane, int& i0, int& i1, float& g0, float& g1) {
    float lg[8];
#pragma unroll
    for (int e = 0; e < 8; ++e) lg[e] = 0.f;
#pragma unroll
    for (int j = 0; j < 8; ++j) {
#pragma unroll
        for (int q = 0; q < 4; ++q) { const f32x4 w0 = rwl[(j * 4 + q) * 64 + lane], w1 = rwl[2048 + (j * 4 + q) * 64 + lane]; const float y = r.v[j][q];
            lg[0] += y * w0.x; lg[1] += y * w0.y; lg[2] += y * w0.z; lg[3] += y * w0.w; lg[4] += y * w1.x; lg[5] += y * w1.y; lg[6] += y * w1.z; lg[7] += y * w1.w; } }
#pragma unroll
    for (int e = 0; e < 8; ++e) lg[e] = wave_sum(lg[e]) + rbias[e];
    i0 = 0; float v0 = lg[0];
#pragma unroll
    for (int e = 1; e < 8; ++e) if (lg[e] > v0) { v0 = lg[e]; i0 = e; }
    i1 = -1; float v1 = -3.0e38f;
#pragma unroll
    for (int e = 0; e < 8; ++e) if (e != i0 && lg[e] > v1) { v1 = lg[e]; i1 = e; }
    const float e1 = __expf(v1 - v0); g0 = 1.f / (1.f + e1); g1 = e1 / (1.f + e1);
}
enum { I_X = 0, I_META, I_EMB_G, I_EMB_B, I_RELB, I_WIN, I_QNG, I_KVNG, I_WUQ, I_WUKV, I_SINK, I_WPA, I_WPB, I_WOUT, I_LMG, I_LMB, I_LFG, I_LFB,
       I_FW1, I_FW3, I_FW2, I_RW, I_RB, I_MW1, I_MW3, I_MW2, N_IN };
struct Args { const float* in[N_IN]; float* out; unsigned char* ws; int ph_lo, ph_hi; };

__global__ void __launch_bounds__(NWAVES * 64, 2) mk_fwd(Args args) {
    extern __shared__ __attribute__((aligned(16))) unsigned char lds_raw[];
    LAS unsigned char* const lds = (LAS unsigned char*)lds_raw;
    char* const ldsg = (char*)lds_raw;
    volatile LAS unsigned* const MISC = (volatile LAS unsigned*)(lds + MISC_OFF);
    const int wave = __builtin_amdgcn_readfirstlane((int)threadIdx.x >> 6);
    const int tid = wave * 64 + lane_id();
    const int G_k = gridDim.x; const int bx_k = blockIdx.x;
    for (int u = tid; u < (LDS_BYTES - LDSCTL_OFF) / 4; u += NWAVES * 64) ((LAS unsigned*)(lds + LDSCTL_OFF))[u] = 0u;
    __syncthreads();
    volatile LAS unsigned long long* const PT = (volatile LAS unsigned long long*)(lds + PT_OFF);
    if (tid == 0) {
#pragma unroll
        for (int i = 0; i < N_IN; ++i) PT[i] = (unsigned long long)args.in[i];
        PT[N_IN] = (unsigned long long)args.out; PT[N_IN + 1] = (unsigned long long)args.ws; }
    const int lo = args.ph_lo, hi = args.ph_hi;
    __syncthreads();
#define LDP(i) ({ const unsigned long long v_ = PT[i]; (unsigned long long)(unsigned)__builtin_amdgcn_readfirstlane((int)(unsigned)v_) | ((unsigned long long)(unsigned)__builtin_amdgcn_readfirstlane((int)(unsigned)(v_ >> 32)) << 32); })
#define INP(i) ((const float*)(const GAS float*)LDP(i))
#define WSP() ((unsigned char*)(GAS unsigned char*)LDP(N_IN + 1))
#define OUTP() ((float*)(GAS float*)LDP(N_IN))
#define PH_WS() int* SLOT_TOK; float* SLOT_GATE; int* TOK_SLOT; asm volatile("" ::: "memory"); int tid = wave * 64 + lane_id(); asm volatile("" : "+v"(tid)); const int lane = tid & 63; (void)lane; \
    int G = G_k, bx = bx_k; asm volatile("" : "+s"(G), "+s"(bx));     \
    const int vcu = (G % 8 == 0) ? (bx % 8) * (G / 8) + bx / 8 : bx; const int gw = vcu * NWAVES + wave, NGW = G * NWAVES; (void)gw; (void)NGW; (void)vcu; unsigned char* const ws = WSP(); \
    bf16* const HB = (bf16*)(ws + WS_HB); float* const CS = (float*)(ws + WS_CS); float* const SN = (float*)(ws + WS_SN); float* const SSQ = (float*)(ws + WS_SSQ); bf16* const X = (bf16*)(ws + WS_X); \
    SLOT_TOK = (int*)(ws + WS_SLOTTOK); SLOT_GATE = (float*)(ws + WS_SLOTGATE); TOK_SLOT = (int*)(ws + WS_TOKSLOT); (void)HB; (void)CS; (void)SN; (void)SSQ; (void)X; (void)SLOT_TOK; (void)SLOT_GATE; (void)TOK_SLOT
    XcdBarrier bar; { unsigned char* const ws0 = WSP(); bar.bar = (unsigned*)(ws0 + WS_CTL) + CW_BAR; bar.x = 0; bar.st = nullptr;
    if (hi - lo > 1) bar = xcd_barrier_post((unsigned*)(ws0 + WS_CTL) + CW_BAR, MISC + 8, tid); }
#define IN(k) (lo <= (k) && (k) < hi)
#define SEAM(k) do { if (IN(k) && IN((k) + 1)) xcd_barrier(bar, wave * 64 + lane_id()); } while (0)

    if (IN(0)) { PH_WS();
        LAS float* scr = (LAS float*)(lds + RING_OFF + wave * 16384);
        constexpr int I_IN = (D / 64) * (INDIM / 32), I_UQ = (QRANK / 64) * (3072 / 32), I_UKV = (KVRANK / 64) * (4096 / 32), I_SQ = (D / 64) * (D / 32), I_LAYER = I_IN + I_UQ + I_UKV + 3 * I_SQ;
        constexpr int I_F = (D / 64) * (DFF / 32), I_F2 = (DFF / 64) * (D / 32), NITEMS = 2 * I_LAYER + 2 * I_F + I_F2;
        for (int it = gw; it < NITEMS; it += NGW) {
            int r = it;
            if (r < 2 * I_LAYER) { const int l = r / I_LAYER; r -= l * I_LAYER; unsigned char* wl = ws + WS_W + l * WL_STRIDE;
                if (r < I_IN) { const int nblk = INDIM / 32, kb = r / nblk, nb = r % nblk; transpose_item(INP(I_WIN) + (size_t)l * D * INDIM, INDIM, 64 * kb, 32 * nb, (bf16*)(ws + WS_W + l * WL_STRIDE + WL_IN), D, dmap_in(32 * nb), 0, nullptr, scr, lane); continue; } r -= I_IN;
                if (r < I_UQ) { const int nblk = 3072 / 32, kb = r / nblk, nb = r % nblk; transpose_item(INP(I_WUQ) + (size_t)l * QRANK * 3072, 3072, 64 * kb, 32 * nb, (bf16*)(ws + WS_W + l * WL_STRIDE + WL_UQ), QRANK, dmap_uq(32 * nb), 0, INP(I_QNG) + l * QRANK, scr, lane); continue; } r -= I_UQ;
                if (r < I_UKV) { const int nblk = 4096 / 32, kb = r / nblk, nb = r % nblk; transpose_item(INP(I_WUKV) + (size_t)l * KVRANK * 4096, 4096, 64 * kb, 32 * nb, (bf16*)(ws + WS_W + l * WL_STRIDE + WL_UKV), KVRANK, 32 * nb, 0, INP(I_KVNG) + l * KVRANK, scr, lane); continue; } r -= I_UKV;
                { const int which = r / I_SQ; r -= which * I_SQ; const int nblk = D / 32, kb = r / nblk, nb = r % nblk;
                  if (which == 0) transpose_item(INP(I_WPA) + (size_t)l * D * D, D, 64 * kb, 32 * nb, (bf16*)(ws + WS_W + l * WL_STRIDE + WL_AB), 2 * D, 32 * nb, 0, nullptr, scr, lane);
                  else if (which == 1) transpose_item(INP(I_WPB) + (size_t)l * D * D, D, 64 * kb, 32 * nb, (bf16*)(ws + WS_W + l * WL_STRIDE + WL_AB), 2 * D, 32 * nb, D, nullptr, scr, lane);
                  else transpose_item(INP(I_WOUT) + (size_t)l * D * D, D, 64 * kb, 32 * nb, (bf16*)(ws + WS_W + l * WL_STRIDE + WL_OUT), D, 32 * nb, 0, nullptr, scr, lane);
                  continue; }
            }
            r -= 2 * I_LAYER;
            if (r < 2 * I_F) { const int which = r / I_F; r -= which * I_F; const int nblk = DFF / 32, kb = r / nblk, nb = r % nblk;
                transpose_item(INP(which ? I_FW3 : I_FW1), DFF, 64 * kb, 32 * nb, (bf16*)(ws + WS_WF13), D, dmap_glu(32 * nb) + (which ? 128 : 0), 0, nullptr, scr, lane); continue; }
            r -= 2 * I_F;
            { const int nblk = D / 32, kb = r / nblk, nb = r % nblk; transpose_item(INP(I_FW2), D, 64 * kb, 32 * nb, (bf16*)(ws + WS_WF2), DFF, 32 * nb, 0, nullptr, scr, lane); }
        }
        for (int i = gw * 64 + lane; i < 2 * 192 * 256; i += NGW * 64) { const int l = i / (192 * 256), q = i % (192 * 256), rr = q / 256, c16 = q % 256; const int row = rr < 96 ? 1312 + rr : 1440 + (rr - 96);
            *(GAS v4u*)(ws + WS_W + l * WL_STRIDE + WL_IN + (size_t)row * (D * 2) + c16 * 16) = (v4u){0u, 0u, 0u, 0u}; }
        for (int i = gw * 64 + lane; i < LPOS * 32; i += NGW * 64) { const int pos = i >> 5, k = i & 31; const float inv = powf(10000.f, -(float)(2 * k) / 64.f); const float ang = (float)pos * inv; CS[i] = cosf(ang); SN[i] = sinf(ang); }
        for (int i = gw * 64 + lane; i < 16 * 512; i += NGW * 64) { const int hh = i >> 9, rel = (i & 511) - 256; const float bv = INP(I_RELB)[t5_bucket(rel) * 16 + hh] * LOG2E;
            ((float*)(ws + WS_TW))[i] = (rel >= -128 && rel <= 128) ? bv : att::NEG_BIG; if (rel < 0) ((float*)(ws + WS_TM))[hh * 256 + rel + 256] = bv; }
        if (gw == 0 && lane < 32) ((float*)(ws + WS_SINK))[lane] = INP(I_SINK)[lane] * LOG2E;
        { const float* eg = INP(I_EMB_G); const float* eb = INP(I_EMB_B); const float* xin = INP(I_X); const float* min_ = INP(I_META);
#define P0_LOAD(R, m) row_load_f32(R, (m) < TREAL ? xin + (size_t)(m) * D : min_ + (size_t)(((m) - TREAL) & 15) * D, lane)
#define P0_PROC(R, m) do { ln_normalize(R); ln_affine(R, eg, eb, lane); row_store_bf16(R, HB + (size_t)(m) * D, lane); } while (0)
          Row8 ra{}, rb{}; int m = gw; if (m < T) P0_LOAD(ra, m);
          for (; m < T; m += 2 * NGW) { const int m1 = m + NGW, m2 = m + 2 * NGW; if (m1 < T) P0_LOAD(rb, m1); P0_PROC(ra, m); if (m1 < T) { if (m2 < T) P0_LOAD(ra, m2); P0_PROC(rb, m1); } }
#undef P0_LOAD
#undef P0_PROC
          for (int mz = T + gw; mz < TP; mz += NGW) { GAS v2u* o8 = (GAS v2u*)(HB + (size_t)mz * D) + lane;
#pragma unroll
              for (int j = 0; j < 8; ++j) o8[64 * j] = (v2u){0u, 0u}; } }
    }
    SEAM(0);

#pragma unroll 1
    for (int l = 0; l < 2; ++l) {
        const int P = 1 + 9 * l + (l ? 0 : 0);
        const int nM_all = TREAL / 256;
        const int nM_post = TREAL / 256; const bool tail_post = (l == 0);
        if (IN(P + 0)) { PH_WS();
            ProbDense pr; pr.so.init(nM_all, NIN / 256, G, bx, true); pr.A = (const char*)HB; pr.Bt = (const char*)(ws + WS_W + l * WL_STRIDE + WL_IN); pr.tstep = 256 * (size_t)D * 2;
            epi::EpiWin E{(bf16*)(ws + WS_CQ), (bf16*)(ws + WS_CKV), (bf16*)(ws + WS_KR), (bf16*)(ws + WS_QB), (bf16*)(ws + WS_KB), (bf16*)(ws + WS_VB), (bf16*)(ws + WS_GR), (bf16*)(ws + WS_GBB), SSQ, CS, SN};
            pg8::gemm_phase<epi::EpiWin, ProbDense>(lds + RING_OFF, D, pr, E, tid);
        }
        SEAM(P + 0);
        if (IN(P + 1)) { PH_WS();
            { ProbDense pr; pr.so.init(nM_all, 3072 / 256, G, bx, true); pr.A = (const char*)(ws + WS_CQ); pr.Bt = (const char*)(ws + WS_W + l * WL_STRIDE + WL_UQ); pr.tstep = 256 * (size_t)QRANK * 2;
              epi::EpiUq E{(bf16*)(ws + WS_Q), SSQ, CS, SN};
              pg8::gemm_phase<epi::EpiUq, ProbDense>(lds + RING_OFF, QRANK, pr, E, tid); }
            { ProbDense pr; pr.so.init(nM_all, 4096 / 256, G, bx, true); pr.A = (const char*)(ws + WS_CKV); pr.Bt = (const char*)(ws + WS_W + l * WL_STRIDE + WL_UKV); pr.tstep = 256 * (size_t)KVRANK * 2;
              epi::EpiUkv E{(bf16*)(ws + WS_KN), (bf16*)(ws + WS_V), SSQ};
              pg8::gemm_phase<epi::EpiUkv, ProbDense>(lds + RING_OFF, KVRANK, pr, E, tid); }
        }
        SEAM(P + 1);
        if (IN(P + 2)) { PH_WS();
            const int nqb = l == 0 ? 17 : 16, nmla_full = NB * NH * 16, nmla = NB * NH * nqb;
            for (int u = vcu; u < nmla; u += G) {
                int b, h, qb;
                if (u < nmla_full) { qb = u & 15; h = (u >> 4) & 15; b = u >> 8; } else { const int v = u - nmla_full; qb = 16; h = v & 15; b = v >> 4; }
                att::mla_unit4((att::lds_ptr)(lds + RING_OFF), (const bf16*)(ws + WS_Q), (const bf16*)(ws + WS_KN), (const bf16*)(ws + WS_KR), (const bf16*)(ws + WS_V), (bf16*)(ws + WS_OAB), b, h, qb, tid);
            }
            const int nj = l == 0 ? 65 : 64, nswa_full = NB * 4 * 64, nswa = NB * 4 * nj;
            int tables_hk = -1;
            for (int u = vcu; u < nswa; u += G) {
                int b, hk, j;
                if (u < nswa_full) { j = u & 63; hk = (u >> 6) & 3; b = u >> 8; } else { const int v = u - nswa_full; j = 64; hk = v & 3; b = v >> 2; }
                att::swa_unit2((att::lds_ptr)(lds + RING_OFF), (const bf16*)(ws + WS_QB), (const bf16*)(ws + WS_KB), (const bf16*)(ws + WS_VB), (bf16*)(ws + WS_OAB), (const float*)(ws + WS_TW), (const float*)(ws + WS_TM), (const float*)(ws + WS_SINK) + 16 * l, b, hk, j, tables_hk, tid);
            }
        }
        SEAM(P + 2);
        if (IN(P + 3)) { PH_WS();
            ProbDense pr; pr.so.init(nM_post, D / 256, G, bx, tail_post); pr.A = (const char*)(ws + WS_OAB); pr.Bt = (const char*)(ws + WS_W + l * WL_STRIDE + WL_AB); pr.tstep = 256 * (size_t)(2 * D) * 2;
            epi::EpiProj E{(bf16*)(ws + WS_MG), (const bf16*)(ws + WS_GR), (const bf16*)(ws + WS_GBB)};
            pg8::gemm_phase<epi::EpiProj, ProbDense>(lds + RING_OFF, 2 * D, pr, E, tid);
        }
        SEAM(P + 3);
        if (IN(P + 4)) { PH_WS();
            ProbDense pr; pr.so.init(nM_post, D / 256, G, bx, tail_post); pr.A = (const char*)(ws + WS_MG); pr.Bt = (const char*)(ws + WS_W + l * WL_STRIDE + WL_OUT); pr.tstep = 256 * (size_t)D * 2;
            epi::EpiResid E{X, HB};
            pg8::gemm_phase<epi::EpiResid, ProbDense>(lds + RING_OFF, D, pr, E, tid);
        }
        SEAM(P + 4);
        if (IN(P + 5)) { PH_WS();
            const float* g = INP(I_LMG) + l * D; const float* bta = INP(I_LMB) + l * D;
            const int nrows = l == 0 ? T : TREAL;
            int h0 = 0, h1 = 0, h2 = 0, h3 = 0, h4 = 0, h5 = 0, h6 = 0, h7 = 0;
            LAS f32x4* const rwl = (LAS f32x4*)(lds + RING_OFF);
            if (l == 1) { const GAS f32x4* rwg = (const GAS f32x4*)INP(I_RW); for (int i = tid; i < D * 2; i += NWAVES * 64) { const int k = i >> 1, hf = i & 1; rwl[hf * 2048 + ((k >> 8) * 4 + (k & 3)) * 64 + ((k >> 2) & 63)] = rwg[i]; } __syncthreads(); }
#define LM_PROC(r, m) do { ln_normalize(r); ln_affine(r, g, bta, lane); row_store_bf16(r, HB + (size_t)(m) * D, lane); \
                if (l == 1) { int i0_, i1_; float g0_, g1_; router_row(r, rwl, rbias, lane, i0_, i1_, g0_, g1_); \
                    if (lane == 0) { int* ti = (int*)(ws + WS_TOPI); float* tg = (float*)(ws + WS_TOPG); ti[2 * (m)] = i0_; ti[2 * (m) + 1] = i1_; tg[2 * (m)] = g0_; tg[2 * (m) + 1] = g1_; } \
                    h0 += (i0_ == 0) + (i1_ == 0); h1 += (i0_ == 1) + (i1_ == 1); h2 += (i0_ == 2) + (i1_ == 2); h3 += (i0_ == 3) + (i1_ == 3); \
                    h4 += (i0_ == 4) + (i1_ == 4); h5 += (i0_ == 5) + (i1_ == 5); h6 += (i0_ == 6) + (i1_ == 6); h7 += (i0_ == 7) + (i1_ == 7); } } while (0)
            { const float* rbias = INP(I_RB); Row8 ra{}, rb{}; int m = gw; if (m < nrows) row_load_bf16(ra, X + (size_t)m * D, lane);
              for (; m < nrows; m += 2 * NGW) { const int m1 = m + NGW, m2 = m + 2 * NGW; if (m1 < nrows) row_load_bf16(rb, X + (size_t)m1 * D, lane); LM_PROC(ra, m);
                  if (m1 < nrows) { if (m2 < nrows) row_load_bf16(ra, X + (size_t)m2 * D, lane); LM_PROC(rb, m1); } } }
#undef LM_PROC
            if (l == 1 && lane == 0) { int* wh = (int*)(ws + WS_WHIST) + gw * 8; wh[0] = h0; wh[1] = h1; wh[2] = h2; wh[3] = h3; wh[4] = h4; wh[5] = h5; wh[6] = h6; wh[7] = h7; }
        }
        SEAM(P + 5);
        if (l == 0) {
            if (IN(P + 6)) { PH_WS();
                ProbDense pr; pr.so.init(nM_all, 2 * DFF / 256, G, bx, true); pr.A = (const char*)HB; pr.Bt = (const char*)(ws + WS_WF13); pr.tstep = 256 * (size_t)D * 2;
                epi::EpiSwiglu E{(bf16*)(ws + WS_ACT)};
                pg8::gemm_phase<epi::EpiSwiglu, ProbDense>(lds + RING_OFF, D, pr, E, tid);
            }
            SEAM(P + 6);
            if (IN(P + 7)) { PH_WS();
                ProbDense pr; pr.so.init(nM_all, D / 256, G, bx, true); pr.A = (const char*)(ws + WS_ACT); pr.Bt = (const char*)(ws + WS_WF2); pr.tstep = 256 * (size_t)DFF * 2;
                epi::EpiResid E{X, HB};
                pg8::gemm_phase<epi::EpiResid, ProbDense>(lds + RING_OFF, DFF, pr, E, tid);
            }
            SEAM(P + 7);
            if (IN(P + 8)) { PH_WS();
                const float* g = INP(I_LFG); const float* bta = INP(I_LFB);
#define LF_PROC(r, m) do { ln_normalize(r); ln_affine(r, g, bta, lane); row_store_bf16(r, HB + (size_t)(m) * D, lane); } while (0)
                { Row8 ra{}, rb{}; int m = gw; if (m < T) row_load_bf16(ra, X + (size_t)m * D, lane);
                  for (; m < T; m += 2 * NGW) { const int m1 = m + NGW, m2 = m + 2 * NGW; if (m1 < T) row_load_bf16(rb, X + (size_t)m1 * D, lane); LF_PROC(ra, m);
                      if (m1 < T) { if (m2 < T) row_load_bf16(ra, X + (size_t)m2 * D, lane); LF_PROC(rb, m1); } } }
#undef LF_PROC
            }
            SEAM(P + 8);
        } else {
            if (IN(P + 6)) { PH_WS();
                LAS int* hist = (LAS int*)(lds + RING_OFF);
                LAS int* segsum = hist + 2048 * 8;
                LAS int* segpre = segsum + 64 * 8;
                LAS int* tot = segpre + 64 * 8;
                const int* wh = (const int*)(ws + WS_WHIST);
                for (int i = tid; i < NGW * 8; i += NWAVES * 64) hist[i] = wh[i];
                __syncthreads();
                { const int e = tid & 7, seg = tid >> 3; int s = 0;
_Pragma("unroll 1")
                  for (int w = 0; w < 32; ++w) { const int ww = seg * 32 + w; if (ww < NGW) s += hist[ww * 8 + e]; } segsum[seg * 8 + e] = s; }
                __syncthreads();
                if (tid < 8) { int run = 0;
_Pragma("unroll 1")
                    for (int s = 0; s < 64; ++s) { segpre[s * 8 + tid] = run; run += segsum[s * 8 + tid]; } tot[tid] = run; }
                __syncthreads();
                if (tid == 0) { int ts = 0; for (int e = 0; e < 8; ++e) { tot[8 + e] = ts; ts += (tot[e] + 255) >> 8; } tot[16] = ts;
                    if (bx == 0) for (int e = 0; e < 9; ++e) ((int*)(ws + WS_CTL))[CW_MOE_TS + e] = tot[8 + e]; }
                __syncthreads();
                int base = 0;
                if (lane < 8) { base = tot[8 + lane] * 256 + segpre[(gw >> 5) * 8 + lane];
_Pragma("unroll 1")
                    for (int w = (gw & ~31); w < gw; ++w) base += hist[w * 8 + lane]; }
                const int* ti = (const int*)(ws + WS_TOPI); const float* tg = (const float*)(ws + WS_TOPG);
                for (int m = gw; m < TREAL; m += NGW) {
#pragma unroll
                    for (int k = 0; k < 2; ++k) { const int e = __builtin_amdgcn_readfirstlane(ti[2 * m + k]); const float gt = tg[2 * m + k];
                        const int slot = __builtin_amdgcn_readlane(base, e); if (lane == e) base += 1;
                        if (lane == 0) { SLOT_TOK[slot] = m; SLOT_GATE[slot] = gt; TOK_SLOT[2 * m + k] = slot; } }
                }
                if (vcu < 8) { const int e = vcu; const int s0 = tot[8 + e] * 256 + tot[e], s1 = tot[8 + e + 1] * 256; for (int s = s0 + tid; s < s1; s += NWAVES * 64) { SLOT_TOK[s] = T; SLOT_GATE[s] = 0.f; } }
                __syncthreads();
                LAS float* scr = (LAS float*)(lds + RING_OFF + wave * 16384);
                constexpr int I_F = (D / 64) * (DFF / 32), I_F2 = (DFF / 64) * (D / 32), I_E = 2 * I_F + I_F2;
                { const float* mw1 = INP(I_MW1); const float* mw3 = INP(I_MW3); const float* mw2 = INP(I_MW2);
#define MOE_DESC(d, it_) do { const int e_ = (it_) / I_E; int r_ = (it_) - e_ * I_E; \
                    if (r_ < 2 * I_F) { const int wh_ = r_ / I_F; r_ -= wh_ * I_F; const int kb_ = r_ / (DFF / 32), nb_ = r_ % (DFF / 32); \
                        d.W = (wh_ ? mw3 : mw1) + (size_t)e_ * D * DFF; d.ldw = DFF; d.k0 = 64 * kb_; d.n0 = 32 * nb_; d.WT = (bf16*)(ws + WS_MW13) + (size_t)e_ * 2 * DFF * D; d.ldt = D; d.drow = dmap_glu(32 * nb_) + (wh_ ? 128 : 0); } \
                    else { r_ -= 2 * I_F; const int kb_ = r_ / (D / 32), nb_ = r_ % (D / 32); \
                        d.W = mw2 + (size_t)e_ * DFF * D; d.ldw = D; d.k0 = 64 * kb_; d.n0 = 32 * nb_; d.WT = (bf16*)(ws + WS_MW2) + (size_t)e_ * D * DFF; d.ldt = DFF; d.drow = 32 * nb_; } } while (0)
                  constexpr int NIT = NE * I_E; TDesc da{}, db{}; f32x4 va[8] = {}, vb[8] = {};
                  int it = gw; if (it < NIT) { MOE_DESC(da, it); t_load(da, va, lane); }
                  for (; it < NIT; it += 2 * NGW) { const int it1 = it + NGW, it2 = it + 2 * NGW;
                      if (it1 < NIT) { MOE_DESC(db, it1); t_load(db, vb, lane); }
                      t_finish(da, va, scr, lane);
                      if (it1 < NIT) { if (it2 < NIT) { MOE_DESC(da, it2); t_load(da, va, lane); } t_finish(db, vb, scr, lane); } }
#undef MOE_DESC
                }
            }
            SEAM(P + 6);
            MoeTiles mt;
            if (IN(P + 7) || IN(P + 8)) { unsigned char* const ws = WSP();
#pragma unroll
                for (int e = 0; e < 9; ++e) mt.ts[e] = __builtin_amdgcn_readfirstlane(((const int*)(ws + WS_CTL))[CW_MOE_TS + e]);
            } else {
#pragma unroll
                for (int e = 0; e < 9; ++e) mt.ts[e] = 0;
            }
            if (IN(P + 7)) { PH_WS();
                ProbMoe1 pr; pr.so.init(mt.ts[8], 2 * DFF / 256, G, bx); pr.HBp = (const char*)HB; pr.slot_tok = SLOT_TOK; pr.W = (const char*)(ws + WS_MW13); pr.mt = mt;
                epi::EpiSwiglu E{(bf16*)(ws + WS_MACT)};
                pg8::gemm_phase<epi::EpiSwiglu, ProbMoe1, true>(lds + RING_OFF, D, pr, E, tid);
            }
            SEAM(P + 7);
            if (IN(P + 8)) { PH_WS();
                ProbMoe2 pr; pr.so.init(mt.ts[8], D / 256, G, bx); pr.ACTp = (const char*)(ws + WS_MACT); pr.W = (const char*)(ws + WS_MW2); pr.mt = mt;
                epi::EpiMoeDown E{(bf16*)(ws + WS_Y), SLOT_GATE};
                pg8::gemm_phase<epi::EpiMoeDown, ProbMoe2>(lds + RING_OFF, DFF, pr, E, tid);
            }
            SEAM(P + 8);
            if (IN(P + 9)) { PH_WS();
                const float* g = INP(I_LFG) + D; const float* bta = INP(I_LFB) + D; const bf16* Y = (const bf16*)(ws + WS_Y);
#define FL_LOAD(R, m) do { const int s0_ = TOK_SLOT[2 * (m)], s1_ = TOK_SLOT[2 * (m) + 1]; \
                    _Pragma("unroll") for (int j = 0; j < 8; ++j) { const v2u hw = *((const GAS v2u*)(HB + (size_t)(m) * D) + lane + 64 * j), y0 = *((const GAS v2u*)(Y + (size_t)s0_ * D) + lane + 64 * j), y1 = *((const GAS v2u*)(Y + (size_t)s1_ * D) + lane + 64 * j); \
                        R.v[j] = (bf4(hw) * ALPHA + bf4(y0)) + bf4(y1); } } while (0)
#define FL_PROC(R, m) do { ln_normalize(R); ln_affine(R, g, bta, lane); GAS f32x4* o = (GAS f32x4*)(outp + (size_t)(m) * D) + lane; \
                    _Pragma("unroll") for (int j = 0; j < 8; ++j) o[64 * j] = R.v[j]; } while (0)
                { float* const outp = OUTP(); Row8 ra{}, rb{}; int m = gw; if (m < TREAL) FL_LOAD(ra, m);
                  for (; m < TREAL; m += 2 * NGW) { const int m1 = m + NGW, m2 = m + 2 * NGW; if (m1 < TREAL) FL_LOAD(rb, m1); FL_PROC(ra, m);
                      if (m1 < TREAL) { if (m2 < TREAL) FL_LOAD(ra, m2); FL_PROC(rb, m1); } } }
#undef FL_LOAD
#undef FL_PROC
            }
        }
    }
#undef IN
#undef SEAM
}

#ifndef MK_ONE_LAUNCH
#define MK_ONE_LAUNCH 0
#endif
extern "C" void kernel_launch(void* const* d_in, const int* in_sizes, int n_in, void* d_out, int out_size, void* d_ws, size_t ws_size, hipStream_t stream) {
    static int grid = 0;
    if (grid == 0) {
        if (n_in != N_IN || in_sizes[0] != NB * SEQ * D || out_size != NB * SEQ * D || ws_size < WS_END) { fprintf(stderr, "kernel_launch: shape mismatch: n_in %d in0 %d out %d ws %zu (need %zu)\n", n_in, n_in > 0 ? in_sizes[0] : -1, out_size, ws_size, (size_t)WS_END); grid = -1; return; }
        int dev = 0, cus = 0, per_cu = 0;
        if (hipGetDevice(&dev) != hipSuccess || hipDeviceGetAttribute(&cus, hipDeviceAttributeMultiprocessorCount, dev) != hipSuccess) { fprintf(stderr, "kernel_launch: device query failed\n"); grid = -1; return; }
        if (hipFuncSetAttribute((const void*)mk_fwd, hipFuncAttributeMaxDynamicSharedMemorySize, LDS_BYTES) != hipSuccess) { fprintf(stderr, "kernel_launch: hipFuncSetAttribute failed\n"); grid = -1; return; }
        if (hipOccupancyMaxActiveBlocksPerMultiprocessor(&per_cu, (const void*)mk_fwd, NWAVES * 64, LDS_BYTES) != hipSuccess || per_cu < 1) fprintf(stderr, "kernel_launch: occupancy query reports %d\n", per_cu);
        (void)hipGetLastError();
        grid = cus;
    }
    if (grid < 0) return;
    if (hipMemsetAsync((char*)d_ws + WS_CTL, 0, CTL_ZERO_BYTES, stream) != hipSuccess) { fprintf(stderr, "kernel_launch: memset failed\n"); return; }
    Args a{};
    for (int i = 0; i < N_IN; ++i) a.in[i] = (const float*)d_in[i];
    a.out = (float*)d_out; a.ws = (unsigned char*)d_ws;
#if MK_ONE_LAUNCH
    a.ph_lo = 0; a.ph_hi = N_PHASES;
    hipLaunchKernelGGL(mk_fwd, dim3(grid), dim3(NWAVES * 64), LDS_BYTES, stream, a);
#else
    for (int p = 0; p < N_PHASES; ++p) { a.ph_lo = p; a.ph_hi = p + 1; hipLaunchKernelGGL(mk_fwd, dim3(grid), dim3(NWAVES * 64), LDS_BYTES, stream, a); }
#endif
    const hipError_t le = hipPeekAtLastError();
    if (le != hipSuccess) fprintf(stderr, "kernel_launch: launch failed: %s\n", hipGetErrorName(le));
}
```

```cpp
#define MK_ONE_LAUNCH 1
#include <hip/hip_runtime.h>
#include <cstdio>
#include <cstdint>
namespace pg8 {
#define PG8_LAS __attribute__((address_space(3)))
typedef unsigned short bf16_t;
typedef short bf16x8 __attribute__((ext_vector_type(8)));
typedef float f32x4 __attribute__((ext_vector_type(4)));
typedef float f32x2 __attribute__((ext_vector_type(2)));
typedef unsigned u32x4 __attribute__((ext_vector_type(4)));
typedef unsigned u32x2 __attribute__((ext_vector_type(2)));
constexpr int BM = 256, BK = 64, HALF = 128, HTB = HALF * BK * 2  , STAGE_BYTES = 8 * HTB, NXCD = 8, WGM = 8;

__host__ __device__ __forceinline__ int lds_byte(int r, int c) { const int st = (r >> 4) * 2 + (c >> 5), rr = r & 15, cc = c & 31, ob = rr * 64 + cc * 2; return st * 1024 + (ob ^ (((ob >> 9) & 1) << 5)); }
__host__ __device__ __forceinline__ void stage_rc(int b, int& R, int& C) { const int st = b / 1024, sb = b % 1024, swz = sb ^ (((sb >> 9) & 1) << 5); R = (st >> 1) * 16 + swz / 64; C = (st & 1) * 32 + (swz % 64) / 2; }
__host__ __device__ __forceinline__ int perm32(int rho) { const int n = rho >> 4, i = rho & 15; return 8 * (i >> 2) + 4 * n + (i & 3); }

struct Unit { int pm, pn; };

struct StaticOrder {
    int nM, nN, nwg, G, c, ntail;
    __device__ __forceinline__ void init(int nM_, int nN_, int G_, int c_, bool tail = false) { nM = nM_; nN = nN_; nwg = nM * nN; G = G_; c = c_; ntail = tail ? nN_ : 0; }
    __device__ __forceinline__ bool next(int i, Unit& u) const {
        const long L = (long)i * G + c; if (L >= nwg + ntail) return false;
        if (L >= nwg) { u.pm = nM; u.pn = (int)(L - nwg); return true; }
        int wgid = (int)L; { const int q = nwg / NXCD, r = nwg % NXCD, xcd = wgid % NXCD, off = wgid / NXCD; wgid = (xcd < r ? xcd * (q + 1) : r * (q + 1) + (xcd - r) * q) + off; }
        const int nig = WGM * nN, gid = wgid / nig, fm = gid * WGM, gsz = (nM - fm) < WGM ? (nM - fm) : WGM;
        u.pm = fm + ((wgid % nig) % gsz); u.pn = (wgid % nig) / gsz; return true;
    }
    __device__ __forceinline__ bool is_half(const Unit& u) const { return ntail != 0 && u.pm == nM; }
};
__device__ __forceinline__ unsigned cvt_pk_bf16(float lo, float hi) { unsigned r; asm volatile("v_cvt_pk_bf16_f32 %0, %1, %2" : "=v"(r) : "v"(lo), "v"(hi)); return r; }
__device__ __forceinline__ float bf_lo(unsigned w) { return __uint_as_float(w << 16); }
__device__ __forceinline__ float bf_hi(unsigned w) { return __uint_as_float(w & 0xffff0000u); }

template <class Epi, class Prob, bool GATHER = false>
__device__ __forceinline__ void gemm_phase(PG8_LAS unsigned char* lds, const int K, const Prob& S, const Epi& E, const int tid_in) {
    int tid_ = tid_in; asm volatile("" : "+v"(tid_));
    const int tid = tid_, wid = __builtin_amdgcn_readfirstlane(tid >> 6), lane = tid & 63, wr = wid >> 2, wc = wid & 3, fr = lane & 15, fq = lane >> 4;
    const int nt = K / BK;
    int sR[2], sC[2];
    unsigned voffA[2][2], nvoffA[2][2], voffB[2];
#pragma unroll
    for (int i = 0; i < 2; ++i) { int R, C; stage_rc(tid * 16 + i * 8192, R, C); sR[i] = R; sC[i] = C; const int Rb = (R & ~31) + perm32(R & 31);
        voffB[i] = (unsigned)(Rb * K + C) * 2u;
        voffA[0][i] = (unsigned)(R * K + C) * 2u; voffA[1][i] = (unsigned)((R + HALF) * K + C) * 2u; nvoffA[0][i] = voffA[0][i]; nvoffA[1][i] = voffA[1][i]; }
    const size_t kstep = (size_t)(BK * 2);
    const size_t hstep = (size_t)HALF * K * 2;
    const unsigned ldsw = (unsigned)wid * 1024u;
    const int aoff = lds_byte(wr * 64 + fr, fq * 8), boff = lds_byte(wc * 32 + fr, fq * 8);
#define PG8_SA(b, h) (((b) * 2 + (h)) * HTB)
#define PG8_SB(b, h) ((4 + (b) * 2 + (h)) * HTB)
#define PG8_STAGE(bufoff, gbase, voff) do { _Pragma("unroll") for (int _i = 0; _i < 2; ++_i) \
        __builtin_amdgcn_global_load_lds((const unsigned*)((const char*)(gbase) + (voff)[_i]), (PG8_LAS unsigned*)(lds + (bufoff) + ldsw + _i * 8192), 16, 0, 0); } while (0)
#define PG8_LDA(dst, b, h) do { _Pragma("unroll") for (int m = 0; m < 4; ++m) _Pragma("unroll") for (int k = 0; k < 2; ++k) dst[m][k] = *(const PG8_LAS bf16x8*)(lds + PG8_SA(b, h) + aoff + m * 2048 + k * 1024); } while (0)
#define PG8_LDB(dst, b, h) do { _Pragma("unroll") for (int n = 0; n < 2; ++n) _Pragma("unroll") for (int k = 0; k < 2; ++k) dst[n][k] = *(const PG8_LAS bf16x8*)(lds + PG8_SB(b, h) + boff + n * 2048 + k * 1024); } while (0)
#define PG8_MMA(ai, bj, At, Bt) do { __builtin_amdgcn_s_setprio(1); _Pragma("unroll") for (int m = 0; m < 4; ++m) _Pragma("unroll") for (int n = 0; n < 2; ++n) _Pragma("unroll") for (int k = 0; k < 2; ++k) \
        acc[ai][bj][m][n] = __builtin_amdgcn_mfma_f32_16x16x32_bf16(Bt[n][k], At[m][k], acc[ai][bj][m][n], 0, 0, 0); __builtin_amdgcn_s_setprio(0); } while (0)
#define PG8_WAIT_V(n) asm volatile("s_waitcnt vmcnt(" #n ")" ::: "memory")
#define PG8_WAIT_L(n) asm volatile("s_waitcnt lgkmcnt(" #n ")" ::: "memory")
#define PG8_BAR __builtin_amdgcn_s_barrier()
#define PG8_SCHED __builtin_amdgcn_sched_barrier(0)
    Unit cur, nxt; int ui = 0;
    if (!S.next(0, cur)) return;
    f32x4 acc[2][2][4][2];
#pragma unroll
    for (int a = 0; a < 2; ++a)
#pragma unroll
        for (int b = 0; b < 2; ++b)
#pragma unroll
            for (int m = 0; m < 4; ++m)
#pragma unroll
                for (int n = 0; n < 2; ++n) acc[a][b][m][n] = (f32x4){0.f, 0.f, 0.f, 0.f};
    bf16x8 At[4][2], B0[2][2], B1[2][2];
    const char* cA = S.a_base(cur); const char* cB = S.b_base(cur);
    if constexpr (GATHER) {
#pragma unroll
        for (int h = 0; h < 2; ++h)
#pragma unroll
            for (int i = 0; i < 2; ++i) { voffA[h][i] = (unsigned)(S.a_row(cur, sR[i] + h * HALF) * K + sC[i]) * 2u; nvoffA[h][i] = voffA[h][i]; }
    }
    PG8_STAGE(PG8_SB(0, 0), cB, voffB); PG8_STAGE(PG8_SB(0, 1), cB + hstep, voffB); PG8_STAGE(PG8_SA(0, 0), cA, voffA[0]); PG8_STAGE(PG8_SA(0, 1), cA, voffA[1]);
    if (wr == 1) PG8_BAR;
    PG8_WAIT_V(2); PG8_BAR;
    PG8_STAGE(PG8_SB(1, 0), cB + kstep, voffB); PG8_STAGE(PG8_SA(1, 0), cA + kstep, voffA[0]); PG8_STAGE(PG8_SB(1, 1), cB + hstep + kstep, voffB);
    PG8_WAIT_V(6); PG8_BAR;
    for (;;) {
        const bool has_next = S.next(ui + 1, nxt);
        const bool half = S.is_half(cur);
        const char* nA = has_next ? S.a_base(nxt) : cA; const char* nB = has_next ? S.b_base(nxt) : cB;
        if constexpr (GATHER) { if (has_next) {
#pragma unroll
            for (int h = 0; h < 2; ++h)
#pragma unroll
                for (int i = 0; i < 2; ++i) nvoffA[h][i] = (unsigned)(S.a_row(nxt, sR[i] + h * HALF) * K + sC[i]) * 2u; } }
        for (int t = 0; t < nt; t += 2) {
            const bool last = (t == nt - 2);
            if constexpr (Epi::MID) { if (t == (nt >> 1)) E.mid(acc, cur, wr, wc, fr, fq); }
            const char* a1 = cA + (size_t)(t + 1) * kstep;
            const char* a2 = last ? nA : cA + (size_t)(t + 2) * kstep; const char* b2 = last ? nB : cB + (size_t)(t + 2) * kstep;
            const char* a3 = a2 + kstep; const char* b3 = b2 + kstep;
            unsigned vA2[2][2];
#pragma unroll
            for (int h = 0; h < 2; ++h)
#pragma unroll
                for (int i = 0; i < 2; ++i) vA2[h][i] = GATHER ? (last ? nvoffA[h][i] : voffA[h][i]) : voffA[h][i];
            PG8_LDB(B0, 0, 0); PG8_LDB(B1, 0, 1); PG8_SCHED; PG8_LDA(At, 0, 0); PG8_STAGE(PG8_SA(1, 1), a1, voffA[1]);
            PG8_WAIT_V(8); PG8_WAIT_L(0); PG8_BAR; PG8_MMA(0, 0, At, B0); PG8_MMA(0, 1, At, B1); PG8_BAR; PG8_SCHED;
            if (!half) PG8_LDA(At, 0, 1); PG8_STAGE(PG8_SB(0, 0), b2, voffB); PG8_STAGE(PG8_SB(0, 1), b2 + hstep, voffB); PG8_STAGE(PG8_SA(0, 0), a2, vA2[0]);
            PG8_WAIT_V(8); PG8_WAIT_L(0); PG8_BAR; if (!half) { PG8_MMA(1, 0, At, B0); PG8_MMA(1, 1, At, B1); } PG8_BAR; PG8_SCHED;
            PG8_LDB(B0, 1, 0); PG8_LDB(B1, 1, 1); PG8_SCHED; PG8_LDA(At, 1, 0); PG8_STAGE(PG8_SA(0, 1), a2, vA2[1]);
            PG8_WAIT_V(8); PG8_WAIT_L(0); PG8_BAR; PG8_MMA(0, 0, At, B0); PG8_MMA(0, 1, At, B1); PG8_BAR; PG8_SCHED;
            if (!half) PG8_LDA(At, 1, 1); PG8_STAGE(PG8_SB(1, 0), b3, voffB); PG8_STAGE(PG8_SB(1, 1), b3 + hstep, voffB); PG8_STAGE(PG8_SA(1, 0), a3, vA2[0]);
            PG8_WAIT_V(8); PG8_WAIT_L(0); PG8_BAR; if (!half) { PG8_MMA(1, 0, At, B0); PG8_MMA(1, 1, At, B1); } PG8_BAR; PG8_SCHED;
        }
        if (wr == 0) PG8_BAR;
        E(acc, cur, wr, wc, fr, fq);
        if (!has_next) break;
#pragma unroll
        for (int a = 0; a < 2; ++a)
#pragma unroll
            for (int b = 0; b < 2; ++b)
#pragma unroll
                for (int m = 0; m < 4; ++m)
#pragma unroll
                    for (int n = 0; n < 2; ++n) acc[a][b][m][n] = (f32x4){0.f, 0.f, 0.f, 0.f};
        cur = nxt; cA = nA; cB = nB; ++ui;
        if constexpr (GATHER) {
#pragma unroll
            for (int h = 0; h < 2; ++h)
#pragma unroll
                for (int i = 0; i < 2; ++i) voffA[h][i] = nvoffA[h][i]; }
        if (wr == 1) PG8_BAR;
    }
    PG8_WAIT_V(0);
    PG8_BAR;
#undef PG8_SA
#undef PG8_SB
#undef PG8_STAGE
#undef PG8_LDA
#undef PG8_LDB
#undef PG8_MMA
#undef PG8_WAIT_V
#undef PG8_WAIT_L
#undef PG8_BAR
#undef PG8_SCHED
}
}
constexpr int D = 2048, NB = 8, SEQ = 4096, NMETA = 16, NH = 16;
constexpr int TREAL = NB * SEQ;
constexpr int T = TREAL + NB * NMETA;
constexpr int TP = 33024;
constexpr int LPOS = SEQ + NMETA;
constexpr int QRANK = 768, KVRANK = 512, DFF = 5632, NE = 8;
constexpr int NIN = 8704;
constexpr int INDIM = 8512;
constexpr float LN_EPS = 1e-5f, RMS_EPS = 1e-6f, ALPHA = 1.4142135623730951f;
constexpr float LOG2E = 1.4426950408889634f;
constexpr float QK_SCALE_MLA = 0.07216878364870322f * LOG2E;
constexpr float QK_SCALE_SWA = 0.08838834764831845f * LOG2E;

__device__ __forceinline__ int row_pos(int row) { return row < TREAL ? NMETA + (row & (SEQ - 1)) : ((row - TREAL) & (NMETA - 1)); }

struct ProbDense {
    pg8::StaticOrder so; const char* A; const char* Bt; size_t tstep;
    __device__ __forceinline__ bool next(int i, pg8::Unit& u) const { return so.next(i, u); }
    __device__ __forceinline__ const char* a_base(const pg8::Unit& u) const { return A + (size_t)u.pm * tstep; }
    __device__ __forceinline__ const char* b_base(const pg8::Unit& u) const { return Bt + (size_t)u.pn * tstep; }
    __device__ __forceinline__ int a_row(const pg8::Unit&, int) const { return 0; }
    __device__ __forceinline__ bool is_half(const pg8::Unit& u) const { return so.is_half(u); }
};
struct MoeTiles { int ts[9]; };
__device__ __forceinline__ int moe_expert(const MoeTiles& mt, int pm) { int e = 0;
#pragma unroll
    for (int k = 1; k < 8; ++k) e += (pm >= mt.ts[k]) ? 1 : 0; return e; }
struct ProbMoe1 {
    pg8::StaticOrder so; const char* HBp; const int* slot_tok; const char* W; MoeTiles mt;
    __device__ __forceinline__ bool next(int i, pg8::Unit& u) const { return so.next(i, u); }
    __device__ __forceinline__ const char* a_base(const pg8::Unit&) const { return HBp; }
    __device__ __forceinline__ const char* b_base(const pg8::Unit& u) const { return W + (size_t)moe_expert(mt, u.pm) * ((size_t)2 * DFF * D * 2) + (size_t)u.pn * (256 * (size_t)D * 2); }
    __device__ __forceinline__ int a_row(const pg8::Unit& u, int r) const { return slot_tok[u.pm * 256 + r]; }
    __device__ __forceinline__ bool is_half(const pg8::Unit&) const { return false; }
};
struct ProbMoe2 {
    pg8::StaticOrder so; const char* ACTp; const char* W; MoeTiles mt;
    __device__ __forceinline__ bool next(int i, pg8::Unit& u) const { return so.next(i, u); }
    __device__ __forceinline__ const char* a_base(const pg8::Unit& u) const { return ACTp + (size_t)u.pm * (256 * (size_t)DFF * 2); }
    __device__ __forceinline__ const char* b_base(const pg8::Unit& u) const { return W + (size_t)moe_expert(mt, u.pm) * ((size_t)D * DFF * 2) + (size_t)u.pn * (256 * (size_t)DFF * 2); }
    __device__ __forceinline__ int a_row(const pg8::Unit&, int) const { return 0; }
    __device__ __forceinline__ bool is_half(const pg8::Unit&) const { return false; }
};

namespace epi {
using pg8::f32x4; using pg8::u32x4; using pg8::bf16_t; using pg8::Unit; using pg8::cvt_pk_bf16;
typedef const f32x4 (&AccRef)[2][2][4][2];
__device__ __forceinline__ void store8(bf16_t* p, f32x4 v0, f32x4 v1) { u32x4 w; w.x = cvt_pk_bf16(v0[0], v0[1]); w.y = cvt_pk_bf16(v0[2], v0[3]); w.z = cvt_pk_bf16(v1[0], v1[1]); w.w = cvt_pk_bf16(v1[2], v1[3]); *(u32x4*)p = w; }
__device__ __forceinline__ void load8(const bf16_t* p, f32x4& v0, f32x4& v1) { const u32x4 w = *(const u32x4*)p;
    v0 = (f32x4){pg8::bf_lo(w.x), pg8::bf_hi(w.x), pg8::bf_lo(w.y), pg8::bf_hi(w.y)}; v1 = (f32x4){pg8::bf_lo(w.z), pg8::bf_hi(w.z), pg8::bf_lo(w.w), pg8::bf_hi(w.w)}; }
__device__ __forceinline__ void unpack8(u32x4 w, f32x4& v0, f32x4& v1) { v0 = (f32x4){pg8::bf_lo(w.x), pg8::bf_hi(w.x), pg8::bf_lo(w.y), pg8::bf_hi(w.y)}; v1 = (f32x4){pg8::bf_lo(w.z), pg8::bf_hi(w.z), pg8::bf_lo(w.w), pg8::bf_hi(w.w)}; }
__device__ __forceinline__ bool epi_fence() { asm volatile("" ::: "memory"); return true; }
__device__ __forceinline__ float sigmoidf_(float x) { return __builtin_amdgcn_rcpf(1.f + __builtin_amdgcn_exp2f(-x * LOG2E)); }
#define EPI_AM _Pragma("unroll") for (int ai = 0; ai < 2; ++ai) _Pragma("unroll") for (int m = 0; m < 4; ++m) if (epi_fence())

struct EpiWin {
    static constexpr bool MID = false;
    bf16_t *CQ, *CKV, *KR, *QB, *KB, *VB, *GR, *GBb; float* SSQ; const float *CS, *SN;
    __device__ __forceinline__ void operator()(AccRef acc, const Unit& u, int wr, int wc, int fr, int fq) const {
        const int pn = u.pn, row0 = u.pm * 256 + wr * 64 + fr, cw = wc * 32 + fq * 8;
        if (pn < 5) {
            bf16_t* dst = pn < 3 ? CQ : CKV; const int ld = pn < 3 ? QRANK : KVRANK, c0 = (pn < 3 ? pn : pn - 3) * 256;
            EPI_AM { const int row = row0 + ai * 128 + m * 16; float s = 0.f;
#pragma unroll
                for (int bj = 0; bj < 2; ++bj) { const f32x4 v0 = acc[ai][bj][m][0], v1 = acc[ai][bj][m][1];
                    s += (v0[0] * v0[0] + v0[1] * v0[1]) + (v0[2] * v0[2] + v0[3] * v0[3]) + (v1[0] * v1[0] + v1[1] * v1[1]) + (v1[2] * v1[2] + v1[3] * v1[3]);
                    store8(dst + (size_t)row * ld + c0 + bj * 128 + cw, v0, v1); }
                s += __shfl_xor(s, 16); s += __shfl_xor(s, 32);
                if (fq == 0) SSQ[(size_t)row * 20 + pn * 4 + wc] = s; }
        } else if (pn == 5) {
            if (wc == 0) { EPI_AM { const int row = row0 + ai * 128 + m * 16, pos = row_pos(row);
                const f32x4 c0 = *(const f32x4*)(CS + pos * 32 + fq * 8), c1 = *(const f32x4*)(CS + pos * 32 + fq * 8 + 4), s0 = *(const f32x4*)(SN + pos * 32 + fq * 8), s1 = *(const f32x4*)(SN + pos * 32 + fq * 8 + 4);
                const f32x4 x10 = acc[ai][0][m][0], x11 = acc[ai][0][m][1], x20 = acc[ai][1][m][0], x21 = acc[ai][1][m][1];
                store8(KR + (size_t)row * 64 + fq * 8, x10 * c0 - x20 * s0, x11 * c1 - x21 * s1);
                store8(KR + (size_t)row * 64 + 32 + fq * 8, x10 * s0 + x20 * c0, x11 * s1 + x21 * c1); } }
        } else if (pn < 14) {
            EPI_AM { const int row = row0 + ai * 128 + m * 16;
#pragma unroll
                for (int bj = 0; bj < 2; ++bj) store8(QB + (size_t)row * 2048 + (pn - 6) * 256 + bj * 128 + cw, acc[ai][bj][m][0] * QK_SCALE_SWA, acc[ai][bj][m][1] * QK_SCALE_SWA); }
        } else if (pn < 18) {
            bf16_t* dst = pn < 16 ? KB : VB; const int c0 = (pn < 16 ? pn - 14 : pn - 16) * 256;
            EPI_AM { const int row = row0 + ai * 128 + m * 16;
#pragma unroll
                for (int bj = 0; bj < 2; ++bj) store8(dst + (size_t)row * 512 + c0 + bj * 128 + cw, acc[ai][bj][m][0], acc[ai][bj][m][1]); }
        } else {
            const int c0 = (pn - 18) * 128 + cw;
            EPI_AM { const int row = row0 + ai * 128 + m * 16; f32x4 r[2], g[2];
#pragma unroll
                for (int n = 0; n < 2; ++n)
#pragma unroll
                    for (int j = 0; j < 4; ++j) { const float a = acc[ai][0][m][n][j], b = fmaxf(acc[ai][1][m][n][j], -30.f);
                        const float ea = __builtin_amdgcn_exp2f(-a * LOG2E), eb = __builtin_amdgcn_exp2f(-b * LOG2E);
                        g[n][j] = __builtin_amdgcn_rcpf(1.f + eb); r[n][j] = (1.f + eb) * __builtin_amdgcn_rcpf(1.f + ea); }
                store8(GR + (size_t)row * 2048 + c0, r[0], r[1]); store8(GBb + (size_t)row * 2048 + c0, g[0], g[1]); }
        }
    }
};
struct EpiUq {
    static constexpr bool MID = false;
    bf16_t* Q; const float* SSQ; const float *CS, *SN;
    __device__ __forceinline__ void operator()(AccRef acc, const Unit& u, int wr, int wc, int fr, int fq) const {
        const int pn = u.pn, row0 = u.pm * 256 + wr * 64 + fr, cw = wc * 32 + fq * 8;
#pragma unroll
        for (int ai = 0; ai < 2; ++ai) { f32x4 q[4][3];
#pragma unroll
            for (int m = 0; m < 4; ++m) { const float* sp = SSQ + (size_t)(row0 + ai * 128 + m * 16) * 20; q[m][0] = *(const f32x4*)sp; q[m][1] = *(const f32x4*)(sp + 4); q[m][2] = *(const f32x4*)(sp + 8); }
            asm volatile("" ::: "memory");
#pragma unroll
            for (int m = 0; m < 4; ++m) { const int row = row0 + ai * 128 + m * 16;
                const float ss = ((q[m][0][0] + q[m][0][1]) + (q[m][0][2] + q[m][0][3])) + ((q[m][1][0] + q[m][1][1]) + (q[m][1][2] + q[m][1][3])) + ((q[m][2][0] + q[m][2][1]) + (q[m][2][2] + q[m][2][3]));
                const float rs = __builtin_amdgcn_rsqf(ss * (1.f / QRANK) + RMS_EPS) * QK_SCALE_MLA;
                if (pn < 8) {
#pragma unroll
                    for (int bj = 0; bj < 2; ++bj) store8(Q + (size_t)row * 3072 + (2 * pn + bj) * 192 + cw, acc[ai][bj][m][0] * rs, acc[ai][bj][m][1] * rs);
                } else {
                    const int head = 4 * (pn - 8) + wc, pos = row_pos(row);
                    const f32x4 c0 = *(const f32x4*)(CS + pos * 32 + fq * 8), c1 = *(const f32x4*)(CS + pos * 32 + fq * 8 + 4), s0 = *(const f32x4*)(SN + pos * 32 + fq * 8), s1 = *(const f32x4*)(SN + pos * 32 + fq * 8 + 4);
                    const f32x4 x10 = acc[ai][0][m][0] * rs, x11 = acc[ai][0][m][1] * rs, x20 = acc[ai][1][m][0] * rs, x21 = acc[ai][1][m][1] * rs;
                    store8(Q + (size_t)row * 3072 + head * 192 + 128 + fq * 8, x10 * c0 - x20 * s0, x11 * c1 - x21 * s1);
                    store8(Q + (size_t)row * 3072 + head * 192 + 160 + fq * 8, x10 * s0 + x20 * c0, x11 * s1 + x21 * c1);
                } }
            asm volatile("" ::: "memory"); }
    }
};
struct EpiUkv {
    static constexpr bool MID = false;
    bf16_t *KN, *V; const float* SSQ;
    __device__ __forceinline__ void operator()(AccRef acc, const Unit& u, int wr, int wc, int fr, int fq) const {
        const int pn = u.pn, row0 = u.pm * 256 + wr * 64 + fr, cw = wc * 32 + fq * 8;
        f32x4 q[2][4][2];
#pragma unroll
        for (int ai = 0; ai < 2; ++ai)
#pragma unroll
            for (int m = 0; m < 4; ++m) { const float* sp = SSQ + (size_t)(row0 + ai * 128 + m * 16) * 20 + 12; q[ai][m][0] = *(const f32x4*)sp; q[ai][m][1] = *(const f32x4*)(sp + 4); }
        asm volatile("" ::: "memory");
#pragma unroll
        for (int ai = 0; ai < 2; ++ai)
#pragma unroll
            for (int m = 0; m < 4; ++m) { const int row = row0 + ai * 128 + m * 16; const f32x4 q0 = q[ai][m][0], q1 = q[ai][m][1];
                const float ss = ((q0[0] + q0[1]) + (q0[2] + q0[3])) + ((q1[0] + q1[1]) + (q1[2] + q1[3]));
                const float rs = __builtin_amdgcn_rsqf(ss * (1.f / KVRANK) + RMS_EPS);
                store8(KN + (size_t)row * 2048 + pn * 128 + cw, acc[ai][0][m][0] * rs, acc[ai][0][m][1] * rs);
                store8(V + (size_t)row * 2048 + pn * 128 + cw, acc[ai][1][m][0] * rs, acc[ai][1][m][1] * rs); }
    }
};
struct EpiProj {
    static constexpr bool MID = true;
    bf16_t* MG; const bf16_t *GR, *GBb;
    __device__ __forceinline__ void mid(f32x4 (&acc)[2][2][4][2], const Unit& u, int wr, int wc, int fr, int fq) const {
        int row0 = u.pm * 256 + wr * 64 + fr, c0 = u.pn * 256 + wc * 32 + fq * 8; asm volatile("" : "+v"(row0), "+v"(c0));
#pragma unroll
        for (int ai = 0; ai < 2; ++ai) { u32x4 w[4][2];
#pragma unroll
            for (int m = 0; m < 4; ++m)
#pragma unroll
                for (int bj = 0; bj < 2; ++bj) w[m][bj] = *(const u32x4*)(GR + (size_t)(row0 + ai * 128 + m * 16) * 2048 + c0 + bj * 128);
            asm volatile("" ::: "memory");
#pragma unroll
            for (int m = 0; m < 4; ++m)
#pragma unroll
                for (int bj = 0; bj < 2; ++bj) { f32x4 r0, r1; unpack8(w[m][bj], r0, r1); acc[ai][bj][m][0] *= r0; acc[ai][bj][m][1] *= r1; }
            asm volatile("" ::: "memory"); }
    }
    __device__ __forceinline__ void operator()(AccRef acc, const Unit& u, int wr, int wc, int fr, int fq) const {
        const int row0 = u.pm * 256 + wr * 64 + fr, c0 = u.pn * 256 + wc * 32 + fq * 8;
#pragma unroll
        for (int ai = 0; ai < 2; ++ai) { u32x4 w[4][2];
#pragma unroll
            for (int m = 0; m < 4; ++m)
#pragma unroll
                for (int bj = 0; bj < 2; ++bj) w[m][bj] = *(const u32x4*)(GBb + (size_t)(row0 + ai * 128 + m * 16) * 2048 + c0 + bj * 128);
            asm volatile("" ::: "memory");
#pragma unroll
            for (int m = 0; m < 4; ++m)
#pragma unroll
                for (int bj = 0; bj < 2; ++bj) { f32x4 g0, g1; unpack8(w[m][bj], g0, g1); store8(MG + (size_t)(row0 + ai * 128 + m * 16) * 2048 + c0 + bj * 128, acc[ai][bj][m][0] * g0, acc[ai][bj][m][1] * g1); }
            asm volatile("" ::: "memory"); }
    }
};
struct EpiResid {
    static constexpr bool MID = false;
    bf16_t* X; const bf16_t* HB;
    __device__ __forceinline__ void operator()(AccRef acc, const Unit& u, int wr, int wc, int fr, int fq) const {
        const int row0 = u.pm * 256 + wr * 64 + fr, c0 = u.pn * 256 + wc * 32 + fq * 8;
#pragma unroll
        for (int ai = 0; ai < 2; ++ai) { u32x4 w[4][2];
#pragma unroll
            for (int m = 0; m < 4; ++m)
#pragma unroll
                for (int bj = 0; bj < 2; ++bj) w[m][bj] = *(const u32x4*)(HB + (size_t)(row0 + ai * 128 + m * 16) * 2048 + c0 + bj * 128);
            asm volatile("" ::: "memory");
#pragma unroll
            for (int m = 0; m < 4; ++m)
#pragma unroll
                for (int bj = 0; bj < 2; ++bj) { f32x4 h0, h1; unpack8(w[m][bj], h0, h1);
                    store8(X + (size_t)(row0 + ai * 128 + m * 16) * 2048 + c0 + bj * 128, h0 * ALPHA + acc[ai][bj][m][0], h1 * ALPHA + acc[ai][bj][m][1]); }
            asm volatile("" ::: "memory"); }
    }
};
struct EpiSwiglu {
    static constexpr bool MID = false;
    bf16_t* ACT;
    __device__ __forceinline__ void operator()(AccRef acc, const Unit& u, int wr, int wc, int fr, int fq) const {
        const int row0 = u.pm * 256 + wr * 64 + fr, c0 = u.pn * 128 + wc * 32 + fq * 8;
        EPI_AM { const int row = row0 + ai * 128 + m * 16; f32x4 o[2];
#pragma unroll
            for (int n = 0; n < 2; ++n)
#pragma unroll
                for (int j = 0; j < 4; ++j) { const float g = acc[ai][0][m][n][j]; o[n][j] = g * sigmoidf_(g) * acc[ai][1][m][n][j]; }
            store8(ACT + (size_t)row * DFF + c0, o[0], o[1]); }
    }
};
struct EpiMoeDown {
    static constexpr bool MID = false;
    bf16_t* Y; const float* slot_gate;
    __device__ __forceinline__ void operator()(AccRef acc, const Unit& u, int wr, int wc, int fr, int fq) const {
        const int row0 = u.pm * 256 + wr * 64 + fr, c0 = u.pn * 256 + wc * 32 + fq * 8;
        float gt[2][4];
#pragma unroll
        for (int ai = 0; ai < 2; ++ai)
#pragma unroll
            for (int m = 0; m < 4; ++m) gt[ai][m] = slot_gate[row0 + ai * 128 + m * 16];
        asm volatile("" ::: "memory");
#pragma unroll
        for (int ai = 0; ai < 2; ++ai)
#pragma unroll
            for (int m = 0; m < 4; ++m) { const int row = row0 + ai * 128 + m * 16; const float g = gt[ai][m];
#pragma unroll
                for (int bj = 0; bj < 2; ++bj) store8(Y + (size_t)row * 2048 + c0 + bj * 128, acc[ai][bj][m][0] * g, acc[ai][bj][m][1] * g); }
    }
};
#undef EPI_AM
}
namespace att {
typedef unsigned short bf16;
typedef short bf16x8 __attribute__((ext_vector_type(8)));
typedef short s16x4 __attribute__((ext_vector_type(4)));
typedef float f32x16 __attribute__((ext_vector_type(16)));
typedef unsigned u32x4 __attribute__((ext_vector_type(4)));
#define ATT_LAS __attribute__((address_space(3)))
#define SBAR() __builtin_amdgcn_sched_barrier(0)
constexpr int KN_BYTES = 16384, KR_BYTES = 8192, V_BYTES = 16384, BUF_BYTES = KN_BYTES + KR_BYTES + V_BYTES;
constexpr int OFF_KN = 0, OFF_KR = KN_BYTES, OFF_V = KN_BYTES + KR_BYTES;
constexpr int OFF_WS = 2 * BUF_BYTES;
constexpr int OFF_BT = OFF_WS + 8 * 64 * 4;
constexpr int ATT_LDS_BYTES = OFF_BT + 4 * 260 * 4;
constexpr float NEG_BIG = -1e30f;
constexpr float THR2 = 8.f;

__device__ __forceinline__ int crow(int r, int hi) { return (r & 3) + 8 * (r >> 2) + 4 * hi; }
__device__ __forceinline__ unsigned cvtpk(float lo, float hi) { unsigned r; asm volatile("v_cvt_pk_bf16_f32 %0, %1, %2" : "=v"(r) : "v"(lo), "v"(hi)); return r; }
__device__ __forceinline__ int kn_off(int row, int colB) { return row * 256 + (colB ^ ((row & 15) << 4)); }
__device__ __forceinline__ int kr_off(int row, int colB) { return row * 128 + (colB ^ (((row >> 1) & 7) << 4)); }
__device__ __forceinline__ int v_st(int k, int c) { const int kk = (k & ~0xC) | ((k & 4) << 1) | ((k & 8) >> 1); return ((kk >> 3) * 4 + (c >> 5)) * 512 + ((kk & 7) * 32 + (c & 31)) * 2; }
__device__ __forceinline__ int v_rd_base(int lane) { return ((lane & 3) << 3) | (((lane >> 2) & 3) << 6) | (((lane >> 4) & 1) << 5) | (((lane >> 5) & 1) << 8); }
constexpr int v_rd_off(int d0, int ks, int half) { return d0 * 512 + ks * 4096 + half * 2048; }
template <int OFF> __device__ __forceinline__ s16x4 tr_read(int vb) { s16x4 r; asm volatile("ds_read_b64_tr_b16 %0, %1 offset:%2" : "=&v"(r) : "v"(vb), "i"(OFF) : "memory"); return r; }
template <int D0> __device__ __forceinline__ void pv_one(f32x16& od, int vb, bf16x8 pa0, bf16x8 pa1, bf16x8 pa2, bf16x8 pa3) {
    const s16x4 l0 = tr_read<v_rd_off(D0, 0, 0)>(vb), h0 = tr_read<v_rd_off(D0, 0, 1)>(vb), l1 = tr_read<v_rd_off(D0, 1, 0)>(vb), h1 = tr_read<v_rd_off(D0, 1, 1)>(vb);
    const s16x4 l2 = tr_read<v_rd_off(D0, 2, 0)>(vb), h2 = tr_read<v_rd_off(D0, 2, 1)>(vb), l3 = tr_read<v_rd_off(D0, 3, 0)>(vb), h3 = tr_read<v_rd_off(D0, 3, 1)>(vb);
    asm volatile("s_waitcnt lgkmcnt(0)" ::: "memory"); SBAR();
#define PK(L, H) (bf16x8){L[0], L[1], L[2], L[3], H[0], H[1], H[2], H[3]}
    od = __builtin_amdgcn_mfma_f32_32x32x16_bf16(pa0, PK(l0, h0), od, 0, 0, 0);
    od = __builtin_amdgcn_mfma_f32_32x32x16_bf16(pa1, PK(l1, h1), od, 0, 0, 0);
    od = __builtin_amdgcn_mfma_f32_32x32x16_bf16(pa2, PK(l2, h2), od, 0, 0, 0);
    od = __builtin_amdgcn_mfma_f32_32x32x16_bf16(pa3, PK(l3, h3), od, 0, 0, 0);
#undef PK
}
__device__ __forceinline__ void pv_all(f32x16* o, int vb, bf16x8 pa0, bf16x8 pa1, bf16x8 pa2, bf16x8 pa3) {
    pv_one<0>(o[0], vb, pa0, pa1, pa2, pa3); pv_one<1>(o[1], vb, pa0, pa1, pa2, pa3); pv_one<2>(o[2], vb, pa0, pa1, pa2, pa3); pv_one<3>(o[3], vb, pa0, pa1, pa2, pa3);
}
}
namespace att {
constexpr int M2_KSLOT = KN_BYTES + KR_BYTES;
constexpr int M2_OFF_K = 0, M2_OFF_V = 3 * M2_KSLOT;
constexpr int M2_OFF_WS = M2_OFF_V + 3 * V_BYTES;
constexpr int M2_LDS_BYTES = M2_OFF_WS + 8 * 64 * 4;
typedef __attribute__((address_space(3))) unsigned char* lds_ptr;

}
namespace att {
constexpr int M3_NT = 65;
__device__ __forceinline__ void softmax_seg(f32x16& p0, f32x16& p1, float& m_reg, float& l_reg, float& alpha, bf16x8& pa0, bf16x8& pa1, bf16x8& pa2, bf16x8& pa3) {
    float pmax = p0[0];
#pragma unroll
    for (int r = 1; r < 16; ++r) pmax = fmaxf(pmax, p0[r]);
#pragma unroll
    for (int r = 0; r < 16; ++r) pmax = fmaxf(pmax, p1[r]);
    { auto rr = __builtin_amdgcn_permlane32_swap(__float_as_uint(pmax), __float_as_uint(pmax), false, false); pmax = fmaxf(__uint_as_float(rr[0]), __uint_as_float(rr[1])); }
    if (__builtin_expect(__all(pmax - m_reg <= THR2), 1)) { alpha = 1.f; }
    else { const float mn = fmaxf(m_reg, pmax); alpha = __builtin_amdgcn_exp2f(m_reg - mn); m_reg = mn; }
    const float mn = m_reg; float ps = 0.f;
#pragma unroll
    for (int r = 0; r < 16; ++r) { p0[r] = __builtin_amdgcn_exp2f(p0[r] - mn); ps += p0[r]; }
#pragma unroll
    for (int r = 0; r < 16; ++r) { p1[r] = __builtin_amdgcn_exp2f(p1[r] - mn); ps += p1[r]; }
    { auto rr = __builtin_amdgcn_permlane32_swap(__float_as_uint(ps), __float_as_uint(ps), false, false); ps = __uint_as_float(rr[0]) + __uint_as_float(rr[1]); }
    l_reg = l_reg * alpha + ps;
#define PK4(P, BASE, OUT) do { unsigned a0 = cvtpk(P[BASE + 0], P[BASE + 1]), a1 = cvtpk(P[BASE + 2], P[BASE + 3]);   \
    unsigned b0 = cvtpk(P[BASE + 4], P[BASE + 5]), b1 = cvtpk(P[BASE + 6], P[BASE + 7]);                              \
    auto r0 = __builtin_amdgcn_permlane32_swap(a0, b0, false, false); auto r1 = __builtin_amdgcn_permlane32_swap(a1, b1, false, false); \
    u32x4 w = {r0[0], r1[0], r0[1], r1[1]}; OUT = *reinterpret_cast<bf16x8*>(&w); } while (0)
    PK4(p0, 0, pa0); PK4(p0, 8, pa1); PK4(p1, 0, pa2); PK4(p1, 8, pa3);
#undef PK4
}

}
namespace att {
constexpr int S2_OFF_K = 0, S2_OFF_V = 3 * KN_BYTES, S2_OFF_TW = S2_OFF_V + 3 * V_BYTES;
constexpr int S2_OFF_TM = S2_OFF_TW + 4 * 512 * 4, S2_OFF_WS = S2_OFF_TM + 4 * 256 * 4, S2_LDS_BYTES = S2_OFF_WS + 8 * 64 * 4;
__device__ __forceinline__ void swa_unit2(lds_ptr lds, const bf16* __restrict__ QB, const bf16* __restrict__ KB, const bf16* __restrict__ VB, bf16* __restrict__ OAB,
                                          const float* __restrict__ tw_g, const float* __restrict__ tm_g, const float* __restrict__ sink_l2, int b, int hk, int j, int& tables_hk, const int tid_in) {
    int tid_ = tid_in; asm volatile("" : "+v"(tid_)); const int tid = tid_, lane = tid & 63, r32 = lane & 31, hi = lane >> 5; const int wid = __builtin_amdgcn_readfirstlane(tid >> 6);
    const bool metaq = (j == 64);
    const int hq = 4 * hk + (wid >> 1);
    const bool wave_on = !metaq || (wid & 1) == 0;
    const int qpos = metaq ? (r32 & 15) : (NMETA + 64 * j + 32 * (wid & 1) + r32);
    const int qrow = metaq ? (TREAL + 16 * b + (r32 & 15)) : (b * SEQ + 64 * j + 32 * (wid & 1) + r32);
    __attribute__((address_space(3))) float* wsf = (__attribute__((address_space(3))) float*)(lds + S2_OFF_WS) + wid * 64;
    int nt, kt_lo = 0;
    if (metaq) nt = 3; else { kt_lo = j - 2 < 0 ? 0 : j - 2; const int kt_hi = j + 2 > 63 ? 63 : j + 2; nt = 1 + (kt_hi - kt_lo + 1); }
#define S2_KPOS0(t) (metaq ? 64 * (t) : ((t) == 0 ? 0 : NMETA + 64 * (kt_lo + (t) - 1)))
#define S2_ROW(kp) ({ int kp_ = (kp) > LPOS - 1 ? LPOS - 1 : (kp); (kp_ < NMETA ? TREAL + 16 * b + kp_ : b * SEQ + kp_ - NMETA); })
    int kk_k[2], kk_v[2]; unsigned co_k[2], co_v[2];
#pragma unroll
    for (int i = 0; i < 2; ++i) { const int P = 2 * wid + i;
        { const int row = 4 * P + (lane >> 4), c = (lane & 15) ^ (row & 15); kk_k[i] = row; co_k[i] = (unsigned)(c * 16); }
        { const int q = 64 * P + lane, s = q >> 5, kk = (s >> 2) * 8 + ((q & 31) >> 2), col = (s & 3) * 32 + (q & 3) * 8, k = (kk & ~0xC) | ((kk & 4) << 1) | ((kk & 8) >> 1); kk_v[i] = k; co_v[i] = (unsigned)(col * 2); } }
    const char* const kb_h = (const char*)KB + hk * 256; const char* const vb_h = (const char*)VB + hk * 256;
#define S2_DMA(src, dstoff) __builtin_amdgcn_global_load_lds((const unsigned*)(src), (__attribute__((address_space(3))) unsigned*)(lds + (dstoff)), 16, 0, 0)
#define S2_DMA_TILE(t, slot) do { const int kp0_ = S2_KPOS0(t); \
        _Pragma("unroll") for (int i_ = 0; i_ < 2; ++i_) { S2_DMA(kb_h + (size_t)S2_ROW(kp0_ + kk_k[i_]) * 1024 + co_k[i_], S2_OFF_K + (slot) * KN_BYTES + (2 * wid + i_) * 1024); \
                                                          S2_DMA(vb_h + (size_t)S2_ROW(kp0_ + kk_v[i_]) * 1024 + co_v[i_], S2_OFF_V + (slot) * V_BYTES + (2 * wid + i_) * 1024); } } while (0)
#define S2_BAR() do { asm volatile("s_waitcnt lgkmcnt(0)" ::: "memory"); __builtin_amdgcn_s_barrier(); asm volatile("" ::: "memory"); } while (0)
    S2_DMA_TILE(0, 0); S2_DMA_TILE(1, 1); S2_DMA_TILE(2, 2);
    bf16x8 qr[8];
    { const bf16* qp = QB + (size_t)qrow * 2048 + hq * 128 + hi * 8;
#pragma unroll
      for (int d0 = 0; d0 < 8; ++d0) qr[d0] = *reinterpret_cast<const bf16x8*>(qp + d0 * 16); }
    if (tables_hk != hk) {
        __attribute__((address_space(3))) float* tw = (__attribute__((address_space(3))) float*)(lds + S2_OFF_TW); __attribute__((address_space(3))) float* tm = (__attribute__((address_space(3))) float*)(lds + S2_OFF_TM);
        for (int i = tid; i < 4 * 512; i += 512) tw[i] = tw_g[(4 * hk) * 512 + i];
        for (int i = tid; i < 4 * 256; i += 512) tm[i] = tm_g[(4 * hk) * 256 + i];
        tables_hk = hk;
    }
    const int xkn = (r32 & 15) << 4, hb = hi * 16;
    const int vlane = v_rd_base(lane);
    const float sink = sink_l2[hq];
    float m_reg = sink, l_reg = 1.f; f32x16 o[4];
#pragma unroll
    for (int d = 0; d < 4; ++d) o[d] = f32x16{};
    f32x16 p0, p1; bf16x8 pa0, pa1, pa2, pa3;
#define S2_KLD(d, A0, A1) do { const int of_ = (((d) * 32 + hb) ^ xn_); A0 = *(const __attribute__((address_space(3))) bf16x8*)(kb_ + of_); A1 = *(const __attribute__((address_space(3))) bf16x8*)(kb_ + of_ + 8192); } while (0)
#define S2_KMM(d, A0, A1) do { p0 = __builtin_amdgcn_mfma_f32_32x32x16_bf16(A0, qr[d], p0, 0, 0, 0); p1 = __builtin_amdgcn_mfma_f32_32x32x16_bf16(A1, qr[d], p1, 0, 0, 0); } while (0)
    int slot = 0;
    for (int t = 0; t < nt; ++t) {
        { const int ahead = (nt < t + 3 ? nt : t + 3) - t - 1;
          if (ahead >= 2) asm volatile("s_waitcnt vmcnt(8)" ::: "memory"); else if (ahead == 1) asm volatile("s_waitcnt vmcnt(4)" ::: "memory"); else asm volatile("s_waitcnt vmcnt(0)" ::: "memory"); }
        S2_BAR();
        if (wave_on) {
            const int kpos0 = S2_KPOS0(t);
            __builtin_amdgcn_s_setprio(3);
            { int xn_ = xkn; asm volatile("" : "+v"(xn_)); const lds_ptr kb_ = lds + S2_OFF_K + slot * KN_BYTES + r32 * 256; p0 = f32x16{}; p1 = f32x16{};
              bf16x8 k0a, k0b, k1a, k1b, k2a, k2b, k3a, k3b;
              S2_KLD(0, k0a, k0b); S2_KLD(1, k1a, k1b); S2_KLD(2, k2a, k2b); S2_KLD(3, k3a, k3b); SBAR();
              S2_KMM(0, k0a, k0b); S2_KLD(4, k0a, k0b); SBAR(); S2_KMM(1, k1a, k1b); S2_KLD(5, k1a, k1b); SBAR(); S2_KMM(2, k2a, k2b); S2_KLD(6, k2a, k2b); SBAR(); S2_KMM(3, k3a, k3b); S2_KLD(7, k3a, k3b); SBAR();
              S2_KMM(4, k0a, k0b); SBAR(); S2_KMM(5, k1a, k1b); SBAR(); S2_KMM(6, k2a, k2b); SBAR(); S2_KMM(7, k3a, k3b); }
            __builtin_amdgcn_s_setprio(0);
            if (!metaq && t == 0) {
                int base = 4 * hi - qpos; base = base < -256 ? -256 : base;
                const __attribute__((address_space(3))) float* tb = (const __attribute__((address_space(3))) float*)(lds + S2_OFF_TM) + (wid >> 1) * 256 + base + 256;
#pragma unroll
                for (int r = 0; r < 16; ++r) { if (r < 8) p0[r] += tb[(r & 3) + 8 * (r >> 2)]; else p0[r] = NEG_BIG; p1[r] = NEG_BIG; }
            } else {
                const int base = kpos0 + 4 * hi - qpos;
                const __attribute__((address_space(3))) float* tb = (const __attribute__((address_space(3))) float*)(lds + S2_OFF_TW) + (wid >> 1) * 512 + base + 256;
#pragma unroll
                for (int r = 0; r < 16; ++r) { p0[r] += tb[(r & 3) + 8 * (r >> 2)]; p1[r] += tb[(r & 3) + 8 * (r >> 2) + 32]; }
                if (kpos0 + 64 > LPOS) {
#pragma unroll
                    for (int r = 0; r < 16; ++r) { if (kpos0 + crow(r, hi) >= LPOS) p0[r] = NEG_BIG; if (kpos0 + 32 + crow(r, hi) >= LPOS) p1[r] = NEG_BIG; } }
            }
            float alpha; softmax_seg(p0, p1, m_reg, l_reg, alpha, pa0, pa1, pa2, pa3);
            if (__any(alpha < 1.f)) { if (hi == 0) wsf[r32] = alpha; asm volatile("s_waitcnt lgkmcnt(0)" ::: "memory");
#pragma unroll
                for (int d = 0; d < 4; ++d)
#pragma unroll
                    for (int r = 0; r < 16; ++r) o[d][r] *= wsf[crow(r, hi)]; }
            __builtin_amdgcn_s_setprio(3); pv_all(o, (int)(uintptr_t)(lds + S2_OFF_V + slot * V_BYTES) + vlane, pa0, pa1, pa2, pa3); __builtin_amdgcn_s_setprio(0);
        }
        if (t + 3 < nt) { S2_BAR(); S2_DMA_TILE(t + 3, slot); }
        slot = slot == 2 ? 0 : slot + 1;
    }
    if (wave_on) {
        if (hi == 0) wsf[32 + r32] = l_reg; asm volatile("s_waitcnt lgkmcnt(0)" ::: "memory");
        const int orow0 = metaq ? (TREAL + 16 * b) : (b * SEQ + 64 * j + 32 * (wid & 1));
#pragma unroll
        for (int r = 0; r < 16; ++r) { const int rw = crow(r, hi); const float rl = __builtin_amdgcn_rcpf(wsf[32 + rw]);
            if (!metaq || rw < 16) { bf16* op = OAB + (size_t)(orow0 + rw) * 4096 + 2048 + hq * 128 + r32;
#pragma unroll
                for (int d0 = 0; d0 < 4; ++d0) op[d0 * 32] = (bf16)(cvtpk(o[d0][r] * rl, 0.f) & 0xffffu); } }
    }
    asm volatile("s_waitcnt vmcnt(0)" ::: "memory"); S2_BAR();
#undef S2_KPOS0
#undef S2_ROW
#undef S2_DMA
#undef S2_DMA_TILE
#undef S2_BAR
#undef S2_KLD
#undef S2_KMM
}
}
namespace att {
template <int OFF> __device__ __forceinline__ bf16x8 lds_rd128(int addr) { bf16x8 r; asm volatile("ds_read_b128 %0, %1 offset:%2" : "=&v"(r) : "v"(addr), "i"(OFF) : "memory"); return r; }
#define M4_XFULL(KS, VS) do { \
    int xn_ = xkn, xr_ = xkr; asm volatile("" : "+v"(xn_), "+v"(xr_)); \
    const int kbn_ = (int)(uintptr_t)(lds + M2_OFF_K + (KS) * M2_KSLOT) + r32 * 256, kbr_ = (int)(uintptr_t)(lds + M2_OFF_K + (KS) * M2_KSLOT + KN_BYTES) + r32 * 128; \
    const int vb_ = (int)(uintptr_t)(lds + M2_OFF_V + (VS) * V_BYTES) + vlane; (void)vb_; \
    bf16x8 ka0, ka1, ka2, ka3, ka4, kb0, kb1, kb2, kb3, kb4; s16x4 vl0, vl1, vl2, vl3, vl4, vh0, vh1, vh2, vh3, vh4; \
    p0 = f32x16{}; p1 = f32x16{}; \
    { const int a_ = kbn_ + (((0) * 32 + hb) ^ xn_); ka0 = lds_rd128<0>(a_); kb0 = lds_rd128<8192>(a_); } \
    { const int a_ = kbn_ + (((1) * 32 + hb) ^ xn_); ka1 = lds_rd128<0>(a_); kb1 = lds_rd128<8192>(a_); } \
    { const int a_ = kbn_ + (((2) * 32 + hb) ^ xn_); ka2 = lds_rd128<0>(a_); kb2 = lds_rd128<8192>(a_); } \
    { const int a_ = kbn_ + (((3) * 32 + hb) ^ xn_); ka3 = lds_rd128<0>(a_); kb3 = lds_rd128<8192>(a_); } \
    { const int a_ = kbn_ + (((4) * 32 + hb) ^ xn_); ka4 = lds_rd128<0>(a_); kb4 = lds_rd128<8192>(a_); } \
    asm volatile("s_waitcnt lgkmcnt(8)" ::: "memory"); SBAR(); p0 = __builtin_amdgcn_mfma_f32_32x32x16_bf16(ka0, qr[0], p0, 0, 0, 0); p1 = __builtin_amdgcn_mfma_f32_32x32x16_bf16(kb0, qr[0], p1, 0, 0, 0); SBAR(); \
    { const int a_ = kbn_ + (((5) * 32 + hb) ^ xn_); ka0 = lds_rd128<0>(a_); kb0 = lds_rd128<8192>(a_); } \
    asm volatile("s_waitcnt lgkmcnt(8)" ::: "memory"); SBAR(); p0 = __builtin_amdgcn_mfma_f32_32x32x16_bf16(ka1, qr[1], p0, 0, 0, 0); p1 = __builtin_amdgcn_mfma_f32_32x32x16_bf16(kb1, qr[1], p1, 0, 0, 0); SBAR(); \
    { const int a_ = kbn_ + (((6) * 32 + hb) ^ xn_); ka1 = lds_rd128<0>(a_); kb1 = lds_rd128<8192>(a_); } \
    asm volatile("s_waitcnt lgkmcnt(8)" ::: "memory"); SBAR(); p0 = __builtin_amdgcn_mfma_f32_32x32x16_bf16(ka2, qr[2], p0, 0, 0, 0); p1 = __builtin_amdgcn_mfma_f32_32x32x16_bf16(kb2, qr[2], p1, 0, 0, 0); SBAR(); \
    { const int a_ = kbn_ + (((7) * 32 + hb) ^ xn_); ka2 = lds_rd128<0>(a_); kb2 = lds_rd128<8192>(a_); } \
    asm volatile("s_waitcnt lgkmcnt(8)" ::: "memory"); SBAR(); p0 = __builtin_amdgcn_mfma_f32_32x32x16_bf16(ka3, qr[3], p0, 0, 0, 0); p1 = __builtin_amdgcn_mfma_f32_32x32x16_bf16(kb3, qr[3], p1, 0, 0, 0); SBAR(); \
    { const int a_ = kbr_ + (((0) * 32 + hb) ^ xr_); ka3 = lds_rd128<0>(a_); kb3 = lds_rd128<4096>(a_); } \
    asm volatile("s_waitcnt lgkmcnt(8)" ::: "memory"); SBAR(); p0 = __builtin_amdgcn_mfma_f32_32x32x16_bf16(ka4, qr[4], p0, 0, 0, 0); p1 = __builtin_amdgcn_mfma_f32_32x32x16_bf16(kb4, qr[4], p1, 0, 0, 0); SBAR(); \
    { const int a_ = kbr_ + (((1) * 32 + hb) ^ xr_); ka4 = lds_rd128<0>(a_); kb4 = lds_rd128<4096>(a_); } \
    asm volatile("s_waitcnt lgkmcnt(8)" ::: "memory"); SBAR(); p0 = __builtin_amdgcn_mfma_f32_32x32x16_bf16(ka0, qr[5], p0, 0, 0, 0); p1 = __builtin_amdgcn_mfma_f32_32x32x16_bf16(kb0, qr[5], p1, 0, 0, 0); SBAR(); \
    { const int a_ = kbr_ + (((2) * 32 + hb) ^ xr_); ka0 = lds_rd128<0>(a_); kb0 = lds_rd128<4096>(a_); } \
    asm volatile("s_waitcnt lgkmcnt(8)" ::: "memory"); SBAR(); p0 = __builtin_amdgcn_mfma_f32_32x32x16_bf16(ka1, qr[6], p0, 0, 0, 0); p1 = __builtin_amdgcn_mfma_f32_32x32x16_bf16(kb1, qr[6], p1, 0, 0, 0); SBAR(); \
    { const int a_ = kbr_ + (((3) * 32 + hb) ^ xr_); ka1 = lds_rd128<0>(a_); kb1 = lds_rd128<4096>(a_); } \
    asm volatile("s_waitcnt lgkmcnt(8)" ::: "memory"); SBAR(); p0 = __builtin_amdgcn_mfma_f32_32x32x16_bf16(ka2, qr[7], p0, 0, 0, 0); p1 = __builtin_amdgcn_mfma_f32_32x32x16_bf16(kb2, qr[7], p1, 0, 0, 0); SBAR(); \
    { vl2 = tr_read<v_rd_off(0, 0, 0)>(vb_); vh2 = tr_read<v_rd_off(0, 0, 1)>(vb_); } \
    asm volatile("s_waitcnt lgkmcnt(8)" ::: "memory"); SBAR(); p0 = __builtin_amdgcn_mfma_f32_32x32x16_bf16(ka3, qr[8], p0, 0, 0, 0); p1 = __builtin_amdgcn_mfma_f32_32x32x16_bf16(kb3, qr[8], p1, 0, 0, 0); SBAR(); \
    { vl3 = tr_read<v_rd_off(0, 1, 0)>(vb_); vh3 = tr_read<v_rd_off(0, 1, 1)>(vb_); } \
    asm volatile("s_waitcnt lgkmcnt(8)" ::: "memory"); SBAR(); p0 = __builtin_amdgcn_mfma_f32_32x32x16_bf16(ka4, qr[9], p0, 0, 0, 0); p1 = __builtin_amdgcn_mfma_f32_32x32x16_bf16(kb4, qr[9], p1, 0, 0, 0); SBAR(); \
    { vl4 = tr_read<v_rd_off(0, 2, 0)>(vb_); vh4 = tr_read<v_rd_off(0, 2, 1)>(vb_); } \
    asm volatile("s_waitcnt lgkmcnt(8)" ::: "memory"); SBAR(); p0 = __builtin_amdgcn_mfma_f32_32x32x16_bf16(ka0, qr[10], p0, 0, 0, 0); p1 = __builtin_amdgcn_mfma_f32_32x32x16_bf16(kb0, qr[10], p1, 0, 0, 0); SBAR(); \
    { vl0 = tr_read<v_rd_off(0, 3, 0)>(vb_); vh0 = tr_read<v_rd_off(0, 3, 1)>(vb_); } \
    asm volatile("s_waitcnt lgkmcnt(8)" ::: "memory"); SBAR(); p0 = __builtin_amdgcn_mfma_f32_32x32x16_bf16(ka1, qr[11], p0, 0, 0, 0); p1 = __builtin_amdgcn_mfma_f32_32x32x16_bf16(kb1, qr[11], p1, 0, 0, 0); SBAR(); \
    { vl1 = tr_read<v_rd_off(1, 0, 0)>(vb_); vh1 = tr_read<v_rd_off(1, 0, 1)>(vb_); } \
    asm volatile("s_waitcnt lgkmcnt(8)" ::: "memory"); SBAR(); o[0] = __builtin_amdgcn_mfma_f32_32x32x16_bf16(pa0, (bf16x8){vl2[0], vl2[1], vl2[2], vl2[3], vh2[0], vh2[1], vh2[2], vh2[3]}, o[0], 0, 0, 0); SBAR(); \
    { vl2 = tr_read<v_rd_off(1, 1, 0)>(vb_); vh2 = tr_read<v_rd_off(1, 1, 1)>(vb_); } \
    asm volatile("s_waitcnt lgkmcnt(8)" ::: "memory"); SBAR(); o[0] = __builtin_amdgcn_mfma_f32_32x32x16_bf16(pa1, (bf16x8){vl3[0], vl3[1], vl3[2], vl3[3], vh3[0], vh3[1], vh3[2], vh3[3]}, o[0], 0, 0, 0); SBAR(); \
    { vl3 = tr_read<v_rd_off(1, 2, 0)>(vb_); vh3 = tr_read<v_rd_off(1, 2, 1)>(vb_); } \
    asm volatile("s_waitcnt lgkmcnt(8)" ::: "memory"); SBAR(); o[0] = __builtin_amdgcn_mfma_f32_32x32x16_bf16(pa2, (bf16x8){vl4[0], vl4[1], vl4[2], vl4[3], vh4[0], vh4[1], vh4[2], vh4[3]}, o[0], 0, 0, 0); SBAR(); \
    { vl4 = tr_read<v_rd_off(1, 3, 0)>(vb_); vh4 = tr_read<v_rd_off(1, 3, 1)>(vb_); } \
    asm volatile("s_waitcnt lgkmcnt(8)" ::: "memory"); SBAR(); o[0] = __builtin_amdgcn_mfma_f32_32x32x16_bf16(pa3, (bf16x8){vl0[0], vl0[1], vl0[2], vl0[3], vh0[0], vh0[1], vh0[2], vh0[3]}, o[0], 0, 0, 0); SBAR(); \
    { vl0 = tr_read<v_rd_off(2, 0, 0)>(vb_); vh0 = tr_read<v_rd_off(2, 0, 1)>(vb_); } \
    asm volatile("s_waitcnt lgkmcnt(8)" ::: "memory"); SBAR(); o[1] = __builtin_amdgcn_mfma_f32_32x32x16_bf16(pa0, (bf16x8){vl1[0], vl1[1], vl1[2], vl1[3], vh1[0], vh1[1], vh1[2], vh1[3]}, o[1], 0, 0, 0); SBAR(); \
    { vl1 = tr_read<v_rd_off(2, 1, 0)>(vb_); vh1 = tr_read<v_rd_off(2, 1, 1)>(vb_); } \
    asm volatile("s_waitcnt lgkmcnt(8)" ::: "memory"); SBAR(); o[1] = __builtin_amdgcn_mfma_f32_32x32x16_bf16(pa1, (bf16x8){vl2[0], vl2[1], vl2[2], vl2[3], vh2[0], vh2[1], vh2[2], vh2[3]}, o[1], 0, 0, 0); SBAR(); \
    { vl2 = tr_read<v_rd_off(2, 2, 0)>(vb_); vh2 = tr_read<v_rd_off(2, 2, 1)>(vb_); } \
    asm volatile("s_waitcnt lgkmcnt(8)" ::: "memory"); SBAR(); o[1] = __builtin_amdgcn_mfma_f32_32x32x16_bf16(pa2, (bf16x8){vl3[0], vl3[1], vl3[2], vl3[3], vh3[0], vh3[1], vh3[2], vh3[3]}, o[1], 0, 0, 0); SBAR(); \
    { vl3 = tr_read<v_rd_off(2, 3, 0)>(vb_); vh3 = tr_read<v_rd_off(2, 3, 1)>(vb_); } \
    asm volatile("s_waitcnt lgkmcnt(8)" ::: "memory"); SBAR(); o[1] = __builtin_amdgcn_mfma_f32_32x32x16_bf16(pa3, (bf16x8){vl4[0], vl4[1], vl4[2], vl4[3], vh4[0], vh4[1], vh4[2], vh4[3]}, o[1], 0, 0, 0); SBAR(); \
    { vl4 = tr_read<v_rd_off(3, 0, 0)>(vb_); vh4 = tr_read<v_rd_off(3, 0, 1)>(vb_); } \
    asm volatile("s_waitcnt lgkmcnt(8)" ::: "memory"); SBAR(); o[2] = __builtin_amdgcn_mfma_f32_32x32x16_bf16(pa0, (bf16x8){vl0[0], vl0[1], vl0[2], vl0[3], vh0[0], vh0[1], vh0[2], vh0[3]}, o[2], 0, 0, 0); SBAR(); \
    { vl0 = tr_read<v_rd_off(3, 1, 0)>(vb_); vh0 = tr_read<v_rd_off(3, 1, 1)>(vb_); } \
    asm volatile("s_waitcnt lgkmcnt(8)" ::: "memory"); SBAR(); o[2] = __builtin_amdgcn_mfma_f32_32x32x16_bf16(pa1, (bf16x8){vl1[0], vl1[1], vl1[2], vl1[3], vh1[0], vh1[1], vh1[2], vh1[3]}, o[2], 0, 0, 0); SBAR(); \
    { vl1 = tr_read<v_rd_off(3, 2, 0)>(vb_); vh1 = tr_read<v_rd_off(3, 2, 1)>(vb_); } \
    asm volatile("s_waitcnt lgkmcnt(8)" ::: "memory"); SBAR(); o[2] = __builtin_amdgcn_mfma_f32_32x32x16_bf16(pa2, (bf16x8){vl2[0], vl2[1], vl2[2], vl2[3], vh2[0], vh2[1], vh2[2], vh2[3]}, o[2], 0, 0, 0); SBAR(); \
    { vl2 = tr_read<v_rd_off(3, 3, 0)>(vb_); vh2 = tr_read<v_rd_off(3, 3, 1)>(vb_); } \
    asm volatile("s_waitcnt lgkmcnt(8)" ::: "memory"); SBAR(); o[2] = __builtin_amdgcn_mfma_f32_32x32x16_bf16(pa3, (bf16x8){vl3[0], vl3[1], vl3[2], vl3[3], vh3[0], vh3[1], vh3[2], vh3[3]}, o[2], 0, 0, 0); SBAR(); \
    asm volatile("s_waitcnt lgkmcnt(6)" ::: "memory"); SBAR(); o[3] = __builtin_amdgcn_mfma_f32_32x32x16_bf16(pa0, (bf16x8){vl4[0], vl4[1], vl4[2], vl4[3], vh4[0], vh4[1], vh4[2], vh4[3]}, o[3], 0, 0, 0); SBAR(); \
    asm volatile("s_waitcnt lgkmcnt(4)" ::: "memory"); SBAR(); o[3] = __builtin_amdgcn_mfma_f32_32x32x16_bf16(pa1, (bf16x8){vl0[0], vl0[1], vl0[2], vl0[3], vh0[0], vh0[1], vh0[2], vh0[3]}, o[3], 0, 0, 0); SBAR(); \
    asm volatile("s_waitcnt lgkmcnt(2)" ::: "memory"); SBAR(); o[3] = __builtin_amdgcn_mfma_f32_32x32x16_bf16(pa2, (bf16x8){vl1[0], vl1[1], vl1[2], vl1[3], vh1[0], vh1[1], vh1[2], vh1[3]}, o[3], 0, 0, 0); SBAR(); \
    asm volatile("s_waitcnt lgkmcnt(0)" ::: "memory"); SBAR(); o[3] = __builtin_amdgcn_mfma_f32_32x32x16_bf16(pa3, (bf16x8){vl2[0], vl2[1], vl2[2], vl2[3], vh2[0], vh2[1], vh2[2], vh2[3]}, o[3], 0, 0, 0); SBAR(); \
} while (0)
#define M4_XFIRST(KS, VS) do { \
    int xn_ = xkn, xr_ = xkr; asm volatile("" : "+v"(xn_), "+v"(xr_)); \
    const int kbn_ = (int)(uintptr_t)(lds + M2_OFF_K + (KS) * M2_KSLOT) + r32 * 256, kbr_ = (int)(uintptr_t)(lds + M2_OFF_K + (KS) * M2_KSLOT + KN_BYTES) + r32 * 128; \
    const int vb_ = (int)(uintptr_t)(lds + M2_OFF_V + (VS) * V_BYTES) + vlane; (void)vb_; \
    bf16x8 ka0, ka1, ka2, ka3, ka4, kb0, kb1, kb2, kb3, kb4; s16x4 vl0, vl1, vl2, vl3, vl4, vh0, vh1, vh2, vh3, vh4; \
    p0 = f32x16{}; p1 = f32x16{}; \
    { const int a_ = kbn_ + (((0) * 32 + hb) ^ xn_); ka0 = lds_rd128<0>(a_); kb0 = lds_rd128<8192>(a_); } \
    { const int a_ = kbn_ + (((1) * 32 + hb) ^ xn_); ka1 = lds_rd128<0>(a_); kb1 = lds_rd128<8192>(a_); } \
    { const int a_ = kbn_ + (((2) * 32 + hb) ^ xn_); ka2 = lds_rd128<0>(a_); kb2 = lds_rd128<8192>(a_); } \
    { const int a_ = kbn_ + (((3) * 32 + hb) ^ xn_); ka3 = lds_rd128<0>(a_); kb3 = lds_rd128<8192>(a_); } \
    { const int a_ = kbn_ + (((4) * 32 + hb) ^ xn_); ka4 = lds_rd128<0>(a_); kb4 = lds_rd128<8192>(a_); } \
    asm volatile("s_waitcnt lgkmcnt(8)" ::: "memory"); SBAR(); p0 = __builtin_amdgcn_mfma_f32_32x32x16_bf16(ka0, qr[0], p0, 0, 0, 0); p1 = __builtin_amdgcn_mfma_f32_32x32x16_bf16(kb0, qr[0], p1, 0, 0, 0); SBAR(); \
    { const int a_ = kbn_ + (((5) * 32 + hb) ^ xn_); ka0 = lds_rd128<0>(a_); kb0 = lds_rd128<8192>(a_); } \
    asm volatile("s_waitcnt lgkmcnt(8)" ::: "memory"); SBAR(); p0 = __builtin_amdgcn_mfma_f32_32x32x16_bf16(ka1, qr[1], p0, 0, 0, 0); p1 = __builtin_amdgcn_mfma_f32_32x32x16_bf16(kb1, qr[1], p1, 0, 0, 0); SBAR(); \
    { const int a_ = kbn_ + (((6) * 32 + hb) ^ xn_); ka1 = lds_rd128<0>(a_); kb1 = lds_rd128<8192>(a_); } \
    asm volatile("s_waitcnt lgkmcnt(8)" ::: "memory"); SBAR(); p0 = __builtin_amdgcn_mfma_f32_32x32x16_bf16(ka2, qr[2], p0, 0, 0, 0); p1 = __builtin_amdgcn_mfma_f32_32x32x16_bf16(kb2, qr[2], p1, 0, 0, 0); SBAR(); \
    { const int a_ = kbn_ + (((7) * 32 + hb) ^ xn_); ka2 = lds_rd128<0>(a_); kb2 = lds_rd128<8192>(a_); } \
    asm volatile("s_waitcnt lgkmcnt(8)" ::: "memory"); SBAR(); p0 = __builtin_amdgcn_mfma_f32_32x32x16_bf16(ka3, qr[3], p0, 0, 0, 0); p1 = __builtin_amdgcn_mfma_f32_32x32x16_bf16(kb3, qr[3], p1, 0, 0, 0); SBAR(); \
    { const int a_ = kbr_ + (((0) * 32 + hb) ^ xr_); ka3 = lds_rd128<0>(a_); kb3 = lds_rd128<4096>(a_); } \
    asm volatile("s_waitcnt lgkmcnt(8)" ::: "memory"); SBAR(); p0 = __builtin_amdgcn_mfma_f32_32x32x16_bf16(ka4, qr[4], p0, 0, 0, 0); p1 = __builtin_amdgcn_mfma_f32_32x32x16_bf16(kb4, qr[4], p1, 0, 0, 0); SBAR(); \
    { const int a_ = kbr_ + (((1) * 32 + hb) ^ xr_); ka4 = lds_rd128<0>(a_); kb4 = lds_rd128<4096>(a_); } \
    asm volatile("s_waitcnt lgkmcnt(8)" ::: "memory"); SBAR(); p0 = __builtin_amdgcn_mfma_f32_32x32x16_bf16(ka0, qr[5], p0, 0, 0, 0); p1 = __builtin_amdgcn_mfma_f32_32x32x16_bf16(kb0, qr[5], p1, 0, 0, 0); SBAR(); \
    { const int a_ = kbr_ + (((2) * 32 + hb) ^ xr_); ka0 = lds_rd128<0>(a_); kb0 = lds_rd128<4096>(a_); } \
    asm volatile("s_waitcnt lgkmcnt(8)" ::: "memory"); SBAR(); p0 = __builtin_amdgcn_mfma_f32_32x32x16_bf16(ka1, qr[6], p0, 0, 0, 0); p1 = __builtin_amdgcn_mfma_f32_32x32x16_bf16(kb1, qr[6], p1, 0, 0, 0); SBAR(); \
    { const int a_ = kbr_ + (((3) * 32 + hb) ^ xr_); ka1 = lds_rd128<0>(a_); kb1 = lds_rd128<4096>(a_); } \
    asm volatile("s_waitcnt lgkmcnt(8)" ::: "memory"); SBAR(); p0 = __builtin_amdgcn_mfma_f32_32x32x16_bf16(ka2, qr[7], p0, 0, 0, 0); p1 = __builtin_amdgcn_mfma_f32_32x32x16_bf16(kb2, qr[7], p1, 0, 0, 0); SBAR(); \
    asm volatile("s_waitcnt lgkmcnt(6)" ::: "memory"); SBAR(); p0 = __builtin_amdgcn_mfma_f32_32x32x16_bf16(ka3, qr[8], p0, 0, 0, 0); p1 = __builtin_amdgcn_mfma_f32_32x32x16_bf16(kb3, qr[8], p1, 0, 0, 0); SBAR(); \
    asm volatile("s_waitcnt lgkmcnt(4)" ::: "memory"); SBAR(); p0 = __builtin_amdgcn_mfma_f32_32x32x16_bf16(ka4, qr[9], p0, 0, 0, 0); p1 = __builtin_amdgcn_mfma_f32_32x32x16_bf16(kb4, qr[9], p1, 0, 0, 0); SBAR(); \
    asm volatile("s_waitcnt lgkmcnt(2)" ::: "memory"); SBAR(); p0 = __builtin_amdgcn_mfma_f32_32x32x16_bf16(ka0, qr[10], p0, 0, 0, 0); p1 = __builtin_amdgcn_mfma_f32_32x32x16_bf16(kb0, qr[10], p1, 0, 0, 0); SBAR(); \
    asm volatile("s_waitcnt lgkmcnt(0)" ::: "memory"); SBAR(); p0 = __builtin_amdgcn_mfma_f32_32x32x16_bf16(ka1, qr[11], p0, 0, 0, 0); p1 = __builtin_amdgcn_mfma_f32_32x32x16_bf16(kb1, qr[11], p1, 0, 0, 0); SBAR(); \
} while (0)

__device__ __forceinline__ void mla_unit4(lds_ptr lds, const bf16* __restrict__ Q, const bf16* __restrict__ KN, const bf16* __restrict__ KR, const bf16* __restrict__ V, bf16* __restrict__ OAB, int b, int h, int qb, const int tid_in) {
    int tid_ = tid_in; asm volatile("" : "+v"(tid_)); const int tid = tid_, lane = tid & 63, r32 = lane & 31, hi = lane >> 5; const int wid = __builtin_amdgcn_readfirstlane(tid >> 6);
    const bool metaq = (qb == 16);
    const bool wave_on = !metaq || wid == 0;
    const int qrow = metaq ? (TREAL + 16 * b + (r32 & 15)) : (b * SEQ + qb * 256 + wid * 32 + r32);
    __attribute__((address_space(3))) float* wsf = (__attribute__((address_space(3))) float*)(lds + M2_OFF_WS) + wid * 64;
    unsigned so_kn[2], so_kr, so_v[2];
#pragma unroll
    for (int i = 0; i < 2; ++i) { const int P = 2 * wid + i;
        { const int row = 4 * P + (lane >> 4), c = (lane & 15) ^ (row & 15); so_kn[i] = (unsigned)(row * 4096 + c * 16); }
        { const int q = 64 * P + lane, s = q >> 5, kk = (s >> 2) * 8 + ((q & 31) >> 2), col = (s & 3) * 32 + (q & 3) * 8, k = (kk & ~0xC) | ((kk & 4) << 1) | ((kk & 8) >> 1); so_v[i] = (unsigned)(k * 4096 + col * 2); } }
    { const int row = 8 * wid + (lane >> 3), c = (lane & 7) ^ ((row >> 1) & 7); so_kr = (unsigned)(row * 128 + c * 16); }
    const char* const kn_h = (const char*)KN + h * 256; const char* const v_h = (const char*)V + h * 256; const char* const kr_b = (const char*)KR;
    const size_t real0 = (size_t)b * SEQ, meta0 = (size_t)TREAL + 16 * b;
#define M3_ROW(t) ((t) == 0 ? meta0 : real0 + (size_t)((t) - 1) * 64)
#define M3_DMA(src, dstoff) __builtin_amdgcn_global_load_lds((const unsigned*)(src), (__attribute__((address_space(3))) unsigned*)(lds + (dstoff)), 16, 0, 0)
#define M3_DMA_K(t, slot) do { const size_t g_ = M3_ROW(t); const int so_ = M2_OFF_K + (slot) * M2_KSLOT; \
        M3_DMA(kn_h + g_ * 4096 + so_kn[0], so_ + (2 * wid) * 1024); M3_DMA(kn_h + g_ * 4096 + so_kn[1], so_ + (2 * wid + 1) * 1024); M3_DMA(kr_b + g_ * 128 + so_kr, so_ + KN_BYTES + wid * 1024); } while (0)
#define M3_DMA_V(t, slot) do { const size_t g_ = M3_ROW(t); const int so_ = M2_OFF_V + (slot) * V_BYTES; \
        M3_DMA(v_h + g_ * 4096 + so_v[0], so_ + (2 * wid) * 1024); M3_DMA(v_h + g_ * 4096 + so_v[1], so_ + (2 * wid + 1) * 1024); } while (0)
#define M3_WAIT(n) asm volatile("s_waitcnt vmcnt(" #n ")" ::: "memory")
#define M3_BAR() do { asm volatile("" ::: "memory"); __builtin_amdgcn_s_barrier(); asm volatile("" ::: "memory"); } while (0)
#define M3_EVENT(i, s3) do { if ((i) + 2 < M3_NT) M3_DMA_K((i) + 2, (s3) == 0 ? 2 : (s3) - 1); if ((i) + 1 < M3_NT) M3_DMA_V((i) + 1, (s3) == 2 ? 0 : (s3) + 1); } while (0)
#define M3_WAITI(i) do { if ((i) < M3_NT - 2) M3_WAIT(5); else M3_WAIT(0); } while (0)
    M3_DMA_K(0, 0); M3_DMA_V(0, 0); M3_DMA_K(1, 1);
    bf16x8 qr[12];
    { const bf16* qp = Q + (size_t)qrow * 3072 + h * 192 + hi * 8;
#pragma unroll
      for (int d0 = 0; d0 < 12; ++d0) qr[d0] = *reinterpret_cast<const bf16x8*>(qp + d0 * 16); }
    const int xkn = (r32 & 15) << 4, xkr = ((r32 >> 1) & 7) << 4, hb = hi * 16;
    const int vlane = v_rd_base(lane);
#define M3_PV(slot) pv_all(o, (int)(uintptr_t)(lds + M2_OFF_V + (slot) * V_BYTES) + vlane, pa0, pa1, pa2, pa3)
#define M3_Y(j) do { if (wave_on) { if ((j) == 0) { _Pragma("unroll") for (int r = 0; r < 16; ++r) { if (crow(r, hi) >= 16) p0[r] = NEG_BIG; p1[r] = NEG_BIG; } } \
        float alpha_; softmax_seg(p0, p1, m_reg, l_reg, alpha_, pa0, pa1, pa2, pa3); \
        if (__any(alpha_ < 1.f)) { if (hi == 0) wsf[r32] = alpha_; asm volatile("s_waitcnt lgkmcnt(0)" ::: "memory"); \
            _Pragma("unroll") for (int d = 0; d < 4; ++d) _Pragma("unroll") for (int r = 0; r < 16; ++r) o[d][r] *= wsf[crow(r, hi)]; } } } while (0)
    float m_reg = NEG_BIG, l_reg = 0.f; f32x16 o[4];
#pragma unroll
    for (int d = 0; d < 4; ++d) o[d] = f32x16{};
    f32x16 p0, p1; bf16x8 pa0, pa1, pa2, pa3;
    int s3 = 0;
    if (wid < 4) {
        M3_WAITI(0); M3_BAR();
        if (wave_on) M4_XFIRST(0, 0);
        M3_BAR(); M3_EVENT(0, 0);
        M3_Y(0);
        s3 = 1;
        for (int j = 1; j < M3_NT; ++j) {
            M3_WAITI(j); M3_BAR();
            if (wave_on) { __builtin_amdgcn_s_setprio(3); M4_XFULL(s3, (s3 == 0 ? 2 : s3 - 1)); __builtin_amdgcn_s_setprio(0); }
            M3_BAR(); M3_EVENT(j, s3);
            M3_Y(j);
            s3 = s3 == 2 ? 0 : s3 + 1;
        }
        M3_BAR();
        if (wave_on) M3_PV(s3 == 0 ? 2 : s3 - 1);
        M3_BAR();
    } else {
        M3_WAITI(0); M3_BAR(); M3_EVENT(0, 0);
        M3_BAR();
        if (wave_on) M4_XFIRST(0, 0);
        M3_WAITI(1); M3_BAR(); M3_EVENT(1, 1);
        M3_Y(0);
        s3 = 1;
        for (int j = 1; j < M3_NT; ++j) {
            M3_BAR();
            if (wave_on) { __builtin_amdgcn_s_setprio(3); M4_XFULL(s3, (s3 == 0 ? 2 : s3 - 1)); __builtin_amdgcn_s_setprio(0); }
            M3_WAITI(j + 1); M3_BAR(); { const int s3n = s3 == 2 ? 0 : s3 + 1; M3_EVENT(j + 1, s3n); }
            M3_Y(j);
            s3 = s3 == 2 ? 0 : s3 + 1;
        }
        M3_BAR();
        if (wave_on) M3_PV(s3 == 0 ? 2 : s3 - 1);
    }
    if (wave_on) {
        if (hi == 0) wsf[32 + r32] = l_reg; asm volatile("s_waitcnt lgkmcnt(0)" ::: "memory");
        const int orow0 = metaq ? (TREAL + 16 * b) : (b * SEQ + qb * 256 + wid * 32);
#pragma unroll
        for (int r = 0; r < 16; ++r) { const int rw = crow(r, hi); const float rl = __builtin_amdgcn_rcpf(wsf[32 + rw]);
            if (!metaq || rw < 16) { bf16* op = OAB + (size_t)(orow0 + rw) * 4096 + h * 128 + r32;
#pragma unroll
                for (int d0 = 0; d0 < 4; ++d0) op[d0 * 32] = (bf16)(cvtpk(o[d0][r] * rl, 0.f) & 0xffffu); } }
    }
    M3_WAIT(0); M3_BAR();
#undef M3_ROW
#undef M3_DMA
#undef M3_DMA_K
#undef M3_DMA_V
#undef M3_WAIT
#undef M3_BAR
#undef M3_EVENT
#undef M3_WAITI
#undef M3_PV
#undef M3_Y
}
#undef M4_XFULL
#undef M4_XFIRST
}
constexpr int NWAVES = 8;
constexpr int N_PHASES = 20;
constexpr size_t MiB = 1u << 20, KiB32 = 32768;
constexpr size_t WS_CTL = 0, CTL_ZERO_BYTES = 65536;
constexpr size_t WS_CS = 1 * MiB, WS_SN = WS_CS + 540672;
constexpr size_t WS_BIAS = 3 * MiB;
constexpr size_t WS_TW = WS_BIAS, WS_TM = WS_BIAS + 32768, WS_SINK = WS_BIAS + 49152;
constexpr size_t WS_WHIST = WS_BIAS + 65536;
constexpr size_t WS_TOPI = 4 * MiB, WS_TOPG = WS_TOPI + 262144, WS_TOKSLOT = WS_TOPG + 262144;
constexpr size_t WS_SLOTTOK = 5 * MiB, WS_SLOTGATE = WS_SLOTTOK + 294912;
constexpr size_t WS_SSQ = 6 * MiB;
constexpr size_t WS_HB = 9 * MiB;
constexpr size_t WS_W = 138 * MiB;
constexpr size_t WL_IN = 0, WL_UQ = 34 * MiB, WL_UKV = WL_UQ + 9 * MiB / 2, WL_AB = WL_UKV + 4 * MiB, WL_OUT = WL_AB + 16 * MiB, WL_STRIDE = WL_OUT + 8 * MiB;
constexpr size_t WS_WF13 = WS_W + 2 * WL_STRIDE, WS_WF2 = WS_WF13 + 44 * MiB, WS_WEND = WS_WF2 + 22 * MiB;
constexpr size_t AR = 337 * MiB;
constexpr size_t WS_CQ = AR, WS_CKV = WS_CQ + 1548 * KiB32, WS_KR = WS_CKV + 1032 * KiB32, WS_QB = WS_KR + 132 * KiB32;
constexpr size_t WS_KB = WS_QB + 129 * MiB, WS_VB = WS_KB + 1032 * KiB32, WS_GR = WS_VB + 1032 * KiB32, WS_GBB = WS_GR + 129 * MiB;
constexpr size_t WS_Q = WS_GBB + 129 * MiB, WS_KN = WS_Q + 6192 * KiB32  , WS_V = WS_KN + 129 * MiB, WS_OAB = WS_V + 129 * MiB, WS_MIX_END = WS_OAB + 258 * MiB;
constexpr size_t WS_MG = WS_Q;
constexpr size_t WS_X = WS_OAB;
constexpr size_t WS_ACT = AR;
constexpr size_t WS_MW13 = 138 * MiB, WS_MW2 = WS_MW13 + 8 * 44 * MiB;
constexpr size_t WS_MACT = WS_MW2 + 8 * 22 * MiB;
constexpr size_t WS_Y = WS_MACT + 726 * MiB;
constexpr size_t WS_END = WS_Y + 264 * MiB;
static_assert(WS_MIX_END <= 1700 * MiB && WS_END <= 1700 * MiB, "d_ws map");
static_assert(WS_ACT + (size_t)TP * DFF * 2 <= WS_X, "dense ACT vs X");
static_assert(WS_SSQ + (size_t)TP * 20 * 4 <= WS_HB && WS_SLOTGATE + 294912 <= WS_SSQ && WS_TOKSLOT + 262144 <= WS_SLOTTOK && WS_SN + 540672 <= WS_BIAS, "small tables");
static_assert(WS_KR + (size_t)TP * 64 * 2 <= WS_QB, "KR");
constexpr int CW_TMO = 0, CW_CODE = 1;
constexpr int CW_MOE_TS = 64;
constexpr int CW_BAR = 4096;
constexpr int RING_OFF = 0, RING_BYTES = 131072;
constexpr int LDSCTL_OFF = RING_BYTES, MISC_OFF = LDSCTL_OFF + 320, PT_OFF = LDSCTL_OFF + 512;
constexpr int LDS_BYTES = 147456;
static_assert(att::ATT_LDS_BYTES <= RING_BYTES && att::M2_LDS_BYTES <= RING_BYTES && att::S2_LDS_BYTES <= RING_BYTES, "attention LDS");

#define GAS __attribute__((address_space(1)))
#define LAS __attribute__((address_space(3)))
typedef unsigned short bf16;
typedef unsigned v4u __attribute__((ext_vector_type(4)));
typedef unsigned v2u __attribute__((ext_vector_type(2)));
typedef float f32x4 __attribute__((ext_vector_type(4)));
typedef GAS unsigned gu32;
#define RLX_AGENT __ATOMIC_RELAXED, __HIP_MEMORY_SCOPE_AGENT
#define LDS_WAIT() asm volatile("s_waitcnt lgkmcnt(0)" ::: "memory")
#define VM_WAIT() asm volatile("s_waitcnt vmcnt(0)" ::: "memory")
__device__ __forceinline__ unsigned f2bf(float f) { unsigned u = __builtin_bit_cast(unsigned, f); return (u + 0x7fffu + ((u >> 16) & 1u)) >> 16; }
__device__ __forceinline__ unsigned pk2(float lo, float hi) { return f2bf(lo) | (f2bf(hi) << 16); }

#define XB_TMO      128
#define XB_XCNT(j)  (256  + 64 * (j))
#define XB_XSUB(j)  (1280 + 64 * (j))
#define XB_XGEN(j)  (2304 + 64 * (j))
#define XB_TOP      3328
#define XB_TOPGEN   3392
#define XCD_BAR_WORDS 3456
#define XB_SPIN_CAP (1u << 22)
__device__ __forceinline__ unsigned xb_ld(unsigned* p)              { return __hip_atomic_load(p, __ATOMIC_RELAXED, __HIP_MEMORY_SCOPE_AGENT); }
__device__ __forceinline__ unsigned xb_add(unsigned* p, unsigned v) { return __hip_atomic_fetch_add(p, v, __ATOMIC_RELAXED, __HIP_MEMORY_SCOPE_AGENT); }
__device__ __forceinline__ unsigned xb_xcc_id() { return (unsigned)__builtin_amdgcn_s_getreg((3 << 11) | 20) & 0xFu; }
#define XB_SPIN(cond, bar) do { unsigned _sp = 0; while (cond) { __builtin_amdgcn_s_sleep(1); \
    if ((++_sp & 255u) == 0u) { if (xb_ld(&(bar)[XB_TMO])) break; if (_sp > XB_SPIN_CAP) { atomicAdd(&(bar)[XB_TMO], 1u); break; } } } } while (0)
struct XcdBarrier { unsigned* bar; unsigned x; volatile LAS unsigned* st; };
__device__ __forceinline__ XcdBarrier xcd_barrier_post(unsigned* bar, volatile LAS unsigned* st, const int tid) {
    XcdBarrier b; b.bar = bar; b.x = xb_xcc_id(); b.st = st;
    if (tid == 0) (void)xb_add(&bar[XB_XCNT(b.x)], 1u);
    return b;
}
__device__ __forceinline__ void xcd_barrier_complete(unsigned* bar, unsigned x, unsigned& nloc, unsigned& nx) {
    const unsigned G = gridDim.x * gridDim.y * gridDim.z;
    unsigned sum, cnt, mine, sp = 0u;
    for (;;) {
        sum = 0u; cnt = 0u; mine = 0u;
#pragma unroll
        for (unsigned j = 0; j < 16; ++j) { const unsigned c = xb_ld(&bar[XB_XCNT(j)]); sum += c; cnt += (c > 0u) ? 1u : 0u; mine = (j == x) ? c : mine; }
        if (sum == G) break;
        __builtin_amdgcn_s_sleep(1);
        if ((++sp & 255u) == 0u) { if (xb_ld(&bar[XB_TMO])) break; if (sp > XB_SPIN_CAP) { atomicAdd(&bar[XB_TMO], 1u); break; } }
    }
    nloc = mine > 0u ? mine : 1u; nx = cnt > 0u ? cnt : 1u;
}
__device__ __forceinline__ void xcd_barrier(const XcdBarrier& b, const int tid) {
    asm volatile("s_waitcnt vmcnt(0)" ::: "memory");
    __syncthreads();
    if (tid == 0) {
        unsigned* bar = b.bar;
        __builtin_amdgcn_s_waitcnt(0);
        unsigned nloc = b.st[0], nx = b.st[1];
        if (nloc == 0u) { xcd_barrier_complete(bar, b.x, nloc, nx); b.st[0] = nloc; b.st[1] = nx; }
        const unsigned old = xb_add(&bar[XB_XSUB(b.x)], 1u);
        const unsigned gen = old / nloc;
        if (old + 1u == (gen + 1u) * nloc) {
            __builtin_amdgcn_fence(__ATOMIC_RELEASE, "agent");
            asm volatile("s_waitcnt vmcnt(0)" ::: "memory");
            const unsigned og = xb_add(&bar[XB_TOP], 1u);
            const unsigned tg = og / nx;
            if (og + 1u == (tg + 1u) * nx) xb_add(&bar[XB_TOPGEN], 1u);
            else XB_SPIN(xb_ld(&bar[XB_TOPGEN]) == tg, bar);
            __builtin_amdgcn_fence(__ATOMIC_ACQUIRE, "agent");
            xb_add(&bar[XB_XGEN(b.x)], 1u);
            asm volatile("s_waitcnt vmcnt(0)" ::: "memory");
        } else {
            XB_SPIN(xb_ld(&bar[XB_XGEN(b.x)]) == gen, bar);
            __builtin_amdgcn_fence(__ATOMIC_ACQUIRE, "agent");
            asm volatile("s_waitcnt vmcnt(0)" ::: "memory");
        }
    }
    __syncthreads();
}

__device__ __forceinline__ int lane_id() { int l; asm volatile("v_mbcnt_lo_u32_b32 %0, -1, 0\n\tv_mbcnt_hi_u32_b32 %0, -1, %0" : "=v"(l)); return l; }
__device__ __forceinline__ float wave_sum(float v) {
#pragma unroll
    for (int o = 1; o < 64; o <<= 1) v += __shfl_xor(v, o);
    return v;
}
__device__ __forceinline__ void transpose_item(const float* __restrict__ W, int ldw, int k0, int n0, bf16* __restrict__ WT, size_t ldt, int drow, int koff, const float* __restrict__ g, LAS float* scr, int lane) {
    const int kr = lane >> 3, c4 = (lane & 7) * 4;
    f32x4 v[8];
#pragma unroll
    for (int i = 0; i < 8; ++i) v[i] = *(const GAS f32x4*)(W + (size_t)(k0 + 8 * i + kr) * ldw + n0 + c4);
    if (g) {
#pragma unroll
        for (int i = 0; i < 8; ++i) v[i] = v[i] * g[k0 + 8 * i + kr]; }
#pragma unroll
    for (int i = 0; i < 8; ++i) { LAS float* d = scr + (8 * i + kr) * 33 + c4; d[0] = v[i].x; d[1] = v[i].y; d[2] = v[i].z; d[3] = v[i].w; }
    LDS_WAIT(); asm volatile("" ::: "memory");
    const int c = lane & 7;
#pragma unroll
    for (int j = 0; j < 4; ++j) { const int n = (lane >> 3) + 8 * j; const LAS float* s = scr + (8 * c) * 33 + n;
        v4u o; o.x = pk2(s[0 * 33], s[1 * 33]); o.y = pk2(s[2 * 33], s[3 * 33]); o.z = pk2(s[4 * 33], s[5 * 33]); o.w = pk2(s[6 * 33], s[7 * 33]);
        *(GAS v4u*)(WT + (size_t)(drow + n) * ldt + koff + k0 + 8 * c) = o; }
    LDS_WAIT(); asm volatile("" ::: "memory");
}
struct TDesc { const float* W; bf16* WT; size_t ldt; int ldw, k0, n0, drow; };
__device__ __forceinline__ void t_load(const TDesc& d, f32x4 (&v)[8], int lane) {
    const int kr = lane >> 3, c4 = (lane & 7) * 4;
#pragma unroll
    for (int i = 0; i < 8; ++i) v[i] = *(const GAS f32x4*)(d.W + (size_t)(d.k0 + 8 * i + kr) * d.ldw + d.n0 + c4);
}
__device__ __forceinline__ void t_finish(const TDesc& d, const f32x4 (&v)[8], LAS float* scr, int lane) {
    const int kr = lane >> 3, c4 = (lane & 7) * 4;
#pragma unroll
    for (int i = 0; i < 8; ++i) { LAS float* p = scr + (8 * i + kr) * 33 + c4; p[0] = v[i].x; p[1] = v[i].y; p[2] = v[i].z; p[3] = v[i].w; }
    LDS_WAIT(); asm volatile("" ::: "memory");
    const int c = lane & 7;
#pragma unroll
    for (int j = 0; j < 4; ++j) { const int n = (lane >> 3) + 8 * j; const LAS float* s = scr + (8 * c) * 33 + n;
        v4u o; o.x = pk2(s[0 * 33], s[1 * 33]); o.y = pk2(s[2 * 33], s[3 * 33]); o.z = pk2(s[4 * 33], s[5 * 33]); o.w = pk2(s[6 * 33], s[7 * 33]);
        *(GAS v4u*)(d.WT + (size_t)(d.drow + n) * d.ldt + d.k0 + 8 * c) = o; }
    LDS_WAIT(); asm volatile("" ::: "memory");
}
__device__ __forceinline__ int dmap_in(int n0) {
    if (n0 < 1280) return n0;
    if (n0 < 1312) return 1280;
    if (n0 < 1344) return 1280 + 128;
    if (n0 < 3392) return 1536 + (n0 - 1344);
    if (n0 < 3904) return 3584 + (n0 - 3392);
    if (n0 < 4416) return 4096 + (n0 - 3904);
    if (n0 < 6464) { const int a = n0 - 4416; return 4608 + 256 * (a >> 7) + (a & 127); }
    const int a = n0 - 6464; return 4608 + 256 * (a >> 7) + 128 + (a & 127);
}
__device__ __forceinline__ int dmap_uq(int n0) {
    const int head = n0 / 192, off = n0 - head * 192;
    if (off < 128) return 256 * (head >> 1) + 128 * (head & 1) + off;
    if (off < 160) return 256 * (8 + (head >> 2)) + 32 * (head & 3);
    return 256 * (8 + (head >> 2)) + 128 + 32 * (head & 3);
}
__device__ __forceinline__ int dmap_glu(int n0) { return 256 * (n0 >> 7) + (n0 & 127); }
struct Row8 { f32x4 v[8]; };
__device__ __forceinline__ void ln_normalize(Row8& r) {
    float s = 0.f;
#pragma unroll
    for (int j = 0; j < 8; ++j) s += (r.v[j].x + r.v[j].y) + (r.v[j].z + r.v[j].w);
    const float mean = wave_sum(s) * (1.f / D); float s2 = 0.f;
#pragma unroll
    for (int j = 0; j < 8; ++j) { r.v[j] = r.v[j] - mean; s2 += (r.v[j].x * r.v[j].x + r.v[j].y * r.v[j].y) + (r.v[j].z * r.v[j].z + r.v[j].w * r.v[j].w); }
    const float rstd = 1.f / sqrtf(wave_sum(s2) * (1.f / D) + LN_EPS);
#pragma unroll
    for (int j = 0; j < 8; ++j) r.v[j] = r.v[j] * rstd;
}
__device__ __forceinline__ void ln_affine(Row8& r, const float* __restrict__ g, const float* __restrict__ b, int lane) {
#pragma unroll
    for (int jj = 0; jj < 4; ++jj) { const f32x4* gp = (const f32x4*)g + 2 * (lane + 64 * jj); const f32x4* bp = (const f32x4*)b + 2 * (lane + 64 * jj);
        r.v[2 * jj] = r.v[2 * jj] * gp[0] + bp[0]; r.v[2 * jj + 1] = r.v[2 * jj + 1] * gp[1] + bp[1]; }
}
__device__ __forceinline__ void row_store_bf16(const Row8& r, bf16* orow, int lane) {
#pragma unroll
    for (int jj = 0; jj < 4; ++jj) { v4u w; w.x = pk2(r.v[2 * jj].x, r.v[2 * jj].y); w.y = pk2(r.v[2 * jj].z, r.v[2 * jj].w); w.z = pk2(r.v[2 * jj + 1].x, r.v[2 * jj + 1].y); w.w = pk2(r.v[2 * jj + 1].z, r.v[2 * jj + 1].w);
        *((GAS v4u*)orow + lane + 64 * jj) = w; }
}
__device__ __forceinline__ void row_load_f32(Row8& r, const float* xrow, int lane) {
#pragma unroll
    for (int jj = 0; jj < 4; ++jj) { const GAS f32x4* p = (const GAS f32x4*)xrow + 2 * (lane + 64 * jj); r.v[2 * jj] = p[0]; r.v[2 * jj + 1] = p[1]; }
}
__device__ __forceinline__ f32x4 bf4(v2u w);
__device__ __forceinline__ void bf8(v4u w, f32x4& a, f32x4& b) { a = bf4((v2u){w.x, w.y}); b = bf4((v2u){w.z, w.w}); }
__device__ __forceinline__ void row_load_bf16(Row8& r, const bf16* xrow, int lane) {
#pragma unroll
    for (int jj = 0; jj < 4; ++jj) bf8(*((const GAS v4u*)xrow + lane + 64 * jj), r.v[2 * jj], r.v[2 * jj + 1]);
}
__device__ __forceinline__ void row_store_f32(const Row8& r, float* orow, int lane) {
#pragma unroll
    for (int jj = 0; jj < 4; ++jj) { GAS f32x4* p = (GAS f32x4*)orow + 2 * (lane + 64 * jj); p[0] = r.v[2 * jj]; p[1] = r.v[2 * jj + 1]; }
}
__device__ __forceinline__ f32x4 bf4(v2u w) { return (f32x4){__uint_as_float(w.x << 16), __uint_as_float(w.x & 0xffff0000u), __uint_as_float(w.y << 16), __uint_as_float(w.y & 0xffff0000u)}; }
__device__ __forceinline__ int t5_bucket(int rel) {
    const int n = rel < 0 ? -rel : rel; int v;
    if (n < 8) v = n; else if (n < 12) v = 8; else if (n < 16) v = 9; else if (n < 23) v = 10; else if (n < 32) v = 11; else if (n < 46) v = 12; else if (n < 64) v = 13; else if (n < 91) v = 14; else v = 15;
    return (rel > 0 ? 16 : 0) + v;
}

__device__ __forceinline__ void router_row(const Row8& r, const LAS f32x4* rwl, const float* __restrict__ rbias, int lane, int& i0, int& i1, float& g0, float& g1) {
    float lg[8];
#pragma unroll
    for (int e = 0; e < 8; ++e) lg[e] = 0.f;
#pragma unroll
    for (int j = 0; j < 8; ++j) {
#pragma unroll
        for (int q = 0; q < 4; ++q) { const f32x4 w0 = rwl[(j * 4 + q) * 64 + lane], w1 = rwl[2048 + (j * 4 + q) * 64 + lane]; const float y = r.v[j][q];
            lg[0] += y * w0.x; lg[1] += y * w0.y; lg[2] += y * w0.z; lg[3] += y * w0.w; lg[4] += y * w1.x; lg[5] += y * w1.y; lg[6] += y * w1.z; lg[7] += y * w1.w; } }
#pragma unroll
    for (int e = 0; e < 8; ++e) lg[e] = wave_sum(lg[e]) + rbias[e];
    i0 = 0; float v0 = lg[0];
#pragma unroll
    for (int e = 1; e < 8; ++e) if (lg[e] > v0) { v0 = lg[e]; i0 = e; }
    i1 = -1; float v1 = -3.0e38f;
#pragma unroll
    for (int e = 0; e < 8; ++e) if (e != i0 && lg[e] > v1) { v1 = lg[e]; i1 = e; }
    const float e1 = __expf(v1 - v0); g0 = 1.f / (1.f + e1); g1 = e1 / (1.f + e1);
}
enum { I_X = 0, I_META, I_EMB_G, I_EMB_B, I_RELB, I_WIN, I_QNG, I_KVNG, I_WUQ, I_WUKV, I_SINK, I_WPA, I_WPB, I_WOUT, I_LMG, I_LMB, I_LFG, I_LFB,
       I_FW1, I_FW3, I_FW2, I_RW, I_RB, I_MW1, I_MW3, I_MW2, N_IN };
struct Args { const float* in[N_IN]; float* out; unsigned char* ws; int ph_lo, ph_hi; };

__global__ void __launch_bounds__(NWAVES * 64, 2) mk_fwd(Args args) {
    extern __shared__ __attribute__((aligned(16))) unsigned char lds_raw[];
    LAS unsigned char* const lds = (LAS unsigned char*)lds_raw;
    char* const ldsg = (char*)lds_raw;
    volatile LAS unsigned* const MISC = (volatile LAS unsigned*)(lds + MISC_OFF);
    const int wave = __builtin_amdgcn_readfirstlane((int)threadIdx.x >> 6);
    const int tid = wave * 64 + lane_id();
    const int G_k = gridDim.x; const int bx_k = blockIdx.x;
    for (int u = tid; u < (LDS_BYTES - LDSCTL_OFF) / 4; u += NWAVES * 64) ((LAS unsigned*)(lds + LDSCTL_OFF))[u] = 0u;
    __syncthreads();
    volatile LAS unsigned long long* const PT = (volatile LAS unsigned long long*)(lds + PT_OFF);
    if (tid == 0) {
#pragma unroll
        for (int i = 0; i < N_IN; ++i) PT[i] = (unsigned long long)args.in[i];
        PT[N_IN] = (unsigned long long)args.out; PT[N_IN + 1] = (unsigned long long)args.ws; }
    const int lo = args.ph_lo, hi = args.ph_hi;
    __syncthreads();
#define LDP(i) ({ const unsigned long long v_ = PT[i]; (unsigned long long)(unsigned)__builtin_amdgcn_readfirstlane((int)(unsigned)v_) | ((unsigned long long)(unsigned)__builtin_amdgcn_readfirstlane((int)(unsigned)(v_ >> 32)) << 32); })
#define INP(i) ((const float*)(const GAS float*)LDP(i))
#define WSP() ((unsigned char*)(GAS unsigned char*)LDP(N_IN + 1))
#define OUTP() ((float*)(GAS float*)LDP(N_IN))
#define PH_WS() int* SLOT_TOK; float* SLOT_GATE; int* TOK_SLOT; asm volatile("" ::: "memory"); int tid = wave * 64 + lane_id(); asm volatile("" : "+v"(tid)); const int lane = tid & 63; (void)lane; \
    int G = G_k, bx = bx_k; asm volatile("" : "+s"(G), "+s"(bx));     \
    const int vcu = (G % 8 == 0) ? (bx % 8) * (G / 8) + bx / 8 : bx; const int gw = vcu * NWAVES + wave, NGW = G * NWAVES; (void)gw; (void)NGW; (void)vcu; unsigned char* const ws = WSP(); \
    bf16* const HB = (bf16*)(ws + WS_HB); float* const CS = (float*)(ws + WS_CS); float* const SN = (float*)(ws + WS_SN); float* const SSQ = (float*)(ws + WS_SSQ); bf16* const X = (bf16*)(ws + WS_X); \
    SLOT_TOK = (int*)(ws + WS_SLOTTOK); SLOT_GATE = (float*)(ws + WS_SLOTGATE); TOK_SLOT = (int*)(ws + WS_TOKSLOT); (void)HB; (void)CS; (void)SN; (void)SSQ; (void)X; (void)SLOT_TOK; (void)SLOT_GATE; (void)TOK_SLOT
    XcdBarrier bar; { unsigned char* const ws0 = WSP(); bar.bar = (unsigned*)(ws0 + WS_CTL) + CW_BAR; bar.x = 0; bar.st = nullptr;
    if (hi - lo > 1) bar = xcd_barrier_post((unsigned*)(ws0 + WS_CTL) + CW_BAR, MISC + 8, tid); }
#define IN(k) (lo <= (k) && (k) < hi)
#define SEAM(k) do { if (IN(k) && IN((k) + 1)) xcd_barrier(bar, wave * 64 + lane_id()); } while (0)

    if (IN(0)) { PH_WS();
        LAS float* scr = (LAS float*)(lds + RING_OFF + wave * 16384);
        constexpr int I_IN = (D / 64) * (INDIM / 32), I_UQ = (QRANK / 64) * (3072 / 32), I_UKV = (KVRANK / 64) * (4096 / 32), I_SQ = (D / 64) * (D / 32), I_LAYER = I_IN + I_UQ + I_UKV + 3 * I_SQ;
        constexpr int I_F = (D / 64) * (DFF / 32), I_F2 = (DFF / 64) * (D / 32), NITEMS = 2 * I_LAYER + 2 * I_F + I_F2;
        for (int it = gw; it < NITEMS; it += NGW) {
            int r = it;
            if (r < 2 * I_LAYER) { const int l = r / I_LAYER; r -= l * I_LAYER; unsigned char* wl = ws + WS_W + l * WL_STRIDE;
                if (r < I_IN) { const int nblk = INDIM / 32, kb = r / nblk, nb = r % nblk; transpose_item(INP(I_WIN) + (size_t)l * D * INDIM, INDIM, 64 * kb, 32 * nb, (bf16*)(ws + WS_W + l * WL_STRIDE + WL_IN), D, dmap_in(32 * nb), 0, nullptr, scr, lane); continue; } r -= I_IN;
                if (r < I_UQ) { const int nblk = 3072 / 32, kb = r / nblk, nb = r % nblk; transpose_item(INP(I_WUQ) + (size_t)l * QRANK * 3072, 3072, 64 * kb, 32 * nb, (bf16*)(ws + WS_W + l * WL_STRIDE + WL_UQ), QRANK, dmap_uq(32 * nb), 0, INP(I_QNG) + l * QRANK, scr, lane); continue; } r -= I_UQ;
                if (r < I_UKV) { const int nblk = 4096 / 32, kb = r / nblk, nb = r % nblk; transpose_item(INP(I_WUKV) + (size_t)l * KVRANK * 4096, 4096, 64 * kb, 32 * nb, (bf16*)(ws + WS_W + l * WL_STRIDE + WL_UKV), KVRANK, 32 * nb, 0, INP(I_KVNG) + l * KVRANK, scr, lane); continue; } r -= I_UKV;
                { const int which = r / I_SQ; r -= which * I_SQ; const int nblk = D / 32, kb = r / nblk, nb = r % nblk;
                  if (which == 0) transpose_item(INP(I_WPA) + (size_t)l * D * D, D, 64 * kb, 32 * nb, (bf16*)(ws + WS_W + l * WL_STRIDE + WL_AB), 2 * D, 32 * nb, 0, nullptr, scr, lane);
                  else if (which == 1) transpose_item(INP(I_WPB) + (size_t)l * D * D, D, 64 * kb, 32 * nb, (bf16*)(ws + WS_W + l * WL_STRIDE + WL_AB), 2 * D, 32 * nb, D, nullptr, scr, lane);
                  else transpose_item(INP(I_WOUT) + (size_t)l * D * D, D, 64 * kb, 32 * nb, (bf16*)(ws + WS_W + l * WL_STRIDE + WL_OUT), D, 32 * nb, 0, nullptr, scr, lane);
                  continue; }
            }
            r -= 2 * I_LAYER;
            if (r < 2 * I_F) { const int which = r / I_F; r -= which * I_F; const int nblk = DFF / 32, kb = r / nblk, nb = r % nblk;
                transpose_item(INP(which ? I_FW3 : I_FW1), DFF, 64 * kb, 32 * nb, (bf16*)(ws + WS_WF13), D, dmap_glu(32 * nb) + (which ? 128 : 0), 0, nullptr, scr, lane); continue; }
            r -= 2 * I_F;
            { const int nblk = D / 32, kb = r / nblk, nb = r % nblk; transpose_item(INP(I_FW2), D, 64 * kb, 32 * nb, (bf16*)(ws + WS_WF2), DFF, 32 * nb, 0, nullptr, scr, lane); }
        }
        for (int i = gw * 64 + lane; i < 2 * 192 * 256; i += NGW * 64) { const int l = i / (192 * 256), q = i % (192 * 256), rr = q / 256, c16 = q % 256; const int row = rr < 96 ? 1312 + rr : 1440 + (rr - 96);
            *(GAS v4u*)(ws + WS_W + l * WL_STRIDE + WL_IN + (size_t)row * (D * 2) + c16 * 16) = (v4u){0u, 0u, 0u, 0u}; }
        for (int i = gw * 64 + lane; i < LPOS * 32; i += NGW * 64) { const int pos = i >> 5, k = i & 31; const float inv = powf(10000.f, -(float)(2 * k) / 64.f); const float ang = (float)pos * inv; CS[i] = cosf(ang); SN[i] = sinf(ang); }
        for (int i = gw * 64 + lane; i < 16 * 512; i += NGW * 64) { const int hh = i >> 9, rel = (i & 511) - 256; const float bv = INP(I_RELB)[t5_bucket(rel) * 16 + hh] * LOG2E;
            ((float*)(ws + WS_TW))[i] = (rel >= -128 && rel <= 128) ? bv : att::NEG_BIG; if (rel < 0) ((float*)(ws + WS_TM))[hh * 256 + rel + 256] = bv; }
        if (gw == 0 && lane < 32) ((float*)(ws + WS_SINK))[lane] = INP(I_SINK)[lane] * LOG2E;
        { const float* eg = INP(I_EMB_G); const float* eb = INP(I_EMB_B); const float* xin = INP(I_X); const float* min_ = INP(I_META);
#define P0_LOAD(R, m) row_load_f32(R, (m) < TREAL ? xin + (size_t)(m) * D : min_ + (size_t)(((m) - TREAL) & 15) * D, lane)
#define P0_PROC(R, m) do { ln_normalize(R); ln_affine(R, eg, eb, lane); row_store_bf16(R, HB + (size_t)(m) * D, lane); } while (0)
          Row8 ra{}, rb{}; int m = gw; if (m < T) P0_LOAD(ra, m);
          for (; m < T; m += 2 * NGW) { const int m1 = m + NGW, m2 = m + 2 * NGW; if (m1 < T) P0_LOAD(rb, m1); P0_PROC(ra, m); if (m1 < T) { if (m2 < T) P0_LOAD(ra, m2); P0_PROC(rb, m1); } }
#undef P0_LOAD
#undef P0_PROC
          for (int mz = T + gw; mz < TP; mz += NGW) { GAS v2u* o8 = (GAS v2u*)(HB + (size_t)mz * D) + lane;
#pragma unroll
              for (int j = 0; j < 8; ++j) o8[64 * j] = (v2u){0u, 0u}; } }
    }
    SEAM(0);

#pragma unroll 1
    for (int l = 0; l < 2; ++l) {
        const int P = 1 + 9 * l + (l ? 0 : 0);
        const int nM_all = TREAL / 256;
        const int nM_post = TREAL / 256; const bool tail_post = (l == 0);
        if (IN(P + 0)) { PH_WS();
            ProbDense pr; pr.so.init(nM_all, NIN / 256, G, bx, true); pr.A = (const char*)HB; pr.Bt = (const char*)(ws + WS_W + l * WL_STRIDE + WL_IN); pr.tstep = 256 * (size_t)D * 2;
            epi::EpiWin E{(bf16*)(ws + WS_CQ), (bf16*)(ws + WS_CKV), (bf16*)(ws + WS_KR), (bf16*)(ws + WS_QB), (bf16*)(ws + WS_KB), (bf16*)(ws + WS_VB), (bf16*)(ws + WS_GR), (bf16*)(ws + WS_GBB), SSQ, CS, SN};
            pg8::gemm_phase<epi::EpiWin, ProbDense>(lds + RING_OFF, D, pr, E, tid);
        }
        SEAM(P + 0);
        if (IN(P + 1)) { PH_WS();
            { ProbDense pr; pr.so.init(nM_all, 3072 / 256, G, bx, true); pr.A = (const char*)(ws + WS_CQ); pr.Bt = (const char*)(ws + WS_W + l * WL_STRIDE + WL_UQ); pr.tstep = 256 * (size_t)QRANK * 2;
              epi::EpiUq E{(bf16*)(ws + WS_Q), SSQ, CS, SN};
              pg8::gemm_phase<epi::EpiUq, ProbDense>(lds + RING_OFF, QRANK, pr, E, tid); }
            { ProbDense pr; pr.so.init(nM_all, 4096 / 256, G, bx, true); pr.A = (const char*)(ws + WS_CKV); pr.Bt = (const char*)(ws + WS_W + l * WL_STRIDE + WL_UKV); pr.tstep = 256 * (size_t)KVRANK * 2;
              epi::EpiUkv E{(bf16*)(ws + WS_KN), (bf16*)(ws + WS_V), SSQ};
              pg8::gemm_phase<epi::EpiUkv, ProbDense>(lds + RING_OFF, KVRANK, pr, E, tid); }
        }
        SEAM(P + 1);
        if (IN(P + 2)) { PH_WS();
            const int nqb = l == 0 ? 17 : 16, nmla_full = NB * NH * 16, nmla = NB * NH * nqb;
            for (int u = vcu; u < nmla; u += G) {
                int b, h, qb;
                if (u < nmla_full) { qb = u & 15; h = (u >> 4) & 15; b = u >> 8; } else { const int v = u - nmla_full; qb = 16; h = v & 15; b = v >> 4; }
                att::mla_unit4((att::lds_ptr)(lds + RING_OFF), (const bf16*)(ws + WS_Q), (const bf16*)(ws + WS_KN), (const bf16*)(ws + WS_KR), (const bf16*)(ws + WS_V), (bf16*)(ws + WS_OAB), b, h, qb, tid);
            }
            const int nj = l == 0 ? 65 : 64, nswa_full = NB * 4 * 64, nswa = NB * 4 * nj;
            int tables_hk = -1;
            for (int u = vcu; u < nswa; u += G) {
                int b, hk, j;
                if (u < nswa_full) { j = u & 63; hk = (u >> 6) & 3; b = u >> 8; } else { const int v = u - nswa_full; j = 64; hk = v & 3; b = v >> 2; }
                att::swa_unit2((att::lds_ptr)(lds + RING_OFF), (const bf16*)(ws + WS_QB), (const bf16*)(ws + WS_KB), (const bf16*)(ws + WS_VB), (bf16*)(ws + WS_OAB), (const float*)(ws + WS_TW), (const float*)(ws + WS_TM), (const float*)(ws + WS_SINK) + 16 * l, b, hk, j, tables_hk, tid);
            }
        }
        SEAM(P + 2);
        if (IN(P + 3)) { PH_WS();
            ProbDense pr; pr.so.init(nM_post, D / 256, G, bx, tail_post); pr.A = (const char*)(ws + WS_OAB); pr.Bt = (const char*)(ws + WS_W + l * WL_STRIDE + WL_AB); pr.tstep = 256 * (size_t)(2 * D) * 2;
            epi::EpiProj E{(bf16*)(ws + WS_MG), (const bf16*)(ws + WS_GR), (const bf16*)(ws + WS_GBB)};
            pg8::gemm_phase<epi::EpiProj, ProbDense>(lds + RING_OFF, 2 * D, pr, E, tid);
        }
        SEAM(P + 3);
        if (IN(P + 4)) { PH_WS();
            ProbDense pr; pr.so.init(nM_post, D / 256, G, bx, tail_post); pr.A = (const char*)(ws + WS_MG); pr.Bt = (const char*)(ws + WS_W + l * WL_STRIDE + WL_OUT); pr.tstep = 256 * (size_t)D * 2;
            epi::EpiResid E{X, HB};
            pg8::gemm_phase<epi::EpiResid, ProbDense>(lds + RING_OFF, D, pr, E, tid);
        }
        SEAM(P + 4);
        if (IN(P + 5)) { PH_WS();
            const float* g = INP(I_LMG) + l * D; const float* bta = INP(I_LMB) + l * D;
            const int nrows = l == 0 ? T : TREAL;
            int h0 = 0, h1 = 0, h2 = 0, h3 = 0, h4 = 0, h5 = 0, h6 = 0, h7 = 0;
            LAS f32x4* const rwl = (LAS f32x4*)(lds + RING_OFF);
            if (l == 1) { const GAS f32x4* rwg = (const GAS f32x4*)INP(I_RW); for (int i = tid; i < D * 2; i += NWAVES * 64) { const int k = i >> 1, hf = i & 1, e = k & 7, jq = (2 * (k >> 9) + (e >> 2)) * 4 + (e & 3); rwl[hf * 2048 + jq * 64 + ((k >> 3) & 63)] = rwg[i]; } __syncthreads(); }
#define LM_PROC(r, m) do { ln_normalize(r); ln_affine(r, g, bta, lane); row_store_bf16(r, HB + (size_t)(m) * D, lane); \
                if (l == 1) { int i0_, i1_; float g0_, g1_; router_row(r, rwl, rbias, lane, i0_, i1_, g0_, g1_); \
                    if (lane == 0) { int* ti = (int*)(ws + WS_TOPI); float* tg = (float*)(ws + WS_TOPG); ti[2 * (m)] = i0_; ti[2 * (m) + 1] = i1_; tg[2 * (m)] = g0_; tg[2 * (m) + 1] = g1_; } \
                    h0 += (i0_ == 0) + (i1_ == 0); h1 += (i0_ == 1) + (i1_ == 1); h2 += (i0_ == 2) + (i1_ == 2); h3 += (i0_ == 3) + (i1_ == 3); \
                    h4 += (i0_ == 4) + (i1_ == 4); h5 += (i0_ == 5) + (i1_ == 5); h6 += (i0_ == 6) + (i1_ == 6); h7 += (i0_ == 7) + (i1_ == 7); } } while (0)
            { const float* rbias = INP(I_RB); Row8 ra{}, rb{}; int m = gw; if (m < nrows) row_load_bf16(ra, X + (size_t)m * D, lane);
              for (; m < nrows; m += 2 * NGW) { const int m1 = m + NGW, m2 = m + 2 * NGW; if (m1 < nrows) row_load_bf16(rb, X + (size_t)m1 * D, lane); LM_PROC(ra, m);
                  if (m1 < nrows) { if (m2 < nrows) row_load_bf16(ra, X + (size_t)m2 * D, lane); LM_PROC(rb, m1); } } }
#undef LM_PROC
            if (l == 1 && lane == 0) { int* wh = (int*)(ws + WS_WHIST) + gw * 8; wh[0] = h0; wh[1] = h1; wh[2] = h2; wh[3] = h3; wh[4] = h4; wh[5] = h5; wh[6] = h6; wh[7] = h7; }
        }
        SEAM(P + 5);
        if (l == 0) {
            if (IN(P + 6)) { PH_WS();
                ProbDense pr; pr.so.init(nM_all, 2 * DFF / 256, G, bx, true); pr.A = (const char*)HB; pr.Bt = (const char*)(ws + WS_WF13); pr.tstep = 256 * (size_t)D * 2;
                epi::EpiSwiglu E{(bf16*)(ws + WS_ACT)};
                pg8::gemm_phase<epi::EpiSwiglu, ProbDense>(lds + RING_OFF, D, pr, E, tid);
            }
            SEAM(P + 6);
            if (IN(P + 7)) { PH_WS();
                ProbDense pr; pr.so.init(nM_all, D / 256, G, bx, true); pr.A = (const char*)(ws + WS_ACT); pr.Bt = (const char*)(ws + WS_WF2); pr.tstep = 256 * (size_t)DFF * 2;
                epi::EpiResid E{X, HB};
                pg8::gemm_phase<epi::EpiResid, ProbDense>(lds + RING_OFF, DFF, pr, E, tid);
            }
            SEAM(P + 7);
            if (IN(P + 8)) { PH_WS();
                const float* g = INP(I_LFG); const float* bta = INP(I_LFB);
#define LF_PROC(r, m) do { ln_normalize(r); ln_affine(r, g, bta, lane); row_store_bf16(r, HB + (size_t)(m) * D, lane); } while (0)
                { Row8 ra{}, rb{}; int m = gw; if (m < T) row_load_bf16(ra, X + (size_t)m * D, lane);
                  for (; m < T; m += 2 * NGW) { const int m1 = m + NGW, m2 = m + 2 * NGW; if (m1 < T) row_load_bf16(rb, X + (size_t)m1 * D, lane); LF_PROC(ra, m);
                      if (m1 < T) { if (m2 < T) row_load_bf16(ra, X + (size_t)m2 * D, lane); LF_PROC(rb, m1); } } }
#undef LF_PROC
            }
            SEAM(P + 8);
        } else {
            if (IN(P + 6)) { PH_WS();
                LAS int* hist = (LAS int*)(lds + RING_OFF);
                LAS int* segsum = hist + 2048 * 8;
                LAS int* segpre = segsum + 64 * 8;
                LAS int* tot = segpre + 64 * 8;
                const int* wh = (const int*)(ws + WS_WHIST);
                for (int i = tid; i < NGW * 8; i += NWAVES * 64) hist[i] = wh[i];
                __syncthreads();
                { const int e = tid & 7, seg = tid >> 3; int s = 0;
_Pragma("unroll 1")
                  for (int w = 0; w < 32; ++w) { const int ww = seg * 32 + w; if (ww < NGW) s += hist[ww * 8 + e]; } segsum[seg * 8 + e] = s; }
                __syncthreads();
                if (tid < 8) { int run = 0;
_Pragma("unroll 1")
                    for (int s = 0; s < 64; ++s) { segpre[s * 8 + tid] = run; run += segsum[s * 8 + tid]; } tot[tid] = run; }
                __syncthreads();
                if (tid == 0) { int ts = 0; for (int e = 0; e < 8; ++e) { tot[8 + e] = ts; ts += (tot[e] + 255) >> 8; } tot[16] = ts;
                    if (bx == 0) for (int e = 0; e < 9; ++e) ((int*)(ws + WS_CTL))[CW_MOE_TS + e] = tot[8 + e]; }
                __syncthreads();
                int base = 0;
                if (lane < 8) { base = tot[8 + lane] * 256 + segpre[(gw >> 5) * 8 + lane];
_Pragma("unroll 1")
                    for (int w = (gw & ~31); w < gw; ++w) base += hist[w * 8 + lane]; }
                const int* ti = (const int*)(ws + WS_TOPI); const float* tg = (const float*)(ws + WS_TOPG);
                for (int m = gw; m < TREAL; m += NGW) {
#pragma unroll
                    for (int k = 0; k < 2; ++k) { const int e = __builtin_amdgcn_readfirstlane(ti[2 * m + k]); const float gt = tg[2 * m + k];
                        const int slot = __builtin_amdgcn_readlane(base, e); if (lane == e) base += 1;
                        if (lane == 0) { SLOT_TOK[slot] = m; SLOT_GATE[slot] = gt; TOK_SLOT[2 * m + k] = slot; } }
                }
                if (vcu < 8) { const int e = vcu; const int s0 = tot[8 + e] * 256 + tot[e], s1 = tot[8 + e + 1] * 256; for (int s = s0 + tid; s < s1; s += NWAVES * 64) { SLOT_TOK[s] = T; SLOT_GATE[s] = 0.f; } }
                __syncthreads();
                LAS float* scr = (LAS float*)(lds + RING_OFF + wave * 16384);
                constexpr int I_F = (D / 64) * (DFF / 32), I_F2 = (DFF / 64) * (D / 32), I_E = 2 * I_F + I_F2;
                { const float* mw1 = INP(I_MW1); const float* mw3 = INP(I_MW3); const float* mw2 = INP(I_MW2);
#define MOE_DESC(d, it_) do { const int e_ = (it_) / I_E; int r_ = (it_) - e_ * I_E; \
                    if (r_ < 2 * I_F) { const int wh_ = r_ / I_F; r_ -= wh_ * I_F; const int kb_ = r_ / (DFF / 32), nb_ = r_ % (DFF / 32); \
                        d.W = (wh_ ? mw3 : mw1) + (size_t)e_ * D * DFF; d.ldw = DFF; d.k0 = 64 * kb_; d.n0 = 32 * nb_; d.WT = (bf16*)(ws + WS_MW13) + (size_t)e_ * 2 * DFF * D; d.ldt = D; d.drow = dmap_glu(32 * nb_) + (wh_ ? 128 : 0); } \
                    else { r_ -= 2 * I_F; const int kb_ = r_ / (D / 32), nb_ = r_ % (D / 32); \
                        d.W = mw2 + (size_t)e_ * DFF * D; d.ldw = D; d.k0 = 64 * kb_; d.n0 = 32 * nb_; d.WT = (bf16*)(ws + WS_MW2) + (size_t)e_ * D * DFF; d.ldt = DFF; d.drow = 32 * nb_; } } while (0)
                  constexpr int NIT = NE * I_E; TDesc da{}, db{}; f32x4 va[8] = {}, vb[8] = {};
                  int it = gw; if (it < NIT) { MOE_DESC(da, it); t_load(da, va, lane); }
                  for (; it < NIT; it += 2 * NGW) { const int it1 = it + NGW, it2 = it + 2 * NGW;
                      if (it1 < NIT) { MOE_DESC(db, it1); t_load(db, vb, lane); }
                      t_finish(da, va, scr, lane);
                      if (it1 < NIT) { if (it2 < NIT) { MOE_DESC(da, it2); t_load(da, va, lane); } t_finish(db, vb, scr, lane); } }
#undef MOE_DESC
                }
            }
            SEAM(P + 6);
            MoeTiles mt;
            if (IN(P + 7) || IN(P + 8)) { unsigned char* const ws = WSP();
#pragma unroll
                for (int e = 0; e < 9; ++e) mt.ts[e] = __builtin_amdgcn_readfirstlane(((const int*)(ws + WS_CTL))[CW_MOE_TS + e]);
            } else {
#pragma unroll
                for (int e = 0; e < 9; ++e) mt.ts[e] = 0;
            }
            if (IN(P + 7)) { PH_WS();
                ProbMoe1 pr; pr.so.init(mt.ts[8], 2 * DFF / 256, G, bx); pr.HBp = (const char*)HB; pr.slot_tok = SLOT_TOK; pr.W = (const char*)(ws + WS_MW13); pr.mt = mt;
                epi::EpiSwiglu E{(bf16*)(ws + WS_MACT)};
                pg8::gemm_phase<epi::EpiSwiglu, ProbMoe1, true>(lds + RING_OFF, D, pr, E, tid);
            }
            SEAM(P + 7);
            if (IN(P + 8)) { PH_WS();
                ProbMoe2 pr; pr.so.init(mt.ts[8], D / 256, G, bx); pr.ACTp = (const char*)(ws + WS_MACT); pr.W = (const char*)(ws + WS_MW2); pr.mt = mt;
                epi::EpiMoeDown E{(bf16*)(ws + WS_Y), SLOT_GATE};
                pg8::gemm_phase<epi::EpiMoeDown, ProbMoe2>(lds + RING_OFF, DFF, pr, E, tid);
            }
            SEAM(P + 8);
            if (IN(P + 9)) { PH_WS();
                const float* g = INP(I_LFG) + D; const float* bta = INP(I_LFB) + D; const bf16* Y = (const bf16*)(ws + WS_Y);
#define FL_LOAD(R, m) do { const int s0_ = TOK_SLOT[2 * (m)], s1_ = TOK_SLOT[2 * (m) + 1]; \
                    _Pragma("unroll") for (int jj = 0; jj < 4; ++jj) { f32x4 h0, h1, a0, a1, b0, b1; bf8(*((const GAS v4u*)(HB + (size_t)(m) * D) + lane + 64 * jj), h0, h1); \
                        bf8(*((const GAS v4u*)(Y + (size_t)s0_ * D) + lane + 64 * jj), a0, a1); bf8(*((const GAS v4u*)(Y + (size_t)s1_ * D) + lane + 64 * jj), b0, b1); \
                        R.v[2 * jj] = (h0 * ALPHA + a0) + b0; R.v[2 * jj + 1] = (h1 * ALPHA + a1) + b1; } } while (0)
#define FL_PROC(R, m) do { ln_normalize(R); ln_affine(R, g, bta, lane); row_store_f32(R, outp + (size_t)(m) * D, lane); } while (0)
                { float* const outp = OUTP(); Row8 ra{}, rb{}; int m = gw; if (m < TREAL) FL_LOAD(ra, m);
                  for (; m < TREAL; m += 2 * NGW) { const int m1 = m + NGW, m2 = m + 2 * NGW; if (m1 < TREAL) FL_LOAD(rb, m1); FL_PROC(ra, m);
                      if (m1 < TREAL) { if (m2 < TREAL) FL_LOAD(ra, m2); FL_PROC(rb, m1); } } }
#undef FL_LOAD
#undef FL_PROC
            }
        }
    }
#undef IN
#undef SEAM
}

#ifndef MK_ONE_LAUNCH
#define MK_ONE_LAUNCH 0
#endif
extern "C" void kernel_launch(void* const* d_in, const int* in_sizes, int n_in, void* d_out, int out_size, void* d_ws, size_t ws_size, hipStream_t stream) {
    static int grid = 0;
    if (grid == 0) {
        if (n_in != N_IN || in_sizes[0] != NB * SEQ * D || out_size != NB * SEQ * D || ws_size < WS_END) { fprintf(stderr, "kernel_launch: shape mismatch: n_in %d in0 %d out %d ws %zu (need %zu)\n", n_in, n_in > 0 ? in_sizes[0] : -1, out_size, ws_size, (size_t)WS_END); grid = -1; return; }
        int dev = 0, cus = 0, per_cu = 0;
        if (hipGetDevice(&dev) != hipSuccess || hipDeviceGetAttribute(&cus, hipDeviceAttributeMultiprocessorCount, dev) != hipSuccess) { fprintf(stderr, "kernel_launch: device query failed\n"); grid = -1; return; }
        if (hipFuncSetAttribute((const void*)mk_fwd, hipFuncAttributeMaxDynamicSharedMemorySize, LDS_BYTES) != hipSuccess) { fprintf(stderr, "kernel_launch: hipFuncSetAttribute failed\n"); grid = -1; return; }
        if (hipOccupancyMaxActiveBlocksPerMultiprocessor(&per_cu, (const void*)mk_fwd, NWAVES * 64, LDS_BYTES) != hipSuccess || per_cu < 1) fprintf(stderr, "kernel_launch: occupancy query reports %d\n", per_cu);
        (void)hipGetLastError();
        grid = cus;
    }
    if (grid < 0) return;
    if (hipMemsetAsync((char*)d_ws + WS_CTL, 0, CTL_ZERO_BYTES, stream) != hipSuccess) { fprintf(stderr, "kernel_launch: memset failed\n"); return; }
    Args a{};
    for (int i = 0; i < N_IN; ++i) a.in[i] = (const float*)d_in[i];
    a.out = (float*)d_out; a.ws = (unsigned char*)d_ws;
#if MK_ONE_LAUNCH
    a.ph_lo = 0; a.ph_hi = N_PHASES;
    hipLaunchKernelGGL(mk_fwd, dim3(grid), dim3(NWAVES * 64), LDS_BYTES, stream, a);
#else
    for (int p = 0; p < N_PHASES; ++p) { a.ph_lo = p; a.ph_hi = p + 1; hipLaunchKernelGGL(mk_fwd, dim3(grid), dim3(NWAVES * 64), LDS_BYTES, stream, a); }
#endif
    const hipError_t le = hipPeekAtLastError();
    if (le != hipSuccess) fprintf(stderr, "kernel_launch: launch failed: %s\n", hipGetErrorName(le));
}
```

```cpp
#define MK_ONE_LAUNCH 1
#include <hip/hip_runtime.h>
#include <cstdio>
#include <cstdint>
namespace pg8 {
#define PG8_LAS __attribute__((address_space(3)))
typedef unsigned short bf16_t;
typedef short bf16x8 __attribute__((ext_vector_type(8)));
typedef float f32x4 __attribute__((ext_vector_type(4)));
typedef float f32x2 __attribute__((ext_vector_type(2)));
typedef unsigned u32x4 __attribute__((ext_vector_type(4)));
typedef unsigned u32x2 __attribute__((ext_vector_type(2)));
constexpr int BM = 256, BK = 64, HALF = 128, HTB = HALF * BK * 2  , STAGE_BYTES = 8 * HTB, NXCD = 8, WGM = 8;

__host__ __device__ __forceinline__ int lds_byte(int r, int c) { const int st = (r >> 4) * 2 + (c >> 5), rr = r & 15, cc = c & 31, ob = rr * 64 + cc * 2; return st * 1024 + (ob ^ (((ob >> 9) & 1) << 5)); }
__host__ __device__ __forceinline__ void stage_rc(int b, int& R, int& C) { const int st = b / 1024, sb = b % 1024, swz = sb ^ (((sb >> 9) & 1) << 5); R = (st >> 1) * 16 + swz / 64; C = (st & 1) * 32 + (swz % 64) / 2; }
__host__ __device__ __forceinline__ int perm32(int rho) { const int n = rho >> 4, i = rho & 15; return 8 * (i >> 2) + 4 * n + (i & 3); }

struct Unit { int pm, pn; };

struct StaticOrder {
    int nM, nN, nwg, G, c, ntail;
    __device__ __forceinline__ void init(int nM_, int nN_, int G_, int c_, bool tail = false) { nM = nM_; nN = nN_; nwg = nM * nN; G = G_; c = c_; ntail = tail ? nN_ : 0; }
    __device__ __forceinline__ bool next(int i, Unit& u) const {
        const long L = (long)i * G + c; if (L >= nwg + ntail) return false;
        if (L >= nwg) { u.pm = nM; u.pn = (int)(L - nwg); return true; }
        int wgid = (int)L; { const int q = nwg / NXCD, r = nwg % NXCD, xcd = wgid % NXCD, off = wgid / NXCD; wgid = (xcd < r ? xcd * (q + 1) : r * (q + 1) + (xcd - r) * q) + off; }
        const int nig = WGM * nN, gid = wgid / nig, fm = gid * WGM, gsz = (nM - fm) < WGM ? (nM - fm) : WGM;
        u.pm = fm + ((wgid % nig) % gsz); u.pn = (wgid % nig) / gsz; return true;
    }
    __device__ __forceinline__ bool is_half(const Unit& u) const { return ntail != 0 && u.pm == nM; }
};
__device__ __forceinline__ unsigned cvt_pk_bf16(float lo, float hi) { unsigned r; asm volatile("v_cvt_pk_bf16_f32 %0, %1, %2" : "=v"(r) : "v"(lo), "v"(hi)); return r; }
__device__ __forceinline__ float bf_lo(unsigned w) { return __uint_as_float(w << 16); }
__device__ __forceinline__ float bf_hi(unsigned w) { return __uint_as_float(w & 0xffff0000u); }

template <class Epi, class Prob, bool GATHER = false>
__device__ __forceinline__ void gemm_phase(PG8_LAS unsigned char* lds, const int K, const Prob& S, const Epi& E, const int tid_in) {
    int tid_ = tid_in; asm volatile("" : "+v"(tid_));
    const int tid = tid_, wid = __builtin_amdgcn_readfirstlane(tid >> 6), lane = tid & 63, wr = wid >> 2, wc = wid & 3, fr = lane & 15, fq = lane >> 4;
    const int nt = K / BK;
    int sR[2], sC[2];
    unsigned voffA[2][2], nvoffA[2][2], voffB[2];
#pragma unroll
    for (int i = 0; i < 2; ++i) { int R, C; stage_rc(tid * 16 + i * 8192, R, C); sR[i] = R; sC[i] = C; const int Rb = (R & ~31) + perm32(R & 31);
        voffB[i] = (unsigned)(Rb * K + C) * 2u;
        voffA[0][i] = (unsigned)(R * K + C) * 2u; voffA[1][i] = (unsigned)((R + HALF) * K + C) * 2u; nvoffA[0][i] = voffA[0][i]; nvoffA[1][i] = voffA[1][i]; }
    const size_t kstep = (size_t)(BK * 2);
    const size_t hstep = (size_t)HALF * K * 2;
    const unsigned ldsw = (unsigned)wid * 1024u;
    const int aoff = lds_byte(wr * 64 + fr, fq * 8), boff = lds_byte(wc * 32 + fr, fq * 8);
#define PG8_SA(b, h) (((b) * 2 + (h)) * HTB)
#define PG8_SB(b, h) ((4 + (b) * 2 + (h)) * HTB)
#define PG8_STAGE(bufoff, gbase, voff) do { _Pragma("unroll") for (int _i = 0; _i < 2; ++_i) \
        __builtin_amdgcn_global_load_lds((const unsigned*)((const char*)(gbase) + (voff)[_i]), (PG8_LAS unsigned*)(lds + (bufoff) + ldsw + _i * 8192), 16, 0, 0); } while (0)
#define PG8_LDA(dst, b, h) do { _Pragma("unroll") for (int m = 0; m < 4; ++m) _Pragma("unroll") for (int k = 0; k < 2; ++k) dst[m][k] = *(const PG8_LAS bf16x8*)(lds + PG8_SA(b, h) + aoff + m * 2048 + k * 1024); } while (0)
#define PG8_LDB(dst, b, h) do { _Pragma("unroll") for (int n = 0; n < 2; ++n) _Pragma("unroll") for (int k = 0; k < 2; ++k) dst[n][k] = *(const PG8_LAS bf16x8*)(lds + PG8_SB(b, h) + boff + n * 2048 + k * 1024); } while (0)
#define PG8_MMA(ai, bj, At, Bt) do { __builtin_amdgcn_s_setprio(1); _Pragma("unroll") for (int m = 0; m < 4; ++m) _Pragma("unroll") for (int n = 0; n < 2; ++n) _Pragma("unroll") for (int k = 0; k < 2; ++k) \
        acc[ai][bj][m][n] = __builtin_amdgcn_mfma_f32_16x16x32_bf16(Bt[n][k], At[m][k], acc[ai][bj][m][n], 0, 0, 0); __builtin_amdgcn_s_setprio(0); } while (0)
#define PG8_WAIT_V(n) asm volatile("s_waitcnt vmcnt(" #n ")" ::: "memory")
#define PG8_WAIT_L(n) asm volatile("s_waitcnt lgkmcnt(" #n ")" ::: "memory")
#define PG8_BAR __builtin_amdgcn_s_barrier()
#define PG8_SCHED __builtin_amdgcn_sched_barrier(0)
    Unit cur, nxt; int ui = 0;
    if (!S.next(0, cur)) return;
    f32x4 acc[2][2][4][2];
#pragma unroll
    for (int a = 0; a < 2; ++a)
#pragma unroll
        for (int b = 0; b < 2; ++b)
#pragma unroll
            for (int m = 0; m < 4; ++m)
#pragma unroll
                for (int n = 0; n < 2; ++n) acc[a][b][m][n] = (f32x4){0.f, 0.f, 0.f, 0.f};
    bf16x8 At[4][2], B0[2][2], B1[2][2];
    const char* cA = S.a_base(cur); const char* cB = S.b_base(cur);
    if constexpr (GATHER) {
#pragma unroll
        for (int h = 0; h < 2; ++h)
#pragma unroll
            for (int i = 0; i < 2; ++i) { voffA[h][i] = (unsigned)(S.a_row(cur, sR[i] + h * HALF) * K + sC[i]) * 2u; nvoffA[h][i] = voffA[h][i]; }
    }
    PG8_STAGE(PG8_SB(0, 0), cB, voffB); PG8_STAGE(PG8_SB(0, 1), cB + hstep, voffB); PG8_STAGE(PG8_SA(0, 0), cA, voffA[0]); PG8_STAGE(PG8_SA(0, 1), cA, voffA[1]);
    if (wr == 1) PG8_BAR;
    PG8_WAIT_V(2); PG8_BAR;
    PG8_STAGE(PG8_SB(1, 0), cB + kstep, voffB); PG8_STAGE(PG8_SA(1, 0), cA + kstep, voffA[0]); PG8_STAGE(PG8_SB(1, 1), cB + hstep + kstep, voffB);
    PG8_WAIT_V(6); PG8_BAR;
    for (;;) {
        const bool has_next = S.next(ui + 1, nxt);
        const bool half = S.is_half(cur);
        const char* nA = has_next ? S.a_base(nxt) : cA; const char* nB = has_next ? S.b_base(nxt) : cB;
        if constexpr (GATHER) { if (has_next) {
#pragma unroll
            for (int h = 0; h < 2; ++h)
#pragma unroll
                for (int i = 0; i < 2; ++i) nvoffA[h][i] = (unsigned)(S.a_row(nxt, sR[i] + h * HALF) * K + sC[i]) * 2u; } }
        for (int t = 0; t < nt; t += 2) {
            const bool last = (t == nt - 2);
            if constexpr (Epi::MID) { if (t == (nt >> 1)) E.mid(acc, cur, wr, wc, fr, fq); }
            const char* a1 = cA + (size_t)(t + 1) * kstep;
            const char* a2 = last ? nA : cA + (size_t)(t + 2) * kstep; const char* b2 = last ? nB : cB + (size_t)(t + 2) * kstep;
            const char* a3 = a2 + kstep; const char* b3 = b2 + kstep;
            unsigned vA2[2][2];
#pragma unroll
            for (int h = 0; h < 2; ++h)
#pragma unroll
                for (int i = 0; i < 2; ++i) vA2[h][i] = GATHER ? (last ? nvoffA[h][i] : voffA[h][i]) : voffA[h][i];
            PG8_LDB(B0, 0, 0); PG8_LDB(B1, 0, 1); PG8_SCHED; PG8_LDA(At, 0, 0); PG8_STAGE(PG8_SA(1, 1), a1, voffA[1]);
            PG8_WAIT_V(8); PG8_WAIT_L(0); PG8_BAR; PG8_MMA(0, 0, At, B0); PG8_MMA(0, 1, At, B1); PG8_BAR; PG8_SCHED;
            if (!half) PG8_LDA(At, 0, 1); PG8_STAGE(PG8_SB(0, 0), b2, voffB); PG8_STAGE(PG8_SB(0, 1), b2 + hstep, voffB); PG8_STAGE(PG8_SA(0, 0), a2, vA2[0]);
            PG8_WAIT_V(8); PG8_WAIT_L(0); PG8_BAR; if (!half) { PG8_MMA(1, 0, At, B0); PG8_MMA(1, 1, At, B1); } PG8_BAR; PG8_SCHED;
            PG8_LDB(B0, 1, 0); PG8_LDB(B1, 1, 1); PG8_SCHED; PG8_LDA(At, 1, 0); PG8_STAGE(PG8_SA(0, 1), a2, vA2[1]);
            PG8_WAIT_V(8); PG8_WAIT_L(0); PG8_BAR; PG8_MMA(0, 0, At, B0); PG8_MMA(0, 1, At, B1); PG8_BAR; PG8_SCHED;
            if (!half) PG8_LDA(At, 1, 1); PG8_STAGE(PG8_SB(1, 0), b3, voffB); PG8_STAGE(PG8_SB(1, 1), b3 + hstep, voffB); PG8_STAGE(PG8_SA(1, 0), a3, vA2[0]);
            PG8_WAIT_V(8); PG8_WAIT_L(0); PG8_BAR; if (!half) { PG8_MMA(1, 0, At, B0); PG8_MMA(1, 1, At, B1); } PG8_BAR; PG8_SCHED;
        }
        if (wr == 0) PG8_BAR;
        E(acc, cur, wr, wc, fr, fq);
        if (!has_next) break;
#pragma unroll
        for (int a = 0; a < 2; ++a)
#pragma unroll
            for (int b = 0; b < 2; ++b)
#pragma unroll
                for (int m = 0; m < 4; ++m)
#pragma unroll
                    for (int n = 0; n < 2; ++n) acc[a][b][m][n] = (f32x4){0.f, 0.f, 0.f, 0.f};
        cur = nxt; cA = nA; cB = nB; ++ui;
        if constexpr (GATHER) {
#pragma unroll
            for (int h = 0; h < 2; ++h)
#pragma unroll
                for (int i = 0; i < 2; ++i) voffA[h][i] = nvoffA[h][i]; }
        if (wr == 1) PG8_BAR;
    }
    PG8_WAIT_V(0);
    PG8_BAR;
#undef PG8_SA
#undef PG8_SB
#undef PG8_STAGE
#undef PG8_LDA
#undef PG8_LDB
#undef PG8_MMA
#undef PG8_WAIT_V
#undef PG8_WAIT_L
#undef PG8_BAR
#undef PG8_SCHED
}
}
constexpr int D = 2048, NB = 8, SEQ = 4096, NMETA = 16, NH = 16;
constexpr int TREAL = NB * SEQ;
constexpr int T = TREAL + NB * NMETA;
constexpr int TP = 33024;
constexpr int LPOS = SEQ + NMETA;
constexpr int QRANK = 768, KVRANK = 512, DFF = 5632, NE = 8;
constexpr int NIN = 8704;
constexpr int INDIM = 8512;
constexpr float LN_EPS = 1e-5f, RMS_EPS = 1e-6f, ALPHA = 1.4142135623730951f;
constexpr float LOG2E = 1.4426950408889634f;
constexpr float QK_SCALE_MLA = 0.07216878364870322f * LOG2E;
constexpr float QK_SCALE_SWA = 0.08838834764831845f * LOG2E;

__device__ __forceinline__ int row_pos(int row) { return row < TREAL ? NMETA + (row & (SEQ - 1)) : ((row - TREAL) & (NMETA - 1)); }

struct ProbDense {
    pg8::StaticOrder so; const char* A; const char* Bt; size_t tstep;
    __device__ __forceinline__ bool next(int i, pg8::Unit& u) const { return so.next(i, u); }
    __device__ __forceinline__ const char* a_base(const pg8::Unit& u) const { return A + (size_t)u.pm * tstep; }
    __device__ __forceinline__ const char* b_base(const pg8::Unit& u) const { return Bt + (size_t)u.pn * tstep; }
    __device__ __forceinline__ int a_row(const pg8::Unit&, int) const { return 0; }
    __device__ __forceinline__ bool is_half(const pg8::Unit& u) const { return so.is_half(u); }
};
struct MoeTiles { int ts[9]; };
__device__ __forceinline__ int moe_expert(const MoeTiles& mt, int pm) { int e = 0;
#pragma unroll
    for (int k = 1; k < 8; ++k) e += (pm >= mt.ts[k]) ? 1 : 0; return e; }
struct ProbMoe1 {
    pg8::StaticOrder so; const char* HBp; const int* slot_tok; const char* W; MoeTiles mt;
    __device__ __forceinline__ bool next(int i, pg8::Unit& u) const { return so.next(i, u); }
    __device__ __forceinline__ const char* a_base(const pg8::Unit&) const { return HBp; }
    __device__ __forceinline__ const char* b_base(const pg8::Unit& u) const { return W + (size_t)moe_expert(mt, u.pm) * ((size_t)2 * DFF * D * 2) + (size_t)u.pn * (256 * (size_t)D * 2); }
    __device__ __forceinline__ int a_row(const pg8::Unit& u, int r) const { return slot_tok[u.pm * 256 + r]; }
    __device__ __forceinline__ bool is_half(const pg8::Unit&) const { return false; }
};
struct ProbMoe2 {
    pg8::StaticOrder so; const char* ACTp; const char* W; MoeTiles mt;
    __device__ __forceinline__ bool next(int i, pg8::Unit& u) const { return so.next(i, u); }
    __device__ __forceinline__ const char* a_base(const pg8::Unit& u) const { return ACTp + (size_t)u.pm * (256 * (size_t)DFF * 2); }
    __device__ __forceinline__ const char* b_base(const pg8::Unit& u) const { return W + (size_t)moe_expert(mt, u.pm) * ((size_t)D * DFF * 2) + (size_t)u.pn * (256 * (size_t)DFF * 2); }
    __device__ __forceinline__ int a_row(const pg8::Unit&, int) const { return 0; }
    __device__ __forceinline__ bool is_half(const pg8::Unit&) const { return false; }
};

namespace epi {
using pg8::f32x4; using pg8::u32x4; using pg8::bf16_t; using pg8::Unit; using pg8::cvt_pk_bf16;
typedef const f32x4 (&AccRef)[2][2][4][2];
__device__ __forceinline__ void store8(bf16_t* p, f32x4 v0, f32x4 v1) { u32x4 w; w.x = cvt_pk_bf16(v0[0], v0[1]); w.y = cvt_pk_bf16(v0[2], v0[3]); w.z = cvt_pk_bf16(v1[0], v1[1]); w.w = cvt_pk_bf16(v1[2], v1[3]); *(u32x4*)p = w; }
__device__ __forceinline__ void load8(const bf16_t* p, f32x4& v0, f32x4& v1) { const u32x4 w = *(const u32x4*)p;
    v0 = (f32x4){pg8::bf_lo(w.x), pg8::bf_hi(w.x), pg8::bf_lo(w.y), pg8::bf_hi(w.y)}; v1 = (f32x4){pg8::bf_lo(w.z), pg8::bf_hi(w.z), pg8::bf_lo(w.w), pg8::bf_hi(w.w)}; }
__device__ __forceinline__ void unpack8(u32x4 w, f32x4& v0, f32x4& v1) { v0 = (f32x4){pg8::bf_lo(w.x), pg8::bf_hi(w.x), pg8::bf_lo(w.y), pg8::bf_hi(w.y)}; v1 = (f32x4){pg8::bf_lo(w.z), pg8::bf_hi(w.z), pg8::bf_lo(w.w), pg8::bf_hi(w.w)}; }
__device__ __forceinline__ bool epi_fence() { asm volatile("" ::: "memory"); return true; }
__device__ __forceinline__ float sigmoidf_(float x) { return __builtin_amdgcn_rcpf(1.f + __builtin_amdgcn_exp2f(-x * LOG2E)); }
#define EPI_AM _Pragma("unroll") for (int ai = 0; ai < 2; ++ai) _Pragma("unroll") for (int m = 0; m < 4; ++m) if (epi_fence())

struct EpiWin {
    static constexpr bool MID = false;
    bf16_t *CQ, *CKV, *KR, *QB, *KB, *VB, *GR, *GBb; float* SSQ; const float *CS, *SN;
    __device__ __forceinline__ void operator()(AccRef acc, const Unit& u, int wr, int wc, int fr, int fq) const {
        const int pn = u.pn, row0 = u.pm * 256 + wr * 64 + fr, cw = wc * 32 + fq * 8;
        if (pn < 5) {
            bf16_t* dst = pn < 3 ? CQ : CKV; const int ld = pn < 3 ? QRANK : KVRANK, c0 = (pn < 3 ? pn : pn - 3) * 256;
            EPI_AM { const int row = row0 + ai * 128 + m * 16; float s = 0.f;
#pragma unroll
                for (int bj = 0; bj < 2; ++bj) { const f32x4 v0 = acc[ai][bj][m][0], v1 = acc[ai][bj][m][1];
                    s += (v0[0] * v0[0] + v0[1] * v0[1]) + (v0[2] * v0[2] + v0[3] * v0[3]) + (v1[0] * v1[0] + v1[1] * v1[1]) + (v1[2] * v1[2] + v1[3] * v1[3]);
                    store8(dst + (size_t)row * ld + c0 + bj * 128 + cw, v0, v1); }
                s += __shfl_xor(s, 16); s += __shfl_xor(s, 32);
                if (fq == 0) SSQ[(size_t)row * 20 + pn * 4 + wc] = s; }
        } else if (pn == 5) {
            if (wc == 0) { EPI_AM { const int row = row0 + ai * 128 + m * 16, pos = row_pos(row);
                const f32x4 c0 = *(const f32x4*)(CS + pos * 32 + fq * 8), c1 = *(const f32x4*)(CS + pos * 32 + fq * 8 + 4), s0 = *(const f32x4*)(SN + pos * 32 + fq * 8), s1 = *(const f32x4*)(SN + pos * 32 + fq * 8 + 4);
                const f32x4 x10 = acc[ai][0][m][0], x11 = acc[ai][0][m][1], x20 = acc[ai][1][m][0], x21 = acc[ai][1][m][1];
                store8(KR + (size_t)row * 64 + fq * 8, x10 * c0 - x20 * s0, x11 * c1 - x21 * s1);
                store8(KR + (size_t)row * 64 + 32 + fq * 8, x10 * s0 + x20 * c0, x11 * s1 + x21 * c1); } }
        } else if (pn < 14) {
            EPI_AM { const int row = row0 + ai * 128 + m * 16;
#pragma unroll
                for (int bj = 0; bj < 2; ++bj) store8(QB + (size_t)row * 2048 + (pn - 6) * 256 + bj * 128 + cw, acc[ai][bj][m][0] * QK_SCALE_SWA, acc[ai][bj][m][1] * QK_SCALE_SWA); }
        } else if (pn < 18) {
            bf16_t* dst = pn < 16 ? KB : VB; const int c0 = (pn < 16 ? pn - 14 : pn - 16) * 256;
            EPI_AM { const int row = row0 + ai * 128 + m * 16;
#pragma unroll
                for (int bj = 0; bj < 2; ++bj) store8(dst + (size_t)row * 512 + c0 + bj * 128 + cw, acc[ai][bj][m][0], acc[ai][bj][m][1]); }
        } else {
            const int c0 = (pn - 18) * 128 + cw;
            EPI_AM { const int row = row0 + ai * 128 + m * 16; f32x4 r[2], g[2];
#pragma unroll
                for (int n = 0; n < 2; ++n)
#pragma unroll
                    for (int j = 0; j < 4; ++j) { const float a = acc[ai][0][m][n][j], b = fmaxf(acc[ai][1][m][n][j], -30.f);
                        const float ea = __builtin_amdgcn_exp2f(-a * LOG2E), eb = __builtin_amdgcn_exp2f(-b * LOG2E);
                        g[n][j] = __builtin_amdgcn_rcpf(1.f + eb); r[n][j] = (1.f + eb) * __builtin_amdgcn_rcpf(1.f + ea); }
                store8(GR + (size_t)row * 2048 + c0, r[0], r[1]); store8(GBb + (size_t)row * 2048 + c0, g[0], g[1]); }
        }
    }
};
struct EpiUq {
    static constexpr bool MID = false;
    bf16_t* Q; const float* SSQ; const float *CS, *SN;
    __device__ __forceinline__ void operator()(AccRef acc, const Unit& u, int wr, int wc, int fr, int fq) const {
        const int pn = u.pn, row0 = u.pm * 256 + wr * 64 + fr, cw = wc * 32 + fq * 8;
#pragma unroll
        for (int ai = 0; ai < 2; ++ai) { f32x4 q[4][3];
#pragma unroll
            for (int m = 0; m < 4; ++m) { const float* sp = SSQ + (size_t)(row0 + ai * 128 + m * 16) * 20; q[m][0] = *(const f32x4*)sp; q[m][1] = *(const f32x4*)(sp + 4); q[m][2] = *(const f32x4*)(sp + 8); }
            asm volatile("" ::: "memory");
#pragma unroll
            for (int m = 0; m < 4; ++m) { const int row = row0 + ai * 128 + m * 16;
                const float ss = ((q[m][0][0] + q[m][0][1]) + (q[m][0][2] + q[m][0][3])) + ((q[m][1][0] + q[m][1][1]) + (q[m][1][2] + q[m][1][3])) + ((q[m][2][0] + q[m][2][1]) + (q[m][2][2] + q[m][2][3]));
                const float rs = __builtin_amdgcn_rsqf(ss * (1.f / QRANK) + RMS_EPS) * QK_SCALE_MLA;
                if (pn < 8) {
#pragma unroll
                    for (int bj = 0; bj < 2; ++bj) store8(Q + (size_t)row * 3072 + (2 * pn + bj) * 192 + cw, acc[ai][bj][m][0] * rs, acc[ai][bj][m][1] * rs);
                } else {
                    const int head = 4 * (pn - 8) + wc, pos = row_pos(row);
                    const f32x4 c0 = *(const f32x4*)(CS + pos * 32 + fq * 8), c1 = *(const f32x4*)(CS + pos * 32 + fq * 8 + 4), s0 = *(const f32x4*)(SN + pos * 32 + fq * 8), s1 = *(const f32x4*)(SN + pos * 32 + fq * 8 + 4);
                    const f32x4 x10 = acc[ai][0][m][0] * rs, x11 = acc[ai][0][m][1] * rs, x20 = acc[ai][1][m][0] * rs, x21 = acc[ai][1][m][1] * rs;
                    store8(Q + (size_t)row * 3072 + head * 192 + 128 + fq * 8, x10 * c0 - x20 * s0, x11 * c1 - x21 * s1);
                    store8(Q + (size_t)row * 3072 + head * 192 + 160 + fq * 8, x10 * s0 + x20 * c0, x11 * s1 + x21 * c1);
                } }
            asm volatile("" ::: "memory"); }
    }
};
struct EpiUkv {
    static constexpr bool MID = false;
    bf16_t *KN, *V; const float* SSQ;
    __device__ __forceinline__ void operator()(AccRef acc, const Unit& u, int wr, int wc, int fr, int fq) const {
        const int pn = u.pn, row0 = u.pm * 256 + wr * 64 + fr, cw = wc * 32 + fq * 8;
        f32x4 q[2][4][2];
#pragma unroll
        for (int ai = 0; ai < 2; ++ai)
#pragma unroll
            for (int m = 0; m < 4; ++m) { const float* sp = SSQ + (size_t)(row0 + ai * 128 + m * 16) * 20 + 12; q[ai][m][0] = *(const f32x4*)sp; q[ai][m][1] = *(const f32x4*)(sp + 4); }
        asm volatile("" ::: "memory");
#pragma unroll
        for (int ai = 0; ai < 2; ++ai)
#pragma unroll
            for (int m = 0; m < 4; ++m) { const int row = row0 + ai * 128 + m * 16; const f32x4 q0 = q[ai][m][0], q1 = q[ai][m][1];
                const float ss = ((q0[0] + q0[1]) + (q0[2] + q0[3])) + ((q1[0] + q1[1]) + (q1[2] + q1[3]));
                const float rs = __builtin_amdgcn_rsqf(ss * (1.f / KVRANK) + RMS_EPS);
                store8(KN + (size_t)row * 2048 + pn * 128 + cw, acc[ai][0][m][0] * rs, acc[ai][0][m][1] * rs);
                store8(V + (size_t)row * 2048 + pn * 128 + cw, acc[ai][1][m][0] * rs, acc[ai][1][m][1] * rs); }
    }
};
struct EpiProj {
    static constexpr bool MID = true;
    bf16_t* MG; const bf16_t *GR, *GBb;
    __device__ __forceinline__ void mid(f32x4 (&acc)[2][2][4][2], const Unit& u, int wr, int wc, int fr, int fq) const {
        int row0 = u.pm * 256 + wr * 64 + fr, c0 = u.pn * 256 + wc * 32 + fq * 8; asm volatile("" : "+v"(row0), "+v"(c0));
#pragma unroll
        for (int ai = 0; ai < 2; ++ai) { u32x4 w[4][2];
#pragma unroll
            for (int m = 0; m < 4; ++m)
#pragma unroll
                for (int bj = 0; bj < 2; ++bj) w[m][bj] = *(const u32x4*)(GR + (size_t)(row0 + ai * 128 + m * 16) * 2048 + c0 + bj * 128);
            asm volatile("" ::: "memory");
#pragma unroll
            for (int m = 0; m < 4; ++m)
#pragma unroll
                for (int bj = 0; bj < 2; ++bj) { f32x4 r0, r1; unpack8(w[m][bj], r0, r1); acc[ai][bj][m][0] *= r0; acc[ai][bj][m][1] *= r1; }
            asm volatile("" ::: "memory"); }
    }
    __device__ __forceinline__ void operator()(AccRef acc, const Unit& u, int wr, int wc, int fr, int fq) const {
        const int row0 = u.pm * 256 + wr * 64 + fr, c0 = u.pn * 256 + wc * 32 + fq * 8;
#pragma unroll
        for (int ai = 0; ai < 2; ++ai) { u32x4 w[4][2];
#pragma unroll
            for (int m = 0; m < 4; ++m)
#pragma unroll
                for (int bj = 0; bj < 2; ++bj) w[m][bj] = *(const u32x4*)(GBb + (size_t)(row0 + ai * 128 + m * 16) * 2048 + c0 + bj * 128);
            asm volatile("" ::: "memory");
#pragma unroll
            for (int m = 0; m < 4; ++m)
#pragma unroll
                for (int bj = 0; bj < 2; ++bj) { f32x4 g0, g1; unpack8(w[m][bj], g0, g1); store8(MG + (size_t)(row0 + ai * 128 + m * 16) * 2048 + c0 + bj * 128, acc[ai][bj][m][0] * g0, acc[ai][bj][m][1] * g1); }
            asm volatile("" ::: "memory"); }
    }
};
struct EpiResid {
    static constexpr bool MID = false;
    bf16_t* X; const bf16_t* HB;
    __device__ __forceinline__ void operator()(AccRef acc, const Unit& u, int wr, int wc, int fr, int fq) const {
        const int row0 = u.pm * 256 + wr * 64 + fr, c0 = u.pn * 256 + wc * 32 + fq * 8;
#pragma unroll
        for (int ai = 0; ai < 2; ++ai) { u32x4 w[4][2];
#pragma unroll
            for (int m = 0; m < 4; ++m)
#pragma unroll
                for (int bj = 0; bj < 2; ++bj) w[m][bj] = *(const u32x4*)(HB + (size_t)(row0 + ai * 128 + m * 16) * 2048 + c0 + bj * 128);
            asm volatile("" ::: "memory");
#pragma unroll
            for (int m = 0; m < 4; ++m)
#pragma unroll
                for (int bj = 0; bj < 2; ++bj) { f32x4 h0, h1; unpack8(w[m][bj], h0, h1);
                    store8(X + (size_t)(row0 + ai * 128 + m * 16) * 2048 + c0 + bj * 128, h0 * ALPHA + acc[ai][bj][m][0], h1 * ALPHA + acc[ai][bj][m][1]); }
            asm volatile("" ::: "memory"); }
    }
};
struct EpiSwiglu {
    static constexpr bool MID = false;
    bf16_t* ACT;
    __device__ __forceinline__ void operator()(AccRef acc, const Unit& u, int wr, int wc, int fr, int fq) const {
        const int row0 = u.pm * 256 + wr * 64 + fr, c0 = u.pn * 128 + wc * 32 + fq * 8;
        EPI_AM { const int row = row0 + ai * 128 + m * 16; f32x4 o[2];
#pragma unroll
            for (int n = 0; n < 2; ++n)
#pragma unroll
                for (int j = 0; j < 4; ++j) { const float g = acc[ai][0][m][n][j]; o[n][j] = g * sigmoidf_(g) * acc[ai][1][m][n][j]; }
            store8(ACT + (size_t)row * DFF + c0, o[0], o[1]); }
    }
};
struct EpiMoeDown {
    static constexpr bool MID = false;
    bf16_t* Y; const float* slot_gate;
    __device__ __forceinline__ void operator()(AccRef acc, const Unit& u, int wr, int wc, int fr, int fq) const {
        const int row0 = u.pm * 256 + wr * 64 + fr, c0 = u.pn * 256 + wc * 32 + fq * 8;
        float gt[2][4];
#pragma unroll
        for (int ai = 0; ai < 2; ++ai)
#pragma unroll
            for (int m = 0; m < 4; ++m) gt[ai][m] = slot_gate[row0 + ai * 128 + m * 16];
        asm volatile("" ::: "memory");
#pragma unroll
        for (int ai = 0; ai < 2; ++ai)
#pragma unroll
            for (int m = 0; m < 4; ++m) { const int row = row0 + ai * 128 + m * 16; const float g = gt[ai][m];
#pragma unroll
                for (int bj = 0; bj < 2; ++bj) store8(Y + (size_t)row * 2048 + c0 + bj * 128, acc[ai][bj][m][0] * g, acc[ai][bj][m][1] * g); }
    }
};
#undef EPI_AM
}
namespace att {
typedef unsigned short bf16;
typedef short bf16x8 __attribute__((ext_vector_type(8)));
typedef short s16x4 __attribute__((ext_vector_type(4)));
typedef float f32x16 __attribute__((ext_vector_type(16)));
typedef unsigned u32x4 __attribute__((ext_vector_type(4)));
#define ATT_LAS __attribute__((address_space(3)))
#define SBAR() __builtin_amdgcn_sched_barrier(0)
constexpr int KN_BYTES = 16384, KR_BYTES = 8192, V_BYTES = 16384, BUF_BYTES = KN_BYTES + KR_BYTES + V_BYTES;
constexpr int OFF_KN = 0, OFF_KR = KN_BYTES, OFF_V = KN_BYTES + KR_BYTES;
constexpr int OFF_WS = 2 * BUF_BYTES;
constexpr int OFF_BT = OFF_WS + 8 * 64 * 4;
constexpr int ATT_LDS_BYTES = OFF_BT + 4 * 260 * 4;
constexpr float NEG_BIG = -1e30f;
constexpr float THR2 = 8.f;

__device__ __forceinline__ int crow(int r, int hi) { return (r & 3) + 8 * (r >> 2) + 4 * hi; }
__device__ __forceinline__ unsigned cvtpk(float lo, float hi) { unsigned r; asm volatile("v_cvt_pk_bf16_f32 %0, %1, %2" : "=v"(r) : "v"(lo), "v"(hi)); return r; }
__device__ __forceinline__ int kn_off(int row, int colB) { return row * 256 + (colB ^ ((row & 15) << 4)); }
__device__ __forceinline__ int kr_off(int row, int colB) { return row * 128 + (colB ^ (((row >> 1) & 7) << 4)); }
__device__ __forceinline__ int v_st(int k, int c) { const int kk = (k & ~0xC) | ((k & 4) << 1) | ((k & 8) >> 1); return ((kk >> 3) * 4 + (c >> 5)) * 512 + ((kk & 7) * 32 + (c & 31)) * 2; }
__device__ __forceinline__ int v_rd_base(int lane) { return ((lane & 3) << 3) | (((lane >> 2) & 3) << 6) | (((lane >> 4) & 1) << 5) | (((lane >> 5) & 1) << 8); }
constexpr int v_rd_off(int d0, int ks, int half) { return d0 * 512 + ks * 4096 + half * 2048; }
template <int OFF> __device__ __forceinline__ s16x4 tr_read(int vb) { s16x4 r; asm volatile("ds_read_b64_tr_b16 %0, %1 offset:%2" : "=&v"(r) : "v"(vb), "i"(OFF) : "memory"); return r; }
template <int D0> __device__ __forceinline__ void pv_one(f32x16& od, int vb, bf16x8 pa0, bf16x8 pa1, bf16x8 pa2, bf16x8 pa3) {
    const s16x4 l0 = tr_read<v_rd_off(D0, 0, 0)>(vb), h0 = tr_read<v_rd_off(D0, 0, 1)>(vb), l1 = tr_read<v_rd_off(D0, 1, 0)>(vb), h1 = tr_read<v_rd_off(D0, 1, 1)>(vb);
    const s16x4 l2 = tr_read<v_rd_off(D0, 2, 0)>(vb), h2 = tr_read<v_rd_off(D0, 2, 1)>(vb), l3 = tr_read<v_rd_off(D0, 3, 0)>(vb), h3 = tr_read<v_rd_off(D0, 3, 1)>(vb);
    asm volatile("s_waitcnt lgkmcnt(0)" ::: "memory"); SBAR();
#define PK(L, H) (bf16x8){L[0], L[1], L[2], L[3], H[0], H[1], H[2], H[3]}
    od = __builtin_amdgcn_mfma_f32_32x32x16_bf16(pa0, PK(l0, h0), od, 0, 0, 0);
    od = __builtin_amdgcn_mfma_f32_32x32x16_bf16(pa1, PK(l1, h1), od, 0, 0, 0);
    od = __builtin_amdgcn_mfma_f32_32x32x16_bf16(pa2, PK(l2, h2), od, 0, 0, 0);
    od = __builtin_amdgcn_mfma_f32_32x32x16_bf16(pa3, PK(l3, h3), od, 0, 0, 0);
#undef PK
}
__device__ __forceinline__ void pv_all(f32x16* o, int vb, bf16x8 pa0, bf16x8 pa1, bf16x8 pa2, bf16x8 pa3) {
    pv_one<0>(o[0], vb, pa0, pa1, pa2, pa3); pv_one<1>(o[1], vb, pa0, pa1, pa2, pa3); pv_one<2>(o[2], vb, pa0, pa1, pa2, pa3); pv_one<3>(o[3], vb, pa0, pa1, pa2, pa3);
}
}
namespace att {
constexpr int M2_KSLOT = KN_BYTES + KR_BYTES;
constexpr int M2_OFF_K = 0, M2_OFF_V = 3 * M2_KSLOT;
constexpr int M2_OFF_WS = M2_OFF_V + 3 * V_BYTES;
constexpr int M2_LDS_BYTES = M2_OFF_WS + 8 * 64 * 4;
typedef __attribute__((address_space(3))) unsigned char* lds_ptr;

}
namespace att {
constexpr int M3_NT = 65;
__device__ __forceinline__ void softmax_seg(f32x16& p0, f32x16& p1, float& m_reg, float& l_reg, float& alpha, bf16x8& pa0, bf16x8& pa1, bf16x8& pa2, bf16x8& pa3) {
    float pmax = p0[0];
#pragma unroll
    for (int r = 1; r < 16; ++r) pmax = fmaxf(pmax, p0[r]);
#pragma unroll
    for (int r = 0; r < 16; ++r) pmax = fmaxf(pmax, p1[r]);
    { auto rr = __builtin_amdgcn_permlane32_swap(__float_as_uint(pmax), __float_as_uint(pmax), false, false); pmax = fmaxf(__uint_as_float(rr[0]), __uint_as_float(rr[1])); }
    if (__builtin_expect(__all(pmax - m_reg <= THR2), 1)) { alpha = 1.f; }
    else { const float mn = fmaxf(m_reg, pmax); alpha = __builtin_amdgcn_exp2f(m_reg - mn); m_reg = mn; }
    const float mn = m_reg; float ps = 0.f;
#pragma unroll
    for (int r = 0; r < 16; ++r) { p0[r] = __builtin_amdgcn_exp2f(p0[r] - mn); ps += p0[r]; }
#pragma unroll
    for (int r = 0; r < 16; ++r) { p1[r] = __builtin_amdgcn_exp2f(p1[r] - mn); ps += p1[r]; }
    { auto rr = __builtin_amdgcn_permlane32_swap(__float_as_uint(ps), __float_as_uint(ps), false, false); ps = __uint_as_float(rr[0]) + __uint_as_float(rr[1]); }
    l_reg = l_reg * alpha + ps;
#define PK4(P, BASE, OUT) do { unsigned a0 = cvtpk(P[BASE + 0], P[BASE + 1]), a1 = cvtpk(P[BASE + 2], P[BASE + 3]);   \
    unsigned b0 = cvtpk(P[BASE + 4], P[BASE + 5]), b1 = cvtpk(P[BASE + 6], P[BASE + 7]);                              \
    auto r0 = __builtin_amdgcn_permlane32_swap(a0, b0, false, false); auto r1 = __builtin_amdgcn_permlane32_swap(a1, b1, false, false); \
    u32x4 w = {r0[0], r1[0], r0[1], r1[1]}; OUT = *reinterpret_cast<bf16x8*>(&w); } while (0)
    PK4(p0, 0, pa0); PK4(p0, 8, pa1); PK4(p1, 0, pa2); PK4(p1, 8, pa3);
#undef PK4
}

}
namespace att {
constexpr int S2_OFF_K = 0, S2_OFF_V = 3 * KN_BYTES, S2_OFF_TW = S2_OFF_V + 3 * V_BYTES;
constexpr int S2_OFF_TM = S2_OFF_TW + 4 * 512 * 4, S2_OFF_WS = S2_OFF_TM + 4 * 256 * 4, S2_LDS_BYTES = S2_OFF_WS + 8 * 64 * 4;
__device__ __forceinline__ void swa_unit2(lds_ptr lds, const bf16* __restrict__ QB, const bf16* __restrict__ KB, const bf16* __restrict__ VB, bf16* __restrict__ OAB,
                                          const float* __restrict__ tw_g, const float* __restrict__ tm_g, const float* __restrict__ sink_l2, int b, int hk, int j, int& tables_hk, const int tid_in) {
    int tid_ = tid_in; asm volatile("" : "+v"(tid_)); const int tid = tid_, lane = tid & 63, r32 = lane & 31, hi = lane >> 5; const int wid = __builtin_amdgcn_readfirstlane(tid >> 6);
    const bool metaq = (j == 64);
    const int hq = 4 * hk + (wid >> 1);
    const bool wave_on = !metaq || (wid & 1) == 0;
    const int qpos = metaq ? (r32 & 15) : (NMETA + 64 * j + 32 * (wid & 1) + r32);
    const int qrow = metaq ? (TREAL + 16 * b + (r32 & 15)) : (b * SEQ + 64 * j + 32 * (wid & 1) + r32);
    __attribute__((address_space(3))) float* wsf = (__attribute__((address_space(3))) float*)(lds + S2_OFF_WS) + wid * 64;
    int nt, kt_lo = 0;
    if (metaq) nt = 3; else { kt_lo = j - 2 < 0 ? 0 : j - 2; const int kt_hi = j + 2 > 63 ? 63 : j + 2; nt = 1 + (kt_hi - kt_lo + 1); }
#define S2_KPOS0(t) (metaq ? 64 * (t) : ((t) == 0 ? 0 : NMETA + 64 * (kt_lo + (t) - 1)))
#define S2_ROW(kp) ({ int kp_ = (kp) > LPOS - 1 ? LPOS - 1 : (kp); (kp_ < NMETA ? TREAL + 16 * b + kp_ : b * SEQ + kp_ - NMETA); })
    int kk_k[2], kk_v[2]; unsigned co_k[2], co_v[2];
#pragma unroll
    for (int i = 0; i < 2; ++i) { const int P = 2 * wid + i;
        { const int row = 4 * P + (lane >> 4), c = (lane & 15) ^ (row & 15); kk_k[i] = row; co_k[i] = (unsigned)(c * 16); }
        { const int q = 64 * P + lane, s = q >> 5, kk = (s >> 2) * 8 + ((q & 31) >> 2), col = (s & 3) * 32 + (q & 3) * 8, k = (kk & ~0xC) | ((kk & 4) << 1) | ((kk & 8) >> 1); kk_v[i] = k; co_v[i] = (unsigned)(col * 2); } }
    const char* const kb_h = (const char*)KB + hk * 256; const char* const vb_h = (const char*)VB + hk * 256;
#define S2_DMA(src, dstoff) __builtin_amdgcn_global_load_lds((const unsigned*)(src), (__attribute__((address_space(3))) unsigned*)(lds + (dstoff)), 16, 0, 0)
#define S2_DMA_TILE(t, slot) do { const int kp0_ = S2_KPOS0(t); \
        _Pragma("unroll") for (int i_ = 0; i_ < 2; ++i_) { S2_DMA(kb_h + (size_t)S2_ROW(kp0_ + kk_k[i_]) * 1024 + co_k[i_], S2_OFF_K + (slot) * KN_BYTES + (2 * wid + i_) * 1024); \
                                                          S2_DMA(vb_h + (size_t)S2_ROW(kp0_ + kk_v[i_]) * 1024 + co_v[i_], S2_OFF_V + (slot) * V_BYTES + (2 * wid + i_) * 1024); } } while (0)
#define S2_BAR() do { asm volatile("s_waitcnt lgkmcnt(0)" ::: "memory"); __builtin_amdgcn_s_barrier(); asm volatile("" ::: "memory"); } while (0)
    S2_DMA_TILE(0, 0); S2_DMA_TILE(1, 1); S2_DMA_TILE(2, 2);
    bf16x8 qr[8];
    { const bf16* qp = QB + (size_t)qrow * 2048 + hq * 128 + hi * 8;
#pragma unroll
      for (int d0 = 0; d0 < 8; ++d0) qr[d0] = *reinterpret_cast<const bf16x8*>(qp + d0 * 16); }
    if (tables_hk != hk) {
        __attribute__((address_space(3))) float* tw = (__attribute__((address_space(3))) float*)(lds + S2_OFF_TW); __attribute__((address_space(3))) float* tm = (__attribute__((address_space(3))) float*)(lds + S2_OFF_TM);
        for (int i = tid; i < 4 * 512; i += 512) tw[i] = tw_g[(4 * hk) * 512 + i];
        for (int i = tid; i < 4 * 256; i += 512) tm[i] = tm_g[(4 * hk) * 256 + i];
        tables_hk = hk;
    }
    const int xkn = (r32 & 15) << 4, hb = hi * 16;
    const int vlane = v_rd_base(lane);
    const float sink = sink_l2[hq];
    float m_reg = sink, l_reg = 1.f; f32x16 o[4];
#pragma unroll
    for (int d = 0; d < 4; ++d) o[d] = f32x16{};
    f32x16 p0, p1; bf16x8 pa0, pa1, pa2, pa3;
#define S2_KLD(d, A0, A1) do { const int of_ = (((d) * 32 + hb) ^ xn_); A0 = *(const __attribute__((address_space(3))) bf16x8*)(kb_ + of_); A1 = *(const __attribute__((address_space(3))) bf16x8*)(kb_ + of_ + 8192); } while (0)
#define S2_KMM(d, A0, A1) do { p0 = __builtin_amdgcn_mfma_f32_32x32x16_bf16(A0, qr[d], p0, 0, 0, 0); p1 = __builtin_amdgcn_mfma_f32_32x32x16_bf16(A1, qr[d], p1, 0, 0, 0); } while (0)
    int slot = 0;
    for (int t = 0; t < nt; ++t) {
        { const int ahead = (nt < t + 3 ? nt : t + 3) - t - 1;
          if (ahead >= 2) asm volatile("s_waitcnt vmcnt(8)" ::: "memory"); else if (ahead == 1) asm volatile("s_waitcnt vmcnt(4)" ::: "memory"); else asm volatile("s_waitcnt vmcnt(0)" ::: "memory"); }
        S2_BAR();
        if (wave_on) {
            const int kpos0 = S2_KPOS0(t);
            __builtin_amdgcn_s_setprio(3);
            { int xn_ = xkn; asm volatile("" : "+v"(xn_)); const lds_ptr kb_ = lds + S2_OFF_K + slot * KN_BYTES + r32 * 256; p0 = f32x16{}; p1 = f32x16{};
              bf16x8 k0a, k0b, k1a, k1b, k2a, k2b, k3a, k3b;
              S2_KLD(0, k0a, k0b); S2_KLD(1, k1a, k1b); S2_KLD(2, k2a, k2b); S2_KLD(3, k3a, k3b); SBAR();
              S2_KMM(0, k0a, k0b); S2_KLD(4, k0a, k0b); SBAR(); S2_KMM(1, k1a, k1b); S2_KLD(5, k1a, k1b); SBAR(); S2_KMM(2, k2a, k2b); S2_KLD(6, k2a, k2b); SBAR(); S2_KMM(3, k3a, k3b); S2_KLD(7, k3a, k3b); SBAR();
              S2_KMM(4, k0a, k0b); SBAR(); S2_KMM(5, k1a, k1b); SBAR(); S2_KMM(6, k2a, k2b); SBAR(); S2_KMM(7, k3a, k3b); }
            __builtin_amdgcn_s_setprio(0);
            if (!metaq && t == 0) {
                int base = 4 * hi - qpos; base = base < -256 ? -256 : base;
                const __attribute__((address_space(3))) float* tb = (const __attribute__((address_space(3))) float*)(lds + S2_OFF_TM) + (wid >> 1) * 256 + base + 256;
#pragma unroll
                for (int r = 0; r < 16; ++r) { if (r < 8) p0[r] += tb[(r & 3) + 8 * (r >> 2)]; else p0[r] = NEG_BIG; p1[r] = NEG_BIG; }
            } else {
                const int base = kpos0 + 4 * hi - qpos;
                const __attribute__((address_space(3))) float* tb = (const __attribute__((address_space(3))) float*)(lds + S2_OFF_TW) + (wid >> 1) * 512 + base + 256;
#pragma unroll
                for (int r = 0; r < 16; ++r) { p0[r] += tb[(r & 3) + 8 * (r >> 2)]; p1[r] += tb[(r & 3) + 8 * (r >> 2) + 32]; }
                if (kpos0 + 64 > LPOS) {
#pragma unroll
                    for (int r = 0; r < 16; ++r) { if (kpos0 + crow(r, hi) >= LPOS) p0[r] = NEG_BIG; if (kpos0 + 32 + crow(r, hi) >= LPOS) p1[r] = NEG_BIG; } }
            }
            float alpha; softmax_seg(p0, p1, m_reg, l_reg, alpha, pa0, pa1, pa2, pa3);
            if (__any(alpha < 1.f)) { if (hi == 0) wsf[r32] = alpha; asm volatile("s_waitcnt lgkmcnt(0)" ::: "memory");
#pragma unroll
                for (int d = 0; d < 4; ++d)
#pragma unroll
                    for (int r = 0; r < 16; ++r) o[d][r] *= wsf[crow(r, hi)]; }
            __builtin_amdgcn_s_setprio(3); pv_all(o, (int)(uintptr_t)(lds + S2_OFF_V + slot * V_BYTES) + vlane, pa0, pa1, pa2, pa3); __builtin_amdgcn_s_setprio(0);
        }
        if (t + 3 < nt) { S2_BAR(); S2_DMA_TILE(t + 3, slot); }
        slot = slot == 2 ? 0 : slot + 1;
    }
    if (wave_on) {
        if (hi == 0) wsf[32 + r32] = l_reg; asm volatile("s_waitcnt lgkmcnt(0)" ::: "memory");
        const int orow0 = metaq ? (TREAL + 16 * b) : (b * SEQ + 64 * j + 32 * (wid & 1));
#pragma unroll
        for (int r = 0; r < 16; ++r) { const int rw = crow(r, hi); const float rl = __builtin_amdgcn_rcpf(wsf[32 + rw]);
            if (!metaq || rw < 16) { bf16* op = OAB + (size_t)(orow0 + rw) * 4096 + 2048 + hq * 128 + r32;
#pragma unroll
                for (int d0 = 0; d0 < 4; ++d0) op[d0 * 32] = (bf16)(cvtpk(o[d0][r] * rl, 0.f) & 0xffffu); } }
    }
    asm volatile("s_waitcnt vmcnt(0)" ::: "memory"); S2_BAR();
#undef S2_KPOS0
#undef S2_ROW
#undef S2_DMA
#undef S2_DMA_TILE
#undef S2_BAR
#undef S2_KLD
#undef S2_KMM
}
}
namespace att {
template <int OFF> __device__ __forceinline__ bf16x8 lds_rd128(int addr) { bf16x8 r; asm volatile("ds_read_b128 %0, %1 offset:%2" : "=&v"(r) : "v"(addr), "i"(OFF) : "memory"); return r; }
#define M4_XFULL(KS, VS) do { \
    int xn_ = xkn, xr_ = xkr; asm volatile("" : "+v"(xn_), "+v"(xr_)); \
    const int kbn_ = (int)(uintptr_t)(lds + M2_OFF_K + (KS) * M2_KSLOT) + r32 * 256, kbr_ = (int)(uintptr_t)(lds + M2_OFF_K + (KS) * M2_KSLOT + KN_BYTES) + r32 * 128; \
    const int vb_ = (int)(uintptr_t)(lds + M2_OFF_V + (VS) * V_BYTES) + vlane; (void)vb_; \
    bf16x8 ka0, ka1, ka2, ka3, ka4, kb0, kb1, kb2, kb3, kb4; s16x4 vl0, vl1, vl2, vl3, vl4, vh0, vh1, vh2, vh3, vh4; \
    p0 = f32x16{}; p1 = f32x16{}; \
    { const int a_ = kbn_ + (((0) * 32 + hb) ^ xn_); ka0 = lds_rd128<0>(a_); kb0 = lds_rd128<8192>(a_); } \
    { const int a_ = kbn_ + (((1) * 32 + hb) ^ xn_); ka1 = lds_rd128<0>(a_); kb1 = lds_rd128<8192>(a_); } \
    { const int a_ = kbn_ + (((2) * 32 + hb) ^ xn_); ka2 = lds_rd128<0>(a_); kb2 = lds_rd128<8192>(a_); } \
    { const int a_ = kbn_ + (((3) * 32 + hb) ^ xn_); ka3 = lds_rd128<0>(a_); kb3 = lds_rd128<8192>(a_); } \
    { const int a_ = kbn_ + (((4) * 32 + hb) ^ xn_); ka4 = lds_rd128<0>(a_); kb4 = lds_rd128<8192>(a_); } \
    asm volatile("s_waitcnt lgkmcnt(8)" ::: "memory"); SBAR(); p0 = __builtin_amdgcn_mfma_f32_32x32x16_bf16(ka0, qr[0], p0, 0, 0, 0); p1 = __builtin_amdgcn_mfma_f32_32x32x16_bf16(kb0, qr[0], p1, 0, 0, 0); SBAR(); \
    { const int a_ = kbn_ + (((5) * 32 + hb) ^ xn_); ka0 = lds_rd128<0>(a_); kb0 = lds_rd128<8192>(a_); } \
    asm volatile("s_waitcnt lgkmcnt(8)" ::: "memory"); SBAR(); p0 = __builtin_amdgcn_mfma_f32_32x32x16_bf16(ka1, qr[1], p0, 0, 0, 0); p1 = __builtin_amdgcn_mfma_f32_32x32x16_bf16(kb1, qr[1], p1, 0, 0, 0); SBAR(); \
    { const int a_ = kbn_ + (((6) * 32 + hb) ^ xn_); ka1 = lds_rd128<0>(a_); kb1 = lds_rd128<8192>(a_); } \
    asm volatile("s_waitcnt lgkmcnt(8)" ::: "memory"); SBAR(); p0 = __builtin_amdgcn_mfma_f32_32x32x16_bf16(ka2, qr[2], p0, 0, 0, 0); p1 = __builtin_amdgcn_mfma_f32_32x32x16_bf16(kb2, qr[2], p1, 0, 0, 0); SBAR(); \
    { const int a_ = kbn_ + (((7) * 32 + hb) ^ xn_); ka2 = lds_rd128<0>(a_); kb2 = lds_rd128<8192>(a_); } \
    asm volatile("s_waitcnt lgkmcnt(8)" ::: "memory"); SBAR(); p0 = __builtin_amdgcn_mfma_f32_32x32x16_bf16(ka3, qr[3], p0, 0, 0, 0); p1 = __builtin_amdgcn_mfma_f32_32x32x16_bf16(kb3, qr[3], p1, 0, 0, 0); SBAR(); \
    { const int a_ = kbr_ + (((0) * 32 + hb) ^ xr_); ka3 = lds_rd128<0>(a_); kb3 = lds_rd128<4096>(a_); } \
    asm volatile("s_waitcnt lgkmcnt(8)" ::: "memory"); SBAR(); p0 = __builtin_amdgcn_mfma_f32_32x32x16_bf16(ka4, qr[4], p0, 0, 0, 0); p1 = __builtin_amdgcn_mfma_f32_32x32x16_bf16(kb4, qr[4], p1, 0, 0, 0); SBAR(); \
    { const int a_ = kbr_ + (((1) * 32 + hb) ^ xr_); ka4 = lds_rd128<0>(a_); kb4 = lds_rd128<4096>(a_); } \
    asm volatile("s_waitcnt lgkmcnt(8)" ::: "memory"); SBAR(); p0 = __builtin_amdgcn_mfma_f32_32x32x16_bf16(ka0, qr[5], p0, 0, 0, 0); p1 = __builtin_amdgcn_mfma_f32_32x32x16_bf16(kb0, qr[5], p1, 0, 0, 0); SBAR(); \
    { const int a_ = kbr_ + (((2) * 32 + hb) ^ xr_); ka0 = lds_rd128<0>(a_); kb0 = lds_rd128<4096>(a_); } \
    asm volatile("s_waitcnt lgkmcnt(8)" ::: "memory"); SBAR(); p0 = __builtin_amdgcn_mfma_f32_32x32x16_bf16(ka1, qr[6], p0, 0, 0, 0); p1 = __builtin_amdgcn_mfma_f32_32x32x16_bf16(kb1, qr[6], p1, 0, 0, 0); SBAR(); \
    { const int a_ = kbr_ + (((3) * 32 + hb) ^ xr_); ka1 = lds_rd128<0>(a_); kb1 = lds_rd128<4096>(a_); } \
    asm volatile("s_waitcnt lgkmcnt(8)" ::: "memory"); SBAR(); p0 = __builtin_amdgcn_mfma_f32_32x32x16_bf16(ka2, qr[7], p0, 0, 0, 0); p1 = __builtin_amdgcn_mfma_f32_32x32x16_bf16(kb2, qr[7], p1, 0, 0, 0); SBAR(); \
    { vl2 = tr_read<v_rd_off(0, 0, 0)>(vb_); vh2 = tr_read<v_rd_off(0, 0, 1)>(vb_); } \
    asm volatile("s_waitcnt lgkmcnt(8)" ::: "memory"); SBAR(); p0 = __builtin_amdgcn_mfma_f32_32x32x16_bf16(ka3, qr[8], p0, 0, 0, 0); p1 = __builtin_amdgcn_mfma_f32_32x32x16_bf16(kb3, qr[8], p1, 0, 0, 0); SBAR(); \
    { vl3 = tr_read<v_rd_off(0, 1, 0)>(vb_); vh3 = tr_read<v_rd_off(0, 1, 1)>(vb_); } \
    asm volatile("s_waitcnt lgkmcnt(8)" ::: "memory"); SBAR(); p0 = __builtin_amdgcn_mfma_f32_32x32x16_bf16(ka4, qr[9], p0, 0, 0, 0); p1 = __builtin_amdgcn_mfma_f32_32x32x16_bf16(kb4, qr[9], p1, 0, 0, 0); SBAR(); \
    { vl4 = tr_read<v_rd_off(0, 2, 0)>(vb_); vh4 = tr_read<v_rd_off(0, 2, 1)>(vb_); } \
    asm volatile("s_waitcnt lgkmcnt(8)" ::: "memory"); SBAR(); p0 = __builtin_amdgcn_mfma_f32_32x32x16_bf16(ka0, qr[10], p0, 0, 0, 0); p1 = __builtin_amdgcn_mfma_f32_32x32x16_bf16(kb0, qr[10], p1, 0, 0, 0); SBAR(); \
    { vl0 = tr_read<v_rd_off(0, 3, 0)>(vb_); vh0 = tr_read<v_rd_off(0, 3, 1)>(vb_); } \
    asm volatile("s_waitcnt lgkmcnt(8)" ::: "memory"); SBAR(); p0 = __builtin_amdgcn_mfma_f32_32x32x16_bf16(ka1, qr[11], p0, 0, 0, 0); p1 = __builtin_amdgcn_mfma_f32_32x32x16_bf16(kb1, qr[11], p1, 0, 0, 0); SBAR(); \
    { vl1 = tr_read<v_rd_off(1, 0, 0)>(vb_); vh1 = tr_read<v_rd_off(1, 0, 1)>(vb_); } \
    asm volatile("s_waitcnt lgkmcnt(8)" ::: "memory"); SBAR(); o[0] = __builtin_amdgcn_mfma_f32_32x32x16_bf16(pa0, (bf16x8){vl2[0], vl2[1], vl2[2], vl2[3], vh2[0], vh2[1], vh2[2], vh2[3]}, o[0], 0, 0, 0); SBAR(); \
    { vl2 = tr_read<v_rd_off(1, 1, 0)>(vb_); vh2 = tr_read<v_rd_off(1, 1, 1)>(vb_); } \
    asm volatile("s_waitcnt lgkmcnt(8)" ::: "memory"); SBAR(); o[0] = __builtin_amdgcn_mfma_f32_32x32x16_bf16(pa1, (bf16x8){vl3[0], vl3[1], vl3[2], vl3[3], vh3[0], vh3[1], vh3[2], vh3[3]}, o[0], 0, 0, 0); SBAR(); \
    { vl3 = tr_read<v_rd_off(1, 2, 0)>(vb_); vh3 = tr_read<v_rd_off(1, 2, 1)>(vb_); } \
    asm volatile("s_waitcnt lgkmcnt(8)" ::: "memory"); SBAR(); o[0] = __builtin_amdgcn_mfma_f32_32x32x16_bf16(pa2, (bf16x8){vl4[0], vl4[1], vl4[2], vl4[3], vh4[0], vh4[1], vh4[2], vh4[3]}, o[0], 0, 0, 0); SBAR(); \
    { vl4 = tr_read<v_rd_off(1, 3, 0)>(vb_); vh4 = tr_read<v_rd_off(1, 3, 1)>(vb_); } \
    asm volatile("s_waitcnt lgkmcnt(8)" ::: "memory"); SBAR(); o[0] = __builtin_amdgcn_mfma_f32_32x32x16_bf16(pa3, (bf16x8){vl0[0], vl0[1], vl0[2], vl0[3], vh0[0], vh0[1], vh0[2], vh0[3]}, o[0], 0, 0, 0); SBAR(); \
    { vl0 = tr_read<v_rd_off(2, 0, 0)>(vb_); vh0 = tr_read<v_rd_off(2, 0, 1)>(vb_); } \
    asm volatile("s_waitcnt lgkmcnt(8)" ::: "memory"); SBAR(); o[1] = __builtin_amdgcn_mfma_f32_32x32x16_bf16(pa0, (bf16x8){vl1[0], vl1[1], vl1[2], vl1[3], vh1[0], vh1[1], vh1[2], vh1[3]}, o[1], 0, 0, 0); SBAR(); \
    { vl1 = tr_read<v_rd_off(2, 1, 0)>(vb_); vh1 = tr_read<v_rd_off(2, 1, 1)>(vb_); } \
    asm volatile("s_waitcnt lgkmcnt(8)" ::: "memory"); SBAR(); o[1] = __builtin_amdgcn_mfma_f32_32x32x16_bf16(pa1, (bf16x8){vl2[0], vl2[1], vl2[2], vl2[3], vh2[0], vh2[1], vh2[2], vh2[3]}, o[1], 0, 0, 0); SBAR(); \
    { vl2 = tr_read<v_rd_off(2, 2, 0)>(vb_); vh2 = tr_read<v_rd_off(2, 2, 1)>(vb_); } \
    asm volatile("s_waitcnt lgkmcnt(8)" ::: "memory"); SBAR(); o[1] = __builtin_amdgcn_mfma_f32_32x32x16_bf16(pa2, (bf16x8){vl3[0], vl3[1], vl3[2], vl3[3], vh3[0], vh3[1], vh3[2], vh3[3]}, o[1], 0, 0, 0); SBAR(); \
    { vl3 = tr_read<v_rd_off(2, 3, 0)>(vb_); vh3 = tr_read<v_rd_off(2, 3, 1)>(vb_); } \
    asm volatile("s_waitcnt lgkmcnt(8)" ::: "memory"); SBAR(); o[1] = __builtin_amdgcn_mfma_f32_32x32x16_bf16(pa3, (bf16x8){vl4[0], vl4[1], vl4[2], vl4[3], vh4[0], vh4[1], vh4[2], vh4[3]}, o[1], 0, 0, 0); SBAR(); \
    { vl4 = tr_read<v_rd_off(3, 0, 0)>(vb_); vh4 = tr_read<v_rd_off(3, 0, 1)>(vb_); } \
    asm volatile("s_waitcnt lgkmcnt(8)" ::: "memory"); SBAR(); o[2] = __builtin_amdgcn_mfma_f32_32x32x16_bf16(pa0, (bf16x8){vl0[0], vl0[1], vl0[2], vl0[3], vh0[0], vh0[1], vh0[2], vh0[3]}, o[2], 0, 0, 0); SBAR(); \
    { vl0 = tr_read<v_rd_off(3, 1, 0)>(vb_); vh0 = tr_read<v_rd_off(3, 1, 1)>(vb_); } \
    asm volatile("s_waitcnt lgkmcnt(8)" ::: "memory"); SBAR(); o[2] = __builtin_amdgcn_mfma_f32_32x32x16_bf16(pa1, (bf16x8){vl1[0], vl1[1], vl1[2], vl1[3], vh1[0], vh1[1], vh1[2], vh1[3]}, o[2], 0, 0, 0); SBAR(); \
    { vl1 = tr_read<v_rd_off(3, 2, 0)>(vb_); vh1 = tr_read<v_rd_off(3, 2, 1)>(vb_); } \
    asm volatile("s_waitcnt lgkmcnt(8)" ::: "memory"); SBAR(); o[2] = __builtin_amdgcn_mfma_f32_32x32x16_bf16(pa2, (bf16x8){vl2[0], vl2[1], vl2[2], vl2[3], vh2[0], vh2[1], vh2[2], vh2[3]}, o[2], 0, 0, 0); SBAR(); \
    { vl2 = tr_read<v_rd_off(3, 3, 0)>(vb_); vh2 = tr_read<v_rd_off(3, 3, 1)>(vb_); } \
    asm volatile("s_waitcnt lgkmcnt(8)" ::: "memory"); SBAR(); o[2] = __builtin_amdgcn_mfma_f32_32x32x16_bf16(pa3, (bf16x8){vl3[0], vl3[1], vl3[2], vl3[3], vh3[0], vh3[1], vh3[2], vh3[3]}, o[2], 0, 0, 0); SBAR(); \
    asm volatile("s_waitcnt lgkmcnt(6)" ::: "memory"); SBAR(); o[3] = __builtin_amdgcn_mfma_f32_32x32x16_bf16(pa0, (bf16x8){vl4[0], vl4[1], vl4[2], vl4[3], vh4[0], vh4[1], vh4[2], vh4[3]}, o[3], 0, 0, 0); SBAR(); \
    asm volatile("s_waitcnt lgkmcnt(4)" ::: "memory"); SBAR(); o[3] = __builtin_amdgcn_mfma_f32_32x32x16_bf16(pa1, (bf16x8){vl0[0], vl0[1], vl0[2], vl0[3], vh0[0], vh0[1], vh0[2], vh0[3]}, o[3], 0, 0, 0); SBAR(); \
    asm volatile("s_waitcnt lgkmcnt(2)" ::: "memory"); SBAR(); o[3] = __builtin_amdgcn_mfma_f32_32x32x16_bf16(pa2, (bf16x8){vl1[0], vl1[1], vl1[2], vl1[3], vh1[0], vh1[1], vh1[2], vh1[3]}, o[3], 0, 0, 0); SBAR(); \
    asm volatile("s_waitcnt lgkmcnt(0)" ::: "memory"); SBAR(); o[3] = __builtin_amdgcn_mfma_f32_32x32x16_bf16(pa3, (bf16x8){vl2[0], vl2[1], vl2[2], vl2[3], vh2[0], vh2[1], vh2[2], vh2[3]}, o[3], 0, 0, 0); SBAR(); \
} while (0)
#define M4_XFIRST(KS, VS) do { \
    int xn_ = xkn, xr_ = xkr; asm volatile("" : "+v"(xn_), "+v"(xr_)); \
    const int kbn_ = (int)(uintptr_t)(lds + M2_OFF_K + (KS) * M2_KSLOT) + r32 * 256, kbr_ = (int)(uintptr_t)(lds + M2_OFF_K + (KS) * M2_KSLOT + KN_BYTES) + r32 * 128; \
    const int vb_ = (int)(uintptr_t)(lds + M2_OFF_V + (VS) * V_BYTES) + vlane; (void)vb_; \
    bf16x8 ka0, ka1, ka2, ka3, ka4, kb0, kb1, kb2, kb3, kb4; s16x4 vl0, vl1, vl2, vl3, vl4, vh0, vh1, vh2, vh3, vh4; \
    p0 = f32x16{}; p1 = f32x16{}; \
    { const int a_ = kbn_ + (((0) * 32 + hb) ^ xn_); ka0 = lds_rd128<0>(a_); kb0 = lds_rd128<8192>(a_); } \
    { const int a_ = kbn_ + (((1) * 32 + hb) ^ xn_); ka1 = lds_rd128<0>(a_); kb1 = lds_rd128<8192>(a_); } \
    { const int a_ = kbn_ + (((2) * 32 + hb) ^ xn_); ka2 = lds_rd128<0>(a_); kb2 = lds_rd128<8192>(a_); } \
    { const int a_ = kbn_ + (((3) * 32 + hb) ^ xn_); ka3 = lds_rd128<0>(a_); kb3 = lds_rd128<8192>(a_); } \
    { const int a_ = kbn_ + (((4) * 32 + hb) ^ xn_); ka4 = lds_rd128<0>(a_); kb4 = lds_rd128<8192>(a_); } \
    asm volatile("s_waitcnt lgkmcnt(8)" ::: "memory"); SBAR(); p0 = __builtin_amdgcn_mfma_f32_32x32x16_bf16(ka0, qr[0], p0, 0, 0, 0); p1 = __builtin_amdgcn_mfma_f32_32x32x16_bf16(kb0, qr[0], p1, 0, 0, 0); SBAR(); \
    { const int a_ = kbn_ + (((5) * 32 + hb) ^ xn_); ka0 = lds_rd128<0>(a_); kb0 = lds_rd128<8192>(a_); } \
    asm volatile("s_waitcnt lgkmcnt(8)" ::: "memory"); SBAR(); p0 = __builtin_amdgcn_mfma_f32_32x32x16_bf16(ka1, qr[1], p0, 0, 0, 0); p1 = __builtin_amdgcn_mfma_f32_32x32x16_bf16(kb1, qr[1], p1, 0, 0, 0); SBAR(); \
    { const int a_ = kbn_ + (((6) * 32 + hb) ^ xn_); ka1 = lds_rd128<0>(a_); kb1 = lds_rd128<8192>(a_); } \
    asm volatile("s_waitcnt lgkmcnt(8)" ::: "memory"); SBAR(); p0 = __builtin_amdgcn_mfma_f32_32x32x16_bf16(ka2, qr[2], p0, 0, 0, 0); p1 = __builtin_amdgcn_mfma_f32_32x32x16_bf16(kb2, qr[2], p1, 0, 0, 0); SBAR(); \
    { const int a_ = kbn_ + (((7) * 32 + hb) ^ xn_); ka2 = lds_rd128<0>(a_); kb2 = lds_rd128<8192>(a_); } \
    asm volatile("s_waitcnt lgkmcnt(8)" ::: "memory"); SBAR(); p0 = __builtin_amdgcn_mfma_f32_32x32x16_bf16(ka3, qr[3], p0, 0, 0, 0); p1 = __builtin_amdgcn_mfma_f32_32x32x16_bf16(kb3, qr[3], p1, 0, 0, 0); SBAR(); \
    { const int a_ = kbr_ + (((0) * 32 + hb) ^ xr_); ka3 = lds_rd128<0>(a_); kb3 = lds_rd128<4096>(a_); } \
    asm volatile("s_waitcnt lgkmcnt(8)" ::: "memory"); SBAR(); p0 = __builtin_amdgcn_mfma_f32_32x32x16_bf16(ka4, qr[4], p0, 0, 0, 0); p1 = __builtin_amdgcn_mfma_f32_32x32x16_bf16(kb4, qr[4], p1, 0, 0, 0); SBAR(); \
    { const int a_ = kbr_ + (((1) * 32 + hb) ^ xr_); ka4 = lds_rd128<0>(a_); kb4 = lds_rd128<4096>(a_); } \
    asm volatile("s_waitcnt lgkmcnt(8)" ::: "memory"); SBAR(); p0 = __builtin_amdgcn_mfma_f32_32x32x16_bf16(ka0, qr[5], p0, 0, 0, 0); p1 = __builtin_amdgcn_mfma_f32_32x32x16_bf16(kb0, qr[5], p1, 0, 0, 0); SBAR(); \
    { const int a_ = kbr_ + (((2) * 32 + hb) ^ xr_); ka0 = lds_rd128<0>(a_); kb0 = lds_rd128<4096>(a_); } \
    asm volatile("s_waitcnt lgkmcnt(8)" ::: "memory"); SBAR(); p0 = __builtin_amdgcn_mfma_f32_32x32x16_bf16(ka1, qr[6], p0, 0, 0, 0); p1 = __builtin_amdgcn_mfma_f32_32x32x16_bf16(kb1, qr[6], p1, 0, 0, 0); SBAR(); \
    { const int a_ = kbr_ + (((3) * 32 + hb) ^ xr_); ka1 = lds_rd128<0>(a_); kb1 = lds_rd128<4096>(a_); } \
    asm volatile("s_waitcnt lgkmcnt(8)" ::: "memory"); SBAR(); p0 = __builtin_amdgcn_mfma_f32_32x32x16_bf16(ka2, qr[7], p0, 0, 0, 0); p1 = __builtin_amdgcn_mfma_f32_32x32x16_bf16(kb2, qr[7], p1, 0, 0, 0); SBAR(); \
    asm volatile("s_waitcnt lgkmcnt(6)" ::: "memory"); SBAR(); p0 = __builtin_amdgcn_mfma_f32_32x32x16_bf16(ka3, qr[8], p0, 0, 0, 0); p1 = __builtin_amdgcn_mfma_f32_32x32x16_bf16(kb3, qr[8], p1, 0, 0, 0); SBAR(); \
    asm volatile("s_waitcnt lgkmcnt(4)" ::: "memory"); SBAR(); p0 = __builtin_amdgcn_mfma_f32_32x32x16_bf16(ka4, qr[9], p0, 0, 0, 0); p1 = __builtin_amdgcn_mfma_f32_32x32x16_bf16(kb4, qr[9], p1, 0, 0, 0); SBAR(); \
    asm volatile("s_waitcnt lgkmcnt(2)" ::: "memory"); SBAR(); p0 = __builtin_amdgcn_mfma_f32_32x32x16_bf16(ka0, qr[10], p0, 0, 0, 0); p1 = __builtin_amdgcn_mfma_f32_32x32x16_bf16(kb0, qr[10], p1, 0, 0, 0); SBAR(); \
    asm volatile("s_waitcnt lgkmcnt(0)" ::: "memory"); SBAR(); p0 = __builtin_amdgcn_mfma_f32_32x32x16_bf16(ka1, qr[11], p0, 0, 0, 0); p1 = __builtin_amdgcn_mfma_f32_32x32x16_bf16(kb1, qr[11], p1, 0, 0, 0); SBAR(); \
} while (0)

__device__ __forceinline__ void mla_unit4(lds_ptr lds, const bf16* __restrict__ Q, const bf16* __restrict__ KN, const bf16* __restrict__ KR, const bf16* __restrict__ V, bf16* __restrict__ OAB, int b, int h, int qb, const int tid_in) {
    int tid_ = tid_in; asm volatile("" : "+v"(tid_)); const int tid = tid_, lane = tid & 63, r32 = lane & 31, hi = lane >> 5; const int wid = __builtin_amdgcn_readfirstlane(tid >> 6);
    const bool metaq = (qb == 16);
    const bool wave_on = !metaq || wid == 0;
    const int qrow = metaq ? (TREAL + 16 * b + (r32 & 15)) : (b * SEQ + qb * 256 + wid * 32 + r32);
    __attribute__((address_space(3))) float* wsf = (__attribute__((address_space(3))) float*)(lds + M2_OFF_WS) + wid * 64;
    unsigned so_kn[2], so_kr, so_v[2];
#pragma unroll
    for (int i = 0; i < 2; ++i) { const int P = 2 * wid + i;
        { const int row = 4 * P + (lane >> 4), c = (lane & 15) ^ (row & 15); so_kn[i] = (unsigned)(row * 4096 + c * 16); }
        { const int q = 64 * P + lane, s = q >> 5, kk = (s >> 2) * 8 + ((q & 31) >> 2), col = (s & 3) * 32 + (q & 3) * 8, k = (kk & ~0xC) | ((kk & 4) << 1) | ((kk & 8) >> 1); so_v[i] = (unsigned)(k * 4096 + col * 2); } }
    { const int row = 8 * wid + (lane >> 3), c = (lane & 7) ^ ((row >> 1) & 7); so_kr = (unsigned)(row * 128 + c * 16); }
    const char* const kn_h = (const char*)KN + h * 256; const char* const v_h = (const char*)V + h * 256; const char* const kr_b = (const char*)KR;
    const size_t real0 = (size_t)b * SEQ, meta0 = (size_t)TREAL + 16 * b;
#define M3_ROW(t) ((t) == 0 ? meta0 : real0 + (size_t)((t) - 1) * 64)
#define M3_DMA(src, dstoff) __builtin_amdgcn_global_load_lds((const unsigned*)(src), (__attribute__((address_space(3))) unsigned*)(lds + (dstoff)), 16, 0, 0)
#define M3_DMA_K(t, slot) do { const size_t g_ = M3_ROW(t); const int so_ = M2_OFF_K + (slot) * M2_KSLOT; \
        M3_DMA(kn_h + g_ * 4096 + so_kn[0], so_ + (2 * wid) * 1024); M3_DMA(kn_h + g_ * 4096 + so_kn[1], so_ + (2 * wid + 1) * 1024); M3_DMA(kr_b + g_ * 128 + so_kr, so_ + KN_BYTES + wid * 1024); } while (0)
#define M3_DMA_V(t, slot) do { const size_t g_ = M3_ROW(t); const int so_ = M2_OFF_V + (slot) * V_BYTES; \
        M3_DMA(v_h + g_ * 4096 + so_v[0], so_ + (2 * wid) * 1024); M3_DMA(v_h + g_ * 4096 + so_v[1], so_ + (2 * wid + 1) * 1024); } while (0)
#define M3_WAIT(n) asm volatile("s_waitcnt vmcnt(" #n ")" ::: "memory")
#define M3_BAR() do { asm volatile("" ::: "memory"); __builtin_amdgcn_s_barrier(); asm volatile("" ::: "memory"); } while (0)
#define M3_EVENT(i, s3) do { if ((i) + 2 < M3_NT) M3_DMA_K((i) + 2, (s3) == 0 ? 2 : (s3) - 1); if ((i) + 1 < M3_NT) M3_DMA_V((i) + 1, (s3) == 2 ? 0 : (s3) + 1); } while (0)
#define M3_WAITI(i) do { if ((i) < M3_NT - 2) M3_WAIT(5); else M3_WAIT(0); } while (0)
    M3_DMA_K(0, 0); M3_DMA_V(0, 0); M3_DMA_K(1, 1);
    bf16x8 qr[12];
    { const bf16* qp = Q + (size_t)qrow * 3072 + h * 192 + hi * 8;
#pragma unroll
      for (int d0 = 0; d0 < 12; ++d0) qr[d0] = *reinterpret_cast<const bf16x8*>(qp + d0 * 16); }
    const int xkn = (r32 & 15) << 4, xkr = ((r32 >> 1) & 7) << 4, hb = hi * 16;
    const int vlane = v_rd_base(lane);
#define M3_PV(slot) pv_all(o, (int)(uintptr_t)(lds + M2_OFF_V + (slot) * V_BYTES) + vlane, pa0, pa1, pa2, pa3)
#define M3_Y(j) do { if (wave_on) { if ((j) == 0) { _Pragma("unroll") for (int r = 0; r < 16; ++r) { if (crow(r, hi) >= 16) p0[r] = NEG_BIG; p1[r] = NEG_BIG; } } \
        float alpha_; softmax_seg(p0, p1, m_reg, l_reg, alpha_, pa0, pa1, pa2, pa3); \
        if (__any(alpha_ < 1.f)) { if (hi == 0) wsf[r32] = alpha_; asm volatile("s_waitcnt lgkmcnt(0)" ::: "memory"); \
            _Pragma("unroll") for (int d = 0; d < 4; ++d) _Pragma("unroll") for (int r = 0; r < 16; ++r) o[d][r] *= wsf[crow(r, hi)]; } } } while (0)
    float m_reg = NEG_BIG, l_reg = 0.f; f32x16 o[4];
#pragma unroll
    for (int d = 0; d < 4; ++d) o[d] = f32x16{};
    f32x16 p0, p1; bf16x8 pa0, pa1, pa2, pa3;
    int s3 = 0;
    if (wid < 4) {
        M3_WAITI(0); M3_BAR();
        if (wave_on) M4_XFIRST(0, 0);
        M3_BAR(); M3_EVENT(0, 0);
        M3_Y(0);
        s3 = 1;
        for (int j = 1; j < M3_NT; ++j) {
            M3_WAITI(j); M3_BAR();
            if (wave_on) { __builtin_amdgcn_s_setprio(3); M4_XFULL(s3, (s3 == 0 ? 2 : s3 - 1)); __builtin_amdgcn_s_setprio(0); }
            M3_BAR(); M3_EVENT(j, s3);
            M3_Y(j);
            s3 = s3 == 2 ? 0 : s3 + 1;
        }
        M3_BAR();
        if (wave_on) M3_PV(s3 == 0 ? 2 : s3 - 1);
        M3_BAR();
    } else {
        M3_WAITI(0); M3_BAR(); M3_EVENT(0, 0);
        M3_BAR();
        if (wave_on) M4_XFIRST(0, 0);
        M3_WAITI(1); M3_BAR(); M3_EVENT(1, 1);
        M3_Y(0);
        s3 = 1;
        for (int j = 1; j < M3_NT; ++j) {
            M3_BAR();
            if (wave_on) { __builtin_amdgcn_s_setprio(3); M4_XFULL(s3, (s3 == 0 ? 2 : s3 - 1)); __builtin_amdgcn_s_setprio(0); }
            M3_WAITI(j + 1); M3_BAR(); { const int s3n = s3 == 2 ? 0 : s3 + 1; M3_EVENT(j + 1, s3n); }
            M3_Y(j);
            s3 = s3 == 2 ? 0 : s3 + 1;
        }
        M3_BAR();
        if (wave_on) M3_PV(s3 == 0 ? 2 : s3 - 1);
    }
    if (wave_on) {
        if (hi == 0) wsf[32 + r32] = l_reg; asm volatile("s_waitcnt lgkmcnt(0)" ::: "memory");
        const int orow0 = metaq ? (TREAL + 16 * b) : (b * SEQ + qb * 256 + wid * 32);
#pragma unroll
        for (int r = 0; r < 16; ++r) { const int rw = crow(r, hi); const float rl = __builtin_amdgcn_rcpf(wsf[32 + rw]);
            if (!metaq || rw < 16) { bf16* op = OAB + (size_t)(orow0 + rw) * 4096 + h * 128 + r32;
#pragma unroll
                for (int d0 = 0; d0 < 4; ++d0) op[d0 * 32] = (bf16)(cvtpk(o[d0][r] * rl, 0.f) & 0xffffu); } }
    }
    M3_WAIT(0); M3_BAR();
#undef M3_ROW
#undef M3_DMA
#undef M3_DMA_K
#undef M3_DMA_V
#undef M3_WAIT
#undef M3_BAR
#undef M3_EVENT
#undef M3_WAITI
#undef M3_PV
#undef M3_Y
}
#undef M4_XFULL
#undef M4_XFIRST
}
constexpr int NWAVES = 8;
constexpr int N_PHASES = 20;
constexpr size_t MiB = 1u << 20, KiB32 = 32768;
constexpr size_t WS_CTL = 0, CTL_ZERO_BYTES = 65536;
constexpr size_t WS_CS = 1 * MiB, WS_SN = WS_CS + 540672;
constexpr size_t WS_BIAS = 3 * MiB;
constexpr size_t WS_TW = WS_BIAS, WS_TM = WS_BIAS + 32768, WS_SINK = WS_BIAS + 49152;
constexpr size_t WS_WHIST = WS_BIAS + 65536;
constexpr size_t WS_TOPI = 4 * MiB, WS_TOPG = WS_TOPI + 262144, WS_TOKSLOT = WS_TOPG + 262144;
constexpr size_t WS_SLOTTOK = 5 * MiB, WS_SLOTGATE = WS_SLOTTOK + 294912;
constexpr size_t WS_SSQ = 6 * MiB;
constexpr size_t WS_HB = 9 * MiB;
constexpr size_t WS_W = 138 * MiB;
constexpr size_t WL_IN = 0, WL_UQ = 34 * MiB, WL_UKV = WL_UQ + 9 * MiB / 2, WL_AB = WL_UKV + 4 * MiB, WL_OUT = WL_AB + 16 * MiB, WL_STRIDE = WL_OUT + 8 * MiB;
constexpr size_t WS_WF13 = WS_W + 2 * WL_STRIDE, WS_WF2 = WS_WF13 + 44 * MiB, WS_WEND = WS_WF2 + 22 * MiB;
constexpr size_t AR = 337 * MiB;
constexpr size_t WS_CQ = AR, WS_CKV = WS_CQ + 1548 * KiB32, WS_KR = WS_CKV + 1032 * KiB32, WS_QB = WS_KR + 132 * KiB32;
constexpr size_t WS_KB = WS_QB + 129 * MiB, WS_VB = WS_KB + 1032 * KiB32, WS_GR = WS_VB + 1032 * KiB32, WS_GBB = WS_GR + 129 * MiB;
constexpr size_t WS_Q = WS_GBB + 129 * MiB, WS_KN = WS_Q + 6192 * KiB32  , WS_V = WS_KN + 129 * MiB, WS_OAB = WS_V + 129 * MiB, WS_MIX_END = WS_OAB + 258 * MiB;
constexpr size_t WS_MG = WS_Q;
constexpr size_t WS_X = WS_OAB;
constexpr size_t WS_ACT = AR;
constexpr size_t WS_MW13 = 138 * MiB, WS_MW2 = WS_MW13 + 8 * 44 * MiB;
constexpr size_t WS_MACT = WS_MW2 + 8 * 22 * MiB;
constexpr size_t WS_Y = WS_MACT + 726 * MiB;
constexpr size_t WS_END = WS_Y + 264 * MiB;
static_assert(WS_MIX_END <= 1700 * MiB && WS_END <= 1700 * MiB, "d_ws map");
static_assert(WS_ACT + (size_t)TP * DFF * 2 <= WS_X, "dense ACT vs X");
static_assert(WS_SSQ + (size_t)TP * 20 * 4 <= WS_HB && WS_SLOTGATE + 294912 <= WS_SSQ && WS_TOKSLOT + 262144 <= WS_SLOTTOK && WS_SN + 540672 <= WS_BIAS, "small tables");
static_assert(WS_KR + (size_t)TP * 64 * 2 <= WS_QB, "KR");
constexpr int CW_TMO = 0, CW_CODE = 1;
constexpr int CW_MOE_TS = 64;
constexpr int CW_BAR = 4096;
constexpr int RING_OFF = 0, RING_BYTES = 131072;
constexpr int LDSCTL_OFF = RING_BYTES, MISC_OFF = LDSCTL_OFF + 320, PT_OFF = LDSCTL_OFF + 512;
constexpr int LDS_BYTES = 147456;
static_assert(att::ATT_LDS_BYTES <= RING_BYTES && att::M2_LDS_BYTES <= RING_BYTES && att::S2_LDS_BYTES <= RING_BYTES, "attention LDS");

#define GAS __attribute__((address_space(1)))
#define LAS __attribute__((address_space(3)))
typedef unsigned short bf16;
typedef unsigned v4u __attribute__((ext_vector_type(4)));
typedef unsigned v2u __attribute__((ext_vector_type(2)));
typedef float f32x4 __attribute__((ext_vector_type(4)));
typedef GAS unsigned gu32;
#define RLX_AGENT __ATOMIC_RELAXED, __HIP_MEMORY_SCOPE_AGENT
#define LDS_WAIT() asm volatile("s_waitcnt lgkmcnt(0)" ::: "memory")
#define VM_WAIT() asm volatile("s_waitcnt vmcnt(0)" ::: "memory")
__device__ __forceinline__ unsigned f2bf(float f) { unsigned u = __builtin_bit_cast(unsigned, f); return (u + 0x7fffu + ((u >> 16) & 1u)) >> 16; }
__device__ __forceinline__ unsigned pk2(float lo, float hi) { return f2bf(lo) | (f2bf(hi) << 16); }

#define XB_TMO      128
#define XB_XCNT(j)  (256  + 64 * (j))
#define XB_XSUB(j)  (1280 + 64 * (j))
#define XB_XGEN(j)  (2304 + 64 * (j))
#define XB_TOP      3328
#define XB_TOPGEN   3392
#define XCD_BAR_WORDS 3456
#define XB_SPIN_CAP (1u << 22)
__device__ __forceinline__ unsigned xb_ld(unsigned* p)              { return __hip_atomic_load(p, __ATOMIC_RELAXED, __HIP_MEMORY_SCOPE_AGENT); }
__device__ __forceinline__ unsigned xb_add(unsigned* p, unsigned v) { return __hip_atomic_fetch_add(p, v, __ATOMIC_RELAXED, __HIP_MEMORY_SCOPE_AGENT); }
__device__ __forceinline__ unsigned xb_xcc_id() { return (unsigned)__builtin_amdgcn_s_getreg((3 << 11) | 20) & 0xFu; }
#define XB_SPIN(cond, bar) do { unsigned _sp = 0; while (cond) { __builtin_amdgcn_s_sleep(1); \
    if ((++_sp & 255u) == 0u) { if (xb_ld(&(bar)[XB_TMO])) break; if (_sp > XB_SPIN_CAP) { atomicAdd(&(bar)[XB_TMO], 1u); break; } } } } while (0)
struct XcdBarrier { unsigned* bar; unsigned x; volatile LAS unsigned* st; };
__device__ __forceinline__ XcdBarrier xcd_barrier_post(unsigned* bar, volatile LAS unsigned* st, const int tid) {
    XcdBarrier b; b.bar = bar; b.x = xb_xcc_id(); b.st = st;
    if (tid == 0) (void)xb_add(&bar[XB_XCNT(b.x)], 1u);
    return b;
}
__device__ __forceinline__ void xcd_barrier_complete(unsigned* bar, unsigned x, unsigned& nloc, unsigned& nx) {
    const unsigned G = gridDim.x * gridDim.y * gridDim.z;
    unsigned sum, cnt, mine, sp = 0u;
    for (;;) {
        sum = 0u; cnt = 0u; mine = 0u;
#pragma unroll
        for (unsigned j = 0; j < 16; ++j) { const unsigned c = xb_ld(&bar[XB_XCNT(j)]); sum += c; cnt += (c > 0u) ? 1u : 0u; mine = (j == x) ? c : mine; }
        if (sum == G) break;
        __builtin_amdgcn_s_sleep(1);
        if ((++sp & 255u) == 0u) { if (xb_ld(&bar[XB_TMO])) break; if (sp > XB_SPIN_CAP) { atomicAdd(&bar[XB_TMO], 1u); break; } }
    }
    nloc = mine > 0u ? mine : 1u; nx = cnt > 0u ? cnt : 1u;
}
__device__ __forceinline__ void xcd_barrier(const XcdBarrier& b, const int tid) {
    asm volatile("s_waitcnt vmcnt(0)" ::: "memory");
    __syncthreads();
    if (tid == 0) {
        unsigned* bar = b.bar;
        __builtin_amdgcn_s_waitcnt(0);
        unsigned nloc = b.st[0], nx = b.st[1];
        if (nloc == 0u) { xcd_barrier_complete(bar, b.x, nloc, nx); b.st[0] = nloc; b.st[1] = nx; }
        const unsigned old = xb_add(&bar[XB_XSUB(b.x)], 1u);
        const unsigned gen = old / nloc;
        if (old + 1u == (gen + 1u) * nloc) {
            __builtin_amdgcn_fence(__ATOMIC_RELEASE, "agent");
            asm volatile("s_waitcnt vmcnt(0)" ::: "memory");
            const unsigned og = xb_add(&bar[XB_TOP], 1u);
            const unsigned tg = og / nx;
            if (og + 1u == (tg + 1u) * nx) xb_add(&bar[XB_TOPGEN], 1u);
            else XB_SPIN(xb_ld(&bar[XB_TOPGEN]) == tg, bar);
            __builtin_amdgcn_fence(__ATOMIC_ACQUIRE, "agent");
            xb_add(&bar[XB_XGEN(b.x)], 1u);
            asm volatile("s_waitcnt vmcnt(0)" ::: "memory");
        } else {
            XB_SPIN(xb_ld(&bar[XB_XGEN(b.x)]) == gen, bar);
            __builtin_amdgcn_fence(__ATOMIC_ACQUIRE, "agent");
            asm volatile("s_waitcnt vmcnt(0)" ::: "memory");
        }
    }
    __syncthreads();
}

__device__ __forceinline__ int lane_id() { int l; asm volatile("v_mbcnt_lo_u32_b32 %0, -1, 0\n\tv_mbcnt_hi_u32_b32 %0, -1, %0" : "=v"(l)); return l; }
__device__ __forceinline__ float wave_sum(float v) {
#pragma unroll
    for (int o = 1; o < 64; o <<= 1) v += __shfl_xor(v, o);
    return v;
}
__device__ __forceinline__ void transpose_item(const float* __restrict__ W, int ldw, int k0, int n0, bf16* __restrict__ WT, size_t ldt, int drow, int koff, const float* __restrict__ g, LAS float* scr, int lane) {
    const int kr = lane >> 3, c4 = (lane & 7) * 4;
    f32x4 v[8];
#pragma unroll
    for (int i = 0; i < 8; ++i) v[i] = *(const GAS f32x4*)(W + (size_t)(k0 + 8 * i + kr) * ldw + n0 + c4);
    if (g) {
#pragma unroll
        for (int i = 0; i < 8; ++i) v[i] = v[i] * g[k0 + 8 * i + kr]; }
#pragma unroll
    for (int i = 0; i < 8; ++i) { LAS float* d = scr + (8 * i + kr) * 33 + c4; d[0] = v[i].x; d[1] = v[i].y; d[2] = v[i].z; d[3] = v[i].w; }
    LDS_WAIT(); asm volatile("" ::: "memory");
    const int c = lane & 7;
#pragma unroll
    for (int j = 0; j < 4; ++j) { const int n = (lane >> 3) + 8 * j; const LAS float* s = scr + (8 * c) * 33 + n;
        v4u o; o.x = pk2(s[0 * 33], s[1 * 33]); o.y = pk2(s[2 * 33], s[3 * 33]); o.z = pk2(s[4 * 33], s[5 * 33]); o.w = pk2(s[6 * 33], s[7 * 33]);
        *(GAS v4u*)(WT + (size_t)(drow + n) * ldt + koff + k0 + 8 * c) = o; }
    LDS_WAIT(); asm volatile("" ::: "memory");
}
struct TDesc { const float* W; bf16* WT; size_t ldt; int ldw, k0, n0, drow; };
__device__ __forceinline__ void t_load(const TDesc& d, f32x4 (&v)[8], int lane) {
    const int kr = lane >> 3, c4 = (lane & 7) * 4;
#pragma unroll
    for (int i = 0; i < 8; ++i) v[i] = *(const GAS f32x4*)(d.W + (size_t)(d.k0 + 8 * i + kr) * d.ldw + d.n0 + c4);
}
__device__ __forceinline__ void t_finish(const TDesc& d, const f32x4 (&v)[8], LAS float* scr, int lane) {
    const int kr = lane >> 3, c4 = (lane & 7) * 4;
#pragma unroll
    for (int i = 0; i < 8; ++i) { LAS float* p = scr + (8 * i + kr) * 33 + c4; p[0] = v[i].x; p[1] = v[i].y; p[2] = v[i].z; p[3] = v[i].w; }
    LDS_WAIT(); asm volatile("" ::: "memory");
    const int c = lane & 7;
#pragma unroll
    for (int j = 0; j < 4; ++j) { const int n = (lane >> 3) + 8 * j; const LAS float* s = scr + (8 * c) * 33 + n;
        v4u o; o.x = pk2(s[0 * 33], s[1 * 33]); o.y = pk2(s[2 * 33], s[3 * 33]); o.z = pk2(s[4 * 33], s[5 * 33]); o.w = pk2(s[6 * 33], s[7 * 33]);
        *(GAS v4u*)(d.WT + (size_t)(d.drow + n) * d.ldt + d.k0 + 8 * c) = o; }
    LDS_WAIT(); asm volatile("" ::: "memory");
}
__device__ __forceinline__ int dmap_in(int n0) {
    if (n0 < 1280) return n0;
    if (n0 < 1312) return 1280;
    if (n0 < 1344) return 1280 + 128;
    if (n0 < 3392) return 1536 + (n0 - 1344);
    if (n0 < 3904) return 3584 + (n0 - 3392);
    if (n0 < 4416) return 4096 + (n0 - 3904);
    if (n0 < 6464) { const int a = n0 - 4416; return 4608 + 256 * (a >> 7) + (a & 127); }
    const int a = n0 - 6464; return 4608 + 256 * (a >> 7) + 128 + (a & 127);
}
__device__ __forceinline__ int dmap_uq(int n0) {
    const int head = n0 / 192, off = n0 - head * 192;
    if (off < 128) return 256 * (head >> 1) + 128 * (head & 1) + off;
    if (off < 160) return 256 * (8 + (head >> 2)) + 32 * (head & 3);
    return 256 * (8 + (head >> 2)) + 128 + 32 * (head & 3);
}
__device__ __forceinline__ int dmap_glu(int n0) { return 256 * (n0 >> 7) + (n0 & 127); }
struct Row8 { f32x4 v[8]; };
__device__ __forceinline__ void ln_normalize(Row8& r) {
    float s = 0.f;
#pragma unroll
    for (int j = 0; j < 8; ++j) s += (r.v[j].x + r.v[j].y) + (r.v[j].z + r.v[j].w);
    const float mean = wave_sum(s) * (1.f / D); float s2 = 0.f;
#pragma unroll
    for (int j = 0; j < 8; ++j) { r.v[j] = r.v[j] - mean; s2 += (r.v[j].x * r.v[j].x + r.v[j].y * r.v[j].y) + (r.v[j].z * r.v[j].z + r.v[j].w * r.v[j].w); }
    const float rstd = 1.f / sqrtf(wave_sum(s2) * (1.f / D) + LN_EPS);
#pragma unroll
    for (int j = 0; j < 8; ++j) r.v[j] = r.v[j] * rstd;
}
__device__ __forceinline__ void ln_affine(Row8& r, const float* __restrict__ g, const float* __restrict__ b, int lane) {
#pragma unroll
    for (int jj = 0; jj < 4; ++jj) { const f32x4* gp = (const f32x4*)g + 2 * (lane + 64 * jj); const f32x4* bp = (const f32x4*)b + 2 * (lane + 64 * jj);
        r.v[2 * jj] = r.v[2 * jj] * gp[0] + bp[0]; r.v[2 * jj + 1] = r.v[2 * jj + 1] * gp[1] + bp[1]; }
}
__device__ __forceinline__ void row_store_bf16(const Row8& r, bf16* orow, int lane) {
#pragma unroll
    for (int jj = 0; jj < 4; ++jj) { v4u w; w.x = pk2(r.v[2 * jj].x, r.v[2 * jj].y); w.y = pk2(r.v[2 * jj].z, r.v[2 * jj].w); w.z = pk2(r.v[2 * jj + 1].x, r.v[2 * jj + 1].y); w.w = pk2(r.v[2 * jj + 1].z, r.v[2 * jj + 1].w);
        *((GAS v4u*)orow + lane + 64 * jj) = w; }
}
__device__ __forceinline__ void row_load_f32(Row8& r, const float* xrow, int lane) {
#pragma unroll
    for (int jj = 0; jj < 4; ++jj) { const GAS f32x4* p = (const GAS f32x4*)xrow + 2 * (lane + 64 * jj); r.v[2 * jj] = p[0]; r.v[2 * jj + 1] = p[1]; }
}
__device__ __forceinline__ f32x4 bf4(v2u w);
__device__ __forceinline__ void bf8(v4u w, f32x4& a, f32x4& b) { a = bf4((v2u){w.x, w.y}); b = bf4((v2u){w.z, w.w}); }
__device__ __forceinline__ void row_load_bf16(Row8& r, const bf16* xrow, int lane) {
#pragma unroll
    for (int jj = 0; jj < 4; ++jj) bf8(*((const GAS v4u*)xrow + lane + 64 * jj), r.v[2 * jj], r.v[2 * jj + 1]);
}
__device__ __forceinline__ void row_store_f32(const Row8& r, float* orow, int lane) {
#pragma unroll
    for (int jj = 0; jj < 4; ++jj) { GAS f32x4* p = (GAS f32x4*)orow + 2 * (lane + 64 * jj); p[0] = r.v[2 * jj]; p[1] = r.v[2 * jj + 1]; }
}
__device__ __forceinline__ f32x4 bf4(v2u w) { return (f32x4){__uint_as_float(w.x << 16), __uint_as_float(w.x & 0xffff0000u), __uint_as_float(w.y << 16), __uint_as_float(w.y & 0xffff0000u)}; }
__device__ __forceinline__ int t5_bucket(int rel) {
    const int n = rel < 0 ? -rel : rel; int v;
    if (n < 8) v = n; else if (n < 12) v = 8; else if (n < 16) v = 9; else if (n < 23) v = 10; else if (n < 32) v = 11; else if (n < 46) v = 12; else if (n < 64) v = 13; else if (n < 91) v = 14; else v = 15;
    return (rel > 0 ? 16 : 0) + v;
}

__device__ __forceinline__ void router_row(const Row8& r, const LAS f32x4* rwl, const float* __restrict__ rbias, int lane, int& i0, int& i1, float& g0, float& g1) {
    float lg[8];
#pragma unroll
    for (int e = 0; e < 8; ++e) lg[e] = 0.f;
#pragma unroll
    for (int j = 0; j < 8; ++j) {
#pragma unroll
        for (int q = 0; q < 4; ++q) { const f32x4 w0 = rwl[(j * 4 + q) * 64 + lane], w1 = rwl[2048 + (j * 4 + q) * 64 + lane]; const float y = r.v[j][q];
            lg[0] += y * w0.x; lg[1] += y * w0.y; lg[2] += y * w0.z; lg[3] += y * w0.w; lg[4] += y * w1.x; lg[5] += y * w1.y; lg[6] += y * w1.z; lg[7] += y * w1.w; } }
#pragma unroll
    for (int e = 0; e < 8; ++e) lg[e] = wave_sum(lg[e]) + rbias[e];
    i0 = 0; float v0 = lg[0];
#pragma unroll
    for (int e = 1; e < 8; ++e) if (lg[e] > v0) { v0 = lg[e]; i0 = e; }
    i1 = -1; float v1 = -3.0e38f;
#pragma unroll
    for (int e = 0; e < 8; ++e) if (e != i0 && lg[e] > v1) { v1 = lg[e]; i1 = e; }
    const float e1 = __expf(v1 - v0); g0 = 1.f / (1.f + e1); g1 = e1 / (1.f + e1);
}
enum { I_X = 0, I_META, I_EMB_G, I_EMB_B, I_RELB, I_WIN, I_QNG, I_KVNG, I_WUQ, I_WUKV, I_SINK, I_WPA, I_WPB, I_WOUT, I_LMG, I_LMB, I_LFG, I_LFB,
       I_FW1, I_FW3, I_FW2, I_RW, I_RB, I_MW1, I_MW3, I_MW2, N_IN };
struct Args { const float* in[N_IN]; float* out; unsigned char* ws; int ph_lo, ph_hi; };

__global__ void __launch_bounds__(NWAVES * 64, 2) mk_fwd(Args args) {
    extern __shared__ __attribute__((aligned(16))) unsigned char lds_raw[];
    LAS unsigned char* const lds = (LAS unsigned char*)lds_raw;
    char* const ldsg = (char*)lds_raw;
    volatile LAS unsigned* const MISC = (volatile LAS unsigned*)(lds + MISC_OFF);
    const int wave = __builtin_amdgcn_readfirstlane((int)threadIdx.x >> 6);
    const int tid = wave * 64 + lane_id();
    const int G_k = gridDim.x; const int bx_k = blockIdx.x;
    for (int u = tid; u < (LDS_BYTES - LDSCTL_OFF) / 4; u += NWAVES * 64) ((LAS unsigned*)(lds + LDSCTL_OFF))[u] = 0u;
    __syncthreads();
    volatile LAS unsigned long long* const PT = (volatile LAS unsigned long long*)(lds + PT_OFF);
    if (tid == 0) {
#pragma unroll
        for (int i = 0; i < N_IN; ++i) PT[i] = (unsigned long long)args.in[i];
        PT[N_IN] = (unsigned long long)args.out; PT[N_IN + 1] = (unsigned long long)args.ws; }
    const int lo = args.ph_lo, hi = args.ph_hi;
    __syncthreads();
#define LDP(i) ({ const unsigned long long v_ = PT[i]; (unsigned long long)(unsigned)__builtin_amdgcn_readfirstlane((int)(unsigned)v_) | ((unsigned long long)(unsigned)__builtin_amdgcn_readfirstlane((int)(unsigned)(v_ >> 32)) << 32); })
#define INP(i) ((const float*)(const GAS float*)LDP(i))
#define WSP() ((unsigned char*)(GAS unsigned char*)LDP(N_IN + 1))
#define OUTP() ((float*)(GAS float*)LDP(N_IN))
#define PH_WS() int* SLOT_TOK; float* SLOT_GATE; int* TOK_SLOT; asm volatile("" ::: "memory"); int tid = wave * 64 + lane_id(); asm volatile("" : "+v"(tid)); const int lane = tid & 63; (void)lane; \
    int G = G_k, bx = bx_k; asm volatile("" : "+s"(G), "+s"(bx));     \
    const int vcu = (G % 8 == 0) ? (bx % 8) * (G / 8) + bx / 8 : bx; const int gw = vcu * NWAVES + wave, NGW = G * NWAVES; (void)gw; (void)NGW; (void)vcu; unsigned char* const ws = WSP(); \
    bf16* const HB = (bf16*)(ws + WS_HB); float* const CS = (float*)(ws + WS_CS); float* const SN = (float*)(ws + WS_SN); float* const SSQ = (float*)(ws + WS_SSQ); bf16* const X = (bf16*)(ws + WS_X); \
    SLOT_TOK = (int*)(ws + WS_SLOTTOK); SLOT_GATE = (float*)(ws + WS_SLOTGATE); TOK_SLOT = (int*)(ws + WS_TOKSLOT); (void)HB; (void)CS; (void)SN; (void)SSQ; (void)X; (void)SLOT_TOK; (void)SLOT_GATE; (void)TOK_SLOT
    XcdBarrier bar; { unsigned char* const ws0 = WSP(); bar.bar = (unsigned*)(ws0 + WS_CTL) + CW_BAR; bar.x = 0; bar.st = nullptr;
    if (hi - lo > 1) bar = xcd_barrier_post((unsigned*)(ws0 + WS_CTL) + CW_BAR, MISC + 8, tid); }
#define IN(k) (lo <= (k) && (k) < hi)
#define SEAM(k) do { if (IN(k) && IN((k) + 1)) xcd_barrier(bar, wave * 64 + lane_id()); } while (0)

    if (IN(0)) { PH_WS();
        LAS float* scr = (LAS float*)(lds + RING_OFF + wave * 16384);
        constexpr int I_IN = (D / 64) * (INDIM / 32), I_UQ = (QRANK / 64) * (3072 / 32), I_UKV = (KVRANK / 64) * (4096 / 32), I_SQ = (D / 64) * (D / 32), I_LAYER = I_IN + I_UQ + I_UKV + 3 * I_SQ;
        constexpr int I_F = (D / 64) * (DFF / 32), I_F2 = (DFF / 64) * (D / 32), NITEMS = 2 * I_LAYER + 2 * I_F + I_F2;
        for (int it = gw; it < NITEMS; it += NGW) {
            int r = it;
            if (r < 2 * I_LAYER) { const int l = r / I_LAYER; r -= l * I_LAYER; unsigned char* wl = ws + WS_W + l * WL_STRIDE;
                if (r < I_IN) { const int nblk = INDIM / 32, kb = r / nblk, nb = r % nblk; transpose_item(INP(I_WIN) + (size_t)l * D * INDIM, INDIM, 64 * kb, 32 * nb, (bf16*)(ws + WS_W + l * WL_STRIDE + WL_IN), D, dmap_in(32 * nb), 0, nullptr, scr, lane); continue; } r -= I_IN;
                if (r < I_UQ) { const int nblk = 3072 / 32, kb = r / nblk, nb = r % nblk; transpose_item(INP(I_WUQ) + (size_t)l * QRANK * 3072, 3072, 64 * kb, 32 * nb, (bf16*)(ws + WS_W + l * WL_STRIDE + WL_UQ), QRANK, dmap_uq(32 * nb), 0, INP(I_QNG) + l * QRANK, scr, lane); continue; } r -= I_UQ;
                if (r < I_UKV) { const int nblk = 4096 / 32, kb = r / nblk, nb = r % nblk; transpose_item(INP(I_WUKV) + (size_t)l * KVRANK * 4096, 4096, 64 * kb, 32 * nb, (bf16*)(ws + WS_W + l * WL_STRIDE + WL_UKV), KVRANK, 32 * nb, 0, INP(I_KVNG) + l * KVRANK, scr, lane); continue; } r -= I_UKV;
                { const int which = r / I_SQ; r -= which * I_SQ; const int nblk = D / 32, kb = r / nblk, nb = r % nblk;
                  if (which == 0) transpose_item(INP(I_WPA) + (size_t)l * D * D, D, 64 * kb, 32 * nb, (bf16*)(ws + WS_W + l * WL_STRIDE + WL_AB), 2 * D, 32 * nb, 0, nullptr, scr, lane);
                  else if (which == 1) transpose_item(INP(I_WPB) + (size_t)l * D * D, D, 64 * kb, 32 * nb, (bf16*)(ws + WS_W + l * WL_STRIDE + WL_AB), 2 * D, 32 * nb, D, nullptr, scr, lane);
                  else transpose_item(INP(I_WOUT) + (size_t)l * D * D, D, 64 * kb, 32 * nb, (bf16*)(ws + WS_W + l * WL_STRIDE + WL_OUT), D, 32 * nb, 0, nullptr, scr, lane);
                  continue; }
            }
            r -= 2 * I_LAYER;
            if (r < 2 * I_F) { const int which = r / I_F; r -= which * I_F; const int nblk = DFF / 32, kb = r / nblk, nb = r % nblk;
                transpose_item(INP(which ? I_FW3 : I_FW1), DFF, 64 * kb, 32 * nb, (bf16*)(ws + WS_WF13), D, dmap_glu(32 * nb) + (which ? 128 : 0), 0, nullptr, scr, lane); continue; }
            r -= 2 * I_F;
            { const int nblk = D / 32, kb = r / nblk, nb = r % nblk; transpose_item(INP(I_FW2), D, 64 * kb, 32 * nb, (bf16*)(ws + WS_WF2), DFF, 32 * nb, 0, nullptr, scr, lane); }
        }
        for (int i = gw * 64 + lane; i < 2 * 192 * 256; i += NGW * 64) { const int l = i / (192 * 256), q = i % (192 * 256), rr = q / 256, c16 = q % 256; const int row = rr < 96 ? 1312 + rr : 1440 + (rr - 96);
            *(GAS v4u*)(ws + WS_W + l * WL_STRIDE + WL_IN + (size_t)row * (D * 2) + c16 * 16) = (v4u){0u, 0u, 0u, 0u}; }
        for (int i = gw * 64 + lane; i < LPOS * 32; i += NGW * 64) { const int pos = i >> 5, k = i & 31; const float inv = powf(10000.f, -(float)(2 * k) / 64.f); const float ang = (float)pos * inv; CS[i] = cosf(ang); SN[i] = sinf(ang); }
        for (int i = gw * 64 + lane; i < 16 * 512; i += NGW * 64) { const int hh = i >> 9, rel = (i & 511) - 256; const float bv = INP(I_RELB)[t5_bucket(rel) * 16 + hh] * LOG2E;
            ((float*)(ws + WS_TW))[i] = (rel >= -128 && rel <= 128) ? bv : att::NEG_BIG; if (rel < 0) ((float*)(ws + WS_TM))[hh * 256 + rel + 256] = bv; }
        if (gw == 0 && lane < 32) ((float*)(ws + WS_SINK))[lane] = INP(I_SINK)[lane] * LOG2E;
        { const float* eg = INP(I_EMB_G); const float* eb = INP(I_EMB_B); const float* xin = INP(I_X); const float* min_ = INP(I_META);
#define P0_LOAD(R, m) row_load_f32(R, (m) < TREAL ? xin + (size_t)(m) * D : min_ + (size_t)(((m) - TREAL) & 15) * D, lane)
#define P0_PROC(R, m) do { ln_normalize(R); ln_affine(R, eg, eb, lane); row_store_bf16(R, HB + (size_t)(m) * D, lane); } while (0)
          Row8 ra{}, rb{}; int m = gw; if (m < T) P0_LOAD(ra, m);
          for (; m < T; m += 2 * NGW) { const int m1 = m + NGW, m2 = m + 2 * NGW; if (m1 < T) P0_LOAD(rb, m1); P0_PROC(ra, m); if (m1 < T) { if (m2 < T) P0_LOAD(ra, m2); P0_PROC(rb, m1); } }
#undef P0_LOAD
#undef P0_PROC
          for (int mz = T + gw; mz < TP; mz += NGW) { GAS v2u* o8 = (GAS v2u*)(HB + (size_t)mz * D) + lane;
#pragma unroll
              for (int j = 0; j < 8; ++j) o8[64 * j] = (v2u){0u, 0u}; } }
    }
    SEAM(0);

#pragma unroll 1
    for (int l = 0; l < 2; ++l) {
        const int P = 1 + 9 * l + (l ? 0 : 0);
        const int nM_all = TREAL / 256;
        const int nM_post = TREAL / 256; const bool tail_post = (l == 0);
        if (IN(P + 0)) { PH_WS();
            ProbDense pr; pr.so.init(nM_all, NIN / 256, G, bx, true); pr.A = (const char*)HB; pr.Bt = (const char*)(ws + WS_W + l * WL_STRIDE + WL_IN); pr.tstep = 256 * (size_t)D * 2;
            epi::EpiWin E{(bf16*)(ws + WS_CQ), (bf16*)(ws + WS_CKV), (bf16*)(ws + WS_KR), (bf16*)(ws + WS_QB), (bf16*)(ws + WS_KB), (bf16*)(ws + WS_VB), (bf16*)(ws + WS_GR), (bf16*)(ws + WS_GBB), SSQ, CS, SN};
            pg8::gemm_phase<epi::EpiWin, ProbDense>(lds + RING_OFF, D, pr, E, tid);
        }
        SEAM(P + 0);
        if (IN(P + 1)) { PH_WS();
            { ProbDense pr; pr.so.init(nM_all, 3072 / 256, G, bx, true); pr.A = (const char*)(ws + WS_CQ); pr.Bt = (const char*)(ws + WS_W + l * WL_STRIDE + WL_UQ); pr.tstep = 256 * (size_t)QRANK * 2;
              epi::EpiUq E{(bf16*)(ws + WS_Q), SSQ, CS, SN};
              pg8::gemm_phase<epi::EpiUq, ProbDense>(lds + RING_OFF, QRANK, pr, E, tid); }
            { ProbDense pr; pr.so.init(nM_all, 4096 / 256, G, bx, true); pr.A = (const char*)(ws + WS_CKV); pr.Bt = (const char*)(ws + WS_W + l * WL_STRIDE + WL_UKV); pr.tstep = 256 * (size_t)KVRANK * 2;
              epi::EpiUkv E{(bf16*)(ws + WS_KN), (bf16*)(ws + WS_V), SSQ};
              pg8::gemm_phase<epi::EpiUkv, ProbDense>(lds + RING_OFF, KVRANK, pr, E, tid); }
        }
        SEAM(P + 1);
        if (IN(P + 2)) { PH_WS();
            const int nqb = l == 0 ? 17 : 16, nmla_full = NB * NH * 16, nmla = NB * NH * nqb;
            for (int u = vcu; u < nmla; u += G) {
                int b, h, qb;
                if (u < nmla_full) { qb = u & 15; h = (u >> 4) & 15; b = u >> 8; } else { const int v = u - nmla_full; qb = 16; h = v & 15; b = v >> 4; }
                att::mla_unit4((att::lds_ptr)(lds + RING_OFF), (const bf16*)(ws + WS_Q), (const bf16*)(ws + WS_KN), (const bf16*)(ws + WS_KR), (const bf16*)(ws + WS_V), (bf16*)(ws + WS_OAB), b, h, qb, tid);
            }
            const int nj = l == 0 ? 65 : 64, nswa_full = NB * 4 * 64, nswa = NB * 4 * nj;
            int tables_hk = -1;
            for (int u = vcu; u < nswa; u += G) {
                int b, hk, j;
                if (u < nswa_full) { j = u & 63; hk = (u >> 6) & 3; b = u >> 8; } else { const int v = u - nswa_full; j = 64; hk = v & 3; b = v >> 2; }
                att::swa_unit2((att::lds_ptr)(lds + RING_OFF), (const bf16*)(ws + WS_QB), (const bf16*)(ws + WS_KB), (const bf16*)(ws + WS_VB), (bf16*)(ws + WS_OAB), (const float*)(ws + WS_TW), (const float*)(ws + WS_TM), (const float*)(ws + WS_SINK) + 16 * l, b, hk, j, tables_hk, tid);
            }
        }
        SEAM(P + 2);
        if (IN(P + 3)) { PH_WS();
            ProbDense pr; pr.so.init(nM_post, D / 256, G, bx, tail_post); pr.A = (const char*)(ws + WS_OAB); pr.Bt = (const char*)(ws + WS_W + l * WL_STRIDE + WL_AB); pr.tstep = 256 * (size_t)(2 * D) * 2;
            epi::EpiProj E{(bf16*)(ws + WS_MG), (const bf16*)(ws + WS_GR), (const bf16*)(ws + WS_GBB)};
            pg8::gemm_phase<epi::EpiProj, ProbDense>(lds + RING_OFF, 2 * D, pr, E, tid);
        }
        SEAM(P + 3);
        if (IN(P + 4)) { PH_WS();
            ProbDense pr; pr.so.init(nM_post, D / 256, G, bx, tail_post); pr.A = (const char*)(ws + WS_MG); pr.Bt = (const char*)(ws + WS_W + l * WL_STRIDE + WL_OUT); pr.tstep = 256 * (size_t)D * 2;
            epi::EpiResid E{X, HB};
            pg8::gemm_phase<epi::EpiResid, ProbDense>(lds + RING_OFF, D, pr, E, tid);
        }
        SEAM(P + 4);
        if (IN(P + 5)) { PH_WS();
            const float* g = INP(I_LMG) + l * D; const float* bta = INP(I_LMB) + l * D;
            const int nrows = l == 0 ? T : TREAL;
            int h0 = 0, h1 = 0, h2 = 0, h3 = 0, h4 = 0, h5 = 0, h6 = 0, h7 = 0;
            LAS f32x4* const rwl = (LAS f32x4*)(lds + RING_OFF);
            if (l == 1) { const GAS f32x4* rwg = (const GAS f32x4*)INP(I_RW); for (int i = tid; i < D * 2; i += NWAVES * 64) { const int k = i >> 1, hf = i & 1, e = k & 7, jq = (2 * (k >> 9) + (e >> 2)) * 4 + (e & 3); rwl[hf * 2048 + jq * 64 + ((k >> 3) & 63)] = rwg[i]; } __syncthreads(); }
#define LM_PROC(r, m) do { ln_normalize(r); ln_affine(r, g, bta, lane); row_store_bf16(r, HB + (size_t)(m) * D, lane); \
                if (l == 1) { int i0_, i1_; float g0_, g1_; router_row(r, rwl, rbias, lane, i0_, i1_, g0_, g1_); \
                    if (lane == 0) { int* ti = (int*)(ws + WS_TOPI); float* tg = (float*)(ws + WS_TOPG); ti[2 * (m)] = i0_; ti[2 * (m) + 1] = i1_; tg[2 * (m)] = g0_; tg[2 * (m) + 1] = g1_; } \
                    h0 += (i0_ == 0) + (i1_ == 0); h1 += (i0_ == 1) + (i1_ == 1); h2 += (i0_ == 2) + (i1_ == 2); h3 += (i0_ == 3) + (i1_ == 3); \
                    h4 += (i0_ == 4) + (i1_ == 4); h5 += (i0_ == 5) + (i1_ == 5); h6 += (i0_ == 6) + (i1_ == 6); h7 += (i0_ == 7) + (i1_ == 7); } } while (0)
            { const float* rbias = INP(I_RB); Row8 ra{}, rb{}; int m = gw; if (m < nrows) row_load_bf16(ra, X + (size_t)m * D, lane);
              for (; m < nrows; m += 2 * NGW) { const int m1 = m + NGW, m2 = m + 2 * NGW; if (m1 < nrows) row_load_bf16(rb, X + (size_t)m1 * D, lane); LM_PROC(ra, m);
                  if (m1 < nrows) { if (m2 < nrows) row_load_bf16(ra, X + (size_t)m2 * D, lane); LM_PROC(rb, m1); } } }
#undef LM_PROC
            if (l == 1 && lane == 0) { int* wh = (int*)(ws + WS_WHIST) + gw * 8; wh[0] = h0; wh[1] = h1; wh[2] = h2; wh[3] = h3; wh[4] = h4; wh[5] = h5; wh[6] = h6; wh[7] = h7; }
        }
        SEAM(P + 5);
        if (l == 0) {
            if (IN(P + 6)) { PH_WS();
                ProbDense pr; pr.so.init(nM_all, 2 * DFF / 256, G, bx, true); pr.A = (const char*)HB; pr.Bt = (const char*)(ws + WS_WF13); pr.tstep = 256 * (size_t)D * 2;
                epi::EpiSwiglu E{(bf16*)(ws + WS_ACT)};
                pg8::gemm_phase<epi::EpiSwiglu, ProbDense>(lds + RING_OFF, D, pr, E, tid);
            }
            SEAM(P + 6);
            if (IN(P + 7)) { PH_WS();
                ProbDense pr; pr.so.init(nM_all, D / 256, G, bx, true); pr.A = (const char*)(ws + WS_ACT); pr.Bt = (const char*)(ws + WS_WF2); pr.tstep = 256 * (size_t)DFF * 2;
                epi::EpiResid E{X, HB};
                pg8::gemm_phase<epi::EpiResid, ProbDense>(lds + RING_OFF, DFF, pr, E, tid);
            }
            SEAM(P + 7);
            if (IN(P + 8)) { PH_WS();
                const float* g = INP(I_LFG); const float* bta = INP(I_LFB);
#define LF_PROC(r, m) do { ln_normalize(r); ln_affine(r, g, bta, lane); row_store_bf16(r, HB + (size_t)(m) * D, lane); } while (0)
                { Row8 ra{}, rb{}; int m = gw; if (m < T) row_load_bf16(ra, X + (size_t)m * D, lane);
                  for (; m < T; m += 2 * NGW) { const int m1 = m + NGW, m2 = m + 2 * NGW; if (m1 < T) row_load_bf16(rb, X + (size_t)m1 * D, lane); LF_PROC(ra, m);
                      if (m1 < T) { if (m2 < T) row_load_bf16(ra, X + (size_t)m2 * D, lane); LF_PROC(rb, m1); } } }
#undef LF_PROC
            }
            SEAM(P + 8);
        } else {
            if (IN(P + 6)) { PH_WS();
                LAS int* hist = (LAS int*)(lds + RING_OFF);
                LAS int* segsum = hist + 2048 * 8;
                LAS int* segpre = segsum + 64 * 8;
                LAS int* tot = segpre + 64 * 8;
                const int* wh = (const int*)(ws + WS_WHIST);
                for (int i = tid; i < NGW * 8; i += NWAVES * 64) hist[i] = wh[i];
                __syncthreads();
                { const int e = tid & 7, seg = tid >> 3; int s = 0;
_Pragma("unroll 1")
                  for (int w = 0; w < 32; ++w) { const int ww = seg * 32 + w; if (ww < NGW) s += hist[ww * 8 + e]; } segsum[seg * 8 + e] = s; }
                __syncthreads();
                if (tid < 8) { int run = 0;
_Pragma("unroll 1")
                    for (int s = 0; s < 64; ++s) { segpre[s * 8 + tid] = run; run += segsum[s * 8 + tid]; } tot[tid] = run; }
                __syncthreads();
                if (tid == 0) { int ts = 0; for (int e = 0; e < 8; ++e) { tot[8 + e] = ts; ts += (tot[e] + 255) >> 8; } tot[16] = ts;
                    if (bx == 0) for (int e = 0; e < 9; ++e) ((int*)(ws + WS_CTL))[CW_MOE_TS + e] = tot[8 + e]; }
                __syncthreads();
                int base = 0;
                if (lane < 8) { base = tot[8 + lane] * 256 + segpre[(gw >> 5) * 8 + lane];
_Pragma("unroll 1")
                    for (int w = (gw & ~31); w < gw; ++w) base += hist[w * 8 + lane]; }
                const int* ti = (const int*)(ws + WS_TOPI); const float* tg = (const float*)(ws + WS_TOPG);
                for (int i0 = 0; gw + i0 * NGW < TREAL; i0 += 16) {
                    const int m = gw + (i0 + (lane >> 1)) * NGW, kk = lane & 1; const bool valid = lane < 32 && m < TREAL;
                    const int e = valid ? ti[2 * m + kk] : 8; const float gt = valid ? tg[2 * m + kk] : 0.f;
                    int myslot = 0;
#pragma unroll
                    for (int e2 = 0; e2 < 8; ++e2) { const unsigned long long mask = __ballot(e == e2); const int b_e = __builtin_amdgcn_readlane(base, e2);
                        if (e == e2) myslot = b_e + __popcll(mask & ((1ull << lane) - 1ull)); if (lane == e2) base += __popcll(mask); }
                    if (valid) { SLOT_TOK[myslot] = m; SLOT_GATE[myslot] = gt; TOK_SLOT[2 * m + kk] = myslot; }
                }
                if (vcu < 8) { const int e = vcu; const int s0 = tot[8 + e] * 256 + tot[e], s1 = tot[8 + e + 1] * 256; for (int s = s0 + tid; s < s1; s += NWAVES * 64) { SLOT_TOK[s] = T; SLOT_GATE[s] = 0.f; } }
                __syncthreads();
                LAS float* scr = (LAS float*)(lds + RING_OFF + wave * 16384);
                constexpr int I_F = (D / 64) * (DFF / 32), I_F2 = (DFF / 64) * (D / 32), I_E = 2 * I_F + I_F2;
                { const float* mw1 = INP(I_MW1); const float* mw3 = INP(I_MW3); const float* mw2 = INP(I_MW2);
#define MOE_DESC(d, it_) do { const int e_ = (it_) / I_E; int r_ = (it_) - e_ * I_E; \
                    if (r_ < 2 * I_F) { const int wh_ = r_ / I_F; r_ -= wh_ * I_F; const int kb_ = r_ / (DFF / 32), nb_ = r_ % (DFF / 32); \
                        d.W = (wh_ ? mw3 : mw1) + (size_t)e_ * D * DFF; d.ldw = DFF; d.k0 = 64 * kb_; d.n0 = 32 * nb_; d.WT = (bf16*)(ws + WS_MW13) + (size_t)e_ * 2 * DFF * D; d.ldt = D; d.drow = dmap_glu(32 * nb_) + (wh_ ? 128 : 0); } \
                    else { r_ -= 2 * I_F; const int kb_ = r_ / (D / 32), nb_ = r_ % (D / 32); \
                        d.W = mw2 + (size_t)e_ * DFF * D; d.ldw = D; d.k0 = 64 * kb_; d.n0 = 32 * nb_; d.WT = (bf16*)(ws + WS_MW2) + (size_t)e_ * D * DFF; d.ldt = DFF; d.drow = 32 * nb_; } } while (0)
                  constexpr int NIT = NE * I_E; TDesc da{}, db{}; f32x4 va[8] = {}, vb[8] = {};
                  int it = gw; if (it < NIT) { MOE_DESC(da, it); t_load(da, va, lane); }
                  for (; it < NIT; it += 2 * NGW) { const int it1 = it + NGW, it2 = it + 2 * NGW;
                      if (it1 < NIT) { MOE_DESC(db, it1); t_load(db, vb, lane); }
                      t_finish(da, va, scr, lane);
                      if (it1 < NIT) { if (it2 < NIT) { MOE_DESC(da, it2); t_load(da, va, lane); } t_finish(db, vb, scr, lane); } }
#undef MOE_DESC
                }
            }
            SEAM(P + 6);
            MoeTiles mt;
            if (IN(P + 7) || IN(P + 8)) { unsigned char* const ws = WSP();
#pragma unroll
                for (int e = 0; e < 9; ++e) mt.ts[e] = __builtin_amdgcn_readfirstlane(((const int*)(ws + WS_CTL))[CW_MOE_TS + e]);
            } else {
#pragma unroll
                for (int e = 0; e < 9; ++e) mt.ts[e] = 0;
            }
            if (IN(P + 7)) { PH_WS();
                ProbMoe1 pr; pr.so.init(mt.ts[8], 2 * DFF / 256, G, bx); pr.HBp = (const char*)HB; pr.slot_tok = SLOT_TOK; pr.W = (const char*)(ws + WS_MW13); pr.mt = mt;
                epi::EpiSwiglu E{(bf16*)(ws + WS_MACT)};
                pg8::gemm_phase<epi::EpiSwiglu, ProbMoe1, true>(lds + RING_OFF, D, pr, E, tid);
            }
            SEAM(P + 7);
            if (IN(P + 8)) { PH_WS();
                ProbMoe2 pr; pr.so.init(mt.ts[8], D / 256, G, bx); pr.ACTp = (const char*)(ws + WS_MACT); pr.W = (const char*)(ws + WS_MW2); pr.mt = mt;
                epi::EpiMoeDown E{(bf16*)(ws + WS_Y), SLOT_GATE};
                pg8::gemm_phase<epi::EpiMoeDown, ProbMoe2>(lds + RING_OFF, DFF, pr, E, tid);
            }
            SEAM(P + 8);
            if (IN(P + 9)) { PH_WS();
                const float* g = INP(I_LFG) + D; const float* bta = INP(I_LFB) + D; const bf16* Y = (const bf16*)(ws + WS_Y);
#define FL_LOAD(R, m) do { const int s0_ = TOK_SLOT[2 * (m)], s1_ = TOK_SLOT[2 * (m) + 1]; \
                    _Pragma("unroll") for (int jj = 0; jj < 4; ++jj) { f32x4 h0, h1, a0, a1, b0, b1; bf8(*((const GAS v4u*)(HB + (size_t)(m) * D) + lane + 64 * jj), h0, h1); \
                        bf8(*((const GAS v4u*)(Y + (size_t)s0_ * D) + lane + 64 * jj), a0, a1); bf8(*((const GAS v4u*)(Y + (size_t)s1_ * D) + lane + 64 * jj), b0, b1); \
                        R.v[2 * jj] = (h0 * ALPHA + a0) + b0; R.v[2 * jj + 1] = (h1 * ALPHA + a1) + b1; } } while (0)
#define FL_PROC(R, m) do { ln_normalize(R); ln_affine(R, g, bta, lane); row_store_f32(R, outp + (size_t)(m) * D, lane); } while (0)
                { float* const outp = OUTP(); Row8 ra{}, rb{}; int m = gw; if (m < TREAL) FL_LOAD(ra, m);
                  for (; m < TREAL; m += 2 * NGW) { const int m1 = m + NGW, m2 = m + 2 * NGW; if (m1 < TREAL) FL_LOAD(rb, m1); FL_PROC(ra, m);
                      if (m1 < TREAL) { if (m2 < TREAL) FL_LOAD(ra, m2); FL_PROC(rb, m1); } } }
#undef FL_LOAD
#undef FL_PROC
            }
        }
    }
#undef IN
#undef SEAM
}

#ifndef MK_ONE_LAUNCH
#define MK_ONE_LAUNCH 0
#endif
extern "C" void kernel_launch(void* const* d_in, const int* in_sizes, int n_in, void* d_out, int out_size, void* d_ws, size_t ws_size, hipStream_t stream) {
    static int grid = 0;
    if (grid == 0) {
        if (n_in != N_IN || in_sizes[0] != NB * SEQ * D || out_size != NB * SEQ * D || ws_size < WS_END) { fprintf(stderr, "kernel_launch: shape mismatch: n_in %d in0 %d out %d ws %zu (need %zu)\n", n_in, n_in > 0 ? in_sizes[0] : -1, out_size, ws_size, (size_t)WS_END); grid = -1; return; }
        int dev = 0, cus = 0, per_cu = 0;
        if (hipGetDevice(&dev) != hipSuccess || hipDeviceGetAttribute(&cus, hipDeviceAttributeMultiprocessorCount, dev) != hipSuccess) { fprintf(stderr, "kernel_launch: device query failed\n"); grid = -1; return; }
        if (hipFuncSetAttribute((const void*)mk_fwd, hipFuncAttributeMaxDynamicSharedMemorySize, LDS_BYTES) != hipSuccess) { fprintf(stderr, "kernel_launch: hipFuncSetAttribute failed\n"); grid = -1; return; }
        if (hipOccupancyMaxActiveBlocksPerMultiprocessor(&per_cu, (const void*)mk_fwd, NWAVES * 64, LDS_BYTES) != hipSuccess || per_cu < 1) fprintf(stderr, "kernel_launch: occupancy query reports %d\n", per_cu);
        (void)hipGetLastError();
        grid = cus;
    }
    if (grid < 0) return;
    if (hipMemsetAsync((char*)d_ws + WS_CTL, 0, CTL_ZERO_BYTES, stream) != hipSuccess) { fprintf(stderr, "kernel_launch: memset failed\n"); return; }
    Args a{};
    for (int i = 0; i < N_IN; ++i) a.in[i] = (const float*)d_in[i];
    a.out = (float*)d_out; a.ws = (unsigned char*)d_ws;
#if MK_ONE_LAUNCH
    a.ph_lo = 0; a.ph_hi = N_PHASES;
    hipLaunchKernelGGL(mk_fwd, dim3(grid), dim3(NWAVES * 64), LDS_BYTES, stream, a);
#else
    for (int p = 0; p < N_PHASES; ++p) { a.ph_lo = p; a.ph_hi = p + 1; hipLaunchKernelGGL(mk_fwd, dim3(grid), dim3(NWAVES * 64), LDS_BYTES, stream, a); }
#endif
    const hipError_t le = hipPeekAtLastError();
    if (le != hipSuccess) fprintf(stderr, "kernel_launch: launch failed: %s\n", hipGetErrorName(le));
}
```

```cpp
#define MK_ONE_LAUNCH 1
#include <hip/hip_runtime.h>
#include <cstdio>
#include <cstdint>
#include <type_traits>
namespace pg8 {
#define PG8_LAS __attribute__((address_space(3)))
typedef unsigned short bf16_t;
typedef short bf16x8 __attribute__((ext_vector_type(8)));
typedef float f32x4 __attribute__((ext_vector_type(4)));
typedef float f32x2 __attribute__((ext_vector_type(2)));
typedef unsigned u32x4 __attribute__((ext_vector_type(4)));
typedef unsigned u32x2 __attribute__((ext_vector_type(2)));
constexpr int BM = 256, BK = 64, HALF = 128, HTB = HALF * BK * 2  , STAGE_BYTES = 8 * HTB, NXCD = 8, WGM = 8;

__host__ __device__ __forceinline__ int lds_byte(int r, int c) { const int st = (r >> 4) * 2 + (c >> 5), rr = r & 15, cc = c & 31, ob = rr * 64 + cc * 2; return st * 1024 + (ob ^ (((ob >> 9) & 1) << 5)); }
__host__ __device__ __forceinline__ void stage_rc(int b, int& R, int& C) { const int st = b / 1024, sb = b % 1024, swz = sb ^ (((sb >> 9) & 1) << 5); R = (st >> 1) * 16 + swz / 64; C = (st & 1) * 32 + (swz % 64) / 2; }
__host__ __device__ __forceinline__ int perm32(int rho) { const int n = rho >> 4, i = rho & 15; return 8 * (i >> 2) + 4 * n + (i & 3); }

struct Unit { int pm, pn, ks; };

struct StaticOrder {
    int nM, nN, nwg, G, c, ntail, kshift;
    __device__ __forceinline__ void init(int nM_, int nN_, int G_, int c_, bool tail = false, int kshift_ = 0) { nM = nM_; nN = nN_; nwg = nM * nN; G = G_; c = c_; kshift = kshift_; ntail = tail ? (nN_ << kshift_) : 0; }
    __device__ __forceinline__ bool next(int i, Unit& u) const {
        const long L = (long)i * G + c; if (L >= nwg + ntail) return false;
        u.ks = -1;
        if (L >= nwg) { const int t = (int)(L - nwg); u.pm = nM; u.pn = t >> kshift; if (kshift) u.ks = t & ((1 << kshift) - 1); return true; }
        int wgid = (int)L; { const int q = nwg / NXCD, r = nwg % NXCD, xcd = wgid % NXCD, off = wgid / NXCD; wgid = (xcd < r ? xcd * (q + 1) : r * (q + 1) + (xcd - r) * q) + off; }
        const int nig = WGM * nN, gid = wgid / nig, fm = gid * WGM, gsz = (nM - fm) < WGM ? (nM - fm) : WGM;
        u.pm = fm + ((wgid % nig) % gsz); u.pn = (wgid % nig) / gsz; return true;
    }
    __device__ __forceinline__ bool is_half(const Unit& u) const { return ntail != 0 && u.pm == nM; }
};
typedef __bf16 bf16x2_t __attribute__((ext_vector_type(2)));
__device__ __forceinline__ unsigned cvt_pk_bf16(float lo, float hi) { const f32x2 v = {lo, hi}; const bf16x2_t b = __builtin_convertvector(v, bf16x2_t); return __builtin_bit_cast(unsigned, b); }
__device__ __forceinline__ float bf_lo(unsigned w) { return __uint_as_float(w << 16); }
__device__ __forceinline__ float bf_hi(unsigned w) { return __uint_as_float(w & 0xffff0000u); }

template <class Epi, class Prob, bool GATHER = false>
__device__ __forceinline__ void gemm_phase(PG8_LAS unsigned char* lds, const int K, const Prob& S, const Epi& E, const int tid_in) {
    int tid_ = tid_in; asm volatile("" : "+v"(tid_));
    const int tid = tid_, wid = __builtin_amdgcn_readfirstlane(tid >> 6), lane = tid & 63, wr = wid >> 2, wc = wid & 3, fr = lane & 15, fq = lane >> 4;
    const int nt_full = K / BK;
    int sR[2], sC[2];
    unsigned voffA[2][2], nvoffA[2][2], voffB[2]; int ntok[2][2] = {{0, 0}, {0, 0}};
#pragma unroll
    for (int i = 0; i < 2; ++i) { int R, C; stage_rc(tid * 16 + i * 8192, R, C); sR[i] = R; sC[i] = C; const int Rb = (R & ~31) + perm32(R & 31);
        voffB[i] = (unsigned)(Rb * K + C) * 2u;
        voffA[0][i] = (unsigned)(R * K + C) * 2u; voffA[1][i] = (unsigned)((R + HALF) * K + C) * 2u; nvoffA[0][i] = voffA[0][i]; nvoffA[1][i] = voffA[1][i]; }
    const size_t kstep = (size_t)(BK * 2);
    const size_t hstep = (size_t)HALF * K * 2;
    const unsigned ldsw = (unsigned)wid * 1024u;
    const int aoff = lds_byte(wr * 64 + fr, fq * 8), boff = lds_byte(wc * 32 + fr, fq * 8);
#define PG8_SA(b, h) (((b) * 2 + (h)) * HTB)
#define PG8_SB(b, h) ((4 + (b) * 2 + (h)) * HTB)
#define PG8_STAGE(bufoff, gbase, voff) do { _Pragma("unroll") for (int _i = 0; _i < 2; ++_i) \
        __builtin_amdgcn_global_load_lds((const unsigned*)((const char*)(gbase) + (voff)[_i]), (PG8_LAS unsigned*)(lds + (bufoff) + ldsw + _i * 8192), 16, 0, 0); } while (0)
#define PG8_LDA(dst, b, h) do { _Pragma("unroll") for (int m = 0; m < 4; ++m) _Pragma("unroll") for (int k = 0; k < 2; ++k) dst[m][k] = *(const PG8_LAS bf16x8*)(lds + PG8_SA(b, h) + aoff + m * 2048 + k * 1024); } while (0)
#define PG8_LDB(dst, b, h) do { _Pragma("unroll") for (int n = 0; n < 2; ++n) _Pragma("unroll") for (int k = 0; k < 2; ++k) dst[n][k] = *(const PG8_LAS bf16x8*)(lds + PG8_SB(b, h) + boff + n * 2048 + k * 1024); } while (0)
#define PG8_MMA(ai, bj, At, Bt) do { __builtin_amdgcn_s_setprio(1); _Pragma("unroll") for (int m = 0; m < 4; ++m) _Pragma("unroll") for (int n = 0; n < 2; ++n) _Pragma("unroll") for (int k = 0; k < 2; ++k) \
        acc[ai][bj][m][n] = __builtin_amdgcn_mfma_f32_16x16x32_bf16(Bt[n][k], At[m][k], acc[ai][bj][m][n], 0, 0, 0); __builtin_amdgcn_s_setprio(0); } while (0)
#define PG8_WAIT_V(n) asm volatile("s_waitcnt vmcnt(" #n ")" ::: "memory")
#define PG8_WAIT_L(n) asm volatile("s_waitcnt lgkmcnt(" #n ")" ::: "memory")
#define PG8_WAIT_VR(relax) asm volatile("s_cmp_lg_u32 %0, 0\n\ts_cbranch_scc1 .Lrlx%=\n\ts_waitcnt vmcnt(8)\n.Lrlx%=:\n\ts_waitcnt vmcnt(%1)" :: "s"(relax), "n"(8 + Epi::NST) : "memory", "scc")
#define PG8_BAR __builtin_amdgcn_s_barrier()
#define PG8_SCHED __builtin_amdgcn_sched_barrier(0)
    Unit cur, nxt; int ui = 0; int post = 0;
    if (!S.next(0, cur)) return;
    f32x4 acc[2][2][4][2];
#pragma unroll
    for (int a = 0; a < 2; ++a)
#pragma unroll
        for (int b = 0; b < 2; ++b)
#pragma unroll
            for (int m = 0; m < 4; ++m)
#pragma unroll
                for (int n = 0; n < 2; ++n) acc[a][b][m][n] = (f32x4){0.f, 0.f, 0.f, 0.f};
    bf16x8 At[4][2], B0[2][2], B1[2][2];
    const char* cA = S.a_base(cur); const char* cB = S.b_base(cur);
    if constexpr (GATHER) {
#pragma unroll
        for (int h = 0; h < 2; ++h)
#pragma unroll
            for (int i = 0; i < 2; ++i) { voffA[h][i] = (unsigned)(S.a_row(cur, sR[i] + h * HALF) * K + sC[i]) * 2u; nvoffA[h][i] = voffA[h][i]; }
    }
    PG8_STAGE(PG8_SB(0, 0), cB, voffB); PG8_STAGE(PG8_SB(0, 1), cB + hstep, voffB); PG8_STAGE(PG8_SA(0, 0), cA, voffA[0]); PG8_STAGE(PG8_SA(0, 1), cA, voffA[1]);
    if (wr == 1) PG8_BAR;
    PG8_WAIT_V(2); PG8_BAR;
    PG8_STAGE(PG8_SB(1, 0), cB + kstep, voffB); PG8_STAGE(PG8_SA(1, 0), cA + kstep, voffA[0]); PG8_STAGE(PG8_SB(1, 1), cB + hstep + kstep, voffB);
    PG8_WAIT_V(6); PG8_BAR;
    for (;;) {
        const bool has_next = S.next(ui + 1, nxt);
        const bool half = S.is_half(cur);
        const int nt = S.nt(cur, nt_full);
        const char* nA = has_next ? S.a_base(nxt) : cA; const char* nB = has_next ? S.b_base(nxt) : cB;
        if constexpr (GATHER) { if (has_next) {
#pragma unroll
            for (int h = 0; h < 2; ++h)
#pragma unroll
                for (int i = 0; i < 2; ++i) ntok[h][i] = S.a_row(nxt, sR[i] + h * HALF); } }
        for (int t = 0; t < nt; t += 2) {
            const bool last = (t == nt - 2); int tz_ = t; asm volatile("" : "+s"(tz_)); const int relax = (tz_ == 0) ? post : 0;
            if constexpr (Epi::MID) { if (t == (nt >> 1)) E.mid(acc, cur, wr, wc, fr, fq); }
            const char* a1 = cA + (size_t)(t + 1) * kstep;
            const char* a2 = last ? nA : cA + (size_t)(t + 2) * kstep; const char* b2 = last ? nB : cB + (size_t)(t + 2) * kstep;
            const char* a3 = a2 + kstep; const char* b3 = b2 + kstep;
            unsigned vA2[2][2];
#pragma unroll
            for (int h = 0; h < 2; ++h)
#pragma unroll
                for (int i = 0; i < 2; ++i) vA2[h][i] = voffA[h][i];
            if constexpr (GATHER) { if (last) {
                asm volatile("" : "+v"(ntok[0][0]), "+v"(ntok[0][1]), "+v"(ntok[1][0]), "+v"(ntok[1][1]));
                if (has_next) {
#pragma unroll
                    for (int h = 0; h < 2; ++h)
#pragma unroll
                        for (int i = 0; i < 2; ++i) nvoffA[h][i] = (unsigned)(ntok[h][i] * K + sC[i]) * 2u; }
                vA2[0][0] = nvoffA[0][0]; vA2[0][1] = nvoffA[0][1]; vA2[1][0] = nvoffA[1][0]; vA2[1][1] = nvoffA[1][1]; } }
            PG8_LDB(B0, 0, 0); PG8_LDB(B1, 0, 1); PG8_SCHED; PG8_LDA(At, 0, 0); PG8_STAGE(PG8_SA(1, 1), a1, voffA[1]);
            PG8_WAIT_VR(relax); PG8_WAIT_L(0); PG8_BAR; PG8_MMA(0, 0, At, B0); PG8_MMA(0, 1, At, B1); PG8_BAR; PG8_SCHED;
            if (!half) PG8_LDA(At, 0, 1); PG8_STAGE(PG8_SB(0, 0), b2, voffB); PG8_STAGE(PG8_SB(0, 1), b2 + hstep, voffB); PG8_STAGE(PG8_SA(0, 0), a2, vA2[0]);
            PG8_WAIT_VR(relax); PG8_WAIT_L(0); PG8_BAR; if (!half) { PG8_MMA(1, 0, At, B0); PG8_MMA(1, 1, At, B1); } PG8_BAR; PG8_SCHED;
            PG8_LDB(B0, 1, 0); PG8_LDB(B1, 1, 1); PG8_SCHED; PG8_LDA(At, 1, 0); PG8_STAGE(PG8_SA(0, 1), a2, vA2[1]);
            PG8_WAIT_V(8); PG8_WAIT_L(0); PG8_BAR; PG8_MMA(0, 0, At, B0); PG8_MMA(0, 1, At, B1); PG8_BAR; PG8_SCHED;
            if (!half) PG8_LDA(At, 1, 1); PG8_STAGE(PG8_SB(1, 0), b3, voffB); PG8_STAGE(PG8_SB(1, 1), b3 + hstep, voffB); PG8_STAGE(PG8_SA(1, 0), a3, vA2[0]);
            PG8_WAIT_V(8); PG8_WAIT_L(0); PG8_BAR; if (!half) { PG8_MMA(1, 0, At, B0); PG8_MMA(1, 1, At, B1); } PG8_BAR; PG8_SCHED;
        }
        if (wr == 0) PG8_BAR;
        E(acc, cur, wr, wc, fr, fq);
        if (!has_next) break;
#pragma unroll
        for (int a = 0; a < 2; ++a)
#pragma unroll
            for (int b = 0; b < 2; ++b)
#pragma unroll
                for (int m = 0; m < 4; ++m)
#pragma unroll
                    for (int n = 0; n < 2; ++n) acc[a][b][m][n] = (f32x4){0.f, 0.f, 0.f, 0.f};
        cur = nxt; cA = nA; cB = nB; ++ui; post = Epi::NST > 0 ? 1 : 0; asm volatile("" : "+s"(post));
        if constexpr (GATHER) {
#pragma unroll
            for (int h = 0; h < 2; ++h)
#pragma unroll
                for (int i = 0; i < 2; ++i) voffA[h][i] = nvoffA[h][i]; }
        if (wr == 1) PG8_BAR;
    }
    PG8_WAIT_V(0);
    PG8_BAR;
#undef PG8_SA
#undef PG8_SB
#undef PG8_STAGE
#undef PG8_LDA
#undef PG8_LDB
#undef PG8_MMA
#undef PG8_WAIT_V
#undef PG8_WAIT_VR
#undef PG8_WAIT_L
#undef PG8_BAR
#undef PG8_SCHED
}
}
constexpr int D = 2048, NB = 8, SEQ = 4096, NMETA = 16, NH = 16;
constexpr int TREAL = NB * SEQ;
constexpr int T = TREAL + NB * NMETA;
constexpr int TP = 33024;
constexpr int LPOS = SEQ + NMETA;
constexpr int QRANK = 768, KVRANK = 512, DFF = 5632, NE = 8;
constexpr int NIN = 8704;
constexpr int INDIM = 8512;
constexpr float LN_EPS = 1e-5f, RMS_EPS = 1e-6f, ALPHA = 1.4142135623730951f;
constexpr float LOG2E = 1.4426950408889634f;
constexpr float QK_SCALE_MLA = 0.07216878364870322f * LOG2E;
constexpr float QK_SCALE_SWA = 0.08838834764831845f * LOG2E;

__device__ __forceinline__ int row_pos(int row) { return row < TREAL ? NMETA + (row & (SEQ - 1)) : ((row - TREAL) & (NMETA - 1)); }

struct ProbDense {
    pg8::StaticOrder so; const char* A; const char* Bt; size_t tstep;
    __device__ __forceinline__ bool next(int i, pg8::Unit& u) const { return so.next(i, u); }
    __device__ __forceinline__ size_t koff(const pg8::Unit& u) const { return u.ks < 0 ? (size_t)0 : (size_t)u.ks * ((tstep >> 8) >> so.kshift); }
    __device__ __forceinline__ const char* a_base(const pg8::Unit& u) const { return A + (size_t)u.pm * tstep + koff(u); }
    __device__ __forceinline__ const char* b_base(const pg8::Unit& u) const { return Bt + (size_t)u.pn * tstep + koff(u); }
    __device__ __forceinline__ int a_row(const pg8::Unit&, int) const { return 0; }
    __device__ __forceinline__ bool is_half(const pg8::Unit& u) const { return so.is_half(u); }
    __device__ __forceinline__ int nt(const pg8::Unit& u, int ntf) const { return u.ks < 0 ? ntf : (ntf >> so.kshift); }
};
struct MoeTiles { int ts[9]; };
__device__ __forceinline__ int moe_expert(const MoeTiles& mt, int pm) { int e = 0;
#pragma unroll
    for (int k = 1; k < 8; ++k) e += (pm >= mt.ts[k]) ? 1 : 0; return e; }
constexpr size_t MW_MiB = 1u << 20, MW_B = 1583 * MW_MiB, MW_E = 66 * MW_MiB, MW_E5 = 138 * MW_MiB, MW_E6 = 271 * MW_MiB, MW_E7A = 1067 * MW_MiB, MW_E7B = 205 * MW_MiB;
__device__ __forceinline__ const char* moe_w13(int e, const char* out, const char* ws) {
    return e <= 3 ? out + (size_t)e * MW_E : (e == 4 ? ws + MW_B + 22 * MW_MiB : (e == 5 ? ws + MW_E5 : (e == 6 ? ws + MW_E6 : ws + MW_E7A))); }
__device__ __forceinline__ const char* moe_w2(int e, const char* out, const char* ws) {
    return e <= 2 ? out + (size_t)e * MW_E + 44 * MW_MiB : (e == 3 ? ws + MW_B : (e == 4 ? ws + MW_B + 66 * MW_MiB : (e == 5 ? ws + MW_E5 + 44 * MW_MiB : (e == 6 ? ws + MW_E6 + 44 * MW_MiB : ws + MW_E7B)))); }
struct ProbMoe1 {
    pg8::StaticOrder so; const char* HBp; const int* slot_tok; const char* outp; const char* wsb; MoeTiles mt;
    __device__ __forceinline__ bool next(int i, pg8::Unit& u) const { return so.next(i, u); }
    __device__ __forceinline__ const char* a_base(const pg8::Unit&) const { return HBp; }
    __device__ __forceinline__ const char* b_base(const pg8::Unit& u) const { return moe_w13(moe_expert(mt, u.pm), outp, wsb) + (size_t)u.pn * (256 * (size_t)D * 2); }
    __device__ __forceinline__ int a_row(const pg8::Unit& u, int r) const { return slot_tok[u.pm * 256 + r]; }
    __device__ __forceinline__ bool is_half(const pg8::Unit&) const { return false; }
    __device__ __forceinline__ int nt(const pg8::Unit&, int ntf) const { return ntf; }
};
constexpr int MOE_KS = 4, MOE_KS_NT = DFF / 64 / MOE_KS, MOE_MAIN_TILES = TREAL * 2 / 256;
static_assert(MOE_KS_NT % 2 == 0 && MOE_KS_NT * MOE_KS * 64 == DFF, "split-K pieces");
struct ProbMoe2 {
    pg8::StaticOrder so; const char* ACTp; const char* outp; const char* wsb; MoeTiles mt; int extra;
    __device__ __forceinline__ bool next(int i, pg8::Unit& u) const {
        const long L = (long)i * so.G + so.c; if (L < so.nwg) return so.next(i, u);
        const int t = (int)(L - so.nwg); if (t >= extra * 8 * MOE_KS) return false;
        u.ks = t & (MOE_KS - 1); u.pn = (t >> 2) & 7; u.pm = MOE_MAIN_TILES + (t >> 5); return true; }
    __device__ __forceinline__ size_t koff(const pg8::Unit& u) const { return u.ks < 0 ? (size_t)0 : (size_t)u.ks * (MOE_KS_NT * 64 * 2); }
    __device__ __forceinline__ const char* a_base(const pg8::Unit& u) const { return ACTp + (size_t)u.pm * (256 * (size_t)DFF * 2) + koff(u); }
    __device__ __forceinline__ const char* b_base(const pg8::Unit& u) const { return moe_w2(moe_expert(mt, u.pm), outp, wsb) + (size_t)u.pn * (256 * (size_t)DFF * 2) + koff(u); }
    __device__ __forceinline__ int a_row(const pg8::Unit&, int) const { return 0; }
    __device__ __forceinline__ bool is_half(const pg8::Unit&) const { return false; }
    __device__ __forceinline__ int nt(const pg8::Unit& u, int ntf) const { return u.ks < 0 ? ntf : MOE_KS_NT; }
};

namespace epi {
using pg8::f32x4; using pg8::u32x4; using pg8::bf16_t; using pg8::Unit; using pg8::cvt_pk_bf16;
typedef const f32x4 (&AccRef)[2][2][4][2];
__device__ __forceinline__ void store8(bf16_t* p, f32x4 v0, f32x4 v1) { u32x4 w; w.x = cvt_pk_bf16(v0[0], v0[1]); w.y = cvt_pk_bf16(v0[2], v0[3]); w.z = cvt_pk_bf16(v1[0], v1[1]); w.w = cvt_pk_bf16(v1[2], v1[3]); *(u32x4*)p = w; }
__device__ __forceinline__ void load8(const bf16_t* p, f32x4& v0, f32x4& v1) { const u32x4 w = *(const u32x4*)p;
    v0 = (f32x4){pg8::bf_lo(w.x), pg8::bf_hi(w.x), pg8::bf_lo(w.y), pg8::bf_hi(w.y)}; v1 = (f32x4){pg8::bf_lo(w.z), pg8::bf_hi(w.z), pg8::bf_lo(w.w), pg8::bf_hi(w.w)}; }
__device__ __forceinline__ void unpack8(u32x4 w, f32x4& v0, f32x4& v1) { v0 = (f32x4){pg8::bf_lo(w.x), pg8::bf_hi(w.x), pg8::bf_lo(w.y), pg8::bf_hi(w.y)}; v1 = (f32x4){pg8::bf_lo(w.z), pg8::bf_hi(w.z), pg8::bf_lo(w.w), pg8::bf_hi(w.w)}; }
__device__ __forceinline__ bool epi_fence() { asm volatile("" ::: "memory"); return true; }
__device__ __forceinline__ float sigmoidf_(float x) { return __builtin_amdgcn_rcpf(1.f + __builtin_amdgcn_exp2f(-x * LOG2E)); }
#define EPI_AM _Pragma("unroll") for (int ai = 0; ai < 2; ++ai) _Pragma("unroll") for (int m = 0; m < 4; ++m) if (epi_fence())

struct EpiWin {
    static constexpr bool MID = false; static constexpr int NST = 0;
    bf16_t *CQ, *CKV, *KR, *QB, *KB, *VB, *GR, *GBb; float* SSQ; const float *CS, *SN;
    __device__ __forceinline__ void operator()(AccRef acc, const Unit& u, int wr, int wc, int fr, int fq) const {
        const int pn = u.pn, row0 = u.pm * 256 + wr * 64 + fr, cw = wc * 32 + fq * 8;
        if (pn < 5) {
            bf16_t* dst = pn < 3 ? CQ : CKV; const int ld = pn < 3 ? QRANK : KVRANK, c0 = (pn < 3 ? pn : pn - 3) * 256;
            EPI_AM { const int row = row0 + ai * 128 + m * 16; float s = 0.f;
#pragma unroll
                for (int bj = 0; bj < 2; ++bj) { const f32x4 v0 = acc[ai][bj][m][0], v1 = acc[ai][bj][m][1];
                    s += (v0[0] * v0[0] + v0[1] * v0[1]) + (v0[2] * v0[2] + v0[3] * v0[3]) + (v1[0] * v1[0] + v1[1] * v1[1]) + (v1[2] * v1[2] + v1[3] * v1[3]);
                    store8(dst + (size_t)row * ld + c0 + bj * 128 + cw, v0, v1); }
                { auto r16 = __builtin_amdgcn_permlane16_swap(__float_as_uint(s), __float_as_uint(s), false, false); s = __uint_as_float(r16[0]) + __uint_as_float(r16[1]);
                  auto r32 = __builtin_amdgcn_permlane32_swap(__float_as_uint(s), __float_as_uint(s), false, false); s = __uint_as_float(r32[0]) + __uint_as_float(r32[1]); }
                if (fq == 0) SSQ[(size_t)row * 20 + pn * 4 + wc] = s; }
        } else if (pn == 5) {
            if (wc == 0) {
#pragma unroll
                for (int rp = 0; rp < 4; ++rp) { f32x4 cs_[2][4];
#pragma unroll
                    for (int mm = 0; mm < 2; ++mm) { const int rr = 2 * rp + mm, pos = row_pos(row0 + (rr >> 2) * 128 + (rr & 3) * 16);
                        cs_[mm][0] = *(const f32x4*)(CS + pos * 32 + fq * 8); cs_[mm][1] = *(const f32x4*)(CS + pos * 32 + fq * 8 + 4); cs_[mm][2] = *(const f32x4*)(SN + pos * 32 + fq * 8); cs_[mm][3] = *(const f32x4*)(SN + pos * 32 + fq * 8 + 4); }
                    asm volatile("" ::: "memory");
#pragma unroll
                    for (int mm = 0; mm < 2; ++mm) { const int rr = 2 * rp + mm, ai = rr >> 2, m = rr & 3, row = row0 + ai * 128 + m * 16; const f32x4 c0 = cs_[mm][0], c1 = cs_[mm][1], s0 = cs_[mm][2], s1 = cs_[mm][3];
                        const f32x4 x10 = acc[ai][0][m][0], x11 = acc[ai][0][m][1], x20 = acc[ai][1][m][0], x21 = acc[ai][1][m][1];
                        store8(KR + (size_t)row * 64 + fq * 8, x10 * c0 - x20 * s0, x11 * c1 - x21 * s1);
                        store8(KR + (size_t)row * 64 + 32 + fq * 8, x10 * s0 + x20 * c0, x11 * s1 + x21 * c1); }
                    asm volatile("" ::: "memory"); } }
        } else if (pn < 14) {
            EPI_AM { const int row = row0 + ai * 128 + m * 16;
#pragma unroll
                for (int bj = 0; bj < 2; ++bj) store8(QB + (size_t)row * 2048 + (pn - 6) * 256 + bj * 128 + cw, acc[ai][bj][m][0] * QK_SCALE_SWA, acc[ai][bj][m][1] * QK_SCALE_SWA); }
        } else if (pn < 18) {
            bf16_t* dst = pn < 16 ? KB : VB; const int c0 = (pn < 16 ? pn - 14 : pn - 16) * 256;
            EPI_AM { const int row = row0 + ai * 128 + m * 16;
#pragma unroll
                for (int bj = 0; bj < 2; ++bj) store8(dst + (size_t)row * 512 + c0 + bj * 128 + cw, acc[ai][bj][m][0], acc[ai][bj][m][1]); }
        } else {
            const int c0 = (pn - 18) * 128 + cw;
            EPI_AM { const int row = row0 + ai * 128 + m * 16; f32x4 r[2], g[2];
#pragma unroll
                for (int n = 0; n < 2; ++n)
#pragma unroll
                    for (int j = 0; j < 4; ++j) { const float a = acc[ai][0][m][n][j], b = fmaxf(acc[ai][1][m][n][j], -30.f);
                        const float ea = __builtin_amdgcn_exp2f(-a * LOG2E), eb = __builtin_amdgcn_exp2f(-b * LOG2E);
                        g[n][j] = __builtin_amdgcn_rcpf(1.f + eb); r[n][j] = (1.f + eb) * __builtin_amdgcn_rcpf(1.f + ea); }
                store8(GR + (size_t)row * 2048 + c0, r[0], r[1]); store8(GBb + (size_t)row * 2048 + c0, g[0], g[1]); }
        }
    }
};
struct EpiUq {
    static constexpr bool MID = false; static constexpr int NST = 16;
    bf16_t* Q; const float* SSQ; const float *CS, *SN;
    __device__ __forceinline__ void operator()(AccRef acc, const Unit& u, int wr, int wc, int fr, int fq) const {
        const int pn = u.pn, row0 = u.pm * 256 + wr * 64 + fr, cw = wc * 32 + fq * 8;
#pragma unroll
        for (int ai = 0; ai < 2; ++ai) { f32x4 q[4][3]; float rs[4];
#pragma unroll
            for (int m = 0; m < 4; ++m) { const float* sp = SSQ + (size_t)(row0 + ai * 128 + m * 16) * 20; q[m][0] = *(const f32x4*)sp; q[m][1] = *(const f32x4*)(sp + 4); q[m][2] = *(const f32x4*)(sp + 8); }
            asm volatile("" ::: "memory");
#pragma unroll
            for (int m = 0; m < 4; ++m) { const float ss = ((q[m][0][0] + q[m][0][1]) + (q[m][0][2] + q[m][0][3])) + ((q[m][1][0] + q[m][1][1]) + (q[m][1][2] + q[m][1][3])) + ((q[m][2][0] + q[m][2][1]) + (q[m][2][2] + q[m][2][3]));
                rs[m] = __builtin_amdgcn_rsqf(ss * (1.f / QRANK) + RMS_EPS) * QK_SCALE_MLA; }
            if (pn < 8) {
#pragma unroll
                for (int m = 0; m < 4; ++m) { const int row = row0 + ai * 128 + m * 16;
#pragma unroll
                    for (int bj = 0; bj < 2; ++bj) store8(Q + (size_t)row * 3072 + (2 * pn + bj) * 192 + cw, acc[ai][bj][m][0] * rs[m], acc[ai][bj][m][1] * rs[m]); }
            } else {
                const int head = 4 * (pn - 8) + wc;
#pragma unroll
                for (int mp = 0; mp < 2; ++mp) { f32x4 cs_[2][4];
#pragma unroll
                    for (int mm = 0; mm < 2; ++mm) { const int pos = row_pos(row0 + ai * 128 + (2 * mp + mm) * 16);
                        cs_[mm][0] = *(const f32x4*)(CS + pos * 32 + fq * 8); cs_[mm][1] = *(const f32x4*)(CS + pos * 32 + fq * 8 + 4); cs_[mm][2] = *(const f32x4*)(SN + pos * 32 + fq * 8); cs_[mm][3] = *(const f32x4*)(SN + pos * 32 + fq * 8 + 4); }
                    asm volatile("" ::: "memory");
#pragma unroll
                    for (int mm = 0; mm < 2; ++mm) { const int m = 2 * mp + mm, row = row0 + ai * 128 + m * 16; const f32x4 c0 = cs_[mm][0], c1 = cs_[mm][1], s0 = cs_[mm][2], s1 = cs_[mm][3];
                        const f32x4 x10 = acc[ai][0][m][0] * rs[m], x11 = acc[ai][0][m][1] * rs[m], x20 = acc[ai][1][m][0] * rs[m], x21 = acc[ai][1][m][1] * rs[m];
                        store8(Q + (size_t)row * 3072 + head * 192 + 128 + fq * 8, x10 * c0 - x20 * s0, x11 * c1 - x21 * s1);
                        store8(Q + (size_t)row * 3072 + head * 192 + 160 + fq * 8, x10 * s0 + x20 * c0, x11 * s1 + x21 * c1); }
                    asm volatile("" ::: "memory"); }
            }
            asm volatile("" ::: "memory"); }
    }
};
struct EpiUkv {
    static constexpr bool MID = false; static constexpr int NST = 16;
    bf16_t *KN, *V; const float* SSQ;
    __device__ __forceinline__ void operator()(AccRef acc, const Unit& u, int wr, int wc, int fr, int fq) const {
        const int pn = u.pn, row0 = u.pm * 256 + wr * 64 + fr, cw = wc * 32 + fq * 8;
        f32x4 q[2][4][2];
#pragma unroll
        for (int ai = 0; ai < 2; ++ai)
#pragma unroll
            for (int m = 0; m < 4; ++m) { const float* sp = SSQ + (size_t)(row0 + ai * 128 + m * 16) * 20 + 12; q[ai][m][0] = *(const f32x4*)sp; q[ai][m][1] = *(const f32x4*)(sp + 4); }
        asm volatile("" ::: "memory");
#pragma unroll
        for (int ai = 0; ai < 2; ++ai)
#pragma unroll
            for (int m = 0; m < 4; ++m) { const int row = row0 + ai * 128 + m * 16; const f32x4 q0 = q[ai][m][0], q1 = q[ai][m][1];
                const float ss = ((q0[0] + q0[1]) + (q0[2] + q0[3])) + ((q1[0] + q1[1]) + (q1[2] + q1[3]));
                const float rs = __builtin_amdgcn_rsqf(ss * (1.f / KVRANK) + RMS_EPS);
                store8(KN + (size_t)row * 2048 + pn * 128 + cw, acc[ai][0][m][0] * rs, acc[ai][0][m][1] * rs);
                store8(V + (size_t)row * 2048 + pn * 128 + cw, acc[ai][1][m][0] * rs, acc[ai][1][m][1] * rs); }
    }
};
struct EpiProj {
    static constexpr bool MID = true; static constexpr int NST = 16;
    bf16_t* MG; const bf16_t *GR, *GBb;
    __device__ __forceinline__ void mid(f32x4 (&acc)[2][2][4][2], const Unit& u, int wr, int wc, int fr, int fq) const {
        int row0 = u.pm * 256 + wr * 64 + fr, c0 = u.pn * 256 + wc * 32 + fq * 8; asm volatile("" : "+v"(row0), "+v"(c0));
#pragma unroll
        for (int ai = 0; ai < 2; ++ai) { u32x4 w[4][2];
#pragma unroll
            for (int m = 0; m < 4; ++m)
#pragma unroll
                for (int bj = 0; bj < 2; ++bj) w[m][bj] = *(const u32x4*)(GR + (size_t)(row0 + ai * 128 + m * 16) * 2048 + c0 + bj * 128);
            asm volatile("" ::: "memory");
#pragma unroll
            for (int m = 0; m < 4; ++m)
#pragma unroll
                for (int bj = 0; bj < 2; ++bj) { f32x4 r0, r1; unpack8(w[m][bj], r0, r1); acc[ai][bj][m][0] *= r0; acc[ai][bj][m][1] *= r1; }
            asm volatile("" ::: "memory"); }
    }
    __device__ __forceinline__ void operator()(AccRef acc, const Unit& u, int wr, int wc, int fr, int fq) const {
        const int row0 = u.pm * 256 + wr * 64 + fr, c0 = u.pn * 256 + wc * 32 + fq * 8;
#pragma unroll
        for (int ai = 0; ai < 2; ++ai) { u32x4 w[4][2];
#pragma unroll
            for (int m = 0; m < 4; ++m)
#pragma unroll
                for (int bj = 0; bj < 2; ++bj) w[m][bj] = *(const u32x4*)(GBb + (size_t)(row0 + ai * 128 + m * 16) * 2048 + c0 + bj * 128);
            asm volatile("" ::: "memory");
#pragma unroll
            for (int m = 0; m < 4; ++m)
#pragma unroll
                for (int bj = 0; bj < 2; ++bj) { f32x4 g0, g1; unpack8(w[m][bj], g0, g1); store8(MG + (size_t)(row0 + ai * 128 + m * 16) * 2048 + c0 + bj * 128, acc[ai][bj][m][0] * g0, acc[ai][bj][m][1] * g1); }
            asm volatile("" ::: "memory"); }
    }
};
struct EpiResid {
    static constexpr bool MID = false; static constexpr int NST = 16;
    bf16_t* X; const bf16_t* HB; bf16_t* XP;
    __device__ __forceinline__ void operator()(AccRef acc, const Unit& u, int wr, int wc, int fr, int fq) const {
        const int row0 = u.pm * 256 + wr * 64 + fr, c0 = u.pn * 256 + wc * 32 + fq * 8;
        const bool part = u.ks >= 1; const float al = part ? 0.f : ALPHA;
        bf16_t* const X = part ? XP + ((ptrdiff_t)(u.ks - 1) * 256 - (ptrdiff_t)u.pm * 256) * 2048 : this->X;
#pragma unroll
        for (int ai = 0; ai < 2; ++ai) { u32x4 w[4][2];
#pragma unroll
            for (int m = 0; m < 4; ++m)
#pragma unroll
                for (int bj = 0; bj < 2; ++bj) w[m][bj] = *(const u32x4*)(HB + (size_t)(row0 + ai * 128 + m * 16) * 2048 + c0 + bj * 128);
            asm volatile("" ::: "memory");
#pragma unroll
            for (int m = 0; m < 4; ++m)
#pragma unroll
                for (int bj = 0; bj < 2; ++bj) { f32x4 h0, h1; unpack8(w[m][bj], h0, h1);
                    store8(X + (size_t)(row0 + ai * 128 + m * 16) * 2048 + c0 + bj * 128, h0 * al + acc[ai][bj][m][0], h1 * al + acc[ai][bj][m][1]); }
            asm volatile("" ::: "memory"); }
    }
};
struct EpiSwiglu {
    static constexpr bool MID = false; static constexpr int NST = 8;
    bf16_t* ACT;
    __device__ __forceinline__ void operator()(AccRef acc, const Unit& u, int wr, int wc, int fr, int fq) const {
        const int row0 = u.pm * 256 + wr * 64 + fr, c0 = u.pn * 128 + wc * 32 + fq * 8;
        EPI_AM { const int row = row0 + ai * 128 + m * 16; f32x4 o[2];
#pragma unroll
            for (int n = 0; n < 2; ++n)
#pragma unroll
                for (int j = 0; j < 4; ++j) { const float g = acc[ai][0][m][n][j]; o[n][j] = g * sigmoidf_(g) * acc[ai][1][m][n][j]; }
            store8(ACT + (size_t)row * DFF + c0, o[0], o[1]); }
    }
};
struct EpiMoeDown {
    static constexpr bool MID = false; static constexpr int NST = 16;
    bf16_t* Y; const float* slot_gate; bf16_t* YP;
    __device__ __forceinline__ void operator()(AccRef acc, const Unit& u, int wr, int wc, int fr, int fq) const {
        const int row0 = u.pm * 256 + wr * 64 + fr, c0 = u.pn * 256 + wc * 32 + fq * 8;
        bf16_t* const Y = u.ks >= 1 ? YP + ((ptrdiff_t)(u.ks - 1) * 2048 - (ptrdiff_t)MOE_MAIN_TILES * 256) * 2048 : this->Y;
        float gt[2][4];
#pragma unroll
        for (int ai = 0; ai < 2; ++ai)
#pragma unroll
            for (int m = 0; m < 4; ++m) gt[ai][m] = slot_gate[row0 + ai * 128 + m * 16];
        asm volatile("" ::: "memory");
#pragma unroll
        for (int ai = 0; ai < 2; ++ai)
#pragma unroll
            for (int m = 0; m < 4; ++m) { const int row = row0 + ai * 128 + m * 16; const float g = gt[ai][m];
#pragma unroll
                for (int bj = 0; bj < 2; ++bj) store8(Y + (size_t)row * 2048 + c0 + bj * 128, acc[ai][bj][m][0] * g, acc[ai][bj][m][1] * g); }
    }
};
#undef EPI_AM
}
namespace att {
typedef unsigned short bf16;
typedef short bf16x8 __attribute__((ext_vector_type(8)));
typedef short s16x4 __attribute__((ext_vector_type(4)));
typedef float f32x16 __attribute__((ext_vector_type(16)));
typedef unsigned u32x4 __attribute__((ext_vector_type(4)));
#define ATT_LAS __attribute__((address_space(3)))
#define SBAR() __builtin_amdgcn_sched_barrier(0)
constexpr int KN_BYTES = 16384, KR_BYTES = 8192, V_BYTES = 16384, BUF_BYTES = KN_BYTES + KR_BYTES + V_BYTES;
constexpr int OFF_KN = 0, OFF_KR = KN_BYTES, OFF_V = KN_BYTES + KR_BYTES;
constexpr int OFF_WS = 2 * BUF_BYTES;
constexpr int OFF_BT = OFF_WS + 8 * 64 * 4;
constexpr int ATT_LDS_BYTES = OFF_BT + 4 * 260 * 4;
constexpr float NEG_BIG = -1e30f;
constexpr float THR2 = 8.f;

__device__ __forceinline__ int crow(int r, int hi) { return (r & 3) + 8 * (r >> 2) + 4 * hi; }
__device__ __forceinline__ unsigned cvtpk(float lo, float hi) { return pg8::cvt_pk_bf16(lo, hi); }
__device__ __forceinline__ int kn_off(int row, int colB) { return row * 256 + (colB ^ ((row & 15) << 4)); }
__device__ __forceinline__ int kr_off(int row, int colB) { return row * 128 + (colB ^ (((row >> 1) & 7) << 4)); }
__device__ __forceinline__ int v_st(int k, int c) { const int kk = (k & ~0xC) | ((k & 4) << 1) | ((k & 8) >> 1); return ((kk >> 3) * 4 + (c >> 5)) * 512 + ((kk & 7) * 32 + (c & 31)) * 2; }
__device__ __forceinline__ int v_rd_base(int lane) { return ((lane & 3) << 3) | (((lane >> 2) & 3) << 6) | (((lane >> 4) & 1) << 5) | (((lane >> 5) & 1) << 8); }
constexpr int v_rd_off(int d0, int ks, int half) { return d0 * 512 + ks * 4096 + half * 2048; }
template <int OFF> __device__ __forceinline__ s16x4 tr_read(int vb) { s16x4 r; asm volatile("ds_read_b64_tr_b16 %0, %1 offset:%2" : "=&v"(r) : "v"(vb), "i"(OFF) : "memory"); return r; }
template <int D0> __device__ __forceinline__ void pv_one(f32x16& od, int vb, bf16x8 pa0, bf16x8 pa1, bf16x8 pa2, bf16x8 pa3) {
    const s16x4 l0 = tr_read<v_rd_off(D0, 0, 0)>(vb), h0 = tr_read<v_rd_off(D0, 0, 1)>(vb), l1 = tr_read<v_rd_off(D0, 1, 0)>(vb), h1 = tr_read<v_rd_off(D0, 1, 1)>(vb);
    const s16x4 l2 = tr_read<v_rd_off(D0, 2, 0)>(vb), h2 = tr_read<v_rd_off(D0, 2, 1)>(vb), l3 = tr_read<v_rd_off(D0, 3, 0)>(vb), h3 = tr_read<v_rd_off(D0, 3, 1)>(vb);
    asm volatile("s_waitcnt lgkmcnt(0)" ::: "memory"); SBAR();
#define PK(L, H) (bf16x8){L[0], L[1], L[2], L[3], H[0], H[1], H[2], H[3]}
    od = __builtin_amdgcn_mfma_f32_32x32x16_bf16(pa0, PK(l0, h0), od, 0, 0, 0);
    od = __builtin_amdgcn_mfma_f32_32x32x16_bf16(pa1, PK(l1, h1), od, 0, 0, 0);
    od = __builtin_amdgcn_mfma_f32_32x32x16_bf16(pa2, PK(l2, h2), od, 0, 0, 0);
    od = __builtin_amdgcn_mfma_f32_32x32x16_bf16(pa3, PK(l3, h3), od, 0, 0, 0);
#undef PK
}
__device__ __forceinline__ void pv_all(f32x16* o, int vb, bf16x8 pa0, bf16x8 pa1, bf16x8 pa2, bf16x8 pa3) {
    pv_one<0>(o[0], vb, pa0, pa1, pa2, pa3); pv_one<1>(o[1], vb, pa0, pa1, pa2, pa3); pv_one<2>(o[2], vb, pa0, pa1, pa2, pa3); pv_one<3>(o[3], vb, pa0, pa1, pa2, pa3);
}
}
namespace att {
constexpr int M2_KSLOT = KN_BYTES + KR_BYTES;
constexpr int M2_OFF_K = 0, M2_OFF_V = 3 * M2_KSLOT;
constexpr int M2_OFF_WS = M2_OFF_V + 3 * V_BYTES;
constexpr int M2_LDS_BYTES = M2_OFF_WS + 8 * 64 * 4;
typedef __attribute__((address_space(3))) unsigned char* lds_ptr;

}
namespace att {
constexpr int M3_NT = 65;
__device__ __forceinline__ void softmax_seg(f32x16& p0, f32x16& p1, float& m_reg, float& l_reg, float& alpha, bf16x8& pa0, bf16x8& pa1, bf16x8& pa2, bf16x8& pa3) {
    float pmax = p0[0];
#pragma unroll
    for (int r = 1; r < 16; ++r) pmax = fmaxf(pmax, p0[r]);
#pragma unroll
    for (int r = 0; r < 16; ++r) pmax = fmaxf(pmax, p1[r]);
    { auto rr = __builtin_amdgcn_permlane32_swap(__float_as_uint(pmax), __float_as_uint(pmax), false, false); pmax = fmaxf(__uint_as_float(rr[0]), __uint_as_float(rr[1])); }
    if (__builtin_expect(__all(pmax - m_reg <= THR2), 1)) { alpha = 1.f; }
    else { const float mn = fmaxf(m_reg, pmax); alpha = __builtin_amdgcn_exp2f(m_reg - mn); m_reg = mn; }
    const float mn = m_reg; float ps = 0.f;
#pragma unroll
    for (int r = 0; r < 16; ++r) { p0[r] = __builtin_amdgcn_exp2f(p0[r] - mn); ps += p0[r]; }
#pragma unroll
    for (int r = 0; r < 16; ++r) { p1[r] = __builtin_amdgcn_exp2f(p1[r] - mn); ps += p1[r]; }
    { auto rr = __builtin_amdgcn_permlane32_swap(__float_as_uint(ps), __float_as_uint(ps), false, false); ps = __uint_as_float(rr[0]) + __uint_as_float(rr[1]); }
    l_reg = l_reg * alpha + ps;
#define PK4(P, BASE, OUT) do { unsigned a0 = cvtpk(P[BASE + 0], P[BASE + 1]), a1 = cvtpk(P[BASE + 2], P[BASE + 3]);   \
    unsigned b0 = cvtpk(P[BASE + 4], P[BASE + 5]), b1 = cvtpk(P[BASE + 6], P[BASE + 7]);                              \
    auto r0 = __builtin_amdgcn_permlane32_swap(a0, b0, false, false); auto r1 = __builtin_amdgcn_permlane32_swap(a1, b1, false, false); \
    u32x4 w = {r0[0], r1[0], r0[1], r1[1]}; OUT = *reinterpret_cast<bf16x8*>(&w); } while (0)
    PK4(p0, 0, pa0); PK4(p0, 8, pa1); PK4(p1, 0, pa2); PK4(p1, 8, pa3);
#undef PK4
}

}
namespace att {
constexpr int S2_OFF_K = 0, S2_OFF_V = 3 * KN_BYTES, S2_OFF_TW = S2_OFF_V + 3 * V_BYTES;
constexpr int S2_OFF_TM = S2_OFF_TW + 4 * 512 * 4, S2_OFF_WS = S2_OFF_TM + 4 * 256 * 4, S2_LDS_BYTES = S2_OFF_WS + 8 * 64 * 4;
__device__ __forceinline__ void swa_unit2(lds_ptr lds, const bf16* __restrict__ QB, const bf16* __restrict__ KB, const bf16* __restrict__ VB, bf16* __restrict__ OAB,
                                          const float* __restrict__ tw_g, const float* __restrict__ tm_g, const float* __restrict__ sink_l2, int b, int hk, int j, int& tables_hk, const int tid_in) {
    int tid_ = tid_in; asm volatile("" : "+v"(tid_)); const int tid = tid_, lane = tid & 63, r32 = lane & 31, hi = lane >> 5; const int wid = __builtin_amdgcn_readfirstlane(tid >> 6);
    const bool metaq = (j == 64);
    const int hq = 4 * hk + (wid >> 1);
    const bool wave_on = !metaq || (wid & 1) == 0;
    const int qpos = metaq ? (r32 & 15) : (NMETA + 64 * j + 32 * (wid & 1) + r32);
    const int qrow = metaq ? (TREAL + 16 * b + (r32 & 15)) : (b * SEQ + 64 * j + 32 * (wid & 1) + r32);
    __attribute__((address_space(3))) float* wsf = (__attribute__((address_space(3))) float*)(lds + S2_OFF_WS) + wid * 64;
    int nt, kt_lo = 0;
    if (metaq) nt = 3; else { kt_lo = j - 2 < 0 ? 0 : j - 2; const int kt_hi = j + 2 > 63 ? 63 : j + 2; nt = 1 + (kt_hi - kt_lo + 1); }
#define S2_KPOS0(t) (metaq ? 64 * (t) : ((t) == 0 ? 0 : NMETA + 64 * (kt_lo + (t) - 1)))
#define S2_ROW(kp) ({ int kp_ = (kp) > LPOS - 1 ? LPOS - 1 : (kp); (kp_ < NMETA ? TREAL + 16 * b + kp_ : b * SEQ + kp_ - NMETA); })
    int kk_k[2], kk_v[2]; unsigned co_k[2], co_v[2];
#pragma unroll
    for (int i = 0; i < 2; ++i) { const int P = 2 * wid + i;
        { const int row = 4 * P + (lane >> 4), c = (lane & 15) ^ (row & 15); kk_k[i] = row; co_k[i] = (unsigned)(c * 16); }
        { const int q = 64 * P + lane, s = q >> 5, kk = (s >> 2) * 8 + ((q & 31) >> 2), col = (s & 3) * 32 + (q & 3) * 8, k = (kk & ~0xC) | ((kk & 4) << 1) | ((kk & 8) >> 1); kk_v[i] = k; co_v[i] = (unsigned)(col * 2); } }
    const char* const kb_h = (const char*)KB + hk * 256; const char* const vb_h = (const char*)VB + hk * 256;
#define S2_DMA(src, dstoff) __builtin_amdgcn_global_load_lds((const unsigned*)(src), (__attribute__((address_space(3))) unsigned*)(lds + (dstoff)), 16, 0, 0)
#define S2_DMA_TILE(t, slot) do { const int kp0_ = S2_KPOS0(t); \
        _Pragma("unroll") for (int i_ = 0; i_ < 2; ++i_) { S2_DMA(kb_h + (size_t)S2_ROW(kp0_ + kk_k[i_]) * 1024 + co_k[i_], S2_OFF_K + (slot) * KN_BYTES + (2 * wid + i_) * 1024); \
                                                          S2_DMA(vb_h + (size_t)S2_ROW(kp0_ + kk_v[i_]) * 1024 + co_v[i_], S2_OFF_V + (slot) * V_BYTES + (2 * wid + i_) * 1024); } } while (0)
#define S2_BAR() do { asm volatile("s_waitcnt lgkmcnt(0)" ::: "memory"); __builtin_amdgcn_s_barrier(); asm volatile("" ::: "memory"); } while (0)
    S2_DMA_TILE(0, 0); S2_DMA_TILE(1, 1); S2_DMA_TILE(2, 2);
    bf16x8 qr[8];
    { const bf16* qp = QB + (size_t)qrow * 2048 + hq * 128 + hi * 8;
#pragma unroll
      for (int d0 = 0; d0 < 8; ++d0) qr[d0] = *reinterpret_cast<const bf16x8*>(qp + d0 * 16); }
    if (tables_hk != hk) {
        __attribute__((address_space(3))) float* tw = (__attribute__((address_space(3))) float*)(lds + S2_OFF_TW); __attribute__((address_space(3))) float* tm = (__attribute__((address_space(3))) float*)(lds + S2_OFF_TM);
        for (int i = tid; i < 4 * 512; i += 512) tw[i] = tw_g[(4 * hk) * 512 + i];
        for (int i = tid; i < 4 * 256; i += 512) tm[i] = tm_g[(4 * hk) * 256 + i];
        tables_hk = hk;
    }
    const int xkn = (r32 & 15) << 4, hb = hi * 16;
    const int vlane = v_rd_base(lane);
    const float sink = sink_l2[hq];
    float m_reg = sink, l_reg = 1.f; f32x16 o[4];
#pragma unroll
    for (int d = 0; d < 4; ++d) o[d] = f32x16{};
    f32x16 p0, p1; bf16x8 pa0, pa1, pa2, pa3;
#define S2_KLD(d, A0, A1) do { const int of_ = (((d) * 32 + hb) ^ xn_); A0 = *(const __attribute__((address_space(3))) bf16x8*)(kb_ + of_); A1 = *(const __attribute__((address_space(3))) bf16x8*)(kb_ + of_ + 8192); } while (0)
#define S2_KMM(d, A0, A1) do { p0 = __builtin_amdgcn_mfma_f32_32x32x16_bf16(A0, qr[d], p0, 0, 0, 0); p1 = __builtin_amdgcn_mfma_f32_32x32x16_bf16(A1, qr[d], p1, 0, 0, 0); } while (0)
    int slot = 0;
    for (int t = 0; t < nt; ++t) {
        { const int ahead = (nt < t + 3 ? nt : t + 3) - t - 1;
          if (ahead >= 2) asm volatile("s_waitcnt vmcnt(8)" ::: "memory"); else if (ahead == 1) asm volatile("s_waitcnt vmcnt(4)" ::: "memory"); else asm volatile("s_waitcnt vmcnt(0)" ::: "memory"); }
        S2_BAR();
        if (wave_on) {
            const int kpos0 = S2_KPOS0(t);
            __builtin_amdgcn_s_setprio(3);
            { int xn_ = xkn; asm volatile("" : "+v"(xn_)); const lds_ptr kb_ = lds + S2_OFF_K + slot * KN_BYTES + r32 * 256; p0 = f32x16{}; p1 = f32x16{};
              bf16x8 k0a, k0b, k1a, k1b, k2a, k2b, k3a, k3b;
              S2_KLD(0, k0a, k0b); S2_KLD(1, k1a, k1b); S2_KLD(2, k2a, k2b); S2_KLD(3, k3a, k3b); SBAR();
              S2_KMM(0, k0a, k0b); S2_KLD(4, k0a, k0b); SBAR(); S2_KMM(1, k1a, k1b); S2_KLD(5, k1a, k1b); SBAR(); S2_KMM(2, k2a, k2b); S2_KLD(6, k2a, k2b); SBAR(); S2_KMM(3, k3a, k3b); S2_KLD(7, k3a, k3b); SBAR();
              S2_KMM(4, k0a, k0b); SBAR(); S2_KMM(5, k1a, k1b); SBAR(); S2_KMM(6, k2a, k2b); SBAR(); S2_KMM(7, k3a, k3b); }
            __builtin_amdgcn_s_setprio(0);
            if (!metaq && t == 0) {
                int base = 4 * hi - qpos; base = base < -256 ? -256 : base;
                const __attribute__((address_space(3))) float* tb = (const __attribute__((address_space(3))) float*)(lds + S2_OFF_TM) + (wid >> 1) * 256 + base + 256;
#pragma unroll
                for (int r = 0; r < 16; ++r) { if (r < 8) p0[r] += tb[(r & 3) + 8 * (r >> 2)]; else p0[r] = NEG_BIG; p1[r] = NEG_BIG; }
            } else {
                const int base = kpos0 + 4 * hi - qpos;
                const __attribute__((address_space(3))) float* tb = (const __attribute__((address_space(3))) float*)(lds + S2_OFF_TW) + (wid >> 1) * 512 + base + 256;
#pragma unroll
                for (int r = 0; r < 16; ++r) { p0[r] += tb[(r & 3) + 8 * (r >> 2)]; p1[r] += tb[(r & 3) + 8 * (r >> 2) + 32]; }
                if (kpos0 + 64 > LPOS) {
#pragma unroll
                    for (int r = 0; r < 16; ++r) { if (kpos0 + crow(r, hi) >= LPOS) p0[r] = NEG_BIG; if (kpos0 + 32 + crow(r, hi) >= LPOS) p1[r] = NEG_BIG; } }
            }
            float alpha; softmax_seg(p0, p1, m_reg, l_reg, alpha, pa0, pa1, pa2, pa3);
            if (__any(alpha < 1.f)) { if (hi == 0) wsf[r32] = alpha; asm volatile("s_waitcnt lgkmcnt(0)" ::: "memory");
#pragma unroll
                for (int d = 0; d < 4; ++d)
#pragma unroll
                    for (int r = 0; r < 16; ++r) o[d][r] *= wsf[crow(r, hi)]; }
            __builtin_amdgcn_s_setprio(3); pv_all(o, (int)(uintptr_t)(lds + S2_OFF_V + slot * V_BYTES) + vlane, pa0, pa1, pa2, pa3); __builtin_amdgcn_s_setprio(0);
        }
        if (t + 3 < nt) { S2_BAR(); S2_DMA_TILE(t + 3, slot); }
        slot = slot == 2 ? 0 : slot + 1;
    }
    if (wave_on) {
        if (hi == 0) wsf[32 + r32] = l_reg; asm volatile("s_waitcnt lgkmcnt(0)" ::: "memory");
        const int orow0 = metaq ? (TREAL + 16 * b) : (b * SEQ + 64 * j + 32 * (wid & 1));
#pragma unroll
        for (int r = 0; r < 16; ++r) { const int rw = crow(r, hi); const float rl = __builtin_amdgcn_rcpf(wsf[32 + rw]);
            if (!metaq || rw < 16) { bf16* op = OAB + (size_t)(orow0 + rw) * 4096 + 2048 + hq * 128 + r32;
#pragma unroll
                for (int d0 = 0; d0 < 4; ++d0) op[d0 * 32] = (bf16)(cvtpk(o[d0][r] * rl, 0.f) & 0xffffu); } }
    }
    asm volatile("s_waitcnt vmcnt(0)" ::: "memory"); S2_BAR();
#undef S2_KPOS0
#undef S2_ROW
#undef S2_DMA
#undef S2_DMA_TILE
#undef S2_BAR
#undef S2_KLD
#undef S2_KMM
}
}
namespace att {
template <int OFF> __device__ __forceinline__ bf16x8 lds_rd128(int addr) { bf16x8 r; asm volatile("ds_read_b128 %0, %1 offset:%2" : "=&v"(r) : "v"(addr), "i"(OFF) : "memory"); return r; }
#define M4_XFULL(KS, VS) do { \
    int xn_ = xkn, xr_ = xkr; asm volatile("" : "+v"(xn_), "+v"(xr_)); \
    const int kbn_ = (int)(uintptr_t)(lds + M2_OFF_K + (KS) * M2_KSLOT) + r32 * 256, kbr_ = (int)(uintptr_t)(lds + M2_OFF_K + (KS) * M2_KSLOT + KN_BYTES) + r32 * 128; \
    const int vb_ = (int)(uintptr_t)(lds + M2_OFF_V + (VS) * V_BYTES) + vlane; (void)vb_; \
    bf16x8 ka0, ka1, ka2, ka3, ka4, kb0, kb1, kb2, kb3, kb4; s16x4 vl0, vl1, vl2, vl3, vl4, vh0, vh1, vh2, vh3, vh4; \
    p0 = f32x16{}; p1 = f32x16{}; \
    { const int a_ = kbn_ + (((0) * 32 + hb) ^ xn_); ka0 = lds_rd128<0>(a_); kb0 = lds_rd128<8192>(a_); } \
    { const int a_ = kbn_ + (((1) * 32 + hb) ^ xn_); ka1 = lds_rd128<0>(a_); kb1 = lds_rd128<8192>(a_); } \
    { const int a_ = kbn_ + (((2) * 32 + hb) ^ xn_); ka2 = lds_rd128<0>(a_); kb2 = lds_rd128<8192>(a_); } \
    { const int a_ = kbn_ + (((3) * 32 + hb) ^ xn_); ka3 = lds_rd128<0>(a_); kb3 = lds_rd128<8192>(a_); } \
    { const int a_ = kbn_ + (((4) * 32 + hb) ^ xn_); ka4 = lds_rd128<0>(a_); kb4 = lds_rd128<8192>(a_); } \
    asm volatile("s_waitcnt lgkmcnt(8)" ::: "memory"); SBAR(); p0 = __builtin_amdgcn_mfma_f32_32x32x16_bf16(ka0, qr[0], p0, 0, 0, 0); p1 = __builtin_amdgcn_mfma_f32_32x32x16_bf16(kb0, qr[0], p1, 0, 0, 0); SBAR(); \
    { const int a_ = kbn_ + (((5) * 32 + hb) ^ xn_); ka0 = lds_rd128<0>(a_); kb0 = lds_rd128<8192>(a_); } \
    asm volatile("s_waitcnt lgkmcnt(8)" ::: "memory"); SBAR(); p0 = __builtin_amdgcn_mfma_f32_32x32x16_bf16(ka1, qr[1], p0, 0, 0, 0); p1 = __builtin_amdgcn_mfma_f32_32x32x16_bf16(kb1, qr[1], p1, 0, 0, 0); SBAR(); \
    { const int a_ = kbn_ + (((6) * 32 + hb) ^ xn_); ka1 = lds_rd128<0>(a_); kb1 = lds_rd128<8192>(a_); } \
    asm volatile("s_waitcnt lgkmcnt(8)" ::: "memory"); SBAR(); p0 = __builtin_amdgcn_mfma_f32_32x32x16_bf16(ka2, qr[2], p0, 0, 0, 0); p1 = __builtin_amdgcn_mfma_f32_32x32x16_bf16(kb2, qr[2], p1, 0, 0, 0); SBAR(); \
    { const int a_ = kbn_ + (((7) * 32 + hb) ^ xn_); ka2 = lds_rd128<0>(a_); kb2 = lds_rd128<8192>(a_); } \
    asm volatile("s_waitcnt lgkmcnt(8)" ::: "memory"); SBAR(); p0 = __builtin_amdgcn_mfma_f32_32x32x16_bf16(ka3, qr[3], p0, 0, 0, 0); p1 = __builtin_amdgcn_mfma_f32_32x32x16_bf16(kb3, qr[3], p1, 0, 0, 0); SBAR(); \
    { const int a_ = kbr_ + (((0) * 32 + hb) ^ xr_); ka3 = lds_rd128<0>(a_); kb3 = lds_rd128<4096>(a_); } \
    asm volatile("s_waitcnt lgkmcnt(8)" ::: "memory"); SBAR(); p0 = __builtin_amdgcn_mfma_f32_32x32x16_bf16(ka4, qr[4], p0, 0, 0, 0); p1 = __builtin_amdgcn_mfma_f32_32x32x16_bf16(kb4, qr[4], p1, 0, 0, 0); SBAR(); \
    { const int a_ = kbr_ + (((1) * 32 + hb) ^ xr_); ka4 = lds_rd128<0>(a_); kb4 = lds_rd128<4096>(a_); } \
    asm volatile("s_waitcnt lgkmcnt(8)" ::: "memory"); SBAR(); p0 = __builtin_amdgcn_mfma_f32_32x32x16_bf16(ka0, qr[5], p0, 0, 0, 0); p1 = __builtin_amdgcn_mfma_f32_32x32x16_bf16(kb0, qr[5], p1, 0, 0, 0); SBAR(); \
    { const int a_ = kbr_ + (((2) * 32 + hb) ^ xr_); ka0 = lds_rd128<0>(a_); kb0 = lds_rd128<4096>(a_); } \
    asm volatile("s_waitcnt lgkmcnt(8)" ::: "memory"); SBAR(); p0 = __builtin_amdgcn_mfma_f32_32x32x16_bf16(ka1, qr[6], p0, 0, 0, 0); p1 = __builtin_amdgcn_mfma_f32_32x32x16_bf16(kb1, qr[6], p1, 0, 0, 0); SBAR(); \
    { const int a_ = kbr_ + (((3) * 32 + hb) ^ xr_); ka1 = lds_rd128<0>(a_); kb1 = lds_rd128<4096>(a_); } \
    asm volatile("s_waitcnt lgkmcnt(8)" ::: "memory"); SBAR(); p0 = __builtin_amdgcn_mfma_f32_32x32x16_bf16(ka2, qr[7], p0, 0, 0, 0); p1 = __builtin_amdgcn_mfma_f32_32x32x16_bf16(kb2, qr[7], p1, 0, 0, 0); SBAR(); \
    { vl2 = tr_read<v_rd_off(0, 0, 0)>(vb_); vh2 = tr_read<v_rd_off(0, 0, 1)>(vb_); } \
    asm volatile("s_waitcnt lgkmcnt(8)" ::: "memory"); SBAR(); p0 = __builtin_amdgcn_mfma_f32_32x32x16_bf16(ka3, qr[8], p0, 0, 0, 0); p1 = __builtin_amdgcn_mfma_f32_32x32x16_bf16(kb3, qr[8], p1, 0, 0, 0); SBAR(); \
    { vl3 = tr_read<v_rd_off(0, 1, 0)>(vb_); vh3 = tr_read<v_rd_off(0, 1, 1)>(vb_); } \
    asm volatile("s_waitcnt lgkmcnt(8)" ::: "memory"); SBAR(); p0 = __builtin_amdgcn_mfma_f32_32x32x16_bf16(ka4, qr[9], p0, 0, 0, 0); p1 = __builtin_amdgcn_mfma_f32_32x32x16_bf16(kb4, qr[9], p1, 0, 0, 0); SBAR(); \
    { vl4 = tr_read<v_rd_off(0, 2, 0)>(vb_); vh4 = tr_read<v_rd_off(0, 2, 1)>(vb_); } \
    asm volatile("s_waitcnt lgkmcnt(8)" ::: "memory"); SBAR(); p0 = __builtin_amdgcn_mfma_f32_32x32x16_bf16(ka0, qr[10], p0, 0, 0, 0); p1 = __builtin_amdgcn_mfma_f32_32x32x16_bf16(kb0, qr[10], p1, 0, 0, 0); SBAR(); \
    { vl0 = tr_read<v_rd_off(0, 3, 0)>(vb_); vh0 = tr_read<v_rd_off(0, 3, 1)>(vb_); } \
    asm volatile("s_waitcnt lgkmcnt(8)" ::: "memory"); SBAR(); p0 = __builtin_amdgcn_mfma_f32_32x32x16_bf16(ka1, qr[11], p0, 0, 0, 0); p1 = __builtin_amdgcn_mfma_f32_32x32x16_bf16(kb1, qr[11], p1, 0, 0, 0); SBAR(); \
    { vl1 = tr_read<v_rd_off(1, 0, 0)>(vb_); vh1 = tr_read<v_rd_off(1, 0, 1)>(vb_); } \
    asm volatile("s_waitcnt lgkmcnt(8)" ::: "memory"); SBAR(); o[0] = __builtin_amdgcn_mfma_f32_32x32x16_bf16(pa0, (bf16x8){vl2[0], vl2[1], vl2[2], vl2[3], vh2[0], vh2[1], vh2[2], vh2[3]}, o[0], 0, 0, 0); SBAR(); \
    { vl2 = tr_read<v_rd_off(1, 1, 0)>(vb_); vh2 = tr_read<v_rd_off(1, 1, 1)>(vb_); } \
    asm volatile("s_waitcnt lgkmcnt(8)" ::: "memory"); SBAR(); o[0] = __builtin_amdgcn_mfma_f32_32x32x16_bf16(pa1, (bf16x8){vl3[0], vl3[1], vl3[2], vl3[3], vh3[0], vh3[1], vh3[2], vh3[3]}, o[0], 0, 0, 0); SBAR(); \
    { vl3 = tr_read<v_rd_off(1, 2, 0)>(vb_); vh3 = tr_read<v_rd_off(1, 2, 1)>(vb_); } \
    asm volatile("s_waitcnt lgkmcnt(8)" ::: "memory"); SBAR(); o[0] = __builtin_amdgcn_mfma_f32_32x32x16_bf16(pa2, (bf16x8){vl4[0], vl4[1], vl4[2], vl4[3], vh4[0], vh4[1], vh4[2], vh4[3]}, o[0], 0, 0, 0); SBAR(); \
    { vl4 = tr_read<v_rd_off(1, 3, 0)>(vb_); vh4 = tr_read<v_rd_off(1, 3, 1)>(vb_); } \
    asm volatile("s_waitcnt lgkmcnt(8)" ::: "memory"); SBAR(); o[0] = __builtin_amdgcn_mfma_f32_32x32x16_bf16(pa3, (bf16x8){vl0[0], vl0[1], vl0[2], vl0[3], vh0[0], vh0[1], vh0[2], vh0[3]}, o[0], 0, 0, 0); SBAR(); \
    { vl0 = tr_read<v_rd_off(2, 0, 0)>(vb_); vh0 = tr_read<v_rd_off(2, 0, 1)>(vb_); } \
    asm volatile("s_waitcnt lgkmcnt(8)" ::: "memory"); SBAR(); o[1] = __builtin_amdgcn_mfma_f32_32x32x16_bf16(pa0, (bf16x8){vl1[0], vl1[1], vl1[2], vl1[3], vh1[0], vh1[1], vh1[2], vh1[3]}, o[1], 0, 0, 0); SBAR(); \
    { vl1 = tr_read<v_rd_off(2, 1, 0)>(vb_); vh1 = tr_read<v_rd_off(2, 1, 1)>(vb_); } \
    asm volatile("s_waitcnt lgkmcnt(8)" ::: "memory"); SBAR(); o[1] = __builtin_amdgcn_mfma_f32_32x32x16_bf16(pa1, (bf16x8){vl2[0], vl2[1], vl2[2], vl2[3], vh2[0], vh2[1], vh2[2], vh2[3]}, o[1], 0, 0, 0); SBAR(); \
    { vl2 = tr_read<v_rd_off(2, 2, 0)>(vb_); vh2 = tr_read<v_rd_off(2, 2, 1)>(vb_); } \
    asm volatile("s_waitcnt lgkmcnt(8)" ::: "memory"); SBAR(); o[1] = __builtin_amdgcn_mfma_f32_32x32x16_bf16(pa2, (bf16x8){vl3[0], vl3[1], vl3[2], vl3[3], vh3[0], vh3[1], vh3[2], vh3[3]}, o[1], 0, 0, 0); SBAR(); \
    { vl3 = tr_read<v_rd_off(2, 3, 0)>(vb_); vh3 = tr_read<v_rd_off(2, 3, 1)>(vb_); } \
    asm volatile("s_waitcnt lgkmcnt(8)" ::: "memory"); SBAR(); o[1] = __builtin_amdgcn_mfma_f32_32x32x16_bf16(pa3, (bf16x8){vl4[0], vl4[1], vl4[2], vl4[3], vh4[0], vh4[1], vh4[2], vh4[3]}, o[1], 0, 0, 0); SBAR(); \
    { vl4 = tr_read<v_rd_off(3, 0, 0)>(vb_); vh4 = tr_read<v_rd_off(3, 0, 1)>(vb_); } \
    asm volatile("s_waitcnt lgkmcnt(8)" ::: "memory"); SBAR(); o[2] = __builtin_amdgcn_mfma_f32_32x32x16_bf16(pa0, (bf16x8){vl0[0], vl0[1], vl0[2], vl0[3], vh0[0], vh0[1], vh0[2], vh0[3]}, o[2], 0, 0, 0); SBAR(); \
    { vl0 = tr_read<v_rd_off(3, 1, 0)>(vb_); vh0 = tr_read<v_rd_off(3, 1, 1)>(vb_); } \
    asm volatile("s_waitcnt lgkmcnt(8)" ::: "memory"); SBAR(); o[2] = __builtin_amdgcn_mfma_f32_32x32x16_bf16(pa1, (bf16x8){vl1[0], vl1[1], vl1[2], vl1[3], vh1[0], vh1[1], vh1[2], vh1[3]}, o[2], 0, 0, 0); SBAR(); \
    { vl1 = tr_read<v_rd_off(3, 2, 0)>(vb_); vh1 = tr_read<v_rd_off(3, 2, 1)>(vb_); } \
    asm volatile("s_waitcnt lgkmcnt(8)" ::: "memory"); SBAR(); o[2] = __builtin_amdgcn_mfma_f32_32x32x16_bf16(pa2, (bf16x8){vl2[0], vl2[1], vl2[2], vl2[3], vh2[0], vh2[1], vh2[2], vh2[3]}, o[2], 0, 0, 0); SBAR(); \
    { vl2 = tr_read<v_rd_off(3, 3, 0)>(vb_); vh2 = tr_read<v_rd_off(3, 3, 1)>(vb_); } \
    asm volatile("s_waitcnt lgkmcnt(8)" ::: "memory"); SBAR(); o[2] = __builtin_amdgcn_mfma_f32_32x32x16_bf16(pa3, (bf16x8){vl3[0], vl3[1], vl3[2], vl3[3], vh3[0], vh3[1], vh3[2], vh3[3]}, o[2], 0, 0, 0); SBAR(); \
    asm volatile("s_waitcnt lgkmcnt(6)" ::: "memory"); SBAR(); o[3] = __builtin_amdgcn_mfma_f32_32x32x16_bf16(pa0, (bf16x8){vl4[0], vl4[1], vl4[2], vl4[3], vh4[0], vh4[1], vh4[2], vh4[3]}, o[3], 0, 0, 0); SBAR(); \
    asm volatile("s_waitcnt lgkmcnt(4)" ::: "memory"); SBAR(); o[3] = __builtin_amdgcn_mfma_f32_32x32x16_bf16(pa1, (bf16x8){vl0[0], vl0[1], vl0[2], vl0[3], vh0[0], vh0[1], vh0[2], vh0[3]}, o[3], 0, 0, 0); SBAR(); \
    asm volatile("s_waitcnt lgkmcnt(2)" ::: "memory"); SBAR(); o[3] = __builtin_amdgcn_mfma_f32_32x32x16_bf16(pa2, (bf16x8){vl1[0], vl1[1], vl1[2], vl1[3], vh1[0], vh1[1], vh1[2], vh1[3]}, o[3], 0, 0, 0); SBAR(); \
    asm volatile("s_waitcnt lgkmcnt(0)" ::: "memory"); SBAR(); o[3] = __builtin_amdgcn_mfma_f32_32x32x16_bf16(pa3, (bf16x8){vl2[0], vl2[1], vl2[2], vl2[3], vh2[0], vh2[1], vh2[2], vh2[3]}, o[3], 0, 0, 0); SBAR(); \
} while (0)
#define M4_XFIRST(KS, VS) do { \
    int xn_ = xkn, xr_ = xkr; asm volatile("" : "+v"(xn_), "+v"(xr_)); \
    const int kbn_ = (int)(uintptr_t)(lds + M2_OFF_K + (KS) * M2_KSLOT) + r32 * 256, kbr_ = (int)(uintptr_t)(lds + M2_OFF_K + (KS) * M2_KSLOT + KN_BYTES) + r32 * 128; \
    const int vb_ = (int)(uintptr_t)(lds + M2_OFF_V + (VS) * V_BYTES) + vlane; (void)vb_; \
    bf16x8 ka0, ka1, ka2, ka3, ka4, kb0, kb1, kb2, kb3, kb4; s16x4 vl0, vl1, vl2, vl3, vl4, vh0, vh1, vh2, vh3, vh4; \
    p0 = f32x16{}; p1 = f32x16{}; \
    { const int a_ = kbn_ + (((0) * 32 + hb) ^ xn_); ka0 = lds_rd128<0>(a_); kb0 = lds_rd128<8192>(a_); } \
    { const int a_ = kbn_ + (((1) * 32 + hb) ^ xn_); ka1 = lds_rd128<0>(a_); kb1 = lds_rd128<8192>(a_); } \
    { const int a_ = kbn_ + (((2) * 32 + hb) ^ xn_); ka2 = lds_rd128<0>(a_); kb2 = lds_rd128<8192>(a_); } \
    { const int a_ = kbn_ + (((3) * 32 + hb) ^ xn_); ka3 = lds_rd128<0>(a_); kb3 = lds_rd128<8192>(a_); } \
    { const int a_ = kbn_ + (((4) * 32 + hb) ^ xn_); ka4 = lds_rd128<0>(a_); kb4 = lds_rd128<8192>(a_); } \
    asm volatile("s_waitcnt lgkmcnt(8)" ::: "memory"); SBAR(); p0 = __builtin_amdgcn_mfma_f32_32x32x16_bf16(ka0, qr[0], p0, 0, 0, 0); p1 = __builtin_amdgcn_mfma_f32_32x32x16_bf16(kb0, qr[0], p1, 0, 0, 0); SBAR(); \
    { const int a_ = kbn_ + (((5) * 32 + hb) ^ xn_); ka0 = lds_rd128<0>(a_); kb0 = lds_rd128<8192>(a_); } \
    asm volatile("s_waitcnt lgkmcnt(8)" ::: "memory"); SBAR(); p0 = __builtin_amdgcn_mfma_f32_32x32x16_bf16(ka1, qr[1], p0, 0, 0, 0); p1 = __builtin_amdgcn_mfma_f32_32x32x16_bf16(kb1, qr[1], p1, 0, 0, 0); SBAR(); \
    { const int a_ = kbn_ + (((6) * 32 + hb) ^ xn_); ka1 = lds_rd128<0>(a_); kb1 = lds_rd128<8192>(a_); } \
    asm volatile("s_waitcnt lgkmcnt(8)" ::: "memory"); SBAR(); p0 = __builtin_amdgcn_mfma_f32_32x32x16_bf16(ka2, qr[2], p0, 0, 0, 0); p1 = __builtin_amdgcn_mfma_f32_32x32x16_bf16(kb2, qr[2], p1, 0, 0, 0); SBAR(); \
    { const int a_ = kbn_ + (((7) * 32 + hb) ^ xn_); ka2 = lds_rd128<0>(a_); kb2 = lds_rd128<8192>(a_); } \
    asm volatile("s_waitcnt lgkmcnt(8)" ::: "memory"); SBAR(); p0 = __builtin_amdgcn_mfma_f32_32x32x16_bf16(ka3, qr[3], p0, 0, 0, 0); p1 = __builtin_amdgcn_mfma_f32_32x32x16_bf16(kb3, qr[3], p1, 0, 0, 0); SBAR(); \
    { const int a_ = kbr_ + (((0) * 32 + hb) ^ xr_); ka3 = lds_rd128<0>(a_); kb3 = lds_rd128<4096>(a_); } \
    asm volatile("s_waitcnt lgkmcnt(8)" ::: "memory"); SBAR(); p0 = __builtin_amdgcn_mfma_f32_32x32x16_bf16(ka4, qr[4], p0, 0, 0, 0); p1 = __builtin_amdgcn_mfma_f32_32x32x16_bf16(kb4, qr[4], p1, 0, 0, 0); SBAR(); \
    { const int a_ = kbr_ + (((1) * 32 + hb) ^ xr_); ka4 = lds_rd128<0>(a_); kb4 = lds_rd128<4096>(a_); } \
    asm volatile("s_waitcnt lgkmcnt(8)" ::: "memory"); SBAR(); p0 = __builtin_amdgcn_mfma_f32_32x32x16_bf16(ka0, qr[5], p0, 0, 0, 0); p1 = __builtin_amdgcn_mfma_f32_32x32x16_bf16(kb0, qr[5], p1, 0, 0, 0); SBAR(); \
    { const int a_ = kbr_ + (((2) * 32 + hb) ^ xr_); ka0 = lds_rd128<0>(a_); kb0 = lds_rd128<4096>(a_); } \
    asm volatile("s_waitcnt lgkmcnt(8)" ::: "memory"); SBAR(); p0 = __builtin_amdgcn_mfma_f32_32x32x16_bf16(ka1, qr[6], p0, 0, 0, 0); p1 = __builtin_amdgcn_mfma_f32_32x32x16_bf16(kb1, qr[6], p1, 0, 0, 0); SBAR(); \
    { const int a_ = kbr_ + (((3) * 32 + hb) ^ xr_); ka1 = lds_rd128<0>(a_); kb1 = lds_rd128<4096>(a_); } \
    asm volatile("s_waitcnt lgkmcnt(8)" ::: "memory"); SBAR(); p0 = __builtin_amdgcn_mfma_f32_32x32x16_bf16(ka2, qr[7], p0, 0, 0, 0); p1 = __builtin_amdgcn_mfma_f32_32x32x16_bf16(kb2, qr[7], p1, 0, 0, 0); SBAR(); \
    asm volatile("s_waitcnt lgkmcnt(6)" ::: "memory"); SBAR(); p0 = __builtin_amdgcn_mfma_f32_32x32x16_bf16(ka3, qr[8], p0, 0, 0, 0); p1 = __builtin_amdgcn_mfma_f32_32x32x16_bf16(kb3, qr[8], p1, 0, 0, 0); SBAR(); \
    asm volatile("s_waitcnt lgkmcnt(4)" ::: "memory"); SBAR(); p0 = __builtin_amdgcn_mfma_f32_32x32x16_bf16(ka4, qr[9], p0, 0, 0, 0); p1 = __builtin_amdgcn_mfma_f32_32x32x16_bf16(kb4, qr[9], p1, 0, 0, 0); SBAR(); \
    asm volatile("s_waitcnt lgkmcnt(2)" ::: "memory"); SBAR(); p0 = __builtin_amdgcn_mfma_f32_32x32x16_bf16(ka0, qr[10], p0, 0, 0, 0); p1 = __builtin_amdgcn_mfma_f32_32x32x16_bf16(kb0, qr[10], p1, 0, 0, 0); SBAR(); \
    asm volatile("s_waitcnt lgkmcnt(0)" ::: "memory"); SBAR(); p0 = __builtin_amdgcn_mfma_f32_32x32x16_bf16(ka1, qr[11], p0, 0, 0, 0); p1 = __builtin_amdgcn_mfma_f32_32x32x16_bf16(kb1, qr[11], p1, 0, 0, 0); SBAR(); \
} while (0)

__device__ __forceinline__ void mla_unit4(lds_ptr lds, const bf16* __restrict__ Q, const bf16* __restrict__ KN, const bf16* __restrict__ KR, const bf16* __restrict__ V, bf16* __restrict__ OAB, int b, int h, int qb, const int tid_in) {
    int tid_ = tid_in; asm volatile("" : "+v"(tid_)); const int tid = tid_, lane = tid & 63, r32 = lane & 31, hi = lane >> 5; const int wid = __builtin_amdgcn_readfirstlane(tid >> 6);
    const bool metaq = (qb == 16);
    const bool wave_on = !metaq || wid == 0;
    const int qrow = metaq ? (TREAL + 16 * b + (r32 & 15)) : (b * SEQ + qb * 256 + wid * 32 + r32);
    __attribute__((address_space(3))) float* wsf = (__attribute__((address_space(3))) float*)(lds + M2_OFF_WS) + wid * 64;
    unsigned so_kn[2], so_kr, so_v[2];
#pragma unroll
    for (int i = 0; i < 2; ++i) { const int P = 2 * wid + i;
        { const int row = 4 * P + (lane >> 4), c = (lane & 15) ^ (row & 15); so_kn[i] = (unsigned)(row * 4096 + c * 16); }
        { const int q = 64 * P + lane, s = q >> 5, kk = (s >> 2) * 8 + ((q & 31) >> 2), col = (s & 3) * 32 + (q & 3) * 8, k = (kk & ~0xC) | ((kk & 4) << 1) | ((kk & 8) >> 1); so_v[i] = (unsigned)(k * 4096 + col * 2); } }
    { const int row = 8 * wid + (lane >> 3), c = (lane & 7) ^ ((row >> 1) & 7); so_kr = (unsigned)(row * 128 + c * 16); }
    const char* const kn_h = (const char*)KN + h * 256; const char* const v_h = (const char*)V + h * 256; const char* const kr_b = (const char*)KR;
    const size_t real0 = (size_t)b * SEQ, meta0 = (size_t)TREAL + 16 * b;
#define M3_ROW(t) ((t) == 0 ? meta0 : real0 + (size_t)((t) - 1) * 64)
#define M3_DMA(src, dstoff) __builtin_amdgcn_global_load_lds((const unsigned*)(src), (__attribute__((address_space(3))) unsigned*)(lds + (dstoff)), 16, 0, 0)
#define M3_DMA_K(t, slot) do { const size_t g_ = M3_ROW(t); const int so_ = M2_OFF_K + (slot) * M2_KSLOT; \
        M3_DMA(kn_h + g_ * 4096 + so_kn[0], so_ + (2 * wid) * 1024); M3_DMA(kn_h + g_ * 4096 + so_kn[1], so_ + (2 * wid + 1) * 1024); M3_DMA(kr_b + g_ * 128 + so_kr, so_ + KN_BYTES + wid * 1024); } while (0)
#define M3_DMA_V(t, slot) do { const size_t g_ = M3_ROW(t); const int so_ = M2_OFF_V + (slot) * V_BYTES; \
        M3_DMA(v_h + g_ * 4096 + so_v[0], so_ + (2 * wid) * 1024); M3_DMA(v_h + g_ * 4096 + so_v[1], so_ + (2 * wid + 1) * 1024); } while (0)
#define M3_WAIT(n) asm volatile("s_waitcnt vmcnt(" #n ")" ::: "memory")
#define M3_BAR() do { asm volatile("" ::: "memory"); __builtin_amdgcn_s_barrier(); asm volatile("" ::: "memory"); } while (0)
#define M3_EVENT(i, s3) do { if ((i) + 2 < M3_NT) M3_DMA_K((i) + 2, (s3) == 0 ? 2 : (s3) - 1); if ((i) + 1 < M3_NT) M3_DMA_V((i) + 1, (s3) == 2 ? 0 : (s3) + 1); } while (0)
#define M3_WAITI(i) do { if ((i) < M3_NT - 2) M3_WAIT(5); else M3_WAIT(0); } while (0)
    M3_DMA_K(0, 0); M3_DMA_V(0, 0); M3_DMA_K(1, 1);
    bf16x8 qr[12];
    { const bf16* qp = Q + (size_t)qrow * 3072 + h * 192 + hi * 8;
#pragma unroll
      for (int d0 = 0; d0 < 12; ++d0) qr[d0] = *reinterpret_cast<const bf16x8*>(qp + d0 * 16); }
    const int xkn = (r32 & 15) << 4, xkr = ((r32 >> 1) & 7) << 4, hb = hi * 16;
    const int vlane = v_rd_base(lane);
#define M3_PV(slot) pv_all(o, (int)(uintptr_t)(lds + M2_OFF_V + (slot) * V_BYTES) + vlane, pa0, pa1, pa2, pa3)
#define M3_Y(j) do { if (wave_on) { if ((j) == 0) { _Pragma("unroll") for (int r = 0; r < 16; ++r) { if (crow(r, hi) >= 16) p0[r] = NEG_BIG; p1[r] = NEG_BIG; } } \
        float alpha_; softmax_seg(p0, p1, m_reg, l_reg, alpha_, pa0, pa1, pa2, pa3); \
        if (__any(alpha_ < 1.f)) { if (hi == 0) wsf[r32] = alpha_; asm volatile("s_waitcnt lgkmcnt(0)" ::: "memory"); \
            _Pragma("unroll") for (int d = 0; d < 4; ++d) _Pragma("unroll") for (int r = 0; r < 16; ++r) o[d][r] *= wsf[crow(r, hi)]; } } } while (0)
    float m_reg = NEG_BIG, l_reg = 0.f; f32x16 o[4];
#pragma unroll
    for (int d = 0; d < 4; ++d) o[d] = f32x16{};
    f32x16 p0, p1; bf16x8 pa0, pa1, pa2, pa3;
    int s3 = 0;
    if (wid < 4) {
        M3_WAITI(0); M3_BAR();
        if (wave_on) M4_XFIRST(0, 0);
        M3_BAR(); M3_EVENT(0, 0);
        M3_Y(0);
        s3 = 1;
        for (int j = 1; j < M3_NT; ++j) {
            M3_WAITI(j); M3_BAR();
            if (wave_on) { __builtin_amdgcn_s_setprio(3); M4_XFULL(s3, (s3 == 0 ? 2 : s3 - 1)); __builtin_amdgcn_s_setprio(0); }
            M3_BAR(); M3_EVENT(j, s3);
            M3_Y(j);
            s3 = s3 == 2 ? 0 : s3 + 1;
        }
        M3_BAR();
        if (wave_on) M3_PV(s3 == 0 ? 2 : s3 - 1);
        M3_BAR();
    } else {
        M3_WAITI(0); M3_BAR(); M3_EVENT(0, 0);
        M3_BAR();
        if (wave_on) M4_XFIRST(0, 0);
        M3_WAITI(1); M3_BAR(); M3_EVENT(1, 1);
        M3_Y(0);
        s3 = 1;
        for (int j = 1; j < M3_NT; ++j) {
            M3_BAR();
            if (wave_on) { __builtin_amdgcn_s_setprio(3); M4_XFULL(s3, (s3 == 0 ? 2 : s3 - 1)); __builtin_amdgcn_s_setprio(0); }
            M3_WAITI(j + 1); M3_BAR(); { const int s3n = s3 == 2 ? 0 : s3 + 1; M3_EVENT(j + 1, s3n); }
            M3_Y(j);
            s3 = s3 == 2 ? 0 : s3 + 1;
        }
        M3_BAR();
        if (wave_on) M3_PV(s3 == 0 ? 2 : s3 - 1);
    }
    if (wave_on) {
        if (hi == 0) wsf[32 + r32] = l_reg; asm volatile("s_waitcnt lgkmcnt(0)" ::: "memory");
        const int orow0 = metaq ? (TREAL + 16 * b) : (b * SEQ + qb * 256 + wid * 32);
#pragma unroll
        for (int r = 0; r < 16; ++r) { const int rw = crow(r, hi); const float rl = __builtin_amdgcn_rcpf(wsf[32 + rw]);
            if (!metaq || rw < 16) { bf16* op = OAB + (size_t)(orow0 + rw) * 4096 + h * 128 + r32;
#pragma unroll
                for (int d0 = 0; d0 < 4; ++d0) op[d0 * 32] = (bf16)(cvtpk(o[d0][r] * rl, 0.f) & 0xffffu); } }
    }
    M3_WAIT(0); M3_BAR();
#undef M3_ROW
#undef M3_DMA
#undef M3_DMA_K
#undef M3_DMA_V
#undef M3_WAIT
#undef M3_BAR
#undef M3_EVENT
#undef M3_WAITI
#undef M3_PV
#undef M3_Y
}
#undef M4_XFULL
#undef M4_XFIRST
}
enum { I_X = 0, I_META, I_EMB_G, I_EMB_B, I_RELB, I_WIN, I_QNG, I_KVNG, I_WUQ, I_WUKV, I_SINK, I_WPA, I_WPB, I_WOUT, I_LMG, I_LMB, I_LFG, I_LFB,
       I_FW1, I_FW3, I_FW2, I_RW, I_RB, I_MW1, I_MW3, I_MW2, N_IN };
constexpr int NWAVES = 8;
constexpr int N_PHASES = 20;
constexpr size_t MiB = 1u << 20, KiB32 = 32768;
constexpr size_t WS_CTL = 0, CTL_ZERO_BYTES = 65536;
constexpr size_t WS_CS = 1 * MiB, WS_SN = WS_CS + 540672;
constexpr size_t WS_BIAS = 3 * MiB;
constexpr size_t WS_TW = WS_BIAS, WS_TM = WS_BIAS + 32768, WS_SINK = WS_BIAS + 49152;
constexpr size_t WS_WHIST = WS_BIAS + 65536;
constexpr size_t WS_TOPI = 4 * MiB, WS_TOPG = WS_TOPI + 262144, WS_TOKSLOT = WS_TOPG + 262144;
constexpr size_t WS_SLOTTOK = 5 * MiB, WS_SLOTGATE = WS_SLOTTOK + 294912;
constexpr size_t WS_SSQ = 6 * MiB;
constexpr size_t WS_HB = 9 * MiB;
constexpr size_t WS_W = 138 * MiB;
constexpr size_t WL_IN = 0, WL_UQ = 34 * MiB, WL_UKV = WL_UQ + 9 * MiB / 2, WL_AB = WL_UKV + 4 * MiB, WL_OUT = WL_AB + 16 * MiB, WL_STRIDE = WL_OUT + 8 * MiB;
constexpr size_t WS_WF13 = WS_W + 2 * WL_STRIDE, WS_WF2 = WS_WF13 + 44 * MiB, WS_WEND = WS_WF2 + 22 * MiB;
constexpr size_t AR = 337 * MiB;
constexpr size_t WS_CQ = AR, WS_CKV = WS_CQ + 1548 * KiB32, WS_KR = WS_CKV + 1032 * KiB32, WS_QB = WS_KR + 132 * KiB32;
constexpr size_t WS_KB = WS_QB + 129 * MiB, WS_VB = WS_KB + 1032 * KiB32, WS_GR = WS_VB + 1032 * KiB32, WS_GBB = WS_GR + 129 * MiB;
constexpr size_t WS_Q = WS_GBB + 129 * MiB, WS_KN = WS_Q + 6192 * KiB32  , WS_V = WS_KN + 129 * MiB, WS_OAB = WS_V + 129 * MiB, WS_MIX_END = WS_OAB + 258 * MiB;
constexpr size_t WS_MG = WS_Q;
constexpr size_t WS_X = WS_OAB;
constexpr size_t WS_ACT = AR;
constexpr size_t WS_MACT = 337 * MiB;
constexpr size_t WS_Y = 1265 * MiB;
constexpr size_t WS_YP = WS_Y + 264 * MiB;
constexpr size_t WS_XP = 1672 * MiB;
constexpr size_t WS_END = WS_XP + 4 * MiB;
static_assert(MW_E5 == WS_W && MW_E5 + MW_E <= WS_W + WL_STRIDE, "expert 5 over layer 0's mixer weights only");
static_assert(MW_E6 >= WS_WF13 && MW_E6 + MW_E <= WS_WEND && WS_WEND <= WS_MACT, "expert 6 over the dense FFN weights only");
static_assert(MW_E7B >= WS_W + WL_STRIDE + WL_IN && MW_E7B + 22 * MiB <= WS_W + WL_STRIDE + WL_UQ, "expert 7 w2 over layer 1's w_in copy only");
static_assert(MW_E7A >= WS_KN && MW_E7A + 44 * MiB <= WS_V && WS_MACT + 726 * MiB <= MW_E7A && MW_E7A + 44 * MiB <= WS_Y, "expert 7 w13 over the MLA K buffer only");
static_assert(MW_B >= WS_MIX_END && MW_B + 88 * MiB <= WS_XP && WS_YP + 24 * MiB <= MW_B, "free tail");
static_assert(WS_MIX_END <= 1700 * MiB && WS_END <= 1700 * MiB, "d_ws map");
static_assert(WS_ACT + (size_t)TP * DFF * 2 <= WS_X, "dense ACT vs X");
static_assert(WS_SSQ + (size_t)TP * 20 * 4 <= WS_HB && WS_SLOTGATE + 294912 <= WS_SSQ && WS_TOKSLOT + 262144 <= WS_SLOTTOK && WS_SN + 540672 <= WS_BIAS, "small tables");
static_assert(WS_KR + (size_t)TP * 64 * 2 <= WS_QB, "KR");
constexpr int CW_TMO = 0, CW_CODE = 1;
constexpr int CW_ATT = 100;
constexpr int CW_FILL = 104;
constexpr int CW_MOE_TS = 64;
constexpr int CW_BAR = 4096;
constexpr int RING_OFF = 0, RING_BYTES = 131072;
constexpr int LDSCTL_OFF = RING_BYTES, MISC_OFF = LDSCTL_OFF + 320, PT_OFF = LDSCTL_OFF + 512;
constexpr int LDS_BYTES = 147456;
static_assert(att::ATT_LDS_BYTES <= RING_BYTES && att::M2_LDS_BYTES <= RING_BYTES && att::S2_LDS_BYTES <= RING_BYTES, "attention LDS");

#define GAS __attribute__((address_space(1)))
#define LAS __attribute__((address_space(3)))
typedef unsigned short bf16;
typedef unsigned v4u __attribute__((ext_vector_type(4)));
typedef unsigned v2u __attribute__((ext_vector_type(2)));
typedef float f32x4 __attribute__((ext_vector_type(4)));
typedef GAS unsigned gu32;
#define RLX_AGENT __ATOMIC_RELAXED, __HIP_MEMORY_SCOPE_AGENT
#define LDS_WAIT() asm volatile("s_waitcnt lgkmcnt(0)" ::: "memory")
#define VM_WAIT() asm volatile("s_waitcnt vmcnt(0)" ::: "memory")
__device__ __forceinline__ unsigned f2bf(float f) { unsigned u = __builtin_bit_cast(unsigned, f); return (u + 0x7fffu + ((u >> 16) & 1u)) >> 16; }
__device__ __forceinline__ unsigned pk2(float lo, float hi) { return pg8::cvt_pk_bf16(lo, hi); }

#define XB_TMO      128
#define XB_XCNT(j)  (256  + 64 * (j))
#define XB_XSUB(j)  (1280 + 64 * (j))
#define XB_XGEN(j)  (2304 + 64 * (j))
#define XB_TOP      3328
#define XB_TOPGEN   3392
#define XCD_BAR_WORDS 3456
#define XB_SPIN_CAP (1u << 22)
__device__ __forceinline__ unsigned xb_ld(unsigned* p)              { return __hip_atomic_load(p, __ATOMIC_RELAXED, __HIP_MEMORY_SCOPE_AGENT); }
__device__ __forceinline__ unsigned xb_add(unsigned* p, unsigned v) { return __hip_atomic_fetch_add(p, v, __ATOMIC_RELAXED, __HIP_MEMORY_SCOPE_AGENT); }
__device__ __forceinline__ unsigned xb_xcc_id() { return (unsigned)__builtin_amdgcn_s_getreg((3 << 11) | 20) & 0xFu; }
#define XB_SPIN(cond, bar) do { unsigned _sp = 0; while (cond) { __builtin_amdgcn_s_sleep(1); \
    if ((++_sp & 255u) == 0u) { if (xb_ld(&(bar)[XB_TMO])) break; if (_sp > XB_SPIN_CAP) { atomicAdd(&(bar)[XB_TMO], 1u); break; } } } } while (0)
struct XcdBarrier { unsigned* bar; unsigned x; volatile LAS unsigned* st; };
__device__ __forceinline__ XcdBarrier xcd_barrier_post(unsigned* bar, volatile LAS unsigned* st, const int tid) {
    XcdBarrier b; b.bar = bar; b.x = xb_xcc_id(); b.st = st;
    if (tid == 0) (void)xb_add(&bar[XB_XCNT(b.x)], 1u);
    return b;
}
__device__ __forceinline__ void xcd_barrier_complete(unsigned* bar, unsigned x, unsigned& nloc, unsigned& nx) {
    const unsigned G = gridDim.x * gridDim.y * gridDim.z;
    unsigned sum, cnt, mine, sp = 0u;
    for (;;) {
        sum = 0u; cnt = 0u; mine = 0u;
#pragma unroll
        for (unsigned j = 0; j < 16; ++j) { const unsigned c = xb_ld(&bar[XB_XCNT(j)]); sum += c; cnt += (c > 0u) ? 1u : 0u; mine = (j == x) ? c : mine; }
        if (sum == G) break;
        __builtin_amdgcn_s_sleep(1);
        if ((++sp & 255u) == 0u) { if (xb_ld(&bar[XB_TMO])) break; if (sp > XB_SPIN_CAP) { atomicAdd(&bar[XB_TMO], 1u); break; } }
    }
    nloc = mine > 0u ? mine : 1u; nx = cnt > 0u ? cnt : 1u;
}
__device__ __forceinline__ void xcd_barrier(const XcdBarrier& b, const int tid) {
    asm volatile("s_waitcnt vmcnt(0)" ::: "memory");
    __syncthreads();
    if (tid == 0) {
        unsigned* bar = b.bar;
        __builtin_amdgcn_s_waitcnt(0);
        unsigned nloc = b.st[0], nx = b.st[1];
        if (nloc == 0u) { xcd_barrier_complete(bar, b.x, nloc, nx); b.st[0] = nloc; b.st[1] = nx; }
        const unsigned old = xb_add(&bar[XB_XSUB(b.x)], 1u);
        const unsigned gen = old / nloc;
        if (old + 1u == (gen + 1u) * nloc) {
            __builtin_amdgcn_fence(__ATOMIC_RELEASE, "agent");
            asm volatile("s_waitcnt vmcnt(0)" ::: "memory");
            const unsigned og = xb_add(&bar[XB_TOP], 1u);
            const unsigned tg = og / nx;
            if (og + 1u == (tg + 1u) * nx) xb_add(&bar[XB_TOPGEN], 1u);
            else XB_SPIN(xb_ld(&bar[XB_TOPGEN]) == tg, bar);
            __builtin_amdgcn_fence(__ATOMIC_ACQUIRE, "agent");
            xb_add(&bar[XB_XGEN(b.x)], 1u);
            asm volatile("s_waitcnt vmcnt(0)" ::: "memory");
        } else {
            XB_SPIN(xb_ld(&bar[XB_XGEN(b.x)]) == gen, bar);
            __builtin_amdgcn_fence(__ATOMIC_ACQUIRE, "agent");
            asm volatile("s_waitcnt vmcnt(0)" ::: "memory");
        }
    }
    __syncthreads();
}

__device__ __forceinline__ int lane_id() { int l; asm volatile("v_mbcnt_lo_u32_b32 %0, -1, 0\n\tv_mbcnt_hi_u32_b32 %0, -1, %0" : "=v"(l)); return l; }
__device__ __forceinline__ float dpp_add(float v, const int ctrl_tag) {
    int r;
    if (ctrl_tag == 0) r = __builtin_amdgcn_update_dpp(0, __float_as_int(v), 0xB1, 0xF, 0xF, true);
    else if (ctrl_tag == 1) r = __builtin_amdgcn_update_dpp(0, __float_as_int(v), 0x4E, 0xF, 0xF, true);
    else if (ctrl_tag == 2) r = __builtin_amdgcn_update_dpp(0, __float_as_int(v), 0x141, 0xF, 0xF, true);
    else r = __builtin_amdgcn_update_dpp(0, __float_as_int(v), 0x140, 0xF, 0xF, true);
    return v + __int_as_float(r);
}
__device__ __forceinline__ float wave_sum(float v) {
    v = dpp_add(v, 0); v = dpp_add(v, 1); v = dpp_add(v, 2); v = dpp_add(v, 3);
    const float r0 = __int_as_float(__builtin_amdgcn_readlane(__float_as_int(v), 0)), r1 = __int_as_float(__builtin_amdgcn_readlane(__float_as_int(v), 16));
    const float r2 = __int_as_float(__builtin_amdgcn_readlane(__float_as_int(v), 32)), r3 = __int_as_float(__builtin_amdgcn_readlane(__float_as_int(v), 48));
    return (r0 + r1) + (r2 + r3);
}
__device__ __forceinline__ void transpose_item(const float* __restrict__ W, int ldw, int k0, int n0, bf16* __restrict__ WT, size_t ldt, int drow, int koff, const float* __restrict__ g, LAS float* scr, int lane) {
    const int kr = lane >> 3, c4 = (lane & 7) * 4;
    f32x4 v[8];
#pragma unroll
    for (int i = 0; i < 8; ++i) v[i] = *(const GAS f32x4*)(W + (size_t)(k0 + 8 * i + kr) * ldw + n0 + c4);
    if (g) {
#pragma unroll
        for (int i = 0; i < 8; ++i) v[i] = v[i] * g[k0 + 8 * i + kr]; }
#pragma unroll
    for (int i = 0; i < 8; ++i) { LAS float* d = scr + (8 * i + kr) * 33 + c4; d[0] = v[i].x; d[1] = v[i].y; d[2] = v[i].z; d[3] = v[i].w; }
    LDS_WAIT(); asm volatile("" ::: "memory");
    const int c = lane & 7;
#pragma unroll
    for (int j = 0; j < 4; ++j) { const int n = (lane >> 3) + 8 * j; const LAS float* s = scr + (8 * c) * 33 + n;
        v4u o; o.x = pk2(s[0 * 33], s[1 * 33]); o.y = pk2(s[2 * 33], s[3 * 33]); o.z = pk2(s[4 * 33], s[5 * 33]); o.w = pk2(s[6 * 33], s[7 * 33]);
        *(GAS v4u*)(WT + (size_t)(drow + n) * ldt + koff + k0 + 8 * c) = o; }
    LDS_WAIT(); asm volatile("" ::: "memory");
}
struct TDesc { const float* W; bf16* WT; size_t ldt; int ldw, k0, n0, drow; };
__device__ __forceinline__ void t_load(const TDesc& d, f32x4 (&v)[8], int lane) {
    const int kr = lane >> 3, c4 = (lane & 7) * 4;
#pragma unroll
    for (int i = 0; i < 8; ++i) v[i] = __builtin_nontemporal_load((const GAS f32x4*)(d.W + (size_t)(d.k0 + 8 * i + kr) * d.ldw + d.n0 + c4));
}
__device__ __forceinline__ void t_finish(const TDesc& d, const f32x4 (&v)[8], LAS float* scr, int lane) {
    const int kr = lane >> 3, c4 = (lane & 7) * 4;
#pragma unroll
    for (int i = 0; i < 8; ++i) { LAS float* p = scr + (8 * i + kr) * 33 + c4; p[0] = v[i].x; p[1] = v[i].y; p[2] = v[i].z; p[3] = v[i].w; }
    LDS_WAIT(); asm volatile("" ::: "memory");
    const int c = lane & 7;
#pragma unroll
    for (int j = 0; j < 4; ++j) { const int n = (lane >> 3) + 8 * j; const LAS float* s = scr + (8 * c) * 33 + n;
        v4u o; o.x = pk2(s[0 * 33], s[1 * 33]); o.y = pk2(s[2 * 33], s[3 * 33]); o.z = pk2(s[4 * 33], s[5 * 33]); o.w = pk2(s[6 * 33], s[7 * 33]);
        __builtin_nontemporal_store(o, (GAS v4u*)(d.WT + (size_t)(d.drow + n) * d.ldt + d.k0 + 8 * c)); }
    LDS_WAIT(); asm volatile("" ::: "memory");
}
__device__ __forceinline__ int dmap_in(int n0) {
    if (n0 < 1280) return n0;
    if (n0 < 1312) return 1280;
    if (n0 < 1344) return 1280 + 128;
    if (n0 < 3392) return 1536 + (n0 - 1344);
    if (n0 < 3904) return 3584 + (n0 - 3392);
    if (n0 < 4416) return 4096 + (n0 - 3904);
    if (n0 < 6464) { const int a = n0 - 4416; return 4608 + 256 * (a >> 7) + (a & 127); }
    const int a = n0 - 6464; return 4608 + 256 * (a >> 7) + 128 + (a & 127);
}
__device__ __forceinline__ int dmap_uq(int n0) {
    const int head = n0 / 192, off = n0 - head * 192;
    if (off < 128) return 256 * (head >> 1) + 128 * (head & 1) + off;
    if (off < 160) return 256 * (8 + (head >> 2)) + 32 * (head & 3);
    return 256 * (8 + (head >> 2)) + 128 + 32 * (head & 3);
}
__device__ __forceinline__ int dmap_glu(int n0) { return 256 * (n0 >> 7) + (n0 & 127); }
constexpr int DI_IN = (D / 64) * (INDIM / 32), DI_UQ = (QRANK / 64) * (3072 / 32), DI_UKV = (KVRANK / 64) * (4096 / 32), DI_SQ = (D / 64) * (D / 32), DI_LAYER = DI_IN + DI_UQ + DI_UKV + 3 * DI_SQ;
constexpr int DI_F = (D / 64) * (DFF / 32), DI_F2 = (DFF / 64) * (D / 32), DI_N = 2 * DI_LAYER + 2 * DI_F + DI_F2, DI_DEFER = DI_N - DI_LAYER;
static_assert(DI_DEFER % 8 == 0, "claim granularity");
__device__ __forceinline__ const float* pt_in(LAS unsigned char* lds, int i) {
    const unsigned long long v = ((volatile LAS unsigned long long*)(lds + PT_OFF))[i];
    const unsigned long long u = (unsigned long long)(unsigned)__builtin_amdgcn_readfirstlane((int)(unsigned)v) | ((unsigned long long)(unsigned)__builtin_amdgcn_readfirstlane((int)(unsigned)(v >> 32)) << 32);
    return (const float*)(const GAS float*)u; }
__device__ __forceinline__ void dense_item(const int it, LAS unsigned char* lds, unsigned char* ws, LAS float* scr, int lane) {
#define PIN(i) pt_in(lds, (i))
    constexpr int I_IN = DI_IN, I_UQ = DI_UQ, I_UKV = DI_UKV, I_SQ = DI_SQ, I_LAYER = DI_LAYER, I_F = DI_F; (void)I_SQ;
            int r = it;
            if (r < 2 * I_LAYER) { const int l = r / I_LAYER; r -= l * I_LAYER; unsigned char* wl = ws + WS_W + l * WL_STRIDE;
                if (r < I_IN) { const int nblk = INDIM / 32, kb = r / nblk, nb = r % nblk; transpose_item(PIN(I_WIN) + (size_t)l * D * INDIM, INDIM, 64 * kb, 32 * nb, (bf16*)(ws + WS_W + l * WL_STRIDE + WL_IN), D, dmap_in(32 * nb), 0, nullptr, scr, lane); return; } r -= I_IN;
                if (r < I_UQ) { const int nblk = 3072 / 32, kb = r / nblk, nb = r % nblk; transpose_item(PIN(I_WUQ) + (size_t)l * QRANK * 3072, 3072, 64 * kb, 32 * nb, (bf16*)(ws + WS_W + l * WL_STRIDE + WL_UQ), QRANK, dmap_uq(32 * nb), 0, PIN(I_QNG) + l * QRANK, scr, lane); return; } r -= I_UQ;
                if (r < I_UKV) { const int nblk = 4096 / 32, kb = r / nblk, nb = r % nblk; transpose_item(PIN(I_WUKV) + (size_t)l * KVRANK * 4096, 4096, 64 * kb, 32 * nb, (bf16*)(ws + WS_W + l * WL_STRIDE + WL_UKV), KVRANK, 32 * nb, 0, PIN(I_KVNG) + l * KVRANK, scr, lane); return; } r -= I_UKV;
                { const int which = r / I_SQ; r -= which * I_SQ; const int nblk = D / 32, kb = r / nblk, nb = r % nblk;
                  if (which == 0) transpose_item(PIN(I_WPA) + (size_t)l * D * D, D, 64 * kb, 32 * nb, (bf16*)(ws + WS_W + l * WL_STRIDE + WL_AB), 2 * D, 32 * nb, 0, nullptr, scr, lane);
                  else if (which == 1) transpose_item(PIN(I_WPB) + (size_t)l * D * D, D, 64 * kb, 32 * nb, (bf16*)(ws + WS_W + l * WL_STRIDE + WL_AB), 2 * D, 32 * nb, D, nullptr, scr, lane);
                  else transpose_item(PIN(I_WOUT) + (size_t)l * D * D, D, 64 * kb, 32 * nb, (bf16*)(ws + WS_W + l * WL_STRIDE + WL_OUT), D, 32 * nb, 0, nullptr, scr, lane);
                  return; }
            }
            r -= 2 * I_LAYER;
            if (r < 2 * I_F) { const int which = r / I_F; r -= which * I_F; const int nblk = DFF / 32, kb = r / nblk, nb = r % nblk;
                transpose_item(PIN(which ? I_FW3 : I_FW1), DFF, 64 * kb, 32 * nb, (bf16*)(ws + WS_WF13), D, dmap_glu(32 * nb) + (which ? 128 : 0), 0, nullptr, scr, lane); return; }
            r -= 2 * I_F;
            { const int nblk = D / 32, kb = r / nblk, nb = r % nblk; transpose_item(PIN(I_FW2), D, 64 * kb, 32 * nb, (bf16*)(ws + WS_WF2), DFF, 32 * nb, 0, nullptr, scr, lane); }
#undef PIN
}
constexpr int MC_IF = (D / 64) * (DFF / 32), MC_IF2 = (DFF / 64) * (D / 32), MC_IE = 2 * MC_IF + MC_IF2, MC_NIT = NE * MC_IE, MC_EARLY = 5 * MC_IE;
static_assert(MC_IE % 8 == 0, "claim granularity");
__device__ __forceinline__ int mc_start(int li) { return li == 0 ? 0 : (4 + li) * MC_IE; }
__device__ __forceinline__ int mc_count(int li) { return li == 0 ? MC_EARLY : MC_IE; }
__device__ __forceinline__ int mc_minseam(int li) { return li == 0 ? 0 : (li == 1 ? 6 : (li == 2 ? 9 : 13)); }
struct MoeConv { const float* mw1; const float* mw3; const float* mw2; const char* out; const char* ws; unsigned* ctr; };
__device__ __forceinline__ void moe_desc(const MoeConv& c, int it, TDesc& d) {
    const int e = it / MC_IE; int r = it - e * MC_IE;
    if (r < 2 * MC_IF) { const int wh = r / MC_IF; r -= wh * MC_IF; const int kb = r / (DFF / 32), nb = r % (DFF / 32);
        d.W = (wh ? c.mw3 : c.mw1) + (size_t)e * D * DFF; d.ldw = DFF; d.k0 = 64 * kb; d.n0 = 32 * nb; d.WT = (bf16*)moe_w13(e, c.out, c.ws); d.ldt = D; d.drow = dmap_glu(32 * nb) + (wh ? 128 : 0); }
    else { r -= 2 * MC_IF; const int kb = r / (D / 32), nb = r % (D / 32);
        d.W = c.mw2 + (size_t)e * DFF * D; d.ldw = D; d.k0 = 64 * kb; d.n0 = 32 * nb; d.WT = (bf16*)moe_w2(e, c.out, c.ws); d.ldt = DFF; d.drow = 32 * nb; }
}
template <int NPW>
__device__ __forceinline__ void moe_conv_run(const MoeConv& c, int base, int wave, int lane, LAS float* scr) {
    TDesc da{}, db{}; f32x4 va[8] = {}, vb[8] = {};
    const int lim = base < MC_EARLY ? MC_EARLY : (base / MC_IE + 1) * MC_IE;
    int it = base + wave; if (it < lim) { moe_desc(c, it, da); t_load(da, va, lane); }
#pragma unroll 1
    for (int j = 0; j < NPW; j += 2) { const int it1 = it + 8, it2 = it + 16; const bool h1 = (j + 1 < NPW) && it1 < lim, h2 = (j + 2 < NPW) && it2 < lim;
        if (h1) { moe_desc(c, it1, db); t_load(db, vb, lane); }
        if (it < lim) t_finish(da, va, scr, lane);
        if (h1) { if (h2) { moe_desc(c, it2, da); t_load(da, va, lane); } t_finish(db, vb, scr, lane); }
        it = it2; }
}
__device__ __forceinline__ unsigned moe_claim(const MoeConv& c, unsigned n, int seam, unsigned& mask) {
    if (seam <= 5 && !(mask & 16u)) { const unsigned b = xb_add(c.ctr + 4, n); if (b < (unsigned)DI_DEFER) return (unsigned)MC_NIT + 1u + b; mask |= 16u; }
#pragma unroll
    for (int li = 0; li < 4; ++li) if (seam >= mc_minseam(li) && !(mask & (1u << li))) { const unsigned b = xb_add(c.ctr + li, n); if (b < (unsigned)mc_count(li)) return (unsigned)mc_start(li) + b; mask |= 1u << li; }
    return (unsigned)MC_NIT;
}
__device__ __forceinline__ void xcd_barrier_fill(const XcdBarrier& b, const int tid, const MoeConv& mc, const int seam, LAS unsigned char* lds) {
    asm volatile("s_waitcnt vmcnt(0)" ::: "memory");
    __syncthreads();
    unsigned gen = 0u;
    if (tid == 0) {
        unsigned* bar = b.bar;
        __builtin_amdgcn_s_waitcnt(0);
        unsigned nloc = b.st[0], nx = b.st[1];
        if (nloc == 0u) { xcd_barrier_complete(bar, b.x, nloc, nx); b.st[0] = nloc; b.st[1] = nx; }
        const unsigned old = xb_add(&bar[XB_XSUB(b.x)], 1u);
        gen = old / nloc;
        if (old + 1u == (gen + 1u) * nloc) {
            __builtin_amdgcn_fence(__ATOMIC_RELEASE, "agent");
            asm volatile("s_waitcnt vmcnt(0)" ::: "memory");
            const unsigned og = xb_add(&bar[XB_TOP], 1u);
            const unsigned tg = og / nx;
            if (og + 1u == (tg + 1u) * nx) xb_add(&bar[XB_TOPGEN], 1u);
            else XB_SPIN(xb_ld(&bar[XB_TOPGEN]) == tg, bar);
            __builtin_amdgcn_fence(__ATOMIC_ACQUIRE, "agent");
            xb_add(&bar[XB_XGEN(b.x)], 1u);
            asm volatile("s_waitcnt vmcnt(0)" ::: "memory");
            b.st[2] = 1u;
        } else b.st[2] = 0u;
    }
    __syncthreads();
    const int wave = __builtin_amdgcn_readfirstlane(tid >> 6), lane = tid & 63;
    LAS float* scr = (LAS float*)(lds + RING_OFF + wave * 16384);
    unsigned done = b.st[2];
#pragma unroll 1
    while (done == 0u) {
        __syncthreads();
        if (tid == 0) {
            unsigned* bar = b.bar;
            if (xb_ld(&bar[XB_XGEN(b.x)]) != gen) { __builtin_amdgcn_fence(__ATOMIC_ACQUIRE, "agent"); asm volatile("s_waitcnt vmcnt(0)" ::: "memory"); b.st[2] = 1u; }
            else { unsigned mask = b.st[4]; const unsigned base = moe_claim(mc, 8u, seam, mask); b.st[4] = mask;
                if (base == (unsigned)MC_NIT) {
                    XB_SPIN(xb_ld(&bar[XB_XGEN(b.x)]) == gen, bar);
                    __builtin_amdgcn_fence(__ATOMIC_ACQUIRE, "agent"); asm volatile("s_waitcnt vmcnt(0)" ::: "memory"); b.st[2] = 1u; }
                else b.st[3] = base; }
        }
        __syncthreads();
        done = b.st[2];
        if (done == 0u) { const unsigned base = b.st[3];
            if (base > (unsigned)MC_NIT) dense_item(DI_LAYER + (int)(base - (unsigned)MC_NIT - 1u) + wave, lds, (unsigned char*)mc.ws, scr, lane);
            else moe_conv_run<1>(mc, (int)base, wave, lane, scr);
            asm volatile("s_waitcnt vmcnt(0)" ::: "memory"); }
    }
    __syncthreads();
}

struct Row8 { f32x4 v[8]; };
__device__ __forceinline__ void ln_normalize(Row8& r) {
    float s = 0.f;
#pragma unroll
    for (int j = 0; j < 8; ++j) s += (r.v[j].x + r.v[j].y) + (r.v[j].z + r.v[j].w);
    const float mean = wave_sum(s) * (1.f / D); float s2 = 0.f;
#pragma unroll
    for (int j = 0; j < 8; ++j) { r.v[j] = r.v[j] - mean; s2 += (r.v[j].x * r.v[j].x + r.v[j].y * r.v[j].y) + (r.v[j].z * r.v[j].z + r.v[j].w * r.v[j].w); }
    const float rstd = __builtin_amdgcn_rsqf(wave_sum(s2) * (1.f / D) + LN_EPS);
#pragma unroll
    for (int j = 0; j < 8; ++j) r.v[j] = r.v[j] * rstd;
}
__device__ __forceinline__ void ln_affine(Row8& r, const float* __restrict__ g, const float* __restrict__ b, int lane) {
#pragma unroll
    for (int jj = 0; jj < 4; ++jj) { const f32x4* gp = (const f32x4*)g + 2 * (lane + 64 * jj); const f32x4* bp = (const f32x4*)b + 2 * (lane + 64 * jj);
        r.v[2 * jj] = r.v[2 * jj] * gp[0] + bp[0]; r.v[2 * jj + 1] = r.v[2 * jj + 1] * gp[1] + bp[1]; }
}
__device__ __forceinline__ void ln_affine_r(Row8& r, const Row8& gv, const Row8& bv) {
#pragma unroll
    for (int j = 0; j < 8; ++j) r.v[j] = r.v[j] * gv.v[j] + bv.v[j];
}
__device__ __forceinline__ void row_store_bf16(const Row8& r, bf16* orow, int lane) {
#pragma unroll
    for (int jj = 0; jj < 4; ++jj) { v4u w; w.x = pk2(r.v[2 * jj].x, r.v[2 * jj].y); w.y = pk2(r.v[2 * jj].z, r.v[2 * jj].w); w.z = pk2(r.v[2 * jj + 1].x, r.v[2 * jj + 1].y); w.w = pk2(r.v[2 * jj + 1].z, r.v[2 * jj + 1].w);
        *((GAS v4u*)orow + lane + 64 * jj) = w; }
}
__device__ __forceinline__ void row_load_f32(Row8& r, const float* xrow, int lane) {
#pragma unroll
    for (int jj = 0; jj < 4; ++jj) { const GAS f32x4* p = (const GAS f32x4*)xrow + 2 * (lane + 64 * jj); r.v[2 * jj] = p[0]; r.v[2 * jj + 1] = p[1]; }
}
__device__ __forceinline__ f32x4 bf4(v2u w);
__device__ __forceinline__ void bf8(v4u w, f32x4& a, f32x4& b) { a = bf4((v2u){w.x, w.y}); b = bf4((v2u){w.z, w.w}); }
__device__ __forceinline__ void row_load_bf16(Row8& r, const bf16* xrow, int lane) {
#pragma unroll
    for (int jj = 0; jj < 4; ++jj) bf8(*((const GAS v4u*)xrow + lane + 64 * jj), r.v[2 * jj], r.v[2 * jj + 1]);
}
__device__ __forceinline__ void meta_partials_n(Row8& r, const bf16* P, int stride_rows, int row, int lane) {
#pragma unroll 1
    for (int p = 0; p < 3; ++p) { Row8 t; row_load_bf16(t, P + ((size_t)p * stride_rows + row) * 2048, lane);
#pragma unroll
        for (int j = 0; j < 8; ++j) r.v[j] = r.v[j] + t.v[j]; }
}
__device__ __forceinline__ void meta_partials(Row8& r, const bf16* P, int row, int lane) { meta_partials_n(r, P, 256, row, lane); }
__device__ __forceinline__ void row_store_f32(const Row8& r, float* orow, int lane) {
#pragma unroll
    for (int jj = 0; jj < 4; ++jj) { GAS f32x4* p = (GAS f32x4*)orow + 2 * (lane + 64 * jj); p[0] = r.v[2 * jj]; p[1] = r.v[2 * jj + 1]; }
}
__device__ __forceinline__ f32x4 bf4(v2u w) { return (f32x4){__uint_as_float(w.x << 16), __uint_as_float(w.x & 0xffff0000u), __uint_as_float(w.y << 16), __uint_as_float(w.y & 0xffff0000u)}; }
__device__ __forceinline__ int t5_bucket(int rel) {
    const int n = rel < 0 ? -rel : rel; int v;
    if (n < 8) v = n; else if (n < 12) v = 8; else if (n < 16) v = 9; else if (n < 23) v = 10; else if (n < 32) v = 11; else if (n < 46) v = 12; else if (n < 64) v = 13; else if (n < 91) v = 14; else v = 15;
    return (rel > 0 ? 16 : 0) + v;
}

__device__ __forceinline__ void router_row(const Row8& r, const LAS f32x4* rwl, const float* __restrict__ rbias, int lane, int& i0, int& i1, float& g0, float& g1) {
    float lg[8];
#pragma unroll
    for (int e = 0; e < 8; ++e) lg[e] = 0.f;
#pragma unroll
    for (int j = 0; j < 8; ++j) {
#pragma unroll
        for (int q = 0; q < 4; ++q) { const f32x4 w0 = rwl[(j * 4 + q) * 64 + lane], w1 = rwl[2048 + (j * 4 + q) * 64 + lane]; const float y = r.v[j][q];
            lg[0] += y * w0.x; lg[1] += y * w0.y; lg[2] += y * w0.z; lg[3] += y * w0.w; lg[4] += y * w1.x; lg[5] += y * w1.y; lg[6] += y * w1.z; lg[7] += y * w1.w; } }
#pragma unroll
    for (int e = 0; e < 8; ++e) lg[e] = wave_sum(lg[e]) + rbias[e];
    i0 = 0; float v0 = lg[0];
#pragma unroll
    for (int e = 1; e < 8; ++e) if (lg[e] > v0) { v0 = lg[e]; i0 = e; }
    i1 = -1; float v1 = -3.0e38f;
#pragma unroll
    for (int e = 0; e < 8; ++e) if (e != i0 && lg[e] > v1) { v1 = lg[e]; i1 = e; }
    const float e1 = __expf(v1 - v0); g0 = 1.f / (1.f + e1); g1 = e1 / (1.f + e1);
}
struct Args { const float* in[N_IN]; float* out; unsigned char* ws; int ph_lo, ph_hi; };

__global__ void __launch_bounds__(NWAVES * 64, 2) mk_fwd(Args args) {
    extern __shared__ __attribute__((aligned(16))) unsigned char lds_raw[];
    LAS unsigned char* const lds = (LAS unsigned char*)lds_raw;
    char* const ldsg = (char*)lds_raw;
    volatile LAS unsigned* const MISC = (volatile LAS unsigned*)(lds + MISC_OFF);
    const int wave = __builtin_amdgcn_readfirstlane((int)threadIdx.x >> 6);
    const int tid = wave * 64 + lane_id();
    const int G_k = gridDim.x; const int bx_k = blockIdx.x;
    for (int u = tid; u < (LDS_BYTES - LDSCTL_OFF) / 4; u += NWAVES * 64) ((LAS unsigned*)(lds + LDSCTL_OFF))[u] = 0u;
    __syncthreads();
    volatile LAS unsigned long long* const PT = (volatile LAS unsigned long long*)(lds + PT_OFF);
    if (tid == 0) {
#pragma unroll
        for (int i = 0; i < N_IN; ++i) PT[i] = (unsigned long long)args.in[i];
        PT[N_IN] = (unsigned long long)args.out; PT[N_IN + 1] = (unsigned long long)args.ws; }
    const int lo = args.ph_lo, hi = args.ph_hi;
    __syncthreads();
#define LDP(i) ({ const unsigned long long v_ = PT[i]; (unsigned long long)(unsigned)__builtin_amdgcn_readfirstlane((int)(unsigned)v_) | ((unsigned long long)(unsigned)__builtin_amdgcn_readfirstlane((int)(unsigned)(v_ >> 32)) << 32); })
#define INP(i) ((const float*)(const GAS float*)LDP(i))
#define WSP() ((unsigned char*)(GAS unsigned char*)LDP(N_IN + 1))
#define OUTP() ((float*)(GAS float*)LDP(N_IN))
#define PH_WS() int* SLOT_TOK; float* SLOT_GATE; int* TOK_SLOT; asm volatile("" ::: "memory"); int tid = wave * 64 + lane_id(); asm volatile("" : "+v"(tid)); const int lane = tid & 63; (void)lane; \
    int G = G_k, bx = bx_k; asm volatile("" : "+s"(G), "+s"(bx));     \
    const int vcu = (G % 8 == 0) ? (bx % 8) * (G / 8) + bx / 8 : bx; const int gw = vcu * NWAVES + wave, NGW = G * NWAVES; (void)gw; (void)NGW; (void)vcu; unsigned char* const ws = WSP(); \
    bf16* const HB = (bf16*)(ws + WS_HB); float* const CS = (float*)(ws + WS_CS); float* const SN = (float*)(ws + WS_SN); float* const SSQ = (float*)(ws + WS_SSQ); bf16* const X = (bf16*)(ws + WS_X); \
    SLOT_TOK = (int*)(ws + WS_SLOTTOK); SLOT_GATE = (float*)(ws + WS_SLOTGATE); TOK_SLOT = (int*)(ws + WS_TOKSLOT); (void)HB; (void)CS; (void)SN; (void)SSQ; (void)X; (void)SLOT_TOK; (void)SLOT_GATE; (void)TOK_SLOT
    XcdBarrier bar; { unsigned char* const ws0 = WSP(); bar.bar = (unsigned*)(ws0 + WS_CTL) + CW_BAR; bar.x = 0; bar.st = nullptr;
    if (hi - lo > 1) bar = xcd_barrier_post((unsigned*)(ws0 + WS_CTL) + CW_BAR, MISC + 8, tid); }
#define IN(k) (lo <= (k) && (k) < hi)
#define SEAM(k) do { if (IN(k) && IN((k) + 1)) xcd_barrier(bar, wave * 64 + lane_id()); } while (0)
#define MOECONV(wsp_) MoeConv{INP(I_MW1), INP(I_MW3), INP(I_MW2), (const char*)OUTP(), (const char*)(wsp_), (unsigned*)((wsp_) + WS_CTL) + CW_FILL}
#define SEAMF(k) do { if (IN(k) && IN((k) + 1)) { unsigned char* const wsf_ = WSP(); const MoeConv mc_ = MOECONV(wsf_); xcd_barrier_fill(bar, wave * 64 + lane_id(), mc_, (k), lds); } } while (0)

    if (IN(0)) { PH_WS();
        LAS float* scr = (LAS float*)(lds + RING_OFF + wave * 16384);
        for (int it = gw; it < DI_LAYER; it += NGW) dense_item(it, lds, ws, scr, lane);
        for (int i = gw * 64 + lane; i < 2 * 192 * 256; i += NGW * 64) { const int l = i / (192 * 256), q = i % (192 * 256), rr = q / 256, c16 = q % 256; const int row = rr < 96 ? 1312 + rr : 1440 + (rr - 96);
            *(GAS v4u*)(ws + WS_W + l * WL_STRIDE + WL_IN + (size_t)row * (D * 2) + c16 * 16) = (v4u){0u, 0u, 0u, 0u}; }
        for (int i = gw * 64 + lane; i < LPOS * 32; i += NGW * 64) { const int pos = i >> 5, k = i & 31; const float inv = powf(10000.f, -(float)(2 * k) / 64.f); const float ang = (float)pos * inv; CS[i] = cosf(ang); SN[i] = sinf(ang); }
        for (int i = gw * 64 + lane; i < 16 * 512; i += NGW * 64) { const int hh = i >> 9, rel = (i & 511) - 256; const float bv = INP(I_RELB)[t5_bucket(rel) * 16 + hh] * LOG2E;
            ((float*)(ws + WS_TW))[i] = (rel >= -128 && rel <= 128) ? bv : att::NEG_BIG; if (rel < 0) ((float*)(ws + WS_TM))[hh * 256 + rel + 256] = bv; }
        if (gw == 0 && lane < 32) ((float*)(ws + WS_SINK))[lane] = INP(I_SINK)[lane] * LOG2E;
        { const float* eg = INP(I_EMB_G); const float* eb = INP(I_EMB_B); const float* xin = INP(I_X); const float* min_ = INP(I_META);
#define P0_LOAD(R, m) row_load_f32(R, (m) < TREAL ? xin + (size_t)(m) * D : min_ + (size_t)(((m) - TREAL) & 15) * D, lane)
#define P0_PROC(R, m) do { ln_normalize(R); ln_affine_r(R, gv, bv); row_store_bf16(R, HB + (size_t)(m) * D, lane); } while (0)
          Row8 gv, bv; row_load_f32(gv, eg, lane); row_load_f32(bv, eb, lane);
          Row8 ra{}, rb{}; int m = gw; if (m < T) P0_LOAD(ra, m);
          for (; m < T; m += 2 * NGW) { const int m1 = m + NGW, m2 = m + 2 * NGW; if (m1 < T) P0_LOAD(rb, m1); P0_PROC(ra, m); if (m1 < T) { if (m2 < T) P0_LOAD(ra, m2); P0_PROC(rb, m1); } }
#undef P0_LOAD
#undef P0_PROC
          for (int mz = T + gw; mz < TP; mz += NGW) { GAS v2u* o8 = (GAS v2u*)(HB + (size_t)mz * D) + lane;
#pragma unroll
              for (int j = 0; j < 8; ++j) o8[64 * j] = (v2u){0u, 0u}; } }
    }
    SEAM(0);

#pragma unroll 1
    for (int l = 0; l < 2; ++l) {
        const int P = 1 + 9 * l + (l ? 0 : 0);
        const int nM_all = TREAL / 256;
        const int nM_post = TREAL / 256; const bool tail_post = (l == 0);
        if (IN(P + 0)) { PH_WS();
            ProbDense pr; pr.so.init(nM_all, NIN / 256, G, bx, true); pr.A = (const char*)HB; pr.Bt = (const char*)(ws + WS_W + l * WL_STRIDE + WL_IN); pr.tstep = 256 * (size_t)D * 2;
            epi::EpiWin E{(bf16*)(ws + WS_CQ), (bf16*)(ws + WS_CKV), (bf16*)(ws + WS_KR), (bf16*)(ws + WS_QB), (bf16*)(ws + WS_KB), (bf16*)(ws + WS_VB), (bf16*)(ws + WS_GR), (bf16*)(ws + WS_GBB), SSQ, CS, SN};
            pg8::gemm_phase<epi::EpiWin, ProbDense>(lds + RING_OFF, D, pr, E, tid);
        }
        SEAMF(P + 0);
        if (IN(P + 1)) { PH_WS();
            { ProbDense pr; pr.so.init(nM_all, 3072 / 256, G, bx, true); pr.A = (const char*)(ws + WS_CQ); pr.Bt = (const char*)(ws + WS_W + l * WL_STRIDE + WL_UQ); pr.tstep = 256 * (size_t)QRANK * 2;
              epi::EpiUq E{(bf16*)(ws + WS_Q), SSQ, CS, SN};
              pg8::gemm_phase<epi::EpiUq, ProbDense>(lds + RING_OFF, QRANK, pr, E, tid); }
            { ProbDense pr; pr.so.init(nM_all, 4096 / 256, G, bx, true); pr.A = (const char*)(ws + WS_CKV); pr.Bt = (const char*)(ws + WS_W + l * WL_STRIDE + WL_UKV); pr.tstep = 256 * (size_t)KVRANK * 2;
              epi::EpiUkv E{(bf16*)(ws + WS_KN), (bf16*)(ws + WS_V), SSQ};
              pg8::gemm_phase<epi::EpiUkv, ProbDense>(lds + RING_OFF, KVRANK, pr, E, tid); }
        }
        SEAMF(P + 1);
        if (IN(P + 2)) { PH_WS();
            const int nmla_full = NB * NH * 16, nmeta = l == 0 ? NB * NH : 0, nj = l == 0 ? 65 : 64, nswa = NB * 4 * nj, ndyn = nmeta + nswa;
            unsigned* const actr = (unsigned*)(ws + WS_CTL) + CW_ATT + l;
            int tables_hk = -1, ustat = vcu;
            unsigned nxt = 0u;
_Pragma("unroll 1")
            for (;;) {
                int kind, b, h, qj;
                if (ustat < nmla_full) { kind = 0; qj = ustat & 15; h = (ustat >> 4) & 15; b = ustat >> 8; ustat += G;
                    if (ustat >= nmla_full && tid == 0) nxt = xb_add(actr, 1u); }
                else {
                    __syncthreads(); if (tid == 0) MISC[11] = nxt; __syncthreads();
                    const int it = __builtin_amdgcn_readfirstlane((int)MISC[11]);
                    if (it >= ndyn) break;
                    if (it < nmeta) { kind = 0; b = it >> 4; h = it & 15; qj = 16; }
                    else { kind = 1; const int v = it - nmeta, per_hk = NB * nj; h = v / per_hk; const int r = v - h * per_hk; b = r / nj; qj = r - b * nj; }
                }
                asm volatile("" : "+s"(kind), "+s"(b), "+s"(h), "+s"(qj));
                if (kind == 0) att::mla_unit4((att::lds_ptr)(lds + RING_OFF), (const bf16*)(ws + WS_Q), (const bf16*)(ws + WS_KN), (const bf16*)(ws + WS_KR), (const bf16*)(ws + WS_V), (bf16*)(ws + WS_OAB), b, h, qj, tid);
                else att::swa_unit2((att::lds_ptr)(lds + RING_OFF), (const bf16*)(ws + WS_QB), (const bf16*)(ws + WS_KB), (const bf16*)(ws + WS_VB), (bf16*)(ws + WS_OAB), (const float*)(ws + WS_TW), (const float*)(ws + WS_TM), (const float*)(ws + WS_SINK) + 16 * l, b, h, qj, tables_hk, tid);
                if (ustat >= nmla_full && !(kind == 0 && qj < 16) && tid == 0) nxt = xb_add(actr, 1u);
            }
        }
        SEAMF(P + 2);
        if (IN(P + 3)) { PH_WS();
            ProbDense pr; pr.so.init(nM_post, D / 256, G, bx, tail_post); pr.A = (const char*)(ws + WS_OAB); pr.Bt = (const char*)(ws + WS_W + l * WL_STRIDE + WL_AB); pr.tstep = 256 * (size_t)(2 * D) * 2;
            epi::EpiProj E{(bf16*)(ws + WS_MG), (const bf16*)(ws + WS_GR), (const bf16*)(ws + WS_GBB)};
            pg8::gemm_phase<epi::EpiProj, ProbDense>(lds + RING_OFF, 2 * D, pr, E, tid);
        }
        SEAMF(P + 3);
        if (IN(P + 4)) { PH_WS();
            ProbDense pr; pr.so.init(nM_post, D / 256, G, bx, tail_post, 2); pr.A = (const char*)(ws + WS_MG); pr.Bt = (const char*)(ws + WS_W + l * WL_STRIDE + WL_OUT); pr.tstep = 256 * (size_t)D * 2;
            epi::EpiResid E{X, HB, (bf16*)(ws + WS_XP)};
            pg8::gemm_phase<epi::EpiResid, ProbDense>(lds + RING_OFF, D, pr, E, tid);
        }
        SEAMF(P + 4);
        if (IN(P + 5)) { PH_WS();
            if (l == 0) {
                LAS float* scr = (LAS float*)(lds + RING_OFF + wave * 16384); unsigned* const dctr = (unsigned*)(ws + WS_CTL) + CW_FILL + 4;
_Pragma("unroll 1")
                for (;;) {
                    __syncthreads(); if (tid == 0) MISC[11] = xb_add(dctr, 8u); __syncthreads();
                    const unsigned base = MISC[11];
                    if (base >= (unsigned)DI_DEFER) break;
                    dense_item(DI_LAYER + (int)base + wave, lds, ws, scr, lane);
                }
                asm volatile("s_waitcnt vmcnt(0)" ::: "memory"); __syncthreads();
            }
            const float* g = INP(I_LMG) + l * D; const float* bta = INP(I_LMB) + l * D;
            const int nrows = l == 0 ? T : TREAL;
            int h0 = 0, h1 = 0, h2 = 0, h3 = 0, h4 = 0, h5 = 0, h6 = 0, h7 = 0;
            LAS f32x4* const rwl = (LAS f32x4*)(lds + RING_OFF);
            if (l == 1) { const GAS f32x4* rwg = (const GAS f32x4*)INP(I_RW); for (int i = tid; i < D * 2; i += NWAVES * 64) { const int k = i >> 1, hf = i & 1, e = k & 7, jq = (2 * (k >> 9) + (e >> 2)) * 4 + (e & 3); rwl[hf * 2048 + jq * 64 + ((k >> 3) & 63)] = rwg[i]; } __syncthreads(); }
#define LM_PROC(r, m) do { if (l == 0 && (m) >= TREAL) meta_partials(r, (const bf16*)(ws + WS_XP), (m) - TREAL, lane); ln_normalize(r); ln_affine_r(r, gv, bv); row_store_bf16(r, HB + (size_t)(m) * D, lane); \
                if (l == 1) { int i0_, i1_; float g0_, g1_; router_row(r, rwl, rbias, lane, i0_, i1_, g0_, g1_); \
                    if (lane == 0) { int* ti = (int*)(ws + WS_TOPI); float* tg = (float*)(ws + WS_TOPG); ti[2 * (m)] = i0_; ti[2 * (m) + 1] = i1_; tg[2 * (m)] = g0_; tg[2 * (m) + 1] = g1_; } \
                    h0 += (i0_ == 0) + (i1_ == 0); h1 += (i0_ == 1) + (i1_ == 1); h2 += (i0_ == 2) + (i1_ == 2); h3 += (i0_ == 3) + (i1_ == 3); \
                    h4 += (i0_ == 4) + (i1_ == 4); h5 += (i0_ == 5) + (i1_ == 5); h6 += (i0_ == 6) + (i1_ == 6); h7 += (i0_ == 7) + (i1_ == 7); } } while (0)
            { const float* rbias = INP(I_RB); Row8 gv, bv; row_load_f32(gv, g, lane); row_load_f32(bv, bta, lane); Row8 ra{}, rb{}; int m = gw; if (m < nrows) row_load_bf16(ra, X + (size_t)m * D, lane);
              for (; m < nrows; m += 2 * NGW) { const int m1 = m + NGW, m2 = m + 2 * NGW; if (m1 < nrows) row_load_bf16(rb, X + (size_t)m1 * D, lane); LM_PROC(ra, m);
                  if (m1 < nrows) { if (m2 < nrows) row_load_bf16(ra, X + (size_t)m2 * D, lane); LM_PROC(rb, m1); } } }
#undef LM_PROC
            if (l == 1 && lane == 0) { int* wh = (int*)(ws + WS_WHIST) + gw * 8; wh[0] = h0; wh[1] = h1; wh[2] = h2; wh[3] = h3; wh[4] = h4; wh[5] = h5; wh[6] = h6; wh[7] = h7; }
        }
        if (l == 0) SEAM(P + 5); else SEAMF(P + 5);
        if (l == 0) {
            if (IN(P + 6)) { PH_WS();
                ProbDense pr; pr.so.init(nM_all, 2 * DFF / 256, G, bx, true); pr.A = (const char*)HB; pr.Bt = (const char*)(ws + WS_WF13); pr.tstep = 256 * (size_t)D * 2;
                epi::EpiSwiglu E{(bf16*)(ws + WS_ACT)};
                pg8::gemm_phase<epi::EpiSwiglu, ProbDense>(lds + RING_OFF, D, pr, E, tid);
            }
            SEAMF(P + 6);
            if (IN(P + 7)) { PH_WS();
                ProbDense pr; pr.so.init(nM_all, D / 256, G, bx, true, 2); pr.A = (const char*)(ws + WS_ACT); pr.Bt = (const char*)(ws + WS_WF2); pr.tstep = 256 * (size_t)DFF * 2;
                epi::EpiResid E{X, HB, (bf16*)(ws + WS_XP)};
                pg8::gemm_phase<epi::EpiResid, ProbDense>(lds + RING_OFF, DFF, pr, E, tid);
            }
            SEAMF(P + 7);
            if (IN(P + 8)) { PH_WS();
                const float* g = INP(I_LFG); const float* bta = INP(I_LFB);
#define LF_PROC(r, m) do { if ((m) >= TREAL) meta_partials(r, (const bf16*)(ws + WS_XP), (m) - TREAL, lane); ln_normalize(r); ln_affine_r(r, gv, bv); row_store_bf16(r, HB + (size_t)(m) * D, lane); } while (0)
                { Row8 gv, bv; row_load_f32(gv, g, lane); row_load_f32(bv, bta, lane); Row8 ra{}, rb{}; int m = gw; if (m < T) row_load_bf16(ra, X + (size_t)m * D, lane);
                  for (; m < T; m += 2 * NGW) { const int m1 = m + NGW, m2 = m + 2 * NGW; if (m1 < T) row_load_bf16(rb, X + (size_t)m1 * D, lane); LF_PROC(ra, m);
                      if (m1 < T) { if (m2 < T) row_load_bf16(ra, X + (size_t)m2 * D, lane); LF_PROC(rb, m1); } } }
#undef LF_PROC
            }
            SEAM(P + 8);
        } else {
            if (IN(P + 6)) { PH_WS();
                LAS int* hist = (LAS int*)(lds + RING_OFF);
                LAS int* segsum = hist + 2048 * 8;
                LAS int* segpre = segsum + 64 * 8;
                LAS int* tot = segpre + 64 * 8;
                const int* wh = (const int*)(ws + WS_WHIST);
                for (int i = tid; i < NGW * 8; i += NWAVES * 64) hist[i] = wh[i];
                __syncthreads();
                { const int e = tid & 7, seg = tid >> 3; int s = 0;
_Pragma("unroll 1")
                  for (int w = 0; w < 32; ++w) { const int ww = seg * 32 + w; if (ww < NGW) s += hist[ww * 8 + e]; } segsum[seg * 8 + e] = s; }
                __syncthreads();
                if (tid < 8) { int run = 0;
_Pragma("unroll 1")
                    for (int s = 0; s < 64; ++s) { segpre[s * 8 + tid] = run; run += segsum[s * 8 + tid]; } tot[tid] = run; }
                __syncthreads();
                if (tid == 0) { int ts = 0; for (int e = 0; e < 8; ++e) { tot[8 + e] = ts; ts += (tot[e] + 255) >> 8; } tot[16] = ts;
                    if (bx == 0) for (int e = 0; e < 9; ++e) ((int*)(ws + WS_CTL))[CW_MOE_TS + e] = tot[8 + e]; }
                __syncthreads();
                int base = 0;
                if (lane < 8) { base = tot[8 + lane] * 256 + segpre[(gw >> 5) * 8 + lane];
_Pragma("unroll 1")
                    for (int w = (gw & ~31); w < gw; ++w) base += hist[w * 8 + lane]; }
                const int* ti = (const int*)(ws + WS_TOPI); const float* tg = (const float*)(ws + WS_TOPG);
                for (int i0 = 0; gw + i0 * NGW < TREAL; i0 += 16) {
                    const int m = gw + (i0 + (lane >> 1)) * NGW, kk = lane & 1; const bool valid = lane < 32 && m < TREAL;
                    const int e = valid ? ti[2 * m + kk] : 8; const float gt = valid ? tg[2 * m + kk] : 0.f;
                    int myslot = 0;
#pragma unroll
                    for (int e2 = 0; e2 < 8; ++e2) { const unsigned long long mask = __ballot(e == e2); const int b_e = __builtin_amdgcn_readlane(base, e2);
                        if (e == e2) myslot = b_e + __popcll(mask & ((1ull << lane) - 1ull)); if (lane == e2) base += __popcll(mask); }
                    if (valid) { SLOT_TOK[myslot] = m; SLOT_GATE[myslot] = gt; TOK_SLOT[2 * m + kk] = myslot; }
                }
                if (vcu < 8) { const int e = vcu; const int s0 = tot[8 + e] * 256 + tot[e], s1 = tot[8 + e + 1] * 256; for (int s = s0 + tid; s < s1; s += NWAVES * 64) { SLOT_TOK[s] = T; SLOT_GATE[s] = 0.f; } }
                __syncthreads();
                { LAS float* scr = (LAS float*)(lds + RING_OFF + wave * 16384);
                  const MoeConv mc = MOECONV(ws);
                  unsigned nxt = 0u, lmask = 16u; if (tid == 0) nxt = moe_claim(mc, 32u, 99, lmask);
_Pragma("unroll 1")
                  for (;;) {
                      __syncthreads();
                      if (tid == 0) MISC[11] = nxt;
                      __syncthreads();
                      const unsigned base = MISC[11];
                      if (base >= (unsigned)MC_NIT) break;
                      if (tid == 0) nxt = moe_claim(mc, 32u, 99, lmask);
                      moe_conv_run<4>(mc, (int)base, wave, lane, scr);
                  } }
            }
            SEAM(P + 6);
            MoeTiles mt;
            if (IN(P + 7) || IN(P + 8)) { unsigned char* const ws = WSP();
#pragma unroll
                for (int e = 0; e < 9; ++e) mt.ts[e] = __builtin_amdgcn_readfirstlane(((const int*)(ws + WS_CTL))[CW_MOE_TS + e]);
            } else {
#pragma unroll
                for (int e = 0; e < 9; ++e) mt.ts[e] = 0;
            }
            if (IN(P + 7)) { PH_WS();
                ProbMoe1 pr; pr.so.init(mt.ts[8], 2 * DFF / 256, G, bx); pr.HBp = (const char*)HB; pr.slot_tok = SLOT_TOK; pr.outp = (const char*)OUTP(); pr.wsb = (const char*)ws; pr.mt = mt;
                epi::EpiSwiglu E{(bf16*)(ws + WS_MACT)};
                pg8::gemm_phase<epi::EpiSwiglu, ProbMoe1, true>(lds + RING_OFF, D, pr, E, tid);
            }
            SEAM(P + 7);
            if (IN(P + 8)) { PH_WS();
                ProbMoe2 pr; pr.so.init(MOE_MAIN_TILES, D / 256, G, bx); pr.extra = mt.ts[8] - MOE_MAIN_TILES; pr.ACTp = (const char*)(ws + WS_MACT); pr.outp = (const char*)OUTP(); pr.wsb = (const char*)ws; pr.mt = mt;
                epi::EpiMoeDown E{(bf16*)(ws + WS_Y), SLOT_GATE, (bf16*)(ws + WS_YP)};
                pg8::gemm_phase<epi::EpiMoeDown, ProbMoe2>(lds + RING_OFF, DFF, pr, E, tid);
            }
            SEAM(P + 8);
            if (IN(P + 9)) { PH_WS();
                const float* g = INP(I_LFG) + D; const float* bta = INP(I_LFB) + D; const bf16* Y = (const bf16*)(ws + WS_Y);
#define FL_LOAD(R, m, F) do { const int s0_ = TOK_SLOT[2 * (m)], s1_ = TOK_SLOT[2 * (m) + 1]; F = (s0_ >= MOE_MAIN_TILES * 256 ? 1 : 0) | (s1_ >= MOE_MAIN_TILES * 256 ? 2 : 0); \
                    _Pragma("unroll") for (int jj = 0; jj < 4; ++jj) { f32x4 h0, h1, a0, a1, b0, b1; bf8(*((const GAS v4u*)(HB + (size_t)(m) * D) + lane + 64 * jj), h0, h1); \
                        bf8(*((const GAS v4u*)(Y + (size_t)s0_ * D) + lane + 64 * jj), a0, a1); bf8(*((const GAS v4u*)(Y + (size_t)s1_ * D) + lane + 64 * jj), b0, b1); \
                        R.v[2 * jj] = (h0 * ALPHA + a0) + b0; R.v[2 * jj + 1] = (h1 * ALPHA + a1) + b1; } } while (0)
#define FL_PROC(R, m, F) do { if (__builtin_amdgcn_readfirstlane(F)) {                           \
                        _Pragma("unroll 1") for (int k_ = 0; k_ < 2; ++k_) { const int s_ = __builtin_amdgcn_readfirstlane(TOK_SLOT[2 * (m) + k_]); if (s_ >= MOE_MAIN_TILES * 256) meta_partials_n(R, YP, 2048, s_ - MOE_MAIN_TILES * 256, lane); } } \
                    ln_normalize(R); ln_affine_r(R, gv, bv); row_store_f32(R, outp + (size_t)(m) * D, lane); } while (0)
                { float* const outp = OUTP(); const bf16* YP = (const bf16*)(ws + WS_YP); Row8 gv, bv; row_load_f32(gv, g, lane); row_load_f32(bv, bta, lane); Row8 ra{}, rb{}; int fa = 0, fb = 0; int m = gw; if (m < TREAL) FL_LOAD(ra, m, fa);
                  for (; m < TREAL; m += 2 * NGW) { const int m1 = m + NGW, m2 = m + 2 * NGW; if (m1 < TREAL) FL_LOAD(rb, m1, fb); FL_PROC(ra, m, fa);
                      if (m1 < TREAL) { if (m2 < TREAL) FL_LOAD(ra, m2, fa); FL_PROC(rb, m1, fb); } } }
#undef FL_LOAD
#undef FL_PROC
            }
        }
    }
#undef IN
#undef SEAM
}

#ifndef MK_ONE_LAUNCH
#define MK_ONE_LAUNCH 0
#endif
extern "C" void kernel_launch(void* const* d_in, const int* in_sizes, int n_in, void* d_out, int out_size, void* d_ws, size_t ws_size, hipStream_t stream) {
    static int grid = 0;
    if (grid == 0) {
        if (n_in != N_IN || in_sizes[0] != NB * SEQ * D || out_size != NB * SEQ * D || ws_size < WS_END) { fprintf(stderr, "kernel_launch: shape mismatch: n_in %d in0 %d out %d ws %zu (need %zu)\n", n_in, n_in > 0 ? in_sizes[0] : -1, out_size, ws_size, (size_t)WS_END); grid = -1; return; }
        int dev = 0, cus = 0, per_cu = 0;
        if (hipGetDevice(&dev) != hipSuccess || hipDeviceGetAttribute(&cus, hipDeviceAttributeMultiprocessorCount, dev) != hipSuccess) { fprintf(stderr, "kernel_launch: device query failed\n"); grid = -1; return; }
        if (hipFuncSetAttribute((const void*)mk_fwd, hipFuncAttributeMaxDynamicSharedMemorySize, LDS_BYTES) != hipSuccess) { fprintf(stderr, "kernel_launch: hipFuncSetAttribute failed\n"); grid = -1; return; }
        if (hipOccupancyMaxActiveBlocksPerMultiprocessor(&per_cu, (const void*)mk_fwd, NWAVES * 64, LDS_BYTES) != hipSuccess || per_cu < 1) fprintf(stderr, "kernel_launch: occupancy query reports %d\n", per_cu);
        (void)hipGetLastError();
        grid = cus;
    }
    if (grid < 0) return;
    if (hipMemsetAsync((char*)d_ws + WS_CTL, 0, CTL_ZERO_BYTES, stream) != hipSuccess) { fprintf(stderr, "kernel_launch: memset failed\n"); return; }
    Args a{};
    for (int i = 0; i < N_IN; ++i) a.in[i] = (const float*)d_in[i];
    a.out = (float*)d_out; a.ws = (unsigned char*)d_ws;
#if MK_ONE_LAUNCH
    a.ph_lo = 0; a.ph_hi = N_PHASES;
    hipLaunchKernelGGL(mk_fwd, dim3(grid), dim3(NWAVES * 64), LDS_BYTES, stream, a);
#else
    for (int p = 0; p < N_PHASES; ++p) { a.ph_lo = p; a.ph_hi = p + 1; hipLaunchKernelGGL(mk_fwd, dim3(grid), dim3(NWAVES * 64), LDS_BYTES, stream, a); }
#endif
    const hipError_t le = hipPeekAtLastError();
    if (le != hipSuccess) fprintf(stderr, "kernel_launch: launch failed: %s\n", hipGetErrorName(le));
}
```

```cpp
#define MK_ONE_LAUNCH 1
#include <hip/hip_runtime.h>
#include <cstdio>
#include <cstdint>
#include <type_traits>
namespace pg8 {
#define PG8_LAS __attribute__((address_space(3)))
typedef unsigned short bf16_t;
typedef short bf16x8 __attribute__((ext_vector_type(8)));
typedef float f32x4 __attribute__((ext_vector_type(4)));
typedef float f32x2 __attribute__((ext_vector_type(2)));
typedef unsigned u32x4 __attribute__((ext_vector_type(4)));
typedef unsigned u32x2 __attribute__((ext_vector_type(2)));
constexpr int BM = 256, BK = 64, HALF = 128, HTB = HALF * BK * 2  , STAGE_BYTES = 8 * HTB, NXCD = 8, WGM = 8;

__host__ __device__ __forceinline__ int lds_byte(int r, int c) { const int st = (r >> 4) * 2 + (c >> 5), rr = r & 15, cc = c & 31, ob = rr * 64 + cc * 2; return st * 1024 + (ob ^ (((ob >> 9) & 1) << 5)); }
__host__ __device__ __forceinline__ void stage_rc(int b, int& R, int& C) { const int st = b / 1024, sb = b % 1024, swz = sb ^ (((sb >> 9) & 1) << 5); R = (st >> 1) * 16 + swz / 64; C = (st & 1) * 32 + (swz % 64) / 2; }
__host__ __device__ __forceinline__ int perm32(int rho) { const int n = rho >> 4, i = rho & 15; return 8 * (i >> 2) + 4 * n + (i & 3); }

struct Unit { int pm, pn, ks; };

struct StaticOrder {
    int nM, nN, nwg, G, c, ntail, kshift;
    __device__ __forceinline__ void init(int nM_, int nN_, int G_, int c_, bool tail = false, int kshift_ = 0) { nM = nM_; nN = nN_; nwg = nM * nN; G = G_; c = c_; kshift = kshift_; ntail = tail ? (nN_ << kshift_) : 0; }
    __device__ __forceinline__ bool next(int i, Unit& u) const {
        const long L = (long)i * G + c; if (L >= nwg + ntail) return false;
        u.ks = -1;
        if (L >= nwg) { const int t = (int)(L - nwg); u.pm = nM; u.pn = t >> kshift; if (kshift) u.ks = t & ((1 << kshift) - 1); return true; }
        int wgid = (int)L; { const int q = nwg / NXCD, r = nwg % NXCD, xcd = wgid % NXCD, off = wgid / NXCD; wgid = (xcd < r ? xcd * (q + 1) : r * (q + 1) + (xcd - r) * q) + off; }
        const int nig = WGM * nN, gid = wgid / nig, fm = gid * WGM, gsz = (nM - fm) < WGM ? (nM - fm) : WGM;
        u.pm = fm + ((wgid % nig) % gsz); u.pn = (wgid % nig) / gsz; return true;
    }
    __device__ __forceinline__ bool is_half(const Unit& u) const { return ntail != 0 && u.pm == nM; }
};
typedef __bf16 bf16x2_t __attribute__((ext_vector_type(2)));
__device__ __forceinline__ unsigned cvt_pk_bf16(float lo, float hi) { const f32x2 v = {lo, hi}; const bf16x2_t b = __builtin_convertvector(v, bf16x2_t); return __builtin_bit_cast(unsigned, b); }
__device__ __forceinline__ float bf_lo(unsigned w) { return __uint_as_float(w << 16); }
__device__ __forceinline__ float bf_hi(unsigned w) { return __uint_as_float(w & 0xffff0000u); }

template <class Epi, class Prob, bool GATHER = false>
__device__ __forceinline__ void gemm_phase(PG8_LAS unsigned char* lds, const int K, const Prob& S, const Epi& E, const int tid_in) {
    int tid_ = tid_in; asm volatile("" : "+v"(tid_));
    const int tid = tid_, wid = __builtin_amdgcn_readfirstlane(tid >> 6), lane = tid & 63, wr = wid >> 2, wc = wid & 3, fr = lane & 15, fq = lane >> 4;
    const int nt_full = K / BK;
    int sR[2], sC[2];
    unsigned voffA[2][2], nvoffA[2][2], voffB[2]; int ntok[2][2] = {{0, 0}, {0, 0}};
#pragma unroll
    for (int i = 0; i < 2; ++i) { int R, C; stage_rc(tid * 16 + i * 8192, R, C); sR[i] = R; sC[i] = C; const int Rb = (R & ~31) + perm32(R & 31);
        voffB[i] = (unsigned)(Rb * K + C) * 2u;
        voffA[0][i] = (unsigned)(R * K + C) * 2u; voffA[1][i] = (unsigned)((R + HALF) * K + C) * 2u; nvoffA[0][i] = voffA[0][i]; nvoffA[1][i] = voffA[1][i]; }
    const size_t kstep = (size_t)(BK * 2);
    const size_t hstep = (size_t)HALF * K * 2;
    const unsigned ldsw = (unsigned)wid * 1024u;
    const int aoff = lds_byte(wr * 64 + fr, fq * 8), boff = lds_byte(wc * 32 + fr, fq * 8);
#define PG8_SA(b, h) (((b) * 2 + (h)) * HTB)
#define PG8_SB(b, h) ((4 + (b) * 2 + (h)) * HTB)
#define PG8_STAGE(bufoff, gbase, voff) do { _Pragma("unroll") for (int _i = 0; _i < 2; ++_i) \
        __builtin_amdgcn_global_load_lds((const unsigned*)((const char*)(gbase) + (voff)[_i]), (PG8_LAS unsigned*)(lds + (bufoff) + ldsw + _i * 8192), 16, 0, 0); } while (0)
#define PG8_LDA(dst, b, h) do { _Pragma("unroll") for (int m = 0; m < 4; ++m) _Pragma("unroll") for (int k = 0; k < 2; ++k) dst[m][k] = *(const PG8_LAS bf16x8*)(lds + PG8_SA(b, h) + aoff + m * 2048 + k * 1024); } while (0)
#define PG8_LDB(dst, b, h) do { _Pragma("unroll") for (int n = 0; n < 2; ++n) _Pragma("unroll") for (int k = 0; k < 2; ++k) dst[n][k] = *(const PG8_LAS bf16x8*)(lds + PG8_SB(b, h) + boff + n * 2048 + k * 1024); } while (0)
#define PG8_MMA(ai, bj, At, Bt) do { __builtin_amdgcn_s_setprio(1); _Pragma("unroll") for (int m = 0; m < 4; ++m) _Pragma("unroll") for (int n = 0; n < 2; ++n) _Pragma("unroll") for (int k = 0; k < 2; ++k) \
        acc[ai][bj][m][n] = __builtin_amdgcn_mfma_f32_16x16x32_bf16(Bt[n][k], At[m][k], acc[ai][bj][m][n], 0, 0, 0); __builtin_amdgcn_s_setprio(0); } while (0)
#define PG8_WAIT_V(n) asm volatile("s_waitcnt vmcnt(" #n ")" ::: "memory")
#define PG8_WAIT_L(n) asm volatile("s_waitcnt lgkmcnt(" #n ")" ::: "memory")
#define PG8_BAR __builtin_amdgcn_s_barrier()
#define PG8_SCHED __builtin_amdgcn_sched_barrier(0)
    Unit cur, nxt; int ui = 0;
    if (!S.next(0, cur)) return;
    f32x4 acc[2][2][4][2];
#pragma unroll
    for (int a = 0; a < 2; ++a)
#pragma unroll
        for (int b = 0; b < 2; ++b)
#pragma unroll
            for (int m = 0; m < 4; ++m)
#pragma unroll
                for (int n = 0; n < 2; ++n) acc[a][b][m][n] = (f32x4){0.f, 0.f, 0.f, 0.f};
    bf16x8 At[4][2], B0[2][2], B1[2][2];
    const char* cA = S.a_base(cur); const char* cB = S.b_base(cur);
    if constexpr (GATHER) {
#pragma unroll
        for (int h = 0; h < 2; ++h)
#pragma unroll
            for (int i = 0; i < 2; ++i) { voffA[h][i] = (unsigned)(S.a_row(cur, sR[i] + h * HALF) * K + sC[i]) * 2u; nvoffA[h][i] = voffA[h][i]; }
    }
    PG8_STAGE(PG8_SB(0, 0), cB, voffB); PG8_STAGE(PG8_SB(0, 1), cB + hstep, voffB); PG8_STAGE(PG8_SA(0, 0), cA, voffA[0]); PG8_STAGE(PG8_SA(0, 1), cA, voffA[1]);
    if (wr == 1) PG8_BAR;
    PG8_WAIT_V(2); PG8_BAR;
    PG8_STAGE(PG8_SB(1, 0), cB + kstep, voffB); PG8_STAGE(PG8_SA(1, 0), cA + kstep, voffA[0]); PG8_STAGE(PG8_SB(1, 1), cB + hstep + kstep, voffB);
    PG8_WAIT_V(6); PG8_BAR;
    for (;;) {
        const bool has_next = S.next(ui + 1, nxt);
        const bool half = S.is_half(cur);
        const int nt = S.nt(cur, nt_full);
        const char* nA = has_next ? S.a_base(nxt) : cA; const char* nB = has_next ? S.b_base(nxt) : cB;
        if constexpr (GATHER) { if (has_next) {
#pragma unroll
            for (int h = 0; h < 2; ++h)
#pragma unroll
                for (int i = 0; i < 2; ++i) ntok[h][i] = S.a_row(nxt, sR[i] + h * HALF); } }
        for (int t = 0; t < nt; t += 2) {
            const bool last = (t == nt - 2);
            if constexpr (Epi::MID) { if (t == (nt >> 1)) E.mid(acc, cur, wr, wc, fr, fq); }
            const char* a1 = cA + (size_t)(t + 1) * kstep;
            const char* a2 = last ? nA : cA + (size_t)(t + 2) * kstep; const char* b2 = last ? nB : cB + (size_t)(t + 2) * kstep;
            const char* a3 = a2 + kstep; const char* b3 = b2 + kstep;
            unsigned vA2[2][2];
#pragma unroll
            for (int h = 0; h < 2; ++h)
#pragma unroll
                for (int i = 0; i < 2; ++i) vA2[h][i] = voffA[h][i];
            if constexpr (GATHER) { if (last) {
                asm volatile("" : "+v"(ntok[0][0]), "+v"(ntok[0][1]), "+v"(ntok[1][0]), "+v"(ntok[1][1]));
                if (has_next) {
#pragma unroll
                    for (int h = 0; h < 2; ++h)
#pragma unroll
                        for (int i = 0; i < 2; ++i) nvoffA[h][i] = (unsigned)(ntok[h][i] * K + sC[i]) * 2u; }
                vA2[0][0] = nvoffA[0][0]; vA2[0][1] = nvoffA[0][1]; vA2[1][0] = nvoffA[1][0]; vA2[1][1] = nvoffA[1][1]; } }
            PG8_LDB(B0, 0, 0); PG8_LDB(B1, 0, 1); PG8_SCHED; PG8_LDA(At, 0, 0); PG8_STAGE(PG8_SA(1, 1), a1, voffA[1]);
            PG8_WAIT_V(8); PG8_WAIT_L(0); PG8_BAR; PG8_MMA(0, 0, At, B0); PG8_MMA(0, 1, At, B1); PG8_BAR; PG8_SCHED;
            if (!half) PG8_LDA(At, 0, 1); PG8_STAGE(PG8_SB(0, 0), b2, voffB); PG8_STAGE(PG8_SB(0, 1), b2 + hstep, voffB); PG8_STAGE(PG8_SA(0, 0), a2, vA2[0]);
            PG8_WAIT_V(8); PG8_WAIT_L(0); PG8_BAR; if (!half) { PG8_MMA(1, 0, At, B0); PG8_MMA(1, 1, At, B1); } PG8_BAR; PG8_SCHED;
            PG8_LDB(B0, 1, 0); PG8_LDB(B1, 1, 1); PG8_SCHED; PG8_LDA(At, 1, 0); PG8_STAGE(PG8_SA(0, 1), a2, vA2[1]);
            PG8_WAIT_V(8); PG8_WAIT_L(0); PG8_BAR; PG8_MMA(0, 0, At, B0); PG8_MMA(0, 1, At, B1); PG8_BAR; PG8_SCHED;
            if (!half) PG8_LDA(At, 1, 1); PG8_STAGE(PG8_SB(1, 0), b3, voffB); PG8_STAGE(PG8_SB(1, 1), b3 + hstep, voffB); PG8_STAGE(PG8_SA(1, 0), a3, vA2[0]);
            PG8_WAIT_V(8); PG8_WAIT_L(0); PG8_BAR; if (!half) { PG8_MMA(1, 0, At, B0); PG8_MMA(1, 1, At, B1); } PG8_BAR; PG8_SCHED;
        }
        if (wr == 0) PG8_BAR;
        E(acc, cur, wr, wc, fr, fq);
        if (!has_next) break;
#pragma unroll
        for (int a = 0; a < 2; ++a)
#pragma unroll
            for (int b = 0; b < 2; ++b)
#pragma unroll
                for (int m = 0; m < 4; ++m)
#pragma unroll
                    for (int n = 0; n < 2; ++n) acc[a][b][m][n] = (f32x4){0.f, 0.f, 0.f, 0.f};
        cur = nxt; cA = nA; cB = nB; ++ui;
        if constexpr (GATHER) {
#pragma unroll
            for (int h = 0; h < 2; ++h)
#pragma unroll
                for (int i = 0; i < 2; ++i) voffA[h][i] = nvoffA[h][i]; }
        if (wr == 1) PG8_BAR;
    }
    PG8_WAIT_V(0);
    PG8_BAR;
#undef PG8_SA
#undef PG8_SB
#undef PG8_STAGE
#undef PG8_LDA
#undef PG8_LDB
#undef PG8_MMA
#undef PG8_WAIT_V
#undef PG8_WAIT_L
#undef PG8_BAR
#undef PG8_SCHED
}
}
constexpr int D = 2048, NB = 8, SEQ = 4096, NMETA = 16, NH = 16;
constexpr int TREAL = NB * SEQ;
constexpr int T = TREAL + NB * NMETA;
constexpr int TP = 33024;
constexpr int LPOS = SEQ + NMETA;
constexpr int QRANK = 768, KVRANK = 512, DFF = 5632, NE = 8;
constexpr int NIN = 8704;
constexpr int INDIM = 8512;
constexpr float LN_EPS = 1e-5f, RMS_EPS = 1e-6f, ALPHA = 1.4142135623730951f;
constexpr float LOG2E = 1.4426950408889634f;
constexpr float QK_SCALE_MLA = 0.07216878364870322f * LOG2E;
constexpr float QK_SCALE_SWA = 0.08838834764831845f * LOG2E;

__device__ __forceinline__ int row_pos(int row) { return row < TREAL ? NMETA + (row & (SEQ - 1)) : ((row - TREAL) & (NMETA - 1)); }

struct ProbDense {
    pg8::StaticOrder so; const char* A; const char* Bt; size_t tstep;
    __device__ __forceinline__ bool next(int i, pg8::Unit& u) const { return so.next(i, u); }
    __device__ __forceinline__ size_t koff(const pg8::Unit& u) const { return u.ks < 0 ? (size_t)0 : (size_t)u.ks * ((tstep >> 8) >> so.kshift); }
    __device__ __forceinline__ const char* a_base(const pg8::Unit& u) const { return A + (size_t)u.pm * tstep + koff(u); }
    __device__ __forceinline__ const char* b_base(const pg8::Unit& u) const { return Bt + (size_t)u.pn * tstep + koff(u); }
    __device__ __forceinline__ int a_row(const pg8::Unit&, int) const { return 0; }
    __device__ __forceinline__ bool is_half(const pg8::Unit& u) const { return so.is_half(u); }
    __device__ __forceinline__ int nt(const pg8::Unit& u, int ntf) const { return u.ks < 0 ? ntf : (ntf >> so.kshift); }
};
struct MoeTiles { int ts[9]; };
__device__ __forceinline__ int moe_expert(const MoeTiles& mt, int pm) { int e = 0;
#pragma unroll
    for (int k = 1; k < 8; ++k) e += (pm >= mt.ts[k]) ? 1 : 0; return e; }
constexpr size_t MW_MiB = 1u << 20, MW_B = 1583 * MW_MiB, MW_E = 66 * MW_MiB, MW_E5 = 138 * MW_MiB, MW_E6 = 271 * MW_MiB, MW_E7A = 1067 * MW_MiB, MW_E7B = 205 * MW_MiB;
__device__ __forceinline__ const char* moe_w13(int e, const char* out, const char* ws) {
    return e <= 3 ? out + (size_t)e * MW_E : (e == 4 ? ws + MW_B + 22 * MW_MiB : (e == 5 ? ws + MW_E5 : (e == 6 ? ws + MW_E6 : ws + MW_E7A))); }
__device__ __forceinline__ const char* moe_w2(int e, const char* out, const char* ws) {
    return e <= 2 ? out + (size_t)e * MW_E + 44 * MW_MiB : (e == 3 ? ws + MW_B : (e == 4 ? ws + MW_B + 66 * MW_MiB : (e == 5 ? ws + MW_E5 + 44 * MW_MiB : (e == 6 ? ws + MW_E6 + 44 * MW_MiB : ws + MW_E7B)))); }
struct ProbMoe1 {
    pg8::StaticOrder so; const char* HBp; const int* slot_tok; const char* outp; const char* wsb; MoeTiles mt;
    __device__ __forceinline__ bool next(int i, pg8::Unit& u) const { return so.next(i, u); }
    __device__ __forceinline__ const char* a_base(const pg8::Unit&) const { return HBp; }
    __device__ __forceinline__ const char* b_base(const pg8::Unit& u) const { return moe_w13(moe_expert(mt, u.pm), outp, wsb) + (size_t)u.pn * (256 * (size_t)D * 2); }
    __device__ __forceinline__ int a_row(const pg8::Unit& u, int r) const { return slot_tok[u.pm * 256 + r]; }
    __device__ __forceinline__ bool is_half(const pg8::Unit&) const { return false; }
    __device__ __forceinline__ int nt(const pg8::Unit&, int ntf) const { return ntf; }
};
constexpr int MOE_KS = 4, MOE_KS_NT = DFF / 64 / MOE_KS, MOE_MAIN_TILES = TREAL * 2 / 256;
static_assert(MOE_KS_NT % 2 == 0 && MOE_KS_NT * MOE_KS * 64 == DFF, "split-K pieces");
struct ProbMoe2 {
    pg8::StaticOrder so; const char* ACTp; const char* outp; const char* wsb; MoeTiles mt; int extra;
    __device__ __forceinline__ bool next(int i, pg8::Unit& u) const {
        const long L = (long)i * so.G + so.c; if (L < so.nwg) return so.next(i, u);
        const int t = (int)(L - so.nwg); if (t >= extra * 8 * MOE_KS) return false;
        u.ks = t & (MOE_KS - 1); u.pn = (t >> 2) & 7; u.pm = MOE_MAIN_TILES + (t >> 5); return true; }
    __device__ __forceinline__ size_t koff(const pg8::Unit& u) const { return u.ks < 0 ? (size_t)0 : (size_t)u.ks * (MOE_KS_NT * 64 * 2); }
    __device__ __forceinline__ const char* a_base(const pg8::Unit& u) const { return ACTp + (size_t)u.pm * (256 * (size_t)DFF * 2) + koff(u); }
    __device__ __forceinline__ const char* b_base(const pg8::Unit& u) const { return moe_w2(moe_expert(mt, u.pm), outp, wsb) + (size_t)u.pn * (256 * (size_t)DFF * 2) + koff(u); }
    __device__ __forceinline__ int a_row(const pg8::Unit&, int) const { return 0; }
    __device__ __forceinline__ bool is_half(const pg8::Unit&) const { return false; }
    __device__ __forceinline__ int nt(const pg8::Unit& u, int ntf) const { return u.ks < 0 ? ntf : MOE_KS_NT; }
};

namespace epi {
using pg8::f32x4; using pg8::u32x4; using pg8::bf16_t; using pg8::Unit; using pg8::cvt_pk_bf16;
typedef const f32x4 (&AccRef)[2][2][4][2];
__device__ __forceinline__ void store8(bf16_t* p, f32x4 v0, f32x4 v1) { u32x4 w; w.x = cvt_pk_bf16(v0[0], v0[1]); w.y = cvt_pk_bf16(v0[2], v0[3]); w.z = cvt_pk_bf16(v1[0], v1[1]); w.w = cvt_pk_bf16(v1[2], v1[3]); *(u32x4*)p = w; }
__device__ __forceinline__ void load8(const bf16_t* p, f32x4& v0, f32x4& v1) { const u32x4 w = *(const u32x4*)p;
    v0 = (f32x4){pg8::bf_lo(w.x), pg8::bf_hi(w.x), pg8::bf_lo(w.y), pg8::bf_hi(w.y)}; v1 = (f32x4){pg8::bf_lo(w.z), pg8::bf_hi(w.z), pg8::bf_lo(w.w), pg8::bf_hi(w.w)}; }
__device__ __forceinline__ void unpack8(u32x4 w, f32x4& v0, f32x4& v1) { v0 = (f32x4){pg8::bf_lo(w.x), pg8::bf_hi(w.x), pg8::bf_lo(w.y), pg8::bf_hi(w.y)}; v1 = (f32x4){pg8::bf_lo(w.z), pg8::bf_hi(w.z), pg8::bf_lo(w.w), pg8::bf_hi(w.w)}; }
__device__ __forceinline__ bool epi_fence() { asm volatile("" ::: "memory"); return true; }
__device__ __forceinline__ float sigmoidf_(float x) { return __builtin_amdgcn_rcpf(1.f + __builtin_amdgcn_exp2f(-x * LOG2E)); }
#define EPI_AM _Pragma("unroll") for (int ai = 0; ai < 2; ++ai) _Pragma("unroll") for (int m = 0; m < 4; ++m) if (epi_fence())

struct EpiWin {
    static constexpr bool MID = false;
    bf16_t *CQ, *CKV, *KR, *QB, *KB, *VB, *GR, *GBb; float* SSQ; const float *CS, *SN;
    __device__ __forceinline__ void operator()(AccRef acc, const Unit& u, int wr, int wc, int fr, int fq) const {
        const int pn = u.pn, row0 = u.pm * 256 + wr * 64 + fr, cw = wc * 32 + fq * 8;
        if (pn < 5) {
            bf16_t* dst = pn < 3 ? CQ : CKV; const int ld = pn < 3 ? QRANK : KVRANK, c0 = (pn < 3 ? pn : pn - 3) * 256;
            EPI_AM { const int row = row0 + ai * 128 + m * 16; float s = 0.f;
#pragma unroll
                for (int bj = 0; bj < 2; ++bj) { const f32x4 v0 = acc[ai][bj][m][0], v1 = acc[ai][bj][m][1];
                    s += (v0[0] * v0[0] + v0[1] * v0[1]) + (v0[2] * v0[2] + v0[3] * v0[3]) + (v1[0] * v1[0] + v1[1] * v1[1]) + (v1[2] * v1[2] + v1[3] * v1[3]);
                    store8(dst + (size_t)row * ld + c0 + bj * 128 + cw, v0, v1); }
                { auto r16 = __builtin_amdgcn_permlane16_swap(__float_as_uint(s), __float_as_uint(s), false, false); s = __uint_as_float(r16[0]) + __uint_as_float(r16[1]);
                  auto r32 = __builtin_amdgcn_permlane32_swap(__float_as_uint(s), __float_as_uint(s), false, false); s = __uint_as_float(r32[0]) + __uint_as_float(r32[1]); }
                if (fq == 0) SSQ[(size_t)row * 20 + pn * 4 + wc] = s; }
        } else if (pn == 5) {
            if (wc == 0) {
#pragma unroll
                for (int rp = 0; rp < 4; ++rp) { f32x4 cs_[2][4];
#pragma unroll
                    for (int mm = 0; mm < 2; ++mm) { const int rr = 2 * rp + mm, pos = row_pos(row0 + (rr >> 2) * 128 + (rr & 3) * 16);
                        cs_[mm][0] = *(const f32x4*)(CS + pos * 32 + fq * 8); cs_[mm][1] = *(const f32x4*)(CS + pos * 32 + fq * 8 + 4); cs_[mm][2] = *(const f32x4*)(SN + pos * 32 + fq * 8); cs_[mm][3] = *(const f32x4*)(SN + pos * 32 + fq * 8 + 4); }
                    asm volatile("" ::: "memory");
#pragma unroll
                    for (int mm = 0; mm < 2; ++mm) { const int rr = 2 * rp + mm, ai = rr >> 2, m = rr & 3, row = row0 + ai * 128 + m * 16; const f32x4 c0 = cs_[mm][0], c1 = cs_[mm][1], s0 = cs_[mm][2], s1 = cs_[mm][3];
                        const f32x4 x10 = acc[ai][0][m][0], x11 = acc[ai][0][m][1], x20 = acc[ai][1][m][0], x21 = acc[ai][1][m][1];
                        store8(KR + (size_t)row * 64 + fq * 8, x10 * c0 - x20 * s0, x11 * c1 - x21 * s1);
                        store8(KR + (size_t)row * 64 + 32 + fq * 8, x10 * s0 + x20 * c0, x11 * s1 + x21 * c1); }
                    asm volatile("" ::: "memory"); } }
        } else if (pn < 14) {
            EPI_AM { const int row = row0 + ai * 128 + m * 16;
#pragma unroll
                for (int bj = 0; bj < 2; ++bj) store8(QB + (size_t)row * 2048 + (pn - 6) * 256 + bj * 128 + cw, acc[ai][bj][m][0] * QK_SCALE_SWA, acc[ai][bj][m][1] * QK_SCALE_SWA); }
        } else if (pn < 18) {
            bf16_t* dst = pn < 16 ? KB : VB; const int c0 = (pn < 16 ? pn - 14 : pn - 16) * 256;
            EPI_AM { const int row = row0 + ai * 128 + m * 16;
#pragma unroll
                for (int bj = 0; bj < 2; ++bj) store8(dst + (size_t)row * 512 + c0 + bj * 128 + cw, acc[ai][bj][m][0], acc[ai][bj][m][1]); }
        } else {
            const int c0 = (pn - 18) * 128 + cw;
            EPI_AM { const int row = row0 + ai * 128 + m * 16; f32x4 r[2], g[2];
#pragma unroll
                for (int n = 0; n < 2; ++n)
#pragma unroll
                    for (int j = 0; j < 4; ++j) { const float a = acc[ai][0][m][n][j], b = fmaxf(acc[ai][1][m][n][j], -30.f);
                        const float ea = __builtin_amdgcn_exp2f(-a * LOG2E), eb = __builtin_amdgcn_exp2f(-b * LOG2E);
                        g[n][j] = __builtin_amdgcn_rcpf(1.f + eb); r[n][j] = (1.f + eb) * __builtin_amdgcn_rcpf(1.f + ea); }
                store8(GR + (size_t)row * 2048 + c0, r[0], r[1]); store8(GBb + (size_t)row * 2048 + c0, g[0], g[1]); }
        }
    }
};
struct EpiUq {
    static constexpr bool MID = false;
    bf16_t* Q; const float* SSQ; const float *CS, *SN;
    __device__ __forceinline__ void operator()(AccRef acc, const Unit& u, int wr, int wc, int fr, int fq) const {
        const int pn = u.pn, row0 = u.pm * 256 + wr * 64 + fr, cw = wc * 32 + fq * 8;
#pragma unroll
        for (int ai = 0; ai < 2; ++ai) { f32x4 q[4][3]; float rs[4];
#pragma unroll
            for (int m = 0; m < 4; ++m) { const float* sp = SSQ + (size_t)(row0 + ai * 128 + m * 16) * 20; q[m][0] = *(const f32x4*)sp; q[m][1] = *(const f32x4*)(sp + 4); q[m][2] = *(const f32x4*)(sp + 8); }
            asm volatile("" ::: "memory");
#pragma unroll
            for (int m = 0; m < 4; ++m) { const float ss = ((q[m][0][0] + q[m][0][1]) + (q[m][0][2] + q[m][0][3])) + ((q[m][1][0] + q[m][1][1]) + (q[m][1][2] + q[m][1][3])) + ((q[m][2][0] + q[m][2][1]) + (q[m][2][2] + q[m][2][3]));
                rs[m] = __builtin_amdgcn_rsqf(ss * (1.f / QRANK) + RMS_EPS) * QK_SCALE_MLA; }
            if (pn < 8) {
#pragma unroll
                for (int m = 0; m < 4; ++m) { const int row = row0 + ai * 128 + m * 16;
#pragma unroll
                    for (int bj = 0; bj < 2; ++bj) store8(Q + (size_t)row * 3072 + (2 * pn + bj) * 192 + cw, acc[ai][bj][m][0] * rs[m], acc[ai][bj][m][1] * rs[m]); }
            } else {
                const int head = 4 * (pn - 8) + wc;
#pragma unroll
                for (int mp = 0; mp < 2; ++mp) { f32x4 cs_[2][4];
#pragma unroll
                    for (int mm = 0; mm < 2; ++mm) { const int pos = row_pos(row0 + ai * 128 + (2 * mp + mm) * 16);
                        cs_[mm][0] = *(const f32x4*)(CS + pos * 32 + fq * 8); cs_[mm][1] = *(const f32x4*)(CS + pos * 32 + fq * 8 + 4); cs_[mm][2] = *(const f32x4*)(SN + pos * 32 + fq * 8); cs_[mm][3] = *(const f32x4*)(SN + pos * 32 + fq * 8 + 4); }
                    asm volatile("" ::: "memory");
#pragma unroll
                    for (int mm = 0; mm < 2; ++mm) { const int m = 2 * mp + mm, row = row0 + ai * 128 + m * 16; const f32x4 c0 = cs_[mm][0], c1 = cs_[mm][1], s0 = cs_[mm][2], s1 = cs_[mm][3];
                        const f32x4 x10 = acc[ai][0][m][0] * rs[m], x11 = acc[ai][0][m][1] * rs[m], x20 = acc[ai][1][m][0] * rs[m], x21 = acc[ai][1][m][1] * rs[m];
                        store8(Q + (size_t)row * 3072 + head * 192 + 128 + fq * 8, x10 * c0 - x20 * s0, x11 * c1 - x21 * s1);
                        store8(Q + (size_t)row * 3072 + head * 192 + 160 + fq * 8, x10 * s0 + x20 * c0, x11 * s1 + x21 * c1); }
                    asm volatile("" ::: "memory"); }
            }
            asm volatile("" ::: "memory"); }
    }
};
struct EpiUkv {
    static constexpr bool MID = false;
    bf16_t *KN, *V; const float* SSQ;
    __device__ __forceinline__ void operator()(AccRef acc, const Unit& u, int wr, int wc, int fr, int fq) const {
        const int pn = u.pn, row0 = u.pm * 256 + wr * 64 + fr, cw = wc * 32 + fq * 8;
        f32x4 q[2][4][2];
#pragma unroll
        for (int ai = 0; ai < 2; ++ai)
#pragma unroll
            for (int m = 0; m < 4; ++m) { const float* sp = SSQ + (size_t)(row0 + ai * 128 + m * 16) * 20 + 12; q[ai][m][0] = *(const f32x4*)sp; q[ai][m][1] = *(const f32x4*)(sp + 4); }
        asm volatile("" ::: "memory");
#pragma unroll
        for (int ai = 0; ai < 2; ++ai)
#pragma unroll
            for (int m = 0; m < 4; ++m) { const int row = row0 + ai * 128 + m * 16; const f32x4 q0 = q[ai][m][0], q1 = q[ai][m][1];
                const float ss = ((q0[0] + q0[1]) + (q0[2] + q0[3])) + ((q1[0] + q1[1]) + (q1[2] + q1[3]));
                const float rs = __builtin_amdgcn_rsqf(ss * (1.f / KVRANK) + RMS_EPS);
                store8(KN + (size_t)row * 2048 + pn * 128 + cw, acc[ai][0][m][0] * rs, acc[ai][0][m][1] * rs);
                store8(V + (size_t)row * 2048 + pn * 128 + cw, acc[ai][1][m][0] * rs, acc[ai][1][m][1] * rs); }
    }
};
struct EpiProj {
    static constexpr bool MID = true;
    bf16_t* MG; const bf16_t *GR, *GBb;
    __device__ __forceinline__ void mid(f32x4 (&acc)[2][2][4][2], const Unit& u, int wr, int wc, int fr, int fq) const {
        int row0 = u.pm * 256 + wr * 64 + fr, c0 = u.pn * 256 + wc * 32 + fq * 8; asm volatile("" : "+v"(row0), "+v"(c0));
#pragma unroll
        for (int ai = 0; ai < 2; ++ai) { u32x4 w[4][2];
#pragma unroll
            for (int m = 0; m < 4; ++m)
#pragma unroll
                for (int bj = 0; bj < 2; ++bj) w[m][bj] = *(const u32x4*)(GR + (size_t)(row0 + ai * 128 + m * 16) * 2048 + c0 + bj * 128);
            asm volatile("" ::: "memory");
#pragma unroll
            for (int m = 0; m < 4; ++m)
#pragma unroll
                for (int bj = 0; bj < 2; ++bj) { f32x4 r0, r1; unpack8(w[m][bj], r0, r1); acc[ai][bj][m][0] *= r0; acc[ai][bj][m][1] *= r1; }
            asm volatile("" ::: "memory"); }
    }
    __device__ __forceinline__ void operator()(AccRef acc, const Unit& u, int wr, int wc, int fr, int fq) const {
        const int row0 = u.pm * 256 + wr * 64 + fr, c0 = u.pn * 256 + wc * 32 + fq * 8;
#pragma unroll
        for (int ai = 0; ai < 2; ++ai) { u32x4 w[4][2];
#pragma unroll
            for (int m = 0; m < 4; ++m)
#pragma unroll
                for (int bj = 0; bj < 2; ++bj) w[m][bj] = *(const u32x4*)(GBb + (size_t)(row0 + ai * 128 + m * 16) * 2048 + c0 + bj * 128);
            asm volatile("" ::: "memory");
#pragma unroll
            for (int m = 0; m < 4; ++m)
#pragma unroll
                for (int bj = 0; bj < 2; ++bj) { f32x4 g0, g1; unpack8(w[m][bj], g0, g1); store8(MG + (size_t)(row0 + ai * 128 + m * 16) * 2048 + c0 + bj * 128, acc[ai][bj][m][0] * g0, acc[ai][bj][m][1] * g1); }
            asm volatile("" ::: "memory"); }
    }
};
struct EpiResid {
    static constexpr bool MID = false;
    bf16_t* X; const bf16_t* HB; bf16_t* XP;
    __device__ __forceinline__ void operator()(AccRef acc, const Unit& u, int wr, int wc, int fr, int fq) const {
        const int row0 = u.pm * 256 + wr * 64 + fr, c0 = u.pn * 256 + wc * 32 + fq * 8;
        const bool part = u.ks >= 1; const float al = part ? 0.f : ALPHA;
        bf16_t* const X = part ? XP + ((ptrdiff_t)(u.ks - 1) * 256 - (ptrdiff_t)u.pm * 256) * 2048 : this->X;
#pragma unroll
        for (int ai = 0; ai < 2; ++ai) { u32x4 w[4][2];
#pragma unroll
            for (int m = 0; m < 4; ++m)
#pragma unroll
                for (int bj = 0; bj < 2; ++bj) w[m][bj] = *(const u32x4*)(HB + (size_t)(row0 + ai * 128 + m * 16) * 2048 + c0 + bj * 128);
            asm volatile("" ::: "memory");
#pragma unroll
            for (int m = 0; m < 4; ++m)
#pragma unroll
                for (int bj = 0; bj < 2; ++bj) { f32x4 h0, h1; unpack8(w[m][bj], h0, h1);
                    store8(X + (size_t)(row0 + ai * 128 + m * 16) * 2048 + c0 + bj * 128, h0 * al + acc[ai][bj][m][0], h1 * al + acc[ai][bj][m][1]); }
            asm volatile("" ::: "memory"); }
    }
};
struct EpiSwiglu {
    static constexpr bool MID = false;
    bf16_t* ACT;
    __device__ __forceinline__ void operator()(AccRef acc, const Unit& u, int wr, int wc, int fr, int fq) const {
        const int row0 = u.pm * 256 + wr * 64 + fr, c0 = u.pn * 128 + wc * 32 + fq * 8;
        EPI_AM { const int row = row0 + ai * 128 + m * 16; f32x4 o[2];
#pragma unroll
            for (int n = 0; n < 2; ++n)
#pragma unroll
                for (int j = 0; j < 4; ++j) { const float g = acc[ai][0][m][n][j]; o[n][j] = g * sigmoidf_(g) * acc[ai][1][m][n][j]; }
            store8(ACT + (size_t)row * DFF + c0, o[0], o[1]); }
    }
};
struct EpiMoeDown {
    static constexpr bool MID = false;
    bf16_t* Y; const float* slot_gate; bf16_t* YP;
    __device__ __forceinline__ void operator()(AccRef acc, const Unit& u, int wr, int wc, int fr, int fq) const {
        const int row0 = u.pm * 256 + wr * 64 + fr, c0 = u.pn * 256 + wc * 32 + fq * 8;
        bf16_t* const Y = u.ks >= 1 ? YP + ((ptrdiff_t)(u.ks - 1) * 2048 - (ptrdiff_t)MOE_MAIN_TILES * 256) * 2048 : this->Y;
        float gt[2][4];
#pragma unroll
        for (int ai = 0; ai < 2; ++ai)
#pragma unroll
            for (int m = 0; m < 4; ++m) gt[ai][m] = slot_gate[row0 + ai * 128 + m * 16];
        asm volatile("" ::: "memory");
#pragma unroll
        for (int ai = 0; ai < 2; ++ai)
#pragma unroll
            for (int m = 0; m < 4; ++m) { const int row = row0 + ai * 128 + m * 16; const float g = gt[ai][m];
#pragma unroll
                for (int bj = 0; bj < 2; ++bj) store8(Y + (size_t)row * 2048 + c0 + bj * 128, acc[ai][bj][m][0] * g, acc[ai][bj][m][1] * g); }
    }
};
#undef EPI_AM
}
namespace att {
typedef unsigned short bf16;
typedef short bf16x8 __attribute__((ext_vector_type(8)));
typedef short s16x4 __attribute__((ext_vector_type(4)));
typedef float f32x16 __attribute__((ext_vector_type(16)));
typedef unsigned u32x4 __attribute__((ext_vector_type(4)));
#define ATT_LAS __attribute__((address_space(3)))
#define SBAR() __builtin_amdgcn_sched_barrier(0)
constexpr int KN_BYTES = 16384, KR_BYTES = 8192, V_BYTES = 16384, BUF_BYTES = KN_BYTES + KR_BYTES + V_BYTES;
constexpr int OFF_KN = 0, OFF_KR = KN_BYTES, OFF_V = KN_BYTES + KR_BYTES;
constexpr int OFF_WS = 2 * BUF_BYTES;
constexpr int OFF_BT = OFF_WS + 8 * 64 * 4;
constexpr int ATT_LDS_BYTES = OFF_BT + 4 * 260 * 4;
constexpr float NEG_BIG = -1e30f;
constexpr float THR2 = 8.f;
constexpr float THRZ = 64.f;

__device__ __forceinline__ int crow(int r, int hi) { return (r & 3) + 8 * (r >> 2) + 4 * hi; }
__device__ __forceinline__ unsigned cvtpk(float lo, float hi) { return pg8::cvt_pk_bf16(lo, hi); }
__device__ __forceinline__ int kn_off(int row, int colB) { return row * 256 + (colB ^ ((row & 15) << 4)); }
__device__ __forceinline__ int kr_off(int row, int colB) { return row * 128 + (colB ^ (((row >> 1) & 7) << 4)); }
__device__ __forceinline__ int v_st(int k, int c) { const int kk = (k & ~0xC) | ((k & 4) << 1) | ((k & 8) >> 1); return ((kk >> 3) * 4 + (c >> 5)) * 512 + ((kk & 7) * 32 + (c & 31)) * 2; }
__device__ __forceinline__ int v_rd_base(int lane) { return ((lane & 3) << 3) | (((lane >> 2) & 3) << 6) | (((lane >> 4) & 1) << 5) | (((lane >> 5) & 1) << 8); }
constexpr int v_rd_off(int d0, int ks, int half) { return d0 * 512 + ks * 4096 + half * 2048; }
template <int OFF> __device__ __forceinline__ s16x4 tr_read(int vb) { s16x4 r; asm volatile("ds_read_b64_tr_b16 %0, %1 offset:%2" : "=&v"(r) : "v"(vb), "i"(OFF) : "memory"); return r; }
template <int D0> __device__ __forceinline__ void pv_one(f32x16& od, int vb, bf16x8 pa0, bf16x8 pa1, bf16x8 pa2, bf16x8 pa3) {
    const s16x4 l0 = tr_read<v_rd_off(D0, 0, 0)>(vb), h0 = tr_read<v_rd_off(D0, 0, 1)>(vb), l1 = tr_read<v_rd_off(D0, 1, 0)>(vb), h1 = tr_read<v_rd_off(D0, 1, 1)>(vb);
    const s16x4 l2 = tr_read<v_rd_off(D0, 2, 0)>(vb), h2 = tr_read<v_rd_off(D0, 2, 1)>(vb), l3 = tr_read<v_rd_off(D0, 3, 0)>(vb), h3 = tr_read<v_rd_off(D0, 3, 1)>(vb);
    asm volatile("s_waitcnt lgkmcnt(0)" ::: "memory"); SBAR();
#define PK(L, H) (bf16x8){L[0], L[1], L[2], L[3], H[0], H[1], H[2], H[3]}
    od = __builtin_amdgcn_mfma_f32_32x32x16_bf16(pa0, PK(l0, h0), od, 0, 0, 0);
    od = __builtin_amdgcn_mfma_f32_32x32x16_bf16(pa1, PK(l1, h1), od, 0, 0, 0);
    od = __builtin_amdgcn_mfma_f32_32x32x16_bf16(pa2, PK(l2, h2), od, 0, 0, 0);
    od = __builtin_amdgcn_mfma_f32_32x32x16_bf16(pa3, PK(l3, h3), od, 0, 0, 0);
#undef PK
}
__device__ __forceinline__ void pv_all(f32x16* o, int vb, bf16x8 pa0, bf16x8 pa1, bf16x8 pa2, bf16x8 pa3) {
    pv_one<0>(o[0], vb, pa0, pa1, pa2, pa3); pv_one<1>(o[1], vb, pa0, pa1, pa2, pa3); pv_one<2>(o[2], vb, pa0, pa1, pa2, pa3); pv_one<3>(o[3], vb, pa0, pa1, pa2, pa3);
}
}
namespace att {
constexpr int M2_KSLOT = KN_BYTES + KR_BYTES;
constexpr int M2_OFF_K = 0, M2_OFF_V = 3 * M2_KSLOT;
constexpr int M2_OFF_WS = M2_OFF_V + 3 * V_BYTES;
constexpr int M2_LDS_BYTES = M2_OFF_WS + 8 * 64 * 4;
typedef __attribute__((address_space(3))) unsigned char* lds_ptr;

}
namespace att {
constexpr int M3_NT = 65;
template <bool ZOFF = false, bool FIRST = false>
__device__ __forceinline__ void softmax_seg(f32x16& p0, f32x16& p1, float& m_reg, float& l_reg, float& alpha, bf16x8& pa0, bf16x8& pa1, bf16x8& pa2, bf16x8& pa3) {
    float pmax = p0[0];
#pragma unroll
    for (int r = 1; r < 16; ++r) pmax = fmaxf(pmax, p0[r]);
#pragma unroll
    for (int r = 0; r < 16; ++r) pmax = fmaxf(pmax, p1[r]);
    { auto rr = __builtin_amdgcn_permlane32_swap(__float_as_uint(pmax), __float_as_uint(pmax), false, false); pmax = fmaxf(__uint_as_float(rr[0]), __uint_as_float(rr[1])); }
    bool zero_off = false;
    if constexpr (ZOFF) {
        bool upd = pmax - m_reg > THRZ; if (FIRST) upd = upd || (pmax < -THRZ);
        if (__builtin_expect(__all(!upd), 1)) { alpha = 1.f; }
        else { const float mn = upd ? pmax : m_reg; alpha = FIRST ? 1.f : __builtin_amdgcn_exp2f(m_reg - mn); m_reg = mn; }
        zero_off = __all(m_reg == 0.f);
    } else {
        if (__builtin_expect(__all(pmax - m_reg <= THR2), 1)) { alpha = 1.f; }
        else { const float mn = fmaxf(m_reg, pmax); alpha = __builtin_amdgcn_exp2f(m_reg - mn); m_reg = mn; }
    }
    float ps = 0.f;
    if (zero_off) {
#pragma unroll
        for (int r = 0; r < 16; ++r) { p0[r] = __builtin_amdgcn_exp2f(p0[r]); ps += p0[r]; }
#pragma unroll
        for (int r = 0; r < 16; ++r) { p1[r] = __builtin_amdgcn_exp2f(p1[r]); ps += p1[r]; }
    } else {
        const float mn = m_reg;
#pragma unroll
        for (int r = 0; r < 16; ++r) { p0[r] = __builtin_amdgcn_exp2f(p0[r] - mn); ps += p0[r]; }
#pragma unroll
        for (int r = 0; r < 16; ++r) { p1[r] = __builtin_amdgcn_exp2f(p1[r] - mn); ps += p1[r]; }
    }
    { auto rr = __builtin_amdgcn_permlane32_swap(__float_as_uint(ps), __float_as_uint(ps), false, false); ps = __uint_as_float(rr[0]) + __uint_as_float(rr[1]); }
    l_reg = l_reg * alpha + ps;
#define PK4(P, BASE, OUT) do { unsigned a0 = cvtpk(P[BASE + 0], P[BASE + 1]), a1 = cvtpk(P[BASE + 2], P[BASE + 3]);   \
    unsigned b0 = cvtpk(P[BASE + 4], P[BASE + 5]), b1 = cvtpk(P[BASE + 6], P[BASE + 7]);                              \
    auto r0 = __builtin_amdgcn_permlane32_swap(a0, b0, false, false); auto r1 = __builtin_amdgcn_permlane32_swap(a1, b1, false, false); \
    u32x4 w = {r0[0], r1[0], r0[1], r1[1]}; OUT = *reinterpret_cast<bf16x8*>(&w); } while (0)
    PK4(p0, 0, pa0); PK4(p0, 8, pa1); PK4(p1, 0, pa2); PK4(p1, 8, pa3);
#undef PK4
}

}
namespace att {
constexpr int S2_OFF_K = 0, S2_OFF_V = 3 * KN_BYTES, S2_OFF_TW = S2_OFF_V + 3 * V_BYTES;
constexpr int S2_OFF_TM = S2_OFF_TW + 4 * 512 * 4, S2_OFF_WS = S2_OFF_TM + 4 * 256 * 4, S2_LDS_BYTES = S2_OFF_WS + 8 * 64 * 4;
__device__ __forceinline__ void swa_unit2(lds_ptr lds, const bf16* __restrict__ QB, const bf16* __restrict__ KB, const bf16* __restrict__ VB, bf16* __restrict__ OAB,
                                          const float* __restrict__ tw_g, const float* __restrict__ tm_g, const float* __restrict__ sink_l2, int b, int hk, int j, int& tables_hk, const int tid_in) {
    int tid_ = tid_in; asm volatile("" : "+v"(tid_)); const int tid = tid_, lane = tid & 63, r32 = lane & 31, hi = lane >> 5; const int wid = __builtin_amdgcn_readfirstlane(tid >> 6);
    const bool metaq = (j == 64);
    const int hq = 4 * hk + (wid >> 1);
    const bool wave_on = !metaq || (wid & 1) == 0;
    const int qpos = metaq ? (r32 & 15) : (NMETA + 64 * j + 32 * (wid & 1) + r32);
    const int qrow = metaq ? (TREAL + 16 * b + (r32 & 15)) : (b * SEQ + 64 * j + 32 * (wid & 1) + r32);
    __attribute__((address_space(3))) float* wsf = (__attribute__((address_space(3))) float*)(lds + S2_OFF_WS) + wid * 64;
    int nt, kt_lo = 0;
    if (metaq) nt = 3; else { kt_lo = j - 2 < 0 ? 0 : j - 2; const int kt_hi = j + 2 > 63 ? 63 : j + 2; nt = 1 + (kt_hi - kt_lo + 1); }
#define S2_KPOS0(t) (metaq ? 64 * (t) : ((t) == 0 ? 0 : NMETA + 64 * (kt_lo + (t) - 1)))
#define S2_ROW(kp) ({ int kp_ = (kp) > LPOS - 1 ? LPOS - 1 : (kp); (kp_ < NMETA ? TREAL + 16 * b + kp_ : b * SEQ + kp_ - NMETA); })
    int kk_k[2], kk_v[2]; unsigned co_k[2], co_v[2];
#pragma unroll
    for (int i = 0; i < 2; ++i) { const int P = 2 * wid + i;
        { const int row = 4 * P + (lane >> 4), c = (lane & 15) ^ (row & 15); kk_k[i] = row; co_k[i] = (unsigned)(c * 16); }
        { const int q = 64 * P + lane, s = q >> 5, kk = (s >> 2) * 8 + ((q & 31) >> 2), col = (s & 3) * 32 + (q & 3) * 8, k = (kk & ~0xC) | ((kk & 4) << 1) | ((kk & 8) >> 1); kk_v[i] = k; co_v[i] = (unsigned)(col * 2); } }
    const char* const kb_h = (const char*)KB + hk * 256; const char* const vb_h = (const char*)VB + hk * 256;
#define S2_DMA(src, dstoff) __builtin_amdgcn_global_load_lds((const unsigned*)(src), (__attribute__((address_space(3))) unsigned*)(lds + (dstoff)), 16, 0, 0)
#define S2_DMA_TILE(t, slot) do { const int kp0_ = S2_KPOS0(t); \
        _Pragma("unroll") for (int i_ = 0; i_ < 2; ++i_) { S2_DMA(kb_h + (size_t)S2_ROW(kp0_ + kk_k[i_]) * 1024 + co_k[i_], S2_OFF_K + (slot) * KN_BYTES + (2 * wid + i_) * 1024); \
                                                          S2_DMA(vb_h + (size_t)S2_ROW(kp0_ + kk_v[i_]) * 1024 + co_v[i_], S2_OFF_V + (slot) * V_BYTES + (2 * wid + i_) * 1024); } } while (0)
#define S2_BAR() do { asm volatile("s_waitcnt lgkmcnt(0)" ::: "memory"); __builtin_amdgcn_s_barrier(); asm volatile("" ::: "memory"); } while (0)
    S2_DMA_TILE(0, 0); S2_DMA_TILE(1, 1); S2_DMA_TILE(2, 2);
    bf16x8 qr[8];
    { const bf16* qp = QB + (size_t)qrow * 2048 + hq * 128 + hi * 8;
#pragma unroll
      for (int d0 = 0; d0 < 8; ++d0) qr[d0] = *reinterpret_cast<const bf16x8*>(qp + d0 * 16); }
    if (tables_hk != hk) {
        __attribute__((address_space(3))) float* tw = (__attribute__((address_space(3))) float*)(lds + S2_OFF_TW); __attribute__((address_space(3))) float* tm = (__attribute__((address_space(3))) float*)(lds + S2_OFF_TM);
        for (int i = tid; i < 4 * 512; i += 512) tw[i] = tw_g[(4 * hk) * 512 + i];
        for (int i = tid; i < 4 * 256; i += 512) tm[i] = tm_g[(4 * hk) * 256 + i];
        tables_hk = hk;
    }
    const int xkn = (r32 & 15) << 4, hb = hi * 16;
    const int vlane = v_rd_base(lane);
    const float sink = sink_l2[hq];
    float m_reg = sink, l_reg = 1.f; f32x16 o[4];
#pragma unroll
    for (int d = 0; d < 4; ++d) o[d] = f32x16{};
    f32x16 p0, p1; bf16x8 pa0, pa1, pa2, pa3;
#define S2_KLD(d, A0, A1) do { const int of_ = (((d) * 32 + hb) ^ xn_); A0 = *(const __attribute__((address_space(3))) bf16x8*)(kb_ + of_); A1 = *(const __attribute__((address_space(3))) bf16x8*)(kb_ + of_ + 8192); } while (0)
#define S2_KMM(d, A0, A1) do { p0 = __builtin_amdgcn_mfma_f32_32x32x16_bf16(A0, qr[d], p0, 0, 0, 0); p1 = __builtin_amdgcn_mfma_f32_32x32x16_bf16(A1, qr[d], p1, 0, 0, 0); } while (0)
    int slot = 0;
    for (int t = 0; t < nt; ++t) {
        { const int ahead = (nt < t + 3 ? nt : t + 3) - t - 1;
          if (ahead >= 2) asm volatile("s_waitcnt vmcnt(8)" ::: "memory"); else if (ahead == 1) asm volatile("s_waitcnt vmcnt(4)" ::: "memory"); else asm volatile("s_waitcnt vmcnt(0)" ::: "memory"); }
        S2_BAR();
        if (wave_on) {
            const int kpos0 = S2_KPOS0(t);
            __builtin_amdgcn_s_setprio(3);
            { int xn_ = xkn; asm volatile("" : "+v"(xn_)); const lds_ptr kb_ = lds + S2_OFF_K + slot * KN_BYTES + r32 * 256; p0 = f32x16{}; p1 = f32x16{};
              bf16x8 k0a, k0b, k1a, k1b, k2a, k2b, k3a, k3b;
              S2_KLD(0, k0a, k0b); S2_KLD(1, k1a, k1b); S2_KLD(2, k2a, k2b); S2_KLD(3, k3a, k3b); SBAR();
              S2_KMM(0, k0a, k0b); S2_KLD(4, k0a, k0b); SBAR(); S2_KMM(1, k1a, k1b); S2_KLD(5, k1a, k1b); SBAR(); S2_KMM(2, k2a, k2b); S2_KLD(6, k2a, k2b); SBAR(); S2_KMM(3, k3a, k3b); S2_KLD(7, k3a, k3b); SBAR();
              S2_KMM(4, k0a, k0b); SBAR(); S2_KMM(5, k1a, k1b); SBAR(); S2_KMM(6, k2a, k2b); SBAR(); S2_KMM(7, k3a, k3b); }
            __builtin_amdgcn_s_setprio(0);
            if (!metaq && t == 0) {
                int base = 4 * hi - qpos; base = base < -256 ? -256 : base;
                const __attribute__((address_space(3))) float* tb = (const __attribute__((address_space(3))) float*)(lds + S2_OFF_TM) + (wid >> 1) * 256 + base + 256;
#pragma unroll
                for (int r = 0; r < 16; ++r) { if (r < 8) p0[r] += tb[(r & 3) + 8 * (r >> 2)]; else p0[r] = NEG_BIG; p1[r] = NEG_BIG; }
            } else {
                const int base = kpos0 + 4 * hi - qpos;
                const __attribute__((address_space(3))) float* tb = (const __attribute__((address_space(3))) float*)(lds + S2_OFF_TW) + (wid >> 1) * 512 + base + 256;
#pragma unroll
                for (int r = 0; r < 16; ++r) { p0[r] += tb[(r & 3) + 8 * (r >> 2)]; p1[r] += tb[(r & 3) + 8 * (r >> 2) + 32]; }
                if (kpos0 + 64 > LPOS) {
#pragma unroll
                    for (int r = 0; r < 16; ++r) { if (kpos0 + crow(r, hi) >= LPOS) p0[r] = NEG_BIG; if (kpos0 + 32 + crow(r, hi) >= LPOS) p1[r] = NEG_BIG; } }
            }
            float alpha; softmax_seg(p0, p1, m_reg, l_reg, alpha, pa0, pa1, pa2, pa3);
            if (__any(alpha < 1.f)) { if (hi == 0) wsf[r32] = alpha; asm volatile("s_waitcnt lgkmcnt(0)" ::: "memory");
#pragma unroll
                for (int d = 0; d < 4; ++d)
#pragma unroll
                    for (int r = 0; r < 16; ++r) o[d][r] *= wsf[crow(r, hi)]; }
            __builtin_amdgcn_s_setprio(3); pv_all(o, (int)(uintptr_t)(lds + S2_OFF_V + slot * V_BYTES) + vlane, pa0, pa1, pa2, pa3); __builtin_amdgcn_s_setprio(0);
        }
        if (t + 3 < nt) { S2_BAR(); S2_DMA_TILE(t + 3, slot); }
        slot = slot == 2 ? 0 : slot + 1;
    }
    if (wave_on) {
        if (hi == 0) wsf[32 + r32] = l_reg; asm volatile("s_waitcnt lgkmcnt(0)" ::: "memory");
        const int orow0 = metaq ? (TREAL + 16 * b) : (b * SEQ + 64 * j + 32 * (wid & 1));
#pragma unroll
        for (int r = 0; r < 16; ++r) { const int rw = crow(r, hi); const float rl = __builtin_amdgcn_rcpf(wsf[32 + rw]);
            if (!metaq || rw < 16) { bf16* op = OAB + (size_t)(orow0 + rw) * 4096 + 2048 + hq * 128 + r32;
#pragma unroll
                for (int d0 = 0; d0 < 4; ++d0) op[d0 * 32] = (bf16)(cvtpk(o[d0][r] * rl, 0.f) & 0xffffu); } }
    }
    asm volatile("s_waitcnt vmcnt(0)" ::: "memory"); S2_BAR();
#undef S2_KPOS0
#undef S2_ROW
#undef S2_DMA
#undef S2_DMA_TILE
#undef S2_BAR
#undef S2_KLD
#undef S2_KMM
}
}
namespace att {
template <int OFF> __device__ __forceinline__ bf16x8 lds_rd128(int addr) { bf16x8 r; asm volatile("ds_read_b128 %0, %1 offset:%2" : "=&v"(r) : "v"(addr), "i"(OFF) : "memory"); return r; }
#define M4_XFULL(KS, VS) do { \
    int xn_ = xkn, xr_ = xkr; asm volatile("" : "+v"(xn_), "+v"(xr_)); \
    const int kbn_ = (int)(uintptr_t)(lds + M2_OFF_K + (KS) * M2_KSLOT) + r32 * 256, kbr_ = (int)(uintptr_t)(lds + M2_OFF_K + (KS) * M2_KSLOT + KN_BYTES) + r32 * 128; \
    const int vb_ = (int)(uintptr_t)(lds + M2_OFF_V + (VS) * V_BYTES) + vlane; (void)vb_; \
    bf16x8 ka0, ka1, ka2, ka3, ka4, kb0, kb1, kb2, kb3, kb4; s16x4 vl0, vl1, vl2, vl3, vl4, vh0, vh1, vh2, vh3, vh4; \
    p0 = f32x16{}; p1 = f32x16{}; \
    { const int a_ = kbn_ + (((0) * 32 + hb) ^ xn_); ka0 = lds_rd128<0>(a_); kb0 = lds_rd128<8192>(a_); } \
    { const int a_ = kbn_ + (((1) * 32 + hb) ^ xn_); ka1 = lds_rd128<0>(a_); kb1 = lds_rd128<8192>(a_); } \
    { const int a_ = kbn_ + (((2) * 32 + hb) ^ xn_); ka2 = lds_rd128<0>(a_); kb2 = lds_rd128<8192>(a_); } \
    { const int a_ = kbn_ + (((3) * 32 + hb) ^ xn_); ka3 = lds_rd128<0>(a_); kb3 = lds_rd128<8192>(a_); } \
    { const int a_ = kbn_ + (((4) * 32 + hb) ^ xn_); ka4 = lds_rd128<0>(a_); kb4 = lds_rd128<8192>(a_); } \
    asm volatile("s_waitcnt lgkmcnt(8)" ::: "memory"); SBAR(); p0 = __builtin_amdgcn_mfma_f32_32x32x16_bf16(ka0, qr[0], p0, 0, 0, 0); p1 = __builtin_amdgcn_mfma_f32_32x32x16_bf16(kb0, qr[0], p1, 0, 0, 0); SBAR(); \
    { const int a_ = kbn_ + (((5) * 32 + hb) ^ xn_); ka0 = lds_rd128<0>(a_); kb0 = lds_rd128<8192>(a_); } \
    asm volatile("s_waitcnt lgkmcnt(8)" ::: "memory"); SBAR(); p0 = __builtin_amdgcn_mfma_f32_32x32x16_bf16(ka1, qr[1], p0, 0, 0, 0); p1 = __builtin_amdgcn_mfma_f32_32x32x16_bf16(kb1, qr[1], p1, 0, 0, 0); SBAR(); \
    { const int a_ = kbn_ + (((6) * 32 + hb) ^ xn_); ka1 = lds_rd128<0>(a_); kb1 = lds_rd128<8192>(a_); } \
    asm volatile("s_waitcnt lgkmcnt(8)" ::: "memory"); SBAR(); p0 = __builtin_amdgcn_mfma_f32_32x32x16_bf16(ka2, qr[2], p0, 0, 0, 0); p1 = __builtin_amdgcn_mfma_f32_32x32x16_bf16(kb2, qr[2], p1, 0, 0, 0); SBAR(); \
    { const int a_ = kbn_ + (((7) * 32 + hb) ^ xn_); ka2 = lds_rd128<0>(a_); kb2 = lds_rd128<8192>(a_); } \
    asm volatile("s_waitcnt lgkmcnt(8)" ::: "memory"); SBAR(); p0 = __builtin_amdgcn_mfma_f32_32x32x16_bf16(ka3, qr[3], p0, 0, 0, 0); p1 = __builtin_amdgcn_mfma_f32_32x32x16_bf16(kb3, qr[3], p1, 0, 0, 0); SBAR(); \
    { const int a_ = kbr_ + (((0) * 32 + hb) ^ xr_); ka3 = lds_rd128<0>(a_); kb3 = lds_rd128<4096>(a_); } \
    asm volatile("s_waitcnt lgkmcnt(8)" ::: "memory"); SBAR(); p0 = __builtin_amdgcn_mfma_f32_32x32x16_bf16(ka4, qr[4], p0, 0, 0, 0); p1 = __builtin_amdgcn_mfma_f32_32x32x16_bf16(kb4, qr[4], p1, 0, 0, 0); SBAR(); \
    { const int a_ = kbr_ + (((1) * 32 + hb) ^ xr_); ka4 = lds_rd128<0>(a_); kb4 = lds_rd128<4096>(a_); } \
    asm volatile("s_waitcnt lgkmcnt(8)" ::: "memory"); SBAR(); p0 = __builtin_amdgcn_mfma_f32_32x32x16_bf16(ka0, qr[5], p0, 0, 0, 0); p1 = __builtin_amdgcn_mfma_f32_32x32x16_bf16(kb0, qr[5], p1, 0, 0, 0); SBAR(); \
    { const int a_ = kbr_ + (((2) * 32 + hb) ^ xr_); ka0 = lds_rd128<0>(a_); kb0 = lds_rd128<4096>(a_); } \
    asm volatile("s_waitcnt lgkmcnt(8)" ::: "memory"); SBAR(); p0 = __builtin_amdgcn_mfma_f32_32x32x16_bf16(ka1, qr[6], p0, 0, 0, 0); p1 = __builtin_amdgcn_mfma_f32_32x32x16_bf16(kb1, qr[6], p1, 0, 0, 0); SBAR(); \
    { const int a_ = kbr_ + (((3) * 32 + hb) ^ xr_); ka1 = lds_rd128<0>(a_); kb1 = lds_rd128<4096>(a_); } \
    asm volatile("s_waitcnt lgkmcnt(8)" ::: "memory"); SBAR(); p0 = __builtin_amdgcn_mfma_f32_32x32x16_bf16(ka2, qr[7], p0, 0, 0, 0); p1 = __builtin_amdgcn_mfma_f32_32x32x16_bf16(kb2, qr[7], p1, 0, 0, 0); SBAR(); \
    { vl2 = tr_read<v_rd_off(0, 0, 0)>(vb_); vh2 = tr_read<v_rd_off(0, 0, 1)>(vb_); } \
    asm volatile("s_waitcnt lgkmcnt(8)" ::: "memory"); SBAR(); p0 = __builtin_amdgcn_mfma_f32_32x32x16_bf16(ka3, qr[8], p0, 0, 0, 0); p1 = __builtin_amdgcn_mfma_f32_32x32x16_bf16(kb3, qr[8], p1, 0, 0, 0); SBAR(); \
    { vl3 = tr_read<v_rd_off(0, 1, 0)>(vb_); vh3 = tr_read<v_rd_off(0, 1, 1)>(vb_); } \
    asm volatile("s_waitcnt lgkmcnt(8)" ::: "memory"); SBAR(); p0 = __builtin_amdgcn_mfma_f32_32x32x16_bf16(ka4, qr[9], p0, 0, 0, 0); p1 = __builtin_amdgcn_mfma_f32_32x32x16_bf16(kb4, qr[9], p1, 0, 0, 0); SBAR(); \
    { vl4 = tr_read<v_rd_off(0, 2, 0)>(vb_); vh4 = tr_read<v_rd_off(0, 2, 1)>(vb_); } \
    asm volatile("s_waitcnt lgkmcnt(8)" ::: "memory"); SBAR(); p0 = __builtin_amdgcn_mfma_f32_32x32x16_bf16(ka0, qr[10], p0, 0, 0, 0); p1 = __builtin_amdgcn_mfma_f32_32x32x16_bf16(kb0, qr[10], p1, 0, 0, 0); SBAR(); \
    { vl0 = tr_read<v_rd_off(0, 3, 0)>(vb_); vh0 = tr_read<v_rd_off(0, 3, 1)>(vb_); } \
    asm volatile("s_waitcnt lgkmcnt(8)" ::: "memory"); SBAR(); p0 = __builtin_amdgcn_mfma_f32_32x32x16_bf16(ka1, qr[11], p0, 0, 0, 0); p1 = __builtin_amdgcn_mfma_f32_32x32x16_bf16(kb1, qr[11], p1, 0, 0, 0); SBAR(); \
    { vl1 = tr_read<v_rd_off(1, 0, 0)>(vb_); vh1 = tr_read<v_rd_off(1, 0, 1)>(vb_); } \
    asm volatile("s_waitcnt lgkmcnt(8)" ::: "memory"); SBAR(); o[0] = __builtin_amdgcn_mfma_f32_32x32x16_bf16(pa0, (bf16x8){vl2[0], vl2[1], vl2[2], vl2[3], vh2[0], vh2[1], vh2[2], vh2[3]}, o[0], 0, 0, 0); SBAR(); \
    { vl2 = tr_read<v_rd_off(1, 1, 0)>(vb_); vh2 = tr_read<v_rd_off(1, 1, 1)>(vb_); } \
    asm volatile("s_waitcnt lgkmcnt(8)" ::: "memory"); SBAR(); o[0] = __builtin_amdgcn_mfma_f32_32x32x16_bf16(pa1, (bf16x8){vl3[0], vl3[1], vl3[2], vl3[3], vh3[0], vh3[1], vh3[2], vh3[3]}, o[0], 0, 0, 0); SBAR(); \
    { vl3 = tr_read<v_rd_off(1, 2, 0)>(vb_); vh3 = tr_read<v_rd_off(1, 2, 1)>(vb_); } \
    asm volatile("s_waitcnt lgkmcnt(8)" ::: "memory"); SBAR(); o[0] = __builtin_amdgcn_mfma_f32_32x32x16_bf16(pa2, (bf16x8){vl4[0], vl4[1], vl4[2], vl4[3], vh4[0], vh4[1], vh4[2], vh4[3]}, o[0], 0, 0, 0); SBAR(); \
    { vl4 = tr_read<v_rd_off(1, 3, 0)>(vb_); vh4 = tr_read<v_rd_off(1, 3, 1)>(vb_); } \
    asm volatile("s_waitcnt lgkmcnt(8)" ::: "memory"); SBAR(); o[0] = __builtin_amdgcn_mfma_f32_32x32x16_bf16(pa3, (bf16x8){vl0[0], vl0[1], vl0[2], vl0[3], vh0[0], vh0[1], vh0[2], vh0[3]}, o[0], 0, 0, 0); SBAR(); \
    { vl0 = tr_read<v_rd_off(2, 0, 0)>(vb_); vh0 = tr_read<v_rd_off(2, 0, 1)>(vb_); } \
    asm volatile("s_waitcnt lgkmcnt(8)" ::: "memory"); SBAR(); o[1] = __builtin_amdgcn_mfma_f32_32x32x16_bf16(pa0, (bf16x8){vl1[0], vl1[1], vl1[2], vl1[3], vh1[0], vh1[1], vh1[2], vh1[3]}, o[1], 0, 0, 0); SBAR(); \
    { vl1 = tr_read<v_rd_off(2, 1, 0)>(vb_); vh1 = tr_read<v_rd_off(2, 1, 1)>(vb_); } \
    asm volatile("s_waitcnt lgkmcnt(8)" ::: "memory"); SBAR(); o[1] = __builtin_amdgcn_mfma_f32_32x32x16_bf16(pa1, (bf16x8){vl2[0], vl2[1], vl2[2], vl2[3], vh2[0], vh2[1], vh2[2], vh2[3]}, o[1], 0, 0, 0); SBAR(); \
    { vl2 = tr_read<v_rd_off(2, 2, 0)>(vb_); vh2 = tr_read<v_rd_off(2, 2, 1)>(vb_); } \
    asm volatile("s_waitcnt lgkmcnt(8)" ::: "memory"); SBAR(); o[1] = __builtin_amdgcn_mfma_f32_32x32x16_bf16(pa2, (bf16x8){vl3[0], vl3[1], vl3[2], vl3[3], vh3[0], vh3[1], vh3[2], vh3[3]}, o[1], 0, 0, 0); SBAR(); \
    { vl3 = tr_read<v_rd_off(2, 3, 0)>(vb_); vh3 = tr_read<v_rd_off(2, 3, 1)>(vb_); } \
    asm volatile("s_waitcnt lgkmcnt(8)" ::: "memory"); SBAR(); o[1] = __builtin_amdgcn_mfma_f32_32x32x16_bf16(pa3, (bf16x8){vl4[0], vl4[1], vl4[2], vl4[3], vh4[0], vh4[1], vh4[2], vh4[3]}, o[1], 0, 0, 0); SBAR(); \
    { vl4 = tr_read<v_rd_off(3, 0, 0)>(vb_); vh4 = tr_read<v_rd_off(3, 0, 1)>(vb_); } \
    asm volatile("s_waitcnt lgkmcnt(8)" ::: "memory"); SBAR(); o[2] = __builtin_amdgcn_mfma_f32_32x32x16_bf16(pa0, (bf16x8){vl0[0], vl0[1], vl0[2], vl0[3], vh0[0], vh0[1], vh0[2], vh0[3]}, o[2], 0, 0, 0); SBAR(); \
    { vl0 = tr_read<v_rd_off(3, 1, 0)>(vb_); vh0 = tr_read<v_rd_off(3, 1, 1)>(vb_); } \
    asm volatile("s_waitcnt lgkmcnt(8)" ::: "memory"); SBAR(); o[2] = __builtin_amdgcn_mfma_f32_32x32x16_bf16(pa1, (bf16x8){vl1[0], vl1[1], vl1[2], vl1[3], vh1[0], vh1[1], vh1[2], vh1[3]}, o[2], 0, 0, 0); SBAR(); \
    { vl1 = tr_read<v_rd_off(3, 2, 0)>(vb_); vh1 = tr_read<v_rd_off(3, 2, 1)>(vb_); } \
    asm volatile("s_waitcnt lgkmcnt(8)" ::: "memory"); SBAR(); o[2] = __builtin_amdgcn_mfma_f32_32x32x16_bf16(pa2, (bf16x8){vl2[0], vl2[1], vl2[2], vl2[3], vh2[0], vh2[1], vh2[2], vh2[3]}, o[2], 0, 0, 0); SBAR(); \
    { vl2 = tr_read<v_rd_off(3, 3, 0)>(vb_); vh2 = tr_read<v_rd_off(3, 3, 1)>(vb_); } \
    asm volatile("s_waitcnt lgkmcnt(8)" ::: "memory"); SBAR(); o[2] = __builtin_amdgcn_mfma_f32_32x32x16_bf16(pa3, (bf16x8){vl3[0], vl3[1], vl3[2], vl3[3], vh3[0], vh3[1], vh3[2], vh3[3]}, o[2], 0, 0, 0); SBAR(); \
    asm volatile("s_waitcnt lgkmcnt(6)" ::: "memory"); SBAR(); o[3] = __builtin_amdgcn_mfma_f32_32x32x16_bf16(pa0, (bf16x8){vl4[0], vl4[1], vl4[2], vl4[3], vh4[0], vh4[1], vh4[2], vh4[3]}, o[3], 0, 0, 0); SBAR(); \
    asm volatile("s_waitcnt lgkmcnt(4)" ::: "memory"); SBAR(); o[3] = __builtin_amdgcn_mfma_f32_32x32x16_bf16(pa1, (bf16x8){vl0[0], vl0[1], vl0[2], vl0[3], vh0[0], vh0[1], vh0[2], vh0[3]}, o[3], 0, 0, 0); SBAR(); \
    asm volatile("s_waitcnt lgkmcnt(2)" ::: "memory"); SBAR(); o[3] = __builtin_amdgcn_mfma_f32_32x32x16_bf16(pa2, (bf16x8){vl1[0], vl1[1], vl1[2], vl1[3], vh1[0], vh1[1], vh1[2], vh1[3]}, o[3], 0, 0, 0); SBAR(); \
    asm volatile("s_waitcnt lgkmcnt(0)" ::: "memory"); SBAR(); o[3] = __builtin_amdgcn_mfma_f32_32x32x16_bf16(pa3, (bf16x8){vl2[0], vl2[1], vl2[2], vl2[3], vh2[0], vh2[1], vh2[2], vh2[3]}, o[3], 0, 0, 0); SBAR(); \
} while (0)
#define M4_XFIRST(KS, VS) do { \
    int xn_ = xkn, xr_ = xkr; asm volatile("" : "+v"(xn_), "+v"(xr_)); \
    const int kbn_ = (int)(uintptr_t)(lds + M2_OFF_K + (KS) * M2_KSLOT) + r32 * 256, kbr_ = (int)(uintptr_t)(lds + M2_OFF_K + (KS) * M2_KSLOT + KN_BYTES) + r32 * 128; \
    const int vb_ = (int)(uintptr_t)(lds + M2_OFF_V + (VS) * V_BYTES) + vlane; (void)vb_; \
    bf16x8 ka0, ka1, ka2, ka3, ka4, kb0, kb1, kb2, kb3, kb4; s16x4 vl0, vl1, vl2, vl3, vl4, vh0, vh1, vh2, vh3, vh4; \
    p0 = f32x16{}; p1 = f32x16{}; \
    { const int a_ = kbn_ + (((0) * 32 + hb) ^ xn_); ka0 = lds_rd128<0>(a_); kb0 = lds_rd128<8192>(a_); } \
    { const int a_ = kbn_ + (((1) * 32 + hb) ^ xn_); ka1 = lds_rd128<0>(a_); kb1 = lds_rd128<8192>(a_); } \
    { const int a_ = kbn_ + (((2) * 32 + hb) ^ xn_); ka2 = lds_rd128<0>(a_); kb2 = lds_rd128<8192>(a_); } \
    { const int a_ = kbn_ + (((3) * 32 + hb) ^ xn_); ka3 = lds_rd128<0>(a_); kb3 = lds_rd128<8192>(a_); } \
    { const int a_ = kbn_ + (((4) * 32 + hb) ^ xn_); ka4 = lds_rd128<0>(a_); kb4 = lds_rd128<8192>(a_); } \
    asm volatile("s_waitcnt lgkmcnt(8)" ::: "memory"); SBAR(); p0 = __builtin_amdgcn_mfma_f32_32x32x16_bf16(ka0, qr[0], p0, 0, 0, 0); p1 = __builtin_amdgcn_mfma_f32_32x32x16_bf16(kb0, qr[0], p1, 0, 0, 0); SBAR(); \
    { const int a_ = kbn_ + (((5) * 32 + hb) ^ xn_); ka0 = lds_rd128<0>(a_); kb0 = lds_rd128<8192>(a_); } \
    asm volatile("s_waitcnt lgkmcnt(8)" ::: "memory"); SBAR(); p0 = __builtin_amdgcn_mfma_f32_32x32x16_bf16(ka1, qr[1], p0, 0, 0, 0); p1 = __builtin_amdgcn_mfma_f32_32x32x16_bf16(kb1, qr[1], p1, 0, 0, 0); SBAR(); \
    { const int a_ = kbn_ + (((6) * 32 + hb) ^ xn_); ka1 = lds_rd128<0>(a_); kb1 = lds_rd128<8192>(a_); } \
    asm volatile("s_waitcnt lgkmcnt(8)" ::: "memory"); SBAR(); p0 = __builtin_amdgcn_mfma_f32_32x32x16_bf16(ka2, qr[2], p0, 0, 0, 0); p1 = __builtin_amdgcn_mfma_f32_32x32x16_bf16(kb2, qr[2], p1, 0, 0, 0); SBAR(); \
    { const int a_ = kbn_ + (((7) * 32 + hb) ^ xn_); ka2 = lds_rd128<0>(a_); kb2 = lds_rd128<8192>(a_); } \
    asm volatile("s_waitcnt lgkmcnt(8)" ::: "memory"); SBAR(); p0 = __builtin_amdgcn_mfma_f32_32x32x16_bf16(ka3, qr[3], p0, 0, 0, 0); p1 = __builtin_amdgcn_mfma_f32_32x32x16_bf16(kb3, qr[3], p1, 0, 0, 0); SBAR(); \
    { const int a_ = kbr_ + (((0) * 32 + hb) ^ xr_); ka3 = lds_rd128<0>(a_); kb3 = lds_rd128<4096>(a_); } \
    asm volatile("s_waitcnt lgkmcnt(8)" ::: "memory"); SBAR(); p0 = __builtin_amdgcn_mfma_f32_32x32x16_bf16(ka4, qr[4], p0, 0, 0, 0); p1 = __builtin_amdgcn_mfma_f32_32x32x16_bf16(kb4, qr[4], p1, 0, 0, 0); SBAR(); \
    { const int a_ = kbr_ + (((1) * 32 + hb) ^ xr_); ka4 = lds_rd128<0>(a_); kb4 = lds_rd128<4096>(a_); } \
    asm volatile("s_waitcnt lgkmcnt(8)" ::: "memory"); SBAR(); p0 = __builtin_amdgcn_mfma_f32_32x32x16_bf16(ka0, qr[5], p0, 0, 0, 0); p1 = __builtin_amdgcn_mfma_f32_32x32x16_bf16(kb0, qr[5], p1, 0, 0, 0); SBAR(); \
    { const int a_ = kbr_ + (((2) * 32 + hb) ^ xr_); ka0 = lds_rd128<0>(a_); kb0 = lds_rd128<4096>(a_); } \
    asm volatile("s_waitcnt lgkmcnt(8)" ::: "memory"); SBAR(); p0 = __builtin_amdgcn_mfma_f32_32x32x16_bf16(ka1, qr[6], p0, 0, 0, 0); p1 = __builtin_amdgcn_mfma_f32_32x32x16_bf16(kb1, qr[6], p1, 0, 0, 0); SBAR(); \
    { const int a_ = kbr_ + (((3) * 32 + hb) ^ xr_); ka1 = lds_rd128<0>(a_); kb1 = lds_rd128<4096>(a_); } \
    asm volatile("s_waitcnt lgkmcnt(8)" ::: "memory"); SBAR(); p0 = __builtin_amdgcn_mfma_f32_32x32x16_bf16(ka2, qr[7], p0, 0, 0, 0); p1 = __builtin_amdgcn_mfma_f32_32x32x16_bf16(kb2, qr[7], p1, 0, 0, 0); SBAR(); \
    asm volatile("s_waitcnt lgkmcnt(6)" ::: "memory"); SBAR(); p0 = __builtin_amdgcn_mfma_f32_32x32x16_bf16(ka3, qr[8], p0, 0, 0, 0); p1 = __builtin_amdgcn_mfma_f32_32x32x16_bf16(kb3, qr[8], p1, 0, 0, 0); SBAR(); \
    asm volatile("s_waitcnt lgkmcnt(4)" ::: "memory"); SBAR(); p0 = __builtin_amdgcn_mfma_f32_32x32x16_bf16(ka4, qr[9], p0, 0, 0, 0); p1 = __builtin_amdgcn_mfma_f32_32x32x16_bf16(kb4, qr[9], p1, 0, 0, 0); SBAR(); \
    asm volatile("s_waitcnt lgkmcnt(2)" ::: "memory"); SBAR(); p0 = __builtin_amdgcn_mfma_f32_32x32x16_bf16(ka0, qr[10], p0, 0, 0, 0); p1 = __builtin_amdgcn_mfma_f32_32x32x16_bf16(kb0, qr[10], p1, 0, 0, 0); SBAR(); \
    asm volatile("s_waitcnt lgkmcnt(0)" ::: "memory"); SBAR(); p0 = __builtin_amdgcn_mfma_f32_32x32x16_bf16(ka1, qr[11], p0, 0, 0, 0); p1 = __builtin_amdgcn_mfma_f32_32x32x16_bf16(kb1, qr[11], p1, 0, 0, 0); SBAR(); \
} while (0)

__device__ __forceinline__ void mla_unit4(lds_ptr lds, const bf16* __restrict__ Q, const bf16* __restrict__ KN, const bf16* __restrict__ KR, const bf16* __restrict__ V, bf16* __restrict__ OAB, int b, int h, int qb, const int tid_in) {
    int tid_ = tid_in; asm volatile("" : "+v"(tid_)); const int tid = tid_, lane = tid & 63, r32 = lane & 31, hi = lane >> 5; const int wid = __builtin_amdgcn_readfirstlane(tid >> 6);
    const bool metaq = (qb == 16);
    const bool wave_on = !metaq || wid == 0;
    const int qrow = metaq ? (TREAL + 16 * b + (r32 & 15)) : (b * SEQ + qb * 256 + wid * 32 + r32);
    __attribute__((address_space(3))) float* wsf = (__attribute__((address_space(3))) float*)(lds + M2_OFF_WS) + wid * 64;
    unsigned so_kn[2], so_kr, so_v[2];
#pragma unroll
    for (int i = 0; i < 2; ++i) { const int P = 2 * wid + i;
        { const int row = 4 * P + (lane >> 4), c = (lane & 15) ^ (row & 15); so_kn[i] = (unsigned)(row * 4096 + c * 16); }
        { const int q = 64 * P + lane, s = q >> 5, kk = (s >> 2) * 8 + ((q & 31) >> 2), col = (s & 3) * 32 + (q & 3) * 8, k = (kk & ~0xC) | ((kk & 4) << 1) | ((kk & 8) >> 1); so_v[i] = (unsigned)(k * 4096 + col * 2); } }
    { const int row = 8 * wid + (lane >> 3), c = (lane & 7) ^ ((row >> 1) & 7); so_kr = (unsigned)(row * 128 + c * 16); }
    const char* const kn_h = (const char*)KN + h * 256; const char* const v_h = (const char*)V + h * 256; const char* const kr_b = (const char*)KR;
    const size_t real0 = (size_t)b * SEQ, meta0 = (size_t)TREAL + 16 * b;
#define M3_ROW(t) ((t) == 0 ? meta0 : real0 + (size_t)((t) - 1) * 64)
#define M3_DMA(src, dstoff) __builtin_amdgcn_global_load_lds((const unsigned*)(src), (__attribute__((address_space(3))) unsigned*)(lds + (dstoff)), 16, 0, 0)
#define M3_DMA_K(t, slot) do { const size_t g_ = M3_ROW(t); const int so_ = M2_OFF_K + (slot) * M2_KSLOT; \
        M3_DMA(kn_h + g_ * 4096 + so_kn[0], so_ + (2 * wid) * 1024); M3_DMA(kn_h + g_ * 4096 + so_kn[1], so_ + (2 * wid + 1) * 1024); M3_DMA(kr_b + g_ * 128 + so_kr, so_ + KN_BYTES + wid * 1024); } while (0)
#define M3_DMA_V(t, slot) do { const size_t g_ = M3_ROW(t); const int so_ = M2_OFF_V + (slot) * V_BYTES; \
        M3_DMA(v_h + g_ * 4096 + so_v[0], so_ + (2 * wid) * 1024); M3_DMA(v_h + g_ * 4096 + so_v[1], so_ + (2 * wid + 1) * 1024); } while (0)
#define M3_WAIT(n) asm volatile("s_waitcnt vmcnt(" #n ")" ::: "memory")
#define M3_BAR() do { asm volatile("" ::: "memory"); __builtin_amdgcn_s_barrier(); asm volatile("" ::: "memory"); } while (0)
#define M3_EVENT(i, s3) do { if ((i) + 2 < M3_NT) M3_DMA_K((i) + 2, (s3) == 0 ? 2 : (s3) - 1); if ((i) + 1 < M3_NT) M3_DMA_V((i) + 1, (s3) == 2 ? 0 : (s3) + 1); } while (0)
#define M3_WAITI(i) do { if ((i) < M3_NT - 2) M3_WAIT(5); else M3_WAIT(0); } while (0)
    M3_DMA_K(0, 0); M3_DMA_V(0, 0); M3_DMA_K(1, 1);
    bf16x8 qr[12];
    { const bf16* qp = Q + (size_t)qrow * 3072 + h * 192 + hi * 8;
#pragma unroll
      for (int d0 = 0; d0 < 12; ++d0) qr[d0] = *reinterpret_cast<const bf16x8*>(qp + d0 * 16); }
    const int xkn = (r32 & 15) << 4, xkr = ((r32 >> 1) & 7) << 4, hb = hi * 16;
    const int vlane = v_rd_base(lane);
#define M3_PV(slot) pv_all(o, (int)(uintptr_t)(lds + M2_OFF_V + (slot) * V_BYTES) + vlane, pa0, pa1, pa2, pa3)
#define M3_Y(j) do { if (wave_on) { if ((j) == 0) { _Pragma("unroll") for (int r = 0; r < 16; ++r) { if (crow(r, hi) >= 16) p0[r] = NEG_BIG; p1[r] = NEG_BIG; } } \
        float alpha_; if ((j) == 0) softmax_seg<true, true>(p0, p1, m_reg, l_reg, alpha_, pa0, pa1, pa2, pa3); else softmax_seg<true, false>(p0, p1, m_reg, l_reg, alpha_, pa0, pa1, pa2, pa3); \
        if (__any(alpha_ < 1.f)) { if (hi == 0) wsf[r32] = alpha_; asm volatile("s_waitcnt lgkmcnt(0)" ::: "memory"); \
            _Pragma("unroll") for (int d = 0; d < 4; ++d) _Pragma("unroll") for (int r = 0; r < 16; ++r) o[d][r] *= wsf[crow(r, hi)]; } } } while (0)
    float m_reg = 0.f, l_reg = 0.f; f32x16 o[4];
#pragma unroll
    for (int d = 0; d < 4; ++d) o[d] = f32x16{};
    f32x16 p0, p1; bf16x8 pa0, pa1, pa2, pa3;
    int s3 = 0;
    if (wid < 4) {
        M3_WAITI(0); M3_BAR();
        if (wave_on) M4_XFIRST(0, 0);
        M3_BAR(); M3_EVENT(0, 0);
        M3_Y(0);
        s3 = 1;
        for (int j = 1; j < M3_NT; ++j) {
            M3_WAITI(j); M3_BAR();
            if (wave_on) { __builtin_amdgcn_s_setprio(3); M4_XFULL(s3, (s3 == 0 ? 2 : s3 - 1)); __builtin_amdgcn_s_setprio(0); }
            M3_BAR(); M3_EVENT(j, s3);
            M3_Y(j);
            s3 = s3 == 2 ? 0 : s3 + 1;
        }
        M3_BAR();
        if (wave_on) M3_PV(s3 == 0 ? 2 : s3 - 1);
        M3_BAR();
    } else {
        M3_WAITI(0); M3_BAR(); M3_EVENT(0, 0);
        M3_BAR();
        if (wave_on) M4_XFIRST(0, 0);
        M3_WAITI(1); M3_BAR(); M3_EVENT(1, 1);
        M3_Y(0);
        s3 = 1;
        for (int j = 1; j < M3_NT; ++j) {
            M3_BAR();
            if (wave_on) { __builtin_amdgcn_s_setprio(3); M4_XFULL(s3, (s3 == 0 ? 2 : s3 - 1)); __builtin_amdgcn_s_setprio(0); }
            M3_WAITI(j + 1); M3_BAR(); { const int s3n = s3 == 2 ? 0 : s3 + 1; M3_EVENT(j + 1, s3n); }
            M3_Y(j);
            s3 = s3 == 2 ? 0 : s3 + 1;
        }
        M3_BAR();
        if (wave_on) M3_PV(s3 == 0 ? 2 : s3 - 1);
    }
    if (wave_on) {
        if (hi == 0) wsf[32 + r32] = l_reg; asm volatile("s_waitcnt lgkmcnt(0)" ::: "memory");
        const int orow0 = metaq ? (TREAL + 16 * b) : (b * SEQ + qb * 256 + wid * 32);
#pragma unroll
        for (int r = 0; r < 16; ++r) { const int rw = crow(r, hi); const float rl = __builtin_amdgcn_rcpf(wsf[32 + rw]);
            if (!metaq || rw < 16) { bf16* op = OAB + (size_t)(orow0 + rw) * 4096 + h * 128 + r32;
#pragma unroll
                for (int d0 = 0; d0 < 4; ++d0) op[d0 * 32] = (bf16)(cvtpk(o[d0][r] * rl, 0.f) & 0xffffu); } }
    }
    M3_WAIT(0); M3_BAR();
#undef M3_ROW
#undef M3_DMA
#undef M3_DMA_K
#undef M3_DMA_V
#undef M3_WAIT
#undef M3_BAR
#undef M3_EVENT
#undef M3_WAITI
#undef M3_PV
#undef M3_Y
}
#undef M4_XFULL
#undef M4_XFIRST
}
enum { I_X = 0, I_META, I_EMB_G, I_EMB_B, I_RELB, I_WIN, I_QNG, I_KVNG, I_WUQ, I_WUKV, I_SINK, I_WPA, I_WPB, I_WOUT, I_LMG, I_LMB, I_LFG, I_LFB,
       I_FW1, I_FW3, I_FW2, I_RW, I_RB, I_MW1, I_MW3, I_MW2, N_IN };
constexpr int NWAVES = 8;
constexpr int N_PHASES = 20;
constexpr size_t MiB = 1u << 20, KiB32 = 32768;
constexpr size_t WS_CTL = 0, CTL_ZERO_BYTES = 65536;
constexpr size_t WS_CS = 1 * MiB, WS_SN = WS_CS + 540672;
constexpr size_t WS_BIAS = 3 * MiB;
constexpr size_t WS_TW = WS_BIAS, WS_TM = WS_BIAS + 32768, WS_SINK = WS_BIAS + 49152;
constexpr size_t WS_WHIST = WS_BIAS + 65536;
constexpr size_t WS_TOPI = 4 * MiB, WS_TOPG = WS_TOPI + 262144, WS_TOKSLOT = WS_TOPG + 262144;
constexpr size_t WS_SLOTTOK = 5 * MiB, WS_SLOTGATE = WS_SLOTTOK + 294912;
constexpr size_t WS_SSQ = 6 * MiB;
constexpr size_t WS_HB = 9 * MiB;
constexpr size_t WS_W = 138 * MiB;
constexpr size_t WL_IN = 0, WL_UQ = 34 * MiB, WL_UKV = WL_UQ + 9 * MiB / 2, WL_AB = WL_UKV + 4 * MiB, WL_OUT = WL_AB + 16 * MiB, WL_STRIDE = WL_OUT + 8 * MiB;
constexpr size_t WS_WF13 = WS_W + 2 * WL_STRIDE, WS_WF2 = WS_WF13 + 44 * MiB, WS_WEND = WS_WF2 + 22 * MiB;
constexpr size_t AR = 337 * MiB;
constexpr size_t WS_CQ = AR, WS_CKV = WS_CQ + 1548 * KiB32, WS_KR = WS_CKV + 1032 * KiB32, WS_QB = WS_KR + 132 * KiB32;
constexpr size_t WS_KB = WS_QB + 129 * MiB, WS_VB = WS_KB + 1032 * KiB32, WS_GR = WS_VB + 1032 * KiB32, WS_GBB = WS_GR + 129 * MiB;
constexpr size_t WS_Q = WS_GBB + 129 * MiB, WS_KN = WS_Q + 6192 * KiB32  , WS_V = WS_KN + 129 * MiB, WS_OAB = WS_V + 129 * MiB, WS_MIX_END = WS_OAB + 258 * MiB;
constexpr size_t WS_MG = WS_Q;
constexpr size_t WS_X = WS_OAB;
constexpr size_t WS_ACT = AR;
constexpr size_t WS_MACT = 337 * MiB;
constexpr size_t WS_Y = 1265 * MiB;
constexpr size_t WS_YP = WS_Y + 264 * MiB;
constexpr size_t WS_XP = 1672 * MiB;
constexpr size_t WS_END = WS_XP + 4 * MiB;
static_assert(MW_E5 == WS_W && MW_E5 + MW_E <= WS_W + WL_STRIDE, "expert 5 over layer 0's mixer weights only");
static_assert(MW_E6 >= WS_WF13 && MW_E6 + MW_E <= WS_WEND && WS_WEND <= WS_MACT, "expert 6 over the dense FFN weights only");
static_assert(MW_E7B >= WS_W + WL_STRIDE + WL_IN && MW_E7B + 22 * MiB <= WS_W + WL_STRIDE + WL_UQ, "expert 7 w2 over layer 1's w_in copy only");
static_assert(MW_E7A >= WS_KN && MW_E7A + 44 * MiB <= WS_V && WS_MACT + 726 * MiB <= MW_E7A && MW_E7A + 44 * MiB <= WS_Y, "expert 7 w13 over the MLA K buffer only");
static_assert(MW_B >= WS_MIX_END && MW_B + 88 * MiB <= WS_XP && WS_YP + 24 * MiB <= MW_B, "free tail");
static_assert(WS_MIX_END <= 1700 * MiB && WS_END <= 1700 * MiB, "d_ws map");
static_assert(WS_ACT + (size_t)TP * DFF * 2 <= WS_X, "dense ACT vs X");
static_assert(WS_SSQ + (size_t)TP * 20 * 4 <= WS_HB && WS_SLOTGATE + 294912 <= WS_SSQ && WS_TOKSLOT + 262144 <= WS_SLOTTOK && WS_SN + 540672 <= WS_BIAS, "small tables");
static_assert(WS_KR + (size_t)TP * 64 * 2 <= WS_QB, "KR");
constexpr int CW_TMO = 0, CW_CODE = 1;
constexpr int CW_ATT = 100;
constexpr int CW_FILL = 104;
constexpr int CW_MOE_TS = 64;
constexpr int CW_BAR = 4096;
constexpr int RING_OFF = 0, RING_BYTES = 131072;
constexpr int LDSCTL_OFF = RING_BYTES, MISC_OFF = LDSCTL_OFF + 320, PT_OFF = LDSCTL_OFF + 512;
constexpr int LDS_BYTES = 147456;
static_assert(att::ATT_LDS_BYTES <= RING_BYTES && att::M2_LDS_BYTES <= RING_BYTES && att::S2_LDS_BYTES <= RING_BYTES, "attention LDS");

#define GAS __attribute__((address_space(1)))
#define LAS __attribute__((address_space(3)))
typedef unsigned short bf16;
typedef unsigned v4u __attribute__((ext_vector_type(4)));
typedef unsigned v2u __attribute__((ext_vector_type(2)));
typedef float f32x4 __attribute__((ext_vector_type(4)));
typedef GAS unsigned gu32;
#define RLX_AGENT __ATOMIC_RELAXED, __HIP_MEMORY_SCOPE_AGENT
#define LDS_WAIT() asm volatile("s_waitcnt lgkmcnt(0)" ::: "memory")
#define VM_WAIT() asm volatile("s_waitcnt vmcnt(0)" ::: "memory")
__device__ __forceinline__ unsigned f2bf(float f) { unsigned u = __builtin_bit_cast(unsigned, f); return (u + 0x7fffu + ((u >> 16) & 1u)) >> 16; }
__device__ __forceinline__ unsigned pk2(float lo, float hi) { return pg8::cvt_pk_bf16(lo, hi); }

#define XB_TMO      128
#define XB_XCNT(j)  (256  + 64 * (j))
#define XB_XSUB(j)  (1280 + 64 * (j))
#define XB_XGEN(j)  (2304 + 64 * (j))
#define XB_TOP      3328
#define XB_TOPGEN   3392
#define XCD_BAR_WORDS 3456
#define XB_SPIN_CAP (1u << 22)
__device__ __forceinline__ unsigned xb_ld(unsigned* p)              { return __hip_atomic_load(p, __ATOMIC_RELAXED, __HIP_MEMORY_SCOPE_AGENT); }
__device__ __forceinline__ unsigned xb_add(unsigned* p, unsigned v) { return __hip_atomic_fetch_add(p, v, __ATOMIC_RELAXED, __HIP_MEMORY_SCOPE_AGENT); }
__device__ __forceinline__ unsigned xb_xcc_id() { return (unsigned)__builtin_amdgcn_s_getreg((3 << 11) | 20) & 0xFu; }
#define XB_SPIN(cond, bar) do { unsigned _sp = 0; while (cond) { __builtin_amdgcn_s_sleep(1); \
    if ((++_sp & 255u) == 0u) { if (xb_ld(&(bar)[XB_TMO])) break; if (_sp > XB_SPIN_CAP) { atomicAdd(&(bar)[XB_TMO], 1u); break; } } } } while (0)
struct XcdBarrier { unsigned* bar; unsigned x; volatile LAS unsigned* st; };
__device__ __forceinline__ XcdBarrier xcd_barrier_post(unsigned* bar, volatile LAS unsigned* st, const int tid) {
    XcdBarrier b; b.bar = bar; b.x = xb_xcc_id(); b.st = st;
    if (tid == 0) (void)xb_add(&bar[XB_XCNT(b.x)], 1u);
    return b;
}
__device__ __forceinline__ void xcd_barrier_complete(unsigned* bar, unsigned x, unsigned& nloc, unsigned& nx) {
    const unsigned G = gridDim.x * gridDim.y * gridDim.z;
    unsigned sum, cnt, mine, sp = 0u;
    for (;;) {
        sum = 0u; cnt = 0u; mine = 0u;
#pragma unroll
        for (unsigned j = 0; j < 16; ++j) { const unsigned c = xb_ld(&bar[XB_XCNT(j)]); sum += c; cnt += (c > 0u) ? 1u : 0u; mine = (j == x) ? c : mine; }
        if (sum == G) break;
        __builtin_amdgcn_s_sleep(1);
        if ((++sp & 255u) == 0u) { if (xb_ld(&bar[XB_TMO])) break; if (sp > XB_SPIN_CAP) { atomicAdd(&bar[XB_TMO], 1u); break; } }
    }
    nloc = mine > 0u ? mine : 1u; nx = cnt > 0u ? cnt : 1u;
}
__device__ __forceinline__ void xcd_barrier(const XcdBarrier& b, const int tid) {
    asm volatile("s_waitcnt vmcnt(0)" ::: "memory");
    __syncthreads();
    if (tid == 0) {
        unsigned* bar = b.bar;
        __builtin_amdgcn_s_waitcnt(0);
        unsigned nloc = b.st[0], nx = b.st[1];
        if (nloc == 0u) { xcd_barrier_complete(bar, b.x, nloc, nx); b.st[0] = nloc; b.st[1] = nx; }
        const unsigned old = xb_add(&bar[XB_XSUB(b.x)], 1u);
        const unsigned gen = old / nloc;
        if (old + 1u == (gen + 1u) * nloc) {
            __builtin_amdgcn_fence(__ATOMIC_RELEASE, "agent");
            asm volatile("s_waitcnt vmcnt(0)" ::: "memory");
            const unsigned og = xb_add(&bar[XB_TOP], 1u);
            const unsigned tg = og / nx;
            if (og + 1u == (tg + 1u) * nx) xb_add(&bar[XB_TOPGEN], 1u);
            else XB_SPIN(xb_ld(&bar[XB_TOPGEN]) == tg, bar);
            __builtin_amdgcn_fence(__ATOMIC_ACQUIRE, "agent");
            xb_add(&bar[XB_XGEN(b.x)], 1u);
            asm volatile("s_waitcnt vmcnt(0)" ::: "memory");
        } else {
            XB_SPIN(xb_ld(&bar[XB_XGEN(b.x)]) == gen, bar);
            __builtin_amdgcn_fence(__ATOMIC_ACQUIRE, "agent");
            asm volatile("s_waitcnt vmcnt(0)" ::: "memory");
        }
    }
    __syncthreads();
}

__device__ __forceinline__ int lane_id() { int l; asm volatile("v_mbcnt_lo_u32_b32 %0, -1, 0\n\tv_mbcnt_hi_u32_b32 %0, -1, %0" : "=v"(l)); return l; }
__device__ __forceinline__ float dpp_add(float v, const int ctrl_tag) {
    int r;
    if (ctrl_tag == 0) r = __builtin_amdgcn_update_dpp(0, __float_as_int(v), 0xB1, 0xF, 0xF, true);
    else if (ctrl_tag == 1) r = __builtin_amdgcn_update_dpp(0, __float_as_int(v), 0x4E, 0xF, 0xF, true);
    else if (ctrl_tag == 2) r = __builtin_amdgcn_update_dpp(0, __float_as_int(v), 0x141, 0xF, 0xF, true);
    else r = __builtin_amdgcn_update_dpp(0, __float_as_int(v), 0x140, 0xF, 0xF, true);
    return v + __int_as_float(r);
}
__device__ __forceinline__ float wave_sum(float v) {
    v = dpp_add(v, 0); v = dpp_add(v, 1); v = dpp_add(v, 2); v = dpp_add(v, 3);
    const float r0 = __int_as_float(__builtin_amdgcn_readlane(__float_as_int(v), 0)), r1 = __int_as_float(__builtin_amdgcn_readlane(__float_as_int(v), 16));
    const float r2 = __int_as_float(__builtin_amdgcn_readlane(__float_as_int(v), 32)), r3 = __int_as_float(__builtin_amdgcn_readlane(__float_as_int(v), 48));
    return (r0 + r1) + (r2 + r3);
}
__device__ __forceinline__ void transpose_item(const float* __restrict__ W, int ldw, int k0, int n0, bf16* __restrict__ WT, size_t ldt, int drow, int koff, const float* __restrict__ g, LAS float* scr, int lane) {
    const int kr = lane >> 3, c4 = (lane & 7) * 4;
    f32x4 v[8];
#pragma unroll
    for (int i = 0; i < 8; ++i) v[i] = *(const GAS f32x4*)(W + (size_t)(k0 + 8 * i + kr) * ldw + n0 + c4);
    if (g) {
#pragma unroll
        for (int i = 0; i < 8; ++i) v[i] = v[i] * g[k0 + 8 * i + kr]; }
#pragma unroll
    for (int i = 0; i < 8; ++i) { LAS float* d = scr + (8 * i + kr) * 33 + c4; d[0] = v[i].x; d[1] = v[i].y; d[2] = v[i].z; d[3] = v[i].w; }
    LDS_WAIT(); asm volatile("" ::: "memory");
    const int c = lane & 7;
#pragma unroll
    for (int j = 0; j < 4; ++j) { const int n = (lane >> 3) + 8 * j; const LAS float* s = scr + (8 * c) * 33 + n;
        v4u o; o.x = pk2(s[0 * 33], s[1 * 33]); o.y = pk2(s[2 * 33], s[3 * 33]); o.z = pk2(s[4 * 33], s[5 * 33]); o.w = pk2(s[6 * 33], s[7 * 33]);
        *(GAS v4u*)(WT + (size_t)(drow + n) * ldt + koff + k0 + 8 * c) = o; }
    LDS_WAIT(); asm volatile("" ::: "memory");
}
struct TDesc { const float* W; bf16* WT; size_t ldt; int ldw, k0, n0, drow; };
__device__ __forceinline__ void t_load(const TDesc& d, f32x4 (&v)[8], int lane) {
    const int kr = lane >> 3, c4 = (lane & 7) * 4;
#pragma unroll
    for (int i = 0; i < 8; ++i) v[i] = __builtin_nontemporal_load((const GAS f32x4*)(d.W + (size_t)(d.k0 + 8 * i + kr) * d.ldw + d.n0 + c4));
}
__device__ __forceinline__ void t_finish(const TDesc& d, const f32x4 (&v)[8], LAS float* scr, int lane) {
    const int kr = lane >> 3, c4 = (lane & 7) * 4;
#pragma unroll
    for (int i = 0; i < 8; ++i) { LAS float* p = scr + (8 * i + kr) * 33 + c4; p[0] = v[i].x; p[1] = v[i].y; p[2] = v[i].z; p[3] = v[i].w; }
    LDS_WAIT(); asm volatile("" ::: "memory");
    const int c = lane & 7;
#pragma unroll
    for (int j = 0; j < 4; ++j) { const int n = (lane >> 3) + 8 * j; const LAS float* s = scr + (8 * c) * 33 + n;
        v4u o; o.x = pk2(s[0 * 33], s[1 * 33]); o.y = pk2(s[2 * 33], s[3 * 33]); o.z = pk2(s[4 * 33], s[5 * 33]); o.w = pk2(s[6 * 33], s[7 * 33]);
        __builtin_nontemporal_store(o, (GAS v4u*)(d.WT + (size_t)(d.drow + n) * d.ldt + d.k0 + 8 * c)); }
    LDS_WAIT(); asm volatile("" ::: "memory");
}
__device__ __forceinline__ int dmap_in(int n0) {
    if (n0 < 1280) return n0;
    if (n0 < 1312) return 1280;
    if (n0 < 1344) return 1280 + 128;
    if (n0 < 3392) return 1536 + (n0 - 1344);
    if (n0 < 3904) return 3584 + (n0 - 3392);
    if (n0 < 4416) return 4096 + (n0 - 3904);
    if (n0 < 6464) { const int a = n0 - 4416; return 4608 + 256 * (a >> 7) + (a & 127); }
    const int a = n0 - 6464; return 4608 + 256 * (a >> 7) + 128 + (a & 127);
}
__device__ __forceinline__ int dmap_uq(int n0) {
    const int head = n0 / 192, off = n0 - head * 192;
    if (off < 128) return 256 * (head >> 1) + 128 * (head & 1) + off;
    if (off < 160) return 256 * (8 + (head >> 2)) + 32 * (head & 3);
    return 256 * (8 + (head >> 2)) + 128 + 32 * (head & 3);
}
__device__ __forceinline__ int dmap_glu(int n0) { return 256 * (n0 >> 7) + (n0 & 127); }
constexpr int DI_IN = (D / 64) * (INDIM / 32), DI_UQ = (QRANK / 64) * (3072 / 32), DI_UKV = (KVRANK / 64) * (4096 / 32), DI_SQ = (D / 64) * (D / 32), DI_LAYER = DI_IN + DI_UQ + DI_UKV + 3 * DI_SQ;
constexpr int DI_F = (D / 64) * (DFF / 32), DI_F2 = (DFF / 64) * (D / 32), DI_N = 2 * DI_LAYER + 2 * DI_F + DI_F2, DI_DEFER = DI_N - DI_LAYER;
static_assert(DI_DEFER % 8 == 0, "claim granularity");
__device__ __forceinline__ const float* pt_in(LAS unsigned char* lds, int i) {
    const unsigned long long v = ((volatile LAS unsigned long long*)(lds + PT_OFF))[i];
    const unsigned long long u = (unsigned long long)(unsigned)__builtin_amdgcn_readfirstlane((int)(unsigned)v) | ((unsigned long long)(unsigned)__builtin_amdgcn_readfirstlane((int)(unsigned)(v >> 32)) << 32);
    return (const float*)(const GAS float*)u; }
__device__ __forceinline__ void dense_item(const int it, LAS unsigned char* lds, unsigned char* ws, LAS float* scr, int lane) {
#define PIN(i) pt_in(lds, (i))
    constexpr int I_IN = DI_IN, I_UQ = DI_UQ, I_UKV = DI_UKV, I_SQ = DI_SQ, I_LAYER = DI_LAYER, I_F = DI_F; (void)I_SQ;
            int r = it;
            if (r < 2 * I_LAYER) { const int l = r / I_LAYER; r -= l * I_LAYER; unsigned char* wl = ws + WS_W + l * WL_STRIDE;
                if (r < I_IN) { const int nblk = INDIM / 32, kb = r / nblk, nb = r % nblk; transpose_item(PIN(I_WIN) + (size_t)l * D * INDIM, INDIM, 64 * kb, 32 * nb, (bf16*)(ws + WS_W + l * WL_STRIDE + WL_IN), D, dmap_in(32 * nb), 0, nullptr, scr, lane); return; } r -= I_IN;
                if (r < I_UQ) { const int nblk = 3072 / 32, kb = r / nblk, nb = r % nblk; transpose_item(PIN(I_WUQ) + (size_t)l * QRANK * 3072, 3072, 64 * kb, 32 * nb, (bf16*)(ws + WS_W + l * WL_STRIDE + WL_UQ), QRANK, dmap_uq(32 * nb), 0, PIN(I_QNG) + l * QRANK, scr, lane); return; } r -= I_UQ;
                if (r < I_UKV) { const int nblk = 4096 / 32, kb = r / nblk, nb = r % nblk; transpose_item(PIN(I_WUKV) + (size_t)l * KVRANK * 4096, 4096, 64 * kb, 32 * nb, (bf16*)(ws + WS_W + l * WL_STRIDE + WL_UKV), KVRANK, 32 * nb, 0, PIN(I_KVNG) + l * KVRANK, scr, lane); return; } r -= I_UKV;
                { const int which = r / I_SQ; r -= which * I_SQ; const int nblk = D / 32, kb = r / nblk, nb = r % nblk;
                  if (which == 0) transpose_item(PIN(I_WPA) + (size_t)l * D * D, D, 64 * kb, 32 * nb, (bf16*)(ws + WS_W + l * WL_STRIDE + WL_AB), 2 * D, 32 * nb, 0, nullptr, scr, lane);
                  else if (which == 1) transpose_item(PIN(I_WPB) + (size_t)l * D * D, D, 64 * kb, 32 * nb, (bf16*)(ws + WS_W + l * WL_STRIDE + WL_AB), 2 * D, 32 * nb, D, nullptr, scr, lane);
                  else transpose_item(PIN(I_WOUT) + (size_t)l * D * D, D, 64 * kb, 32 * nb, (bf16*)(ws + WS_W + l * WL_STRIDE + WL_OUT), D, 32 * nb, 0, nullptr, scr, lane);
                  return; }
            }
            r -= 2 * I_LAYER;
            if (r < 2 * I_F) { const int which = r / I_F; r -= which * I_F; const int nblk = DFF / 32, kb = r / nblk, nb = r % nblk;
                transpose_item(PIN(which ? I_FW3 : I_FW1), DFF, 64 * kb, 32 * nb, (bf16*)(ws + WS_WF13), D, dmap_glu(32 * nb) + (which ? 128 : 0), 0, nullptr, scr, lane); return; }
            r -= 2 * I_F;
            { const int nblk = D / 32, kb = r / nblk, nb = r % nblk; transpose_item(PIN(I_FW2), D, 64 * kb, 32 * nb, (bf16*)(ws + WS_WF2), DFF, 32 * nb, 0, nullptr, scr, lane); }
#undef PIN
}
constexpr int MC_IF = (D / 64) * (DFF / 32), MC_IF2 = (DFF / 64) * (D / 32), MC_IE = 2 * MC_IF + MC_IF2, MC_NIT = NE * MC_IE, MC_EARLY = 5 * MC_IE;
static_assert(MC_IE % 8 == 0, "claim granularity");
__device__ __forceinline__ int mc_start(int li) { return li == 0 ? 0 : (4 + li) * MC_IE; }
__device__ __forceinline__ int mc_count(int li) { return li == 0 ? MC_EARLY : MC_IE; }
__device__ __forceinline__ int mc_minseam(int li) { return li == 0 ? 0 : (li == 1 ? 6 : (li == 2 ? 9 : 13)); }
struct MoeConv { const float* mw1; const float* mw3; const float* mw2; const char* out; const char* ws; unsigned* ctr; };
__device__ __forceinline__ void moe_desc(const MoeConv& c, int it, TDesc& d) {
    const int e = it / MC_IE; int r = it - e * MC_IE;
    if (r < 2 * MC_IF) { const int wh = r / MC_IF; r -= wh * MC_IF; const int kb = r / (DFF / 32), nb = r % (DFF / 32);
        d.W = (wh ? c.mw3 : c.mw1) + (size_t)e * D * DFF; d.ldw = DFF; d.k0 = 64 * kb; d.n0 = 32 * nb; d.WT = (bf16*)moe_w13(e, c.out, c.ws); d.ldt = D; d.drow = dmap_glu(32 * nb) + (wh ? 128 : 0); }
    else { r -= 2 * MC_IF; const int kb = r / (D / 32), nb = r % (D / 32);
        d.W = c.mw2 + (size_t)e * DFF * D; d.ldw = D; d.k0 = 64 * kb; d.n0 = 32 * nb; d.WT = (bf16*)moe_w2(e, c.out, c.ws); d.ldt = DFF; d.drow = 32 * nb; }
}
template <int NPW>
__device__ __forceinline__ void moe_conv_run(const MoeConv& c, int base, int wave, int lane, LAS float* scr) {
    TDesc da{}, db{}; f32x4 va[8] = {}, vb[8] = {};
    const int lim = base < MC_EARLY ? MC_EARLY : (base / MC_IE + 1) * MC_IE;
    int it = base + wave; if (it < lim) { moe_desc(c, it, da); t_load(da, va, lane); }
#pragma unroll 1
    for (int j = 0; j < NPW; j += 2) { const int it1 = it + 8, it2 = it + 16; const bool h1 = (j + 1 < NPW) && it1 < lim, h2 = (j + 2 < NPW) && it2 < lim;
        if (h1) { moe_desc(c, it1, db); t_load(db, vb, lane); }
        if (it < lim) t_finish(da, va, scr, lane);
        if (h1) { if (h2) { moe_desc(c, it2, da); t_load(da, va, lane); } t_finish(db, vb, scr, lane); }
        it = it2; }
}
__device__ __forceinline__ unsigned moe_claim(const MoeConv& c, unsigned n, int seam, unsigned& mask) {
    if (seam <= 5 && !(mask & 16u)) { const unsigned b = xb_add(c.ctr + 4, n); if (b < (unsigned)DI_DEFER) return (unsigned)MC_NIT + 1u + b; mask |= 16u; }
#pragma unroll
    for (int li = 0; li < 4; ++li) if (seam >= mc_minseam(li) && !(mask & (1u << li))) { const unsigned b = xb_add(c.ctr + li, n); if (b < (unsigned)mc_count(li)) return (unsigned)mc_start(li) + b; mask |= 1u << li; }
    return (unsigned)MC_NIT;
}
__device__ __forceinline__ void xcd_barrier_fill(const XcdBarrier& b, const int tid, const MoeConv& mc, const int seam, LAS unsigned char* lds) {
    asm volatile("s_waitcnt vmcnt(0)" ::: "memory");
    __syncthreads();
    unsigned gen = 0u;
    if (tid == 0) {
        unsigned* bar = b.bar;
        __builtin_amdgcn_s_waitcnt(0);
        unsigned nloc = b.st[0], nx = b.st[1];
        if (nloc == 0u) { xcd_barrier_complete(bar, b.x, nloc, nx); b.st[0] = nloc; b.st[1] = nx; }
        const unsigned old = xb_add(&bar[XB_XSUB(b.x)], 1u);
        gen = old / nloc;
        if (old + 1u == (gen + 1u) * nloc) {
            __builtin_amdgcn_fence(__ATOMIC_RELEASE, "agent");
            asm volatile("s_waitcnt vmcnt(0)" ::: "memory");
            const unsigned og = xb_add(&bar[XB_TOP], 1u);
            const unsigned tg = og / nx;
            if (og + 1u == (tg + 1u) * nx) xb_add(&bar[XB_TOPGEN], 1u);
            else XB_SPIN(xb_ld(&bar[XB_TOPGEN]) == tg, bar);
            __builtin_amdgcn_fence(__ATOMIC_ACQUIRE, "agent");
            xb_add(&bar[XB_XGEN(b.x)], 1u);
            asm volatile("s_waitcnt vmcnt(0)" ::: "memory");
            b.st[2] = 1u;
        } else b.st[2] = 0u;
    }
    __syncthreads();
    const int wave = __builtin_amdgcn_readfirstlane(tid >> 6), lane = tid & 63;
    LAS float* scr = (LAS float*)(lds + RING_OFF + wave * 16384);
    unsigned done = b.st[2];
#pragma unroll 1
    while (done == 0u) {
        __syncthreads();
        if (tid == 0) {
            unsigned* bar = b.bar;
            if (xb_ld(&bar[XB_XGEN(b.x)]) != gen) { __builtin_amdgcn_fence(__ATOMIC_ACQUIRE, "agent"); asm volatile("s_waitcnt vmcnt(0)" ::: "memory"); b.st[2] = 1u; }
            else { unsigned mask = b.st[4]; const unsigned base = moe_claim(mc, 8u, seam, mask); b.st[4] = mask;
                if (base == (unsigned)MC_NIT) {
                    XB_SPIN(xb_ld(&bar[XB_XGEN(b.x)]) == gen, bar);
                    __builtin_amdgcn_fence(__ATOMIC_ACQUIRE, "agent"); asm volatile("s_waitcnt vmcnt(0)" ::: "memory"); b.st[2] = 1u; }
                else b.st[3] = base; }
        }
        __syncthreads();
        done = b.st[2];
        if (done == 0u) { const unsigned base = b.st[3];
            if (base > (unsigned)MC_NIT) dense_item(DI_LAYER + (int)(base - (unsigned)MC_NIT - 1u) + wave, lds, (unsigned char*)mc.ws, scr, lane);
            else moe_conv_run<1>(mc, (int)base, wave, lane, scr);
            asm volatile("s_waitcnt vmcnt(0)" ::: "memory"); }
    }
    __syncthreads();
}

struct Row8 { f32x4 v[8]; };
__device__ __forceinline__ void ln_normalize(Row8& r) {
    float s = 0.f;
#pragma unroll
    for (int j = 0; j < 8; ++j) s += (r.v[j].x + r.v[j].y) + (r.v[j].z + r.v[j].w);
    const float mean = wave_sum(s) * (1.f / D); float s2 = 0.f;
#pragma unroll
    for (int j = 0; j < 8; ++j) { r.v[j] = r.v[j] - mean; s2 += (r.v[j].x * r.v[j].x + r.v[j].y * r.v[j].y) + (r.v[j].z * r.v[j].z + r.v[j].w * r.v[j].w); }
    const float rstd = __builtin_amdgcn_rsqf(wave_sum(s2) * (1.f / D) + LN_EPS);
#pragma unroll
    for (int j = 0; j < 8; ++j) r.v[j] = r.v[j] * rstd;
}
__device__ __forceinline__ void ln_affine(Row8& r, const float* __restrict__ g, const float* __restrict__ b, int lane) {
#pragma unroll
    for (int jj = 0; jj < 4; ++jj) { const f32x4* gp = (const f32x4*)g + 2 * (lane + 64 * jj); const f32x4* bp = (const f32x4*)b + 2 * (lane + 64 * jj);
        r.v[2 * jj] = r.v[2 * jj] * gp[0] + bp[0]; r.v[2 * jj + 1] = r.v[2 * jj + 1] * gp[1] + bp[1]; }
}
__device__ __forceinline__ void ln_affine_r(Row8& r, const Row8& gv, const Row8& bv) {
#pragma unroll
    for (int j = 0; j < 8; ++j) r.v[j] = r.v[j] * gv.v[j] + bv.v[j];
}
__device__ __forceinline__ void row_store_bf16(const Row8& r, bf16* orow, int lane) {
#pragma unroll
    for (int jj = 0; jj < 4; ++jj) { v4u w; w.x = pk2(r.v[2 * jj].x, r.v[2 * jj].y); w.y = pk2(r.v[2 * jj].z, r.v[2 * jj].w); w.z = pk2(r.v[2 * jj + 1].x, r.v[2 * jj + 1].y); w.w = pk2(r.v[2 * jj + 1].z, r.v[2 * jj + 1].w);
        *((GAS v4u*)orow + lane + 64 * jj) = w; }
}
__device__ __forceinline__ void row_load_f32(Row8& r, const float* xrow, int lane) {
#pragma unroll
    for (int jj = 0; jj < 4; ++jj) { const GAS f32x4* p = (const GAS f32x4*)xrow + 2 * (lane + 64 * jj); r.v[2 * jj] = p[0]; r.v[2 * jj + 1] = p[1]; }
}
__device__ __forceinline__ f32x4 bf4(v2u w);
__device__ __forceinline__ void bf8(v4u w, f32x4& a, f32x4& b) { a = bf4((v2u){w.x, w.y}); b = bf4((v2u){w.z, w.w}); }
__device__ __forceinline__ void row_load_bf16(Row8& r, const bf16* xrow, int lane) {
#pragma unroll
    for (int jj = 0; jj < 4; ++jj) bf8(*((const GAS v4u*)xrow + lane + 64 * jj), r.v[2 * jj], r.v[2 * jj + 1]);
}
__device__ __forceinline__ void meta_partials_n(Row8& r, const bf16* P, int stride_rows, int row, int lane) {
#pragma unroll 1
    for (int p = 0; p < 3; ++p) { Row8 t; row_load_bf16(t, P + ((size_t)p * stride_rows + row) * 2048, lane);
#pragma unroll
        for (int j = 0; j < 8; ++j) r.v[j] = r.v[j] + t.v[j]; }
}
__device__ __forceinline__ void meta_partials(Row8& r, const bf16* P, int row, int lane) { meta_partials_n(r, P, 256, row, lane); }
__device__ __forceinline__ void row_store_f32(const Row8& r, float* orow, int lane) {
#pragma unroll
    for (int jj = 0; jj < 4; ++jj) { GAS f32x4* p = (GAS f32x4*)orow + 2 * (lane + 64 * jj); p[0] = r.v[2 * jj]; p[1] = r.v[2 * jj + 1]; }
}
__device__ __forceinline__ f32x4 bf4(v2u w) { return (f32x4){__uint_as_float(w.x << 16), __uint_as_float(w.x & 0xffff0000u), __uint_as_float(w.y << 16), __uint_as_float(w.y & 0xffff0000u)}; }
__device__ __forceinline__ int t5_bucket(int rel) {
    const int n = rel < 0 ? -rel : rel; int v;
    if (n < 8) v = n; else if (n < 12) v = 8; else if (n < 16) v = 9; else if (n < 23) v = 10; else if (n < 32) v = 11; else if (n < 46) v = 12; else if (n < 64) v = 13; else if (n < 91) v = 14; else v = 15;
    return (rel > 0 ? 16 : 0) + v;
}

__device__ __forceinline__ void router_row(const Row8& r, const LAS f32x4* rwl, const float* __restrict__ rbias, int lane, int& i0, int& i1, float& g0, float& g1) {
    float lg[8];
#pragma unroll
    for (int e = 0; e < 8; ++e) lg[e] = 0.f;
#pragma unroll
    for (int j = 0; j < 8; ++j) {
#pragma unroll
        for (int q = 0; q < 4; ++q) { const f32x4 w0 = rwl[(j * 4 + q) * 64 + lane], w1 = rwl[2048 + (j * 4 + q) * 64 + lane]; const float y = r.v[j][q];
            lg[0] += y * w0.x; lg[1] += y * w0.y; lg[2] += y * w0.z; lg[3] += y * w0.w; lg[4] += y * w1.x; lg[5] += y * w1.y; lg[6] += y * w1.z; lg[7] += y * w1.w; } }
#pragma unroll
    for (int e = 0; e < 8; ++e) lg[e] = wave_sum(lg[e]) + rbias[e];
    i0 = 0; float v0 = lg[0];
#pragma unroll
    for (int e = 1; e < 8; ++e) if (lg[e] > v0) { v0 = lg[e]; i0 = e; }
    i1 = -1; float v1 = -3.0e38f;
#pragma unroll
    for (int e = 0; e < 8; ++e) if (e != i0 && lg[e] > v1) { v1 = lg[e]; i1 = e; }
    const float e1 = __expf(v1 - v0); g0 = 1.f / (1.f + e1); g1 = e1 / (1.f + e1);
}
struct Args { const float* in[N_IN]; float* out; unsigned char* ws; int ph_lo, ph_hi; };

__global__ void __launch_bounds__(NWAVES * 64, 2) mk_fwd(Args args) {
    extern __shared__ __attribute__((aligned(16))) unsigned char lds_raw[];
    LAS unsigned char* const lds = (LAS unsigned char*)lds_raw;
    char* const ldsg = (char*)lds_raw;
    volatile LAS unsigned* const MISC = (volatile LAS unsigned*)(lds + MISC_OFF);
    const int wave = __builtin_amdgcn_readfirstlane((int)threadIdx.x >> 6);
    const int tid = wave * 64 + lane_id();
    const int G_k = gridDim.x; const int bx_k = blockIdx.x;
    for (int u = tid; u < (LDS_BYTES - LDSCTL_OFF) / 4; u += NWAVES * 64) ((LAS unsigned*)(lds + LDSCTL_OFF))[u] = 0u;
    __syncthreads();
    volatile LAS unsigned long long* const PT = (volatile LAS unsigned long long*)(lds + PT_OFF);
    if (tid == 0) {
#pragma unroll
        for (int i = 0; i < N_IN; ++i) PT[i] = (unsigned long long)args.in[i];
        PT[N_IN] = (unsigned long long)args.out; PT[N_IN + 1] = (unsigned long long)args.ws; }
    const int lo = args.ph_lo, hi = args.ph_hi;
    __syncthreads();
#define LDP(i) ({ const unsigned long long v_ = PT[i]; (unsigned long long)(unsigned)__builtin_amdgcn_readfirstlane((int)(unsigned)v_) | ((unsigned long long)(unsigned)__builtin_amdgcn_readfirstlane((int)(unsigned)(v_ >> 32)) << 32); })
#define INP(i) ((const float*)(const GAS float*)LDP(i))
#define WSP() ((unsigned char*)(GAS unsigned char*)LDP(N_IN + 1))
#define OUTP() ((float*)(GAS float*)LDP(N_IN))
#define PH_WS() int* SLOT_TOK; float* SLOT_GATE; int* TOK_SLOT; asm volatile("" ::: "memory"); int tid = wave * 64 + lane_id(); asm volatile("" : "+v"(tid)); const int lane = tid & 63; (void)lane; \
    int G = G_k, bx = bx_k; asm volatile("" : "+s"(G), "+s"(bx));     \
    const int vcu = (G % 8 == 0) ? (bx % 8) * (G / 8) + bx / 8 : bx; const int gw = vcu * NWAVES + wave, NGW = G * NWAVES; (void)gw; (void)NGW; (void)vcu; unsigned char* const ws = WSP(); \
    bf16* const HB = (bf16*)(ws + WS_HB); float* const CS = (float*)(ws + WS_CS); float* const SN = (float*)(ws + WS_SN); float* const SSQ = (float*)(ws + WS_SSQ); bf16* const X = (bf16*)(ws + WS_X); \
    SLOT_TOK = (int*)(ws + WS_SLOTTOK); SLOT_GATE = (float*)(ws + WS_SLOTGATE); TOK_SLOT = (int*)(ws + WS_TOKSLOT); (void)HB; (void)CS; (void)SN; (void)SSQ; (void)X; (void)SLOT_TOK; (void)SLOT_GATE; (void)TOK_SLOT
    XcdBarrier bar; { unsigned char* const ws0 = WSP(); bar.bar = (unsigned*)(ws0 + WS_CTL) + CW_BAR; bar.x = 0; bar.st = nullptr;
    if (hi - lo > 1) bar = xcd_barrier_post((unsigned*)(ws0 + WS_CTL) + CW_BAR, MISC + 8, tid); }
#define IN(k) (lo <= (k) && (k) < hi)
#define SEAM(k) do { if (IN(k) && IN((k) + 1)) xcd_barrier(bar, wave * 64 + lane_id()); } while (0)
#define MOECONV(wsp_) MoeConv{INP(I_MW1), INP(I_MW3), INP(I_MW2), (const char*)OUTP(), (const char*)(wsp_), (unsigned*)((wsp_) + WS_CTL) + CW_FILL}
#define SEAMF(k) do { if (IN(k) && IN((k) + 1)) { unsigned char* const wsf_ = WSP(); const MoeConv mc_ = MOECONV(wsf_); xcd_barrier_fill(bar, wave * 64 + lane_id(), mc_, (k), lds); } } while (0)

    if (IN(0)) { PH_WS();
        LAS float* scr = (LAS float*)(lds + RING_OFF + wave * 16384);
        for (int it = gw; it < DI_LAYER; it += NGW) dense_item(it, lds, ws, scr, lane);
        for (int i = gw * 64 + lane; i < 2 * 192 * 256; i += NGW * 64) { const int l = i / (192 * 256), q = i % (192 * 256), rr = q / 256, c16 = q % 256; const int row = rr < 96 ? 1312 + rr : 1440 + (rr - 96);
            *(GAS v4u*)(ws + WS_W + l * WL_STRIDE + WL_IN + (size_t)row * (D * 2) + c16 * 16) = (v4u){0u, 0u, 0u, 0u}; }
        for (int i = gw * 64 + lane; i < LPOS * 32; i += NGW * 64) { const int pos = i >> 5, k = i & 31; const float inv = powf(10000.f, -(float)(2 * k) / 64.f); const float ang = (float)pos * inv; CS[i] = cosf(ang); SN[i] = sinf(ang); }
        for (int i = gw * 64 + lane; i < 16 * 512; i += NGW * 64) { const int hh = i >> 9, rel = (i & 511) - 256; const float bv = INP(I_RELB)[t5_bucket(rel) * 16 + hh] * LOG2E;
            ((float*)(ws + WS_TW))[i] = (rel >= -128 && rel <= 128) ? bv : att::NEG_BIG; if (rel < 0) ((float*)(ws + WS_TM))[hh * 256 + rel + 256] = bv; }
        if (gw == 0 && lane < 32) ((float*)(ws + WS_SINK))[lane] = INP(I_SINK)[lane] * LOG2E;
        { const float* eg = INP(I_EMB_G); const float* eb = INP(I_EMB_B); const float* xin = INP(I_X); const float* min_ = INP(I_META);
#define P0_LOAD(R, m) row_load_f32(R, (m) < TREAL ? xin + (size_t)(m) * D : min_ + (size_t)(((m) - TREAL) & 15) * D, lane)
#define P0_PROC(R, m) do { ln_normalize(R); ln_affine_r(R, gv, bv); row_store_bf16(R, HB + (size_t)(m) * D, lane); } while (0)
          Row8 gv, bv; row_load_f32(gv, eg, lane); row_load_f32(bv, eb, lane);
          Row8 ra{}, rb{}; int m = gw; if (m < T) P0_LOAD(ra, m);
          for (; m < T; m += 2 * NGW) { const int m1 = m + NGW, m2 = m + 2 * NGW; if (m1 < T) P0_LOAD(rb, m1); P0_PROC(ra, m); if (m1 < T) { if (m2 < T) P0_LOAD(ra, m2); P0_PROC(rb, m1); } }
#undef P0_LOAD
#undef P0_PROC
          for (int mz = T + gw; mz < TP; mz += NGW) { GAS v2u* o8 = (GAS v2u*)(HB + (size_t)mz * D) + lane;
#pragma unroll
              for (int j = 0; j < 8; ++j) o8[64 * j] = (v2u){0u, 0u}; } }
    }
    SEAM(0);

#pragma unroll 1
    for (int l = 0; l < 2; ++l) {
        const int P = 1 + 9 * l + (l ? 0 : 0);
        const int nM_all = TREAL / 256;
        const int nM_post = TREAL / 256; const bool tail_post = (l == 0);
        if (IN(P + 0)) { PH_WS();
            ProbDense pr; pr.so.init(nM_all, NIN / 256, G, bx, true); pr.A = (const char*)HB; pr.Bt = (const char*)(ws + WS_W + l * WL_STRIDE + WL_IN); pr.tstep = 256 * (size_t)D * 2;
            epi::EpiWin E{(bf16*)(ws + WS_CQ), (bf16*)(ws + WS_CKV), (bf16*)(ws + WS_KR), (bf16*)(ws + WS_QB), (bf16*)(ws + WS_KB), (bf16*)(ws + WS_VB), (bf16*)(ws + WS_GR), (bf16*)(ws + WS_GBB), SSQ, CS, SN};
            pg8::gemm_phase<epi::EpiWin, ProbDense>(lds + RING_OFF, D, pr, E, tid);
        }
        SEAMF(P + 0);
        if (IN(P + 1)) { PH_WS();
            { ProbDense pr; pr.so.init(nM_all, 3072 / 256, G, bx, true); pr.A = (const char*)(ws + WS_CQ); pr.Bt = (const char*)(ws + WS_W + l * WL_STRIDE + WL_UQ); pr.tstep = 256 * (size_t)QRANK * 2;
              epi::EpiUq E{(bf16*)(ws + WS_Q), SSQ, CS, SN};
              pg8::gemm_phase<epi::EpiUq, ProbDense>(lds + RING_OFF, QRANK, pr, E, tid); }
            { ProbDense pr; pr.so.init(nM_all, 4096 / 256, G, bx, true); pr.A = (const char*)(ws + WS_CKV); pr.Bt = (const char*)(ws + WS_W + l * WL_STRIDE + WL_UKV); pr.tstep = 256 * (size_t)KVRANK * 2;
              epi::EpiUkv E{(bf16*)(ws + WS_KN), (bf16*)(ws + WS_V), SSQ};
              pg8::gemm_phase<epi::EpiUkv, ProbDense>(lds + RING_OFF, KVRANK, pr, E, tid); }
        }
        SEAMF(P + 1);
        if (IN(P + 2)) { PH_WS();
            const int nmla_full = NB * NH * 16, nmeta = l == 0 ? NB * NH : 0, nj = l == 0 ? 65 : 64, nswa = NB * 4 * nj, ndyn = nmeta + nswa;
            unsigned* const actr = (unsigned*)(ws + WS_CTL) + CW_ATT + l;
            int tables_hk = -1, ustat = vcu;
            unsigned nxt = 0u;
_Pragma("unroll 1")
            for (;;) {
                int kind, b, h, qj;
                if (ustat < nmla_full) { kind = 0; qj = ustat & 15; h = (ustat >> 4) & 15; b = ustat >> 8; ustat += G;
                    if (ustat >= nmla_full && tid == 0) nxt = xb_add(actr, 1u); }
                else {
                    __syncthreads(); if (tid == 0) MISC[11] = nxt; __syncthreads();
                    const int it = __builtin_amdgcn_readfirstlane((int)MISC[11]);
                    if (it >= ndyn) break;
                    if (it < nmeta) { kind = 0; b = it >> 4; h = it & 15; qj = 16; }
                    else { kind = 1; const int v = it - nmeta, per_hk = NB * nj; h = v / per_hk; const int r = v - h * per_hk; b = r / nj; qj = r - b * nj; }
                }
                asm volatile("" : "+s"(kind), "+s"(b), "+s"(h), "+s"(qj));
                if (kind == 0) att::mla_unit4((att::lds_ptr)(lds + RING_OFF), (const bf16*)(ws + WS_Q), (const bf16*)(ws + WS_KN), (const bf16*)(ws + WS_KR), (const bf16*)(ws + WS_V), (bf16*)(ws + WS_OAB), b, h, qj, tid);
                else att::swa_unit2((att::lds_ptr)(lds + RING_OFF), (const bf16*)(ws + WS_QB), (const bf16*)(ws + WS_KB), (const bf16*)(ws + WS_VB), (bf16*)(ws + WS_OAB), (const float*)(ws + WS_TW), (const float*)(ws + WS_TM), (const float*)(ws + WS_SINK) + 16 * l, b, h, qj, tables_hk, tid);
                if (ustat >= nmla_full && !(kind == 0 && qj < 16) && tid == 0) nxt = xb_add(actr, 1u);
            }
        }
        SEAMF(P + 2);
        if (IN(P + 3)) { PH_WS();
            ProbDense pr; pr.so.init(nM_post, D / 256, G, bx, tail_post); pr.A = (const char*)(ws + WS_OAB); pr.Bt = (const char*)(ws + WS_W + l * WL_STRIDE + WL_AB); pr.tstep = 256 * (size_t)(2 * D) * 2;
            epi::EpiProj E{(bf16*)(ws + WS_MG), (const bf16*)(ws + WS_GR), (const bf16*)(ws + WS_GBB)};
            pg8::gemm_phase<epi::EpiProj, ProbDense>(lds + RING_OFF, 2 * D, pr, E, tid);
        }
        SEAMF(P + 3);
        if (IN(P + 4)) { PH_WS();
            ProbDense pr; pr.so.init(nM_post, D / 256, G, bx, tail_post, 2); pr.A = (const char*)(ws + WS_MG); pr.Bt = (const char*)(ws + WS_W + l * WL_STRIDE + WL_OUT); pr.tstep = 256 * (size_t)D * 2;
            epi::EpiResid E{X, HB, (bf16*)(ws + WS_XP)};
            pg8::gemm_phase<epi::EpiResid, ProbDense>(lds + RING_OFF, D, pr, E, tid);
        }
        SEAMF(P + 4);
        if (IN(P + 5)) { PH_WS();
            if (l == 0) {
                LAS float* scr = (LAS float*)(lds + RING_OFF + wave * 16384); unsigned* const dctr = (unsigned*)(ws + WS_CTL) + CW_FILL + 4;
_Pragma("unroll 1")
                for (;;) {
                    __syncthreads(); if (tid == 0) MISC[11] = xb_add(dctr, 8u); __syncthreads();
                    const unsigned base = MISC[11];
                    if (base >= (unsigned)DI_DEFER) break;
                    dense_item(DI_LAYER + (int)base + wave, lds, ws, scr, lane);
                }
                asm volatile("s_waitcnt vmcnt(0)" ::: "memory"); __syncthreads();
            }
            const float* g = INP(I_LMG) + l * D; const float* bta = INP(I_LMB) + l * D;
            const int nrows = l == 0 ? T : TREAL;
            int h0 = 0, h1 = 0, h2 = 0, h3 = 0, h4 = 0, h5 = 0, h6 = 0, h7 = 0;
            LAS f32x4* const rwl = (LAS f32x4*)(lds + RING_OFF);
            if (l == 1) { const GAS f32x4* rwg = (const GAS f32x4*)INP(I_RW); for (int i = tid; i < D * 2; i += NWAVES * 64) { const int k = i >> 1, hf = i & 1, e = k & 7, jq = (2 * (k >> 9) + (e >> 2)) * 4 + (e & 3); rwl[hf * 2048 + jq * 64 + ((k >> 3) & 63)] = rwg[i]; } __syncthreads(); }
#define LM_PROC(r, m) do { if (l == 0 && (m) >= TREAL) meta_partials(r, (const bf16*)(ws + WS_XP), (m) - TREAL, lane); ln_normalize(r); ln_affine_r(r, gv, bv); row_store_bf16(r, HB + (size_t)(m) * D, lane); \
                if (l == 1) { int i0_, i1_; float g0_, g1_; router_row(r, rwl, rbias, lane, i0_, i1_, g0_, g1_); \
                    if (lane == 0) { int* ti = (int*)(ws + WS_TOPI); float* tg = (float*)(ws + WS_TOPG); ti[2 * (m)] = i0_; ti[2 * (m) + 1] = i1_; tg[2 * (m)] = g0_; tg[2 * (m) + 1] = g1_; } \
                    h0 += (i0_ == 0) + (i1_ == 0); h1 += (i0_ == 1) + (i1_ == 1); h2 += (i0_ == 2) + (i1_ == 2); h3 += (i0_ == 3) + (i1_ == 3); \
                    h4 += (i0_ == 4) + (i1_ == 4); h5 += (i0_ == 5) + (i1_ == 5); h6 += (i0_ == 6) + (i1_ == 6); h7 += (i0_ == 7) + (i1_ == 7); } } while (0)
            { const float* rbias = INP(I_RB); Row8 gv, bv; row_load_f32(gv, g, lane); row_load_f32(bv, bta, lane); Row8 ra{}, rb{}; int m = gw; if (m < nrows) row_load_bf16(ra, X + (size_t)m * D, lane);
              for (; m < nrows; m += 2 * NGW) { const int m1 = m + NGW, m2 = m + 2 * NGW; if (m1 < nrows) row_load_bf16(rb, X + (size_t)m1 * D, lane); LM_PROC(ra, m);
                  if (m1 < nrows) { if (m2 < nrows) row_load_bf16(ra, X + (size_t)m2 * D, lane); LM_PROC(rb, m1); } } }
#undef LM_PROC
            if (l == 1 && lane == 0) { int* wh = (int*)(ws + WS_WHIST) + gw * 8; wh[0] = h0; wh[1] = h1; wh[2] = h2; wh[3] = h3; wh[4] = h4; wh[5] = h5; wh[6] = h6; wh[7] = h7; }
        }
        if (l == 0) SEAM(P + 5); else SEAMF(P + 5);
        if (l == 0) {
            if (IN(P + 6)) { PH_WS();
                ProbDense pr; pr.so.init(nM_all, 2 * DFF / 256, G, bx, true); pr.A = (const char*)HB; pr.Bt = (const char*)(ws + WS_WF13); pr.tstep = 256 * (size_t)D * 2;
                epi::EpiSwiglu E{(bf16*)(ws + WS_ACT)};
                pg8::gemm_phase<epi::EpiSwiglu, ProbDense>(lds + RING_OFF, D, pr, E, tid);
            }
            SEAMF(P + 6);
            if (IN(P + 7)) { PH_WS();
                ProbDense pr; pr.so.init(nM_all, D / 256, G, bx, true, 2); pr.A = (const char*)(ws + WS_ACT); pr.Bt = (const char*)(ws + WS_WF2); pr.tstep = 256 * (size_t)DFF * 2;
                epi::EpiResid E{X, HB, (bf16*)(ws + WS_XP)};
                pg8::gemm_phase<epi::EpiResid, ProbDense>(lds + RING_OFF, DFF, pr, E, tid);
            }
            SEAMF(P + 7);
            if (IN(P + 8)) { PH_WS();
                const float* g = INP(I_LFG); const float* bta = INP(I_LFB);
#define LF_PROC(r, m) do { if ((m) >= TREAL) meta_partials(r, (const bf16*)(ws + WS_XP), (m) - TREAL, lane); ln_normalize(r); ln_affine_r(r, gv, bv); row_store_bf16(r, HB + (size_t)(m) * D, lane); } while (0)
                { Row8 gv, bv; row_load_f32(gv, g, lane); row_load_f32(bv, bta, lane); Row8 ra{}, rb{}; int m = gw; if (m < T) row_load_bf16(ra, X + (size_t)m * D, lane);
                  for (; m < T; m += 2 * NGW) { const int m1 = m + NGW, m2 = m + 2 * NGW; if (m1 < T) row_load_bf16(rb, X + (size_t)m1 * D, lane); LF_PROC(ra, m);
                      if (m1 < T) { if (m2 < T) row_load_bf16(ra, X + (size_t)m2 * D, lane); LF_PROC(rb, m1); } } }
#undef LF_PROC
            }
            SEAM(P + 8);
        } else {
            if (IN(P + 6)) { PH_WS();
                LAS int* hist = (LAS int*)(lds + RING_OFF);
                LAS int* segsum = hist + 2048 * 8;
                LAS int* segpre = segsum + 64 * 8;
                LAS int* tot = segpre + 64 * 8;
                const int* wh = (const int*)(ws + WS_WHIST);
                for (int i = tid; i < NGW * 8; i += NWAVES * 64) hist[i] = wh[i];
                __syncthreads();
                { const int e = tid & 7, seg = tid >> 3; int s = 0;
_Pragma("unroll 1")
                  for (int w = 0; w < 32; ++w) { const int ww = seg * 32 + w; if (ww < NGW) s += hist[ww * 8 + e]; } segsum[seg * 8 + e] = s; }
                __syncthreads();
                if (tid < 8) { int run = 0;
_Pragma("unroll 1")
                    for (int s = 0; s < 64; ++s) { segpre[s * 8 + tid] = run; run += segsum[s * 8 + tid]; } tot[tid] = run; }
                __syncthreads();
                if (tid == 0) { int ts = 0; for (int e = 0; e < 8; ++e) { tot[8 + e] = ts; ts += (tot[e] + 255) >> 8; } tot[16] = ts;
                    if (bx == 0) for (int e = 0; e < 9; ++e) ((int*)(ws + WS_CTL))[CW_MOE_TS + e] = tot[8 + e]; }
                __syncthreads();
                int base = 0;
                if (lane < 8) { base = tot[8 + lane] * 256 + segpre[(gw >> 5) * 8 + lane];
_Pragma("unroll 1")
                    for (int w = (gw & ~31); w < gw; ++w) base += hist[w * 8 + lane]; }
                const int* ti = (const int*)(ws + WS_TOPI); const float* tg = (const float*)(ws + WS_TOPG);
                for (int i0 = 0; gw + i0 * NGW < TREAL; i0 += 16) {
                    const int m = gw + (i0 + (lane >> 1)) * NGW, kk = lane & 1; const bool valid = lane < 32 && m < TREAL;
                    const int e = valid ? ti[2 * m + kk] : 8; const float gt = valid ? tg[2 * m + kk] : 0.f;
                    int myslot = 0;
#pragma unroll
                    for (int e2 = 0; e2 < 8; ++e2) { const unsigned long long mask = __ballot(e == e2); const int b_e = __builtin_amdgcn_readlane(base, e2);
                        if (e == e2) myslot = b_e + __popcll(mask & ((1ull << lane) - 1ull)); if (lane == e2) base += __popcll(mask); }
                    if (valid) { SLOT_TOK[myslot] = m; SLOT_GATE[myslot] = gt; TOK_SLOT[2 * m + kk] = myslot; }
                }
                if (vcu < 8) { const int e = vcu; const int s0 = tot[8 + e] * 256 + tot[e], s1 = tot[8 + e + 1] * 256; for (int s = s0 + tid; s < s1; s += NWAVES * 64) { SLOT_TOK[s] = T; SLOT_GATE[s] = 0.f; } }
                __syncthreads();
                { LAS float* scr = (LAS float*)(lds + RING_OFF + wave * 16384);
                  const MoeConv mc = MOECONV(ws);
                  unsigned nxt = 0u, lmask = 16u; if (tid == 0) nxt = moe_claim(mc, 32u, 99, lmask);
_Pragma("unroll 1")
                  for (;;) {
                      __syncthreads();
                      if (tid == 0) MISC[11] = nxt;
                      __syncthreads();
                      const unsigned base = MISC[11];
                      if (base >= (unsigned)MC_NIT) break;
                      if (tid == 0) nxt = moe_claim(mc, 32u, 99, lmask);
                      moe_conv_run<4>(mc, (int)base, wave, lane, scr);
                  } }
            }
            SEAM(P + 6);
            MoeTiles mt;
            if (IN(P + 7) || IN(P + 8)) { unsigned char* const ws = WSP();
#pragma unroll
                for (int e = 0; e < 9; ++e) mt.ts[e] = __builtin_amdgcn_readfirstlane(((const int*)(ws + WS_CTL))[CW_MOE_TS + e]);
            } else {
#pragma unroll
                for (int e = 0; e < 9; ++e) mt.ts[e] = 0;
            }
            if (IN(P + 7)) { PH_WS();
                ProbMoe1 pr; pr.so.init(mt.ts[8], 2 * DFF / 256, G, bx); pr.HBp = (const char*)HB; pr.slot_tok = SLOT_TOK; pr.outp = (const char*)OUTP(); pr.wsb = (const char*)ws; pr.mt = mt;
                epi::EpiSwiglu E{(bf16*)(ws + WS_MACT)};
                pg8::gemm_phase<epi::EpiSwiglu, ProbMoe1, true>(lds + RING_OFF, D, pr, E, tid);
            }
            SEAM(P + 7);
            if (IN(P + 8)) { PH_WS();
                ProbMoe2 pr; pr.so.init(MOE_MAIN_TILES, D / 256, G, bx); pr.extra = mt.ts[8] - MOE_MAIN_TILES; pr.ACTp = (const char*)(ws + WS_MACT); pr.outp = (const char*)OUTP(); pr.wsb = (const char*)ws; pr.mt = mt;
                epi::EpiMoeDown E{(bf16*)(ws + WS_Y), SLOT_GATE, (bf16*)(ws + WS_YP)};
                pg8::gemm_phase<epi::EpiMoeDown, ProbMoe2>(lds + RING_OFF, DFF, pr, E, tid);
            }
            SEAM(P + 8);
            if (IN(P + 9)) { PH_WS();
                const float* g = INP(I_LFG) + D; const float* bta = INP(I_LFB) + D; const bf16* Y = (const bf16*)(ws + WS_Y);
#define FL_LOAD(R, m, F) do { const int s0_ = TOK_SLOT[2 * (m)], s1_ = TOK_SLOT[2 * (m) + 1]; F = (s0_ >= MOE_MAIN_TILES * 256 ? 1 : 0) | (s1_ >= MOE_MAIN_TILES * 256 ? 2 : 0); \
                    _Pragma("unroll") for (int jj = 0; jj < 4; ++jj) { f32x4 h0, h1, a0, a1, b0, b1; bf8(*((const GAS v4u*)(HB + (size_t)(m) * D) + lane + 64 * jj), h0, h1); \
                        bf8(*((const GAS v4u*)(Y + (size_t)s0_ * D) + lane + 64 * jj), a0, a1); bf8(*((const GAS v4u*)(Y + (size_t)s1_ * D) + lane + 64 * jj), b0, b1); \
                        R.v[2 * jj] = (h0 * ALPHA + a0) + b0; R.v[2 * jj + 1] = (h1 * ALPHA + a1) + b1; } } while (0)
#define FL_PROC(R, m, F) do { if (__builtin_amdgcn_readfirstlane(F)) {                           \
                        _Pragma("unroll 1") for (int k_ = 0; k_ < 2; ++k_) { const int s_ = __builtin_amdgcn_readfirstlane(TOK_SLOT[2 * (m) + k_]); if (s_ >= MOE_MAIN_TILES * 256) meta_partials_n(R, YP, 2048, s_ - MOE_MAIN_TILES * 256, lane); } } \
                    ln_normalize(R); ln_affine_r(R, gv, bv); row_store_f32(R, outp + (size_t)(m) * D, lane); } while (0)
                { float* const outp = OUTP(); const bf16* YP = (const bf16*)(ws + WS_YP); Row8 gv, bv; row_load_f32(gv, g, lane); row_load_f32(bv, bta, lane); Row8 ra{}, rb{}; int fa = 0, fb = 0; int m = gw; if (m < TREAL) FL_LOAD(ra, m, fa);
                  for (; m < TREAL; m += 2 * NGW) { const int m1 = m + NGW, m2 = m + 2 * NGW; if (m1 < TREAL) FL_LOAD(rb, m1, fb); FL_PROC(ra, m, fa);
                      if (m1 < TREAL) { if (m2 < TREAL) FL_LOAD(ra, m2, fa); FL_PROC(rb, m1, fb); } } }
#undef FL_LOAD
#undef FL_PROC
            }
        }
    }
#undef IN
#undef SEAM
}

#ifndef MK_ONE_LAUNCH
#define MK_ONE_LAUNCH 0
#endif
extern "C" void kernel_launch(void* const* d_in, const int* in_sizes, int n_in, void* d_out, int out_size, void* d_ws, size_t ws_size, hipStream_t stream) {
    static int grid = 0;
    if (grid == 0) {
        if (n_in != N_IN || in_sizes[0] != NB * SEQ * D || out_size != NB * SEQ * D || ws_size < WS_END) { fprintf(stderr, "kernel_launch: shape mismatch: n_in %d in0 %d out %d ws %zu (need %zu)\n", n_in, n_in > 0 ? in_sizes[0] : -1, out_size, ws_size, (size_t)WS_END); grid = -1; return; }
        int dev = 0, cus = 0, per_cu = 0;
        if (hipGetDevice(&dev) != hipSuccess || hipDeviceGetAttribute(&cus, hipDeviceAttributeMultiprocessorCount, dev) != hipSuccess) { fprintf(stderr, "kernel_launch: device query failed\n"); grid = -1; return; }
        if (hipFuncSetAttribute((const void*)mk_fwd, hipFuncAttributeMaxDynamicSharedMemorySize, LDS_BYTES) != hipSuccess) { fprintf(stderr, "kernel_launch: hipFuncSetAttribute failed\n"); grid = -1; return; }
        if (hipOccupancyMaxActiveBlocksPerMultiprocessor(&per_cu, (const void*)mk_fwd, NWAVES * 64, LDS_BYTES) != hipSuccess || per_cu < 1) fprintf(stderr, "kernel_launch: occupancy query reports %d\n", per_cu);
        (void)hipGetLastError();
        grid = cus;
    }
    if (grid < 0) return;
    if (hipMemsetAsync((char*)d_ws + WS_CTL, 0, CTL_ZERO_BYTES, stream) != hipSuccess) { fprintf(stderr, "kernel_launch: memset failed\n"); return; }
    Args a{};
    for (int i = 0; i < N_IN; ++i) a.in[i] = (const float*)d_in[i];
    a.out = (float*)d_out; a.ws = (unsigned char*)d_ws;
#if MK_ONE_LAUNCH
    a.ph_lo = 0; a.ph_hi = N_PHASES;
    hipLaunchKernelGGL(mk_fwd, dim3(grid), dim3(NWAVES * 64), LDS_BYTES, stream, a);
#else
    for (int p = 0; p < N_PHASES; ++p) { a.ph_lo = p; a.ph_hi = p + 1; hipLaunchKernelGGL(mk_fwd, dim3(grid), dim3(NWAVES * 64), LDS_BYTES, stream, a); }
#endif
    const hipError_t le = hipPeekAtLastError();
    if (le != hipSuccess) fprintf(stderr, "kernel_launch: launch failed: %s\n", hipGetErrorName(le));
}
```

```cpp
#define MK_ONE_LAUNCH 1
#include <hip/hip_runtime.h>
#include <cstdio>
#include <cstdint>
#include <type_traits>
namespace pg8 {
#define PG8_LAS __attribute__((address_space(3)))
typedef unsigned short bf16_t;
typedef short bf16x8 __attribute__((ext_vector_type(8)));
typedef float f32x4 __attribute__((ext_vector_type(4)));
typedef float f32x2 __attribute__((ext_vector_type(2)));
typedef unsigned u32x4 __attribute__((ext_vector_type(4)));
typedef unsigned u32x2 __attribute__((ext_vector_type(2)));
constexpr int BM = 256, BK = 64, HALF = 128, HTB = HALF * BK * 2  , STAGE_BYTES = 8 * HTB, NXCD = 8, WGM = 8;

__host__ __device__ __forceinline__ int lds_byte(int r, int c) { const int st = (r >> 4) * 2 + (c >> 5), rr = r & 15, cc = c & 31, ob = rr * 64 + cc * 2; return st * 1024 + (ob ^ (((ob >> 9) & 1) << 5)); }
__host__ __device__ __forceinline__ void stage_rc(int b, int& R, int& C) { const int st = b / 1024, sb = b % 1024, swz = sb ^ (((sb >> 9) & 1) << 5); R = (st >> 1) * 16 + swz / 64; C = (st & 1) * 32 + (swz % 64) / 2; }
__host__ __device__ __forceinline__ int perm32(int rho) { const int n = rho >> 4, i = rho & 15; return 8 * (i >> 2) + 4 * n + (i & 3); }

struct Unit { int pm, pn, ks; };

struct StaticOrder {
    int nM, nN, nwg, G, c, ntail, kshift;
    __device__ __forceinline__ void init(int nM_, int nN_, int G_, int c_, bool tail = false, int kshift_ = 0) { nM = nM_; nN = nN_; nwg = nM * nN; G = G_; c = c_; kshift = kshift_; ntail = tail ? (nN_ << kshift_) : 0; }
    __device__ __forceinline__ bool next(int i, Unit& u) const {
        const long L = (long)i * G + c; if (L >= nwg + ntail) return false;
        u.ks = -1;
        if (L >= nwg) { const int t = (int)(L - nwg); u.pm = nM; u.pn = t >> kshift; if (kshift) u.ks = t & ((1 << kshift) - 1); return true; }
        int wgid = (int)L; { const int q = nwg / NXCD, r = nwg % NXCD, xcd = wgid % NXCD, off = wgid / NXCD; wgid = (xcd < r ? xcd * (q + 1) : r * (q + 1) + (xcd - r) * q) + off; }
        const int nig = WGM * nN, gid = wgid / nig, fm = gid * WGM, gsz = (nM - fm) < WGM ? (nM - fm) : WGM;
        u.pm = fm + ((wgid % nig) % gsz); u.pn = (wgid % nig) / gsz; return true;
    }
    __device__ __forceinline__ bool is_half(const Unit& u) const { return ntail != 0 && u.pm == nM; }
};
typedef __bf16 bf16x2_t __attribute__((ext_vector_type(2)));
__device__ __forceinline__ unsigned cvt_pk_bf16(float lo, float hi) { const f32x2 v = {lo, hi}; const bf16x2_t b = __builtin_convertvector(v, bf16x2_t); return __builtin_bit_cast(unsigned, b); }
__device__ __forceinline__ float bf_lo(unsigned w) { return __uint_as_float(w << 16); }
__device__ __forceinline__ float bf_hi(unsigned w) { return __uint_as_float(w & 0xffff0000u); }

template <class Epi, class Prob, bool GATHER = false>
__device__ __forceinline__ void gemm_phase(PG8_LAS unsigned char* lds, const int K, const Prob& S, const Epi& E, const int tid_in) {
    int tid_ = tid_in; asm volatile("" : "+v"(tid_));
    const int tid = tid_, wid = __builtin_amdgcn_readfirstlane(tid >> 6), lane = tid & 63, wr = wid >> 2, wc = wid & 3, fr = lane & 15, fq = lane >> 4;
    const int nt_full = K / BK;
    int sR[2], sC[2];
    unsigned voffA[2][2], nvoffA[2][2], voffB[2]; int ntok[2][2] = {{0, 0}, {0, 0}};
#pragma unroll
    for (int i = 0; i < 2; ++i) { int R, C; stage_rc(tid * 16 + i * 8192, R, C); sR[i] = R; sC[i] = C; const int Rb = (R & ~31) + perm32(R & 31);
        voffB[i] = (unsigned)(Rb * K + C) * 2u;
        voffA[0][i] = (unsigned)(R * K + C) * 2u; voffA[1][i] = (unsigned)((R + HALF) * K + C) * 2u; nvoffA[0][i] = voffA[0][i]; nvoffA[1][i] = voffA[1][i]; }
    const size_t kstep = (size_t)(BK * 2);
    const size_t hstep = (size_t)HALF * K * 2;
    const unsigned ldsw = (unsigned)wid * 1024u;
    const int aoff = lds_byte(wr * 64 + fr, fq * 8), boff = lds_byte(wc * 32 + fr, fq * 8);
#define PG8_SA(b, h) (((b) * 2 + (h)) * HTB)
#define PG8_SB(b, h) ((4 + (b) * 2 + (h)) * HTB)
#define PG8_STAGE(bufoff, gbase, voff) do { _Pragma("unroll") for (int _i = 0; _i < 2; ++_i) \
        __builtin_amdgcn_global_load_lds((const unsigned*)((const char*)(gbase) + (voff)[_i]), (PG8_LAS unsigned*)(lds + (bufoff) + ldsw + _i * 8192), 16, 0, 0); } while (0)
#define PG8_LDA(dst, b, h) do { _Pragma("unroll") for (int m = 0; m < 4; ++m) _Pragma("unroll") for (int k = 0; k < 2; ++k) dst[m][k] = *(const PG8_LAS bf16x8*)(lds + PG8_SA(b, h) + aoff + m * 2048 + k * 1024); } while (0)
#define PG8_LDB(dst, b, h) do { _Pragma("unroll") for (int n = 0; n < 2; ++n) _Pragma("unroll") for (int k = 0; k < 2; ++k) dst[n][k] = *(const PG8_LAS bf16x8*)(lds + PG8_SB(b, h) + boff + n * 2048 + k * 1024); } while (0)
#define PG8_MMA(ai, bj, At, Bt) do { __builtin_amdgcn_s_setprio(1); _Pragma("unroll") for (int m = 0; m < 4; ++m) _Pragma("unroll") for (int n = 0; n < 2; ++n) _Pragma("unroll") for (int k = 0; k < 2; ++k) \
        acc[ai][bj][m][n] = __builtin_amdgcn_mfma_f32_16x16x32_bf16(Bt[n][k], At[m][k], acc[ai][bj][m][n], 0, 0, 0); __builtin_amdgcn_s_setprio(0); } while (0)
#define PG8_WAIT_V(n) asm volatile("s_waitcnt vmcnt(" #n ")" ::: "memory")
#define PG8_WAIT_L(n) asm volatile("s_waitcnt lgkmcnt(" #n ")" ::: "memory")
#define PG8_BAR __builtin_amdgcn_s_barrier()
#define PG8_SCHED __builtin_amdgcn_sched_barrier(0)
    Unit cur, nxt; int ui = 0;
    if (!S.next(0, cur)) return;
    f32x4 acc[2][2][4][2];
#pragma unroll
    for (int a = 0; a < 2; ++a)
#pragma unroll
        for (int b = 0; b < 2; ++b)
#pragma unroll
            for (int m = 0; m < 4; ++m)
#pragma unroll
                for (int n = 0; n < 2; ++n) acc[a][b][m][n] = (f32x4){0.f, 0.f, 0.f, 0.f};
    bf16x8 At[4][2], B0[2][2], B1[2][2];
    const char* cA = S.a_base(cur); const char* cB = S.b_base(cur);
    if constexpr (GATHER) {
#pragma unroll
        for (int h = 0; h < 2; ++h)
#pragma unroll
            for (int i = 0; i < 2; ++i) { voffA[h][i] = (unsigned)(S.a_row(cur, sR[i] + h * HALF) * K + sC[i]) * 2u; nvoffA[h][i] = voffA[h][i]; }
    }
    PG8_STAGE(PG8_SB(0, 0), cB, voffB); PG8_STAGE(PG8_SB(0, 1), cB + hstep, voffB); PG8_STAGE(PG8_SA(0, 0), cA, voffA[0]); PG8_STAGE(PG8_SA(0, 1), cA, voffA[1]);
    if (wr == 1) PG8_BAR;
    PG8_WAIT_V(2); PG8_BAR;
    PG8_STAGE(PG8_SB(1, 0), cB + kstep, voffB); PG8_STAGE(PG8_SA(1, 0), cA + kstep, voffA[0]); PG8_STAGE(PG8_SB(1, 1), cB + hstep + kstep, voffB);
    PG8_WAIT_V(6); PG8_BAR;
    for (;;) {
        const bool has_next = S.next(ui + 1, nxt);
        const bool half = S.is_half(cur);
        const int nt = S.nt(cur, nt_full);
        const char* nA = has_next ? S.a_base(nxt) : cA; const char* nB = has_next ? S.b_base(nxt) : cB;
        if constexpr (GATHER) { if (has_next) {
#pragma unroll
            for (int h = 0; h < 2; ++h)
#pragma unroll
                for (int i = 0; i < 2; ++i) ntok[h][i] = S.a_row(nxt, sR[i] + h * HALF); } }
        for (int t = 0; t < nt; t += 2) {
            const bool last = (t == nt - 2);
            if constexpr (Epi::MID) { if (t == (nt >> 1)) E.mid(acc, cur, wr, wc, fr, fq); }
            const char* a1 = cA + (size_t)(t + 1) * kstep;
            const char* a2 = last ? nA : cA + (size_t)(t + 2) * kstep; const char* b2 = last ? nB : cB + (size_t)(t + 2) * kstep;
            const char* a3 = a2 + kstep; const char* b3 = b2 + kstep;
            unsigned vA2[2][2];
#pragma unroll
            for (int h = 0; h < 2; ++h)
#pragma unroll
                for (int i = 0; i < 2; ++i) vA2[h][i] = voffA[h][i];
            if constexpr (GATHER) { if (last) {
                asm volatile("" : "+v"(ntok[0][0]), "+v"(ntok[0][1]), "+v"(ntok[1][0]), "+v"(ntok[1][1]));
                if (has_next) {
#pragma unroll
                    for (int h = 0; h < 2; ++h)
#pragma unroll
                        for (int i = 0; i < 2; ++i) nvoffA[h][i] = (unsigned)(ntok[h][i] * K + sC[i]) * 2u; }
                vA2[0][0] = nvoffA[0][0]; vA2[0][1] = nvoffA[0][1]; vA2[1][0] = nvoffA[1][0]; vA2[1][1] = nvoffA[1][1]; } }
            PG8_LDB(B0, 0, 0); PG8_LDB(B1, 0, 1); PG8_SCHED; PG8_LDA(At, 0, 0); PG8_STAGE(PG8_SA(1, 1), a1, voffA[1]);
            PG8_WAIT_V(8); PG8_WAIT_L(0); PG8_BAR; PG8_MMA(0, 0, At, B0); PG8_MMA(0, 1, At, B1); PG8_BAR; PG8_SCHED;
            if (!half) PG8_LDA(At, 0, 1); PG8_STAGE(PG8_SB(0, 0), b2, voffB); PG8_STAGE(PG8_SB(0, 1), b2 + hstep, voffB); PG8_STAGE(PG8_SA(0, 0), a2, vA2[0]);
            PG8_WAIT_V(8); PG8_WAIT_L(0); PG8_BAR; if (!half) { PG8_MMA(1, 0, At, B0); PG8_MMA(1, 1, At, B1); } PG8_BAR; PG8_SCHED;
            PG8_LDB(B0, 1, 0); PG8_LDB(B1, 1, 1); PG8_SCHED; PG8_LDA(At, 1, 0); PG8_STAGE(PG8_SA(0, 1), a2, vA2[1]);
            PG8_WAIT_V(8); PG8_WAIT_L(0); PG8_BAR; PG8_MMA(0, 0, At, B0); PG8_MMA(0, 1, At, B1); PG8_BAR; PG8_SCHED;
            if (!half) PG8_LDA(At, 1, 1); PG8_STAGE(PG8_SB(1, 0), b3, voffB); PG8_STAGE(PG8_SB(1, 1), b3 + hstep, voffB); PG8_STAGE(PG8_SA(1, 0), a3, vA2[0]);
            PG8_WAIT_V(8); PG8_WAIT_L(0); PG8_BAR; if (!half) { PG8_MMA(1, 0, At, B0); PG8_MMA(1, 1, At, B1); } PG8_BAR; PG8_SCHED;
        }
        if (wr == 0) PG8_BAR;
        E(acc, cur, wr, wc, fr, fq);
        if (!has_next) break;
#pragma unroll
        for (int a = 0; a < 2; ++a)
#pragma unroll
            for (int b = 0; b < 2; ++b)
#pragma unroll
                for (int m = 0; m < 4; ++m)
#pragma unroll
                    for (int n = 0; n < 2; ++n) acc[a][b][m][n] = (f32x4){0.f, 0.f, 0.f, 0.f};
        cur = nxt; cA = nA; cB = nB; ++ui;
        if constexpr (GATHER) {
#pragma unroll
            for (int h = 0; h < 2; ++h)
#pragma unroll
                for (int i = 0; i < 2; ++i) voffA[h][i] = nvoffA[h][i]; }
        if (wr == 1) PG8_BAR;
    }
    PG8_WAIT_V(0);
    PG8_BAR;
#undef PG8_SA
#undef PG8_SB
#undef PG8_STAGE
#undef PG8_LDA
#undef PG8_LDB
#undef PG8_MMA
#undef PG8_WAIT_V
#undef PG8_WAIT_L
#undef PG8_BAR
#undef PG8_SCHED
}
}
constexpr int D = 2048, NB = 8, SEQ = 4096, NMETA = 16, NH = 16;
constexpr int TREAL = NB * SEQ;
constexpr int T = TREAL + NB * NMETA;
constexpr int TP = 33024;
constexpr int LPOS = SEQ + NMETA;
constexpr int QRANK = 768, KVRANK = 512, DFF = 5632, NE = 8;
constexpr int NIN = 8704;
constexpr int INDIM = 8512;
constexpr float LN_EPS = 1e-5f, RMS_EPS = 1e-6f, ALPHA = 1.4142135623730951f;
constexpr float LOG2E = 1.4426950408889634f;
constexpr float QK_SCALE_MLA = 0.07216878364870322f * LOG2E;
constexpr float QK_SCALE_SWA = 0.08838834764831845f * LOG2E;

__device__ __forceinline__ int row_pos(int row) { return row < TREAL ? NMETA + (row & (SEQ - 1)) : ((row - TREAL) & (NMETA - 1)); }

struct ProbDense {
    pg8::StaticOrder so; const char* A; const char* Bt; size_t tstep;
    __device__ __forceinline__ bool next(int i, pg8::Unit& u) const { return so.next(i, u); }
    __device__ __forceinline__ size_t koff(const pg8::Unit& u) const { return u.ks < 0 ? (size_t)0 : (size_t)u.ks * ((tstep >> 8) >> so.kshift); }
    __device__ __forceinline__ const char* a_base(const pg8::Unit& u) const { return A + (size_t)u.pm * tstep + koff(u); }
    __device__ __forceinline__ const char* b_base(const pg8::Unit& u) const { return Bt + (size_t)u.pn * tstep + koff(u); }
    __device__ __forceinline__ int a_row(const pg8::Unit&, int) const { return 0; }
    __device__ __forceinline__ bool is_half(const pg8::Unit& u) const { return so.is_half(u); }
    __device__ __forceinline__ int nt(const pg8::Unit& u, int ntf) const { return u.ks < 0 ? ntf : (ntf >> so.kshift); }
};
struct MoeTiles { int ts[9]; };
__device__ __forceinline__ int moe_expert(const MoeTiles& mt, int pm) { int e = 0;
#pragma unroll
    for (int k = 1; k < 8; ++k) e += (pm >= mt.ts[k]) ? 1 : 0; return e; }
constexpr size_t MW_MiB = 1u << 20, MW_B = 1583 * MW_MiB, MW_E = 66 * MW_MiB, MW_E5 = 138 * MW_MiB, MW_E6 = 271 * MW_MiB, MW_E7A = 1067 * MW_MiB, MW_E7B = 205 * MW_MiB;
__device__ __forceinline__ const char* moe_w13(int e, const char* out, const char* ws) {
    return e <= 3 ? out + (size_t)e * MW_E : (e == 4 ? ws + MW_B + 22 * MW_MiB : (e == 5 ? ws + MW_E5 : (e == 6 ? ws + MW_E6 : ws + MW_E7A))); }
__device__ __forceinline__ const char* moe_w2(int e, const char* out, const char* ws) {
    return e <= 2 ? out + (size_t)e * MW_E + 44 * MW_MiB : (e == 3 ? ws + MW_B : (e == 4 ? ws + MW_B + 66 * MW_MiB : (e == 5 ? ws + MW_E5 + 44 * MW_MiB : (e == 6 ? ws + MW_E6 + 44 * MW_MiB : ws + MW_E7B)))); }
struct ProbMoe1 {
    pg8::StaticOrder so; const char* HBp; const int* slot_tok; const char* outp; const char* wsb; MoeTiles mt;
    __device__ __forceinline__ bool next(int i, pg8::Unit& u) const { return so.next(i, u); }
    __device__ __forceinline__ const char* a_base(const pg8::Unit&) const { return HBp; }
    __device__ __forceinline__ const char* b_base(const pg8::Unit& u) const { return moe_w13(moe_expert(mt, u.pm), outp, wsb) + (size_t)u.pn * (256 * (size_t)D * 2); }
    __device__ __forceinline__ int a_row(const pg8::Unit& u, int r) const { return slot_tok[u.pm * 256 + r]; }
    __device__ __forceinline__ bool is_half(const pg8::Unit&) const { return false; }
    __device__ __forceinline__ int nt(const pg8::Unit&, int ntf) const { return ntf; }
};
constexpr int MOE_KS = 4, MOE_KS_NT = DFF / 64 / MOE_KS, MOE_MAIN_TILES = TREAL * 2 / 256;
static_assert(MOE_KS_NT % 2 == 0 && MOE_KS_NT * MOE_KS * 64 == DFF, "split-K pieces");
struct ProbMoe2 {
    pg8::StaticOrder so; const char* ACTp; const char* outp; const char* wsb; MoeTiles mt; int extra;
    __device__ __forceinline__ bool next(int i, pg8::Unit& u) const {
        const long L = (long)i * so.G + so.c; if (L < so.nwg) return so.next(i, u);
        const int t = (int)(L - so.nwg); if (t >= extra * 8 * MOE_KS) return false;
        u.ks = t & (MOE_KS - 1); u.pn = (t >> 2) & 7; u.pm = MOE_MAIN_TILES + (t >> 5); return true; }
    __device__ __forceinline__ size_t koff(const pg8::Unit& u) const { return u.ks < 0 ? (size_t)0 : (size_t)u.ks * (MOE_KS_NT * 64 * 2); }
    __device__ __forceinline__ const char* a_base(const pg8::Unit& u) const { return ACTp + (size_t)u.pm * (256 * (size_t)DFF * 2) + koff(u); }
    __device__ __forceinline__ const char* b_base(const pg8::Unit& u) const { return moe_w2(moe_expert(mt, u.pm), outp, wsb) + (size_t)u.pn * (256 * (size_t)DFF * 2) + koff(u); }
    __device__ __forceinline__ int a_row(const pg8::Unit&, int) const { return 0; }
    __device__ __forceinline__ bool is_half(const pg8::Unit&) const { return false; }
    __device__ __forceinline__ int nt(const pg8::Unit& u, int ntf) const { return u.ks < 0 ? ntf : MOE_KS_NT; }
};

namespace epi {
using pg8::f32x4; using pg8::u32x4; using pg8::bf16_t; using pg8::Unit; using pg8::cvt_pk_bf16;
typedef const f32x4 (&AccRef)[2][2][4][2];
__device__ __forceinline__ void store8(bf16_t* p, f32x4 v0, f32x4 v1) { u32x4 w; w.x = cvt_pk_bf16(v0[0], v0[1]); w.y = cvt_pk_bf16(v0[2], v0[3]); w.z = cvt_pk_bf16(v1[0], v1[1]); w.w = cvt_pk_bf16(v1[2], v1[3]); *(u32x4*)p = w; }
__device__ __forceinline__ void load8(const bf16_t* p, f32x4& v0, f32x4& v1) { const u32x4 w = *(const u32x4*)p;
    v0 = (f32x4){pg8::bf_lo(w.x), pg8::bf_hi(w.x), pg8::bf_lo(w.y), pg8::bf_hi(w.y)}; v1 = (f32x4){pg8::bf_lo(w.z), pg8::bf_hi(w.z), pg8::bf_lo(w.w), pg8::bf_hi(w.w)}; }
__device__ __forceinline__ void unpack8(u32x4 w, f32x4& v0, f32x4& v1) { v0 = (f32x4){pg8::bf_lo(w.x), pg8::bf_hi(w.x), pg8::bf_lo(w.y), pg8::bf_hi(w.y)}; v1 = (f32x4){pg8::bf_lo(w.z), pg8::bf_hi(w.z), pg8::bf_lo(w.w), pg8::bf_hi(w.w)}; }
__device__ __forceinline__ bool epi_fence() { asm volatile("" ::: "memory"); return true; }
__device__ __forceinline__ float sigmoidf_(float x) { return __builtin_amdgcn_rcpf(1.f + __builtin_amdgcn_exp2f(-x * LOG2E)); }
#define EPI_AM _Pragma("unroll") for (int ai = 0; ai < 2; ++ai) _Pragma("unroll") for (int m = 0; m < 4; ++m) if (epi_fence())

struct EpiWin {
    static constexpr bool MID = false;
    bf16_t *CQ, *CKV, *KR, *QB, *KB, *VB, *GR, *GBb; float* SSQ; const float *CS, *SN;
    __device__ __forceinline__ void operator()(AccRef acc, const Unit& u, int wr, int wc, int fr, int fq) const {
        const int pn = u.pn, row0 = u.pm * 256 + wr * 64 + fr, cw = wc * 32 + fq * 8;
        if (pn < 5) {
            bf16_t* dst = pn < 3 ? CQ : CKV; const int ld = pn < 3 ? QRANK : KVRANK, c0 = (pn < 3 ? pn : pn - 3) * 256;
            EPI_AM { const int row = row0 + ai * 128 + m * 16; float s = 0.f;
#pragma unroll
                for (int bj = 0; bj < 2; ++bj) { const f32x4 v0 = acc[ai][bj][m][0], v1 = acc[ai][bj][m][1];
                    s += (v0[0] * v0[0] + v0[1] * v0[1]) + (v0[2] * v0[2] + v0[3] * v0[3]) + (v1[0] * v1[0] + v1[1] * v1[1]) + (v1[2] * v1[2] + v1[3] * v1[3]);
                    store8(dst + (size_t)row * ld + c0 + bj * 128 + cw, v0, v1); }
                { auto r16 = __builtin_amdgcn_permlane16_swap(__float_as_uint(s), __float_as_uint(s), false, false); s = __uint_as_float(r16[0]) + __uint_as_float(r16[1]);
                  auto r32 = __builtin_amdgcn_permlane32_swap(__float_as_uint(s), __float_as_uint(s), false, false); s = __uint_as_float(r32[0]) + __uint_as_float(r32[1]); }
                if (fq == 0) SSQ[(size_t)row * 20 + pn * 4 + wc] = s; }
        } else if (pn == 5) {
            if (wc == 0) {
#pragma unroll
                for (int rp = 0; rp < 4; ++rp) { f32x4 cs_[2][4];
#pragma unroll
                    for (int mm = 0; mm < 2; ++mm) { const int rr = 2 * rp + mm, pos = row_pos(row0 + (rr >> 2) * 128 + (rr & 3) * 16);
                        cs_[mm][0] = *(const f32x4*)(CS + pos * 32 + fq * 8); cs_[mm][1] = *(const f32x4*)(CS + pos * 32 + fq * 8 + 4); cs_[mm][2] = *(const f32x4*)(SN + pos * 32 + fq * 8); cs_[mm][3] = *(const f32x4*)(SN + pos * 32 + fq * 8 + 4); }
                    asm volatile("" ::: "memory");
#pragma unroll
                    for (int mm = 0; mm < 2; ++mm) { const int rr = 2 * rp + mm, ai = rr >> 2, m = rr & 3, row = row0 + ai * 128 + m * 16; const f32x4 c0 = cs_[mm][0], c1 = cs_[mm][1], s0 = cs_[mm][2], s1 = cs_[mm][3];
                        const f32x4 x10 = acc[ai][0][m][0], x11 = acc[ai][0][m][1], x20 = acc[ai][1][m][0], x21 = acc[ai][1][m][1];
                        store8(KR + (size_t)row * 64 + fq * 8, x10 * c0 - x20 * s0, x11 * c1 - x21 * s1);
                        store8(KR + (size_t)row * 64 + 32 + fq * 8, x10 * s0 + x20 * c0, x11 * s1 + x21 * c1); }
                    asm volatile("" ::: "memory"); } }
        } else if (pn < 14) {
            EPI_AM { const int row = row0 + ai * 128 + m * 16;
#pragma unroll
                for (int bj = 0; bj < 2; ++bj) store8(QB + (size_t)row * 2048 + (pn - 6) * 256 + bj * 128 + cw, acc[ai][bj][m][0] * QK_SCALE_SWA, acc[ai][bj][m][1] * QK_SCALE_SWA); }
        } else if (pn < 18) {
            bf16_t* dst = pn < 16 ? KB : VB; const int c0 = (pn < 16 ? pn - 14 : pn - 16) * 256;
            EPI_AM { const int row = row0 + ai * 128 + m * 16;
#pragma unroll
                for (int bj = 0; bj < 2; ++bj) store8(dst + (size_t)row * 512 + c0 + bj * 128 + cw, acc[ai][bj][m][0], acc[ai][bj][m][1]); }
        } else {
            const int c0 = (pn - 18) * 128 + cw;
            EPI_AM { const int row = row0 + ai * 128 + m * 16; f32x4 r[2], g[2];
#pragma unroll
                for (int n = 0; n < 2; ++n)
#pragma unroll
                    for (int j = 0; j < 4; ++j) { const float a = acc[ai][0][m][n][j], b = fmaxf(acc[ai][1][m][n][j], -30.f);
                        const float ea = __builtin_amdgcn_exp2f(-a * LOG2E), eb = __builtin_amdgcn_exp2f(-b * LOG2E);
                        g[n][j] = __builtin_amdgcn_rcpf(1.f + eb); r[n][j] = (1.f + eb) * __builtin_amdgcn_rcpf(1.f + ea); }
                store8(GR + (size_t)row * 2048 + c0, r[0], r[1]); store8(GBb + (size_t)row * 2048 + c0, g[0], g[1]); }
        }
    }
};
struct EpiUq {
    static constexpr bool MID = false;
    bf16_t* Q; const float* SSQ; const float *CS, *SN;
    __device__ __forceinline__ void operator()(AccRef acc, const Unit& u, int wr, int wc, int fr, int fq) const {
        const int pn = u.pn, row0 = u.pm * 256 + wr * 64 + fr, cw = wc * 32 + fq * 8;
#pragma unroll
        for (int ai = 0; ai < 2; ++ai) { f32x4 q[4][3]; float rs[4];
#pragma unroll
            for (int m = 0; m < 4; ++m) { const float* sp = SSQ + (size_t)(row0 + ai * 128 + m * 16) * 20; q[m][0] = *(const f32x4*)sp; q[m][1] = *(const f32x4*)(sp + 4); q[m][2] = *(const f32x4*)(sp + 8); }
            asm volatile("" ::: "memory");
#pragma unroll
            for (int m = 0; m < 4; ++m) { const float ss = ((q[m][0][0] + q[m][0][1]) + (q[m][0][2] + q[m][0][3])) + ((q[m][1][0] + q[m][1][1]) + (q[m][1][2] + q[m][1][3])) + ((q[m][2][0] + q[m][2][1]) + (q[m][2][2] + q[m][2][3]));
                rs[m] = __builtin_amdgcn_rsqf(ss * (1.f / QRANK) + RMS_EPS) * QK_SCALE_MLA; }
            if (pn < 8) {
#pragma unroll
                for (int m = 0; m < 4; ++m) { const int row = row0 + ai * 128 + m * 16;
#pragma unroll
                    for (int bj = 0; bj < 2; ++bj) store8(Q + (size_t)row * 3072 + (2 * pn + bj) * 192 + cw, acc[ai][bj][m][0] * rs[m], acc[ai][bj][m][1] * rs[m]); }
            } else {
                const int head = 4 * (pn - 8) + wc;
#pragma unroll
                for (int mp = 0; mp < 2; ++mp) { f32x4 cs_[2][4];
#pragma unroll
                    for (int mm = 0; mm < 2; ++mm) { const int pos = row_pos(row0 + ai * 128 + (2 * mp + mm) * 16);
                        cs_[mm][0] = *(const f32x4*)(CS + pos * 32 + fq * 8); cs_[mm][1] = *(const f32x4*)(CS + pos * 32 + fq * 8 + 4); cs_[mm][2] = *(const f32x4*)(SN + pos * 32 + fq * 8); cs_[mm][3] = *(const f32x4*)(SN + pos * 32 + fq * 8 + 4); }
                    asm volatile("" ::: "memory");
#pragma unroll
                    for (int mm = 0; mm < 2; ++mm) { const int m = 2 * mp + mm, row = row0 + ai * 128 + m * 16; const f32x4 c0 = cs_[mm][0], c1 = cs_[mm][1], s0 = cs_[mm][2], s1 = cs_[mm][3];
                        const f32x4 x10 = acc[ai][0][m][0] * rs[m], x11 = acc[ai][0][m][1] * rs[m], x20 = acc[ai][1][m][0] * rs[m], x21 = acc[ai][1][m][1] * rs[m];
                        store8(Q + (size_t)row * 3072 + head * 192 + 128 + fq * 8, x10 * c0 - x20 * s0, x11 * c1 - x21 * s1);
                        store8(Q + (size_t)row * 3072 + head * 192 + 160 + fq * 8, x10 * s0 + x20 * c0, x11 * s1 + x21 * c1); }
                    asm volatile("" ::: "memory"); }
            }
            asm volatile("" ::: "memory"); }
    }
};
struct EpiUkv {
    static constexpr bool MID = false;
    bf16_t *KN, *V; const float* SSQ;
    __device__ __forceinline__ void operator()(AccRef acc, const Unit& u, int wr, int wc, int fr, int fq) const {
        const int pn = u.pn, row0 = u.pm * 256 + wr * 64 + fr, cw = wc * 32 + fq * 8;
        f32x4 q[2][4][2];
#pragma unroll
        for (int ai = 0; ai < 2; ++ai)
#pragma unroll
            for (int m = 0; m < 4; ++m) { const float* sp = SSQ + (size_t)(row0 + ai * 128 + m * 16) * 20 + 12; q[ai][m][0] = *(const f32x4*)sp; q[ai][m][1] = *(const f32x4*)(sp + 4); }
        asm volatile("" ::: "memory");
#pragma unroll
        for (int ai = 0; ai < 2; ++ai)
#pragma unroll
            for (int m = 0; m < 4; ++m) { const int row = row0 + ai * 128 + m * 16; const f32x4 q0 = q[ai][m][0], q1 = q[ai][m][1];
                const float ss = ((q0[0] + q0[1]) + (q0[2] + q0[3])) + ((q1[0] + q1[1]) + (q1[2] + q1[3]));
                const float rs = __builtin_amdgcn_rsqf(ss * (1.f / KVRANK) + RMS_EPS);
                store8(KN + (size_t)row * 2048 + pn * 128 + cw, acc[ai][0][m][0] * rs, acc[ai][0][m][1] * rs);
                store8(V + (size_t)row * 2048 + pn * 128 + cw, acc[ai][1][m][0] * rs, acc[ai][1][m][1] * rs); }
    }
};
struct EpiProj {
    static constexpr bool MID = true;
    bf16_t* MG; const bf16_t *GR, *GBb;
    __device__ __forceinline__ void mid(f32x4 (&acc)[2][2][4][2], const Unit& u, int wr, int wc, int fr, int fq) const {
        int row0 = u.pm * 256 + wr * 64 + fr, c0 = u.pn * 256 + wc * 32 + fq * 8; asm volatile("" : "+v"(row0), "+v"(c0));
#pragma unroll
        for (int ai = 0; ai < 2; ++ai) { u32x4 w[4][2];
#pragma unroll
            for (int m = 0; m < 4; ++m)
#pragma unroll
                for (int bj = 0; bj < 2; ++bj) w[m][bj] = *(const u32x4*)(GR + (size_t)(row0 + ai * 128 + m * 16) * 2048 + c0 + bj * 128);
            asm volatile("" ::: "memory");
#pragma unroll
            for (int m = 0; m < 4; ++m)
#pragma unroll
                for (int bj = 0; bj < 2; ++bj) { f32x4 r0, r1; unpack8(w[m][bj], r0, r1); acc[ai][bj][m][0] *= r0; acc[ai][bj][m][1] *= r1; }
            asm volatile("" ::: "memory"); }
    }
    __device__ __forceinline__ void operator()(AccRef acc, const Unit& u, int wr, int wc, int fr, int fq) const {
        const int row0 = u.pm * 256 + wr * 64 + fr, c0 = u.pn * 256 + wc * 32 + fq * 8;
#pragma unroll
        for (int ai = 0; ai < 2; ++ai) { u32x4 w[4][2];
#pragma unroll
            for (int m = 0; m < 4; ++m)
#pragma unroll
                for (int bj = 0; bj < 2; ++bj) w[m][bj] = *(const u32x4*)(GBb + (size_t)(row0 + ai * 128 + m * 16) * 2048 + c0 + bj * 128);
            asm volatile("" ::: "memory");
#pragma unroll
            for (int m = 0; m < 4; ++m)
#pragma unroll
                for (int bj = 0; bj < 2; ++bj) { f32x4 g0, g1; unpack8(w[m][bj], g0, g1); store8(MG + (size_t)(row0 + ai * 128 + m * 16) * 2048 + c0 + bj * 128, acc[ai][bj][m][0] * g0, acc[ai][bj][m][1] * g1); }
            asm volatile("" ::: "memory"); }
    }
};
struct EpiResid {
    static constexpr bool MID = false;
    bf16_t* X; const bf16_t* HB; bf16_t* XP;
    __device__ __forceinline__ void operator()(AccRef acc, const Unit& u, int wr, int wc, int fr, int fq) const {
        const int row0 = u.pm * 256 + wr * 64 + fr, c0 = u.pn * 256 + wc * 32 + fq * 8;
        const bool part = u.ks >= 1; const float al = part ? 0.f : ALPHA;
        bf16_t* const X = part ? XP + ((ptrdiff_t)(u.ks - 1) * 256 - (ptrdiff_t)u.pm * 256) * 2048 : this->X;
#pragma unroll
        for (int ai = 0; ai < 2; ++ai) { u32x4 w[4][2];
#pragma unroll
            for (int m = 0; m < 4; ++m)
#pragma unroll
                for (int bj = 0; bj < 2; ++bj) w[m][bj] = *(const u32x4*)(HB + (size_t)(row0 + ai * 128 + m * 16) * 2048 + c0 + bj * 128);
            asm volatile("" ::: "memory");
#pragma unroll
            for (int m = 0; m < 4; ++m)
#pragma unroll
                for (int bj = 0; bj < 2; ++bj) { f32x4 h0, h1; unpack8(w[m][bj], h0, h1);
                    store8(X + (size_t)(row0 + ai * 128 + m * 16) * 2048 + c0 + bj * 128, h0 * al + acc[ai][bj][m][0], h1 * al + acc[ai][bj][m][1]); }
            asm volatile("" ::: "memory"); }
    }
};
struct EpiSwiglu {
    static constexpr bool MID = false;
    bf16_t* ACT;
    __device__ __forceinline__ void operator()(AccRef acc, const Unit& u, int wr, int wc, int fr, int fq) const {
        const int row0 = u.pm * 256 + wr * 64 + fr, c0 = u.pn * 128 + wc * 32 + fq * 8;
        EPI_AM { const int row = row0 + ai * 128 + m * 16; f32x4 o[2];
#pragma unroll
            for (int n = 0; n < 2; ++n)
#pragma unroll
                for (int j = 0; j < 4; ++j) { const float g = acc[ai][0][m][n][j]; o[n][j] = g * sigmoidf_(g) * acc[ai][1][m][n][j]; }
            store8(ACT + (size_t)row * DFF + c0, o[0], o[1]); }
    }
};
struct EpiMoeDown {
    static constexpr bool MID = false;
    bf16_t* Y; const float* slot_gate; bf16_t* YP;
    __device__ __forceinline__ void operator()(AccRef acc, const Unit& u, int wr, int wc, int fr, int fq) const {
        const int row0 = u.pm * 256 + wr * 64 + fr, c0 = u.pn * 256 + wc * 32 + fq * 8;
        bf16_t* const Y = u.ks >= 1 ? YP + ((ptrdiff_t)(u.ks - 1) * 2048 - (ptrdiff_t)MOE_MAIN_TILES * 256) * 2048 : this->Y;
        float gt[2][4];
#pragma unroll
        for (int ai = 0; ai < 2; ++ai)
#pragma unroll
            for (int m = 0; m < 4; ++m) gt[ai][m] = slot_gate[row0 + ai * 128 + m * 16];
        asm volatile("" ::: "memory");
#pragma unroll
        for (int ai = 0; ai < 2; ++ai)
#pragma unroll
            for (int m = 0; m < 4; ++m) { const int row = row0 + ai * 128 + m * 16; const float g = gt[ai][m];
#pragma unroll
                for (int bj = 0; bj < 2; ++bj) store8(Y + (size_t)row * 2048 + c0 + bj * 128, acc[ai][bj][m][0] * g, acc[ai][bj][m][1] * g); }
    }
};
#undef EPI_AM
}
namespace att {
typedef unsigned short bf16;
typedef short bf16x8 __attribute__((ext_vector_type(8)));
typedef short s16x4 __attribute__((ext_vector_type(4)));
typedef float f32x16 __attribute__((ext_vector_type(16)));
typedef unsigned u32x4 __attribute__((ext_vector_type(4)));
#define ATT_LAS __attribute__((address_space(3)))
#define SBAR() __builtin_amdgcn_sched_barrier(0)
constexpr int KN_BYTES = 16384, KR_BYTES = 8192, V_BYTES = 16384, BUF_BYTES = KN_BYTES + KR_BYTES + V_BYTES;
constexpr int OFF_KN = 0, OFF_KR = KN_BYTES, OFF_V = KN_BYTES + KR_BYTES;
constexpr int OFF_WS = 2 * BUF_BYTES;
constexpr int OFF_BT = OFF_WS + 8 * 64 * 4;
constexpr int ATT_LDS_BYTES = OFF_BT + 4 * 260 * 4;
constexpr float NEG_BIG = -1e30f;
constexpr float THR2 = 8.f;
constexpr float THRZ = 64.f;

__device__ __forceinline__ int crow(int r, int hi) { return (r & 3) + 8 * (r >> 2) + 4 * hi; }
__device__ __forceinline__ unsigned cvtpk(float lo, float hi) { return pg8::cvt_pk_bf16(lo, hi); }
__device__ __forceinline__ int kn_off(int row, int colB) { return row * 256 + (colB ^ ((row & 15) << 4)); }
__device__ __forceinline__ int kr_off(int row, int colB) { return row * 128 + (colB ^ (((row >> 1) & 7) << 4)); }
__device__ __forceinline__ int v_st(int k, int c) { const int kk = (k & ~0xC) | ((k & 4) << 1) | ((k & 8) >> 1); return ((kk >> 3) * 4 + (c >> 5)) * 512 + ((kk & 7) * 32 + (c & 31)) * 2; }
__device__ __forceinline__ int v_rd_base(int lane) { return ((lane & 3) << 3) | (((lane >> 2) & 3) << 6) | (((lane >> 4) & 1) << 5) | (((lane >> 5) & 1) << 8); }
constexpr int v_rd_off(int d0, int ks, int half) { return d0 * 512 + ks * 4096 + half * 2048; }
template <int OFF> __device__ __forceinline__ s16x4 tr_read(int vb) { s16x4 r; asm volatile("ds_read_b64_tr_b16 %0, %1 offset:%2" : "=&v"(r) : "v"(vb), "i"(OFF) : "memory"); return r; }
template <int D0> __device__ __forceinline__ void pv_one(f32x16& od, int vb, bf16x8 pa0, bf16x8 pa1, bf16x8 pa2, bf16x8 pa3) {
    const s16x4 l0 = tr_read<v_rd_off(D0, 0, 0)>(vb), h0 = tr_read<v_rd_off(D0, 0, 1)>(vb), l1 = tr_read<v_rd_off(D0, 1, 0)>(vb), h1 = tr_read<v_rd_off(D0, 1, 1)>(vb);
    const s16x4 l2 = tr_read<v_rd_off(D0, 2, 0)>(vb), h2 = tr_read<v_rd_off(D0, 2, 1)>(vb), l3 = tr_read<v_rd_off(D0, 3, 0)>(vb), h3 = tr_read<v_rd_off(D0, 3, 1)>(vb);
    asm volatile("s_waitcnt lgkmcnt(0)" ::: "memory"); SBAR();
#define PK(L, H) (bf16x8){L[0], L[1], L[2], L[3], H[0], H[1], H[2], H[3]}
    od = __builtin_amdgcn_mfma_f32_32x32x16_bf16(pa0, PK(l0, h0), od, 0, 0, 0);
    od = __builtin_amdgcn_mfma_f32_32x32x16_bf16(pa1, PK(l1, h1), od, 0, 0, 0);
    od = __builtin_amdgcn_mfma_f32_32x32x16_bf16(pa2, PK(l2, h2), od, 0, 0, 0);
    od = __builtin_amdgcn_mfma_f32_32x32x16_bf16(pa3, PK(l3, h3), od, 0, 0, 0);
#undef PK
}
__device__ __forceinline__ void pv_all(f32x16* o, int vb, bf16x8 pa0, bf16x8 pa1, bf16x8 pa2, bf16x8 pa3) {
    pv_one<0>(o[0], vb, pa0, pa1, pa2, pa3); pv_one<1>(o[1], vb, pa0, pa1, pa2, pa3); pv_one<2>(o[2], vb, pa0, pa1, pa2, pa3); pv_one<3>(o[3], vb, pa0, pa1, pa2, pa3);
}
}
namespace att {
constexpr int M2_KSLOT = KN_BYTES + KR_BYTES;
constexpr int M2_OFF_K = 0, M2_OFF_V = 3 * M2_KSLOT;
constexpr int M2_OFF_WS = M2_OFF_V + 3 * V_BYTES;
constexpr int M2_LDS_BYTES = M2_OFF_WS + 8 * 64 * 4;
typedef __attribute__((address_space(3))) unsigned char* lds_ptr;

}
namespace att {
constexpr int M3_NT = 65;
template <bool ZOFF = false, bool FIRST = false>
__device__ __forceinline__ void softmax_seg(f32x16& p0, f32x16& p1, float& m_reg, float& l_reg, float& alpha, bf16x8& pa0, bf16x8& pa1, bf16x8& pa2, bf16x8& pa3) {
    float pmax = p0[0];
#pragma unroll
    for (int r = 1; r < 16; ++r) pmax = fmaxf(pmax, p0[r]);
#pragma unroll
    for (int r = 0; r < 16; ++r) pmax = fmaxf(pmax, p1[r]);
    { auto rr = __builtin_amdgcn_permlane32_swap(__float_as_uint(pmax), __float_as_uint(pmax), false, false); pmax = fmaxf(__uint_as_float(rr[0]), __uint_as_float(rr[1])); }
    bool zero_off = false;
    if constexpr (ZOFF) {
        bool upd = pmax - m_reg > THRZ; if (FIRST) upd = upd || (pmax < -THRZ);
        if (__builtin_expect(__all(!upd), 1)) { alpha = 1.f; }
        else { const float mn = upd ? pmax : m_reg; alpha = FIRST ? 1.f : __builtin_amdgcn_exp2f(m_reg - mn); m_reg = mn; }
        zero_off = __all(m_reg == 0.f);
    } else {
        if (__builtin_expect(__all(pmax - m_reg <= THR2), 1)) { alpha = 1.f; }
        else { const float mn = fmaxf(m_reg, pmax); alpha = __builtin_amdgcn_exp2f(m_reg - mn); m_reg = mn; }
    }
    float ps = 0.f;
    if (zero_off) {
#pragma unroll
        for (int r = 0; r < 16; ++r) { p0[r] = __builtin_amdgcn_exp2f(p0[r]); ps += p0[r]; }
#pragma unroll
        for (int r = 0; r < 16; ++r) { p1[r] = __builtin_amdgcn_exp2f(p1[r]); ps += p1[r]; }
    } else {
        const float mn = m_reg;
#pragma unroll
        for (int r = 0; r < 16; ++r) { p0[r] = __builtin_amdgcn_exp2f(p0[r] - mn); ps += p0[r]; }
#pragma unroll
        for (int r = 0; r < 16; ++r) { p1[r] = __builtin_amdgcn_exp2f(p1[r] - mn); ps += p1[r]; }
    }
    { auto rr = __builtin_amdgcn_permlane32_swap(__float_as_uint(ps), __float_as_uint(ps), false, false); ps = __uint_as_float(rr[0]) + __uint_as_float(rr[1]); }
    l_reg = l_reg * alpha + ps;
#define PK4(P, BASE, OUT) do { unsigned a0 = cvtpk(P[BASE + 0], P[BASE + 1]), a1 = cvtpk(P[BASE + 2], P[BASE + 3]);   \
    unsigned b0 = cvtpk(P[BASE + 4], P[BASE + 5]), b1 = cvtpk(P[BASE + 6], P[BASE + 7]);                              \
    auto r0 = __builtin_amdgcn_permlane32_swap(a0, b0, false, false); auto r1 = __builtin_amdgcn_permlane32_swap(a1, b1, false, false); \
    u32x4 w = {r0[0], r1[0], r0[1], r1[1]}; OUT = *reinterpret_cast<bf16x8*>(&w); } while (0)
    PK4(p0, 0, pa0); PK4(p0, 8, pa1); PK4(p1, 0, pa2); PK4(p1, 8, pa3);
#undef PK4
}

}
namespace att {
constexpr int S2_OFF_K = 0, S2_OFF_V = 3 * KN_BYTES, S2_OFF_TW = S2_OFF_V + 3 * V_BYTES;
constexpr int S2_OFF_TM = S2_OFF_TW + 4 * 512 * 4, S2_OFF_WS = S2_OFF_TM + 4 * 256 * 4, S2_LDS_BYTES = S2_OFF_WS + 8 * 64 * 4;
__device__ __forceinline__ void swa_unit2(lds_ptr lds, const bf16* __restrict__ QB, const bf16* __restrict__ KB, const bf16* __restrict__ VB, bf16* __restrict__ OAB,
                                          const float* __restrict__ tw_g, const float* __restrict__ tm_g, const float* __restrict__ sink_l2, int b, int hk, int j, int& tables_hk, const int tid_in) {
    int tid_ = tid_in; asm volatile("" : "+v"(tid_)); const int tid = tid_, lane = tid & 63, r32 = lane & 31, hi = lane >> 5; const int wid = __builtin_amdgcn_readfirstlane(tid >> 6);
    const bool metaq = (j == 64);
    const int hq = 4 * hk + (wid >> 1);
    const bool wave_on = !metaq || (wid & 1) == 0;
    const int qpos = metaq ? (r32 & 15) : (NMETA + 64 * j + 32 * (wid & 1) + r32);
    const int qrow = metaq ? (TREAL + 16 * b + (r32 & 15)) : (b * SEQ + 64 * j + 32 * (wid & 1) + r32);
    __attribute__((address_space(3))) float* wsf = (__attribute__((address_space(3))) float*)(lds + S2_OFF_WS) + wid * 64;
    int nt, kt_lo = 0;
    if (metaq) nt = 3; else { kt_lo = j - 2 < 0 ? 0 : j - 2; const int kt_hi = j + 2 > 63 ? 63 : j + 2; nt = 1 + (kt_hi - kt_lo + 1); }
#define S2_KPOS0(t) (metaq ? 64 * (t) : ((t) == 0 ? 0 : NMETA + 64 * (kt_lo + (t) - 1)))
#define S2_ROW(kp) ({ int kp_ = (kp) > LPOS - 1 ? LPOS - 1 : (kp); (kp_ < NMETA ? TREAL + 16 * b + kp_ : b * SEQ + kp_ - NMETA); })
    int kk_k[2], kk_v[2]; unsigned co_k[2], co_v[2];
#pragma unroll
    for (int i = 0; i < 2; ++i) { const int P = 2 * wid + i;
        { const int row = 4 * P + (lane >> 4), c = (lane & 15) ^ (row & 15); kk_k[i] = row; co_k[i] = (unsigned)(c * 16); }
        { const int q = 64 * P + lane, s = q >> 5, kk = (s >> 2) * 8 + ((q & 31) >> 2), col = (s & 3) * 32 + (q & 3) * 8, k = (kk & ~0xC) | ((kk & 4) << 1) | ((kk & 8) >> 1); kk_v[i] = k; co_v[i] = (unsigned)(col * 2); } }
    const char* const kb_h = (const char*)KB + hk * 256; const char* const vb_h = (const char*)VB + hk * 256;
#define S2_DMA(src, dstoff) __builtin_amdgcn_global_load_lds((const unsigned*)(src), (__attribute__((address_space(3))) unsigned*)(lds + (dstoff)), 16, 0, 0)
#define S2_DMA_TILE(t, slot) do { const int kp0_ = S2_KPOS0(t); \
        _Pragma("unroll") for (int i_ = 0; i_ < 2; ++i_) { S2_DMA(kb_h + (size_t)S2_ROW(kp0_ + kk_k[i_]) * 1024 + co_k[i_], S2_OFF_K + (slot) * KN_BYTES + (2 * wid + i_) * 1024); \
                                                          S2_DMA(vb_h + (size_t)S2_ROW(kp0_ + kk_v[i_]) * 1024 + co_v[i_], S2_OFF_V + (slot) * V_BYTES + (2 * wid + i_) * 1024); } } while (0)
#define S2_BAR() do { asm volatile("s_waitcnt lgkmcnt(0)" ::: "memory"); __builtin_amdgcn_s_barrier(); asm volatile("" ::: "memory"); } while (0)
    S2_DMA_TILE(0, 0); S2_DMA_TILE(1, 1); S2_DMA_TILE(2, 2);
    bf16x8 qr[8];
    { const bf16* qp = QB + (size_t)qrow * 2048 + hq * 128 + hi * 8;
#pragma unroll
      for (int d0 = 0; d0 < 8; ++d0) qr[d0] = *reinterpret_cast<const bf16x8*>(qp + d0 * 16); }
    if (tables_hk != hk) {
        __attribute__((address_space(3))) float* tw = (__attribute__((address_space(3))) float*)(lds + S2_OFF_TW); __attribute__((address_space(3))) float* tm = (__attribute__((address_space(3))) float*)(lds + S2_OFF_TM);
        for (int i = tid; i < 4 * 512; i += 512) tw[i] = tw_g[(4 * hk) * 512 + i];
        for (int i = tid; i < 4 * 256; i += 512) tm[i] = tm_g[(4 * hk) * 256 + i];
        tables_hk = hk;
    }
    const int xkn = (r32 & 15) << 4, hb = hi * 16;
    const int vlane = v_rd_base(lane);
    const float sink = sink_l2[hq];
    float m_reg = sink, l_reg = 1.f; f32x16 o[4];
#pragma unroll
    for (int d = 0; d < 4; ++d) o[d] = f32x16{};
    f32x16 p0, p1; bf16x8 pa0, pa1, pa2, pa3;
#define S2_KLD(d, A0, A1) do { const int of_ = (((d) * 32 + hb) ^ xn_); A0 = *(const __attribute__((address_space(3))) bf16x8*)(kb_ + of_); A1 = *(const __attribute__((address_space(3))) bf16x8*)(kb_ + of_ + 8192); } while (0)
#define S2_KMM(d, A0, A1) do { p0 = __builtin_amdgcn_mfma_f32_32x32x16_bf16(A0, qr[d], p0, 0, 0, 0); p1 = __builtin_amdgcn_mfma_f32_32x32x16_bf16(A1, qr[d], p1, 0, 0, 0); } while (0)
    int slot = 0;
    for (int t = 0; t < nt; ++t) {
        { const int ahead = (nt < t + 3 ? nt : t + 3) - t - 1;
          if (ahead >= 2) asm volatile("s_waitcnt vmcnt(8)" ::: "memory"); else if (ahead == 1) asm volatile("s_waitcnt vmcnt(4)" ::: "memory"); else asm volatile("s_waitcnt vmcnt(0)" ::: "memory"); }
        S2_BAR();
        if (wave_on) {
            const int kpos0 = S2_KPOS0(t);
            __builtin_amdgcn_s_setprio(3);
            { int xn_ = xkn; asm volatile("" : "+v"(xn_)); const lds_ptr kb_ = lds + S2_OFF_K + slot * KN_BYTES + r32 * 256; p0 = f32x16{}; p1 = f32x16{};
              bf16x8 k0a, k0b, k1a, k1b, k2a, k2b, k3a, k3b;
              S2_KLD(0, k0a, k0b); S2_KLD(1, k1a, k1b); S2_KLD(2, k2a, k2b); S2_KLD(3, k3a, k3b); SBAR();
              S2_KMM(0, k0a, k0b); S2_KLD(4, k0a, k0b); SBAR(); S2_KMM(1, k1a, k1b); S2_KLD(5, k1a, k1b); SBAR(); S2_KMM(2, k2a, k2b); S2_KLD(6, k2a, k2b); SBAR(); S2_KMM(3, k3a, k3b); S2_KLD(7, k3a, k3b); SBAR();
              S2_KMM(4, k0a, k0b); SBAR(); S2_KMM(5, k1a, k1b); SBAR(); S2_KMM(6, k2a, k2b); SBAR(); S2_KMM(7, k3a, k3b); }
            __builtin_amdgcn_s_setprio(0);
            if (!metaq && t == 0) {
                int base = 4 * hi - qpos; base = base < -256 ? -256 : base;
                const __attribute__((address_space(3))) float* tb = (const __attribute__((address_space(3))) float*)(lds + S2_OFF_TM) + (wid >> 1) * 256 + base + 256;
#pragma unroll
                for (int r = 0; r < 16; ++r) { if (r < 8) p0[r] += tb[(r & 3) + 8 * (r >> 2)]; else p0[r] = NEG_BIG; p1[r] = NEG_BIG; }
            } else {
                const int base = kpos0 + 4 * hi - qpos;
                const __attribute__((address_space(3))) float* tb = (const __attribute__((address_space(3))) float*)(lds + S2_OFF_TW) + (wid >> 1) * 512 + base + 256;
#pragma unroll
                for (int r = 0; r < 16; ++r) { p0[r] += tb[(r & 3) + 8 * (r >> 2)]; p1[r] += tb[(r & 3) + 8 * (r >> 2) + 32]; }
                if (kpos0 + 64 > LPOS) {
#pragma unroll
                    for (int r = 0; r < 16; ++r) { if (kpos0 + crow(r, hi) >= LPOS) p0[r] = NEG_BIG; if (kpos0 + 32 + crow(r, hi) >= LPOS) p1[r] = NEG_BIG; } }
            }
            float alpha; softmax_seg(p0, p1, m_reg, l_reg, alpha, pa0, pa1, pa2, pa3);
            if (__any(alpha < 1.f)) { if (hi == 0) wsf[r32] = alpha; asm volatile("s_waitcnt lgkmcnt(0)" ::: "memory");
#pragma unroll
                for (int d = 0; d < 4; ++d)
#pragma unroll
                    for (int r = 0; r < 16; ++r) o[d][r] *= wsf[crow(r, hi)]; }
            __builtin_amdgcn_s_setprio(3); pv_all(o, (int)(uintptr_t)(lds + S2_OFF_V + slot * V_BYTES) + vlane, pa0, pa1, pa2, pa3); __builtin_amdgcn_s_setprio(0);
        }
        if (t + 3 < nt) { S2_BAR(); S2_DMA_TILE(t + 3, slot); }
        slot = slot == 2 ? 0 : slot + 1;
    }
    if (wave_on) {
        if (hi == 0) wsf[32 + r32] = l_reg; asm volatile("s_waitcnt lgkmcnt(0)" ::: "memory");
        const int orow0 = metaq ? (TREAL + 16 * b) : (b * SEQ + 64 * j + 32 * (wid & 1));
#pragma unroll
        for (int r = 0; r < 16; ++r) { const int rw = crow(r, hi); const float rl = __builtin_amdgcn_rcpf(wsf[32 + rw]);
            if (!metaq || rw < 16) { bf16* op = OAB + (size_t)(orow0 + rw) * 4096 + 2048 + hq * 128 + r32;
#pragma unroll
                for (int d0 = 0; d0 < 4; ++d0) op[d0 * 32] = (bf16)(cvtpk(o[d0][r] * rl, 0.f) & 0xffffu); } }
    }
    asm volatile("s_waitcnt vmcnt(0)" ::: "memory"); S2_BAR();
#undef S2_KPOS0
#undef S2_ROW
#undef S2_DMA
#undef S2_DMA_TILE
#undef S2_BAR
#undef S2_KLD
#undef S2_KMM
}
}
namespace att {
template <int OFF> __device__ __forceinline__ bf16x8 lds_rd128(int addr) { bf16x8 r; asm volatile("ds_read_b128 %0, %1 offset:%2" : "=&v"(r) : "v"(addr), "i"(OFF) : "memory"); return r; }
#define M4_XPRE(KS) do { \
    int xn_ = xkn, xr_ = xkr; asm volatile("" : "+v"(xn_), "+v"(xr_)); \
    const int kbn_ = (int)(uintptr_t)(lds + M2_OFF_K + (KS) * M2_KSLOT) + r32 * 256; (void)xr_; \
    { const int a_ = kbn_ + (((0) * 32 + hb) ^ xn_); ka0 = lds_rd128<0>(a_); kb0 = lds_rd128<8192>(a_); } \
} while (0)
#define M4_XMAIN(KS, VS) do { \
    int xn_ = xkn, xr_ = xkr; asm volatile("" : "+v"(xn_), "+v"(xr_)); \
    const int kbn_ = (int)(uintptr_t)(lds + M2_OFF_K + (KS) * M2_KSLOT) + r32 * 256, kbr_ = (int)(uintptr_t)(lds + M2_OFF_K + (KS) * M2_KSLOT + KN_BYTES) + r32 * 128; \
    const int vb_ = (int)(uintptr_t)(lds + M2_OFF_V + (VS) * V_BYTES) + vlane; (void)vb_; \
    bf16x8 ka1, ka2, ka3, ka4, kb1, kb2, kb3, kb4; s16x4 vl0, vl1, vl2, vl3, vl4, vh0, vh1, vh2, vh3, vh4; \
    p0 = f32x16{}; p1 = f32x16{}; \
    { const int a_ = kbn_ + (((1) * 32 + hb) ^ xn_); ka1 = lds_rd128<0>(a_); kb1 = lds_rd128<8192>(a_); } \
    { const int a_ = kbn_ + (((2) * 32 + hb) ^ xn_); ka2 = lds_rd128<0>(a_); kb2 = lds_rd128<8192>(a_); } \
    { const int a_ = kbn_ + (((3) * 32 + hb) ^ xn_); ka3 = lds_rd128<0>(a_); kb3 = lds_rd128<8192>(a_); } \
    { const int a_ = kbn_ + (((4) * 32 + hb) ^ xn_); ka4 = lds_rd128<0>(a_); kb4 = lds_rd128<8192>(a_); } \
    asm volatile("s_waitcnt lgkmcnt(8)" ::: "memory"); SBAR(); p0 = __builtin_amdgcn_mfma_f32_32x32x16_bf16(ka0, qr[0], p0, 0, 0, 0); p1 = __builtin_amdgcn_mfma_f32_32x32x16_bf16(kb0, qr[0], p1, 0, 0, 0); SBAR(); \
    { const int a_ = kbn_ + (((5) * 32 + hb) ^ xn_); ka0 = lds_rd128<0>(a_); kb0 = lds_rd128<8192>(a_); } \
    asm volatile("s_waitcnt lgkmcnt(8)" ::: "memory"); SBAR(); p0 = __builtin_amdgcn_mfma_f32_32x32x16_bf16(ka1, qr[1], p0, 0, 0, 0); p1 = __builtin_amdgcn_mfma_f32_32x32x16_bf16(kb1, qr[1], p1, 0, 0, 0); SBAR(); \
    { const int a_ = kbn_ + (((6) * 32 + hb) ^ xn_); ka1 = lds_rd128<0>(a_); kb1 = lds_rd128<8192>(a_); } \
    asm volatile("s_waitcnt lgkmcnt(8)" ::: "memory"); SBAR(); p0 = __builtin_amdgcn_mfma_f32_32x32x16_bf16(ka2, qr[2], p0, 0, 0, 0); p1 = __builtin_amdgcn_mfma_f32_32x32x16_bf16(kb2, qr[2], p1, 0, 0, 0); SBAR(); \
    { const int a_ = kbn_ + (((7) * 32 + hb) ^ xn_); ka2 = lds_rd128<0>(a_); kb2 = lds_rd128<8192>(a_); } \
    asm volatile("s_waitcnt lgkmcnt(8)" ::: "memory"); SBAR(); p0 = __builtin_amdgcn_mfma_f32_32x32x16_bf16(ka3, qr[3], p0, 0, 0, 0); p1 = __builtin_amdgcn_mfma_f32_32x32x16_bf16(kb3, qr[3], p1, 0, 0, 0); SBAR(); \
    { const int a_ = kbr_ + (((0) * 32 + hb) ^ xr_); ka3 = lds_rd128<0>(a_); kb3 = lds_rd128<4096>(a_); } \
    asm volatile("s_waitcnt lgkmcnt(8)" ::: "memory"); SBAR(); p0 = __builtin_amdgcn_mfma_f32_32x32x16_bf16(ka4, qr[4], p0, 0, 0, 0); p1 = __builtin_amdgcn_mfma_f32_32x32x16_bf16(kb4, qr[4], p1, 0, 0, 0); SBAR(); \
    { const int a_ = kbr_ + (((1) * 32 + hb) ^ xr_); ka4 = lds_rd128<0>(a_); kb4 = lds_rd128<4096>(a_); } \
    asm volatile("s_waitcnt lgkmcnt(8)" ::: "memory"); SBAR(); p0 = __builtin_amdgcn_mfma_f32_32x32x16_bf16(ka0, qr[5], p0, 0, 0, 0); p1 = __builtin_amdgcn_mfma_f32_32x32x16_bf16(kb0, qr[5], p1, 0, 0, 0); SBAR(); \
    { const int a_ = kbr_ + (((2) * 32 + hb) ^ xr_); ka0 = lds_rd128<0>(a_); kb0 = lds_rd128<4096>(a_); } \
    asm volatile("s_waitcnt lgkmcnt(8)" ::: "memory"); SBAR(); p0 = __builtin_amdgcn_mfma_f32_32x32x16_bf16(ka1, qr[6], p0, 0, 0, 0); p1 = __builtin_amdgcn_mfma_f32_32x32x16_bf16(kb1, qr[6], p1, 0, 0, 0); SBAR(); \
    { const int a_ = kbr_ + (((3) * 32 + hb) ^ xr_); ka1 = lds_rd128<0>(a_); kb1 = lds_rd128<4096>(a_); } \
    asm volatile("s_waitcnt lgkmcnt(8)" ::: "memory"); SBAR(); p0 = __builtin_amdgcn_mfma_f32_32x32x16_bf16(ka2, qr[7], p0, 0, 0, 0); p1 = __builtin_amdgcn_mfma_f32_32x32x16_bf16(kb2, qr[7], p1, 0, 0, 0); SBAR(); \
    { vl2 = tr_read<v_rd_off(0, 0, 0)>(vb_); vh2 = tr_read<v_rd_off(0, 0, 1)>(vb_); } \
    asm volatile("s_waitcnt lgkmcnt(8)" ::: "memory"); SBAR(); p0 = __builtin_amdgcn_mfma_f32_32x32x16_bf16(ka3, qr[8], p0, 0, 0, 0); p1 = __builtin_amdgcn_mfma_f32_32x32x16_bf16(kb3, qr[8], p1, 0, 0, 0); SBAR(); \
    { vl3 = tr_read<v_rd_off(0, 1, 0)>(vb_); vh3 = tr_read<v_rd_off(0, 1, 1)>(vb_); } \
    asm volatile("s_waitcnt lgkmcnt(8)" ::: "memory"); SBAR(); p0 = __builtin_amdgcn_mfma_f32_32x32x16_bf16(ka4, qr[9], p0, 0, 0, 0); p1 = __builtin_amdgcn_mfma_f32_32x32x16_bf16(kb4, qr[9], p1, 0, 0, 0); SBAR(); \
    { vl4 = tr_read<v_rd_off(0, 2, 0)>(vb_); vh4 = tr_read<v_rd_off(0, 2, 1)>(vb_); } \
    asm volatile("s_waitcnt lgkmcnt(8)" ::: "memory"); SBAR(); p0 = __builtin_amdgcn_mfma_f32_32x32x16_bf16(ka0, qr[10], p0, 0, 0, 0); p1 = __builtin_amdgcn_mfma_f32_32x32x16_bf16(kb0, qr[10], p1, 0, 0, 0); SBAR(); \
    { vl0 = tr_read<v_rd_off(0, 3, 0)>(vb_); vh0 = tr_read<v_rd_off(0, 3, 1)>(vb_); } \
    asm volatile("s_waitcnt lgkmcnt(8)" ::: "memory"); SBAR(); p0 = __builtin_amdgcn_mfma_f32_32x32x16_bf16(ka1, qr[11], p0, 0, 0, 0); p1 = __builtin_amdgcn_mfma_f32_32x32x16_bf16(kb1, qr[11], p1, 0, 0, 0); SBAR(); \
    { vl1 = tr_read<v_rd_off(1, 0, 0)>(vb_); vh1 = tr_read<v_rd_off(1, 0, 1)>(vb_); } \
    asm volatile("s_waitcnt lgkmcnt(8)" ::: "memory"); SBAR(); o[0] = __builtin_amdgcn_mfma_f32_32x32x16_bf16(pa0, (bf16x8){vl2[0], vl2[1], vl2[2], vl2[3], vh2[0], vh2[1], vh2[2], vh2[3]}, o[0], 0, 0, 0); SBAR(); \
    { vl2 = tr_read<v_rd_off(1, 1, 0)>(vb_); vh2 = tr_read<v_rd_off(1, 1, 1)>(vb_); } \
    asm volatile("s_waitcnt lgkmcnt(8)" ::: "memory"); SBAR(); o[0] = __builtin_amdgcn_mfma_f32_32x32x16_bf16(pa1, (bf16x8){vl3[0], vl3[1], vl3[2], vl3[3], vh3[0], vh3[1], vh3[2], vh3[3]}, o[0], 0, 0, 0); SBAR(); \
    { vl3 = tr_read<v_rd_off(1, 2, 0)>(vb_); vh3 = tr_read<v_rd_off(1, 2, 1)>(vb_); } \
    asm volatile("s_waitcnt lgkmcnt(8)" ::: "memory"); SBAR(); o[0] = __builtin_amdgcn_mfma_f32_32x32x16_bf16(pa2, (bf16x8){vl4[0], vl4[1], vl4[2], vl4[3], vh4[0], vh4[1], vh4[2], vh4[3]}, o[0], 0, 0, 0); SBAR(); \
    { vl4 = tr_read<v_rd_off(1, 3, 0)>(vb_); vh4 = tr_read<v_rd_off(1, 3, 1)>(vb_); } \
    asm volatile("s_waitcnt lgkmcnt(8)" ::: "memory"); SBAR(); o[0] = __builtin_amdgcn_mfma_f32_32x32x16_bf16(pa3, (bf16x8){vl0[0], vl0[1], vl0[2], vl0[3], vh0[0], vh0[1], vh0[2], vh0[3]}, o[0], 0, 0, 0); SBAR(); \
    { vl0 = tr_read<v_rd_off(2, 0, 0)>(vb_); vh0 = tr_read<v_rd_off(2, 0, 1)>(vb_); } \
    asm volatile("s_waitcnt lgkmcnt(8)" ::: "memory"); SBAR(); o[1] = __builtin_amdgcn_mfma_f32_32x32x16_bf16(pa0, (bf16x8){vl1[0], vl1[1], vl1[2], vl1[3], vh1[0], vh1[1], vh1[2], vh1[3]}, o[1], 0, 0, 0); SBAR(); \
    { vl1 = tr_read<v_rd_off(2, 1, 0)>(vb_); vh1 = tr_read<v_rd_off(2, 1, 1)>(vb_); } \
    asm volatile("s_waitcnt lgkmcnt(8)" ::: "memory"); SBAR(); o[1] = __builtin_amdgcn_mfma_f32_32x32x16_bf16(pa1, (bf16x8){vl2[0], vl2[1], vl2[2], vl2[3], vh2[0], vh2[1], vh2[2], vh2[3]}, o[1], 0, 0, 0); SBAR(); \
    { vl2 = tr_read<v_rd_off(2, 2, 0)>(vb_); vh2 = tr_read<v_rd_off(2, 2, 1)>(vb_); } \
    asm volatile("s_waitcnt lgkmcnt(8)" ::: "memory"); SBAR(); o[1] = __builtin_amdgcn_mfma_f32_32x32x16_bf16(pa2, (bf16x8){vl3[0], vl3[1], vl3[2], vl3[3], vh3[0], vh3[1], vh3[2], vh3[3]}, o[1], 0, 0, 0); SBAR(); \
    { vl3 = tr_read<v_rd_off(2, 3, 0)>(vb_); vh3 = tr_read<v_rd_off(2, 3, 1)>(vb_); } \
    asm volatile("s_waitcnt lgkmcnt(8)" ::: "memory"); SBAR(); o[1] = __builtin_amdgcn_mfma_f32_32x32x16_bf16(pa3, (bf16x8){vl4[0], vl4[1], vl4[2], vl4[3], vh4[0], vh4[1], vh4[2], vh4[3]}, o[1], 0, 0, 0); SBAR(); \
    { vl4 = tr_read<v_rd_off(3, 0, 0)>(vb_); vh4 = tr_read<v_rd_off(3, 0, 1)>(vb_); } \
    asm volatile("s_waitcnt lgkmcnt(8)" ::: "memory"); SBAR(); o[2] = __builtin_amdgcn_mfma_f32_32x32x16_bf16(pa0, (bf16x8){vl0[0], vl0[1], vl0[2], vl0[3], vh0[0], vh0[1], vh0[2], vh0[3]}, o[2], 0, 0, 0); SBAR(); \
    { vl0 = tr_read<v_rd_off(3, 1, 0)>(vb_); vh0 = tr_read<v_rd_off(3, 1, 1)>(vb_); } \
    asm volatile("s_waitcnt lgkmcnt(8)" ::: "memory"); SBAR(); o[2] = __builtin_amdgcn_mfma_f32_32x32x16_bf16(pa1, (bf16x8){vl1[0], vl1[1], vl1[2], vl1[3], vh1[0], vh1[1], vh1[2], vh1[3]}, o[2], 0, 0, 0); SBAR(); \
    { vl1 = tr_read<v_rd_off(3, 2, 0)>(vb_); vh1 = tr_read<v_rd_off(3, 2, 1)>(vb_); } \
    asm volatile("s_waitcnt lgkmcnt(8)" ::: "memory"); SBAR(); o[2] = __builtin_amdgcn_mfma_f32_32x32x16_bf16(pa2, (bf16x8){vl2[0], vl2[1], vl2[2], vl2[3], vh2[0], vh2[1], vh2[2], vh2[3]}, o[2], 0, 0, 0); SBAR(); \
    { vl2 = tr_read<v_rd_off(3, 3, 0)>(vb_); vh2 = tr_read<v_rd_off(3, 3, 1)>(vb_); } \
    asm volatile("s_waitcnt lgkmcnt(8)" ::: "memory"); SBAR(); o[2] = __builtin_amdgcn_mfma_f32_32x32x16_bf16(pa3, (bf16x8){vl3[0], vl3[1], vl3[2], vl3[3], vh3[0], vh3[1], vh3[2], vh3[3]}, o[2], 0, 0, 0); SBAR(); \
    asm volatile("s_waitcnt lgkmcnt(6)" ::: "memory"); SBAR(); o[3] = __builtin_amdgcn_mfma_f32_32x32x16_bf16(pa0, (bf16x8){vl4[0], vl4[1], vl4[2], vl4[3], vh4[0], vh4[1], vh4[2], vh4[3]}, o[3], 0, 0, 0); SBAR(); \
    asm volatile("s_waitcnt lgkmcnt(4)" ::: "memory"); SBAR(); o[3] = __builtin_amdgcn_mfma_f32_32x32x16_bf16(pa1, (bf16x8){vl0[0], vl0[1], vl0[2], vl0[3], vh0[0], vh0[1], vh0[2], vh0[3]}, o[3], 0, 0, 0); SBAR(); \
    asm volatile("s_waitcnt lgkmcnt(2)" ::: "memory"); SBAR(); o[3] = __builtin_amdgcn_mfma_f32_32x32x16_bf16(pa2, (bf16x8){vl1[0], vl1[1], vl1[2], vl1[3], vh1[0], vh1[1], vh1[2], vh1[3]}, o[3], 0, 0, 0); SBAR(); \
    asm volatile("s_waitcnt lgkmcnt(0)" ::: "memory"); SBAR(); o[3] = __builtin_amdgcn_mfma_f32_32x32x16_bf16(pa3, (bf16x8){vl2[0], vl2[1], vl2[2], vl2[3], vh2[0], vh2[1], vh2[2], vh2[3]}, o[3], 0, 0, 0); SBAR(); \
} while (0)
#define M4_XFIRST(KS, VS) do { \
    int xn_ = xkn, xr_ = xkr; asm volatile("" : "+v"(xn_), "+v"(xr_)); \
    const int kbn_ = (int)(uintptr_t)(lds + M2_OFF_K + (KS) * M2_KSLOT) + r32 * 256, kbr_ = (int)(uintptr_t)(lds + M2_OFF_K + (KS) * M2_KSLOT + KN_BYTES) + r32 * 128; \
    const int vb_ = (int)(uintptr_t)(lds + M2_OFF_V + (VS) * V_BYTES) + vlane; (void)vb_; \
    bf16x8 ka0, ka1, ka2, ka3, ka4, kb0, kb1, kb2, kb3, kb4; s16x4 vl0, vl1, vl2, vl3, vl4, vh0, vh1, vh2, vh3, vh4; \
    p0 = f32x16{}; p1 = f32x16{}; \
    { const int a_ = kbn_ + (((0) * 32 + hb) ^ xn_); ka0 = lds_rd128<0>(a_); kb0 = lds_rd128<8192>(a_); } \
    { const int a_ = kbn_ + (((1) * 32 + hb) ^ xn_); ka1 = lds_rd128<0>(a_); kb1 = lds_rd128<8192>(a_); } \
    { const int a_ = kbn_ + (((2) * 32 + hb) ^ xn_); ka2 = lds_rd128<0>(a_); kb2 = lds_rd128<8192>(a_); } \
    { const int a_ = kbn_ + (((3) * 32 + hb) ^ xn_); ka3 = lds_rd128<0>(a_); kb3 = lds_rd128<8192>(a_); } \
    { const int a_ = kbn_ + (((4) * 32 + hb) ^ xn_); ka4 = lds_rd128<0>(a_); kb4 = lds_rd128<8192>(a_); } \
    asm volatile("s_waitcnt lgkmcnt(8)" ::: "memory"); SBAR(); p0 = __builtin_amdgcn_mfma_f32_32x32x16_bf16(ka0, qr[0], p0, 0, 0, 0); p1 = __builtin_amdgcn_mfma_f32_32x32x16_bf16(kb0, qr[0], p1, 0, 0, 0); SBAR(); \
    { const int a_ = kbn_ + (((5) * 32 + hb) ^ xn_); ka0 = lds_rd128<0>(a_); kb0 = lds_rd128<8192>(a_); } \
    asm volatile("s_waitcnt lgkmcnt(8)" ::: "memory"); SBAR(); p0 = __builtin_amdgcn_mfma_f32_32x32x16_bf16(ka1, qr[1], p0, 0, 0, 0); p1 = __builtin_amdgcn_mfma_f32_32x32x16_bf16(kb1, qr[1], p1, 0, 0, 0); SBAR(); \
    { const int a_ = kbn_ + (((6) * 32 + hb) ^ xn_); ka1 = lds_rd128<0>(a_); kb1 = lds_rd128<8192>(a_); } \
    asm volatile("s_waitcnt lgkmcnt(8)" ::: "memory"); SBAR(); p0 = __builtin_amdgcn_mfma_f32_32x32x16_bf16(ka2, qr[2], p0, 0, 0, 0); p1 = __builtin_amdgcn_mfma_f32_32x32x16_bf16(kb2, qr[2], p1, 0, 0, 0); SBAR(); \
    { const int a_ = kbn_ + (((7) * 32 + hb) ^ xn_); ka2 = lds_rd128<0>(a_); kb2 = lds_rd128<8192>(a_); } \
    asm volatile("s_waitcnt lgkmcnt(8)" ::: "memory"); SBAR(); p0 = __builtin_amdgcn_mfma_f32_32x32x16_bf16(ka3, qr[3], p0, 0, 0, 0); p1 = __builtin_amdgcn_mfma_f32_32x32x16_bf16(kb3, qr[3], p1, 0, 0, 0); SBAR(); \
    { const int a_ = kbr_ + (((0) * 32 + hb) ^ xr_); ka3 = lds_rd128<0>(a_); kb3 = lds_rd128<4096>(a_); } \
    asm volatile("s_waitcnt lgkmcnt(8)" ::: "memory"); SBAR(); p0 = __builtin_amdgcn_mfma_f32_32x32x16_bf16(ka4, qr[4], p0, 0, 0, 0); p1 = __builtin_amdgcn_mfma_f32_32x32x16_bf16(kb4, qr[4], p1, 0, 0, 0); SBAR(); \
    { const int a_ = kbr_ + (((1) * 32 + hb) ^ xr_); ka4 = lds_rd128<0>(a_); kb4 = lds_rd128<4096>(a_); } \
    asm volatile("s_waitcnt lgkmcnt(8)" ::: "memory"); SBAR(); p0 = __builtin_amdgcn_mfma_f32_32x32x16_bf16(ka0, qr[5], p0, 0, 0, 0); p1 = __builtin_amdgcn_mfma_f32_32x32x16_bf16(kb0, qr[5], p1, 0, 0, 0); SBAR(); \
    { const int a_ = kbr_ + (((2) * 32 + hb) ^ xr_); ka0 = lds_rd128<0>(a_); kb0 = lds_rd128<4096>(a_); } \
    asm volatile("s_waitcnt lgkmcnt(8)" ::: "memory"); SBAR(); p0 = __builtin_amdgcn_mfma_f32_32x32x16_bf16(ka1, qr[6], p0, 0, 0, 0); p1 = __builtin_amdgcn_mfma_f32_32x32x16_bf16(kb1, qr[6], p1, 0, 0, 0); SBAR(); \
    { const int a_ = kbr_ + (((3) * 32 + hb) ^ xr_); ka1 = lds_rd128<0>(a_); kb1 = lds_rd128<4096>(a_); } \
    asm volatile("s_waitcnt lgkmcnt(8)" ::: "memory"); SBAR(); p0 = __builtin_amdgcn_mfma_f32_32x32x16_bf16(ka2, qr[7], p0, 0, 0, 0); p1 = __builtin_amdgcn_mfma_f32_32x32x16_bf16(kb2, qr[7], p1, 0, 0, 0); SBAR(); \
    asm volatile("s_waitcnt lgkmcnt(6)" ::: "memory"); SBAR(); p0 = __builtin_amdgcn_mfma_f32_32x32x16_bf16(ka3, qr[8], p0, 0, 0, 0); p1 = __builtin_amdgcn_mfma_f32_32x32x16_bf16(kb3, qr[8], p1, 0, 0, 0); SBAR(); \
    asm volatile("s_waitcnt lgkmcnt(4)" ::: "memory"); SBAR(); p0 = __builtin_amdgcn_mfma_f32_32x32x16_bf16(ka4, qr[9], p0, 0, 0, 0); p1 = __builtin_amdgcn_mfma_f32_32x32x16_bf16(kb4, qr[9], p1, 0, 0, 0); SBAR(); \
    asm volatile("s_waitcnt lgkmcnt(2)" ::: "memory"); SBAR(); p0 = __builtin_amdgcn_mfma_f32_32x32x16_bf16(ka0, qr[10], p0, 0, 0, 0); p1 = __builtin_amdgcn_mfma_f32_32x32x16_bf16(kb0, qr[10], p1, 0, 0, 0); SBAR(); \
    asm volatile("s_waitcnt lgkmcnt(0)" ::: "memory"); SBAR(); p0 = __builtin_amdgcn_mfma_f32_32x32x16_bf16(ka1, qr[11], p0, 0, 0, 0); p1 = __builtin_amdgcn_mfma_f32_32x32x16_bf16(kb1, qr[11], p1, 0, 0, 0); SBAR(); \
} while (0)

__device__ __forceinline__ void mla_unit4(lds_ptr lds, const bf16* __restrict__ Q, const bf16* __restrict__ KN, const bf16* __restrict__ KR, const bf16* __restrict__ V, bf16* __restrict__ OAB, int b, int h, int qb, const int tid_in) {
    int tid_ = tid_in; asm volatile("" : "+v"(tid_)); const int tid = tid_, lane = tid & 63, r32 = lane & 31, hi = lane >> 5; const int wid = __builtin_amdgcn_readfirstlane(tid >> 6);
    const bool metaq = (qb == 16);
    const bool wave_on = !metaq || wid == 0;
    const int qrow = metaq ? (TREAL + 16 * b + (r32 & 15)) : (b * SEQ + qb * 256 + wid * 32 + r32);
    __attribute__((address_space(3))) float* wsf = (__attribute__((address_space(3))) float*)(lds + M2_OFF_WS) + wid * 64;
    unsigned so_kn[2], so_kr, so_v[2];
#pragma unroll
    for (int i = 0; i < 2; ++i) { const int P = 2 * wid + i;
        { const int row = 4 * P + (lane >> 4), c = (lane & 15) ^ (row & 15); so_kn[i] = (unsigned)(row * 4096 + c * 16); }
        { const int q = 64 * P + lane, s = q >> 5, kk = (s >> 2) * 8 + ((q & 31) >> 2), col = (s & 3) * 32 + (q & 3) * 8, k = (kk & ~0xC) | ((kk & 4) << 1) | ((kk & 8) >> 1); so_v[i] = (unsigned)(k * 4096 + col * 2); } }
    { const int row = 8 * wid + (lane >> 3), c = (lane & 7) ^ ((row >> 1) & 7); so_kr = (unsigned)(row * 128 + c * 16); }
    const char* const kn_h = (const char*)KN + h * 256; const char* const v_h = (const char*)V + h * 256; const char* const kr_b = (const char*)KR;
    const size_t real0 = (size_t)b * SEQ, meta0 = (size_t)TREAL + 16 * b;
#define M3_ROW(t) ((t) == 0 ? meta0 : real0 + (size_t)((t) - 1) * 64)
#define M3_DMA(src, dstoff) __builtin_amdgcn_global_load_lds((const unsigned*)(src), (__attribute__((address_space(3))) unsigned*)(lds + (dstoff)), 16, 0, 0)
#define M3_DMA_K(t, slot) do { const size_t g_ = M3_ROW(t); const int so_ = M2_OFF_K + (slot) * M2_KSLOT; \
        M3_DMA(kn_h + g_ * 4096 + so_kn[0], so_ + (2 * wid) * 1024); M3_DMA(kn_h + g_ * 4096 + so_kn[1], so_ + (2 * wid + 1) * 1024); M3_DMA(kr_b + g_ * 128 + so_kr, so_ + KN_BYTES + wid * 1024); } while (0)
#define M3_DMA_V(t, slot) do { const size_t g_ = M3_ROW(t); const int so_ = M2_OFF_V + (slot) * V_BYTES; \
        M3_DMA(v_h + g_ * 4096 + so_v[0], so_ + (2 * wid) * 1024); M3_DMA(v_h + g_ * 4096 + so_v[1], so_ + (2 * wid + 1) * 1024); } while (0)
#define M3_WAIT(n) asm volatile("s_waitcnt vmcnt(" #n ")" ::: "memory")
#define M3_BAR() do { asm volatile("" ::: "memory"); __builtin_amdgcn_s_barrier(); asm volatile("" ::: "memory"); } while (0)
#define M3_EVENT(i, s3) do { if ((i) + 2 < M3_NT) M3_DMA_K((i) + 2, (s3) == 0 ? 2 : (s3) - 1); if ((i) + 1 < M3_NT) M3_DMA_V((i) + 1, (s3) == 2 ? 0 : (s3) + 1); } while (0)
#define M3_WAITI(i) do { if ((i) < M3_NT - 2) M3_WAIT(5); else M3_WAIT(0); } while (0)
    M3_DMA_K(0, 0); M3_DMA_V(0, 0); M3_DMA_K(1, 1);
    bf16x8 qr[12];
    { const bf16* qp = Q + (size_t)qrow * 3072 + h * 192 + hi * 8;
#pragma unroll
      for (int d0 = 0; d0 < 12; ++d0) qr[d0] = *reinterpret_cast<const bf16x8*>(qp + d0 * 16); }
    const int xkn = (r32 & 15) << 4, xkr = ((r32 >> 1) & 7) << 4, hb = hi * 16;
    const int vlane = v_rd_base(lane);
#define M3_PV(slot) pv_all(o, (int)(uintptr_t)(lds + M2_OFF_V + (slot) * V_BYTES) + vlane, pa0, pa1, pa2, pa3)
#define M3_Y(j) do { if (wave_on) { if ((j) == 0) { _Pragma("unroll") for (int r = 0; r < 16; ++r) { if (crow(r, hi) >= 16) p0[r] = NEG_BIG; p1[r] = NEG_BIG; } } \
        float alpha_; if ((j) == 0) softmax_seg<true, true>(p0, p1, m_reg, l_reg, alpha_, pa0, pa1, pa2, pa3); else softmax_seg<true, false>(p0, p1, m_reg, l_reg, alpha_, pa0, pa1, pa2, pa3); \
        if (__any(alpha_ < 1.f)) { if (hi == 0) wsf[r32] = alpha_; asm volatile("s_waitcnt lgkmcnt(0)" ::: "memory"); \
            _Pragma("unroll") for (int d = 0; d < 4; ++d) _Pragma("unroll") for (int r = 0; r < 16; ++r) o[d][r] *= wsf[crow(r, hi)]; } } } while (0)
    float m_reg = 0.f, l_reg = 0.f; f32x16 o[4];
#pragma unroll
    for (int d = 0; d < 4; ++d) o[d] = f32x16{};
    f32x16 p0, p1; bf16x8 pa0, pa1, pa2, pa3;
    bf16x8 ka0 = {}, kb0 = {};
    int s3 = 0;
    if (wid < 4) {
        M3_WAITI(0); M3_BAR();
        if (wave_on) M4_XFIRST(0, 0);
        M3_WAIT(0); M3_BAR(); M3_EVENT(0, 0);
        M3_Y(0);
        if (wave_on) M4_XPRE(1);
        s3 = 1;
        for (int j = 1; j < M3_NT; ++j) {
            M3_WAITI(j); M3_BAR();
            if (wave_on) { __builtin_amdgcn_s_setprio(3); M4_XMAIN(s3, (s3 == 0 ? 2 : s3 - 1)); __builtin_amdgcn_s_setprio(0); }
            M3_WAIT(2); M3_BAR(); M3_EVENT(j, s3);
            M3_Y(j);
            s3 = s3 == 2 ? 0 : s3 + 1;
            if (wave_on && j + 1 < M3_NT) M4_XPRE(s3);
        }
        M3_BAR();
        if (wave_on) M3_PV(s3 == 0 ? 2 : s3 - 1);
        M3_BAR();
    } else {
        M3_WAITI(0); M3_BAR(); M3_EVENT(0, 0);
        M3_BAR();
        if (wave_on) M4_XFIRST(0, 0);
        M3_WAITI(1); M3_BAR(); M3_EVENT(1, 1);
        M3_Y(0);
        if (wave_on) M4_XPRE(1);
        s3 = 1;
        for (int j = 1; j < M3_NT; ++j) {
            M3_BAR();
            if (wave_on) { __builtin_amdgcn_s_setprio(3); M4_XMAIN(s3, (s3 == 0 ? 2 : s3 - 1)); __builtin_amdgcn_s_setprio(0); }
            M3_WAITI(j + 1); M3_BAR(); { const int s3n = s3 == 2 ? 0 : s3 + 1; M3_EVENT(j + 1, s3n); }
            M3_Y(j);
            s3 = s3 == 2 ? 0 : s3 + 1;
            if (wave_on && j + 1 < M3_NT) M4_XPRE(s3);
        }
        M3_BAR();
        if (wave_on) M3_PV(s3 == 0 ? 2 : s3 - 1);
    }
    if (wave_on) {
        if (hi == 0) wsf[32 + r32] = l_reg; asm volatile("s_waitcnt lgkmcnt(0)" ::: "memory");
        const int orow0 = metaq ? (TREAL + 16 * b) : (b * SEQ + qb * 256 + wid * 32);
#pragma unroll
        for (int r = 0; r < 16; ++r) { const int rw = crow(r, hi); const float rl = __builtin_amdgcn_rcpf(wsf[32 + rw]);
            if (!metaq || rw < 16) { bf16* op = OAB + (size_t)(orow0 + rw) * 4096 + h * 128 + r32;
#pragma unroll
                for (int d0 = 0; d0 < 4; ++d0) op[d0 * 32] = (bf16)(cvtpk(o[d0][r] * rl, 0.f) & 0xffffu); } }
    }
    M3_WAIT(0); M3_BAR();
#undef M3_ROW
#undef M3_DMA
#undef M3_DMA_K
#undef M3_DMA_V
#undef M3_WAIT
#undef M3_BAR
#undef M3_EVENT
#undef M3_WAITI
#undef M3_PV
#undef M3_Y
}
#undef M4_XMAIN
#undef M4_XPRE
#undef M4_XFIRST
}
enum { I_X = 0, I_META, I_EMB_G, I_EMB_B, I_RELB, I_WIN, I_QNG, I_KVNG, I_WUQ, I_WUKV, I_SINK, I_WPA, I_WPB, I_WOUT, I_LMG, I_LMB, I_LFG, I_LFB,
       I_FW1, I_FW3, I_FW2, I_RW, I_RB, I_MW1, I_MW3, I_MW2, N_IN };
constexpr int NWAVES = 8;
constexpr int N_PHASES = 20;
constexpr size_t MiB = 1u << 20, KiB32 = 32768;
constexpr size_t WS_CTL = 0, CTL_ZERO_BYTES = 65536;
constexpr size_t WS_CS = 1 * MiB, WS_SN = WS_CS + 540672;
constexpr size_t WS_BIAS = 3 * MiB;
constexpr size_t WS_TW = WS_BIAS, WS_TM = WS_BIAS + 32768, WS_SINK = WS_BIAS + 49152;
constexpr size_t WS_WHIST = WS_BIAS + 65536;
constexpr size_t WS_TOPI = 4 * MiB, WS_TOPG = WS_TOPI + 262144, WS_TOKSLOT = WS_TOPG + 262144;
constexpr size_t WS_SLOTTOK = 5 * MiB, WS_SLOTGATE = WS_SLOTTOK + 294912;
constexpr size_t WS_SSQ = 6 * MiB;
constexpr size_t WS_HB = 9 * MiB;
constexpr size_t WS_W = 138 * MiB;
constexpr size_t WL_IN = 0, WL_UQ = 34 * MiB, WL_UKV = WL_UQ + 9 * MiB / 2, WL_AB = WL_UKV + 4 * MiB, WL_OUT = WL_AB + 16 * MiB, WL_STRIDE = WL_OUT + 8 * MiB;
constexpr size_t WS_WF13 = WS_W + 2 * WL_STRIDE, WS_WF2 = WS_WF13 + 44 * MiB, WS_WEND = WS_WF2 + 22 * MiB;
constexpr size_t AR = 337 * MiB;
constexpr size_t WS_CQ = AR, WS_CKV = WS_CQ + 1548 * KiB32, WS_KR = WS_CKV + 1032 * KiB32, WS_QB = WS_KR + 132 * KiB32;
constexpr size_t WS_KB = WS_QB + 129 * MiB, WS_VB = WS_KB + 1032 * KiB32, WS_GR = WS_VB + 1032 * KiB32, WS_GBB = WS_GR + 129 * MiB;
constexpr size_t WS_Q = WS_GBB + 129 * MiB, WS_KN = WS_Q + 6192 * KiB32  , WS_V = WS_KN + 129 * MiB, WS_OAB = WS_V + 129 * MiB, WS_MIX_END = WS_OAB + 258 * MiB;
constexpr size_t WS_MG = WS_Q;
constexpr size_t WS_X = WS_OAB;
constexpr size_t WS_ACT = AR;
constexpr size_t WS_MACT = 337 * MiB;
constexpr size_t WS_Y = 1265 * MiB;
constexpr size_t WS_YP = WS_Y + 264 * MiB;
constexpr size_t WS_XP = 1672 * MiB;
constexpr size_t WS_END = WS_XP + 4 * MiB;
static_assert(MW_E5 == WS_W && MW_E5 + MW_E <= WS_W + WL_STRIDE, "expert 5 over layer 0's mixer weights only");
static_assert(MW_E6 >= WS_WF13 && MW_E6 + MW_E <= WS_WEND && WS_WEND <= WS_MACT, "expert 6 over the dense FFN weights only");
static_assert(MW_E7B >= WS_W + WL_STRIDE + WL_IN && MW_E7B + 22 * MiB <= WS_W + WL_STRIDE + WL_UQ, "expert 7 w2 over layer 1's w_in copy only");
static_assert(MW_E7A >= WS_KN && MW_E7A + 44 * MiB <= WS_V && WS_MACT + 726 * MiB <= MW_E7A && MW_E7A + 44 * MiB <= WS_Y, "expert 7 w13 over the MLA K buffer only");
static_assert(MW_B >= WS_MIX_END && MW_B + 88 * MiB <= WS_XP && WS_YP + 24 * MiB <= MW_B, "free tail");
static_assert(WS_MIX_END <= 1700 * MiB && WS_END <= 1700 * MiB, "d_ws map");
static_assert(WS_ACT + (size_t)TP * DFF * 2 <= WS_X, "dense ACT vs X");
static_assert(WS_SSQ + (size_t)TP * 20 * 4 <= WS_HB && WS_SLOTGATE + 294912 <= WS_SSQ && WS_TOKSLOT + 262144 <= WS_SLOTTOK && WS_SN + 540672 <= WS_BIAS, "small tables");
static_assert(WS_KR + (size_t)TP * 64 * 2 <= WS_QB, "KR");
constexpr int CW_TMO = 0, CW_CODE = 1;
constexpr int CW_ATT = 100;
constexpr int CW_FILL = 104;
constexpr int CW_MOE_TS = 64;
constexpr int CW_BAR = 4096;
constexpr int RING_OFF = 0, RING_BYTES = 131072;
constexpr int LDSCTL_OFF = RING_BYTES, MISC_OFF = LDSCTL_OFF + 320, PT_OFF = LDSCTL_OFF + 512;
constexpr int LDS_BYTES = 147456;
static_assert(att::ATT_LDS_BYTES <= RING_BYTES && att::M2_LDS_BYTES <= RING_BYTES && att::S2_LDS_BYTES <= RING_BYTES, "attention LDS");

#define GAS __attribute__((address_space(1)))
#define LAS __attribute__((address_space(3)))
typedef unsigned short bf16;
typedef unsigned v4u __attribute__((ext_vector_type(4)));
typedef unsigned v2u __attribute__((ext_vector_type(2)));
typedef float f32x4 __attribute__((ext_vector_type(4)));
typedef GAS unsigned gu32;
#define RLX_AGENT __ATOMIC_RELAXED, __HIP_MEMORY_SCOPE_AGENT
#define LDS_WAIT() asm volatile("s_waitcnt lgkmcnt(0)" ::: "memory")
#define VM_WAIT() asm volatile("s_waitcnt vmcnt(0)" ::: "memory")
__device__ __forceinline__ unsigned f2bf(float f) { unsigned u = __builtin_bit_cast(unsigned, f); return (u + 0x7fffu + ((u >> 16) & 1u)) >> 16; }
__device__ __forceinline__ unsigned pk2(float lo, float hi) { return pg8::cvt_pk_bf16(lo, hi); }

#define XB_TMO      128
#define XB_XCNT(j)  (256  + 64 * (j))
#define XB_XSUB(j)  (1280 + 64 * (j))
#define XB_XGEN(j)  (2304 + 64 * (j))
#define XB_TOP      3328
#define XB_TOPGEN   3392
#define XCD_BAR_WORDS 3456
#define XB_SPIN_CAP (1u << 22)
__device__ __forceinline__ unsigned xb_ld(unsigned* p)              { return __hip_atomic_load(p, __ATOMIC_RELAXED, __HIP_MEMORY_SCOPE_AGENT); }
__device__ __forceinline__ unsigned xb_add(unsigned* p, unsigned v) { return __hip_atomic_fetch_add(p, v, __ATOMIC_RELAXED, __HIP_MEMORY_SCOPE_AGENT); }
__device__ __forceinline__ unsigned xb_xcc_id() { return (unsigned)__builtin_amdgcn_s_getreg((3 << 11) | 20) & 0xFu; }
#define XB_SPIN(cond, bar) do { unsigned _sp = 0; while (cond) { __builtin_amdgcn_s_sleep(1); \
    if ((++_sp & 255u) == 0u) { if (xb_ld(&(bar)[XB_TMO])) break; if (_sp > XB_SPIN_CAP) { atomicAdd(&(bar)[XB_TMO], 1u); break; } } } } while (0)
struct XcdBarrier { unsigned* bar; unsigned x; volatile LAS unsigned* st; };
__device__ __forceinline__ XcdBarrier xcd_barrier_post(unsigned* bar, volatile LAS unsigned* st, const int tid) {
    XcdBarrier b; b.bar = bar; b.x = xb_xcc_id(); b.st = st;
    if (tid == 0) (void)xb_add(&bar[XB_XCNT(b.x)], 1u);
    return b;
}
__device__ __forceinline__ void xcd_barrier_complete(unsigned* bar, unsigned x, unsigned& nloc, unsigned& nx) {
    const unsigned G = gridDim.x * gridDim.y * gridDim.z;
    unsigned sum, cnt, mine, sp = 0u;
    for (;;) {
        sum = 0u; cnt = 0u; mine = 0u;
#pragma unroll
        for (unsigned j = 0; j < 16; ++j) { const unsigned c = xb_ld(&bar[XB_XCNT(j)]); sum += c; cnt += (c > 0u) ? 1u : 0u; mine = (j == x) ? c : mine; }
        if (sum == G) break;
        __builtin_amdgcn_s_sleep(1);
        if ((++sp & 255u) == 0u) { if (xb_ld(&bar[XB_TMO])) break; if (sp > XB_SPIN_CAP) { atomicAdd(&bar[XB_TMO], 1u); break; } }
    }
    nloc = mine > 0u ? mine : 1u; nx = cnt > 0u ? cnt : 1u;
}
__device__ __forceinline__ void xcd_barrier(const XcdBarrier& b, const int tid) {
    asm volatile("s_waitcnt vmcnt(0)" ::: "memory");
    __syncthreads();
    if (tid == 0) {
        unsigned* bar = b.bar;
        __builtin_amdgcn_s_waitcnt(0);
        unsigned nloc = b.st[0], nx = b.st[1];
        if (nloc == 0u) { xcd_barrier_complete(bar, b.x, nloc, nx); b.st[0] = nloc; b.st[1] = nx; }
        const unsigned old = xb_add(&bar[XB_XSUB(b.x)], 1u);
        const unsigned gen = old / nloc;
        if (old + 1u == (gen + 1u) * nloc) {
            __builtin_amdgcn_fence(__ATOMIC_RELEASE, "agent");
            asm volatile("s_waitcnt vmcnt(0)" ::: "memory");
            const unsigned og = xb_add(&bar[XB_TOP], 1u);
            const unsigned tg = og / nx;
            if (og + 1u == (tg + 1u) * nx) xb_add(&bar[XB_TOPGEN], 1u);
            else XB_SPIN(xb_ld(&bar[XB_TOPGEN]) == tg, bar);
            __builtin_amdgcn_fence(__ATOMIC_ACQUIRE, "agent");
            xb_add(&bar[XB_XGEN(b.x)], 1u);
            asm volatile("s_waitcnt vmcnt(0)" ::: "memory");
        } else {
            XB_SPIN(xb_ld(&bar[XB_XGEN(b.x)]) == gen, bar);
            __builtin_amdgcn_fence(__ATOMIC_ACQUIRE, "agent");
            asm volatile("s_waitcnt vmcnt(0)" ::: "memory");
        }
    }
    __syncthreads();
}

__device__ __forceinline__ int lane_id() { int l; asm volatile("v_mbcnt_lo_u32_b32 %0, -1, 0\n\tv_mbcnt_hi_u32_b32 %0, -1, %0" : "=v"(l)); return l; }
__device__ __forceinline__ float dpp_add(float v, const int ctrl_tag) {
    int r;
    if (ctrl_tag == 0) r = __builtin_amdgcn_update_dpp(0, __float_as_int(v), 0xB1, 0xF, 0xF, true);
    else if (ctrl_tag == 1) r = __builtin_amdgcn_update_dpp(0, __float_as_int(v), 0x4E, 0xF, 0xF, true);
    else if (ctrl_tag == 2) r = __builtin_amdgcn_update_dpp(0, __float_as_int(v), 0x141, 0xF, 0xF, true);
    else r = __builtin_amdgcn_update_dpp(0, __float_as_int(v), 0x140, 0xF, 0xF, true);
    return v + __int_as_float(r);
}
__device__ __forceinline__ float wave_sum(float v) {
    v = dpp_add(v, 0); v = dpp_add(v, 1); v = dpp_add(v, 2); v = dpp_add(v, 3);
    const float r0 = __int_as_float(__builtin_amdgcn_readlane(__float_as_int(v), 0)), r1 = __int_as_float(__builtin_amdgcn_readlane(__float_as_int(v), 16));
    const float r2 = __int_as_float(__builtin_amdgcn_readlane(__float_as_int(v), 32)), r3 = __int_as_float(__builtin_amdgcn_readlane(__float_as_int(v), 48));
    return (r0 + r1) + (r2 + r3);
}
__device__ __forceinline__ void transpose_item(const float* __restrict__ W, int ldw, int k0, int n0, bf16* __restrict__ WT, size_t ldt, int drow, int koff, const float* __restrict__ g, LAS float* scr, int lane) {
    const int kr = lane >> 3, c4 = (lane & 7) * 4;
    f32x4 v[8];
#pragma unroll
    for (int i = 0; i < 8; ++i) v[i] = *(const GAS f32x4*)(W + (size_t)(k0 + 8 * i + kr) * ldw + n0 + c4);
    if (g) {
#pragma unroll
        for (int i = 0; i < 8; ++i) v[i] = v[i] * g[k0 + 8 * i + kr]; }
#pragma unroll
    for (int i = 0; i < 8; ++i) { LAS float* d = scr + (8 * i + kr) * 33 + c4; d[0] = v[i].x; d[1] = v[i].y; d[2] = v[i].z; d[3] = v[i].w; }
    LDS_WAIT(); asm volatile("" ::: "memory");
    const int c = lane & 7;
#pragma unroll
    for (int j = 0; j < 4; ++j) { const int n = (lane >> 3) + 8 * j; const LAS float* s = scr + (8 * c) * 33 + n;
        v4u o; o.x = pk2(s[0 * 33], s[1 * 33]); o.y = pk2(s[2 * 33], s[3 * 33]); o.z = pk2(s[4 * 33], s[5 * 33]); o.w = pk2(s[6 * 33], s[7 * 33]);
        *(GAS v4u*)(WT + (size_t)(drow + n) * ldt + koff + k0 + 8 * c) = o; }
    LDS_WAIT(); asm volatile("" ::: "memory");
}
struct TDesc { const float* W; bf16* WT; size_t ldt; int ldw, k0, n0, drow; };
__device__ __forceinline__ void t_load(const TDesc& d, f32x4 (&v)[8], int lane) {
    const int kr = lane >> 3, c4 = (lane & 7) * 4;
#pragma unroll
    for (int i = 0; i < 8; ++i) v[i] = __builtin_nontemporal_load((const GAS f32x4*)(d.W + (size_t)(d.k0 + 8 * i + kr) * d.ldw + d.n0 + c4));
}
__device__ __forceinline__ void t_finish(const TDesc& d, const f32x4 (&v)[8], LAS float* scr, int lane) {
    const int kr = lane >> 3, c4 = (lane & 7) * 4;
#pragma unroll
    for (int i = 0; i < 8; ++i) { LAS float* p = scr + (8 * i + kr) * 33 + c4; p[0] = v[i].x; p[1] = v[i].y; p[2] = v[i].z; p[3] = v[i].w; }
    LDS_WAIT(); asm volatile("" ::: "memory");
    const int c = lane & 7;
#pragma unroll
    for (int j = 0; j < 4; ++j) { const int n = (lane >> 3) + 8 * j; const LAS float* s = scr + (8 * c) * 33 + n;
        v4u o; o.x = pk2(s[0 * 33], s[1 * 33]); o.y = pk2(s[2 * 33], s[3 * 33]); o.z = pk2(s[4 * 33], s[5 * 33]); o.w = pk2(s[6 * 33], s[7 * 33]);
        __builtin_nontemporal_store(o, (GAS v4u*)(d.WT + (size_t)(d.drow + n) * d.ldt + d.k0 + 8 * c)); }
    LDS_WAIT(); asm volatile("" ::: "memory");
}
__device__ __forceinline__ int dmap_in(int n0) {
    if (n0 < 1280) return n0;
    if (n0 < 1312) return 1280;
    if (n0 < 1344) return 1280 + 128;
    if (n0 < 3392) return 1536 + (n0 - 1344);
    if (n0 < 3904) return 3584 + (n0 - 3392);
    if (n0 < 4416) return 4096 + (n0 - 3904);
    if (n0 < 6464) { const int a = n0 - 4416; return 4608 + 256 * (a >> 7) + (a & 127); }
    const int a = n0 - 6464; return 4608 + 256 * (a >> 7) + 128 + (a & 127);
}
__device__ __forceinline__ int dmap_uq(int n0) {
    const int head = n0 / 192, off = n0 - head * 192;
    if (off < 128) return 256 * (head >> 1) + 128 * (head & 1) + off;
    if (off < 160) return 256 * (8 + (head >> 2)) + 32 * (head & 3);
    return 256 * (8 + (head >> 2)) + 128 + 32 * (head & 3);
}
__device__ __forceinline__ int dmap_glu(int n0) { return 256 * (n0 >> 7) + (n0 & 127); }
constexpr int DI_IN = (D / 64) * (INDIM / 32), DI_UQ = (QRANK / 64) * (3072 / 32), DI_UKV = (KVRANK / 64) * (4096 / 32), DI_SQ = (D / 64) * (D / 32), DI_LAYER = DI_IN + DI_UQ + DI_UKV + 3 * DI_SQ;
constexpr int DI_F = (D / 64) * (DFF / 32), DI_F2 = (DFF / 64) * (D / 32), DI_N = 2 * DI_LAYER + 2 * DI_F + DI_F2, DI_DEFER = DI_N - DI_LAYER;
static_assert(DI_DEFER % 8 == 0, "claim granularity");
__device__ __forceinline__ const float* pt_in(LAS unsigned char* lds, int i) {
    const unsigned long long v = ((volatile LAS unsigned long long*)(lds + PT_OFF))[i];
    const unsigned long long u = (unsigned long long)(unsigned)__builtin_amdgcn_readfirstlane((int)(unsigned)v) | ((unsigned long long)(unsigned)__builtin_amdgcn_readfirstlane((int)(unsigned)(v >> 32)) << 32);
    return (const float*)(const GAS float*)u; }
__device__ __forceinline__ void dense_item(const int it, LAS unsigned char* lds, unsigned char* ws, LAS float* scr, int lane) {
#define PIN(i) pt_in(lds, (i))
    constexpr int I_IN = DI_IN, I_UQ = DI_UQ, I_UKV = DI_UKV, I_SQ = DI_SQ, I_LAYER = DI_LAYER, I_F = DI_F; (void)I_SQ;
            int r = it;
            if (r < 2 * I_LAYER) { const int l = r / I_LAYER; r -= l * I_LAYER; unsigned char* wl = ws + WS_W + l * WL_STRIDE;
                if (r < I_IN) { const int nblk = INDIM / 32, kb = r / nblk, nb = r % nblk; transpose_item(PIN(I_WIN) + (size_t)l * D * INDIM, INDIM, 64 * kb, 32 * nb, (bf16*)(ws + WS_W + l * WL_STRIDE + WL_IN), D, dmap_in(32 * nb), 0, nullptr, scr, lane); return; } r -= I_IN;
                if (r < I_UQ) { const int nblk = 3072 / 32, kb = r / nblk, nb = r % nblk; transpose_item(PIN(I_WUQ) + (size_t)l * QRANK * 3072, 3072, 64 * kb, 32 * nb, (bf16*)(ws + WS_W + l * WL_STRIDE + WL_UQ), QRANK, dmap_uq(32 * nb), 0, PIN(I_QNG) + l * QRANK, scr, lane); return; } r -= I_UQ;
                if (r < I_UKV) { const int nblk = 4096 / 32, kb = r / nblk, nb = r % nblk; transpose_item(PIN(I_WUKV) + (size_t)l * KVRANK * 4096, 4096, 64 * kb, 32 * nb, (bf16*)(ws + WS_W + l * WL_STRIDE + WL_UKV), KVRANK, 32 * nb, 0, PIN(I_KVNG) + l * KVRANK, scr, lane); return; } r -= I_UKV;
                { const int which = r / I_SQ; r -= which * I_SQ; const int nblk = D / 32, kb = r / nblk, nb = r % nblk;
                  if (which == 0) transpose_item(PIN(I_WPA) + (size_t)l * D * D, D, 64 * kb, 32 * nb, (bf16*)(ws + WS_W + l * WL_STRIDE + WL_AB), 2 * D, 32 * nb, 0, nullptr, scr, lane);
                  else if (which == 1) transpose_item(PIN(I_WPB) + (size_t)l * D * D, D, 64 * kb, 32 * nb, (bf16*)(ws + WS_W + l * WL_STRIDE + WL_AB), 2 * D, 32 * nb, D, nullptr, scr, lane);
                  else transpose_item(PIN(I_WOUT) + (size_t)l * D * D, D, 64 * kb, 32 * nb, (bf16*)(ws + WS_W + l * WL_STRIDE + WL_OUT), D, 32 * nb, 0, nullptr, scr, lane);
                  return; }
            }
            r -= 2 * I_LAYER;
            if (r < 2 * I_F) { const int which = r / I_F; r -= which * I_F; const int nblk = DFF / 32, kb = r / nblk, nb = r % nblk;
                transpose_item(PIN(which ? I_FW3 : I_FW1), DFF, 64 * kb, 32 * nb, (bf16*)(ws + WS_WF13), D, dmap_glu(32 * nb) + (which ? 128 : 0), 0, nullptr, scr, lane); return; }
            r -= 2 * I_F;
            { const int nblk = D / 32, kb = r / nblk, nb = r % nblk; transpose_item(PIN(I_FW2), D, 64 * kb, 32 * nb, (bf16*)(ws + WS_WF2), DFF, 32 * nb, 0, nullptr, scr, lane); }
#undef PIN
}
constexpr int MC_IF = (D / 64) * (DFF / 32), MC_IF2 = (DFF / 64) * (D / 32), MC_IE = 2 * MC_IF + MC_IF2, MC_NIT = NE * MC_IE, MC_EARLY = 5 * MC_IE;
static_assert(MC_IE % 8 == 0, "claim granularity");
__device__ __forceinline__ int mc_start(int li) { return li == 0 ? 0 : (4 + li) * MC_IE; }
__device__ __forceinline__ int mc_count(int li) { return li == 0 ? MC_EARLY : MC_IE; }
__device__ __forceinline__ int mc_minseam(int li) { return li == 0 ? 0 : (li == 1 ? 6 : (li == 2 ? 9 : 13)); }
struct MoeConv { const float* mw1; const float* mw3; const float* mw2; const char* out; const char* ws; unsigned* ctr; };
__device__ __forceinline__ void moe_desc(const MoeConv& c, int it, TDesc& d) {
    const int e = it / MC_IE; int r = it - e * MC_IE;
    if (r < 2 * MC_IF) { const int wh = r / MC_IF; r -= wh * MC_IF; const int kb = r / (DFF / 32), nb = r % (DFF / 32);
        d.W = (wh ? c.mw3 : c.mw1) + (size_t)e * D * DFF; d.ldw = DFF; d.k0 = 64 * kb; d.n0 = 32 * nb; d.WT = (bf16*)moe_w13(e, c.out, c.ws); d.ldt = D; d.drow = dmap_glu(32 * nb) + (wh ? 128 : 0); }
    else { r -= 2 * MC_IF; const int kb = r / (D / 32), nb = r % (D / 32);
        d.W = c.mw2 + (size_t)e * DFF * D; d.ldw = D; d.k0 = 64 * kb; d.n0 = 32 * nb; d.WT = (bf16*)moe_w2(e, c.out, c.ws); d.ldt = DFF; d.drow = 32 * nb; }
}
template <int NPW>
__device__ __forceinline__ void moe_conv_run(const MoeConv& c, int base, int wave, int lane, LAS float* scr) {
    TDesc da{}, db{}; f32x4 va[8] = {}, vb[8] = {};
    const int lim = base < MC_EARLY ? MC_EARLY : (base / MC_IE + 1) * MC_IE;
    int it = base + wave; if (it < lim) { moe_desc(c, it, da); t_load(da, va, lane); }
#pragma unroll 1
    for (int j = 0; j < NPW; j += 2) { const int it1 = it + 8, it2 = it + 16; const bool h1 = (j + 1 < NPW) && it1 < lim, h2 = (j + 2 < NPW) && it2 < lim;
        if (h1) { moe_desc(c, it1, db); t_load(db, vb, lane); }
        if (it < lim) t_finish(da, va, scr, lane);
        if (h1) { if (h2) { moe_desc(c, it2, da); t_load(da, va, lane); } t_finish(db, vb, scr, lane); }
        it = it2; }
}
__device__ __forceinline__ unsigned moe_claim(const MoeConv& c, unsigned n, int seam, unsigned& mask) {
    if (seam <= 5 && !(mask & 16u)) { const unsigned b = xb_add(c.ctr + 4, n); if (b < (unsigned)DI_DEFER) return (unsigned)MC_NIT + 1u + b; mask |= 16u; }
#pragma unroll
    for (int li = 0; li < 4; ++li) if (seam >= mc_minseam(li) && !(mask & (1u << li))) { const unsigned b = xb_add(c.ctr + li, n); if (b < (unsigned)mc_count(li)) return (unsigned)mc_start(li) + b; mask |= 1u << li; }
    return (unsigned)MC_NIT;
}
__device__ __forceinline__ void xcd_barrier_fill(const XcdBarrier& b, const int tid, const MoeConv& mc, const int seam, LAS unsigned char* lds) {
    asm volatile("s_waitcnt vmcnt(0)" ::: "memory");
    __syncthreads();
    unsigned gen = 0u;
    if (tid == 0) {
        unsigned* bar = b.bar;
        __builtin_amdgcn_s_waitcnt(0);
        unsigned nloc = b.st[0], nx = b.st[1];
        if (nloc == 0u) { xcd_barrier_complete(bar, b.x, nloc, nx); b.st[0] = nloc; b.st[1] = nx; }
        const unsigned old = xb_add(&bar[XB_XSUB(b.x)], 1u);
        gen = old / nloc;
        if (old + 1u == (gen + 1u) * nloc) {
            __builtin_amdgcn_fence(__ATOMIC_RELEASE, "agent");
            asm volatile("s_waitcnt vmcnt(0)" ::: "memory");
            const unsigned og = xb_add(&bar[XB_TOP], 1u);
            const unsigned tg = og / nx;
            if (og + 1u == (tg + 1u) * nx) xb_add(&bar[XB_TOPGEN], 1u);
            else XB_SPIN(xb_ld(&bar[XB_TOPGEN]) == tg, bar);
            __builtin_amdgcn_fence(__ATOMIC_ACQUIRE, "agent");
            xb_add(&bar[XB_XGEN(b.x)], 1u);
            asm volatile("s_waitcnt vmcnt(0)" ::: "memory");
            b.st[2] = 1u;
        } else b.st[2] = 0u;
    }
    __syncthreads();
    const int wave = __builtin_amdgcn_readfirstlane(tid >> 6), lane = tid & 63;
    LAS float* scr = (LAS float*)(lds + RING_OFF + wave * 16384);
    unsigned done = b.st[2];
#pragma unroll 1
    while (done == 0u) {
        __syncthreads();
        if (tid == 0) {
            unsigned* bar = b.bar;
            if (xb_ld(&bar[XB_XGEN(b.x)]) != gen) { __builtin_amdgcn_fence(__ATOMIC_ACQUIRE, "agent"); asm volatile("s_waitcnt vmcnt(0)" ::: "memory"); b.st[2] = 1u; }
            else { unsigned mask = b.st[4]; const unsigned base = moe_claim(mc, 8u, seam, mask); b.st[4] = mask;
                if (base == (unsigned)MC_NIT) {
                    XB_SPIN(xb_ld(&bar[XB_XGEN(b.x)]) == gen, bar);
                    __builtin_amdgcn_fence(__ATOMIC_ACQUIRE, "agent"); asm volatile("s_waitcnt vmcnt(0)" ::: "memory"); b.st[2] = 1u; }
                else b.st[3] = base; }
        }
        __syncthreads();
        done = b.st[2];
        if (done == 0u) { const unsigned base = b.st[3];
            if (base > (unsigned)MC_NIT) dense_item(DI_LAYER + (int)(base - (unsigned)MC_NIT - 1u) + wave, lds, (unsigned char*)mc.ws, scr, lane);
            else moe_conv_run<1>(mc, (int)base, wave, lane, scr);
            asm volatile("s_waitcnt vmcnt(0)" ::: "memory"); }
    }
    __syncthreads();
}

struct Row8 { f32x4 v[8]; };
__device__ __forceinline__ void ln_normalize(Row8& r) {
    float s = 0.f;
#pragma unroll
    for (int j = 0; j < 8; ++j) s += (r.v[j].x + r.v[j].y) + (r.v[j].z + r.v[j].w);
    const float mean = wave_sum(s) * (1.f / D); float s2 = 0.f;
#pragma unroll
    for (int j = 0; j < 8; ++j) { r.v[j] = r.v[j] - mean; s2 += (r.v[j].x * r.v[j].x + r.v[j].y * r.v[j].y) + (r.v[j].z * r.v[j].z + r.v[j].w * r.v[j].w); }
    const float rstd = __builtin_amdgcn_rsqf(wave_sum(s2) * (1.f / D) + LN_EPS);
#pragma unroll
    for (int j = 0; j < 8; ++j) r.v[j] = r.v[j] * rstd;
}
__device__ __forceinline__ void ln_affine(Row8& r, const float* __restrict__ g, const float* __restrict__ b, int lane) {
#pragma unroll
    for (int jj = 0; jj < 4; ++jj) { const f32x4* gp = (const f32x4*)g + 2 * (lane + 64 * jj); const f32x4* bp = (const f32x4*)b + 2 * (lane + 64 * jj);
        r.v[2 * jj] = r.v[2 * jj] * gp[0] + bp[0]; r.v[2 * jj + 1] = r.v[2 * jj + 1] * gp[1] + bp[1]; }
}
__device__ __forceinline__ void ln_affine_r(Row8& r, const Row8& gv, const Row8& bv) {
#pragma unroll
    for (int j = 0; j < 8; ++j) r.v[j] = r.v[j] * gv.v[j] + bv.v[j];
}
__device__ __forceinline__ void row_store_bf16(const Row8& r, bf16* orow, int lane) {
#pragma unroll
    for (int jj = 0; jj < 4; ++jj) { v4u w; w.x = pk2(r.v[2 * jj].x, r.v[2 * jj].y); w.y = pk2(r.v[2 * jj].z, r.v[2 * jj].w); w.z = pk2(r.v[2 * jj + 1].x, r.v[2 * jj + 1].y); w.w = pk2(r.v[2 * jj + 1].z, r.v[2 * jj + 1].w);
        *((GAS v4u*)orow + lane + 64 * jj) = w; }
}
__device__ __forceinline__ void row_load_f32(Row8& r, const float* xrow, int lane) {
#pragma unroll
    for (int jj = 0; jj < 4; ++jj) { const GAS f32x4* p = (const GAS f32x4*)xrow + 2 * (lane + 64 * jj); r.v[2 * jj] = p[0]; r.v[2 * jj + 1] = p[1]; }
}
__device__ __forceinline__ f32x4 bf4(v2u w);
__device__ __forceinline__ void bf8(v4u w, f32x4& a, f32x4& b) { a = bf4((v2u){w.x, w.y}); b = bf4((v2u){w.z, w.w}); }
__device__ __forceinline__ void row_load_bf16(Row8& r, const bf16* xrow, int lane) {
#pragma unroll
    for (int jj = 0; jj < 4; ++jj) bf8(*((const GAS v4u*)xrow + lane + 64 * jj), r.v[2 * jj], r.v[2 * jj + 1]);
}
__device__ __forceinline__ void meta_partials_n(Row8& r, const bf16* P, int stride_rows, int row, int lane) {
#pragma unroll 1
    for (int p = 0; p < 3; ++p) { Row8 t; row_load_bf16(t, P + ((size_t)p * stride_rows + row) * 2048, lane);
#pragma unroll
        for (int j = 0; j < 8; ++j) r.v[j] = r.v[j] + t.v[j]; }
}
__device__ __forceinline__ void meta_partials(Row8& r, const bf16* P, int row, int lane) { meta_partials_n(r, P, 256, row, lane); }
__device__ __forceinline__ void row_store_f32(const Row8& r, float* orow, int lane) {
#pragma unroll
    for (int jj = 0; jj < 4; ++jj) { GAS f32x4* p = (GAS f32x4*)orow + 2 * (lane + 64 * jj); p[0] = r.v[2 * jj]; p[1] = r.v[2 * jj + 1]; }
}
__device__ __forceinline__ f32x4 bf4(v2u w) { return (f32x4){__uint_as_float(w.x << 16), __uint_as_float(w.x & 0xffff0000u), __uint_as_float(w.y << 16), __uint_as_float(w.y & 0xffff0000u)}; }
__device__ __forceinline__ int t5_bucket(int rel) {
    const int n = rel < 0 ? -rel : rel; int v;
    if (n < 8) v = n; else if (n < 12) v = 8; else if (n < 16) v = 9; else if (n < 23) v = 10; else if (n < 32) v = 11; else if (n < 46) v = 12; else if (n < 64) v = 13; else if (n < 91) v = 14; else v = 15;
    return (rel > 0 ? 16 : 0) + v;
}

__device__ __forceinline__ void router_row(const Row8& r, const LAS f32x4* rwl, const float* __restrict__ rbias, int lane, int& i0, int& i1, float& g0, float& g1) {
    float lg[8];
#pragma unroll
    for (int e = 0; e < 8; ++e) lg[e] = 0.f;
#pragma unroll
    for (int j = 0; j < 8; ++j) {
#pragma unroll
        for (int q = 0; q < 4; ++q) { const f32x4 w0 = rwl[(j * 4 + q) * 64 + lane], w1 = rwl[2048 + (j * 4 + q) * 64 + lane]; const float y = r.v[j][q];
            lg[0] += y * w0.x; lg[1] += y * w0.y; lg[2] += y * w0.z; lg[3] += y * w0.w; lg[4] += y * w1.x; lg[5] += y * w1.y; lg[6] += y * w1.z; lg[7] += y * w1.w; } }
#pragma unroll
    for (int e = 0; e < 8; ++e) lg[e] = wave_sum(lg[e]) + rbias[e];
    i0 = 0; float v0 = lg[0];
#pragma unroll
    for (int e = 1; e < 8; ++e) if (lg[e] > v0) { v0 = lg[e]; i0 = e; }
    i1 = -1; float v1 = -3.0e38f;
#pragma unroll
    for (int e = 0; e < 8; ++e) if (e != i0 && lg[e] > v1) { v1 = lg[e]; i1 = e; }
    const float e1 = __expf(v1 - v0); g0 = 1.f / (1.f + e1); g1 = e1 / (1.f + e1);
}
struct Args { const float* in[N_IN]; float* out; unsigned char* ws; int ph_lo, ph_hi; };

__global__ void __launch_bounds__(NWAVES * 64, 2) mk_fwd(Args args) {
    extern __shared__ __attribute__((aligned(16))) unsigned char lds_raw[];
    LAS unsigned char* const lds = (LAS unsigned char*)lds_raw;
    char* const ldsg = (char*)lds_raw;
    volatile LAS unsigned* const MISC = (volatile LAS unsigned*)(lds + MISC_OFF);
    const int wave = __builtin_amdgcn_readfirstlane((int)threadIdx.x >> 6);
    const int tid = wave * 64 + lane_id();
    const int G_k = gridDim.x; const int bx_k = blockIdx.x;
    for (int u = tid; u < (LDS_BYTES - LDSCTL_OFF) / 4; u += NWAVES * 64) ((LAS unsigned*)(lds + LDSCTL_OFF))[u] = 0u;
    __syncthreads();
    volatile LAS unsigned long long* const PT = (volatile LAS unsigned long long*)(lds + PT_OFF);
    if (tid == 0) {
#pragma unroll
        for (int i = 0; i < N_IN; ++i) PT[i] = (unsigned long long)args.in[i];
        PT[N_IN] = (unsigned long long)args.out; PT[N_IN + 1] = (unsigned long long)args.ws; }
    const int lo = args.ph_lo, hi = args.ph_hi;
    __syncthreads();
#define LDP(i) ({ const unsigned long long v_ = PT[i]; (unsigned long long)(unsigned)__builtin_amdgcn_readfirstlane((int)(unsigned)v_) | ((unsigned long long)(unsigned)__builtin_amdgcn_readfirstlane((int)(unsigned)(v_ >> 32)) << 32); })
#define INP(i) ((const float*)(const GAS float*)LDP(i))
#define WSP() ((unsigned char*)(GAS unsigned char*)LDP(N_IN + 1))
#define OUTP() ((float*)(GAS float*)LDP(N_IN))
#define PH_WS() int* SLOT_TOK; float* SLOT_GATE; int* TOK_SLOT; asm volatile("" ::: "memory"); int tid = wave * 64 + lane_id(); asm volatile("" : "+v"(tid)); const int lane = tid & 63; (void)lane; \
    int G = G_k, bx = bx_k; asm volatile("" : "+s"(G), "+s"(bx));     \
    const int vcu = (G % 8 == 0) ? (bx % 8) * (G / 8) + bx / 8 : bx; const int gw = vcu * NWAVES + wave, NGW = G * NWAVES; (void)gw; (void)NGW; (void)vcu; unsigned char* const ws = WSP(); \
    bf16* const HB = (bf16*)(ws + WS_HB); float* const CS = (float*)(ws + WS_CS); float* const SN = (float*)(ws + WS_SN); float* const SSQ = (float*)(ws + WS_SSQ); bf16* const X = (bf16*)(ws + WS_X); \
    SLOT_TOK = (int*)(ws + WS_SLOTTOK); SLOT_GATE = (float*)(ws + WS_SLOTGATE); TOK_SLOT = (int*)(ws + WS_TOKSLOT); (void)HB; (void)CS; (void)SN; (void)SSQ; (void)X; (void)SLOT_TOK; (void)SLOT_GATE; (void)TOK_SLOT
    XcdBarrier bar; { unsigned char* const ws0 = WSP(); bar.bar = (unsigned*)(ws0 + WS_CTL) + CW_BAR; bar.x = 0; bar.st = nullptr;
    if (hi - lo > 1) bar = xcd_barrier_post((unsigned*)(ws0 + WS_CTL) + CW_BAR, MISC + 8, tid); }
#define IN(k) (lo <= (k) && (k) < hi)
#define SEAM(k) do { if (IN(k) && IN((k) + 1)) xcd_barrier(bar, wave * 64 + lane_id()); } while (0)
#define MOECONV(wsp_) MoeConv{INP(I_MW1), INP(I_MW3), INP(I_MW2), (const char*)OUTP(), (const char*)(wsp_), (unsigned*)((wsp_) + WS_CTL) + CW_FILL}
#define SEAMF(k) do { if (IN(k) && IN((k) + 1)) { unsigned char* const wsf_ = WSP(); const MoeConv mc_ = MOECONV(wsf_); xcd_barrier_fill(bar, wave * 64 + lane_id(), mc_, (k), lds); } } while (0)

    if (IN(0)) { PH_WS();
        LAS float* scr = (LAS float*)(lds + RING_OFF + wave * 16384);
        for (int it = gw; it < DI_LAYER; it += NGW) dense_item(it, lds, ws, scr, lane);
        for (int i = gw * 64 + lane; i < 2 * 192 * 256; i += NGW * 64) { const int l = i / (192 * 256), q = i % (192 * 256), rr = q / 256, c16 = q % 256; const int row = rr < 96 ? 1312 + rr : 1440 + (rr - 96);
            *(GAS v4u*)(ws + WS_W + l * WL_STRIDE + WL_IN + (size_t)row * (D * 2) + c16 * 16) = (v4u){0u, 0u, 0u, 0u}; }
        for (int i = gw * 64 + lane; i < LPOS * 32; i += NGW * 64) { const int pos = i >> 5, k = i & 31; const float inv = powf(10000.f, -(float)(2 * k) / 64.f); const float ang = (float)pos * inv; CS[i] = cosf(ang); SN[i] = sinf(ang); }
        for (int i = gw * 64 + lane; i < 16 * 512; i += NGW * 64) { const int hh = i >> 9, rel = (i & 511) - 256; const float bv = INP(I_RELB)[t5_bucket(rel) * 16 + hh] * LOG2E;
            ((float*)(ws + WS_TW))[i] = (rel >= -128 && rel <= 128) ? bv : att::NEG_BIG; if (rel < 0) ((float*)(ws + WS_TM))[hh * 256 + rel + 256] = bv; }
        if (gw == 0 && lane < 32) ((float*)(ws + WS_SINK))[lane] = INP(I_SINK)[lane] * LOG2E;
        { const float* eg = INP(I_EMB_G); const float* eb = INP(I_EMB_B); const float* xin = INP(I_X); const float* min_ = INP(I_META);
#define P0_LOAD(R, m) row_load_f32(R, (m) < TREAL ? xin + (size_t)(m) * D : min_ + (size_t)(((m) - TREAL) & 15) * D, lane)
#define P0_PROC(R, m) do { ln_normalize(R); ln_affine_r(R, gv, bv); row_store_bf16(R, HB + (size_t)(m) * D, lane); } while (0)
          Row8 gv, bv; row_load_f32(gv, eg, lane); row_load_f32(bv, eb, lane);
          Row8 ra{}, rb{}; int m = gw; if (m < T) P0_LOAD(ra, m);
          for (; m < T; m += 2 * NGW) { const int m1 = m + NGW, m2 = m + 2 * NGW; if (m1 < T) P0_LOAD(rb, m1); P0_PROC(ra, m); if (m1 < T) { if (m2 < T) P0_LOAD(ra, m2); P0_PROC(rb, m1); } }
#undef P0_LOAD
#undef P0_PROC
          for (int mz = T + gw; mz < TP; mz += NGW) { GAS v2u* o8 = (GAS v2u*)(HB + (size_t)mz * D) + lane;
#pragma unroll
              for (int j = 0; j < 8; ++j) o8[64 * j] = (v2u){0u, 0u}; } }
    }
    SEAM(0);

#pragma unroll 1
    for (int l = 0; l < 2; ++l) {
        const int P = 1 + 9 * l + (l ? 0 : 0);
        const int nM_all = TREAL / 256;
        const int nM_post = TREAL / 256; const bool tail_post = (l == 0);
        if (IN(P + 0)) { PH_WS();
            ProbDense pr; pr.so.init(nM_all, NIN / 256, G, bx, true); pr.A = (const char*)HB; pr.Bt = (const char*)(ws + WS_W + l * WL_STRIDE + WL_IN); pr.tstep = 256 * (size_t)D * 2;
            epi::EpiWin E{(bf16*)(ws + WS_CQ), (bf16*)(ws + WS_CKV), (bf16*)(ws + WS_KR), (bf16*)(ws + WS_QB), (bf16*)(ws + WS_KB), (bf16*)(ws + WS_VB), (bf16*)(ws + WS_GR), (bf16*)(ws + WS_GBB), SSQ, CS, SN};
            pg8::gemm_phase<epi::EpiWin, ProbDense>(lds + RING_OFF, D, pr, E, tid);
        }
        SEAMF(P + 0);
        if (IN(P + 1)) { PH_WS();
            { ProbDense pr; pr.so.init(nM_all, 3072 / 256, G, bx, true); pr.A = (const char*)(ws + WS_CQ); pr.Bt = (const char*)(ws + WS_W + l * WL_STRIDE + WL_UQ); pr.tstep = 256 * (size_t)QRANK * 2;
              epi::EpiUq E{(bf16*)(ws + WS_Q), SSQ, CS, SN};
              pg8::gemm_phase<epi::EpiUq, ProbDense>(lds + RING_OFF, QRANK, pr, E, tid); }
            { ProbDense pr; pr.so.init(nM_all, 4096 / 256, G, bx, true); pr.A = (const char*)(ws + WS_CKV); pr.Bt = (const char*)(ws + WS_W + l * WL_STRIDE + WL_UKV); pr.tstep = 256 * (size_t)KVRANK * 2;
              epi::EpiUkv E{(bf16*)(ws + WS_KN), (bf16*)(ws + WS_V), SSQ};
              pg8::gemm_phase<epi::EpiUkv, ProbDense>(lds + RING_OFF, KVRANK, pr, E, tid); }
        }
        SEAMF(P + 1);
        if (IN(P + 2)) { PH_WS();
            const int nmla_full = NB * NH * 16, nmeta = l == 0 ? NB * NH : 0, nj = l == 0 ? 65 : 64, nswa = NB * 4 * nj, ndyn = nmeta + nswa;
            unsigned* const actr = (unsigned*)(ws + WS_CTL) + CW_ATT + l;
            int tables_hk = -1, ustat = vcu;
            unsigned nxt = 0u;
_Pragma("unroll 1")
            for (;;) {
                int kind, b, h, qj;
                if (ustat < nmla_full) { kind = 0; qj = ustat & 15; h = (ustat >> 4) & 15; b = ustat >> 8; ustat += G;
                    if (ustat >= nmla_full && tid == 0) nxt = xb_add(actr, 1u); }
                else {
                    __syncthreads(); if (tid == 0) MISC[11] = nxt; __syncthreads();
                    const int it = __builtin_amdgcn_readfirstlane((int)MISC[11]);
                    if (it >= ndyn) break;
                    if (it < nmeta) { kind = 0; b = it >> 4; h = it & 15; qj = 16; }
                    else { kind = 1; const int v = it - nmeta, per_hk = NB * nj; h = v / per_hk; const int r = v - h * per_hk; b = r / nj; qj = r - b * nj; }
                }
                asm volatile("" : "+s"(kind), "+s"(b), "+s"(h), "+s"(qj));
                if (kind == 0) att::mla_unit4((att::lds_ptr)(lds + RING_OFF), (const bf16*)(ws + WS_Q), (const bf16*)(ws + WS_KN), (const bf16*)(ws + WS_KR), (const bf16*)(ws + WS_V), (bf16*)(ws + WS_OAB), b, h, qj, tid);
                else att::swa_unit2((att::lds_ptr)(lds + RING_OFF), (const bf16*)(ws + WS_QB), (const bf16*)(ws + WS_KB), (const bf16*)(ws + WS_VB), (bf16*)(ws + WS_OAB), (const float*)(ws + WS_TW), (const float*)(ws + WS_TM), (const float*)(ws + WS_SINK) + 16 * l, b, h, qj, tables_hk, tid);
                if (ustat >= nmla_full && !(kind == 0 && qj < 16) && tid == 0) nxt = xb_add(actr, 1u);
            }
        }
        SEAMF(P + 2);
        if (IN(P + 3)) { PH_WS();
            ProbDense pr; pr.so.init(nM_post, D / 256, G, bx, tail_post); pr.A = (const char*)(ws + WS_OAB); pr.Bt = (const char*)(ws + WS_W + l * WL_STRIDE + WL_AB); pr.tstep = 256 * (size_t)(2 * D) * 2;
            epi::EpiProj E{(bf16*)(ws + WS_MG), (const bf16*)(ws + WS_GR), (const bf16*)(ws + WS_GBB)};
            pg8::gemm_phase<epi::EpiProj, ProbDense>(lds + RING_OFF, 2 * D, pr, E, tid);
        }
        SEAMF(P + 3);
        if (IN(P + 4)) { PH_WS();
            ProbDense pr; pr.so.init(nM_post, D / 256, G, bx, tail_post, 2); pr.A = (const char*)(ws + WS_MG); pr.Bt = (const char*)(ws + WS_W + l * WL_STRIDE + WL_OUT); pr.tstep = 256 * (size_t)D * 2;
            epi::EpiResid E{X, HB, (bf16*)(ws + WS_XP)};
            pg8::gemm_phase<epi::EpiResid, ProbDense>(lds + RING_OFF, D, pr, E, tid);
        }
        SEAMF(P + 4);
        if (IN(P + 5)) { PH_WS();
            if (l == 0) {
                LAS float* scr = (LAS float*)(lds + RING_OFF + wave * 16384); unsigned* const dctr = (unsigned*)(ws + WS_CTL) + CW_FILL + 4;
_Pragma("unroll 1")
                for (;;) {
                    __syncthreads(); if (tid == 0) MISC[11] = xb_add(dctr, 8u); __syncthreads();
                    const unsigned base = MISC[11];
                    if (base >= (unsigned)DI_DEFER) break;
                    dense_item(DI_LAYER + (int)base + wave, lds, ws, scr, lane);
                }
                asm volatile("s_waitcnt vmcnt(0)" ::: "memory"); __syncthreads();
            }
            const float* g = INP(I_LMG) + l * D; const float* bta = INP(I_LMB) + l * D;
            const int nrows = l == 0 ? T : TREAL;
            int h0 = 0, h1 = 0, h2 = 0, h3 = 0, h4 = 0, h5 = 0, h6 = 0, h7 = 0;
            LAS f32x4* const rwl = (LAS f32x4*)(lds + RING_OFF);
            if (l == 1) { const GAS f32x4* rwg = (const GAS f32x4*)INP(I_RW); for (int i = tid; i < D * 2; i += NWAVES * 64) { const int k = i >> 1, hf = i & 1, e = k & 7, jq = (2 * (k >> 9) + (e >> 2)) * 4 + (e & 3); rwl[hf * 2048 + jq * 64 + ((k >> 3) & 63)] = rwg[i]; } __syncthreads(); }
#define LM_PROC(r, m) do { if (l == 0 && (m) >= TREAL) meta_partials(r, (const bf16*)(ws + WS_XP), (m) - TREAL, lane); ln_normalize(r); ln_affine_r(r, gv, bv); row_store_bf16(r, HB + (size_t)(m) * D, lane); \
                if (l == 1) { int i0_, i1_; float g0_, g1_; router_row(r, rwl, rbias, lane, i0_, i1_, g0_, g1_); \
                    if (lane == 0) { int* ti = (int*)(ws + WS_TOPI); float* tg = (float*)(ws + WS_TOPG); ti[2 * (m)] = i0_; ti[2 * (m) + 1] = i1_; tg[2 * (m)] = g0_; tg[2 * (m) + 1] = g1_; } \
                    h0 += (i0_ == 0) + (i1_ == 0); h1 += (i0_ == 1) + (i1_ == 1); h2 += (i0_ == 2) + (i1_ == 2); h3 += (i0_ == 3) + (i1_ == 3); \
                    h4 += (i0_ == 4) + (i1_ == 4); h5 += (i0_ == 5) + (i1_ == 5); h6 += (i0_ == 6) + (i1_ == 6); h7 += (i0_ == 7) + (i1_ == 7); } } while (0)
            { const float* rbias = INP(I_RB); Row8 gv, bv; row_load_f32(gv, g, lane); row_load_f32(bv, bta, lane); Row8 ra{}, rb{}; int m = gw; if (m < nrows) row_load_bf16(ra, X + (size_t)m * D, lane);
              for (; m < nrows; m += 2 * NGW) { const int m1 = m + NGW, m2 = m + 2 * NGW; if (m1 < nrows) row_load_bf16(rb, X + (size_t)m1 * D, lane); LM_PROC(ra, m);
                  if (m1 < nrows) { if (m2 < nrows) row_load_bf16(ra, X + (size_t)m2 * D, lane); LM_PROC(rb, m1); } } }
#undef LM_PROC
            if (l == 1 && lane == 0) { int* wh = (int*)(ws + WS_WHIST) + gw * 8; wh[0] = h0; wh[1] = h1; wh[2] = h2; wh[3] = h3; wh[4] = h4; wh[5] = h5; wh[6] = h6; wh[7] = h7; }
        }
        if (l == 0) SEAM(P + 5); else SEAMF(P + 5);
        if (l == 0) {
            if (IN(P + 6)) { PH_WS();
                ProbDense pr; pr.so.init(nM_all, 2 * DFF / 256, G, bx, true); pr.A = (const char*)HB; pr.Bt = (const char*)(ws + WS_WF13); pr.tstep = 256 * (size_t)D * 2;
                epi::EpiSwiglu E{(bf16*)(ws + WS_ACT)};
                pg8::gemm_phase<epi::EpiSwiglu, ProbDense>(lds + RING_OFF, D, pr, E, tid);
            }
            SEAMF(P + 6);
            if (IN(P + 7)) { PH_WS();
                ProbDense pr; pr.so.init(nM_all, D / 256, G, bx, true, 2); pr.A = (const char*)(ws + WS_ACT); pr.Bt = (const char*)(ws + WS_WF2); pr.tstep = 256 * (size_t)DFF * 2;
                epi::EpiResid E{X, HB, (bf16*)(ws + WS_XP)};
                pg8::gemm_phase<epi::EpiResid, ProbDense>(lds + RING_OFF, DFF, pr, E, tid);
            }
            SEAMF(P + 7);
            if (IN(P + 8)) { PH_WS();
                const float* g = INP(I_LFG); const float* bta = INP(I_LFB);
#define LF_PROC(r, m) do { if ((m) >= TREAL) meta_partials(r, (const bf16*)(ws + WS_XP), (m) - TREAL, lane); ln_normalize(r); ln_affine_r(r, gv, bv); row_store_bf16(r, HB + (size_t)(m) * D, lane); } while (0)
                { Row8 gv, bv; row_load_f32(gv, g, lane); row_load_f32(bv, bta, lane); Row8 ra{}, rb{}; int m = gw; if (m < T) row_load_bf16(ra, X + (size_t)m * D, lane);
                  for (; m < T; m += 2 * NGW) { const int m1 = m + NGW, m2 = m + 2 * NGW; if (m1 < T) row_load_bf16(rb, X + (size_t)m1 * D, lane); LF_PROC(ra, m);
                      if (m1 < T) { if (m2 < T) row_load_bf16(ra, X + (size_t)m2 * D, lane); LF_PROC(rb, m1); } } }
#undef LF_PROC
            }
            SEAM(P + 8);
        } else {
            if (IN(P + 6)) { PH_WS();
                LAS int* hist = (LAS int*)(lds + RING_OFF);
                LAS int* segsum = hist + 2048 * 8;
                LAS int* segpre = segsum + 64 * 8;
                LAS int* tot = segpre + 64 * 8;
                const int* wh = (const int*)(ws + WS_WHIST);
                for (int i = tid; i < NGW * 8; i += NWAVES * 64) hist[i] = wh[i];
                __syncthreads();
                { const int e = tid & 7, seg = tid >> 3; int s = 0;
_Pragma("unroll 1")
                  for (int w = 0; w < 32; ++w) { const int ww = seg * 32 + w; if (ww < NGW) s += hist[ww * 8 + e]; } segsum[seg * 8 + e] = s; }
                __syncthreads();
                if (tid < 8) { int run = 0;
_Pragma("unroll 1")
                    for (int s = 0; s < 64; ++s) { segpre[s * 8 + tid] = run; run += segsum[s * 8 + tid]; } tot[tid] = run; }
                __syncthreads();
                if (tid == 0) { int ts = 0; for (int e = 0; e < 8; ++e) { tot[8 + e] = ts; ts += (tot[e] + 255) >> 8; } tot[16] = ts;
                    if (bx == 0) for (int e = 0; e < 9; ++e) ((int*)(ws + WS_CTL))[CW_MOE_TS + e] = tot[8 + e]; }
                __syncthreads();
                int base = 0;
                if (lane < 8) { base = tot[8 + lane] * 256 + segpre[(gw >> 5) * 8 + lane];
_Pragma("unroll 1")
                    for (int w = (gw & ~31); w < gw; ++w) base += hist[w * 8 + lane]; }
                const int* ti = (const int*)(ws + WS_TOPI); const float* tg = (const float*)(ws + WS_TOPG);
                for (int i0 = 0; gw + i0 * NGW < TREAL; i0 += 16) {
                    const int m = gw + (i0 + (lane >> 1)) * NGW, kk = lane & 1; const bool valid = lane < 32 && m < TREAL;
                    const int e = valid ? ti[2 * m + kk] : 8; const float gt = valid ? tg[2 * m + kk] : 0.f;
                    int myslot = 0;
#pragma unroll
                    for (int e2 = 0; e2 < 8; ++e2) { const unsigned long long mask = __ballot(e == e2); const int b_e = __builtin_amdgcn_readlane(base, e2);
                        if (e == e2) myslot = b_e + __popcll(mask & ((1ull << lane) - 1ull)); if (lane == e2) base += __popcll(mask); }
                    if (valid) { SLOT_TOK[myslot] = m; SLOT_GATE[myslot] = gt; TOK_SLOT[2 * m + kk] = myslot; }
                }
                if (vcu < 8) { const int e = vcu; const int s0 = tot[8 + e] * 256 + tot[e], s1 = tot[8 + e + 1] * 256; for (int s = s0 + tid; s < s1; s += NWAVES * 64) { SLOT_TOK[s] = T; SLOT_GATE[s] = 0.f; } }
                __syncthreads();
                { LAS float* scr = (LAS float*)(lds + RING_OFF + wave * 16384);
                  const MoeConv mc = MOECONV(ws);
                  unsigned nxt = 0u, lmask = 16u; if (tid == 0) nxt = moe_claim(mc, 32u, 99, lmask);
_Pragma("unroll 1")
                  for (;;) {
                      __syncthreads();
                      if (tid == 0) MISC[11] = nxt;
                      __syncthreads();
                      const unsigned base = MISC[11];
                      if (base >= (unsigned)MC_NIT) break;
                      if (tid == 0) nxt = moe_claim(mc, 32u, 99, lmask);
                      moe_conv_run<4>(mc, (int)base, wave, lane, scr);
                  } }
            }
            SEAM(P + 6);
            MoeTiles mt;
            if (IN(P + 7) || IN(P + 8)) { unsigned char* const ws = WSP();
#pragma unroll
                for (int e = 0; e < 9; ++e) mt.ts[e] = __builtin_amdgcn_readfirstlane(((const int*)(ws + WS_CTL))[CW_MOE_TS + e]);
            } else {
#pragma unroll
                for (int e = 0; e < 9; ++e) mt.ts[e] = 0;
            }
            if (IN(P + 7)) { PH_WS();
                ProbMoe1 pr; pr.so.init(mt.ts[8], 2 * DFF / 256, G, bx); pr.HBp = (const char*)HB; pr.slot_tok = SLOT_TOK; pr.outp = (const char*)OUTP(); pr.wsb = (const char*)ws; pr.mt = mt;
                epi::EpiSwiglu E{(bf16*)(ws + WS_MACT)};
                pg8::gemm_phase<epi::EpiSwiglu, ProbMoe1, true>(lds + RING_OFF, D, pr, E, tid);
            }
            SEAM(P + 7);
            if (IN(P + 8)) { PH_WS();
                ProbMoe2 pr; pr.so.init(MOE_MAIN_TILES, D / 256, G, bx); pr.extra = mt.ts[8] - MOE_MAIN_TILES; pr.ACTp = (const char*)(ws + WS_MACT); pr.outp = (const char*)OUTP(); pr.wsb = (const char*)ws; pr.mt = mt;
                epi::EpiMoeDown E{(bf16*)(ws + WS_Y), SLOT_GATE, (bf16*)(ws + WS_YP)};
                pg8::gemm_phase<epi::EpiMoeDown, ProbMoe2>(lds + RING_OFF, DFF, pr, E, tid);
            }
            SEAM(P + 8);
            if (IN(P + 9)) { PH_WS();
                const float* g = INP(I_LFG) + D; const float* bta = INP(I_LFB) + D; const bf16* Y = (const bf16*)(ws + WS_Y);
#define FL_LOAD(R, m, F) do { const int s0_ = TOK_SLOT[2 * (m)], s1_ = TOK_SLOT[2 * (m) + 1]; F = (s0_ >= MOE_MAIN_TILES * 256 ? 1 : 0) | (s1_ >= MOE_MAIN_TILES * 256 ? 2 : 0); \
                    _Pragma("unroll") for (int jj = 0; jj < 4; ++jj) { f32x4 h0, h1, a0, a1, b0, b1; bf8(*((const GAS v4u*)(HB + (size_t)(m) * D) + lane + 64 * jj), h0, h1); \
                        bf8(*((const GAS v4u*)(Y + (size_t)s0_ * D) + lane + 64 * jj), a0, a1); bf8(*((const GAS v4u*)(Y + (size_t)s1_ * D) + lane + 64 * jj), b0, b1); \
                        R.v[2 * jj] = (h0 * ALPHA + a0) + b0; R.v[2 * jj + 1] = (h1 * ALPHA + a1) + b1; } } while (0)
#define FL_PROC(R, m, F) do { if (__builtin_amdgcn_readfirstlane(F)) {                           \
                        _Pragma("unroll 1") for (int k_ = 0; k_ < 2; ++k_) { const int s_ = __builtin_amdgcn_readfirstlane(TOK_SLOT[2 * (m) + k_]); if (s_ >= MOE_MAIN_TILES * 256) meta_partials_n(R, YP, 2048, s_ - MOE_MAIN_TILES * 256, lane); } } \
                    ln_normalize(R); ln_affine_r(R, gv, bv); row_store_f32(R, outp + (size_t)(m) * D, lane); } while (0)
                { float* const outp = OUTP(); const bf16* YP = (const bf16*)(ws + WS_YP); Row8 gv, bv; row_load_f32(gv, g, lane); row_load_f32(bv, bta, lane); Row8 ra{}, rb{}; int fa = 0, fb = 0; int m = gw; if (m < TREAL) FL_LOAD(ra, m, fa);
                  for (; m < TREAL; m += 2 * NGW) { const int m1 = m + NGW, m2 = m + 2 * NGW; if (m1 < TREAL) FL_LOAD(rb, m1, fb); FL_PROC(ra, m, fa);
                      if (m1 < TREAL) { if (m2 < TREAL) FL_LOAD(ra, m2, fa); FL_PROC(rb, m1, fb); } } }
#undef FL_LOAD
#undef FL_PROC
            }
        }
    }
#undef IN
#undef SEAM
}

#ifndef MK_ONE_LAUNCH
#define MK_ONE_LAUNCH 0
#endif
extern "C" void kernel_launch(void* const* d_in, const int* in_sizes, int n_in, void* d_out, int out_size, void* d_ws, size_t ws_size, hipStream_t stream) {
    static int grid = 0;
    if (grid == 0) {
        if (n_in != N_IN || in_sizes[0] != NB * SEQ * D || out_size != NB * SEQ * D || ws_size < WS_END) { fprintf(stderr, "kernel_launch: shape mismatch: n_in %d in0 %d out %d ws %zu (need %zu)\n", n_in, n_in > 0 ? in_sizes[0] : -1, out_size, ws_size, (size_t)WS_END); grid = -1; return; }
        int dev = 0, cus = 0, per_cu = 0;
        if (hipGetDevice(&dev) != hipSuccess || hipDeviceGetAttribute(&cus, hipDeviceAttributeMultiprocessorCount, dev) != hipSuccess) { fprintf(stderr, "kernel_launch: device query failed\n"); grid = -1; return; }
        if (hipFuncSetAttribute((const void*)mk_fwd, hipFuncAttributeMaxDynamicSharedMemorySize, LDS_BYTES) != hipSuccess) { fprintf(stderr, "kernel_launch: hipFuncSetAttribute failed\n"); grid = -1; return; }
        if (hipOccupancyMaxActiveBlocksPerMultiprocessor(&per_cu, (const void*)mk_fwd, NWAVES * 64, LDS_BYTES) != hipSuccess || per_cu < 1) fprintf(stderr, "kernel_launch: occupancy query reports %d\n", per_cu);
        (void)hipGetLastError();
        grid = cus;
    }
    if (grid < 0) return;
    if (hipMemsetAsync((char*)d_ws + WS_CTL, 0, CTL_ZERO_BYTES, stream) != hipSuccess) { fprintf(stderr, "kernel_launch: memset failed\n"); return; }
    Args a{};
    for (int i = 0; i < N_IN; ++i) a.in[i] = (const float*)d_in[i];
    a.out = (float*)d_out; a.ws = (unsigned char*)d_ws;
#if MK_ONE_LAUNCH
    a.ph_lo = 0; a.ph_hi = N_PHASES;
    hipLaunchKernelGGL(mk_fwd, dim3(grid), dim3(NWAVES * 64), LDS_BYTES, stream, a);
#else
    for (int p = 0; p < N_PHASES; ++p) { a.ph_lo = p; a.ph_hi = p + 1; hipLaunchKernelGGL(mk_fwd, dim3(grid), dim3(NWAVES * 64), LDS_BYTES, stream, a); }
#endif
    const hipError_t le = hipPeekAtLastError();
    if (le != hipSuccess) fprintf(stderr, "kernel_launch: launch failed: %s\n", hipGetErrorName(le));
}
```
